# Optimizing an MI355X kernel written in HIP

```python
import math
import jax, jax.numpy as jnp
from jax import lax
import numpy as np

D_MODEL = 1024
BATCH = 8
SEQ = 4096
DEPTH = 1

ATTN_HEADS = 8
ATTN_HEAD_DIM = 64
ATTN_WIDTH = ATTN_HEADS * ATTN_HEAD_DIM
MOBA_BLOCK = 256
MOBA_TOPK = 3
Q_CHUNK = 32
POOL_WIDTH = D_MODEL // 2
POOL_WINDOWS = (2, 4, 8, 16)
POOL_GROUPS = len(POOL_WINDOWS)
POOL_GROUP_DIM = POOL_WIDTH // POOL_GROUPS
IN_WIDTH = 3 * ATTN_WIDTH + POOL_WIDTH + 2 * D_MODEL
PEER_HEADS = 8
PEER_KEYS = 128
PEER_EXPERTS = PEER_KEYS * PEER_KEYS
PEER_QUERY_DIM = 256
PEER_HALF = PEER_QUERY_DIM // 2
PEER_TOPK = 16
PEER_CHUNK = 128
RMS_EPS = 1e-6
NEG_INF = -1e30

kernel_name = "hybrid_moba_pool_peer_block"


def rms_norm(x, gain):
    xf = x.astype(jnp.float32)
    y = xf * lax.rsqrt(jnp.mean(xf * xf, axis=-1, keepdims=True) + RMS_EPS)
    return (y * gain.astype(jnp.float32)).astype(x.dtype)


def modulate(h, shift, scale):
    return h * (1.0 + scale[:, None, :]) + shift[:, None, :]


def alibi_slopes(n_heads):
    return jnp.asarray(2.0 ** (-8.0 * (np.arange(n_heads) + 1) / n_heads), dtype=jnp.float32)


def moba_attention(q, k, v):
    B, H, S, hd = q.shape
    nb = -(-S // MOBA_BLOCK)
    s_pad = nb * MOBA_BLOCK
    pad = ((0, 0), (0, 0), (0, s_pad - S), (0, 0))
    kp = jnp.pad(k, pad)
    vp = jnp.pad(v, pad)
    kb = kp.reshape(B, H, nb, MOBA_BLOCK, hd)
    vb = vp.reshape(B, H, nb, MOBA_BLOCK, hd)
    k_mean = jnp.mean(kb.astype(jnp.float32), axis=3)
    n_sel = min(MOBA_TOPK, nb - 1)
    slopes = alibi_slopes(H)[None, :, None, None]
    scale = hd ** -0.5
    b_ix = jnp.arange(B)[:, None, None, None]
    h_ix = jnp.arange(H)[None, :, None, None]
    in_block = jnp.arange(MOBA_BLOCK)

    def chunk(start):
        qc = lax.dynamic_slice_in_dim(q, start, Q_CHUNK, axis=2).astype(jnp.float32) * scale
        q_pos = start + jnp.arange(Q_CHUNK)
        blk = start // MOBA_BLOCK
        own_start = blk * MOBA_BLOCK
        k_own = lax.dynamic_slice_in_dim(kp, own_start, MOBA_BLOCK, axis=2).astype(jnp.float32)
        v_own = lax.dynamic_slice_in_dim(vp, own_start, MOBA_BLOCK, axis=2).astype(jnp.float32)
        dist_own = q_pos[:, None] - (own_start + in_block)[None, :]
        lg_own = jnp.einsum('bhqd,bhkd->bhqk', qc, k_own) - slopes * dist_own
        lg_own = jnp.where(dist_own >= 0, lg_own, NEG_INF)
        if n_sel == 0:
            p_own = jax.nn.softmax(lg_own, axis=-1)
            out = jnp.einsum('bhqk,bhkd->bhqd', p_own, v_own)
            return out.astype(q.dtype)
        gate = jnp.einsum('bhqd,bhnd->bhqn', qc, k_mean)
        gate = jnp.where(jnp.arange(nb) < blk, gate, NEG_INF)
        _, sel = lax.top_k(gate, n_sel)
        sel_valid = jnp.arange(n_sel) < blk
        k_sel = kb[b_ix, h_ix, sel].astype(jnp.float32)
        v_sel = vb[b_ix, h_ix, sel].astype(jnp.float32)
        dist_sel = q_pos[None, None, :, None, None] - (sel[..., None] * MOBA_BLOCK + in_block)
        lg_sel = jnp.einsum('bhqd,bhqnkd->bhqnk', qc, k_sel) - slopes[..., None] * dist_sel
        lg_sel = jnp.where(sel_valid[:, None], lg_sel, NEG_INF)
        lg = jnp.concatenate([lg_sel.reshape(B, H, Q_CHUNK, n_sel * MOBA_BLOCK), lg_own], axis=-1)
        p = jax.nn.softmax(lg, axis=-1)
        p_sel = p[..., :n_sel * MOBA_BLOCK].reshape(B, H, Q_CHUNK, n_sel, MOBA_BLOCK)
        p_own = p[..., n_sel * MOBA_BLOCK:]
        out = (jnp.einsum('bhqnk,bhqnkd->bhqd', p_sel, v_sel)
               + jnp.einsum('bhqk,bhkd->bhqd', p_own, v_own))
        return out.astype(q.dtype)

    starts = jnp.arange(S // Q_CHUNK) * Q_CHUNK
    outs = lax.map(chunk, starts)
    return outs.transpose(1, 2, 0, 3, 4).reshape(B, H, S, hd)


def multiscale_pool(p, w_mix, b_mix, layer_scale):
    B, S, C = p.shape
    pf = p.astype(jnp.float32).reshape(B, S, POOL_GROUPS, POOL_GROUP_DIM)
    cs0 = jnp.pad(jnp.cumsum(pf, axis=1), ((0, 0), (1, 0), (0, 0), (0, 0)))
    t = jnp.arange(S)
    pooled = []
    for g, w in enumerate(POOL_WINDOWS):
        csg = cs0[:, :, g]
        win = csg[:, 1:] - csg[:, jnp.maximum(t + 1 - w, 0)]
        cnt = jnp.minimum(t + 1, w).astype(jnp.float32)[None, :, None]
        pooled.append(win / cnt - pf[:, :, g])
    pooled = jnp.stack(pooled, axis=2)
    mixed = jnp.einsum('bsgc,gcd->bsgd', pooled, w_mix.astype(jnp.float32)) + b_mix.astype(jnp.float32)
    return (mixed.reshape(B, S, C) * layer_scale.astype(jnp.float32)).astype(p.dtype)


def peer_ffn(h, w_q, sub_keys, expert_u, expert_v):
    B, S, D = h.shape
    T = B * S
    ht = h.reshape(T, D)
    q = (ht @ w_q).reshape(T, PEER_HEADS, 2, PEER_HALF).astype(jnp.float32)
    s = jnp.einsum('thpd,pnd->thpn', q, sub_keys.astype(jnp.float32))
    v1, i1 = lax.top_k(s[:, :, 0], PEER_TOPK)
    v2, i2 = lax.top_k(s[:, :, 1], PEER_TOPK)
    cand = (v1[..., :, None] + v2[..., None, :]).reshape(T, PEER_HEADS, PEER_TOPK * PEER_TOPK)
    top_s, flat = lax.top_k(cand, PEER_TOPK)
    e1 = jnp.take_along_axis(i1, flat // PEER_TOPK, axis=-1)
    e2 = jnp.take_along_axis(i2, flat % PEER_TOPK, axis=-1)
    expert_idx = e1 * PEER_KEYS + e2
    gates = jax.nn.softmax(top_s, axis=-1)
    n_chunks = T // PEER_CHUNK

    def chunk(args):
        hc, idx, g = args
        a = jnp.einsum('cd,chkd->chk', hc, expert_u[idx]).astype(jnp.float32)
        act = (jax.nn.gelu(a) * g).astype(h.dtype)
        return jnp.einsum('chk,chkd->cd', act, expert_v[idx])

    out = lax.map(chunk, (ht.reshape(n_chunks, PEER_CHUNK, D),
                          expert_idx.reshape(n_chunks, PEER_CHUNK, PEER_HEADS, PEER_TOPK),
                          gates.reshape(n_chunks, PEER_CHUNK, PEER_HEADS, PEER_TOPK)))
    return out.reshape(B, S, D)


def setup_inputs(seed: int = 0) -> dict:
    key = jax.random.key(seed)
    ks = jax.random.split(key, 20)
    D = D_MODEL
    nrm = lambda k, shape, s: jax.random.normal(k, shape, dtype=jnp.float32) * s
    return {
        "x": nrm(ks[0], (BATCH, SEQ, D), 1.0),
        "c": nrm(ks[1], (BATCH, D), 1.0),
        "w_ada": nrm(ks[2], (DEPTH, D, 6 * D), 0.5 * D ** -0.5),
        "b_ada": nrm(ks[3], (DEPTH, 6 * D), 0.02),
        "g_norm1": 1.0 + nrm(ks[4], (DEPTH, D), 0.02),
        "w_in": nrm(ks[5], (DEPTH, D, IN_WIDTH), D ** -0.5),
        "w_attn_up": nrm(ks[6], (DEPTH, ATTN_WIDTH, D), ATTN_WIDTH ** -0.5),
        "w_pool_mix": nrm(ks[7], (DEPTH, POOL_GROUPS, POOL_GROUP_DIM, POOL_GROUP_DIM), POOL_GROUP_DIM ** -0.5),
        "b_pool_mix": nrm(ks[8], (DEPTH, POOL_GROUPS, POOL_GROUP_DIM), 0.02),
        "pool_scale": 1.0 + nrm(ks[9], (DEPTH, POOL_WIDTH), 0.05),
        "w_pool_up": nrm(ks[10], (DEPTH, POOL_WIDTH, D), POOL_WIDTH ** -0.5),
        "w_out": nrm(ks[11], (DEPTH, D, D), D ** -0.5),
        "g_norm2": 1.0 + nrm(ks[12], (DEPTH, D), 0.02),
        "w_peer_q": nrm(ks[13], (DEPTH, D, PEER_HEADS * PEER_QUERY_DIM), D ** -0.5),
        "peer_sub_keys": nrm(ks[14], (DEPTH, 2, PEER_KEYS, PEER_HALF), PEER_HALF ** -0.5),
        "peer_u": nrm(ks[15], (DEPTH, PEER_EXPERTS, D), D ** -0.5),
        "peer_v": nrm(ks[16], (DEPTH, PEER_EXPERTS, D), 0.5 * PEER_HEADS ** -0.5),
        "g_final": 1.0 + nrm(ks[17], (D,), 0.02),
    }


def reference(x, c, w_ada, b_ada, g_norm1, w_in, w_attn_up, w_pool_mix, b_pool_mix, pool_scale,
              w_pool_up, w_out, g_norm2, w_peer_q, peer_sub_keys, peer_u, peer_v, g_final):
    B, S, D = x.shape
    A = ATTN_WIDTH
    P = POOL_WIDTH
    split_at = [A, 2 * A, 3 * A, 3 * A + P, 3 * A + P + D]

    def heads(t):
        return t.reshape(B, S, ATTN_HEADS, ATTN_HEAD_DIM).transpose(0, 2, 1, 3)

    c_act = jax.nn.silu(c)
    for l in range(DEPTH):
        mod = c_act @ w_ada[l] + b_ada[l]
        sh1, sc1, gt1, sh2, sc2, gt2 = jnp.split(mod, 6, axis=-1)
        h = modulate(rms_norm(x, g_norm1[l]), sh1, sc1)
        proj = h @ w_in[l]
        q, k, v, p, ga, gb = jnp.split(proj, split_at, axis=-1)
        attn = moba_attention(heads(q), heads(k), heads(v)).transpose(0, 2, 1, 3).reshape(B, S, A)
        pool = multiscale_pool(p, w_pool_mix[l], b_pool_mix[l], pool_scale[l])
        merged = (jax.nn.sigmoid(ga) * (attn @ w_attn_up[l])
                  + jax.nn.sigmoid(gb) * (pool @ w_pool_up[l]))
        x = x + gt1[:, None, :] * (merged @ w_out[l])
        h2 = modulate(rms_norm(x, g_norm2[l]), sh2, sc2)
        x = x + gt2[:, None, :] * peer_ffn(h2, w_peer_q[l], peer_sub_keys[l], peer_u[l], peer_v[l])
    return rms_norm(x, g_final)
```

```cpp
#include <hip/hip_runtime.h>
#include <hip/hip_bf16.h>
#include <cstdio>
#include <cstdint>
#include <cmath>

constexpr int NB = 8, SEQ = 4096, T = NB * SEQ, D = 1024;
constexpr int AW = 512, PW = 512, INW = 4096;
constexpr int NH = 8, HD = 64, MBLK = 256, NBLK = SEQ / MBLK;
constexpr int PQW = 2048, PEXP = 16384, PTOP = 16, PHEADS = 8, PSEL = PHEADS * PTOP;
constexpr float RMS_EPS = 1e-6f;
constexpr float LOG2E = 1.4426950408889634f;
constexpr float QSCALE = 0.125f * LOG2E;
constexpr int NWAVES = 8, NTHREADS = 512;

namespace pg8 {
#define PG8_LAS __attribute__((address_space(3)))
typedef unsigned short bf16_t;
typedef short bf16x8 __attribute__((ext_vector_type(8)));
typedef float f32x4 __attribute__((ext_vector_type(4)));
typedef unsigned u32x4 __attribute__((ext_vector_type(4)));
constexpr int BM = 256, BK = 64, HALF = 128, HTB = HALF * BK * 2  , STAGE_BYTES = 8 * HTB, NXCD = 8, WGM = 8;

__host__ __device__ __forceinline__ int lds_byte(int r, int c) { const int st = (r >> 4) * 2 + (c >> 5), rr = r & 15, cc = c & 31, ob = rr * 64 + cc * 2; return st * 1024 + (ob ^ (((ob >> 9) & 1) << 5)); }
__host__ __device__ __forceinline__ void stage_rc(int b, int& R, int& C) { const int st = b / 1024, sb = b % 1024, swz = sb ^ (((sb >> 9) & 1) << 5); R = (st >> 1) * 16 + swz / 64; C = (st & 1) * 32 + (swz % 64) / 2; }
__host__ __device__ __forceinline__ int perm32(int rho) { const int n = rho >> 4, i = rho & 15; return 8 * (i >> 2) + 4 * n + (i & 3); }

struct Unit { int pm, pn, part; };
struct Gemm {
    const bf16_t* A0; const bf16_t* A1; const bf16_t* B0; const bf16_t* B1; int lda, ldb, K;
    __device__ __forceinline__ const char* a_ptr(const Unit& u) const { return (const char*)(u.part ? A1 : A0) + (size_t)u.pm * BM * lda * 2; }
    __device__ __forceinline__ const char* b_ptr(const Unit& u) const { return (const char*)(u.part ? B1 : B0) + (size_t)u.pn * BM * ldb * 2; }
};

struct StaticOrder {
    int nM, nN, nwg, G, c;
    __host__ __device__ void init(int M, int N, int G_, int c_) { nM = M / BM; nN = N / BM; nwg = nM * nN; G = G_; c = c_; }
    __host__ __device__ bool tile(long L, Unit& u) const {
        if (L >= nwg) return false;
        int wgid = (int)L; { const int q = nwg / NXCD, r = nwg % NXCD, xcd = wgid % NXCD, off = wgid / NXCD; wgid = (xcd < r ? xcd * (q + 1) : r * (q + 1) + (xcd - r) * q) + off; }
        const int nig = WGM * nN, gid = wgid / nig, fm = gid * WGM, gsz = (nM - fm) < WGM ? (nM - fm) : WGM;
        u.pm = fm + ((wgid % nig) % gsz); u.pn = (wgid % nig) / gsz; u.part = 0; return true;
    }
    __host__ __device__ bool next(int i, Unit& u) const { return tile((long)i * G + c, u); }
    __device__ __forceinline__ void a_ready(const Unit&) const {}
    __device__ __forceinline__ void done(const Unit&) const {}
};
struct DualOrder {
    StaticOrder so;
    __host__ __device__ void init(int M, int N, int G_, int c_) { so.init(M, N, G_, c_); }
    __host__ __device__ bool next(int i, Unit& u) const { if (!so.tile((long)(i >> 1) * so.G + so.c, u)) return false; u.part = i & 1; return true; }
    __device__ __forceinline__ void a_ready(const Unit&) const {}
    __device__ __forceinline__ void done(const Unit&) const {}
};

__device__ __forceinline__ unsigned cvt_pk_bf16(float lo, float hi) { unsigned r; asm volatile("v_cvt_pk_bf16_f32 %0, %1, %2" : "=v"(r) : "v"(lo), "v"(hi)); return r; }
__device__ __forceinline__ float bf_lo(unsigned w) { return __uint_as_float(w << 16); }
__device__ __forceinline__ float bf_hi(unsigned w) { return __uint_as_float(w & 0xffff0000u); }
__device__ __forceinline__ float sigmoidf_(float x) { return __builtin_amdgcn_rcpf(1.0f + __builtin_amdgcn_exp2f(-x * 1.4426950408889634f)); }


struct EpiIn {
    static constexpr bool PERM = true, AFTER_DRAIN = false;
    bf16_t* QKVP; bf16_t* GAB; const float* rstd1; const float* bias1p; float* ksum;
    __device__ __forceinline__ void operator()(const f32x4 (&acc)[2][2][4][2], const Unit& u, int wr, int wc, int fr, int fq) const {
        bf16_t* base; int ldc, col0;
        if (u.pn < 8) { base = QKVP + (size_t)(u.pn >> 1) * T * 512; ldc = 512; col0 = (u.pn & 1) * 256; }
        else { base = GAB + (size_t)((u.pn - 8) >> 2) * T * 1024; ldc = 1024; col0 = ((u.pn - 8) & 3) * 256; }
        const float sc = (u.pn < 2) ? QSCALE : 1.0f;
        const int b = u.pm >> 4;
        const int bcol = u.pn * 256 + wc * 32 + 8 * fq;
        f32x4 bv[2][2];
#pragma unroll
        for (int bj = 0; bj < 2; ++bj)
#pragma unroll
            for (int n = 0; n < 2; ++n) { f32x4 s = (f32x4){0.f, 0.f, 0.f, 0.f};
#pragma unroll
                for (int kc = 0; kc < 8; ++kc) s += *(const f32x4*)(bias1p + (size_t)(kc * 8 + b) * INW + bcol + bj * HALF + 4 * n);
                bv[bj][n] = s; }
        const bool isk = (u.pn == 2 || u.pn == 3);
        f32x4 ks[2][2];
#pragma unroll
        for (int bj = 0; bj < 2; ++bj)
#pragma unroll
            for (int n = 0; n < 2; ++n) ks[bj][n] = (f32x4){0.f, 0.f, 0.f, 0.f};
        const int row0 = u.pm * BM + wr * 64 + fr;
#pragma unroll
        for (int ai = 0; ai < 2; ++ai)
#pragma unroll
            for (int m = 0; m < 4; ++m) { const int row = row0 + ai * HALF + m * 16; const float rs = rstd1[row];
                bf16_t* rowp = base + (size_t)row * ldc + col0 + wc * 32 + 8 * fq;
#pragma unroll
                for (int bj = 0; bj < 2; ++bj) { f32x4 v0 = acc[ai][bj][m][0] * rs + bv[bj][0], v1 = acc[ai][bj][m][1] * rs + bv[bj][1];
                    ks[bj][0] += v0; ks[bj][1] += v1;
                    v0 = v0 * sc; v1 = v1 * sc; u32x4 w; w.x = cvt_pk_bf16(v0[0], v0[1]); w.y = cvt_pk_bf16(v0[2], v0[3]); w.z = cvt_pk_bf16(v1[0], v1[1]); w.w = cvt_pk_bf16(v1[2], v1[3]);
                    *(u32x4*)(rowp + bj * HALF) = w; } }
        if (isk) {
#pragma unroll
            for (int bj = 0; bj < 2; ++bj)
#pragma unroll
                for (int n = 0; n < 2; ++n)
#pragma unroll
                    for (int e = 0; e < 4; ++e) { float v = ks[bj][n][e]; v += __shfl_xor(v, 1); v += __shfl_xor(v, 2); v += __shfl_xor(v, 4); v += __shfl_xor(v, 8); ks[bj][n][e] = v; }
            if (fr == 0) { float* kp = ksum + (size_t)u.pm * 512 + (u.pn - 2) * 256 + wc * 32 + 8 * fq;
#pragma unroll
                for (int bj = 0; bj < 2; ++bj)
#pragma unroll
                    for (int n = 0; n < 2; ++n)
#pragma unroll
                        for (int e = 0; e < 4; ++e) atomicAdd(kp + bj * HALF + 4 * n + e, ks[bj][n][e]); }
        }
    }
};

struct EpiUp {
    static constexpr bool PERM = true, AFTER_DRAIN = false;
    bf16_t* merged; const bf16_t* GAB; const float* bprime;
    __device__ __forceinline__ void operator()(const f32x4 (&acc)[2][2][4][2], const Unit& u, int wr, int wc, int fr, int fq) const {
        const int row0 = u.pm * BM + wr * 64 + fr, colb = u.pn * BM + wc * 32 + 8 * fq;
        const bf16_t* gate = GAB + (size_t)u.part * T * 1024;
        f32x4 bv[2][2];
#pragma unroll
        for (int bj = 0; bj < 2; ++bj)
#pragma unroll
            for (int n = 0; n < 2; ++n) { f32x4 s_ = (f32x4){0.f, 0.f, 0.f, 0.f}; if (u.part) { _Pragma("unroll") for (int g_ = 0; g_ < 4; ++g_) s_ += *(const f32x4*)(bprime + g_ * 1024 + colb + bj * HALF + 4 * n); } bv[bj][n] = s_; }
#pragma unroll
        for (int ai = 0; ai < 2; ++ai) {
            u32x4 gpre[4][2], ppre[4][2];
#pragma unroll
            for (int m = 0; m < 4; ++m) { const size_t off = (size_t)(row0 + ai * HALF + m * 16) * 1024 + colb;
#pragma unroll
                for (int bj = 0; bj < 2; ++bj) { gpre[m][bj] = *(const u32x4*)(gate + off + bj * HALF);
                    if (u.part) ppre[m][bj] = __builtin_nontemporal_load((const u32x4*)(merged + off + bj * HALF)); else ppre[m][bj] = (u32x4){0u, 0u, 0u, 0u}; } }
#pragma unroll
            for (int m = 0; m < 4; ++m) { const size_t off = (size_t)(row0 + ai * HALF + m * 16) * 1024 + colb;
#pragma unroll
                for (int bj = 0; bj < 2; ++bj) {
                    const u32x4 gw = gpre[m][bj], pw = ppre[m][bj];
                    f32x4 v0 = acc[ai][bj][m][0] + bv[bj][0], v1 = acc[ai][bj][m][1] + bv[bj][1];
                    v0[0] *= sigmoidf_(bf_lo(gw.x)); v0[1] *= sigmoidf_(bf_hi(gw.x)); v0[2] *= sigmoidf_(bf_lo(gw.y)); v0[3] *= sigmoidf_(bf_hi(gw.y));
                    v1[0] *= sigmoidf_(bf_lo(gw.z)); v1[1] *= sigmoidf_(bf_hi(gw.z)); v1[2] *= sigmoidf_(bf_lo(gw.w)); v1[3] *= sigmoidf_(bf_hi(gw.w));
                    v0[0] += bf_lo(pw.x); v0[1] += bf_hi(pw.x); v0[2] += bf_lo(pw.y); v0[3] += bf_hi(pw.y); v1[0] += bf_lo(pw.z); v1[1] += bf_hi(pw.z); v1[2] += bf_lo(pw.w); v1[3] += bf_hi(pw.w);
                    u32x4 w; w.x = cvt_pk_bf16(v0[0], v0[1]); w.y = cvt_pk_bf16(v0[2], v0[3]); w.z = cvt_pk_bf16(v1[0], v1[1]); w.w = cvt_pk_bf16(v1[2], v1[3]);
                    *(u32x4*)(merged + off + bj * HALF) = w; } }
        }
        if (u.part == 0) asm volatile("s_waitcnt vmcnt(0)" ::: "memory");
    }
};

struct EpiOut {
    static constexpr bool PERM = true, AFTER_DRAIN = false;
    const float* x; float* x1; bf16_t* A2; const float* modf; const float* g2; float* ss2;
    __device__ __forceinline__ void operator()(const f32x4 (&acc)[2][2][4][2], const Unit& u, int wr, int wc, int fr, int fq) const {
        const int row0 = u.pm * BM + wr * 64 + fr, colb = u.pn * BM + wc * 32 + 8 * fq, b = u.pm >> 4;
        f32x4 gt[2][2], gg[2][2];
#pragma unroll
        for (int bj = 0; bj < 2; ++bj)
#pragma unroll
            for (int n = 0; n < 2; ++n) { const int c = colb + bj * HALF + 4 * n; gt[bj][n] = *(const f32x4*)(modf + (size_t)b * 6144 + 2048 + c);
                const f32x4 sc2 = *(const f32x4*)(modf + (size_t)b * 6144 + 4096 + c); gg[bj][n] = *(const f32x4*)(g2 + c) * (sc2 + 1.0f); }
#pragma unroll
        for (int ai = 0; ai < 2; ++ai) {
#pragma unroll
          for (int mh = 0; mh < 2; ++mh) {
            f32x4 xr[2][2][2];
#pragma unroll
            for (int m2 = 0; m2 < 2; ++m2) { const size_t off = (size_t)(row0 + ai * HALF + (2 * mh + m2) * 16) * 1024 + colb;
#pragma unroll
                for (int bj = 0; bj < 2; ++bj) { xr[m2][bj][0] = *(const f32x4*)(x + off + bj * HALF); xr[m2][bj][1] = *(const f32x4*)(x + off + bj * HALF + 4); } }
#pragma unroll
            for (int m2 = 0; m2 < 2; ++m2) { const int m = 2 * mh + m2; const int row = row0 + ai * HALF + m * 16; const size_t off = (size_t)row * 1024 + colb; float ssq = 0.f;
#pragma unroll
                for (int bj = 0; bj < 2; ++bj) {
                    const f32x4 y0 = xr[m2][bj][0] + gt[bj][0] * acc[ai][bj][m][0], y1 = xr[m2][bj][1] + gt[bj][1] * acc[ai][bj][m][1];
                    *(f32x4*)(x1 + off + bj * HALF) = y0; *(f32x4*)(x1 + off + bj * HALF + 4) = y1;
                    ssq += (y0[0] * y0[0] + y0[1] * y0[1]) + (y0[2] * y0[2] + y0[3] * y0[3]) + (y1[0] * y1[0] + y1[1] * y1[1]) + (y1[2] * y1[2] + y1[3] * y1[3]);
                    const f32x4 a0 = y0 * gg[bj][0], a1 = y1 * gg[bj][1];
                    u32x4 w; w.x = cvt_pk_bf16(a0[0], a0[1]); w.y = cvt_pk_bf16(a0[2], a0[3]); w.z = cvt_pk_bf16(a1[0], a1[1]); w.w = cvt_pk_bf16(a1[2], a1[3]);
                    *(u32x4*)(A2 + off + bj * HALF) = w; }
                ssq += __shfl_xor(ssq, 16); ssq += __shfl_xor(ssq, 32);
                if (fq == 0) ss2[(size_t)row * 16 + u.pn * 4 + wc] = ssq; }
          }
        }
    }
};

struct EpiPq {
    static constexpr bool PERM = true, AFTER_DRAIN = false;
    bf16_t* QP; const float* ss2; const float* bias2p;
    __device__ __forceinline__ void operator()(const f32x4 (&acc)[2][2][4][2], const Unit& u, int wr, int wc, int fr, int fq) const {
        const int row0 = u.pm * BM + wr * 64 + fr, colb = u.pn * BM + wc * 32 + 8 * fq, b = u.pm >> 4;
        f32x4 bv[2][2];
#pragma unroll
        for (int bj = 0; bj < 2; ++bj)
#pragma unroll
            for (int n = 0; n < 2; ++n) { f32x4 s = (f32x4){0.f, 0.f, 0.f, 0.f};
#pragma unroll
                for (int kc = 0; kc < 8; ++kc) s += *(const f32x4*)(bias2p + (size_t)(kc * 8 + b) * PQW + colb + bj * HALF + 4 * n);
                bv[bj][n] = s; }
#pragma unroll
        for (int ai = 0; ai < 2; ++ai)
#pragma unroll
            for (int m = 0; m < 4; ++m) { const int row = row0 + ai * HALF + m * 16;
                const f32x4* sp = (const f32x4*)(ss2 + (size_t)row * 16); const f32x4 s4 = (sp[0] + sp[1]) + (sp[2] + sp[3]);
                const float rs = __builtin_amdgcn_rsqf(((s4[0] + s4[1]) + (s4[2] + s4[3])) * (1.0f / D) + RMS_EPS);
                bf16_t* rowp = QP + (size_t)row * PQW + colb;
#pragma unroll
                for (int bj = 0; bj < 2; ++bj) { const f32x4 v0 = acc[ai][bj][m][0] * rs + bv[bj][0], v1 = acc[ai][bj][m][1] * rs + bv[bj][1];
                    u32x4 w; w.x = cvt_pk_bf16(v0[0], v0[1]); w.y = cvt_pk_bf16(v0[2], v0[3]); w.z = cvt_pk_bf16(v1[0], v1[1]); w.w = cvt_pk_bf16(v1[2], v1[3]);
                    *(u32x4*)(rowp + bj * HALF) = w; } }
    }
};

template <class Epi, class Sched, bool ALIGN_EPI = false, bool SP2 = false>
__device__ __forceinline__ void gemm_phase(PG8_LAS unsigned char* lds, const Gemm g, const Sched& S, const Epi& E) {
    int tid_ = threadIdx.x; asm volatile("" : "+v"(tid_));
    const int tid = tid_, wid = __builtin_amdgcn_readfirstlane(tid >> 6), lane = tid & 63, wr = wid >> 2, wc = wid & 3, fr = lane & 15, fq = lane >> 4;
    const int K = g.K, nt = K / BK, lda = g.lda, ldb = g.ldb;
    unsigned voffA[2], voffB[2];
#pragma unroll
    for (int i = 0; i < 2; ++i) { int R, C; stage_rc(tid * 16 + i * 8192, R, C); const int Rb = Epi::PERM ? ((R & ~31) + perm32(R & 31)) : R;
        voffA[i] = (unsigned)(R * lda + C) * 2u; voffB[i] = (unsigned)(Rb * ldb + C) * 2u; }
    const size_t kstep = (size_t)(BK * 2);
    const size_t hstepA = (size_t)HALF * lda * 2, hstepB = (size_t)HALF * ldb * 2;
    const unsigned ldsw = (unsigned)wid * 1024u;
    const int aoff = lds_byte(wr * 64 + fr, fq * 8), boff = lds_byte(wc * 32 + fr, fq * 8);
#define PG8_SA(b, h) (((b) * 2 + (h)) * HTB)
#define PG8_SB(b, h) ((4 + (b) * 2 + (h)) * HTB)
#define PG8_STAGE(bufoff, gbase, voff) do { _Pragma("unroll") for (int _i = 0; _i < 2; ++_i) \
        __builtin_amdgcn_global_load_lds((const unsigned*)((const char*)(gbase) + (voff)[_i]), (PG8_LAS unsigned*)(lds + (bufoff) + ldsw + _i * 8192), 16, 0, 0); } while (0)
#define PG8_LDA(dst, b, h) do { _Pragma("unroll") for (int m = 0; m < 4; ++m) _Pragma("unroll") for (int k = 0; k < 2; ++k) dst[m][k] = *(const PG8_LAS bf16x8*)(lds + PG8_SA(b, h) + aoff + m * 2048 + k * 1024); } while (0)
#define PG8_LDB(dst, b, h) do { _Pragma("unroll") for (int n = 0; n < 2; ++n) _Pragma("unroll") for (int k = 0; k < 2; ++k) dst[n][k] = *(const PG8_LAS bf16x8*)(lds + PG8_SB(b, h) + boff + n * 2048 + k * 1024); } while (0)
#define PG8_MMA(ai, bj, At, Bt) do { __builtin_amdgcn_s_setprio(1); _Pragma("unroll") for (int m = 0; m < 4; ++m) _Pragma("unroll") for (int n = 0; n < 2; ++n) _Pragma("unroll") for (int k = 0; k < 2; ++k) \
        acc[ai][bj][m][n] = __builtin_amdgcn_mfma_f32_16x16x32_bf16(Bt[n][k], At[m][k], acc[ai][bj][m][n], 0, 0, 0); __builtin_amdgcn_s_setprio(0); } while (0)
#define PG8_WAIT_V(n) asm volatile("s_waitcnt vmcnt(" #n ")" ::: "memory")
#define PG8_WAIT_L(n) asm volatile("s_waitcnt lgkmcnt(" #n ")" ::: "memory")
#define PG8_BAR __builtin_amdgcn_s_barrier()
#define PG8_SCHED __builtin_amdgcn_sched_barrier(0)
    Unit cur, nxt; int ui = 0;
    if (!S.next(0, cur)) return;
    f32x4 acc[2][2][4][2];
#pragma unroll
    for (int a = 0; a < 2; ++a)
#pragma unroll
        for (int b = 0; b < 2; ++b)
#pragma unroll
            for (int m = 0; m < 4; ++m)
#pragma unroll
                for (int n = 0; n < 2; ++n) acc[a][b][m][n] = (f32x4){0.f, 0.f, 0.f, 0.f};
    bf16x8 At[4][2], B0[2][2], B1[2][2];
    const char* cA = g.a_ptr(cur); const char* cB = g.b_ptr(cur);
    S.a_ready(cur);
    if constexpr (SP2) {
        PG8_STAGE(PG8_SB(0, 0), cB, voffB); PG8_STAGE(PG8_SB(0, 1), cB + hstepB, voffB); PG8_STAGE(PG8_SA(0, 0), cA, voffA); PG8_STAGE(PG8_SA(0, 1), cA + hstepA, voffA);
        if (wr == 1) PG8_BAR;
        PG8_WAIT_V(2); PG8_BAR;
        PG8_STAGE(PG8_SB(1, 0), cB + kstep, voffB); PG8_STAGE(PG8_SA(1, 0), cA + kstep, voffA); PG8_STAGE(PG8_SB(1, 1), cB + hstepB + kstep, voffB);
        PG8_WAIT_V(6); PG8_BAR;
    } else {
        PG8_STAGE(PG8_SB(0, 0), cB, voffB); PG8_STAGE(PG8_SA(0, 0), cA, voffA); PG8_STAGE(PG8_SB(0, 1), cB + hstepB, voffB); PG8_STAGE(PG8_SA(0, 1), cA + hstepA, voffA);
        if (wr == 1) PG8_BAR;
        PG8_WAIT_V(4); PG8_BAR;
        PG8_STAGE(PG8_SB(1, 0), cB + kstep, voffB); PG8_STAGE(PG8_SA(1, 0), cA + kstep, voffA); PG8_STAGE(PG8_SB(1, 1), cB + hstepB + kstep, voffB);
        PG8_WAIT_V(6); PG8_BAR;
    }
    for (;;) {
        const bool has_next = S.next(ui + 1, nxt);
        const char* nA = has_next ? g.a_ptr(nxt) : cA; const char* nB = has_next ? g.b_ptr(nxt) : cB;
        for (int t = 0; t < nt; t += 2) {
            const bool last = (t == nt - 2);
            const char* a1 = cA + (size_t)(t + 1) * kstep;
            const char* a2 = last ? nA : cA + (size_t)(t + 2) * kstep; const char* b2 = last ? nB : cB + (size_t)(t + 2) * kstep;
            const char* a3 = a2 + kstep; const char* b3 = b2 + kstep;
            if (last && has_next) S.a_ready(nxt);
            if constexpr (SP2) {
            PG8_LDB(B0, 0, 0); PG8_LDB(B1, 0, 1); PG8_SCHED; PG8_LDA(At, 0, 0); PG8_STAGE(PG8_SA(1, 1), a1 + hstepA, voffA);
            PG8_WAIT_V(8); PG8_WAIT_L(0); PG8_BAR; PG8_MMA(0, 0, At, B0); PG8_MMA(0, 1, At, B1); PG8_BAR; PG8_SCHED;
            PG8_LDA(At, 0, 1); PG8_STAGE(PG8_SB(0, 0), b2, voffB); PG8_STAGE(PG8_SB(0, 1), b2 + hstepB, voffB); PG8_STAGE(PG8_SA(0, 0), a2, voffA);
            PG8_WAIT_V(8); PG8_WAIT_L(0); PG8_BAR; PG8_MMA(1, 0, At, B0); PG8_MMA(1, 1, At, B1); PG8_BAR; PG8_SCHED;
            PG8_LDB(B0, 1, 0); PG8_LDB(B1, 1, 1); PG8_SCHED; PG8_LDA(At, 1, 0); PG8_STAGE(PG8_SA(0, 1), a2 + hstepA, voffA);
            PG8_WAIT_V(8); PG8_WAIT_L(0); PG8_BAR; PG8_MMA(0, 0, At, B0); PG8_MMA(0, 1, At, B1); PG8_BAR; PG8_SCHED;
            PG8_LDA(At, 1, 1); PG8_STAGE(PG8_SB(1, 0), b3, voffB); PG8_STAGE(PG8_SB(1, 1), b3 + hstepB, voffB); PG8_STAGE(PG8_SA(1, 0), a3, voffA);
            PG8_WAIT_V(8); PG8_WAIT_L(0); PG8_BAR; PG8_MMA(1, 0, At, B0); PG8_MMA(1, 1, At, B1); PG8_BAR; PG8_SCHED;
            } else {
            PG8_LDB(B0, 0, 0); PG8_SCHED; PG8_LDA(At, 0, 0); PG8_STAGE(PG8_SA(1, 1), a1 + hstepA, voffA);
            PG8_WAIT_L(8); PG8_BAR; PG8_WAIT_L(0); PG8_MMA(0, 0, At, B0); PG8_BAR; PG8_SCHED;
            PG8_LDB(B1, 0, 1); PG8_STAGE(PG8_SB(0, 0), b2, voffB);
            PG8_BAR; PG8_WAIT_L(0); PG8_MMA(0, 1, At, B1); PG8_BAR;
            PG8_LDA(At, 0, 1); PG8_STAGE(PG8_SA(0, 0), a2, voffA);
            PG8_BAR; PG8_WAIT_L(0); PG8_MMA(1, 0, At, B0); PG8_BAR; PG8_SCHED;
            PG8_STAGE(PG8_SB(0, 1), b2 + hstepB, voffB);
            PG8_WAIT_V(6); PG8_BAR; PG8_MMA(1, 1, At, B1); PG8_BAR;
            PG8_LDB(B0, 1, 0); PG8_SCHED; PG8_LDA(At, 1, 0); PG8_STAGE(PG8_SA(0, 1), a2 + hstepA, voffA);
            PG8_WAIT_L(8); PG8_BAR; PG8_WAIT_L(0); PG8_MMA(0, 0, At, B0); PG8_BAR; PG8_SCHED;
            PG8_LDB(B1, 1, 1); PG8_STAGE(PG8_SB(1, 0), b3, voffB);
            PG8_BAR; PG8_WAIT_L(0); PG8_MMA(0, 1, At, B1); PG8_BAR;
            PG8_LDA(At, 1, 1); PG8_STAGE(PG8_SA(1, 0), a3, voffA);
            PG8_BAR; PG8_WAIT_L(0); PG8_MMA(1, 0, At, B0); PG8_BAR; PG8_SCHED;
            PG8_STAGE(PG8_SB(1, 1), b3 + hstepB, voffB);
            PG8_WAIT_V(6); PG8_BAR; PG8_MMA(1, 1, At, B1); PG8_BAR;
            }
        }
        if constexpr (ALIGN_EPI) { if (wr == 0) PG8_BAR; }
        if constexpr (!Epi::AFTER_DRAIN) { E(acc, cur, wr, wc, fr, fq); S.done(cur); }
        if (!has_next) break;
#pragma unroll
        for (int a = 0; a < 2; ++a)
#pragma unroll
            for (int b = 0; b < 2; ++b)
#pragma unroll
                for (int m = 0; m < 4; ++m)
#pragma unroll
                    for (int n = 0; n < 2; ++n) acc[a][b][m][n] = (f32x4){0.f, 0.f, 0.f, 0.f};
        cur = nxt; cA = nA; cB = nB; ++ui;
        if constexpr (ALIGN_EPI) { if (wr == 1) PG8_BAR; }
    }
    PG8_WAIT_V(0);
    if constexpr (!ALIGN_EPI) { if (wr == 0) PG8_BAR; }
    PG8_BAR;
    if constexpr (Epi::AFTER_DRAIN) { E.fused(acc, cur, wr, wc, fr, fq, lds, wid, lane); S.done(cur); }
#undef PG8_SA
#undef PG8_SB
#undef PG8_STAGE
#undef PG8_LDA
#undef PG8_LDB
#undef PG8_MMA
#undef PG8_WAIT_V
#undef PG8_WAIT_L
#undef PG8_BAR
#undef PG8_SCHED
}
}

constexpr size_t MiB = 1u << 20;
constexpr size_t WS_CTL = 0, CTL_ZERO_BYTES = 32 * 1024;
constexpr size_t WS_KSUM = 256 * 1024;
constexpr size_t WS_MODP = 1 * MiB;
constexpr size_t WS_MODF = WS_MODP + 8 * 8 * 6144 * 4;
constexpr size_t WS_BIAS1P = 3 * MiB;
constexpr size_t WS_BIAS2P = 4 * MiB;
constexpr size_t WS_BPRIME = 4 * MiB + 512 * 1024;
constexpr size_t WS_RSTD1 = 5 * MiB;
constexpr size_t WS_SS2 = 6 * MiB;
constexpr size_t WS_SUBK = 8 * MiB;
constexpr size_t WS_WIN = 16 * MiB, WS_WA = 24 * MiB, WS_WP = 25 * MiB, WS_WOUT = 26 * MiB, WS_WQ = 28 * MiB;
constexpr size_t WS_U = 32 * MiB, WS_V = 64 * MiB;
constexpr size_t WS_XG = 96 * MiB;
constexpr size_t WS_H2Q = WS_XG, WS_HS = WS_XG + 32 * MiB;
constexpr size_t WS_QKVP = 160 * MiB;
constexpr size_t WS_GAB = 288 * MiB;
constexpr size_t WS_POOLED = 416 * MiB;
constexpr size_t WS_END = 448 * MiB;
constexpr int CW_TMO = 0, CW_BAR = 4096;

constexpr int RING_OFF = 0, RING_BYTES = 131072;
constexpr int LDS_BYTES = 147456;
constexpr int LDSCTL_OFF = LDS_BYTES - 512, MISC_OFF = LDSCTL_OFF + 320;

#define GAS __attribute__((address_space(1)))
#define LAS __attribute__((address_space(3)))
typedef unsigned short bf16;
typedef unsigned v4u __attribute__((ext_vector_type(4)));
typedef unsigned v2u __attribute__((ext_vector_type(2)));
typedef float f32x4 __attribute__((ext_vector_type(4)));
typedef GAS unsigned gu32;
#define RLX_AGENT __ATOMIC_RELAXED, __HIP_MEMORY_SCOPE_AGENT
#define LDS_WAIT() asm volatile("s_waitcnt lgkmcnt(0)" ::: "memory")
#define VM_WAIT() asm volatile("s_waitcnt vmcnt(0)" ::: "memory")
__device__ __forceinline__ unsigned f2bf(float f) { unsigned u = __builtin_bit_cast(unsigned, f); return (u + 0x7fffu + ((u >> 16) & 1u)) >> 16; }
__device__ __forceinline__ unsigned pk2(float lo, float hi) { return f2bf(lo) | (f2bf(hi) << 16); }
__device__ __forceinline__ float bflo(unsigned w) { return __uint_as_float(w << 16); }
__device__ __forceinline__ float bfhi(unsigned w) { return __uint_as_float(w & 0xffff0000u); }
__device__ __forceinline__ float wave_sum(float v) {
#pragma unroll
    for (int o = 1; o < 64; o <<= 1) v += __shfl_xor(v, o);
    return v;
}
__device__ __forceinline__ float wave_max(float v) {
#pragma unroll
    for (int o = 1; o < 64; o <<= 1) v = fmaxf(v, __shfl_xor(v, o));
    return v;
}

#define XB_TMO      128
#define XB_XCNT(j)  (256  + 64 * (j))
#define XB_XSUB(j)  (1280 + 64 * (j))
#define XB_XGEN(j)  (2304 + 64 * (j))
#define XB_TOP      3328
#define XB_TOPGEN   3392
#define XCD_BAR_WORDS 3456
#define XB_SPIN_CAP (1u << 22)

__device__ __forceinline__ unsigned xb_ld(unsigned* p)              { return __hip_atomic_load(p, __ATOMIC_RELAXED, __HIP_MEMORY_SCOPE_AGENT); }
__device__ __forceinline__ unsigned xb_add(unsigned* p, unsigned v) { return __hip_atomic_fetch_add(p, v, __ATOMIC_RELAXED, __HIP_MEMORY_SCOPE_AGENT); }
__device__ __forceinline__ unsigned xb_xcc_id() { return (unsigned)__builtin_amdgcn_s_getreg((3 << 11) | 20) & 0xFu; }
#define XB_SPIN(cond, bar) do { unsigned _sp = 0; while (cond) { __builtin_amdgcn_s_sleep(1); \
    if ((++_sp & 255u) == 0u) { if (xb_ld(&(bar)[XB_TMO])) break; if (_sp > XB_SPIN_CAP) { atomicAdd(&(bar)[XB_TMO], 1u); break; } } } } while (0)

struct XcdBarrier { unsigned* bar; unsigned x; volatile LAS unsigned* st; };

__device__ __forceinline__ XcdBarrier xcd_barrier_post(unsigned* bar, volatile LAS unsigned* st) {
    XcdBarrier b; b.bar = bar; b.x = xb_xcc_id(); b.st = st;
    if (threadIdx.x == 0) (void)xb_add(&bar[XB_XCNT(b.x)], 1u);
    return b;
}
__device__ __forceinline__ void xcd_barrier_complete(unsigned* bar, unsigned x, unsigned& nloc, unsigned& nx) {
    const unsigned G = gridDim.x * gridDim.y * gridDim.z;
    unsigned sum, cnt, mine, sp = 0u;
    for (;;) {
        sum = 0u; cnt = 0u; mine = 0u;
#pragma unroll
        for (unsigned j = 0; j < 16; ++j) { const unsigned c = xb_ld(&bar[XB_XCNT(j)]); sum += c; cnt += (c > 0u) ? 1u : 0u; mine = (j == x) ? c : mine; }
        if (sum == G) break;
        __builtin_amdgcn_s_sleep(1);
        if ((++sp & 255u) == 0u) { if (xb_ld(&bar[XB_TMO])) break; if (sp > XB_SPIN_CAP) { atomicAdd(&bar[XB_TMO], 1u); break; } }
    }
    nloc = mine > 0u ? mine : 1u; nx = cnt > 0u ? cnt : 1u;
}
__device__ __forceinline__ void xcd_barrier(const XcdBarrier& b) {
    asm volatile("s_waitcnt vmcnt(0)" ::: "memory");
    __syncthreads();
    if (threadIdx.x == 0) {
        unsigned* bar = b.bar;
        __builtin_amdgcn_s_waitcnt(0);
        unsigned nloc = b.st[0], nx = b.st[1];
        if (nloc == 0u) { xcd_barrier_complete(bar, b.x, nloc, nx); b.st[0] = nloc; b.st[1] = nx; }
        const unsigned old = xb_add(&bar[XB_XSUB(b.x)], 1u);
        const unsigned gen = old / nloc;
        if (old + 1u == (gen + 1u) * nloc) {
            __builtin_amdgcn_fence(__ATOMIC_RELEASE, "agent");
            asm volatile("s_waitcnt vmcnt(0)" ::: "memory");
            const unsigned og = xb_add(&bar[XB_TOP], 1u);
            const unsigned tg = og / nx;
            if (og + 1u == (tg + 1u) * nx) xb_add(&bar[XB_TOPGEN], 1u);
            else XB_SPIN(xb_ld(&bar[XB_TOPGEN]) == tg, bar);
            __builtin_amdgcn_fence(__ATOMIC_ACQUIRE, "agent");
            xb_add(&bar[XB_XGEN(b.x)], 1u);
            asm volatile("s_waitcnt vmcnt(0)" ::: "memory");
        } else {
            XB_SPIN(xb_ld(&bar[XB_XGEN(b.x)]) == gen, bar);
            __builtin_amdgcn_fence(__ATOMIC_ACQUIRE, "agent");
            asm volatile("s_waitcnt vmcnt(0)" ::: "memory");
        }
    }
    __syncthreads();
}

struct Frame {
    LAS unsigned char* lds;
    volatile LAS unsigned* MISC;
    gu32* ctl;
    int tid, lane, wave;
    int vcu, G;
};
struct Args { const float* in[18]; float* out; unsigned char* ws; };

__device__ __forceinline__ float modp_sum(const float* modp, int idx) {
    float s = 0.f;
#pragma unroll
    for (int kc = 0; kc < 8; ++kc) s += modp[(size_t)kc * 8 * 6144 + idx];
    return s;
}
template <int MODE>
__device__ __forceinline__ void p0_wg_dot(Frame& F, const float* cin, const float* modp, int soff, const float* W, int N, const float* addv, float* outp, int first, int ntask) {
    LAS float* scr = (LAS float*)(F.lds + RING_OFF + F.wave * 16384);
    const int ncn = N / 64;
    for (int it = first; it < ntask; it += F.G) {
        const int kc = it / ncn, nc = it % ncn, k0 = kc * 128 + F.wave * 16, n = nc * 64 + F.lane;
        float w[16];
#pragma unroll
        for (int kk = 0; kk < 16; ++kk) w[kk] = W[(size_t)(k0 + kk) * N + n];
#pragma unroll
        for (int j = 0; j < 2; ++j) { const int idx = F.lane + 64 * j, b = idx >> 4, kk = idx & 15;
            float cf; if (MODE == 0) { const float cv = cin[b * 1024 + k0 + kk]; cf = cv / (1.0f + __expf(-cv)); } else cf = modp_sum(modp, b * 6144 + soff + k0 + kk);
            scr[idx] = cf; }
        LDS_WAIT(); asm volatile("" ::: "memory");
#pragma unroll
        for (int b = 0; b < 8; ++b) { float s = 0.f;
#pragma unroll
            for (int kk = 0; kk < 16; ++kk) s += scr[b * 16 + kk] * w[kk];
            scr[256 + b * 64 + F.lane] = s; }
        __syncthreads();
        { const int b = F.wave; float s = (addv != nullptr && kc == 0) ? addv[n] : 0.f;
#pragma unroll
          for (int w8 = 0; w8 < 8; ++w8) s += ((LAS float*)(F.lds + RING_OFF + w8 * 16384))[256 + b * 64 + F.lane];
          outp[(size_t)(kc * 8 + b) * N + n] = s; }
        __syncthreads();
    }
}
__device__ __forceinline__ void p0a_mod(Frame& F, const Args& A) { p0_wg_dot<0>(F, A.in[1], nullptr, 0, A.in[2], 6144, A.in[3], (float*)(A.ws + WS_MODP), F.vcu, 8 * 96); }
__device__ __forceinline__ void p0_wp_task(Frame& F, const Args& A, int r) {
    LAS float* scr = (LAS float*)(F.lds + RING_OFF + F.wave * 16384);
    const int g = r >> 6, kq = (r >> 4) & 3, nc = r & 15, n = nc * 64 + F.lane, d0 = 16 * F.wave;
    const float* wmix = A.in[7] + (size_t)(g * 128 + 32 * kq) * 128 + d0; const float* scale = A.in[9] + g * 128 + d0; const float* wup = A.in[10] + (size_t)(g * 128 + d0) * D + n; const float* bmix = A.in[8] + g * 128 + d0;
    float wu[16];
#pragma unroll
    for (int d = 0; d < 16; ++d) wu[d] = wup[(size_t)d * D];
    float bp = 0.f;
#pragma unroll
    for (int d = 0; d < 16; ++d) { wu[d] *= scale[d]; bp += bmix[d] * wu[d]; }
#pragma unroll
    for (int kk = 0; kk < 32; ++kk) { float s = 0.f;
#pragma unroll
        for (int d = 0; d < 16; ++d) s += wmix[kk * 128 + d] * wu[d];
        scr[kk * 64 + F.lane] = s; }
    scr[2048 + F.lane] = bp;
    __syncthreads();
    { float s[4]; float bs = 0.f;
#pragma unroll
      for (int e = 0; e < 4; ++e) s[e] = 0.f;
#pragma unroll
      for (int w8 = 0; w8 < 8; ++w8) { const LAS float* o = (const LAS float*)(F.lds + RING_OFF + w8 * 16384);
#pragma unroll
          for (int e = 0; e < 4; ++e) s[e] += o[(4 * F.wave + e) * 64 + F.lane];
          bs += o[2048 + F.lane]; }
      v2u w; w.x = pk2(s[0], s[1]); w.y = pk2(s[2], s[3]);
      *(GAS v2u*)((bf16*)(A.ws + WS_WP) + (size_t)n * PW + g * 128 + 32 * kq + 4 * F.wave) = w;
      if (kq == 0 && F.wave == 0) ((float*)(A.ws + WS_BPRIME))[g * 1024 + n] = bs; }
    __syncthreads();
}

__device__ __forceinline__ void p0_transpose_item(const float* W, int K, int N, bf16* WT, int row_off, LAS float* scr, int item, int lane) {
    const int nblk = N / 32, kb = item / nblk, nb = item % nblk, k0 = 64 * kb, n0 = 32 * nb;
#pragma unroll 8
    for (int i = 0; i < 32; ++i) { const int kk = 2 * i + (lane >> 5); scr[kk * 33 + (lane & 31)] = W[(size_t)(k0 + kk) * N + n0 + (lane & 31)]; }
    LDS_WAIT(); asm volatile("" ::: "memory");
    const int c = lane & 7;
#pragma unroll
    for (int j = 0; j < 4; ++j) { const int n = (lane >> 3) + 8 * j; const LAS float* s = scr + (8 * c) * 33 + n;
        v4u o; o.x = pk2(s[0 * 33], s[1 * 33]); o.y = pk2(s[2 * 33], s[3 * 33]); o.z = pk2(s[4 * 33], s[5 * 33]); o.w = pk2(s[6 * 33], s[7 * 33]);
        *(GAS v4u*)(WT + (size_t)(row_off + n0 + n) * K + k0 + 8 * c) = o; }
    LDS_WAIT(); asm volatile("" ::: "memory");
}
__device__ __forceinline__ void p0_table_rows4(const float* const (&src)[4], unsigned char* const (&dst)[4], float* const (&scale_out)[4], int off, int lane) {
    f32x4 v[4][4]; float am[4];
#pragma unroll
    for (int u = 0; u < 4; ++u)
#pragma unroll
        for (int q = 0; q < 4; ++q) v[u][q] = *(const f32x4*)(src[u] + 16 * lane + 4 * q);
#pragma unroll
    for (int u = 0; u < 4; ++u) { float a = 0.f;
#pragma unroll
        for (int q = 0; q < 4; ++q) a = fmaxf(fmaxf(a, fmaxf(fabsf(v[u][q][0]), fabsf(v[u][q][1]))), fmaxf(fabsf(v[u][q][2]), fabsf(v[u][q][3])));
        am[u] = a; }
#pragma unroll
    for (int o = 1; o < 64; o <<= 1) {
#pragma unroll
        for (int u = 0; u < 4; ++u) am[u] = fmaxf(am[u], __shfl_xor(am[u], o)); }
#pragma unroll
    for (int u = 0; u < 4; ++u) { const float sc = (am[u] > 0.f) ? am[u] * (1.0f / 127.0f) : 1.0f, inv = 1.0f / sc;
        v4u o;
#pragma unroll
        for (int q = 0; q < 4; ++q) { const int q0 = (int)rintf(v[u][q][0] * inv) + off, q1 = (int)rintf(v[u][q][1] * inv) + off, q2 = (int)rintf(v[u][q][2] * inv) + off, q3 = (int)rintf(v[u][q][3] * inv) + off;
            o[q] = (unsigned)(q0 & 255) | ((unsigned)(q1 & 255) << 8) | ((unsigned)(q2 & 255) << 16) | ((unsigned)q3 << 24); }
        *(GAS v4u*)(dst[u] + ((size_t)(lane >> 3) << 21) + 16 * (lane & 7)) = o;
        if (lane == 0) *scale_out[u] = sc; }
}
template <int STAGE>
__device__ __forceinline__ void p0b_prologue(Frame& F, const Args& A) {
    const int gw = F.vcu * NWAVES + F.wave, NGW = F.G * NWAVES, lane = F.lane;
    const float* modp = (const float*)(A.ws + WS_MODP);
    LAS float* G1 = (LAS float*)(F.lds + 135168);
    if (STAGE == 0) { float* ks = (float*)(A.ws + WS_KSUM); for (int i = F.vcu * NTHREADS + F.tid; i < NB * NBLK * 512; i += F.G * NTHREADS) ks[i] = 0.f; }
    if (STAGE == 0) { for (int r = F.vcu; r < 256; r += F.G) p0_wp_task(F, A, r); }
    else { p0_wg_dot<1>(F, nullptr, modp, 0, A.in[5], INW, nullptr, (float*)(A.ws + WS_BIAS1P), F.vcu, 8 * (INW / 64));
           p0_wg_dot<1>(F, nullptr, modp, 3072, A.in[13], PQW, nullptr, (float*)(A.ws + WS_BIAS2P), F.vcu, 8 * (PQW / 64)); }
    LAS float* scr = (LAS float*)(F.lds + RING_OFF + F.wave * 16384);
    constexpr int I_MODF = 768, I_WIN = (D / 64) * (INW / 32), I_WA = (AW / 64) * (D / 32), I_WOUT = (D / 64) * (D / 32), I_WQ = (D / 64) * (PQW / 32);
    constexpr int I_SUBK = 64;
    constexpr int NITEMS = I_MODF + I_WIN + I_WA + I_WOUT + I_WQ + I_SUBK;
    for (int it = gw; it < NITEMS; it += NGW) {
        int r = it;
        if (r < I_MODF) { if (STAGE != 1) continue; const int idx = r * 64 + lane; ((float*)(A.ws + WS_MODF))[idx] = modp_sum(modp, idx); continue; } r -= I_MODF;
        if (r < I_WIN) { if (STAGE != 0) continue; p0_transpose_item(A.in[5], D, INW, (bf16*)(A.ws + WS_WIN), 0, scr, r, lane); continue; } r -= I_WIN;
        if (r < I_WA) { if (STAGE != 0) continue; p0_transpose_item(A.in[6], AW, D, (bf16*)(A.ws + WS_WA), 0, scr, r, lane); continue; } r -= I_WA;
        if (r < I_WOUT) { if (STAGE != 0) continue; p0_transpose_item(A.in[11], D, D, (bf16*)(A.ws + WS_WOUT), 0, scr, r, lane); continue; } r -= I_WOUT;
        if (r < I_WQ) { if (STAGE != 0) continue; p0_transpose_item(A.in[13], D, PQW, (bf16*)(A.ws + WS_WQ), 0, scr, r, lane); continue; } r -= I_WQ;
        if (r < I_SUBK) { if (STAGE != 0) continue; const float* s = A.in[14] + (size_t)r * 512 + 8 * lane; const f32x4 a = *(const f32x4*)s, b = *(const f32x4*)(s + 4);
            v4u o; o.x = pk2(a[0], a[1]); o.y = pk2(a[2], a[3]); o.z = pk2(b[0], b[1]); o.w = pk2(b[2], b[3]);
            *(GAS v4u*)((bf16*)(A.ws + WS_SUBK) + (size_t)r * 512 + 8 * lane) = o; continue; } r -= I_SUBK;
    }
    auto xg_rows = [&](const int rb) {
        const float* x = A.in[0]; bf16* XG = (bf16*)(A.ws + WS_XG); float* rstd1 = (float*)(A.ws + WS_RSTD1);
            for (int r0 = F.wave; r0 < 128; r0 += 4 * NWAVES) {
                f32x4 v[4][2][2]; float s[4];
#pragma unroll
                for (int u = 0; u < 4; ++u) { const float* xr = x + (size_t)(rb * 128 + r0 + u * NWAVES) * 1024;
#pragma unroll
                    for (int h = 0; h < 2; ++h)
#pragma unroll
                        for (int q = 0; q < 2; ++q) v[u][h][q] = *(const f32x4*)(xr + h * 512 + 8 * lane + 4 * q); }
#pragma unroll
                for (int u = 0; u < 4; ++u) { float t = 0.f;
#pragma unroll
                    for (int h = 0; h < 2; ++h)
#pragma unroll
                        for (int q = 0; q < 2; ++q) t += (v[u][h][q][0] * v[u][h][q][0] + v[u][h][q][1] * v[u][h][q][1]) + (v[u][h][q][2] * v[u][h][q][2] + v[u][h][q][3] * v[u][h][q][3]);
                    s[u] = t; }
#pragma unroll
                for (int o = 1; o < 64; o <<= 1) {
#pragma unroll
                    for (int u = 0; u < 4; ++u) s[u] += __shfl_xor(s[u], o); }
#pragma unroll
                for (int u = 0; u < 4; ++u) { const int row = rb * 128 + r0 + u * NWAVES;
                    if (lane == 0) rstd1[row] = 1.0f / sqrtf(s[u] * (1.0f / D) + RMS_EPS);
#pragma unroll
                    for (int h = 0; h < 2; ++h) { const LAS float* g = G1 + h * 512 + 8 * lane;
                        v4u o; o.x = pk2(v[u][h][0][0] * g[0], v[u][h][0][1] * g[1]); o.y = pk2(v[u][h][0][2] * g[2], v[u][h][0][3] * g[3]); o.z = pk2(v[u][h][1][0] * g[4], v[u][h][1][1] * g[5]); o.w = pk2(v[u][h][1][2] * g[6], v[u][h][1][3] * g[7]);
                        *(GAS v4u*)(XG + (size_t)row * 1024 + h * 512 + 8 * lane) = o; } }
            }
    };
    auto table_rows = [&]() {
    for (int r0 = gw; r0 < 2 * PEXP; r0 += 4 * NGW) {
        const float* src[4]; unsigned char* dst[4]; float* sco[4];
#pragma unroll
        for (int u = 0; u < 4; ++u) { int r = r0 + u * NGW; if (r >= 2 * PEXP) r = r0; const int tb = r / PEXP, e = r % PEXP;
            src[u] = (tb ? A.in[16] : A.in[15]) + (size_t)e * D; dst[u] = A.ws + (tb ? WS_V : WS_U) + (size_t)e * 128; sco[u] = (float*)(A.ws + (tb ? WS_V : WS_U) + 16 * MiB) + e; }
        const int tb0 = r0 / PEXP;
        if ((r0 + 3 * NGW) / PEXP == tb0 && r0 + 3 * NGW < 2 * PEXP) p0_table_rows4(src, dst, sco, tb0 ? 128 : 0, lane);
        else { for (int u = 0; u < 4; ++u) { const int r = r0 + u * NGW; if (r < 2 * PEXP) { const float* s1[4] = {src[u], src[u], src[u], src[u]}; unsigned char* d1[4] = {dst[u], dst[u], dst[u], dst[u]}; float* c1[4] = {sco[u], sco[u], sco[u], sco[u]}; p0_table_rows4(s1, d1, c1, (r / PEXP) ? 128 : 0, lane); } } }
    }
    };
    if (STAGE == 0) table_rows();
    else for (int rb = F.vcu; rb < T / 128; rb += F.G) {
        const float* g1 = A.in[4]; const int b = (rb * 128) / SEQ;
        __syncthreads();
        for (int k = F.tid; k < 1024; k += NTHREADS) G1[k] = g1[k] * (1.0f + modp_sum(modp, b * 6144 + 1024 + k));
        __syncthreads();
        xg_rows(rb);
    }

}
namespace attn_body {
using bf16=__hip_bfloat16;
using bf16x8=__attribute__((ext_vector_type(8)))short;
using s16x4=__attribute__((ext_vector_type(4)))short;
using f32x16=__attribute__((ext_vector_type(16)))float;
using u32x4=__attribute__((ext_vector_type(4)))unsigned;
constexpr int BATCH=8,NHEAD=8,SEQ=4096,D=64,DM=NHEAD*D;
constexpr int NW=8,QBLK=32,QB=QBLK*NW,KVBLK=64,NQB=SEQ/QB;
constexpr int ATTN_PITCH=DM, ATTN_UNIT_ROWS=QB;
__device__ __forceinline__ int crow(int r,int hi){return (r&3)+8*(r>>2)+4*hi;}
#define SBAR() __builtin_amdgcn_sched_barrier(0)
__device__ __forceinline__ void cmask(f32x16&p0,f32x16&p1,int jb,int qrel,int hi){
  const float NEG=-INFINITY; int kb=64*jb+4*hi;
  #pragma unroll
  for(int r=0;r<16;++r){int kv=kb+(r&3)+8*(r>>2); if(kv>qrel)p0[r]=NEG; if(kv+32>qrel)p1[r]=NEG;}
}

constexpr int NSLOT=3, SLOTB=8192;
constexpr int LDS_K=0, LDS_V=NSLOT*SLOTB, LDS_WS=2*NSLOT*SLOTB, LDS_OST=LDS_WS+NW*64*4, LDS_KSL=LDS_OST+NW*4096, LDS_BYTES=LDS_KSL+4096;
constexpr float C2=0.125f*1.4426950408889634f;
__device__ __forceinline__ void glds16(const void*sbase,unsigned voff,unsigned lds_dst){unsigned keep;
  asm volatile("s_mov_b32 %0, m0\n\ts_mov_b32 m0, %3\n\ts_nop 4\n\tglobal_load_lds_dwordx4 %1, %2\n\ts_mov_b32 m0, %0":"=&s"(keep):"v"(voff),"s"(sbase),"s"(lds_dst):"memory");}
__device__ __forceinline__ float max3f(float a,float b,float c){float r;asm("v_max3_f32 %0, %1, %2, %3":"=v"(r):"v"(a),"v"(b),"v"(c));return r;}
__device__ __forceinline__ float max2f(float a,float b){float r;asm("v_max_f32_e32 %0, %1, %2":"=v"(r):"v"(a),"v"(b));return r;}
__device__ __forceinline__ float fadd_s(float a,float b){float r;asm("v_add_f32_e32 %0, %1, %2":"=v"(r):"v"(a),"v"(b));return r;}
__device__ __forceinline__ float fsub_s(float a,float b){float r;asm("v_sub_f32_e32 %0, %1, %2":"=v"(r):"v"(a),"v"(b));return r;}
typedef float f32x2_t __attribute__((ext_vector_type(2))); typedef __bf16 bf16x2_t __attribute__((ext_vector_type(2)));
__device__ __forceinline__ unsigned cvtpk_s(float lo,float hi){f32x2_t v={lo,hi};bf16x2_t b=__builtin_convertvector(v,bf16x2_t);return __builtin_bit_cast(unsigned,b);}
#define WAIT_BAR(N) asm volatile("s_waitcnt vmcnt(" #N ") lgkmcnt(0)\n\ts_barrier":::"memory")

__device__ __forceinline__ void qkt(f32x16&p0,f32x16&p1,const char*Kslot,const bf16x8*qr,const f32x16&negm,int r32,int hi){
  const char*kb=Kslot+hi*1024+r32*16;
  #pragma unroll
  for(int d0=0;d0<4;++d0){
    const bf16x8 b0=*reinterpret_cast<const bf16x8*>(kb+d0*2048);
    const bf16x8 b1=*reinterpret_cast<const bf16x8*>(kb+d0*2048+512);
    if(d0==0){p0=__builtin_amdgcn_mfma_f32_32x32x16_bf16(b0,qr[0],negm,0,0,0);p1=__builtin_amdgcn_mfma_f32_32x32x16_bf16(b1,qr[0],negm,0,0,0);}
    else{p0=__builtin_amdgcn_mfma_f32_32x32x16_bf16(b0,qr[d0],p0,0,0,0);p1=__builtin_amdgcn_mfma_f32_32x32x16_bf16(b1,qr[d0],p1,0,0,0);}}
}
typedef __attribute__((address_space(3))) const char* lds_cptr;
typedef short v4i16_t __attribute__((ext_vector_type(4)));
__device__ __forceinline__ void kload8(bf16x8*kf,lds_cptr kp){
  kf[0]=*(const __attribute__((address_space(3))) bf16x8*)(kp);      kf[1]=*(const __attribute__((address_space(3))) bf16x8*)(kp+512);
  kf[2]=*(const __attribute__((address_space(3))) bf16x8*)(kp+2048); kf[3]=*(const __attribute__((address_space(3))) bf16x8*)(kp+2560);
  kf[4]=*(const __attribute__((address_space(3))) bf16x8*)(kp+4096); kf[5]=*(const __attribute__((address_space(3))) bf16x8*)(kp+4608);
  kf[6]=*(const __attribute__((address_space(3))) bf16x8*)(kp+6144); kf[7]=*(const __attribute__((address_space(3))) bf16x8*)(kp+6656);
}
__device__ __forceinline__ void kload2(bf16x8*kf,lds_cptr kp,int j){ kf[2*j]=*(const __attribute__((address_space(3))) bf16x8*)(kp+j*2048); kf[2*j+1]=*(const __attribute__((address_space(3))) bf16x8*)(kp+j*2048+512); }
__device__ __forceinline__ s16x4 vtr(lds_cptr p){ return __builtin_bit_cast(s16x4,__builtin_amdgcn_ds_read_tr16_b64_v4i16((__attribute__((address_space(3))) v4i16_t*)p)); }
__device__ __forceinline__ float rowmax(const f32x16&p0,const f32x16&p1){
  float a=max3f(p0[0],p0[1],p1[0]),b=max3f(p0[2],p0[3],p1[1]);a=max3f(a,p1[2],p1[3]);
  #pragma unroll
  for(int r=4;r<16;r+=4){a=max3f(a,p0[r],p0[r+1]);b=max3f(b,p0[r+2],p0[r+3]);a=max3f(a,p1[r],p1[r+1]);b=max3f(b,p1[r+2],p1[r+3]);}
  const float m=max2f(a,b);
  auto rr=__builtin_amdgcn_permlane32_swap(__float_as_uint(m),__float_as_uint(m),false,false);
  return max2f(__uint_as_float(rr[0]),__uint_as_float(rr[1]));
}
__device__ __forceinline__ void pv(f32x16*o,int vb,bf16x8 pa0,bf16x8 pa1,bf16x8 pa2,bf16x8 pa3){
  #pragma unroll
  for(int d0=0;d0<2;++d0){s16x4 lo[4],hi[4];
    #pragma unroll
    for(int ks=0;ks<4;++ks){
      asm volatile("ds_read_b64_tr_b16 %0,%1 offset:%c2":"=&v"(lo[ks]):"v"(vb),"i"(d0*4096+ks*1024):"memory");
      asm volatile("ds_read_b64_tr_b16 %0,%1 offset:%c2":"=&v"(hi[ks]):"v"(vb),"i"(d0*4096+ks*1024+512):"memory");}
    asm volatile("s_waitcnt lgkmcnt(0)":::"memory");SBAR();
    #define PK(k) (bf16x8){lo[k][0],lo[k][1],lo[k][2],lo[k][3],hi[k][0],hi[k][1],hi[k][2],hi[k][3]}
    o[d0]=__builtin_amdgcn_mfma_f32_32x32x16_bf16(pa0,PK(0),o[d0],0,0,0);
    o[d0]=__builtin_amdgcn_mfma_f32_32x32x16_bf16(pa1,PK(1),o[d0],0,0,0);
    o[d0]=__builtin_amdgcn_mfma_f32_32x32x16_bf16(pa2,PK(2),o[d0],0,0,0);
    o[d0]=__builtin_amdgcn_mfma_f32_32x32x16_bf16(pa3,PK(3),o[d0],0,0,0);
    #undef PK
  }
}

#ifndef ATTN_STORE16
#define ATTN_STORE16(p,v) (*(u32x4*)(p)=(v))
#endif
template<int THRL> __device__ __forceinline__ void attn_unit(int b,int h,int qb,const bf16*Q,const bf16*__restrict__ K,const bf16*__restrict__ V,bf16*O,const float*ksum,char*shm){
  int tid_=threadIdx.x; asm volatile("":"+v"(tid_)); const int tid=tid_,lane=tid&63,r32=lane&31,hi=lane>>5; const int wid=__builtin_amdgcn_readfirstlane(tid>>6);
  const long rowbase=(long)b*SEQ; const int q0=qb*QB;
  const bf16*Qw=Q+(rowbase+q0+wid*QBLK)*DM+h*D;
  const bf16*Kh=K+rowbase*DM+h*D,*Vh=V+rowbase*DM+h*D;
  const unsigned lds0=(unsigned)(uintptr_t)shm;
  float*wsf=(float*)(shm+LDS_WS)+wid*64;
  const unsigned kvoff=(unsigned)(lane*DM+wid*8)*2u;
  const unsigned vvoff=(unsigned)((16*(wid&3)+(lane>>2))*DM+(wid>>2)*32+(lane&3)*8)*2u;
  const unsigned kdst=lds0+LDS_K+wid*1024, vdst=lds0+LDS_V+wid*1024;
  #define DMA_K(t,slot) glds16(Kh+(long)(NT-1-(t))*KVBLK*DM,kvoff,(unsigned)__builtin_amdgcn_readfirstlane(kdst+(slot)))
  #define DMA_V(t,slot) glds16(Vh+(long)(NT-1-(t))*KVBLK*DM,vvoff,(unsigned)__builtin_amdgcn_readfirstlane(vdst+(slot)))
  const int vb0=(int)(lds0+LDS_V)+((lane>>4)&1)*32+(lane&3)*8+(4*hi+((lane&15)>>2))*64;
  const char*Kbase=shm+LDS_K; bf16x8 kf[8];
  const lds_cptr shm3=(lds_cptr)shm; const lds_cptr kp0=shm3+LDS_K+hi*1024+r32*16; const lds_cptr vp0=shm3+LDS_V+((lane>>4)&1)*32+(lane&3)*8+(4*hi+((lane&15)>>2))*64;
  const int NT=(q0+QB)/KVBLK;
  { float*ksl=(float*)(shm+LDS_KSL); const float k0=ksum[(long)(b*16+(tid>>6))*512+h*64+(tid&63)],k1=ksum[(long)(b*16+8+(tid>>6))*512+h*64+(tid&63)]; ksl[tid]=k0; ksl[512+tid]=k1; }
  DMA_K(0,0);DMA_V(0,0);DMA_K(1,SLOTB);
  bf16x8 qr[4];
  #pragma unroll
  for(int d0=0;d0<4;++d0)qr[d0]=*reinterpret_cast<const bf16x8*>(&Qw[(long)r32*DM+d0*16+hi*8]);
  float mhat=0.f,l_reg=0.f;f32x16 o[2];o[0]=f32x16{};o[1]=f32x16{};const f32x16 zero16=f32x16{};
  const int qrel=wid*QBLK+r32;
  #define CMASK(P0,P1,t) do{int jb_=3-(t); if(jb_>=0)cmask(P0,P1,jb_,qrel,hi);}while(0)
  const unsigned sl2b=0x3FB8AA3Bu-((unsigned)(h+1)<<23);
  const float slope2=__uint_as_float(sl2b), s2x=__uint_as_float(sl2b+(1u<<23)), s8x=__uint_as_float(sl2b+(3u<<23)), s32=__uint_as_float(sl2b+(5u<<23));
  const float s3x=__uint_as_float((unsigned)__builtin_amdgcn_readfirstlane((int)__float_as_uint(slope2*3.0f)));
  #define NBSEL(r) (((r)>>2)==0?nbb0_:((r)>>2)==1?nbb1_:((r)>>2)==2?nbb2_:nbb3_)
  #define NEGV(r) ((((r)&3)==0)?NBSEL(r):(NBSEL(r)+(((r)&3)==1?slope2:((r)&3)==2?s2x:s3x)))
  #define NBB(nb) const float nbb0_=(nb), nbb1_=nbb0_+s8x, nbb2_=nbb1_+s8x, nbb3_=nbb2_+s8x
  #define NBSELC(r) (((r)>>2)==0?nbc0_:((r)>>2)==1?nbc1_:((r)>>2)==2?nbc2_:nbc3_)
  #define SAV(r) (((r)&3)==1?slope2:((r)&3)==2?s2x:s3x)
  #define BIAS(C0,C1,s) do{ NBB(NBV(s)); const float nbc0_=nbb0_+s32,nbc1_=nbb1_+s32,nbc2_=nbb2_+s32,nbc3_=nbb3_+s32; \
      _Pragma("unroll") for(int r=0;r<16;++r){ if((r&3)==0){C0[r]+=NBSEL(r);C1[r]+=NBSELC(r);} else {C0[r]=(C0[r]+NBSEL(r))+SAV(r);C1[r]=(C1[r]+NBSELC(r))+SAV(r);} } }while(0)
  unsigned sel=0u;
  #define NBV(s) ({ const int tl_=NT-1-(s); const int tc_=tl_<0?0:tl_; const int bj_=tc_>>2; const float off_=(bj_>=qb||((sel>>bj_)&1u))?0.f:-1.0e30f; \
      __builtin_fmaf(slope2,(float)(64*tl_+4*hi-q0-qrel),off_-mhat); })
  #define CRC(r) ((float)(((r)&3)+8*((r)>>2)))
  bool resc=false;
  #define START(P0,P1) do{ const float rm=rowmax(P0,P1); resc=false; \
    { const float dl=(rm>-1.0e20f)?rm:0.f; mhat=fadd_s(mhat,dl); \
      _Pragma("unroll") for(int r=0;r<16;++r){P0[r]=fsub_s(P0[r],dl);P1[r]=fsub_s(P1[r],dl);} } \
    _Pragma("unroll") for(int r=0;r<16;++r)P0[r]=__builtin_amdgcn_exp2f(P0[r]); }while(0)
  #define RESC() do{ if(resc){ asm volatile("s_waitcnt lgkmcnt(0)":::"memory"); \
      _Pragma("unroll") for(int d_=0;d_<2;++d_) _Pragma("unroll") for(int r=0;r<16;++r)o[d_][r]*=wsf[crow(r,hi)]; } }while(0)
  f32x16 pA0,pA1,pB0,pB1;
  int sl_prev=0,sl_cur=0,sl_next=SLOTB;
  #define ROT() do{sl_prev=sl_cur;sl_cur=sl_next;sl_next=(sl_next==(NSLOT-1)*SLOTB)?0:sl_next+SLOTB;}while(0)
  DMA_K(2,2*SLOTB);
  WAIT_BAR(3);
  if(qb>0){
    float qf[32];
    _Pragma("unroll") for(int d0=0;d0<4;++d0) _Pragma("unroll") for(int e=0;e<8;++e) qf[d0*8+e]=__uint_as_float(((unsigned)(unsigned short)qr[d0][e])<<16);
    const float*ksl=(const float*)(shm+LDS_KSL)+8*hi;
    float b1=-3.0e38f,b2=-3.0e38f,b3=-3.0e38f; int i1=-1,i2=-1,i3=-1;
    for(int j=0;j<qb;++j){ float g=0.f;
      _Pragma("unroll") for(int d0=0;d0<4;++d0) _Pragma("unroll") for(int e=0;e<8;++e) g=__builtin_fmaf(qf[d0*8+e],ksl[j*64+16*d0+e],g);
      { auto rr=__builtin_amdgcn_permlane32_swap(__float_as_uint(g),__float_as_uint(g),false,false); g=__uint_as_float(rr[0])+__uint_as_float(rr[1]); }
      const bool c1=g>b1,c2=g>b2,c3=g>b3;
      b3=c2?b2:(c3?g:b3); i3=c2?i2:(c3?j:i3); b2=c1?b1:(c2?g:b2); i2=c1?i1:(c2?j:i2); b1=c1?g:b1; i1=c1?j:i1; }
    sel=(1u<<i1)|(i2>=0?(1u<<i2):0u)|(i3>=0?(1u<<i3):0u); }
  qkt(pA0,pA1,Kbase,qr,zero16,r32,hi);asm volatile("s_nop 15\n\ts_nop 7":"+v"(pA0),"+v"(pA1));
  BIAS(pA0,pA1,0);
  CMASK(pA0,pA1,0);
  START(pA0,pA1);
  _Pragma("unroll") for(int r=0;r<16;++r)pA1[r]=__builtin_amdgcn_exp2f(pA1[r]);
  WAIT_BAR(0);
  DMA_K(3,0);DMA_V(1,SLOTB);
  ROT();
  kload8(kf,kp0+sl_cur);
  WAIT_BAR(2);
  s16x4 vlo[8],vhi[8]; u32x4 pw0,pw1,pw2,pw3;
  #define PKW(P,B) cvtpk_s(P[B],P[B+1])
  #define PAF(k) __builtin_bit_cast(bf16x8,pw##k)
  #define VFR(i) (bf16x8){vlo[i][0],vlo[i][1],vlo[i][2],vlo[i][3],vhi[i][0],vhi[i][1],vhi[i][2],vhi[i][3]}
  #define PIN(x) asm volatile("":"+v"(x))
  #define MX3(a,b,c) __builtin_fmaxf(__builtin_fmaxf((a),(b)),(c))
  #define GAPA(MF,A0,A1,A2,A3,W0,W1,PW) do{ MF; sacc+=A0; sacc+=A1; sacc+=A2; sacc+=A3; PIN(sacc); W0; W1; PIN(PW); SBAR(); }while(0)
  #define EX(v) __builtin_amdgcn_exp2f(v)
  #define GAPB(MF,X,B) do{ MF; X[B]=EX(X[B]); X[B+1]=EX(X[B+1]); X[B+2]=EX(X[B+2]); X[B+3]=EX(X[B+3]); PIN(X); SBAR(); }while(0)
  #define VRD(i) do{ vlo[i]=vtr(vp_+(((i)>>2)*4096+((i)&3)*1024)); vhi[i]=vtr(vp_+(((i)>>2)*4096+((i)&3)*1024+512)); }while(0)
  #define KRD(G,j) do{ if(G){ kload2(kf,kp0+sl_next,j); SBAR(); } }while(0)
  #define STEP(C0,C1,P0,P1,t,GK,GV,GL) do{ SBAR(); \
    const lds_cptr vp_=vp0+sl_prev; \
    VRD(0); SBAR(); float sacc=(P0[0]+P0[1]); \
    GAPA(C0=__builtin_amdgcn_mfma_f32_32x32x16_bf16(kf[0],qr[0],zero16,0,0,0), P0[2],P0[3],P0[4],P0[5],     pw0[0]=PKW(P0,0), pw0[1]=PKW(P0,2), pw0); \
    VRD(4); SBAR(); GAPA(C1=__builtin_amdgcn_mfma_f32_32x32x16_bf16(kf[1],qr[0],zero16,0,0,0), P0[6],P0[7],P0[8],P0[9],     pw0[2]=PKW(P0,4), pw0[3]=PKW(P0,6), pw0); \
    VRD(1); SBAR(); GAPA(C0=__builtin_amdgcn_mfma_f32_32x32x16_bf16(kf[2],qr[1],C0,0,0,0),   P0[10],P0[11],P0[12],P0[13], pw1[0]=PKW(P0,8), pw1[1]=PKW(P0,10), pw1); \
    VRD(5); SBAR(); GAPA(C1=__builtin_amdgcn_mfma_f32_32x32x16_bf16(kf[3],qr[1],C1,0,0,0),   P0[14],P0[15],P1[0],P1[1],   pw1[2]=PKW(P0,12),pw1[3]=PKW(P0,14), pw1); \
    VRD(2); SBAR(); GAPA(C0=__builtin_amdgcn_mfma_f32_32x32x16_bf16(kf[4],qr[2],C0,0,0,0),   P1[2],P1[3],P1[4],P1[5],     pw2[0]=PKW(P1,0), pw2[1]=PKW(P1,2), pw2); \
    VRD(6); SBAR(); GAPA(C1=__builtin_amdgcn_mfma_f32_32x32x16_bf16(kf[5],qr[2],C1,0,0,0),   P1[6],P1[7],P1[8],P1[9],     pw2[2]=PKW(P1,4), pw2[3]=PKW(P1,6), pw2); \
    VRD(3); SBAR(); GAPA(C0=__builtin_amdgcn_mfma_f32_32x32x16_bf16(kf[6],qr[3],C0,0,0,0),   P1[10],P1[11],P1[12],P1[13], pw3[0]=PKW(P1,8), pw3[1]=PKW(P1,10), pw3); \
    VRD(7); SBAR(); GAPA(C1=__builtin_amdgcn_mfma_f32_32x32x16_bf16(kf[7],qr[3],C1,0,0,0),   P1[14],P1[15],0.f,0.f,       pw3[2]=PKW(P1,12),pw3[3]=PKW(P1,14), pw3); \
    l_reg+=sacc; \
    if(GK){DMA_K((t)+3,sl_cur);} if(GV){DMA_V((t)+1,sl_next);} \
    BIAS(C0,C1,t); \
    CMASK(C0,C1,t); \
    { float a=MX3(C0[0],C0[1],C1[0]),b=MX3(C0[2],C0[3],C1[1]); a=MX3(a,C1[2],C1[3]); \
      _Pragma("unroll") for(int r=4;r<16;r+=4){a=MX3(a,C0[r],C0[r+1]);b=MX3(b,C0[r+2],C0[r+3]);a=MX3(a,C1[r],C1[r+1]);b=MX3(b,C1[r+2],C1[r+3]);} \
      float rm=__builtin_fmaxf(a,b); { auto rr=__builtin_amdgcn_permlane32_swap(__float_as_uint(rm),__float_as_uint(rm),false,false); rm=__builtin_fmaxf(__uint_as_float(rr[0]),__uint_as_float(rr[1])); } \
      resc=false; \
      if(__builtin_expect(__any(rm>(float)THRL),0)){ const float dl=__builtin_fmaxf(rm,0.f); mhat+=dl; \
        _Pragma("unroll") for(int r=0;r<16;++r){C0[r]-=dl;C1[r]-=dl;} \
        const float f=__builtin_amdgcn_exp2f(-dl); l_reg*=f; if(hi==0)wsf[r32]=f; resc=true; } } \
    SBAR(); \
    GAPB(o[0]=__builtin_amdgcn_mfma_f32_32x32x16_bf16(PAF(0),VFR(0),o[0],0,0,0), C0,0); \
    GAPB(o[1]=__builtin_amdgcn_mfma_f32_32x32x16_bf16(PAF(0),VFR(4),o[1],0,0,0), C0,4); \
    KRD(GL,0); GAPB(o[0]=__builtin_amdgcn_mfma_f32_32x32x16_bf16(PAF(1),VFR(1),o[0],0,0,0), C0,8); \
    KRD(GL,1); GAPB(o[1]=__builtin_amdgcn_mfma_f32_32x32x16_bf16(PAF(1),VFR(5),o[1],0,0,0), C0,12); \
    KRD(GL,2); GAPB(o[0]=__builtin_amdgcn_mfma_f32_32x32x16_bf16(PAF(2),VFR(2),o[0],0,0,0), C1,0); \
    KRD(GL,3); GAPB(o[1]=__builtin_amdgcn_mfma_f32_32x32x16_bf16(PAF(2),VFR(6),o[1],0,0,0), C1,4); \
    GAPB(o[0]=__builtin_amdgcn_mfma_f32_32x32x16_bf16(PAF(3),VFR(3),o[0],0,0,0), C1,8); \
    GAPB(o[1]=__builtin_amdgcn_mfma_f32_32x32x16_bf16(PAF(3),VFR(7),o[1],0,0,0), C1,12); \
    }while(0)
  int t=1;
  #define ENDW(tt) do{ if((tt)+3<NT){WAIT_BAR(2);} else if((tt)+2<NT){WAIT_BAR(1);} else {WAIT_BAR(0);} }while(0)
  #define PEELED_PAIR() do{ \
    STEP(pB0,pB1,pA0,pA1,t,(t+3<NT),(t+1<NT),(t+1<NT));       ENDW(t);   RESC(); ROT(); \
    STEP(pA0,pA1,pB0,pB1,t+1,(t+4<NT),(t+2<NT),(t+2<NT));     ENDW(t+1); RESC(); ROT(); }while(0)
  for(;t<5&&t+1<NT;t+=2){ PEELED_PAIR(); }
  #undef CMASK
  #define CMASK(P0,P1,t) do{}while(0)
  for(;t+5<NT;t+=2){
    STEP(pB0,pB1,pA0,pA1,t,true,true,true);     WAIT_BAR(2); RESC(); ROT();
    STEP(pA0,pA1,pB0,pB1,t+1,true,true,true);   WAIT_BAR(2); RESC(); ROT();
  }
  #undef CMASK
  #define CMASK(P0,P1,t) do{int jb_=3-(t); if(jb_>=0)cmask(P0,P1,jb_,qrel,hi);}while(0)
  for(;t+1<NT;t+=2){ PEELED_PAIR(); }
  STEP(pB0,pB1,pA0,pA1,NT-1,false,false,false); RESC();
  { float sacc=pB0[0]+pB0[1]; _Pragma("unroll") for(int r=2;r<16;++r)sacc+=pB0[r]; _Pragma("unroll") for(int r=0;r<16;++r)sacc+=pB1[r]; l_reg+=sacc;
    pw0=(u32x4){PKW(pB0,0),PKW(pB0,2),PKW(pB0,4),PKW(pB0,6)};pw1=(u32x4){PKW(pB0,8),PKW(pB0,10),PKW(pB0,12),PKW(pB0,14)};pw2=(u32x4){PKW(pB1,0),PKW(pB1,2),PKW(pB1,4),PKW(pB1,6)};pw3=(u32x4){PKW(pB1,8),PKW(pB1,10),PKW(pB1,12),PKW(pB1,14)};
    SBAR(); pv(o,vb0+sl_cur,PAF(0),PAF(1),PAF(2),PAF(3)); }
  #undef PKW
  #undef PAF
  #undef VFR
  #undef PIN
  #undef MX3
  #undef GAPA
  #undef GAPB
  #undef EX
  #undef VRD
  #undef KRD
  #undef STEP
  #undef ENDW
  #undef PEELED_PAIR
  #undef NBV
  #undef CRC
  #undef NEGV
  #undef NBSEL
  #undef NBB
  #undef NBSELC
  #undef SAV
  #undef BIAS
  {auto rr=__builtin_amdgcn_permlane32_swap(__float_as_uint(l_reg),__float_as_uint(l_reg),false,false);l_reg=__uint_as_float(rr[0])+__uint_as_float(rr[1]);}
  if(hi==0)wsf[32+r32]=l_reg;asm volatile("s_waitcnt lgkmcnt(0)":::"memory");
  float rli[16];
  #pragma unroll
  for(int r=0;r<16;++r)rli[r]=__builtin_amdgcn_rcpf(wsf[32+crow(r,hi)]);
  bf16*Ow=O+(rowbase+q0+wid*QBLK)*DM+h*D;
  { bf16*stg=(bf16*)(shm+LDS_OST)+wid*2048;
    #pragma unroll
    for(int r=0;r<16;++r){const int orow=crow(r,hi);
      #pragma unroll
      for(int d0=0;d0<2;++d0)stg[orow*64+d0*32+r32]=__float2bfloat16(o[d0][r]*rli[r]);}
    asm volatile("s_waitcnt lgkmcnt(0)":::"memory");
    #pragma unroll
    for(int i=0;i<4;++i){const int row=i*8+(lane>>3),ch=lane&7; const u32x4 v=*(const u32x4*)(stg+row*64+ch*8); ATTN_STORE16(Ow+(long)row*DM+ch*8,v);} }
  asm volatile("s_waitcnt lgkmcnt(0)\n\ts_barrier":::"memory");
  #undef DMA_K
  #undef DMA_V
  #undef CMASK
  #undef START
  #undef RESC
  #undef ROT
}
constexpr int ATTN_LDS_BYTES=LDS_BYTES;
struct AttnTensors { const bf16* Q; const bf16* K; const bf16* V; bf16* O; };
struct AttnUnit { int bh; int qb; };
struct StaticOrder {
  int vcu,G;
  __device__ __forceinline__ explicit StaticOrder(int grid,int vcu_):vcu(vcu_),G(grid){}
  __device__ __forceinline__ bool next(int i,AttnUnit&u)const{
    if(G!=256){ const int id=vcu+i*G; if(id>=BATCH*NHEAD*NQB)return false; u.bh=id>>4; u.qb=id&15; return true; }
    if(i>=4)return false; const int s=vcu&3; u.bh=vcu>>2; u.qb=(i==0)?s:(i==1)?7-s:(i==2)?8+s:15-s; return true; }
};
template<class Sched,int THRL=8> __device__ __forceinline__ void attn_phase(char*lds,const AttnTensors&T,const float*ksum,const Sched&S){
  AttnUnit u;
  for(int i=0;S.next(i,u);++i){ attn_unit<THRL>(u.bh/NHEAD,u.bh%NHEAD,u.qb,T.Q,T.K,T.V,T.O,ksum,lds); }
}
#undef SBAR
#undef WAIT_BAR
}

__device__ __forceinline__ void pooled_phase(Frame& F, const Args& A) {
    const bf16* P = (const bf16*)(A.ws + WS_QKVP) + (size_t)3 * T * 512; bf16* PO = (bf16*)(A.ws + WS_POOLED);
    const int gw = F.vcu * NWAVES + F.wave, NGW = F.G * NWAVES, lane = F.lane, w = 2 << (lane >> 4);
    for (int tk = gw; tk < T / 16; tk += NGW) {
        const int row0 = tk * 16, s0 = row0 & (SEQ - 1);
        v4u rv[31];
#pragma unroll
        for (int i = 0; i < 31; ++i) { const int sidx = s0 - 15 + i; rv[i] = (sidx >= 0) ? *(const v4u*)(P + (size_t)(row0 - 15 + i) * 512 + 8 * lane) : (v4u){0u, 0u, 0u, 0u}; }
#pragma unroll
        for (int i = 0; i < 16; ++i) {
            const int sidx = s0 + i; float acc[8];
#pragma unroll
            for (int e = 0; e < 8; ++e) acc[e] = 0.f;
#pragma unroll
            for (int k = 0; k < 16; ++k) { const bool ok = (k < w) && (sidx - k >= 0); const v4u x = rv[15 + i - k]; const float msk = ok ? 1.0f : 0.0f;
                acc[0] += msk * bflo(x.x); acc[1] += msk * bfhi(x.x); acc[2] += msk * bflo(x.y); acc[3] += msk * bfhi(x.y); acc[4] += msk * bflo(x.z); acc[5] += msk * bfhi(x.z); acc[6] += msk * bflo(x.w); acc[7] += msk * bfhi(x.w); }
            const float inv = 1.0f / (float)min(sidx + 1, w); const v4u x = rv[15 + i];
            v4u o; o.x = pk2(acc[0] * inv - bflo(x.x), acc[1] * inv - bfhi(x.x)); o.y = pk2(acc[2] * inv - bflo(x.y), acc[3] * inv - bfhi(x.y));
            o.z = pk2(acc[4] * inv - bflo(x.z), acc[5] * inv - bfhi(x.z)); o.w = pk2(acc[6] * inv - bflo(x.w), acc[7] * inv - bfhi(x.w));
            *(v4u*)(PO + (size_t)(row0 + i) * 512 + 8 * lane) = o;
        }
    }
}

namespace rt {
typedef float f32x16 __attribute__((ext_vector_type(16)));
typedef short bf16x8 __attribute__((ext_vector_type(8)));
__device__ __forceinline__ void ce(float& hi, float& lo) { const float a = fmaxf(hi, lo), b = fminf(hi, lo); hi = a; lo = b; }
template <int N> __device__ __forceinline__ void sort_desc(float (&v)[N]) {
#pragma unroll
    for (int k = 2; k <= N; k <<= 1)
#pragma unroll
        for (int j = k >> 1; j > 0; j >>= 1)
#pragma unroll
            for (int i = 0; i < N; ++i) { const int l = i ^ j; if (l > i) { if ((i & k) == 0) ce(v[i], v[l]); else ce(v[l], v[i]); } }
}
template <int N> __device__ __forceinline__ void bitonic_merge_desc(float (&v)[N]) {
#pragma unroll
    for (int j = N >> 1; j > 0; j >>= 1)
#pragma unroll
        for (int i = 0; i < N; ++i) { const int l = i ^ j; if (l > i) ce(v[i], v[l]); }
}
__device__ __forceinline__ void merge_top16(float (&a)[16], const float (&b)[16]) {
#pragma unroll
    for (int i = 0; i < 16; ++i) a[i] = fmaxf(a[i], b[15 - i]);
    bitonic_merge_desc<16>(a);
}
template <bool SORT> __device__ __forceinline__ void pair_merge(float (&a)[16], bool hi) {
    float w[16];
#pragma unroll
    for (int i = 0; i < 16; ++i) w[i] = hi ? a[15 - i] : a[i];
#pragma unroll
    for (int i = 0; i < 16; ++i) { const auto rr = __builtin_amdgcn_permlane32_swap(__float_as_uint(w[i]), __float_as_uint(w[i]), false, false); a[i] = fmaxf(__uint_as_float(rr[0]), __uint_as_float(rr[1])); }
    if (SORT) bitonic_merge_desc<16>(a);
}
__device__ __forceinline__ void fold_tile(const f32x16& acc, int kt, int hi, float (&out)[16]) {
    float g[16];
#pragma unroll
    for (int r = 0; r < 16; ++r) { const unsigned key = (unsigned)(32 * kt + (r & 3) + 8 * (r >> 2)); g[r] = __uint_as_float((__float_as_uint(acc[r]) & ~127u) | key | ((unsigned)hi << 2)); }
    sort_desc<16>(g);
    if (kt == 0) {
#pragma unroll
        for (int r = 0; r < 16; ++r) out[r] = g[r];
    } else merge_top16(out, g);
}
}
__device__ __forceinline__ void router_phase(Frame& F, const Args& A) {
    using namespace rt;
    const bf16* QP = (const bf16*)(A.ws + WS_GAB); const bf16* SK = (const bf16*)(A.ws + WS_SUBK);
    unsigned short* IDX = (unsigned short*)(A.ws + WS_POOLED); float* GATE = (float*)(A.ws + WS_POOLED + 16 * MiB);
    const int lane = F.lane, n32 = lane & 31, hi = lane >> 5, gw = F.vcu * NWAVES + F.wave, NGW = F.G * NWAVES;
    __syncthreads();
    for (int i = F.tid; i < 2 * 128 * 16; i += NTHREADS) { const int r = i >> 4, ch = i & 15; *(LAS v4u*)(F.lds + r * 272 + ch * 16) = *(const v4u*)(SK + (size_t)r * 128 + ch * 8); }
    __syncthreads();
    LAS unsigned char* scr = F.lds + 73728 + F.wave * 1024;
    const LAS unsigned char* afrag = F.lds + n32 * 272 + hi * 16;
    bf16x8 qa[8], qb[8];
#define RT_QLOAD(task_, p_, q_) do { const int tq_ = (task_) * 4 + (n32 >> 3); const bf16* qr_ = QP + (size_t)tq_ * PQW + (n32 & 7) * 256 + (p_) * 128 + 8 * hi; \
        _Pragma("unroll") for (int i = 0; i < 8; ++i) q_[i] = *(const bf16x8*)(qr_ + 16 * i); } while (0)
#define RT_HALF(p_, q_, out_) do { _Pragma("unroll") for (int kt = 0; kt < 4; ++kt) { f32x16 acc = f32x16{}; \
        _Pragma("unroll") for (int ks = 0; ks < 8; ++ks) { const bf16x8 kf = *(const LAS bf16x8*)(afrag + ((p_) * 128 + 32 * kt) * 272 + 32 * ks); acc = __builtin_amdgcn_mfma_f32_32x32x16_bf16(kf, q_[ks], acc, 0, 0, 0); } \
        fold_tile(acc, kt, hi, out_); } pair_merge<true>(out_, hi != 0); } while (0)
    if (gw < T * PHEADS / 32) RT_QLOAD(gw, 0, qa);
    for (int task = gw; task < T * PHEADS / 32; task += NGW) {
        const int t = task * 4 + (n32 >> 3), h = n32 & 7;
        float la[16], lb[16];
        RT_QLOAD(task, 1, qb);
        RT_HALF(0, qa, la);
        { const int nxt = task + NGW; if (nxt < T * PHEADS / 32) RT_QLOAD(nxt, 0, qa); }
        RT_HALF(1, qb, lb);
        { unsigned w[4];
#pragma unroll
          for (int q = 0; q < 4; ++q) {
              const unsigned i0 = __float_as_uint(hi ? lb[4 * q] : la[4 * q]) & 127u, i1 = __float_as_uint(hi ? lb[4 * q + 1] : la[4 * q + 1]) & 127u, i2 = __float_as_uint(hi ? lb[4 * q + 2] : la[4 * q + 2]) & 127u, i3 = __float_as_uint(hi ? lb[4 * q + 3] : la[4 * q + 3]) & 127u;
              w[q] = i0 | (i1 << 8) | (i2 << 16) | (i3 << 24); }
          *(LAS v4u*)(scr + n32 * 32 + hi * 16) = (v4u){w[0], w[1], w[2], w[3]}; }
        float x[16], y[16];
#pragma unroll
        for (int i = 0; i < 16; ++i) { const float av = __uint_as_float(__float_as_uint(la[i]) & ~127u), bv = __uint_as_float(__float_as_uint(lb[i]) & ~127u); x[i] = hi ? bv : av; y[i] = hi ? av : bv; }
        float c0[16], c1[16];
        {
            const unsigned hb = (unsigned)hi << 8;
#define RT_CAND(i, j) __uint_as_float(((__float_as_uint(x[i] + y[j]) & ~511u) | (unsigned)((i) * 16 + (j))) | hb)
#define RT_DIAG(i) (hi ? -3.0e38f : RT_CAND(i, i))
            c0[0] = RT_DIAG(0);
#pragma unroll
            for (int j = 1; j < 16; ++j) c0[j] = RT_CAND(0, j);
            c1[0] = RT_DIAG(1);
#pragma unroll
            for (int j = 2; j < 8; ++j) c1[j - 1] = RT_CAND(1, j);
            c1[7] = RT_DIAG(2); c1[8] = RT_CAND(2, 3); c1[9] = RT_CAND(2, 4); c1[10] = RT_DIAG(3);
#pragma unroll
            for (int k = 11; k < 16; ++k) c1[k] = -3.0e38f;
#undef RT_CAND
#undef RT_DIAG
        }
        sort_desc<16>(c0); sort_desc<16>(c1); merge_top16(c0, c1);
        pair_merge<false>(c0, hi != 0);
        float mx = c0[0];
#pragma unroll
        for (int i = 1; i < 16; ++i) mx = fmaxf(mx, c0[i]);
        float ex[16], sm = 0.f;
#pragma unroll
        for (int i = 0; i < 16; ++i) { ex[i] = __expf(__uint_as_float(__float_as_uint(c0[i]) & ~511u) - mx); sm += ex[i]; }
        const float inv = 1.0f / sm;
        asm volatile("s_waitcnt lgkmcnt(0)" ::: "memory");
        int eo[8]; float go[8];
#pragma unroll
        for (int k = 0; k < 8; ++k) { const float wv = hi ? c0[8 + k] : c0[k]; go[k] = (hi ? ex[8 + k] : ex[k]) * inv;
            const unsigned bits = __float_as_uint(wv), fromhi = (bits >> 8) & 1u, xi = (bits >> 4) & 15u, yj = bits & 15u;
            const unsigned ar = fromhi ? yj : xi, br = fromhi ? xi : yj;
            const unsigned e1 = scr[n32 * 32 + ar], e2 = scr[n32 * 32 + 16 + br];
            eo[k] = (int)(e1 * 128u + e2); }
        unsigned short* ip = IDX + (size_t)t * PSEL + h * PTOP + 8 * hi; float* gp = GATE + (size_t)t * PSEL + h * PTOP + 8 * hi;
        *(v4u*)ip = (v4u){(unsigned)eo[0] | ((unsigned)eo[1] << 16), (unsigned)eo[2] | ((unsigned)eo[3] << 16), (unsigned)eo[4] | ((unsigned)eo[5] << 16), (unsigned)eo[6] | ((unsigned)eo[7] << 16)};
        *(f32x4*)gp = (f32x4){go[0], go[1], go[2], go[3]}; *(f32x4*)(gp + 4) = (f32x4){go[4], go[5], go[6], go[7]};
        asm volatile("s_waitcnt lgkmcnt(0)" ::: "memory");
    }
#undef RT_QLOAD
#undef RT_HALF
    __syncthreads();
}

typedef float f32x2 __attribute__((ext_vector_type(2)));
typedef int v4i __attribute__((ext_vector_type(4)));
__device__ __forceinline__ void h2q_token(const Args& A, int t, int lane) {
    const float* modf = (const float*)(A.ws + WS_MODF); const float* ss2 = (const float*)(A.ws + WS_SS2); const float* g2 = A.in[12];
    const int b = t / SEQ; const float* xr = A.out + (size_t)t * D + 16 * lane;
    const f32x4* sp = (const f32x4*)(ss2 + (size_t)t * 16); const f32x4 s4 = (sp[0] + sp[1]) + (sp[2] + sp[3]);
    const float rs = 1.0f / sqrtf(((s4[0] + s4[1]) + (s4[2] + s4[3])) * (1.0f / D) + RMS_EPS);
    float h2[16]; float am = 0.f;
#pragma unroll
    for (int q = 0; q < 4; ++q) { const int c = 16 * lane + 4 * q; const f32x4 xv = *(const f32x4*)(xr + 4 * q), gg = *(const f32x4*)(g2 + c), sc = *(const f32x4*)(modf + (size_t)b * 6144 + 4096 + c), sh = *(const f32x4*)(modf + (size_t)b * 6144 + 3072 + c);
#pragma unroll
        for (int e = 0; e < 4; ++e) { const float h = xv[e] * rs * (gg[e] * (1.0f + sc[e])) + sh[e]; h2[4 * q + e] = h; am = fmaxf(am, fabsf(h)); } }
    am = fmaxf(am, __shfl_xor(am, 1)); am = fmaxf(am, __shfl_xor(am, 2)); am = fmaxf(am, __shfl_xor(am, 4));
    const float hs = (am > 0.f) ? am * (1.0f / 127.0f) : 1.0f, hinv = 1.0f / hs;
    v4u o;
#pragma unroll
    for (int q = 0; q < 4; ++q) { const int q0 = (int)rintf(h2[4 * q] * hinv), q1 = (int)rintf(h2[4 * q + 1] * hinv), q2 = (int)rintf(h2[4 * q + 2] * hinv), q3 = (int)rintf(h2[4 * q + 3] * hinv);
        o[q] = (unsigned)(q0 & 255) | ((unsigned)(q1 & 255) << 8) | ((unsigned)(q2 & 255) << 16) | ((unsigned)q3 << 24); }
    *(v4u*)(A.ws + WS_H2Q + (size_t)t * D + 16 * lane) = o;
    if ((lane & 7) == 0) ((float*)(A.ws + WS_HS))[(size_t)t * 8 + (lane >> 3)] = hs;
}

__device__ __forceinline__ float gelu_tanh(float x) { const float u = 0.7978845608028654f * (x + 0.044715f * x * x * x); return x / (1.0f + __expf(-2.0f * u)); }
__device__ __forceinline__ void peer_sliced_phase(Frame& F, const Args& A) {
    const int lane = F.lane, c8 = lane & 7, g8 = lane >> 3, gw = F.vcu * NWAVES + F.wave, NGW = F.G * NWAVES;
    const float* modf = (const float*)(A.ws + WS_MODF);
    const unsigned char* U8 = A.ws + WS_U; const unsigned char* V8 = A.ws + WS_V;
    const float* SU = (const float*)(A.ws + WS_U + 16 * MiB); const float* SV = (const float*)(A.ws + WS_V + 16 * MiB);
    const unsigned short* IDX = (const unsigned short*)(A.ws + WS_POOLED); const float* GATE = (const float*)(A.ws + WS_POOLED + 16 * MiB);
    const float* gf = A.in[17];
    LAS float* AL = (LAS float*)(F.lds + F.wave * 17664);
    LAS float* SSQ = AL + 2048;
    LAS float* SAV = AL + 3072;
    LAS float* RS2 = AL + 3088;
    LAS float* GS = AL + 3104;
    LAS unsigned short* IDL = (LAS unsigned short*)(AL + 3360);
    for (int tb = gw * 16; tb < T; tb += NGW * 16) {
        for (int i = lane; i < 2048; i += 64) AL[i] = 0.f;
        for (int i = lane; i < 1024; i += 64) SSQ[i] = 0.f;
#pragma unroll
        for (int i = 0; i < 16; ++i) *(LAS unsigned*)(IDL + i * 128 + 2 * lane) = *(const unsigned*)(IDX + (size_t)(tb + i) * PSEL + 2 * lane);
        if (lane < 16) { const f32x4* sp = (const f32x4*)((const float*)(A.ws + WS_SS2) + (size_t)(tb + lane) * 16); const f32x4 s4 = (sp[0] + sp[1]) + (sp[2] + sp[3]);
            RS2[lane] = 1.0f / sqrtf(((s4[0] + s4[1]) + (s4[2] + s4[3])) * (1.0f / D) + RMS_EPS); }
        LDS_WAIT();
        {
            v4i W0[16], W1[16]; f32x4 X0[4], X1[4]; v4i H; float hs;
            const int bU = tb / SEQ; const float* g2 = A.in[12];
#define PU_X(k, X) do { const int k_ = (k) < 128 ? (k) : 127; const int s_ = k_ >> 4, t_ = tb + (k_ & 15); _Pragma("unroll") for (int q = 0; q < 4; ++q) X[q] = *(const f32x4*)(A.out + (size_t)t_ * D + 128 * s_ + 16 * c8 + 4 * q); } while (0)
#define PU_B(k, W) do { const int k_ = (k) < 128 ? (k) : 127; const int s_ = k_ >> 4; const unsigned base_ = ((unsigned)s_ << 21) + 16u * (unsigned)c8; v4u I[2]; I[0] = *(const LAS v4u*)(IDL + (k_ & 15) * 128 + 16 * g8); I[1] = *(const LAS v4u*)(IDL + (k_ & 15) * 128 + 16 * g8 + 8); \
            _Pragma("unroll") for (int j = 0; j < 16; ++j) W[j] = *(const v4i*)(U8 + (base_ + (((I[j >> 3][(j >> 1) & 3] >> (16 * (j & 1))) & 0xffffu) << 7))); \
            } while (0)
#define PU_Q(k, X) do { const int s_ = (k) >> 4, i_ = (k) & 15; \
            if (i_ == 0) { LDS_WAIT(); if (g8 == 0) { _Pragma("unroll") for (int q = 0; q < 4; ++q) { const int cc = 128 * s_ + 16 * c8 + 4 * q; const f32x4 gg = *(const f32x4*)(g2 + cc), sc = *(const f32x4*)(modf + (size_t)bU * 6144 + 4096 + cc), sh = *(const f32x4*)(modf + (size_t)bU * 6144 + 3072 + cc); \
                *(LAS f32x4*)(GS + c8 * 16 + 4 * q) = gg * (sc + 1.0f); *(LAS f32x4*)(GS + 128 + c8 * 16 + 4 * q) = sh; } } LDS_WAIT(); } \
            const float rs_ = RS2[i_]; float h2[16]; float am = 0.f; \
            _Pragma("unroll") for (int q = 0; q < 4; ++q) { const f32x4 gq = *(const LAS f32x4*)(GS + c8 * 16 + 4 * q), sq = *(const LAS f32x4*)(GS + 128 + c8 * 16 + 4 * q); \
                _Pragma("unroll") for (int e = 0; e < 4; ++e) { const float h = X[q][e] * rs_ * gq[e] + sq[e]; h2[4 * q + e] = h; am = fmaxf(am, fabsf(h)); } } \
            am = fmaxf(am, __shfl_xor(am, 1)); am = fmaxf(am, __shfl_xor(am, 2)); am = fmaxf(am, __shfl_xor(am, 4)); \
            hs = (am > 0.f) ? am * (1.0f / 127.0f) : 1.0f; const float hinv = 1.0f / hs; \
            _Pragma("unroll") for (int q = 0; q < 4; ++q) { const int q0 = (int)rintf(h2[4 * q] * hinv), q1 = (int)rintf(h2[4 * q + 1] * hinv), q2 = (int)rintf(h2[4 * q + 2] * hinv), q3 = (int)rintf(h2[4 * q + 3] * hinv); \
                H[q] = (int)((unsigned)(q0 & 255) | ((unsigned)(q1 & 255) << 8) | ((unsigned)(q2 & 255) << 16) | ((unsigned)q3 << 24)); } } while (0)
#define PU_C(k, W) do { int part[16]; \
            _Pragma("unroll") for (int j = 0; j < 16; ++j) part[j] = __builtin_amdgcn_sdot4(W[j].x, H.x, __builtin_amdgcn_sdot4(W[j].y, H.y, __builtin_amdgcn_sdot4(W[j].z, H.z, __builtin_amdgcn_sdot4(W[j].w, H.w, 0, false), false), false), false); \
            _Pragma("unroll") for (int step = 4; step >= 1; step >>= 1) { const bool up = (lane & step) != 0; \
                _Pragma("unroll") for (int i = 0; i < 2 * step; ++i) { const int send = up ? part[i] : part[i + 2 * step], keep = up ? part[i + 2 * step] : part[i]; part[i] = keep + __shfl_xor(send, step); } } \
            LAS f32x2* ap_ = (LAS f32x2*)(AL + ((k) & 15) * 128 + 2 * lane); f32x2 a_ = *ap_; a_.x += hs * (float)part[0]; a_.y += hs * (float)part[1]; *ap_ = a_; } while (0)
            PU_X(0, X0); PU_X(1, X1); PU_B(0, W0);
#pragma unroll 1
            for (int k = 0; k < 128; k += 2) {
                PU_Q(k, X0); PU_B(k + 1, W1); PU_X(k + 2, X0);
                PU_C(k, W0);
                PU_Q(k + 1, X1); PU_B(k + 2, W0); PU_X(k + 3, X1);
                PU_C(k + 1, W1);
            }
#undef PU_X
#undef PU_B
#undef PU_Q
#undef PU_C
        }
        LDS_WAIT();
#pragma unroll 4
        for (int i = 0; i < 16; ++i) {
            const int t = tb + i; const unsigned e01 = *(const LAS unsigned*)(IDL + i * 128 + 2 * lane); const int e0 = (int)(e01 & 0xffffu), e1 = (int)(e01 >> 16);
            const f32x2 gt = *(const f32x2*)(GATE + (size_t)t * PSEL + 2 * lane); const f32x2 a = *(LAS f32x2*)(AL + i * 128 + 2 * lane);
            f32x2 av; av.x = gelu_tanh(a.x * SU[e0]) * gt.x * SV[e0]; av.y = gelu_tanh(a.y * SU[e1]) * gt.y * SV[e1];
            *(LAS f32x2*)(AL + i * 128 + 2 * lane) = av;
            const float sm = wave_sum(av.x + av.y); if (lane == 0) SAV[i] = 128.0f * sm;
        }
        LDS_WAIT();
        {
            v4u W0[16], W1[16]; f32x2 X0, X1, gt2v = (f32x2){0.f, 0.f};
            const int b = tb / SEQ;
#define PV_B(k, W, X) do { const int k_ = (k) < 128 ? (k) : 127; const int s_ = k_ >> 4, t_ = tb + (k_ & 15); const unsigned base_ = ((unsigned)s_ << 21) + 16u * (unsigned)c8; v4u I[2]; I[0] = *(const LAS v4u*)(IDL + (k_ & 15) * 128 + 16 * g8); I[1] = *(const LAS v4u*)(IDL + (k_ & 15) * 128 + 16 * g8 + 8); \
            _Pragma("unroll") for (int j = 0; j < 16; ++j) W[j] = *(const v4u*)(V8 + (base_ + (((I[j >> 3][(j >> 1) & 3] >> (16 * (j & 1))) & 0xffffu) << 7))); \
            X = *(const f32x2*)(A.out + (size_t)t_ * D + 128 * s_ + 16 * c8 + 2 * g8); } while (0)
#define PV_C(k, W, X) do { const int s_ = (k) >> 4, i_ = (k) & 15; \
            if (i_ == 0) gt2v = *(const f32x2*)(modf + (size_t)b * 6144 + 5120 + 128 * s_ + 16 * c8 + 2 * g8); \
            f32x2 acc[8]; _Pragma("unroll") for (int q = 0; q < 8; ++q) acc[q] = (f32x2){0.f, 0.f}; \
            const LAS f32x4* avp_ = (const LAS f32x4*)(AL + i_ * 128 + 16 * g8); \
            _Pragma("unroll") for (int q4 = 0; q4 < 4; ++q4) { const f32x4 a4 = avp_[q4]; \
                _Pragma("unroll") for (int e = 0; e < 4; ++e) { const float a = a4[e]; const v4u w = W[4 * q4 + e]; \
                    acc[0] += (f32x2){(float)(w.x & 255u), (float)((w.x >> 8) & 255u)} * a; acc[1] += (f32x2){(float)((w.x >> 16) & 255u), (float)(w.x >> 24)} * a; \
                    acc[2] += (f32x2){(float)(w.y & 255u), (float)((w.y >> 8) & 255u)} * a; acc[3] += (f32x2){(float)((w.y >> 16) & 255u), (float)(w.y >> 24)} * a; \
                    acc[4] += (f32x2){(float)(w.z & 255u), (float)((w.z >> 8) & 255u)} * a; acc[5] += (f32x2){(float)((w.z >> 16) & 255u), (float)(w.z >> 24)} * a; \
                    acc[6] += (f32x2){(float)(w.w & 255u), (float)((w.w >> 8) & 255u)} * a; acc[7] += (f32x2){(float)((w.w >> 16) & 255u), (float)(w.w >> 24)} * a; } } \
            float pc[16]; _Pragma("unroll") for (int q = 0; q < 8; ++q) { pc[2 * q] = acc[q].x; pc[2 * q + 1] = acc[q].y; } \
            _Pragma("unroll") for (int step = 4; step >= 1; step >>= 1) { const bool up = (g8 & step) != 0; \
                _Pragma("unroll") for (int i = 0; i < 2 * step; ++i) { const float send = up ? pc[i] : pc[i + 2 * step], keep = up ? pc[i + 2 * step] : pc[i]; pc[i] = keep + __shfl_xor(send, 8 * step); } } \
            const float sav_ = SAV[i_]; f32x2 x2_; x2_.x = X.x + gt2v.x * (pc[0] - sav_); x2_.y = X.y + gt2v.y * (pc[1] - sav_); \
            *(f32x2*)(A.out + (size_t)(tb + i_) * D + 128 * s_ + 16 * c8 + 2 * g8) = x2_; \
            SSQ[i_ * 64 + lane] += x2_.x * x2_.x + x2_.y * x2_.y; } while (0)
            PV_B(0, W0, X0);
#pragma unroll 1
            for (int k = 0; k < 128; k += 2) {
                PV_B(k + 1, W1, X1);
                PV_C(k, W0, X0);
                PV_B(k + 2, W0, X0);
                PV_C(k + 1, W1, X1);
            }
#undef PV_B
#undef PV_C
        }
        VM_WAIT(); LDS_WAIT();
#pragma unroll 2
        for (int i = 0; i < 16; ++i) {
            float* xr = A.out + (size_t)(tb + i) * D + 16 * lane;
            f32x4 v[4];
#pragma unroll
            for (int q = 0; q < 4; ++q) v[q] = __builtin_nontemporal_load((const f32x4*)(xr + 4 * q));
            const float rs = 1.0f / sqrtf(wave_sum(SSQ[i * 64 + lane]) * (1.0f / D) + RMS_EPS);
#pragma unroll
            for (int q = 0; q < 4; ++q) *(f32x4*)(xr + 4 * q) = v[q] * rs * *(const f32x4*)(gf + 16 * lane + 4 * q);
        }
        LDS_WAIT();
    }
}

#ifndef PHASE_ONLY
#define PHASE_ONLY -1
#endif
#ifndef PHASE_SKIP
#define PHASE_SKIP -2
#endif
#define PH(n) ((PHASE_ONLY < 0 || PHASE_ONLY == (n)) && PHASE_SKIP != (n))
#ifndef PROBE_DOUBLE
#define PROBE_DOUBLE -1
#endif
#define REPS(n) for (int rep_ = 0; rep_ < ((PROBE_DOUBLE == (n)) ? 2 : 1); ++rep_)
__global__ void __launch_bounds__(NTHREADS, 2) fwd_megakernel(Args A) {
    extern __shared__ __attribute__((aligned(16))) unsigned char lds[];
    Frame F;
    F.lds = (LAS unsigned char*)lds;
    F.MISC = (volatile LAS unsigned*)(F.lds + MISC_OFF);
    F.tid = threadIdx.x; F.lane = F.tid & 63; F.wave = __builtin_amdgcn_readfirstlane(F.tid >> 6);
    F.G = gridDim.x; { const int bx = blockIdx.x; F.vcu = (F.G % 8 == 0) ? (bx % 8) * (F.G / 8) + bx / 8 : bx; }
    F.ctl = (gu32*)(A.ws + WS_CTL);
    for (int u = F.tid; u < (LDS_BYTES - LDSCTL_OFF) / 4; u += NTHREADS) ((LAS unsigned*)(F.lds + LDSCTL_OFF))[u] = 0u;
    __syncthreads();
    XcdBarrier bar = xcd_barrier_post((unsigned*)(F.ctl + CW_BAR), F.MISC + 8);
#define GRID_BAR() do { xcd_barrier(bar); int t_ = threadIdx.x; asm volatile("" : "+v"(t_)); F.tid = t_; F.lane = t_ & 63; F.wave = __builtin_amdgcn_readfirstlane(t_ >> 6); } while (0)
    unsigned char* ws = A.ws;

    REPS(0) if (PH(0)) { p0a_mod(F, A); p0b_prologue<0>(F, A); }
    GRID_BAR();
    REPS(1) if (PH(1)) p0b_prologue<1>(F, A);
    GRID_BAR();
    REPS(2) if (PH(2)) {
        pg8::Gemm g{(const bf16*)(ws + WS_XG), nullptr, (const bf16*)(ws + WS_WIN), nullptr, D, D, D};
        pg8::StaticOrder S; S.init(T, INW, F.G, (int)blockIdx.x);
        pg8::EpiIn E{(bf16*)(ws + WS_QKVP), (bf16*)(ws + WS_GAB), (const float*)(ws + WS_RSTD1), (const float*)(ws + WS_BIAS1P), (float*)(ws + WS_KSUM)};
        pg8::gemm_phase<pg8::EpiIn, pg8::StaticOrder, true, true>(F.lds + RING_OFF, g, S, E);
    }
    GRID_BAR();
    REPS(3) if (PH(3)) {
        const attn_body::AttnTensors AT{(const attn_body::bf16*)(ws + WS_QKVP), (const attn_body::bf16*)(ws + WS_QKVP) + (size_t)T * 512, (const attn_body::bf16*)(ws + WS_QKVP) + (size_t)2 * T * 512, (PROBE_DOUBLE == 3 && rep_ == 0) ? (attn_body::bf16*)(ws + WS_XG) : (attn_body::bf16*)(ws + WS_QKVP)};
        const attn_body::StaticOrder S((int)F.G, F.vcu);
        attn_body::attn_phase<attn_body::StaticOrder>((char*)lds + RING_OFF, AT, (const float*)(ws + WS_KSUM), S);
    }
    REPS(4) if (PH(4)) pooled_phase(F, A);
    GRID_BAR();
    REPS(5) if (PH(5)) {
        pg8::Gemm g{(const bf16*)(ws + WS_QKVP), (const bf16*)(ws + WS_POOLED), (const bf16*)(ws + WS_WA), (const bf16*)(ws + WS_WP), AW, AW, AW};
        pg8::DualOrder S; S.init(T, D, F.G, (int)blockIdx.x);
        pg8::EpiUp E{(bf16*)(ws + WS_XG), (const bf16*)(ws + WS_GAB), (const float*)(ws + WS_BPRIME)};
        pg8::gemm_phase<pg8::EpiUp, pg8::DualOrder, true, true>(F.lds + RING_OFF, g, S, E);
    }
    GRID_BAR();
    REPS(6) if (PH(6)) {
        pg8::Gemm g{(const bf16*)(ws + WS_XG), nullptr, (const bf16*)(ws + WS_WOUT), nullptr, D, D, D};
        pg8::StaticOrder S; S.init(T, D, F.G, (int)blockIdx.x);
        pg8::EpiOut E{A.in[0], A.out, (bf16*)(ws + WS_QKVP), (const float*)(ws + WS_MODF), A.in[12], (float*)(ws + WS_SS2)};
        pg8::gemm_phase<pg8::EpiOut, pg8::StaticOrder, true, true>(F.lds + RING_OFF, g, S, E);
    }
    GRID_BAR();
    REPS(7) if (PH(7)) {
        pg8::Gemm g{(const bf16*)(ws + WS_QKVP), nullptr, (const bf16*)(ws + WS_WQ), nullptr, D, D, D};
        pg8::StaticOrder S; S.init(T, PQW, F.G, (int)blockIdx.x);
        pg8::EpiPq E{(bf16*)(ws + WS_GAB), (const float*)(ws + WS_SS2), (const float*)(ws + WS_BIAS2P)};
        pg8::gemm_phase<pg8::EpiPq, pg8::StaticOrder, true, true>(F.lds + RING_OFF, g, S, E);
    }
    GRID_BAR();
    REPS(8) if (PH(8)) router_phase(F, A);
    GRID_BAR();
    if (PH(9)) peer_sliced_phase(F, A);
}

extern "C" void kernel_launch(void* const* d_in, const int* in_sizes, int n_in, void* d_out, int out_size, void* d_ws, size_t ws_size, hipStream_t stream) {
    static int grid = 0;
    if (grid == 0) {
        if (n_in != 18 || in_sizes[0] != T * D || out_size != T * D || ws_size < WS_END) { fprintf(stderr, "kernel_launch: unexpected shapes (n_in %d, in0 %d, out %d, ws %zu); nothing launched\n", n_in, n_in > 0 ? in_sizes[0] : -1, out_size, ws_size); grid = -1; return; }
        int dev = 0, cus = 0, per_cu = 0;
        if (hipGetDevice(&dev) != hipSuccess || hipDeviceGetAttribute(&cus, hipDeviceAttributeMultiprocessorCount, dev) != hipSuccess) { grid = -1; return; }
        if (hipFuncSetAttribute((const void*)fwd_megakernel, hipFuncAttributeMaxDynamicSharedMemorySize, LDS_BYTES) != hipSuccess) { fprintf(stderr, "kernel_launch: hipFuncSetAttribute failed\n"); grid = -1; return; }
        if (hipOccupancyMaxActiveBlocksPerMultiprocessor(&per_cu, (const void*)fwd_megakernel, NTHREADS, LDS_BYTES) != hipSuccess || per_cu < 1) { fprintf(stderr, "kernel_launch: occupancy query reports %d workgroups per CU\n", per_cu); per_cu = 1; }
        (void)hipGetLastError();
        grid = cus;
    }
    if (grid < 0) return;
    if (hipMemsetAsync((char*)d_ws + WS_CTL, 0, CTL_ZERO_BYTES, stream) != hipSuccess) { fprintf(stderr, "kernel_launch: hipMemsetAsync failed\n"); return; }
    Args a{};
    for (int i = 0; i < 18; ++i) a.in[i] = (const float*)d_in[i];
    a.out = (float*)d_out; a.ws = (unsigned char*)d_ws;
    void* kargs[] = {&a};
    hipError_t e = hipLaunchCooperativeKernel((const void*)fwd_megakernel, dim3(grid), dim3(NTHREADS), kargs, LDS_BYTES, stream);
    if (e != hipSuccess) fprintf(stderr, "kernel_launch: cooperative launch failed: %s (grid %d)\n", hipGetErrorString(e), grid);
}
```

```cpp
#include <hip/hip_runtime.h>
#include <hip/hip_bf16.h>
#include <cstdio>
#include <cstdint>
#include <cmath>

constexpr int NB = 8, SEQ = 4096, T = NB * SEQ, D = 1024;
constexpr int AW = 512, PW = 512, INW = 4096;
constexpr int NH = 8, HD = 64, MBLK = 256, NBLK = SEQ / MBLK;
constexpr int PQW = 2048, PEXP = 16384, PTOP = 16, PHEADS = 8, PSEL = PHEADS * PTOP;
constexpr float RMS_EPS = 1e-6f;
constexpr float LOG2E = 1.4426950408889634f;
constexpr float QSCALE = 0.125f * LOG2E;
constexpr int NWAVES = 8, NTHREADS = 512;

namespace pg8 {
#define PG8_LAS __attribute__((address_space(3)))
typedef unsigned short bf16_t;
typedef short bf16x8 __attribute__((ext_vector_type(8)));
typedef float f32x4 __attribute__((ext_vector_type(4)));
typedef unsigned u32x4 __attribute__((ext_vector_type(4)));
constexpr int BM = 256, BK = 64, HALF = 128, HTB = HALF * BK * 2  , STAGE_BYTES = 8 * HTB, NXCD = 8, WGM = 8;

__host__ __device__ __forceinline__ int lds_byte(int r, int c) { const int st = (r >> 4) * 2 + (c >> 5), rr = r & 15, cc = c & 31, ob = rr * 64 + cc * 2; return st * 1024 + (ob ^ (((ob >> 9) & 1) << 5)); }
__host__ __device__ __forceinline__ void stage_rc(int b, int& R, int& C) { const int st = b / 1024, sb = b % 1024, swz = sb ^ (((sb >> 9) & 1) << 5); R = (st >> 1) * 16 + swz / 64; C = (st & 1) * 32 + (swz % 64) / 2; }
__host__ __device__ __forceinline__ int perm32(int rho) { const int n = rho >> 4, i = rho & 15; return 8 * (i >> 2) + 4 * n + (i & 3); }

struct Unit { int pm, pn, part; };
struct Gemm {
    const bf16_t* A0; const bf16_t* A1; const bf16_t* B0; const bf16_t* B1; int lda, ldb, K;
    __device__ __forceinline__ const char* a_ptr(const Unit& u) const { return (const char*)(u.part ? A1 : A0) + (size_t)u.pm * BM * lda * 2; }
    __device__ __forceinline__ const char* b_ptr(const Unit& u) const { return (const char*)(u.part ? B1 : B0) + (size_t)u.pn * BM * ldb * 2; }
};

struct StaticOrder {
    int nM, nN, nwg, G, c;
    __host__ __device__ void init(int M, int N, int G_, int c_) { nM = M / BM; nN = N / BM; nwg = nM * nN; G = G_; c = c_; }
    __host__ __device__ bool tile(long L, Unit& u) const {
        if (L >= nwg) return false;
        int wgid = (int)L; { const int q = nwg / NXCD, r = nwg % NXCD, xcd = wgid % NXCD, off = wgid / NXCD; wgid = (xcd < r ? xcd * (q + 1) : r * (q + 1) + (xcd - r) * q) + off; }
        const int nig = WGM * nN, gid = wgid / nig, fm = gid * WGM, gsz = (nM - fm) < WGM ? (nM - fm) : WGM;
        u.pm = fm + ((wgid % nig) % gsz); u.pn = (wgid % nig) / gsz; u.part = 0; return true;
    }
    __host__ __device__ bool next(int i, Unit& u) const { return tile((long)i * G + c, u); }
    __device__ __forceinline__ void a_ready(const Unit&) const {}
    __device__ __forceinline__ void done(const Unit&) const {}
};
struct DualOrder {
    StaticOrder so;
    __host__ __device__ void init(int M, int N, int G_, int c_) { so.init(M, N, G_, c_); }
    __host__ __device__ bool next(int i, Unit& u) const { if (!so.tile((long)(i >> 1) * so.G + so.c, u)) return false; u.part = i & 1; return true; }
    __device__ __forceinline__ void a_ready(const Unit&) const {}
    __device__ __forceinline__ void done(const Unit&) const {}
};

__device__ __forceinline__ unsigned cvt_pk_bf16(float lo, float hi) { unsigned r; asm volatile("v_cvt_pk_bf16_f32 %0, %1, %2" : "=v"(r) : "v"(lo), "v"(hi)); return r; }
__device__ __forceinline__ float bf_lo(unsigned w) { return __uint_as_float(w << 16); }
__device__ __forceinline__ float bf_hi(unsigned w) { return __uint_as_float(w & 0xffff0000u); }
__device__ __forceinline__ float sigmoidf_(float x) { return __builtin_amdgcn_rcpf(1.0f + __builtin_amdgcn_exp2f(-x * 1.4426950408889634f)); }


struct EpiIn {
    static constexpr bool PERM = true, AFTER_DRAIN = false;
    bf16_t* QKVP; bf16_t* GAB; const float* rstd1; const float* bias1p; float* ksum;
    __device__ __forceinline__ void operator()(const f32x4 (&acc)[2][2][4][2], const Unit& u, int wr, int wc, int fr, int fq) const {
        bf16_t* base; int ldc, col0;
        if (u.pn < 8) { base = QKVP + (size_t)(u.pn >> 1) * T * 512; ldc = 512; col0 = (u.pn & 1) * 256; }
        else { base = GAB + (size_t)((u.pn - 8) >> 2) * T * 1024; ldc = 1024; col0 = ((u.pn - 8) & 3) * 256; }
        const float sc = (u.pn < 2) ? QSCALE : 1.0f;
        const int b = u.pm >> 4;
        const int bcol = u.pn * 256 + wc * 32 + 8 * fq;
        f32x4 bv[2][2];
#pragma unroll
        for (int bj = 0; bj < 2; ++bj)
#pragma unroll
            for (int n = 0; n < 2; ++n) { f32x4 s = (f32x4){0.f, 0.f, 0.f, 0.f};
#pragma unroll
                for (int kc = 0; kc < 8; ++kc) s += *(const f32x4*)(bias1p + (size_t)(kc * 8 + b) * INW + bcol + bj * HALF + 4 * n);
                bv[bj][n] = s; }
        const bool isk = (u.pn == 2 || u.pn == 3);
        f32x4 ks[2][2];
#pragma unroll
        for (int bj = 0; bj < 2; ++bj)
#pragma unroll
            for (int n = 0; n < 2; ++n) ks[bj][n] = (f32x4){0.f, 0.f, 0.f, 0.f};
        const int row0 = u.pm * BM + wr * 64 + fr;
#pragma unroll
        for (int ai = 0; ai < 2; ++ai)
#pragma unroll
            for (int m = 0; m < 4; ++m) { const int row = row0 + ai * HALF + m * 16; const float rs = rstd1[row];
                bf16_t* rowp = base + (size_t)row * ldc + col0 + wc * 32 + 8 * fq;
#pragma unroll
                for (int bj = 0; bj < 2; ++bj) { f32x4 v0 = acc[ai][bj][m][0] * rs + bv[bj][0], v1 = acc[ai][bj][m][1] * rs + bv[bj][1];
                    ks[bj][0] += v0; ks[bj][1] += v1;
                    v0 = v0 * sc; v1 = v1 * sc; u32x4 w; w.x = cvt_pk_bf16(v0[0], v0[1]); w.y = cvt_pk_bf16(v0[2], v0[3]); w.z = cvt_pk_bf16(v1[0], v1[1]); w.w = cvt_pk_bf16(v1[2], v1[3]);
                    *(u32x4*)(rowp + bj * HALF) = w; } }
        if (isk) {
#pragma unroll
            for (int bj = 0; bj < 2; ++bj)
#pragma unroll
                for (int n = 0; n < 2; ++n)
#pragma unroll
                    for (int e = 0; e < 4; ++e) { float v = ks[bj][n][e]; v += __shfl_xor(v, 1); v += __shfl_xor(v, 2); v += __shfl_xor(v, 4); v += __shfl_xor(v, 8); ks[bj][n][e] = v; }
            if (fr == 0) { float* kp = ksum + (size_t)u.pm * 512 + (u.pn - 2) * 256 + wc * 32 + 8 * fq;
#pragma unroll
                for (int bj = 0; bj < 2; ++bj)
#pragma unroll
                    for (int n = 0; n < 2; ++n)
#pragma unroll
                        for (int e = 0; e < 4; ++e) atomicAdd(kp + bj * HALF + 4 * n + e, ks[bj][n][e]); }
        }
    }
};

struct EpiUp {
    static constexpr bool PERM = true, AFTER_DRAIN = false;
    bf16_t* merged; const bf16_t* GAB; const float* bprime;
    __device__ __forceinline__ void operator()(const f32x4 (&acc)[2][2][4][2], const Unit& u, int wr, int wc, int fr, int fq) const {
        const int row0 = u.pm * BM + wr * 64 + fr, colb = u.pn * BM + wc * 32 + 8 * fq;
        const bf16_t* gate = GAB + (size_t)u.part * T * 1024;
        f32x4 bv[2][2];
#pragma unroll
        for (int bj = 0; bj < 2; ++bj)
#pragma unroll
            for (int n = 0; n < 2; ++n) { f32x4 s_ = (f32x4){0.f, 0.f, 0.f, 0.f}; if (u.part) { _Pragma("unroll") for (int g_ = 0; g_ < 4; ++g_) s_ += *(const f32x4*)(bprime + g_ * 1024 + colb + bj * HALF + 4 * n); } bv[bj][n] = s_; }
#pragma unroll
        for (int ai = 0; ai < 2; ++ai) {
            u32x4 gpre[4][2], ppre[4][2];
#pragma unroll
            for (int m = 0; m < 4; ++m) { const size_t off = (size_t)(row0 + ai * HALF + m * 16) * 1024 + colb;
#pragma unroll
                for (int bj = 0; bj < 2; ++bj) { gpre[m][bj] = __builtin_nontemporal_load((const u32x4*)(gate + off + bj * HALF));
                    if (u.part) ppre[m][bj] = __builtin_nontemporal_load((const u32x4*)(merged + off + bj * HALF)); else ppre[m][bj] = (u32x4){0u, 0u, 0u, 0u}; } }
#pragma unroll
            for (int m = 0; m < 4; ++m) { const size_t off = (size_t)(row0 + ai * HALF + m * 16) * 1024 + colb;
#pragma unroll
                for (int bj = 0; bj < 2; ++bj) {
                    const u32x4 gw = gpre[m][bj], pw = ppre[m][bj];
                    f32x4 v0 = acc[ai][bj][m][0] + bv[bj][0], v1 = acc[ai][bj][m][1] + bv[bj][1];
                    v0[0] *= sigmoidf_(bf_lo(gw.x)); v0[1] *= sigmoidf_(bf_hi(gw.x)); v0[2] *= sigmoidf_(bf_lo(gw.y)); v0[3] *= sigmoidf_(bf_hi(gw.y));
                    v1[0] *= sigmoidf_(bf_lo(gw.z)); v1[1] *= sigmoidf_(bf_hi(gw.z)); v1[2] *= sigmoidf_(bf_lo(gw.w)); v1[3] *= sigmoidf_(bf_hi(gw.w));
                    v0[0] += bf_lo(pw.x); v0[1] += bf_hi(pw.x); v0[2] += bf_lo(pw.y); v0[3] += bf_hi(pw.y); v1[0] += bf_lo(pw.z); v1[1] += bf_hi(pw.z); v1[2] += bf_lo(pw.w); v1[3] += bf_hi(pw.w);
                    u32x4 w; w.x = cvt_pk_bf16(v0[0], v0[1]); w.y = cvt_pk_bf16(v0[2], v0[3]); w.z = cvt_pk_bf16(v1[0], v1[1]); w.w = cvt_pk_bf16(v1[2], v1[3]);
                    *(u32x4*)(merged + off + bj * HALF) = w; } }
        }
        if (u.part == 0) asm volatile("s_waitcnt vmcnt(0)" ::: "memory");
    }
};

struct EpiOut {
    static constexpr bool PERM = true, AFTER_DRAIN = false;
    const float* x; float* x1; bf16_t* A2; const float* modf; const float* g2; float* ss2;
    __device__ __forceinline__ void operator()(const f32x4 (&acc)[2][2][4][2], const Unit& u, int wr, int wc, int fr, int fq) const {
        const int row0 = u.pm * BM + wr * 64 + fr, colb = u.pn * BM + wc * 32 + 8 * fq, b = u.pm >> 4;
        f32x4 gt[2][2], gg[2][2];
#pragma unroll
        for (int bj = 0; bj < 2; ++bj)
#pragma unroll
            for (int n = 0; n < 2; ++n) { const int c = colb + bj * HALF + 4 * n; gt[bj][n] = *(const f32x4*)(modf + (size_t)b * 6144 + 2048 + c);
                const f32x4 sc2 = *(const f32x4*)(modf + (size_t)b * 6144 + 4096 + c); gg[bj][n] = *(const f32x4*)(g2 + c) * (sc2 + 1.0f); }
#pragma unroll
        for (int ai = 0; ai < 2; ++ai) {
#pragma unroll
          for (int mh = 0; mh < 2; ++mh) {
            f32x4 xr[2][2][2];
#pragma unroll
            for (int m2 = 0; m2 < 2; ++m2) { const size_t off = (size_t)(row0 + ai * HALF + (2 * mh + m2) * 16) * 1024 + colb;
#pragma unroll
                for (int bj = 0; bj < 2; ++bj) { xr[m2][bj][0] = __builtin_nontemporal_load((const f32x4*)(x + off + bj * HALF)); xr[m2][bj][1] = __builtin_nontemporal_load((const f32x4*)(x + off + bj * HALF + 4)); } }
#pragma unroll
            for (int m2 = 0; m2 < 2; ++m2) { const int m = 2 * mh + m2; const int row = row0 + ai * HALF + m * 16; const size_t off = (size_t)row * 1024 + colb; float ssq = 0.f;
#pragma unroll
                for (int bj = 0; bj < 2; ++bj) {
                    const f32x4 y0 = xr[m2][bj][0] + gt[bj][0] * acc[ai][bj][m][0], y1 = xr[m2][bj][1] + gt[bj][1] * acc[ai][bj][m][1];
                    *(f32x4*)(x1 + off + bj * HALF) = y0; *(f32x4*)(x1 + off + bj * HALF + 4) = y1;
                    ssq += (y0[0] * y0[0] + y0[1] * y0[1]) + (y0[2] * y0[2] + y0[3] * y0[3]) + (y1[0] * y1[0] + y1[1] * y1[1]) + (y1[2] * y1[2] + y1[3] * y1[3]);
                    const f32x4 a0 = y0 * gg[bj][0], a1 = y1 * gg[bj][1];
                    u32x4 w; w.x = cvt_pk_bf16(a0[0], a0[1]); w.y = cvt_pk_bf16(a0[2], a0[3]); w.z = cvt_pk_bf16(a1[0], a1[1]); w.w = cvt_pk_bf16(a1[2], a1[3]);
                    *(u32x4*)(A2 + off + bj * HALF) = w; }
                ssq += __shfl_xor(ssq, 16); ssq += __shfl_xor(ssq, 32);
                if (fq == 0) ss2[(size_t)row * 16 + u.pn * 4 + wc] = ssq; }
          }
        }
    }
};

struct EpiPq {
    static constexpr bool PERM = true, AFTER_DRAIN = false;
    bf16_t* QP; const float* ss2; const float* bias2p;
    __device__ __forceinline__ void operator()(const f32x4 (&acc)[2][2][4][2], const Unit& u, int wr, int wc, int fr, int fq) const {
        const int row0 = u.pm * BM + wr * 64 + fr, colb = u.pn * BM + wc * 32 + 8 * fq, b = u.pm >> 4;
        f32x4 bv[2][2];
#pragma unroll
        for (int bj = 0; bj < 2; ++bj)
#pragma unroll
            for (int n = 0; n < 2; ++n) { f32x4 s = (f32x4){0.f, 0.f, 0.f, 0.f};
#pragma unroll
                for (int kc = 0; kc < 8; ++kc) s += *(const f32x4*)(bias2p + (size_t)(kc * 8 + b) * PQW + colb + bj * HALF + 4 * n);
                bv[bj][n] = s; }
#pragma unroll
        for (int ai = 0; ai < 2; ++ai)
#pragma unroll
            for (int m = 0; m < 4; ++m) { const int row = row0 + ai * HALF + m * 16;
                const f32x4* sp = (const f32x4*)(ss2 + (size_t)row * 16); const f32x4 s4 = (sp[0] + sp[1]) + (sp[2] + sp[3]);
                const float rs = __builtin_amdgcn_rsqf(((s4[0] + s4[1]) + (s4[2] + s4[3])) * (1.0f / D) + RMS_EPS);
                bf16_t* rowp = QP + (size_t)row * PQW + colb;
#pragma unroll
                for (int bj = 0; bj < 2; ++bj) { const f32x4 v0 = acc[ai][bj][m][0] * rs + bv[bj][0], v1 = acc[ai][bj][m][1] * rs + bv[bj][1];
                    u32x4 w; w.x = cvt_pk_bf16(v0[0], v0[1]); w.y = cvt_pk_bf16(v0[2], v0[3]); w.z = cvt_pk_bf16(v1[0], v1[1]); w.w = cvt_pk_bf16(v1[2], v1[3]);
                    *(u32x4*)(rowp + bj * HALF) = w; } }
    }
};

template <class Epi, class Sched, bool ALIGN_EPI = false, bool SP2 = false>
__device__ __forceinline__ void gemm_phase(PG8_LAS unsigned char* lds, const Gemm g, const Sched& S, const Epi& E) {
    int tid_ = threadIdx.x; asm volatile("" : "+v"(tid_));
    const int tid = tid_, wid = __builtin_amdgcn_readfirstlane(tid >> 6), lane = tid & 63, wr = wid >> 2, wc = wid & 3, fr = lane & 15, fq = lane >> 4;
    const int K = g.K, nt = K / BK, lda = g.lda, ldb = g.ldb;
    unsigned voffA[2], voffB[2];
#pragma unroll
    for (int i = 0; i < 2; ++i) { int R, C; stage_rc(tid * 16 + i * 8192, R, C); const int Rb = Epi::PERM ? ((R & ~31) + perm32(R & 31)) : R;
        voffA[i] = (unsigned)(R * lda + C) * 2u; voffB[i] = (unsigned)(Rb * ldb + C) * 2u; }
    const size_t kstep = (size_t)(BK * 2);
    const size_t hstepA = (size_t)HALF * lda * 2, hstepB = (size_t)HALF * ldb * 2;
    const unsigned ldsw = (unsigned)wid * 1024u;
    const int aoff = lds_byte(wr * 64 + fr, fq * 8), boff = lds_byte(wc * 32 + fr, fq * 8);
#define PG8_SA(b, h) (((b) * 2 + (h)) * HTB)
#define PG8_SB(b, h) ((4 + (b) * 2 + (h)) * HTB)
#define PG8_STAGE(bufoff, gbase, voff) do { _Pragma("unroll") for (int _i = 0; _i < 2; ++_i) \
        __builtin_amdgcn_global_load_lds((const unsigned*)((const char*)(gbase) + (voff)[_i]), (PG8_LAS unsigned*)(lds + (bufoff) + ldsw + _i * 8192), 16, 0, 0); } while (0)
#define PG8_LDA(dst, b, h) do { _Pragma("unroll") for (int m = 0; m < 4; ++m) _Pragma("unroll") for (int k = 0; k < 2; ++k) dst[m][k] = *(const PG8_LAS bf16x8*)(lds + PG8_SA(b, h) + aoff + m * 2048 + k * 1024); } while (0)
#define PG8_LDB(dst, b, h) do { _Pragma("unroll") for (int n = 0; n < 2; ++n) _Pragma("unroll") for (int k = 0; k < 2; ++k) dst[n][k] = *(const PG8_LAS bf16x8*)(lds + PG8_SB(b, h) + boff + n * 2048 + k * 1024); } while (0)
#define PG8_MMA(ai, bj, At, Bt) do { __builtin_amdgcn_s_setprio(1); _Pragma("unroll") for (int m = 0; m < 4; ++m) _Pragma("unroll") for (int n = 0; n < 2; ++n) _Pragma("unroll") for (int k = 0; k < 2; ++k) \
        acc[ai][bj][m][n] = __builtin_amdgcn_mfma_f32_16x16x32_bf16(Bt[n][k], At[m][k], acc[ai][bj][m][n], 0, 0, 0); __builtin_amdgcn_s_setprio(0); } while (0)
#define PG8_WAIT_V(n) asm volatile("s_waitcnt vmcnt(" #n ")" ::: "memory")
#define PG8_WAIT_L(n) asm volatile("s_waitcnt lgkmcnt(" #n ")" ::: "memory")
#define PG8_BAR __builtin_amdgcn_s_barrier()
#define PG8_SCHED __builtin_amdgcn_sched_barrier(0)
    Unit cur, nxt; int ui = 0;
    if (!S.next(0, cur)) return;
    f32x4 acc[2][2][4][2];
#pragma unroll
    for (int a = 0; a < 2; ++a)
#pragma unroll
        for (int b = 0; b < 2; ++b)
#pragma unroll
            for (int m = 0; m < 4; ++m)
#pragma unroll
                for (int n = 0; n < 2; ++n) acc[a][b][m][n] = (f32x4){0.f, 0.f, 0.f, 0.f};
    bf16x8 At[4][2], B0[2][2], B1[2][2];
    const char* cA = g.a_ptr(cur); const char* cB = g.b_ptr(cur);
    S.a_ready(cur);
    if constexpr (SP2) {
        PG8_STAGE(PG8_SB(0, 0), cB, voffB); PG8_STAGE(PG8_SB(0, 1), cB + hstepB, voffB); PG8_STAGE(PG8_SA(0, 0), cA, voffA); PG8_STAGE(PG8_SA(0, 1), cA + hstepA, voffA);
        if (wr == 1) PG8_BAR;
        PG8_WAIT_V(2); PG8_BAR;
        PG8_STAGE(PG8_SB(1, 0), cB + kstep, voffB); PG8_STAGE(PG8_SA(1, 0), cA + kstep, voffA); PG8_STAGE(PG8_SB(1, 1), cB + hstepB + kstep, voffB);
        PG8_WAIT_V(6); PG8_BAR;
    } else {
        PG8_STAGE(PG8_SB(0, 0), cB, voffB); PG8_STAGE(PG8_SA(0, 0), cA, voffA); PG8_STAGE(PG8_SB(0, 1), cB + hstepB, voffB); PG8_STAGE(PG8_SA(0, 1), cA + hstepA, voffA);
        if (wr == 1) PG8_BAR;
        PG8_WAIT_V(4); PG8_BAR;
        PG8_STAGE(PG8_SB(1, 0), cB + kstep, voffB); PG8_STAGE(PG8_SA(1, 0), cA + kstep, voffA); PG8_STAGE(PG8_SB(1, 1), cB + hstepB + kstep, voffB);
        PG8_WAIT_V(6); PG8_BAR;
    }
    for (;;) {
        const bool has_next = S.next(ui + 1, nxt);
        const char* nA = has_next ? g.a_ptr(nxt) : cA; const char* nB = has_next ? g.b_ptr(nxt) : cB;
        for (int t = 0; t < nt; t += 2) {
            const bool last = (t == nt - 2);
            const char* a1 = cA + (size_t)(t + 1) * kstep;
            const char* a2 = last ? nA : cA + (size_t)(t + 2) * kstep; const char* b2 = last ? nB : cB + (size_t)(t + 2) * kstep;
            const char* a3 = a2 + kstep; const char* b3 = b2 + kstep;
            if (last && has_next) S.a_ready(nxt);
            if constexpr (SP2) {
            PG8_LDB(B0, 0, 0); PG8_LDB(B1, 0, 1); PG8_SCHED; PG8_LDA(At, 0, 0); PG8_STAGE(PG8_SA(1, 1), a1 + hstepA, voffA);
            PG8_WAIT_V(8); PG8_WAIT_L(0); PG8_BAR; PG8_MMA(0, 0, At, B0); PG8_MMA(0, 1, At, B1); PG8_BAR; PG8_SCHED;
            PG8_LDA(At, 0, 1); PG8_STAGE(PG8_SB(0, 0), b2, voffB); PG8_STAGE(PG8_SB(0, 1), b2 + hstepB, voffB); PG8_STAGE(PG8_SA(0, 0), a2, voffA);
            PG8_WAIT_V(8); PG8_WAIT_L(0); PG8_BAR; PG8_MMA(1, 0, At, B0); PG8_MMA(1, 1, At, B1); PG8_BAR; PG8_SCHED;
            PG8_LDB(B0, 1, 0); PG8_LDB(B1, 1, 1); PG8_SCHED; PG8_LDA(At, 1, 0); PG8_STAGE(PG8_SA(0, 1), a2 + hstepA, voffA);
            PG8_WAIT_V(8); PG8_WAIT_L(0); PG8_BAR; PG8_MMA(0, 0, At, B0); PG8_MMA(0, 1, At, B1); PG8_BAR; PG8_SCHED;
            PG8_LDA(At, 1, 1); PG8_STAGE(PG8_SB(1, 0), b3, voffB); PG8_STAGE(PG8_SB(1, 1), b3 + hstepB, voffB); PG8_STAGE(PG8_SA(1, 0), a3, voffA);
            PG8_WAIT_V(8); PG8_WAIT_L(0); PG8_BAR; PG8_MMA(1, 0, At, B0); PG8_MMA(1, 1, At, B1); PG8_BAR; PG8_SCHED;
            } else {
            PG8_LDB(B0, 0, 0); PG8_SCHED; PG8_LDA(At, 0, 0); PG8_STAGE(PG8_SA(1, 1), a1 + hstepA, voffA);
            PG8_WAIT_L(8); PG8_BAR; PG8_WAIT_L(0); PG8_MMA(0, 0, At, B0); PG8_BAR; PG8_SCHED;
            PG8_LDB(B1, 0, 1); PG8_STAGE(PG8_SB(0, 0), b2, voffB);
            PG8_BAR; PG8_WAIT_L(0); PG8_MMA(0, 1, At, B1); PG8_BAR;
            PG8_LDA(At, 0, 1); PG8_STAGE(PG8_SA(0, 0), a2, voffA);
            PG8_BAR; PG8_WAIT_L(0); PG8_MMA(1, 0, At, B0); PG8_BAR; PG8_SCHED;
            PG8_STAGE(PG8_SB(0, 1), b2 + hstepB, voffB);
            PG8_WAIT_V(6); PG8_BAR; PG8_MMA(1, 1, At, B1); PG8_BAR;
            PG8_LDB(B0, 1, 0); PG8_SCHED; PG8_LDA(At, 1, 0); PG8_STAGE(PG8_SA(0, 1), a2 + hstepA, voffA);
            PG8_WAIT_L(8); PG8_BAR; PG8_WAIT_L(0); PG8_MMA(0, 0, At, B0); PG8_BAR; PG8_SCHED;
            PG8_LDB(B1, 1, 1); PG8_STAGE(PG8_SB(1, 0), b3, voffB);
            PG8_BAR; PG8_WAIT_L(0); PG8_MMA(0, 1, At, B1); PG8_BAR;
            PG8_LDA(At, 1, 1); PG8_STAGE(PG8_SA(1, 0), a3, voffA);
            PG8_BAR; PG8_WAIT_L(0); PG8_MMA(1, 0, At, B0); PG8_BAR; PG8_SCHED;
            PG8_STAGE(PG8_SB(1, 1), b3 + hstepB, voffB);
            PG8_WAIT_V(6); PG8_BAR; PG8_MMA(1, 1, At, B1); PG8_BAR;
            }
        }
        if constexpr (ALIGN_EPI) { if (wr == 0) PG8_BAR; }
        if constexpr (!Epi::AFTER_DRAIN) { E(acc, cur, wr, wc, fr, fq); S.done(cur); }
        if (!has_next) break;
#pragma unroll
        for (int a = 0; a < 2; ++a)
#pragma unroll
            for (int b = 0; b < 2; ++b)
#pragma unroll
                for (int m = 0; m < 4; ++m)
#pragma unroll
                    for (int n = 0; n < 2; ++n) acc[a][b][m][n] = (f32x4){0.f, 0.f, 0.f, 0.f};
        cur = nxt; cA = nA; cB = nB; ++ui;
        if constexpr (ALIGN_EPI) { if (wr == 1) PG8_BAR; }
    }
    PG8_WAIT_V(0);
    if constexpr (!ALIGN_EPI) { if (wr == 0) PG8_BAR; }
    PG8_BAR;
    if constexpr (Epi::AFTER_DRAIN) { E.fused(acc, cur, wr, wc, fr, fq, lds, wid, lane); S.done(cur); }
#undef PG8_SA
#undef PG8_SB
#undef PG8_STAGE
#undef PG8_LDA
#undef PG8_LDB
#undef PG8_MMA
#undef PG8_WAIT_V
#undef PG8_WAIT_L
#undef PG8_BAR
#undef PG8_SCHED
}
}

constexpr size_t MiB = 1u << 20;
constexpr size_t WS_CTL = 0, CTL_ZERO_BYTES = 32 * 1024;
constexpr size_t WS_KSUM = 256 * 1024;
constexpr size_t WS_MODP = 1 * MiB;
constexpr size_t WS_MODF = WS_MODP + 8 * 8 * 6144 * 4;
constexpr size_t WS_BIAS1P = 3 * MiB;
constexpr size_t WS_BIAS2P = 4 * MiB;
constexpr size_t WS_BPRIME = 4 * MiB + 512 * 1024;
constexpr size_t WS_RSTD1 = 5 * MiB;
constexpr size_t WS_SS2 = 6 * MiB;
constexpr size_t WS_SUBK = 8 * MiB;
constexpr size_t WS_WIN = 16 * MiB, WS_WA = 24 * MiB, WS_WP = 25 * MiB, WS_WOUT = 26 * MiB, WS_WQ = 28 * MiB;
constexpr size_t WS_U = 32 * MiB, WS_V = 64 * MiB;
constexpr size_t WS_XG = 96 * MiB;
constexpr size_t WS_H2Q = WS_XG, WS_HS = WS_XG + 32 * MiB;
constexpr size_t WS_QKVP = 160 * MiB;
constexpr size_t WS_GAB = 288 * MiB;
constexpr size_t WS_POOLED = 416 * MiB;
constexpr size_t WS_END = 448 * MiB;
constexpr int CW_TMO = 0, CW_BAR = 4096;

constexpr int RING_OFF = 0, RING_BYTES = 131072;
constexpr int LDS_BYTES = 147456;
constexpr int LDSCTL_OFF = LDS_BYTES - 512, MISC_OFF = LDSCTL_OFF + 320;

#define GAS __attribute__((address_space(1)))
#define LAS __attribute__((address_space(3)))
typedef unsigned short bf16;
typedef unsigned v4u __attribute__((ext_vector_type(4)));
typedef unsigned v2u __attribute__((ext_vector_type(2)));
typedef float f32x4 __attribute__((ext_vector_type(4)));
typedef GAS unsigned gu32;
#define RLX_AGENT __ATOMIC_RELAXED, __HIP_MEMORY_SCOPE_AGENT
#define LDS_WAIT() asm volatile("s_waitcnt lgkmcnt(0)" ::: "memory")
#define VM_WAIT() asm volatile("s_waitcnt vmcnt(0)" ::: "memory")
__device__ __forceinline__ unsigned f2bf(float f) { unsigned u = __builtin_bit_cast(unsigned, f); return (u + 0x7fffu + ((u >> 16) & 1u)) >> 16; }
__device__ __forceinline__ unsigned pk2(float lo, float hi) { return f2bf(lo) | (f2bf(hi) << 16); }
__device__ __forceinline__ float bflo(unsigned w) { return __uint_as_float(w << 16); }
__device__ __forceinline__ float bfhi(unsigned w) { return __uint_as_float(w & 0xffff0000u); }
__device__ __forceinline__ float wave_sum(float v) {
#pragma unroll
    for (int o = 1; o < 64; o <<= 1) v += __shfl_xor(v, o);
    return v;
}
__device__ __forceinline__ float wave_max(float v) {
#pragma unroll
    for (int o = 1; o < 64; o <<= 1) v = fmaxf(v, __shfl_xor(v, o));
    return v;
}

#define XB_TMO      128
#define XB_XCNT(j)  (256  + 64 * (j))
#define XB_XSUB(j)  (1280 + 64 * (j))
#define XB_XGEN(j)  (2304 + 64 * (j))
#define XB_TOP      3328
#define XB_TOPGEN   3392
#define XCD_BAR_WORDS 3456
#define XB_SPIN_CAP (1u << 22)

__device__ __forceinline__ unsigned xb_ld(unsigned* p)              { return __hip_atomic_load(p, __ATOMIC_RELAXED, __HIP_MEMORY_SCOPE_AGENT); }
__device__ __forceinline__ unsigned xb_add(unsigned* p, unsigned v) { return __hip_atomic_fetch_add(p, v, __ATOMIC_RELAXED, __HIP_MEMORY_SCOPE_AGENT); }
__device__ __forceinline__ unsigned xb_xcc_id() { return (unsigned)__builtin_amdgcn_s_getreg((3 << 11) | 20) & 0xFu; }
#define XB_SPIN(cond, bar) do { unsigned _sp = 0; while (cond) { __builtin_amdgcn_s_sleep(1); \
    if ((++_sp & 255u) == 0u) { if (xb_ld(&(bar)[XB_TMO])) break; if (_sp > XB_SPIN_CAP) { atomicAdd(&(bar)[XB_TMO], 1u); break; } } } } while (0)

struct XcdBarrier { unsigned* bar; unsigned x; volatile LAS unsigned* st; };

__device__ __forceinline__ XcdBarrier xcd_barrier_post(unsigned* bar, volatile LAS unsigned* st) {
    XcdBarrier b; b.bar = bar; b.x = xb_xcc_id(); b.st = st;
    if (threadIdx.x == 0) (void)xb_add(&bar[XB_XCNT(b.x)], 1u);
    return b;
}
__device__ __forceinline__ void xcd_barrier_complete(unsigned* bar, unsigned x, unsigned& nloc, unsigned& nx) {
    const unsigned G = gridDim.x * gridDim.y * gridDim.z;
    unsigned sum, cnt, mine, sp = 0u;
    for (;;) {
        sum = 0u; cnt = 0u; mine = 0u;
#pragma unroll
        for (unsigned j = 0; j < 16; ++j) { const unsigned c = xb_ld(&bar[XB_XCNT(j)]); sum += c; cnt += (c > 0u) ? 1u : 0u; mine = (j == x) ? c : mine; }
        if (sum == G) break;
        __builtin_amdgcn_s_sleep(1);
        if ((++sp & 255u) == 0u) { if (xb_ld(&bar[XB_TMO])) break; if (sp > XB_SPIN_CAP) { atomicAdd(&bar[XB_TMO], 1u); break; } }
    }
    nloc = mine > 0u ? mine : 1u; nx = cnt > 0u ? cnt : 1u;
}
__device__ __forceinline__ void xcd_barrier(const XcdBarrier& b) {
    asm volatile("s_waitcnt vmcnt(0)" ::: "memory");
    __syncthreads();
    if (threadIdx.x == 0) {
        unsigned* bar = b.bar;
        __builtin_amdgcn_s_waitcnt(0);
        unsigned nloc = b.st[0], nx = b.st[1];
        if (nloc == 0u) { xcd_barrier_complete(bar, b.x, nloc, nx); b.st[0] = nloc; b.st[1] = nx; }
        const unsigned old = xb_add(&bar[XB_XSUB(b.x)], 1u);
        const unsigned gen = old / nloc;
        if (old + 1u == (gen + 1u) * nloc) {
            __builtin_amdgcn_fence(__ATOMIC_RELEASE, "agent");
            asm volatile("s_waitcnt vmcnt(0)" ::: "memory");
            const unsigned og = xb_add(&bar[XB_TOP], 1u);
            const unsigned tg = og / nx;
            if (og + 1u == (tg + 1u) * nx) xb_add(&bar[XB_TOPGEN], 1u);
            else XB_SPIN(xb_ld(&bar[XB_TOPGEN]) == tg, bar);
            __builtin_amdgcn_fence(__ATOMIC_ACQUIRE, "agent");
            xb_add(&bar[XB_XGEN(b.x)], 1u);
            asm volatile("s_waitcnt vmcnt(0)" ::: "memory");
        } else {
            XB_SPIN(xb_ld(&bar[XB_XGEN(b.x)]) == gen, bar);
            __builtin_amdgcn_fence(__ATOMIC_ACQUIRE, "agent");
            asm volatile("s_waitcnt vmcnt(0)" ::: "memory");
        }
    }
    __syncthreads();
}

struct Frame {
    LAS unsigned char* lds;
    volatile LAS unsigned* MISC;
    gu32* ctl;
    int tid, lane, wave;
    int vcu, G;
};
struct Args { const float* in[18]; float* out; unsigned char* ws; };

__device__ __forceinline__ float modp_sum(const float* modp, int idx) {
    float s = 0.f;
#pragma unroll
    for (int kc = 0; kc < 8; ++kc) s += modp[(size_t)kc * 8 * 6144 + idx];
    return s;
}
template <int MODE>
__device__ __forceinline__ void p0_wg_dot(Frame& F, const float* cin, const float* modp, int soff, const float* W, int N, const float* addv, float* outp, int first, int ntask) {
    LAS float* scr = (LAS float*)(F.lds + RING_OFF + F.wave * 16384);
    const int ncn = N / 64;
    for (int it = first; it < ntask; it += F.G) {
        const int kc = it / ncn, nc = it % ncn, k0 = kc * 128 + F.wave * 16, n = nc * 64 + F.lane;
        float w[16];
#pragma unroll
        for (int kk = 0; kk < 16; ++kk) w[kk] = (MODE == 0) ? __builtin_nontemporal_load(W + (size_t)(k0 + kk) * N + n) : W[(size_t)(k0 + kk) * N + n];
#pragma unroll
        for (int j = 0; j < 2; ++j) { const int idx = F.lane + 64 * j, b = idx >> 4, kk = idx & 15;
            float cf; if (MODE == 0) { const float cv = cin[b * 1024 + k0 + kk]; cf = cv / (1.0f + __expf(-cv)); } else cf = modp_sum(modp, b * 6144 + soff + k0 + kk);
            scr[idx] = cf; }
        LDS_WAIT(); asm volatile("" ::: "memory");
#pragma unroll
        for (int b = 0; b < 8; ++b) { float s = 0.f;
#pragma unroll
            for (int kk = 0; kk < 16; ++kk) s += scr[b * 16 + kk] * w[kk];
            scr[256 + b * 64 + F.lane] = s; }
        __syncthreads();
        { const int b = F.wave; float s = (addv != nullptr && kc == 0) ? addv[n] : 0.f;
#pragma unroll
          for (int w8 = 0; w8 < 8; ++w8) s += ((LAS float*)(F.lds + RING_OFF + w8 * 16384))[256 + b * 64 + F.lane];
          outp[(size_t)(kc * 8 + b) * N + n] = s; }
        __syncthreads();
    }
}
__device__ __forceinline__ void p0a_mod(Frame& F, const Args& A) { p0_wg_dot<0>(F, A.in[1], nullptr, 0, A.in[2], 6144, A.in[3], (float*)(A.ws + WS_MODP), F.vcu, 8 * 96); }
__device__ __forceinline__ void p0_wp_task(Frame& F, const Args& A, int r) {
    LAS float* scr = (LAS float*)(F.lds + RING_OFF + F.wave * 16384);
    const int g = r >> 6, kq = (r >> 4) & 3, nc = r & 15, n = nc * 64 + F.lane, d0 = 16 * F.wave;
    const float* wmix = A.in[7] + (size_t)(g * 128 + 32 * kq) * 128 + d0; const float* scale = A.in[9] + g * 128 + d0; const float* wup = A.in[10] + (size_t)(g * 128 + d0) * D + n; const float* bmix = A.in[8] + g * 128 + d0;
    float wu[16];
#pragma unroll
    for (int d = 0; d < 16; ++d) wu[d] = wup[(size_t)d * D];
    float bp = 0.f;
#pragma unroll
    for (int d = 0; d < 16; ++d) { wu[d] *= scale[d]; bp += bmix[d] * wu[d]; }
#pragma unroll
    for (int kk = 0; kk < 32; ++kk) { float s = 0.f;
#pragma unroll
        for (int d = 0; d < 16; ++d) s += wmix[kk * 128 + d] * wu[d];
        scr[kk * 64 + F.lane] = s; }
    scr[2048 + F.lane] = bp;
    __syncthreads();
    { float s[4]; float bs = 0.f;
#pragma unroll
      for (int e = 0; e < 4; ++e) s[e] = 0.f;
#pragma unroll
      for (int w8 = 0; w8 < 8; ++w8) { const LAS float* o = (const LAS float*)(F.lds + RING_OFF + w8 * 16384);
#pragma unroll
          for (int e = 0; e < 4; ++e) s[e] += o[(4 * F.wave + e) * 64 + F.lane];
          bs += o[2048 + F.lane]; }
      v2u w; w.x = pk2(s[0], s[1]); w.y = pk2(s[2], s[3]);
      *(GAS v2u*)((bf16*)(A.ws + WS_WP) + (size_t)n * PW + g * 128 + 32 * kq + 4 * F.wave) = w;
      if (kq == 0 && F.wave == 0) ((float*)(A.ws + WS_BPRIME))[g * 1024 + n] = bs; }
    __syncthreads();
}

__device__ __forceinline__ void p0_transpose_item(const float* W, int K, int N, bf16* WT, int row_off, LAS float* scr, int item, int lane) {
    const int nblk = N / 32, kb = item / nblk, nb = item % nblk, k0 = 64 * kb, n0 = 32 * nb;
#pragma unroll 8
    for (int i = 0; i < 32; ++i) { const int kk = 2 * i + (lane >> 5); scr[kk * 33 + (lane & 31)] = __builtin_nontemporal_load(W + (size_t)(k0 + kk) * N + n0 + (lane & 31)); }
    LDS_WAIT(); asm volatile("" ::: "memory");
    const int c = lane & 7;
#pragma unroll
    for (int j = 0; j < 4; ++j) { const int n = (lane >> 3) + 8 * j; const LAS float* s = scr + (8 * c) * 33 + n;
        v4u o; o.x = pk2(s[0 * 33], s[1 * 33]); o.y = pk2(s[2 * 33], s[3 * 33]); o.z = pk2(s[4 * 33], s[5 * 33]); o.w = pk2(s[6 * 33], s[7 * 33]);
        *(GAS v4u*)(WT + (size_t)(row_off + n0 + n) * K + k0 + 8 * c) = o; }
    LDS_WAIT(); asm volatile("" ::: "memory");
}
__device__ __forceinline__ void p0_table_rows4(const float* const (&src)[4], unsigned char* const (&dst)[4], float* const (&scale_out)[4], int off, int lane) {
    f32x4 v[4][4]; float am[4];
#pragma unroll
    for (int u = 0; u < 4; ++u)
#pragma unroll
        for (int q = 0; q < 4; ++q) v[u][q] = __builtin_nontemporal_load((const f32x4*)(src[u] + 16 * lane + 4 * q));
#pragma unroll
    for (int u = 0; u < 4; ++u) { float a = 0.f;
#pragma unroll
        for (int q = 0; q < 4; ++q) a = fmaxf(fmaxf(a, fmaxf(fabsf(v[u][q][0]), fabsf(v[u][q][1]))), fmaxf(fabsf(v[u][q][2]), fabsf(v[u][q][3])));
        am[u] = a; }
#pragma unroll
    for (int o = 1; o < 64; o <<= 1) {
#pragma unroll
        for (int u = 0; u < 4; ++u) am[u] = fmaxf(am[u], __shfl_xor(am[u], o)); }
#pragma unroll
    for (int u = 0; u < 4; ++u) { const float sc = (am[u] > 0.f) ? am[u] * (1.0f / 127.0f) : 1.0f, inv = 1.0f / sc;
        v4u o;
#pragma unroll
        for (int q = 0; q < 4; ++q) { const int q0 = (int)rintf(v[u][q][0] * inv) + off, q1 = (int)rintf(v[u][q][1] * inv) + off, q2 = (int)rintf(v[u][q][2] * inv) + off, q3 = (int)rintf(v[u][q][3] * inv) + off;
            o[q] = (unsigned)(q0 & 255) | ((unsigned)(q1 & 255) << 8) | ((unsigned)(q2 & 255) << 16) | ((unsigned)q3 << 24); }
        *(GAS v4u*)(dst[u] + ((size_t)(lane >> 3) << 21) + 16 * (lane & 7)) = o;
        if (lane == 0) *scale_out[u] = sc; }
}
template <int STAGE>
__device__ __forceinline__ void p0b_prologue(Frame& F, const Args& A) {
    const int gw = F.vcu * NWAVES + F.wave, NGW = F.G * NWAVES, lane = F.lane;
    const float* modp = (const float*)(A.ws + WS_MODP);
    LAS float* G1 = (LAS float*)(F.lds + 135168);
    if (STAGE == 0) { float* ks = (float*)(A.ws + WS_KSUM); for (int i = F.vcu * NTHREADS + F.tid; i < NB * NBLK * 512; i += F.G * NTHREADS) ks[i] = 0.f; }
    if (STAGE == 0) { for (int r = F.vcu; r < 256; r += F.G) p0_wp_task(F, A, r); }
    else { p0_wg_dot<1>(F, nullptr, modp, 0, A.in[5], INW, nullptr, (float*)(A.ws + WS_BIAS1P), F.vcu, 8 * (INW / 64));
           p0_wg_dot<1>(F, nullptr, modp, 3072, A.in[13], PQW, nullptr, (float*)(A.ws + WS_BIAS2P), F.vcu, 8 * (PQW / 64)); }
    LAS float* scr = (LAS float*)(F.lds + RING_OFF + F.wave * 16384);
    constexpr int I_MODF = 768, I_WIN = (D / 64) * (INW / 32), I_WA = (AW / 64) * (D / 32), I_WOUT = (D / 64) * (D / 32), I_WQ = (D / 64) * (PQW / 32);
    constexpr int I_SUBK = 64;
    constexpr int NITEMS = I_MODF + I_WIN + I_WA + I_WOUT + I_WQ + I_SUBK;
    for (int it = gw; it < NITEMS; it += NGW) {
        int r = it;
        if (r < I_MODF) { if (STAGE != 1) continue; const int idx = r * 64 + lane; ((float*)(A.ws + WS_MODF))[idx] = modp_sum(modp, idx); continue; } r -= I_MODF;
        if (r < I_WIN) { if (STAGE != 0) continue; p0_transpose_item(A.in[5], D, INW, (bf16*)(A.ws + WS_WIN), 0, scr, r, lane); continue; } r -= I_WIN;
        if (r < I_WA) { if (STAGE != 0) continue; p0_transpose_item(A.in[6], AW, D, (bf16*)(A.ws + WS_WA), 0, scr, r, lane); continue; } r -= I_WA;
        if (r < I_WOUT) { if (STAGE != 0) continue; p0_transpose_item(A.in[11], D, D, (bf16*)(A.ws + WS_WOUT), 0, scr, r, lane); continue; } r -= I_WOUT;
        if (r < I_WQ) { if (STAGE != 0) continue; p0_transpose_item(A.in[13], D, PQW, (bf16*)(A.ws + WS_WQ), 0, scr, r, lane); continue; } r -= I_WQ;
        if (r < I_SUBK) { if (STAGE != 0) continue; const float* s = A.in[14] + (size_t)r * 512 + 8 * lane; const f32x4 a = *(const f32x4*)s, b = *(const f32x4*)(s + 4);
            v4u o; o.x = pk2(a[0], a[1]); o.y = pk2(a[2], a[3]); o.z = pk2(b[0], b[1]); o.w = pk2(b[2], b[3]);
            *(GAS v4u*)((bf16*)(A.ws + WS_SUBK) + (size_t)r * 512 + 8 * lane) = o; continue; } r -= I_SUBK;
    }
    auto xg_rows = [&](const int rb) {
        const float* x = A.in[0]; bf16* XG = (bf16*)(A.ws + WS_XG); float* rstd1 = (float*)(A.ws + WS_RSTD1);
            for (int r0 = F.wave; r0 < 128; r0 += 4 * NWAVES) {
                f32x4 v[4][2][2]; float s[4];
#pragma unroll
                for (int u = 0; u < 4; ++u) { const float* xr = x + (size_t)(rb * 128 + r0 + u * NWAVES) * 1024;
#pragma unroll
                    for (int h = 0; h < 2; ++h)
#pragma unroll
                        for (int q = 0; q < 2; ++q) v[u][h][q] = __builtin_nontemporal_load((const f32x4*)(xr + h * 512 + 8 * lane + 4 * q)); }
#pragma unroll
                for (int u = 0; u < 4; ++u) { float t = 0.f;
#pragma unroll
                    for (int h = 0; h < 2; ++h)
#pragma unroll
                        for (int q = 0; q < 2; ++q) t += (v[u][h][q][0] * v[u][h][q][0] + v[u][h][q][1] * v[u][h][q][1]) + (v[u][h][q][2] * v[u][h][q][2] + v[u][h][q][3] * v[u][h][q][3]);
                    s[u] = t; }
#pragma unroll
                for (int o = 1; o < 64; o <<= 1) {
#pragma unroll
                    for (int u = 0; u < 4; ++u) s[u] += __shfl_xor(s[u], o); }
#pragma unroll
                for (int u = 0; u < 4; ++u) { const int row = rb * 128 + r0 + u * NWAVES;
                    if (lane == 0) rstd1[row] = 1.0f / sqrtf(s[u] * (1.0f / D) + RMS_EPS);
#pragma unroll
                    for (int h = 0; h < 2; ++h) { const LAS float* g = G1 + h * 512 + 8 * lane;
                        v4u o; o.x = pk2(v[u][h][0][0] * g[0], v[u][h][0][1] * g[1]); o.y = pk2(v[u][h][0][2] * g[2], v[u][h][0][3] * g[3]); o.z = pk2(v[u][h][1][0] * g[4], v[u][h][1][1] * g[5]); o.w = pk2(v[u][h][1][2] * g[6], v[u][h][1][3] * g[7]);
                        *(GAS v4u*)(XG + (size_t)row * 1024 + h * 512 + 8 * lane) = o; } }
            }
    };
    auto table_rows = [&]() {
    for (int r0 = gw; r0 < 2 * PEXP; r0 += 4 * NGW) {
        const float* src[4]; unsigned char* dst[4]; float* sco[4];
#pragma unroll
        for (int u = 0; u < 4; ++u) { int r = r0 + u * NGW; if (r >= 2 * PEXP) r = r0; const int tb = r / PEXP, e = r % PEXP;
            src[u] = (tb ? A.in[16] : A.in[15]) + (size_t)e * D; dst[u] = A.ws + (tb ? WS_V : WS_U) + (size_t)e * 128; sco[u] = (float*)(A.ws + (tb ? WS_V : WS_U) + 16 * MiB) + e; }
        const int tb0 = r0 / PEXP;
        if ((r0 + 3 * NGW) / PEXP == tb0 && r0 + 3 * NGW < 2 * PEXP) p0_table_rows4(src, dst, sco, tb0 ? 128 : 0, lane);
        else { for (int u = 0; u < 4; ++u) { const int r = r0 + u * NGW; if (r < 2 * PEXP) { const float* s1[4] = {src[u], src[u], src[u], src[u]}; unsigned char* d1[4] = {dst[u], dst[u], dst[u], dst[u]}; float* c1[4] = {sco[u], sco[u], sco[u], sco[u]}; p0_table_rows4(s1, d1, c1, (r / PEXP) ? 128 : 0, lane); } } }
    }
    };
    if (STAGE == 0) table_rows();
    else for (int rb = F.vcu; rb < T / 128; rb += F.G) {
        const float* g1 = A.in[4]; const int b = (rb * 128) / SEQ;
        __syncthreads();
        for (int k = F.tid; k < 1024; k += NTHREADS) G1[k] = g1[k] * (1.0f + modp_sum(modp, b * 6144 + 1024 + k));
        __syncthreads();
        xg_rows(rb);
    }

}
namespace attn_body {
using bf16=__hip_bfloat16;
using bf16x8=__attribute__((ext_vector_type(8)))short;
using s16x4=__attribute__((ext_vector_type(4)))short;
using f32x16=__attribute__((ext_vector_type(16)))float;
using u32x4=__attribute__((ext_vector_type(4)))unsigned;
constexpr int BATCH=8,NHEAD=8,SEQ=4096,D=64,DM=NHEAD*D;
constexpr int NW=8,QBLK=32,QB=QBLK*NW,KVBLK=64,NQB=SEQ/QB;
constexpr int ATTN_PITCH=DM, ATTN_UNIT_ROWS=QB;
__device__ __forceinline__ int crow(int r,int hi){return (r&3)+8*(r>>2)+4*hi;}
#define SBAR() __builtin_amdgcn_sched_barrier(0)
__device__ __forceinline__ void cmask(f32x16&p0,f32x16&p1,int jb,int qrel,int hi){
  const float NEG=-INFINITY; int kb=64*jb+4*hi;
  #pragma unroll
  for(int r=0;r<16;++r){int kv=kb+(r&3)+8*(r>>2); if(kv>qrel)p0[r]=NEG; if(kv+32>qrel)p1[r]=NEG;}
}

constexpr int NSLOT=3, SLOTB=8192;
constexpr int LDS_K=0, LDS_V=NSLOT*SLOTB, LDS_WS=2*NSLOT*SLOTB, LDS_OST=LDS_WS+NW*64*4, LDS_KSL=LDS_OST+NW*4096, LDS_BYTES=LDS_KSL+4096;
constexpr float C2=0.125f*1.4426950408889634f;
__device__ __forceinline__ void glds16(const void*sbase,unsigned voff,unsigned lds_dst){unsigned keep;
  asm volatile("s_mov_b32 %0, m0\n\ts_mov_b32 m0, %3\n\ts_nop 4\n\tglobal_load_lds_dwordx4 %1, %2\n\ts_mov_b32 m0, %0":"=&s"(keep):"v"(voff),"s"(sbase),"s"(lds_dst):"memory");}
__device__ __forceinline__ float max3f(float a,float b,float c){float r;asm("v_max3_f32 %0, %1, %2, %3":"=v"(r):"v"(a),"v"(b),"v"(c));return r;}
__device__ __forceinline__ float max2f(float a,float b){float r;asm("v_max_f32_e32 %0, %1, %2":"=v"(r):"v"(a),"v"(b));return r;}
__device__ __forceinline__ float fadd_s(float a,float b){float r;asm("v_add_f32_e32 %0, %1, %2":"=v"(r):"v"(a),"v"(b));return r;}
__device__ __forceinline__ float fsub_s(float a,float b){float r;asm("v_sub_f32_e32 %0, %1, %2":"=v"(r):"v"(a),"v"(b));return r;}
typedef float f32x2_t __attribute__((ext_vector_type(2))); typedef __bf16 bf16x2_t __attribute__((ext_vector_type(2)));
__device__ __forceinline__ unsigned cvtpk_s(float lo,float hi){f32x2_t v={lo,hi};bf16x2_t b=__builtin_convertvector(v,bf16x2_t);return __builtin_bit_cast(unsigned,b);}
#define WAIT_BAR(N) asm volatile("s_waitcnt vmcnt(" #N ") lgkmcnt(0)\n\ts_barrier":::"memory")

__device__ __forceinline__ void qkt(f32x16&p0,f32x16&p1,const char*Kslot,const bf16x8*qr,const f32x16&negm,int r32,int hi){
  const char*kb=Kslot+hi*1024+r32*16;
  #pragma unroll
  for(int d0=0;d0<4;++d0){
    const bf16x8 b0=*reinterpret_cast<const bf16x8*>(kb+d0*2048);
    const bf16x8 b1=*reinterpret_cast<const bf16x8*>(kb+d0*2048+512);
    if(d0==0){p0=__builtin_amdgcn_mfma_f32_32x32x16_bf16(b0,qr[0],negm,0,0,0);p1=__builtin_amdgcn_mfma_f32_32x32x16_bf16(b1,qr[0],negm,0,0,0);}
    else{p0=__builtin_amdgcn_mfma_f32_32x32x16_bf16(b0,qr[d0],p0,0,0,0);p1=__builtin_amdgcn_mfma_f32_32x32x16_bf16(b1,qr[d0],p1,0,0,0);}}
}
typedef __attribute__((address_space(3))) const char* lds_cptr;
typedef short v4i16_t __attribute__((ext_vector_type(4)));
__device__ __forceinline__ void kload8(bf16x8*kf,lds_cptr kp){
  kf[0]=*(const __attribute__((address_space(3))) bf16x8*)(kp);      kf[1]=*(const __attribute__((address_space(3))) bf16x8*)(kp+512);
  kf[2]=*(const __attribute__((address_space(3))) bf16x8*)(kp+2048); kf[3]=*(const __attribute__((address_space(3))) bf16x8*)(kp+2560);
  kf[4]=*(const __attribute__((address_space(3))) bf16x8*)(kp+4096); kf[5]=*(const __attribute__((address_space(3))) bf16x8*)(kp+4608);
  kf[6]=*(const __attribute__((address_space(3))) bf16x8*)(kp+6144); kf[7]=*(const __attribute__((address_space(3))) bf16x8*)(kp+6656);
}
__device__ __forceinline__ void kload2(bf16x8*kf,lds_cptr kp,int j){ kf[2*j]=*(const __attribute__((address_space(3))) bf16x8*)(kp+j*2048); kf[2*j+1]=*(const __attribute__((address_space(3))) bf16x8*)(kp+j*2048+512); }
__device__ __forceinline__ s16x4 vtr(lds_cptr p){ return __builtin_bit_cast(s16x4,__builtin_amdgcn_ds_read_tr16_b64_v4i16((__attribute__((address_space(3))) v4i16_t*)p)); }
__device__ __forceinline__ float rowmax(const f32x16&p0,const f32x16&p1){
  float a=max3f(p0[0],p0[1],p1[0]),b=max3f(p0[2],p0[3],p1[1]);a=max3f(a,p1[2],p1[3]);
  #pragma unroll
  for(int r=4;r<16;r+=4){a=max3f(a,p0[r],p0[r+1]);b=max3f(b,p0[r+2],p0[r+3]);a=max3f(a,p1[r],p1[r+1]);b=max3f(b,p1[r+2],p1[r+3]);}
  const float m=max2f(a,b);
  auto rr=__builtin_amdgcn_permlane32_swap(__float_as_uint(m),__float_as_uint(m),false,false);
  return max2f(__uint_as_float(rr[0]),__uint_as_float(rr[1]));
}
__device__ __forceinline__ void pv(f32x16*o,int vb,bf16x8 pa0,bf16x8 pa1,bf16x8 pa2,bf16x8 pa3){
  #pragma unroll
  for(int d0=0;d0<2;++d0){s16x4 lo[4],hi[4];
    #pragma unroll
    for(int ks=0;ks<4;++ks){
      asm volatile("ds_read_b64_tr_b16 %0,%1 offset:%c2":"=&v"(lo[ks]):"v"(vb),"i"(d0*4096+ks*1024):"memory");
      asm volatile("ds_read_b64_tr_b16 %0,%1 offset:%c2":"=&v"(hi[ks]):"v"(vb),"i"(d0*4096+ks*1024+512):"memory");}
    asm volatile("s_waitcnt lgkmcnt(0)":::"memory");SBAR();
    #define PK(k) (bf16x8){lo[k][0],lo[k][1],lo[k][2],lo[k][3],hi[k][0],hi[k][1],hi[k][2],hi[k][3]}
    o[d0]=__builtin_amdgcn_mfma_f32_32x32x16_bf16(pa0,PK(0),o[d0],0,0,0);
    o[d0]=__builtin_amdgcn_mfma_f32_32x32x16_bf16(pa1,PK(1),o[d0],0,0,0);
    o[d0]=__builtin_amdgcn_mfma_f32_32x32x16_bf16(pa2,PK(2),o[d0],0,0,0);
    o[d0]=__builtin_amdgcn_mfma_f32_32x32x16_bf16(pa3,PK(3),o[d0],0,0,0);
    #undef PK
  }
}

#ifndef ATTN_STORE16
#define ATTN_STORE16(p,v) (*(u32x4*)(p)=(v))
#endif
template<int THRL> __device__ __forceinline__ void attn_unit(int b,int h,int qb,const bf16*Q,const bf16*__restrict__ K,const bf16*__restrict__ V,bf16*O,const float*ksum,char*shm){
  int tid_=threadIdx.x; asm volatile("":"+v"(tid_)); const int tid=tid_,lane=tid&63,r32=lane&31,hi=lane>>5; const int wid=__builtin_amdgcn_readfirstlane(tid>>6);
  const long rowbase=(long)b*SEQ; const int q0=qb*QB;
  const bf16*Qw=Q+(rowbase+q0+wid*QBLK)*DM+h*D;
  const bf16*Kh=K+rowbase*DM+h*D,*Vh=V+rowbase*DM+h*D;
  const unsigned lds0=(unsigned)(uintptr_t)shm;
  float*wsf=(float*)(shm+LDS_WS)+wid*64;
  const unsigned kvoff=(unsigned)(lane*DM+wid*8)*2u;
  const unsigned vvoff=(unsigned)((16*(wid&3)+(lane>>2))*DM+(wid>>2)*32+(lane&3)*8)*2u;
  const unsigned kdst=lds0+LDS_K+wid*1024, vdst=lds0+LDS_V+wid*1024;
  #define DMA_K(t,slot) glds16(Kh+(long)(NT-1-(t))*KVBLK*DM,kvoff,(unsigned)__builtin_amdgcn_readfirstlane(kdst+(slot)))
  #define DMA_V(t,slot) glds16(Vh+(long)(NT-1-(t))*KVBLK*DM,vvoff,(unsigned)__builtin_amdgcn_readfirstlane(vdst+(slot)))
  const int vb0=(int)(lds0+LDS_V)+((lane>>4)&1)*32+(lane&3)*8+(4*hi+((lane&15)>>2))*64;
  const char*Kbase=shm+LDS_K; bf16x8 kf[8];
  const lds_cptr shm3=(lds_cptr)shm; const lds_cptr kp0=shm3+LDS_K+hi*1024+r32*16; const lds_cptr vp0=shm3+LDS_V+((lane>>4)&1)*32+(lane&3)*8+(4*hi+((lane&15)>>2))*64;
  const int NT=(q0+QB)/KVBLK;
  { float*ksl=(float*)(shm+LDS_KSL); const float k0=ksum[(long)(b*16+(tid>>6))*512+h*64+(tid&63)],k1=ksum[(long)(b*16+8+(tid>>6))*512+h*64+(tid&63)]; ksl[tid]=k0; ksl[512+tid]=k1; }
  DMA_K(0,0);DMA_V(0,0);DMA_K(1,SLOTB);
  bf16x8 qr[4];
  #pragma unroll
  for(int d0=0;d0<4;++d0)qr[d0]=*reinterpret_cast<const bf16x8*>(&Qw[(long)r32*DM+d0*16+hi*8]);
  float mhat=0.f,l_reg=0.f;f32x16 o[2];o[0]=f32x16{};o[1]=f32x16{};const f32x16 zero16=f32x16{};
  const int qrel=wid*QBLK+r32;
  #define CMASK(P0,P1,t) do{int jb_=3-(t); if(jb_>=0)cmask(P0,P1,jb_,qrel,hi);}while(0)
  const unsigned sl2b=0x3FB8AA3Bu-((unsigned)(h+1)<<23);
  const float slope2=__uint_as_float(sl2b), s2x=__uint_as_float(sl2b+(1u<<23)), s8x=__uint_as_float(sl2b+(3u<<23)), s32=__uint_as_float(sl2b+(5u<<23));
  const float s3x=__uint_as_float((unsigned)__builtin_amdgcn_readfirstlane((int)__float_as_uint(slope2*3.0f)));
  #define NBSEL(r) (((r)>>2)==0?nbb0_:((r)>>2)==1?nbb1_:((r)>>2)==2?nbb2_:nbb3_)
  #define NEGV(r) ((((r)&3)==0)?NBSEL(r):(NBSEL(r)+(((r)&3)==1?slope2:((r)&3)==2?s2x:s3x)))
  #define NBB(nb) const float nbb0_=(nb), nbb1_=nbb0_+s8x, nbb2_=nbb1_+s8x, nbb3_=nbb2_+s8x
  #define NBSELC(r) (((r)>>2)==0?nbc0_:((r)>>2)==1?nbc1_:((r)>>2)==2?nbc2_:nbc3_)
  #define SAV(r) (((r)&3)==1?slope2:((r)&3)==2?s2x:s3x)
  #define BIAS(C0,C1,s) do{ NBB(NBV(s)); const float nbc0_=nbb0_+s32,nbc1_=nbb1_+s32,nbc2_=nbb2_+s32,nbc3_=nbb3_+s32; \
      _Pragma("unroll") for(int r=0;r<16;++r){ if((r&3)==0){C0[r]+=NBSEL(r);C1[r]+=NBSELC(r);} else {C0[r]=(C0[r]+NBSEL(r))+SAV(r);C1[r]=(C1[r]+NBSELC(r))+SAV(r);} } }while(0)
  unsigned sel=0u;
  #define NBV(s) ({ const int tl_=NT-1-(s); const int tc_=tl_<0?0:tl_; const int bj_=tc_>>2; const float off_=(bj_>=qb||((sel>>bj_)&1u))?0.f:-1.0e30f; \
      __builtin_fmaf(slope2,(float)(64*tl_+4*hi-q0-qrel),off_-mhat); })
  #define CRC(r) ((float)(((r)&3)+8*((r)>>2)))
  bool resc=false;
  #define START(P0,P1) do{ const float rm=rowmax(P0,P1); resc=false; \
    { const float dl=(rm>-1.0e20f)?rm:0.f; mhat=fadd_s(mhat,dl); \
      _Pragma("unroll") for(int r=0;r<16;++r){P0[r]=fsub_s(P0[r],dl);P1[r]=fsub_s(P1[r],dl);} } \
    _Pragma("unroll") for(int r=0;r<16;++r)P0[r]=__builtin_amdgcn_exp2f(P0[r]); }while(0)
  #define RESC() do{ if(resc){ asm volatile("s_waitcnt lgkmcnt(0)":::"memory"); \
      _Pragma("unroll") for(int d_=0;d_<2;++d_) _Pragma("unroll") for(int r=0;r<16;++r)o[d_][r]*=wsf[crow(r,hi)]; } }while(0)
  f32x16 pA0,pA1,pB0,pB1;
  int sl_prev=0,sl_cur=0,sl_next=SLOTB;
  #define ROT() do{sl_prev=sl_cur;sl_cur=sl_next;sl_next=(sl_next==(NSLOT-1)*SLOTB)?0:sl_next+SLOTB;}while(0)
  DMA_K(2,2*SLOTB);
  WAIT_BAR(3);
  if(qb>0){
    float qf[32];
    _Pragma("unroll") for(int d0=0;d0<4;++d0) _Pragma("unroll") for(int e=0;e<8;++e) qf[d0*8+e]=__uint_as_float(((unsigned)(unsigned short)qr[d0][e])<<16);
    const float*ksl=(const float*)(shm+LDS_KSL)+8*hi;
    float b1=-3.0e38f,b2=-3.0e38f,b3=-3.0e38f; int i1=-1,i2=-1,i3=-1;
    for(int j=0;j<qb;++j){ float g=0.f;
      _Pragma("unroll") for(int d0=0;d0<4;++d0) _Pragma("unroll") for(int e=0;e<8;++e) g=__builtin_fmaf(qf[d0*8+e],ksl[j*64+16*d0+e],g);
      { auto rr=__builtin_amdgcn_permlane32_swap(__float_as_uint(g),__float_as_uint(g),false,false); g=__uint_as_float(rr[0])+__uint_as_float(rr[1]); }
      const bool c1=g>b1,c2=g>b2,c3=g>b3;
      b3=c2?b2:(c3?g:b3); i3=c2?i2:(c3?j:i3); b2=c1?b1:(c2?g:b2); i2=c1?i1:(c2?j:i2); b1=c1?g:b1; i1=c1?j:i1; }
    sel=(1u<<i1)|(i2>=0?(1u<<i2):0u)|(i3>=0?(1u<<i3):0u); }
  qkt(pA0,pA1,Kbase,qr,zero16,r32,hi);asm volatile("s_nop 15\n\ts_nop 7":"+v"(pA0),"+v"(pA1));
  BIAS(pA0,pA1,0);
  CMASK(pA0,pA1,0);
  START(pA0,pA1);
  _Pragma("unroll") for(int r=0;r<16;++r)pA1[r]=__builtin_amdgcn_exp2f(pA1[r]);
  WAIT_BAR(0);
  DMA_K(3,0);DMA_V(1,SLOTB);
  ROT();
  kload8(kf,kp0+sl_cur);
  WAIT_BAR(2);
  s16x4 vlo[8],vhi[8]; u32x4 pw0,pw1,pw2,pw3;
  #define PKW(P,B) cvtpk_s(P[B],P[B+1])
  #define PAF(k) __builtin_bit_cast(bf16x8,pw##k)
  #define VFR(i) (bf16x8){vlo[i][0],vlo[i][1],vlo[i][2],vlo[i][3],vhi[i][0],vhi[i][1],vhi[i][2],vhi[i][3]}
  #define PIN(x) asm volatile("":"+v"(x))
  #define MX3(a,b,c) __builtin_fmaxf(__builtin_fmaxf((a),(b)),(c))
  #define GAPA(MF,A0,A1,A2,A3,W0,W1,PW) do{ MF; sacc+=A0; sacc+=A1; sacc+=A2; sacc+=A3; PIN(sacc); W0; W1; PIN(PW); SBAR(); }while(0)
  #define EX(v) __builtin_amdgcn_exp2f(v)
  #define GAPB(MF,X,B) do{ MF; X[B]=EX(X[B]); X[B+1]=EX(X[B+1]); X[B+2]=EX(X[B+2]); X[B+3]=EX(X[B+3]); PIN(X); SBAR(); }while(0)
  #define VRD(i) do{ vlo[i]=vtr(vp_+(((i)>>2)*4096+((i)&3)*1024)); vhi[i]=vtr(vp_+(((i)>>2)*4096+((i)&3)*1024+512)); }while(0)
  #define KRD(G,j) do{ if(G){ kload2(kf,kp0+sl_next,j); SBAR(); } }while(0)
  #define STEP(C0,C1,P0,P1,t,GK,GV,GL) do{ SBAR(); \
    const lds_cptr vp_=vp0+sl_prev; \
    VRD(0); SBAR(); float sacc=(P0[0]+P0[1]); \
    GAPA(C0=__builtin_amdgcn_mfma_f32_32x32x16_bf16(kf[0],qr[0],zero16,0,0,0), P0[2],P0[3],P0[4],P0[5],     pw0[0]=PKW(P0,0), pw0[1]=PKW(P0,2), pw0); \
    VRD(4); SBAR(); GAPA(C1=__builtin_amdgcn_mfma_f32_32x32x16_bf16(kf[1],qr[0],zero16,0,0,0), P0[6],P0[7],P0[8],P0[9],     pw0[2]=PKW(P0,4), pw0[3]=PKW(P0,6), pw0); \
    VRD(1); SBAR(); GAPA(C0=__builtin_amdgcn_mfma_f32_32x32x16_bf16(kf[2],qr[1],C0,0,0,0),   P0[10],P0[11],P0[12],P0[13], pw1[0]=PKW(P0,8), pw1[1]=PKW(P0,10), pw1); \
    VRD(5); SBAR(); GAPA(C1=__builtin_amdgcn_mfma_f32_32x32x16_bf16(kf[3],qr[1],C1,0,0,0),   P0[14],P0[15],P1[0],P1[1],   pw1[2]=PKW(P0,12),pw1[3]=PKW(P0,14), pw1); \
    VRD(2); SBAR(); GAPA(C0=__builtin_amdgcn_mfma_f32_32x32x16_bf16(kf[4],qr[2],C0,0,0,0),   P1[2],P1[3],P1[4],P1[5],     pw2[0]=PKW(P1,0), pw2[1]=PKW(P1,2), pw2); \
    VRD(6); SBAR(); GAPA(C1=__builtin_amdgcn_mfma_f32_32x32x16_bf16(kf[5],qr[2],C1,0,0,0),   P1[6],P1[7],P1[8],P1[9],     pw2[2]=PKW(P1,4), pw2[3]=PKW(P1,6), pw2); \
    VRD(3); SBAR(); GAPA(C0=__builtin_amdgcn_mfma_f32_32x32x16_bf16(kf[6],qr[3],C0,0,0,0),   P1[10],P1[11],P1[12],P1[13], pw3[0]=PKW(P1,8), pw3[1]=PKW(P1,10), pw3); \
    VRD(7); SBAR(); GAPA(C1=__builtin_amdgcn_mfma_f32_32x32x16_bf16(kf[7],qr[3],C1,0,0,0),   P1[14],P1[15],0.f,0.f,       pw3[2]=PKW(P1,12),pw3[3]=PKW(P1,14), pw3); \
    l_reg+=sacc; \
    if(GK){DMA_K((t)+3,sl_cur);} if(GV){DMA_V((t)+1,sl_next);} \
    BIAS(C0,C1,t); \
    CMASK(C0,C1,t); \
    { float a=MX3(C0[0],C0[1],C1[0]),b=MX3(C0[2],C0[3],C1[1]); a=MX3(a,C1[2],C1[3]); \
      _Pragma("unroll") for(int r=4;r<16;r+=4){a=MX3(a,C0[r],C0[r+1]);b=MX3(b,C0[r+2],C0[r+3]);a=MX3(a,C1[r],C1[r+1]);b=MX3(b,C1[r+2],C1[r+3]);} \
      float rm=__builtin_fmaxf(a,b); { auto rr=__builtin_amdgcn_permlane32_swap(__float_as_uint(rm),__float_as_uint(rm),false,false); rm=__builtin_fmaxf(__uint_as_float(rr[0]),__uint_as_float(rr[1])); } \
      resc=false; \
      if(__builtin_expect(__any(rm>(float)THRL),0)){ const float dl=__builtin_fmaxf(rm,0.f); mhat+=dl; \
        _Pragma("unroll") for(int r=0;r<16;++r){C0[r]-=dl;C1[r]-=dl;} \
        const float f=__builtin_amdgcn_exp2f(-dl); l_reg*=f; if(hi==0)wsf[r32]=f; resc=true; } } \
    SBAR(); \
    GAPB(o[0]=__builtin_amdgcn_mfma_f32_32x32x16_bf16(PAF(0),VFR(0),o[0],0,0,0), C0,0); \
    GAPB(o[1]=__builtin_amdgcn_mfma_f32_32x32x16_bf16(PAF(0),VFR(4),o[1],0,0,0), C0,4); \
    KRD(GL,0); GAPB(o[0]=__builtin_amdgcn_mfma_f32_32x32x16_bf16(PAF(1),VFR(1),o[0],0,0,0), C0,8); \
    KRD(GL,1); GAPB(o[1]=__builtin_amdgcn_mfma_f32_32x32x16_bf16(PAF(1),VFR(5),o[1],0,0,0), C0,12); \
    KRD(GL,2); GAPB(o[0]=__builtin_amdgcn_mfma_f32_32x32x16_bf16(PAF(2),VFR(2),o[0],0,0,0), C1,0); \
    KRD(GL,3); GAPB(o[1]=__builtin_amdgcn_mfma_f32_32x32x16_bf16(PAF(2),VFR(6),o[1],0,0,0), C1,4); \
    GAPB(o[0]=__builtin_amdgcn_mfma_f32_32x32x16_bf16(PAF(3),VFR(3),o[0],0,0,0), C1,8); \
    GAPB(o[1]=__builtin_amdgcn_mfma_f32_32x32x16_bf16(PAF(3),VFR(7),o[1],0,0,0), C1,12); \
    }while(0)
  int t=1;
  #define ENDW(tt) do{ if((tt)+3<NT){WAIT_BAR(2);} else if((tt)+2<NT){WAIT_BAR(1);} else {WAIT_BAR(0);} }while(0)
  #define PEELED_PAIR() do{ \
    STEP(pB0,pB1,pA0,pA1,t,(t+3<NT),(t+1<NT),(t+1<NT));       ENDW(t);   RESC(); ROT(); \
    STEP(pA0,pA1,pB0,pB1,t+1,(t+4<NT),(t+2<NT),(t+2<NT));     ENDW(t+1); RESC(); ROT(); }while(0)
  for(;t<5&&t+1<NT;t+=2){ PEELED_PAIR(); }
  #undef CMASK
  #define CMASK(P0,P1,t) do{}while(0)
  for(;t+5<NT;t+=2){
    STEP(pB0,pB1,pA0,pA1,t,true,true,true);     WAIT_BAR(2); RESC(); ROT();
    STEP(pA0,pA1,pB0,pB1,t+1,true,true,true);   WAIT_BAR(2); RESC(); ROT();
  }
  #undef CMASK
  #define CMASK(P0,P1,t) do{int jb_=3-(t); if(jb_>=0)cmask(P0,P1,jb_,qrel,hi);}while(0)
  for(;t+1<NT;t+=2){ PEELED_PAIR(); }
  STEP(pB0,pB1,pA0,pA1,NT-1,false,false,false); RESC();
  { float sacc=pB0[0]+pB0[1]; _Pragma("unroll") for(int r=2;r<16;++r)sacc+=pB0[r]; _Pragma("unroll") for(int r=0;r<16;++r)sacc+=pB1[r]; l_reg+=sacc;
    pw0=(u32x4){PKW(pB0,0),PKW(pB0,2),PKW(pB0,4),PKW(pB0,6)};pw1=(u32x4){PKW(pB0,8),PKW(pB0,10),PKW(pB0,12),PKW(pB0,14)};pw2=(u32x4){PKW(pB1,0),PKW(pB1,2),PKW(pB1,4),PKW(pB1,6)};pw3=(u32x4){PKW(pB1,8),PKW(pB1,10),PKW(pB1,12),PKW(pB1,14)};
    SBAR(); pv(o,vb0+sl_cur,PAF(0),PAF(1),PAF(2),PAF(3)); }
  #undef PKW
  #undef PAF
  #undef VFR
  #undef PIN
  #undef MX3
  #undef GAPA
  #undef GAPB
  #undef EX
  #undef VRD
  #undef KRD
  #undef STEP
  #undef ENDW
  #undef PEELED_PAIR
  #undef NBV
  #undef CRC
  #undef NEGV
  #undef NBSEL
  #undef NBB
  #undef NBSELC
  #undef SAV
  #undef BIAS
  {auto rr=__builtin_amdgcn_permlane32_swap(__float_as_uint(l_reg),__float_as_uint(l_reg),false,false);l_reg=__uint_as_float(rr[0])+__uint_as_float(rr[1]);}
  if(hi==0)wsf[32+r32]=l_reg;asm volatile("s_waitcnt lgkmcnt(0)":::"memory");
  float rli[16];
  #pragma unroll
  for(int r=0;r<16;++r)rli[r]=__builtin_amdgcn_rcpf(wsf[32+crow(r,hi)]);
  bf16*Ow=O+(rowbase+q0+wid*QBLK)*DM+h*D;
  { bf16*stg=(bf16*)(shm+LDS_OST)+wid*2048;
    #pragma unroll
    for(int r=0;r<16;++r){const int orow=crow(r,hi);
      #pragma unroll
      for(int d0=0;d0<2;++d0)stg[orow*64+d0*32+r32]=__float2bfloat16(o[d0][r]*rli[r]);}
    asm volatile("s_waitcnt lgkmcnt(0)":::"memory");
    #pragma unroll
    for(int i=0;i<4;++i){const int row=i*8+(lane>>3),ch=lane&7; const u32x4 v=*(const u32x4*)(stg+row*64+ch*8); ATTN_STORE16(Ow+(long)row*DM+ch*8,v);} }
  asm volatile("s_waitcnt lgkmcnt(0)\n\ts_barrier":::"memory");
  #undef DMA_K
  #undef DMA_V
  #undef CMASK
  #undef START
  #undef RESC
  #undef ROT
}
constexpr int ATTN_LDS_BYTES=LDS_BYTES;
struct AttnTensors { const bf16* Q; const bf16* K; const bf16* V; bf16* O; };
struct AttnUnit { int bh; int qb; };
struct StaticOrder {
  int vcu,G;
  __device__ __forceinline__ explicit StaticOrder(int grid,int vcu_):vcu(vcu_),G(grid){}
  __device__ __forceinline__ bool next(int i,AttnUnit&u)const{
    if(G!=256){ const int id=vcu+i*G; if(id>=BATCH*NHEAD*NQB)return false; u.bh=id>>4; u.qb=id&15; return true; }
    if(i>=4)return false; const int s=vcu&3; u.bh=vcu>>2; u.qb=(i==0)?s:(i==1)?7-s:(i==2)?8+s:15-s; return true; }
};
template<class Sched,int THRL=8> __device__ __forceinline__ void attn_phase(char*lds,const AttnTensors&T,const float*ksum,const Sched&S){
  AttnUnit u;
  for(int i=0;S.next(i,u);++i){ attn_unit<THRL>(u.bh/NHEAD,u.bh%NHEAD,u.qb,T.Q,T.K,T.V,T.O,ksum,lds); }
}
#undef SBAR
#undef WAIT_BAR
}

__device__ __forceinline__ void pooled_phase(Frame& F, const Args& A) {
    const bf16* P = (const bf16*)(A.ws + WS_QKVP) + (size_t)3 * T * 512; bf16* PO = (bf16*)(A.ws + WS_POOLED);
    const int gw = F.vcu * NWAVES + F.wave, NGW = F.G * NWAVES, lane = F.lane, w = 2 << (lane >> 4);
    for (int tk = gw; tk < T / 16; tk += NGW) {
        const int row0 = tk * 16, s0 = row0 & (SEQ - 1);
        v4u rv[31];
#pragma unroll
        for (int i = 0; i < 31; ++i) { const int sidx = s0 - 15 + i; rv[i] = (sidx >= 0) ? *(const v4u*)(P + (size_t)(row0 - 15 + i) * 512 + 8 * lane) : (v4u){0u, 0u, 0u, 0u}; }
#pragma unroll
        for (int i = 0; i < 16; ++i) {
            const int sidx = s0 + i; float acc[8];
#pragma unroll
            for (int e = 0; e < 8; ++e) acc[e] = 0.f;
#pragma unroll
            for (int k = 0; k < 16; ++k) { const bool ok = (k < w) && (sidx - k >= 0); const v4u x = rv[15 + i - k]; const float msk = ok ? 1.0f : 0.0f;
                acc[0] += msk * bflo(x.x); acc[1] += msk * bfhi(x.x); acc[2] += msk * bflo(x.y); acc[3] += msk * bfhi(x.y); acc[4] += msk * bflo(x.z); acc[5] += msk * bfhi(x.z); acc[6] += msk * bflo(x.w); acc[7] += msk * bfhi(x.w); }
            const float inv = 1.0f / (float)min(sidx + 1, w); const v4u x = rv[15 + i];
            v4u o; o.x = pk2(acc[0] * inv - bflo(x.x), acc[1] * inv - bfhi(x.x)); o.y = pk2(acc[2] * inv - bflo(x.y), acc[3] * inv - bfhi(x.y));
            o.z = pk2(acc[4] * inv - bflo(x.z), acc[5] * inv - bfhi(x.z)); o.w = pk2(acc[6] * inv - bflo(x.w), acc[7] * inv - bfhi(x.w));
            *(v4u*)(PO + (size_t)(row0 + i) * 512 + 8 * lane) = o;
        }
    }
}

namespace rt {
typedef float f32x16 __attribute__((ext_vector_type(16)));
typedef short bf16x8 __attribute__((ext_vector_type(8)));
__device__ __forceinline__ void ce(float& hi, float& lo) { const float a = fmaxf(hi, lo), b = fminf(hi, lo); hi = a; lo = b; }
template <int N> __device__ __forceinline__ void sort_desc(float (&v)[N]) {
#pragma unroll
    for (int k = 2; k <= N; k <<= 1)
#pragma unroll
        for (int j = k >> 1; j > 0; j >>= 1)
#pragma unroll
            for (int i = 0; i < N; ++i) { const int l = i ^ j; if (l > i) { if ((i & k) == 0) ce(v[i], v[l]); else ce(v[l], v[i]); } }
}
template <int N> __device__ __forceinline__ void bitonic_merge_desc(float (&v)[N]) {
#pragma unroll
    for (int j = N >> 1; j > 0; j >>= 1)
#pragma unroll
        for (int i = 0; i < N; ++i) { const int l = i ^ j; if (l > i) ce(v[i], v[l]); }
}
__device__ __forceinline__ void merge_top16(float (&a)[16], const float (&b)[16]) {
#pragma unroll
    for (int i = 0; i < 16; ++i) a[i] = fmaxf(a[i], b[15 - i]);
    bitonic_merge_desc<16>(a);
}
template <bool SORT> __device__ __forceinline__ void pair_merge(float (&a)[16], bool hi) {
    float w[16];
#pragma unroll
    for (int i = 0; i < 16; ++i) w[i] = hi ? a[15 - i] : a[i];
#pragma unroll
    for (int i = 0; i < 16; ++i) { const auto rr = __builtin_amdgcn_permlane32_swap(__float_as_uint(w[i]), __float_as_uint(w[i]), false, false); a[i] = fmaxf(__uint_as_float(rr[0]), __uint_as_float(rr[1])); }
    if (SORT) bitonic_merge_desc<16>(a);
}
__device__ __forceinline__ void fold_tile(const f32x16& acc, int kt, int hi, float (&out)[16]) {
    float g[16];
#pragma unroll
    for (int r = 0; r < 16; ++r) { const unsigned key = (unsigned)(32 * kt + (r & 3) + 8 * (r >> 2)); g[r] = __uint_as_float((__float_as_uint(acc[r]) & ~127u) | key | ((unsigned)hi << 2)); }
    sort_desc<16>(g);
    if (kt == 0) {
#pragma unroll
        for (int r = 0; r < 16; ++r) out[r] = g[r];
    } else merge_top16(out, g);
}
}
__device__ __forceinline__ void router_phase(Frame& F, const Args& A) {
    using namespace rt;
    const bf16* QP = (const bf16*)(A.ws + WS_GAB); const bf16* SK = (const bf16*)(A.ws + WS_SUBK);
    unsigned short* IDX = (unsigned short*)(A.ws + WS_POOLED); float* GATE = (float*)(A.ws + WS_POOLED + 16 * MiB);
    const int lane = F.lane, n32 = lane & 31, hi = lane >> 5, gw = F.vcu * NWAVES + F.wave, NGW = F.G * NWAVES;
    __syncthreads();
    for (int i = F.tid; i < 2 * 128 * 16; i += NTHREADS) { const int r = i >> 4, ch = i & 15; *(LAS v4u*)(F.lds + r * 272 + ch * 16) = *(const v4u*)(SK + (size_t)r * 128 + ch * 8); }
    __syncthreads();
    LAS unsigned char* scr = F.lds + 73728 + F.wave * 1024;
    const LAS unsigned char* afrag = F.lds + n32 * 272 + hi * 16;
    bf16x8 qa[8], qb[8];
#define RT_QLOAD(task_, p_, q_) do { const int tq_ = (task_) * 4 + (n32 >> 3); const bf16* qr_ = QP + (size_t)tq_ * PQW + (n32 & 7) * 256 + (p_) * 128 + 8 * hi; \
        _Pragma("unroll") for (int i = 0; i < 8; ++i) q_[i] = __builtin_nontemporal_load((const bf16x8*)(qr_ + 16 * i)); } while (0)
#define RT_HALF(p_, q_, out_) do { _Pragma("unroll") for (int kt = 0; kt < 4; ++kt) { f32x16 acc = f32x16{}; \
        _Pragma("unroll") for (int ks = 0; ks < 8; ++ks) { const bf16x8 kf = *(const LAS bf16x8*)(afrag + ((p_) * 128 + 32 * kt) * 272 + 32 * ks); acc = __builtin_amdgcn_mfma_f32_32x32x16_bf16(kf, q_[ks], acc, 0, 0, 0); } \
        fold_tile(acc, kt, hi, out_); } pair_merge<true>(out_, hi != 0); } while (0)
    if (gw < T * PHEADS / 32) RT_QLOAD(gw, 0, qa);
    for (int task = gw; task < T * PHEADS / 32; task += NGW) {
        const int t = task * 4 + (n32 >> 3), h = n32 & 7;
        float la[16], lb[16];
        RT_QLOAD(task, 1, qb);
        RT_HALF(0, qa, la);
        { const int nxt = task + NGW; if (nxt < T * PHEADS / 32) RT_QLOAD(nxt, 0, qa); }
        RT_HALF(1, qb, lb);
        { unsigned w[4];
#pragma unroll
          for (int q = 0; q < 4; ++q) {
              const unsigned i0 = __float_as_uint(hi ? lb[4 * q] : la[4 * q]) & 127u, i1 = __float_as_uint(hi ? lb[4 * q + 1] : la[4 * q + 1]) & 127u, i2 = __float_as_uint(hi ? lb[4 * q + 2] : la[4 * q + 2]) & 127u, i3 = __float_as_uint(hi ? lb[4 * q + 3] : la[4 * q + 3]) & 127u;
              w[q] = i0 | (i1 << 8) | (i2 << 16) | (i3 << 24); }
          *(LAS v4u*)(scr + n32 * 32 + hi * 16) = (v4u){w[0], w[1], w[2], w[3]}; }
        float x[16], y[16];
#pragma unroll
        for (int i = 0; i < 16; ++i) { const float av = __uint_as_float(__float_as_uint(la[i]) & ~127u), bv = __uint_as_float(__float_as_uint(lb[i]) & ~127u); x[i] = hi ? bv : av; y[i] = hi ? av : bv; }
        float c0[16], c1[16];
        {
            const unsigned hb = (unsigned)hi << 8;
#define RT_CAND(i, j) __uint_as_float(((__float_as_uint(x[i] + y[j]) & ~511u) | (unsigned)((i) * 16 + (j))) | hb)
#define RT_DIAG(i) (hi ? -3.0e38f : RT_CAND(i, i))
            c0[0] = RT_DIAG(0);
#pragma unroll
            for (int j = 1; j < 16; ++j) c0[j] = RT_CAND(0, j);
            c1[0] = RT_DIAG(1);
#pragma unroll
            for (int j = 2; j < 8; ++j) c1[j - 1] = RT_CAND(1, j);
            c1[7] = RT_DIAG(2); c1[8] = RT_CAND(2, 3); c1[9] = RT_CAND(2, 4); c1[10] = RT_DIAG(3);
#pragma unroll
            for (int k = 11; k < 16; ++k) c1[k] = -3.0e38f;
#undef RT_CAND
#undef RT_DIAG
        }
        sort_desc<16>(c0); sort_desc<16>(c1); merge_top16(c0, c1);
        pair_merge<false>(c0, hi != 0);
        float mx = c0[0];
#pragma unroll
        for (int i = 1; i < 16; ++i) mx = fmaxf(mx, c0[i]);
        float ex[16], sm = 0.f;
#pragma unroll
        for (int i = 0; i < 16; ++i) { ex[i] = __expf(__uint_as_float(__float_as_uint(c0[i]) & ~511u) - mx); sm += ex[i]; }
        const float inv = 1.0f / sm;
        asm volatile("s_waitcnt lgkmcnt(0)" ::: "memory");
        int eo[8]; float go[8];
#pragma unroll
        for (int k = 0; k < 8; ++k) { const float wv = hi ? c0[8 + k] : c0[k]; go[k] = (hi ? ex[8 + k] : ex[k]) * inv;
            const unsigned bits = __float_as_uint(wv), fromhi = (bits >> 8) & 1u, xi = (bits >> 4) & 15u, yj = bits & 15u;
            const unsigned ar = fromhi ? yj : xi, br = fromhi ? xi : yj;
            const unsigned e1 = scr[n32 * 32 + ar], e2 = scr[n32 * 32 + 16 + br];
            eo[k] = (int)(e1 * 128u + e2); }
        unsigned short* ip = IDX + (size_t)t * PSEL + h * PTOP + 8 * hi; float* gp = GATE + (size_t)t * PSEL + h * PTOP + 8 * hi;
        *(v4u*)ip = (v4u){(unsigned)eo[0] | ((unsigned)eo[1] << 16), (unsigned)eo[2] | ((unsigned)eo[3] << 16), (unsigned)eo[4] | ((unsigned)eo[5] << 16), (unsigned)eo[6] | ((unsigned)eo[7] << 16)};
        *(f32x4*)gp = (f32x4){go[0], go[1], go[2], go[3]}; *(f32x4*)(gp + 4) = (f32x4){go[4], go[5], go[6], go[7]};
        asm volatile("s_waitcnt lgkmcnt(0)" ::: "memory");
    }
#undef RT_QLOAD
#undef RT_HALF
    __syncthreads();
}

typedef float f32x2 __attribute__((ext_vector_type(2)));
typedef int v4i __attribute__((ext_vector_type(4)));
__device__ __forceinline__ void h2q_token(const Args& A, int t, int lane) {
    const float* modf = (const float*)(A.ws + WS_MODF); const float* ss2 = (const float*)(A.ws + WS_SS2); const float* g2 = A.in[12];
    const int b = t / SEQ; const float* xr = A.out + (size_t)t * D + 16 * lane;
    const f32x4* sp = (const f32x4*)(ss2 + (size_t)t * 16); const f32x4 s4 = (sp[0] + sp[1]) + (sp[2] + sp[3]);
    const float rs = 1.0f / sqrtf(((s4[0] + s4[1]) + (s4[2] + s4[3])) * (1.0f / D) + RMS_EPS);
    float h2[16]; float am = 0.f;
#pragma unroll
    for (int q = 0; q < 4; ++q) { const int c = 16 * lane + 4 * q; const f32x4 xv = *(const f32x4*)(xr + 4 * q), gg = *(const f32x4*)(g2 + c), sc = *(const f32x4*)(modf + (size_t)b * 6144 + 4096 + c), sh = *(const f32x4*)(modf + (size_t)b * 6144 + 3072 + c);
#pragma unroll
        for (int e = 0; e < 4; ++e) { const float h = xv[e] * rs * (gg[e] * (1.0f + sc[e])) + sh[e]; h2[4 * q + e] = h; am = fmaxf(am, fabsf(h)); } }
    am = fmaxf(am, __shfl_xor(am, 1)); am = fmaxf(am, __shfl_xor(am, 2)); am = fmaxf(am, __shfl_xor(am, 4));
    const float hs = (am > 0.f) ? am * (1.0f / 127.0f) : 1.0f, hinv = 1.0f / hs;
    v4u o;
#pragma unroll
    for (int q = 0; q < 4; ++q) { const int q0 = (int)rintf(h2[4 * q] * hinv), q1 = (int)rintf(h2[4 * q + 1] * hinv), q2 = (int)rintf(h2[4 * q + 2] * hinv), q3 = (int)rintf(h2[4 * q + 3] * hinv);
        o[q] = (unsigned)(q0 & 255) | ((unsigned)(q1 & 255) << 8) | ((unsigned)(q2 & 255) << 16) | ((unsigned)q3 << 24); }
    *(v4u*)(A.ws + WS_H2Q + (size_t)t * D + 16 * lane) = o;
    if ((lane & 7) == 0) ((float*)(A.ws + WS_HS))[(size_t)t * 8 + (lane >> 3)] = hs;
}

__device__ __forceinline__ float gelu_tanh(float x) { const float u = 0.7978845608028654f * (x + 0.044715f * x * x * x); return x / (1.0f + __expf(-2.0f * u)); }
__device__ __forceinline__ void peer_sliced_phase(Frame& F, const Args& A) {
    const int lane = F.lane, c8 = lane & 7, g8 = lane >> 3, gw = F.vcu * NWAVES + F.wave, NGW = F.G * NWAVES;
    const float* modf = (const float*)(A.ws + WS_MODF);
    const unsigned char* U8 = A.ws + WS_U; const unsigned char* V8 = A.ws + WS_V;
    const float* SU = (const float*)(A.ws + WS_U + 16 * MiB); const float* SV = (const float*)(A.ws + WS_V + 16 * MiB);
    const unsigned short* IDX = (const unsigned short*)(A.ws + WS_POOLED); const float* GATE = (const float*)(A.ws + WS_POOLED + 16 * MiB);
    const float* gf = A.in[17];
    LAS float* AL = (LAS float*)(F.lds + F.wave * 17664);
    LAS float* SSQ = AL + 2048;
    LAS float* SAV = AL + 3072;
    LAS float* RS2 = AL + 3088;
    LAS float* GS = AL + 3104;
    LAS unsigned short* IDL = (LAS unsigned short*)(AL + 3360);
    for (int tb = gw * 16; tb < T; tb += NGW * 16) {
        for (int i = lane; i < 2048; i += 64) AL[i] = 0.f;
        for (int i = lane; i < 1024; i += 64) SSQ[i] = 0.f;
#pragma unroll
        for (int i = 0; i < 16; ++i) *(LAS unsigned*)(IDL + i * 128 + 2 * lane) = *(const unsigned*)(IDX + (size_t)(tb + i) * PSEL + 2 * lane);
        if (lane < 16) { const f32x4* sp = (const f32x4*)((const float*)(A.ws + WS_SS2) + (size_t)(tb + lane) * 16); const f32x4 s4 = (sp[0] + sp[1]) + (sp[2] + sp[3]);
            RS2[lane] = 1.0f / sqrtf(((s4[0] + s4[1]) + (s4[2] + s4[3])) * (1.0f / D) + RMS_EPS); }
        LDS_WAIT();
        {
            v4i W0[16], W1[16]; f32x4 X0[4], X1[4]; v4i H; float hs;
            const int bU = tb / SEQ; const float* g2 = A.in[12];
#define PU_X(k, X) do { const int k_ = (k) < 128 ? (k) : 127; const int s_ = k_ >> 4, t_ = tb + (k_ & 15); _Pragma("unroll") for (int q = 0; q < 4; ++q) X[q] = *(const f32x4*)(A.out + (size_t)t_ * D + 128 * s_ + 16 * c8 + 4 * q); } while (0)
#define PU_B(k, W) do { const int k_ = (k) < 128 ? (k) : 127; const int s_ = k_ >> 4; const unsigned base_ = ((unsigned)s_ << 21) + 16u * (unsigned)c8; v4u I[2]; I[0] = *(const LAS v4u*)(IDL + (k_ & 15) * 128 + 16 * g8); I[1] = *(const LAS v4u*)(IDL + (k_ & 15) * 128 + 16 * g8 + 8); \
            _Pragma("unroll") for (int j = 0; j < 16; ++j) W[j] = *(const v4i*)(U8 + (base_ + (((I[j >> 3][(j >> 1) & 3] >> (16 * (j & 1))) & 0xffffu) << 7))); \
            } while (0)
#define PU_Q(k, X) do { const int s_ = (k) >> 4, i_ = (k) & 15; \
            if (i_ == 0) { LDS_WAIT(); if (g8 == 0) { _Pragma("unroll") for (int q = 0; q < 4; ++q) { const int cc = 128 * s_ + 16 * c8 + 4 * q; const f32x4 gg = *(const f32x4*)(g2 + cc), sc = *(const f32x4*)(modf + (size_t)bU * 6144 + 4096 + cc), sh = *(const f32x4*)(modf + (size_t)bU * 6144 + 3072 + cc); \
                *(LAS f32x4*)(GS + c8 * 16 + 4 * q) = gg * (sc + 1.0f); *(LAS f32x4*)(GS + 128 + c8 * 16 + 4 * q) = sh; } } LDS_WAIT(); } \
            const float rs_ = RS2[i_]; float h2[16]; float am = 0.f; \
            _Pragma("unroll") for (int q = 0; q < 4; ++q) { const f32x4 gq = *(const LAS f32x4*)(GS + c8 * 16 + 4 * q), sq = *(const LAS f32x4*)(GS + 128 + c8 * 16 + 4 * q); \
                _Pragma("unroll") for (int e = 0; e < 4; ++e) { const float h = X[q][e] * rs_ * gq[e] + sq[e]; h2[4 * q + e] = h; am = fmaxf(am, fabsf(h)); } } \
            am = fmaxf(am, __shfl_xor(am, 1)); am = fmaxf(am, __shfl_xor(am, 2)); am = fmaxf(am, __shfl_xor(am, 4)); \
            hs = (am > 0.f) ? am * (1.0f / 127.0f) : 1.0f; const float hinv = 1.0f / hs; \
            _Pragma("unroll") for (int q = 0; q < 4; ++q) { const int q0 = (int)rintf(h2[4 * q] * hinv), q1 = (int)rintf(h2[4 * q + 1] * hinv), q2 = (int)rintf(h2[4 * q + 2] * hinv), q3 = (int)rintf(h2[4 * q + 3] * hinv); \
                H[q] = (int)((unsigned)(q0 & 255) | ((unsigned)(q1 & 255) << 8) | ((unsigned)(q2 & 255) << 16) | ((unsigned)q3 << 24)); } } while (0)
#define PU_C(k, W) do { int part[16]; \
            _Pragma("unroll") for (int j = 0; j < 16; ++j) part[j] = __builtin_amdgcn_sdot4(W[j].x, H.x, __builtin_amdgcn_sdot4(W[j].y, H.y, __builtin_amdgcn_sdot4(W[j].z, H.z, __builtin_amdgcn_sdot4(W[j].w, H.w, 0, false), false), false), false); \
            _Pragma("unroll") for (int step = 4; step >= 1; step >>= 1) { const bool up = (lane & step) != 0; \
                _Pragma("unroll") for (int i = 0; i < 2 * step; ++i) { const int send = up ? part[i] : part[i + 2 * step], keep = up ? part[i + 2 * step] : part[i]; part[i] = keep + __shfl_xor(send, step); } } \
            LAS f32x2* ap_ = (LAS f32x2*)(AL + ((k) & 15) * 128 + 2 * lane); f32x2 a_ = *ap_; a_.x += hs * (float)part[0]; a_.y += hs * (float)part[1]; *ap_ = a_; } while (0)
            PU_X(0, X0); PU_X(1, X1); PU_B(0, W0);
#pragma unroll 1
            for (int k = 0; k < 128; k += 2) {
                PU_Q(k, X0); PU_B(k + 1, W1); PU_X(k + 2, X0);
                PU_C(k, W0);
                PU_Q(k + 1, X1); PU_B(k + 2, W0); PU_X(k + 3, X1);
                PU_C(k + 1, W1);
            }
#undef PU_X
#undef PU_B
#undef PU_Q
#undef PU_C
        }
        LDS_WAIT();
#pragma unroll 4
        for (int i = 0; i < 16; ++i) {
            const int t = tb + i; const unsigned e01 = *(const LAS unsigned*)(IDL + i * 128 + 2 * lane); const int e0 = (int)(e01 & 0xffffu), e1 = (int)(e01 >> 16);
            const f32x2 gt = *(const f32x2*)(GATE + (size_t)t * PSEL + 2 * lane); const f32x2 a = *(LAS f32x2*)(AL + i * 128 + 2 * lane);
            f32x2 av; av.x = gelu_tanh(a.x * SU[e0]) * gt.x * SV[e0]; av.y = gelu_tanh(a.y * SU[e1]) * gt.y * SV[e1];
            *(LAS f32x2*)(AL + i * 128 + 2 * lane) = av;
            const float sm = wave_sum(av.x + av.y); if (lane == 0) SAV[i] = 128.0f * sm;
        }
        LDS_WAIT();
        {
            v4u W0[16], W1[16]; f32x2 X0, X1, gt2v = (f32x2){0.f, 0.f};
            const int b = tb / SEQ;
#define PV_B(k, W, X) do { const int k_ = (k) < 128 ? (k) : 127; const int s_ = k_ >> 4, t_ = tb + (k_ & 15); const unsigned base_ = ((unsigned)s_ << 21) + 16u * (unsigned)c8; v4u I[2]; I[0] = *(const LAS v4u*)(IDL + (k_ & 15) * 128 + 16 * g8); I[1] = *(const LAS v4u*)(IDL + (k_ & 15) * 128 + 16 * g8 + 8); \
            _Pragma("unroll") for (int j = 0; j < 16; ++j) W[j] = *(const v4u*)(V8 + (base_ + (((I[j >> 3][(j >> 1) & 3] >> (16 * (j & 1))) & 0xffffu) << 7))); \
            X = __builtin_nontemporal_load((const f32x2*)(A.out + (size_t)t_ * D + 128 * s_ + 16 * c8 + 2 * g8)); } while (0)
#define PV_C(k, W, X) do { const int s_ = (k) >> 4, i_ = (k) & 15; \
            if (i_ == 0) gt2v = *(const f32x2*)(modf + (size_t)b * 6144 + 5120 + 128 * s_ + 16 * c8 + 2 * g8); \
            f32x2 acc[8]; _Pragma("unroll") for (int q = 0; q < 8; ++q) acc[q] = (f32x2){0.f, 0.f}; \
            const LAS f32x4* avp_ = (const LAS f32x4*)(AL + i_ * 128 + 16 * g8); \
            _Pragma("unroll") for (int q4 = 0; q4 < 4; ++q4) { const f32x4 a4 = avp_[q4]; \
                _Pragma("unroll") for (int e = 0; e < 4; ++e) { const float a = a4[e]; const v4u w = W[4 * q4 + e]; \
                    acc[0] += (f32x2){(float)(w.x & 255u), (float)((w.x >> 8) & 255u)} * a; acc[1] += (f32x2){(float)((w.x >> 16) & 255u), (float)(w.x >> 24)} * a; \
                    acc[2] += (f32x2){(float)(w.y & 255u), (float)((w.y >> 8) & 255u)} * a; acc[3] += (f32x2){(float)((w.y >> 16) & 255u), (float)(w.y >> 24)} * a; \
                    acc[4] += (f32x2){(float)(w.z & 255u), (float)((w.z >> 8) & 255u)} * a; acc[5] += (f32x2){(float)((w.z >> 16) & 255u), (float)(w.z >> 24)} * a; \
                    acc[6] += (f32x2){(float)(w.w & 255u), (float)((w.w >> 8) & 255u)} * a; acc[7] += (f32x2){(float)((w.w >> 16) & 255u), (float)(w.w >> 24)} * a; } } \
            float pc[16]; _Pragma("unroll") for (int q = 0; q < 8; ++q) { pc[2 * q] = acc[q].x; pc[2 * q + 1] = acc[q].y; } \
            _Pragma("unroll") for (int step = 4; step >= 1; step >>= 1) { const bool up = (g8 & step) != 0; \
                _Pragma("unroll") for (int i = 0; i < 2 * step; ++i) { const float send = up ? pc[i] : pc[i + 2 * step], keep = up ? pc[i + 2 * step] : pc[i]; pc[i] = keep + __shfl_xor(send, 8 * step); } } \
            const float sav_ = SAV[i_]; f32x2 x2_; x2_.x = X.x + gt2v.x * (pc[0] - sav_); x2_.y = X.y + gt2v.y * (pc[1] - sav_); \
            *(f32x2*)(A.out + (size_t)(tb + i_) * D + 128 * s_ + 16 * c8 + 2 * g8) = x2_; \
            SSQ[i_ * 64 + lane] += x2_.x * x2_.x + x2_.y * x2_.y; } while (0)
            PV_B(0, W0, X0);
#pragma unroll 1
            for (int k = 0; k < 128; k += 2) {
                PV_B(k + 1, W1, X1);
                PV_C(k, W0, X0);
                PV_B(k + 2, W0, X0);
                PV_C(k + 1, W1, X1);
            }
#undef PV_B
#undef PV_C
        }
        VM_WAIT(); LDS_WAIT();
#pragma unroll 2
        for (int i = 0; i < 16; ++i) {
            float* xr = A.out + (size_t)(tb + i) * D + 16 * lane;
            f32x4 v[4];
#pragma unroll
            for (int q = 0; q < 4; ++q) v[q] = __builtin_nontemporal_load((const f32x4*)(xr + 4 * q));
            const float rs = 1.0f / sqrtf(wave_sum(SSQ[i * 64 + lane]) * (1.0f / D) + RMS_EPS);
#pragma unroll
            for (int q = 0; q < 4; ++q) *(f32x4*)(xr + 4 * q) = v[q] * rs * *(const f32x4*)(gf + 16 * lane + 4 * q);
        }
        LDS_WAIT();
    }
}

#ifndef PHASE_ONLY
#define PHASE_ONLY -1
#endif
#ifndef PHASE_SKIP
#define PHASE_SKIP -2
#endif
#define PH(n) ((PHASE_ONLY < 0 || PHASE_ONLY == (n)) && PHASE_SKIP != (n))
#ifndef PROBE_DOUBLE
#define PROBE_DOUBLE -1
#endif
#define REPS(n) for (int rep_ = 0; rep_ < ((PROBE_DOUBLE == (n)) ? 2 : 1); ++rep_)
__global__ void __launch_bounds__(NTHREADS, 2) fwd_megakernel(Args A) {
    extern __shared__ __attribute__((aligned(16))) unsigned char lds[];
    Frame F;
    F.lds = (LAS unsigned char*)lds;
    F.MISC = (volatile LAS unsigned*)(F.lds + MISC_OFF);
    F.tid = threadIdx.x; F.lane = F.tid & 63; F.wave = __builtin_amdgcn_readfirstlane(F.tid >> 6);
    F.G = gridDim.x; { const int bx = blockIdx.x; F.vcu = (F.G % 8 == 0) ? (bx % 8) * (F.G / 8) + bx / 8 : bx; }
    F.ctl = (gu32*)(A.ws + WS_CTL);
    for (int u = F.tid; u < (LDS_BYTES - LDSCTL_OFF) / 4; u += NTHREADS) ((LAS unsigned*)(F.lds + LDSCTL_OFF))[u] = 0u;
    __syncthreads();
    XcdBarrier bar = xcd_barrier_post((unsigned*)(F.ctl + CW_BAR), F.MISC + 8);
#define GRID_BAR() do { xcd_barrier(bar); int t_ = threadIdx.x; asm volatile("" : "+v"(t_)); F.tid = t_; F.lane = t_ & 63; F.wave = __builtin_amdgcn_readfirstlane(t_ >> 6); } while (0)
    unsigned char* ws = A.ws;

    REPS(0) if (PH(0)) { p0a_mod(F, A); p0b_prologue<0>(F, A); }
    GRID_BAR();
    REPS(1) if (PH(1)) p0b_prologue<1>(F, A);
    GRID_BAR();
    REPS(2) if (PH(2)) {
        pg8::Gemm g{(const bf16*)(ws + WS_XG), nullptr, (const bf16*)(ws + WS_WIN), nullptr, D, D, D};
        pg8::StaticOrder S; S.init(T, INW, F.G, (int)blockIdx.x);
        pg8::EpiIn E{(bf16*)(ws + WS_QKVP), (bf16*)(ws + WS_GAB), (const float*)(ws + WS_RSTD1), (const float*)(ws + WS_BIAS1P), (float*)(ws + WS_KSUM)};
        pg8::gemm_phase<pg8::EpiIn, pg8::StaticOrder, true, true>(F.lds + RING_OFF, g, S, E);
    }
    GRID_BAR();
    REPS(3) if (PH(3)) {
        const attn_body::AttnTensors AT{(const attn_body::bf16*)(ws + WS_QKVP), (const attn_body::bf16*)(ws + WS_QKVP) + (size_t)T * 512, (const attn_body::bf16*)(ws + WS_QKVP) + (size_t)2 * T * 512, (PROBE_DOUBLE == 3 && rep_ == 0) ? (attn_body::bf16*)(ws + WS_XG) : (attn_body::bf16*)(ws + WS_QKVP)};
        const attn_body::StaticOrder S((int)F.G, F.vcu);
        attn_body::attn_phase<attn_body::StaticOrder>((char*)lds + RING_OFF, AT, (const float*)(ws + WS_KSUM), S);
    }
    REPS(4) if (PH(4)) pooled_phase(F, A);
    GRID_BAR();
    REPS(5) if (PH(5)) {
        pg8::Gemm g{(const bf16*)(ws + WS_QKVP), (const bf16*)(ws + WS_POOLED), (const bf16*)(ws + WS_WA), (const bf16*)(ws + WS_WP), AW, AW, AW};
        pg8::DualOrder S; S.init(T, D, F.G, (int)blockIdx.x);
        pg8::EpiUp E{(bf16*)(ws + WS_XG), (const bf16*)(ws + WS_GAB), (const float*)(ws + WS_BPRIME)};
        pg8::gemm_phase<pg8::EpiUp, pg8::DualOrder, true, true>(F.lds + RING_OFF, g, S, E);
    }
    GRID_BAR();
    REPS(6) if (PH(6)) {
        pg8::Gemm g{(const bf16*)(ws + WS_XG), nullptr, (const bf16*)(ws + WS_WOUT), nullptr, D, D, D};
        pg8::StaticOrder S; S.init(T, D, F.G, (int)blockIdx.x);
        pg8::EpiOut E{A.in[0], A.out, (bf16*)(ws + WS_QKVP), (const float*)(ws + WS_MODF), A.in[12], (float*)(ws + WS_SS2)};
        pg8::gemm_phase<pg8::EpiOut, pg8::StaticOrder, true, true>(F.lds + RING_OFF, g, S, E);
    }
    GRID_BAR();
    REPS(7) if (PH(7)) {
        pg8::Gemm g{(const bf16*)(ws + WS_QKVP), nullptr, (const bf16*)(ws + WS_WQ), nullptr, D, D, D};
        pg8::StaticOrder S; S.init(T, PQW, F.G, (int)blockIdx.x);
        pg8::EpiPq E{(bf16*)(ws + WS_GAB), (const float*)(ws + WS_SS2), (const float*)(ws + WS_BIAS2P)};
        pg8::gemm_phase<pg8::EpiPq, pg8::StaticOrder, true, true>(F.lds + RING_OFF, g, S, E);
    }
    GRID_BAR();
    REPS(8) if (PH(8)) router_phase(F, A);
    GRID_BAR();
    if (PH(9)) peer_sliced_phase(F, A);
}

extern "C" void kernel_launch(void* const* d_in, const int* in_sizes, int n_in, void* d_out, int out_size, void* d_ws, size_t ws_size, hipStream_t stream) {
    static int grid = 0;
    if (grid == 0) {
        if (n_in != 18 || in_sizes[0] != T * D || out_size != T * D || ws_size < WS_END) { fprintf(stderr, "kernel_launch: unexpected shapes (n_in %d, in0 %d, out %d, ws %zu); nothing launched\n", n_in, n_in > 0 ? in_sizes[0] : -1, out_size, ws_size); grid = -1; return; }
        int dev = 0, cus = 0, per_cu = 0;
        if (hipGetDevice(&dev) != hipSuccess || hipDeviceGetAttribute(&cus, hipDeviceAttributeMultiprocessorCount, dev) != hipSuccess) { grid = -1; return; }
        if (hipFuncSetAttribute((const void*)fwd_megakernel, hipFuncAttributeMaxDynamicSharedMemorySize, LDS_BYTES) != hipSuccess) { fprintf(stderr, "kernel_launch: hipFuncSetAttribute failed\n"); grid = -1; return; }
        if (hipOccupancyMaxActiveBlocksPerMultiprocessor(&per_cu, (const void*)fwd_megakernel, NTHREADS, LDS_BYTES) != hipSuccess || per_cu < 1) { fprintf(stderr, "kernel_launch: occupancy query reports %d workgroups per CU\n", per_cu); per_cu = 1; }
        (void)hipGetLastError();
        grid = cus;
    }
    if (grid < 0) return;
    if (hipMemsetAsync((char*)d_ws + WS_CTL, 0, CTL_ZERO_BYTES, stream) != hipSuccess) { fprintf(stderr, "kernel_launch: hipMemsetAsync failed\n"); return; }
    Args a{};
    for (int i = 0; i < 18; ++i) a.in[i] = (const float*)d_in[i];
    a.out = (float*)d_out; a.ws = (unsigned char*)d_ws;
    void* kargs[] = {&a};
    hipError_t e = hipLaunchCooperativeKernel((const void*)fwd_megakernel, dim3(grid), dim3(NTHREADS), kargs, LDS_BYTES, stream);
    if (e != hipSuccess) fprintf(stderr, "kernel_launch: cooperative launch failed: %s (grid %d)\n", hipGetErrorString(e), grid);
}
```

```cpp
#include <hip/hip_runtime.h>
#include <hip/hip_bf16.h>
#include <cstdio>
#include <cstdint>
#include <cmath>

constexpr int NB = 8, SEQ = 4096, T = NB * SEQ, D = 1024;
constexpr int AW = 512, PW = 512, INW = 4096;
constexpr int NH = 8, HD = 64, MBLK = 256, NBLK = SEQ / MBLK;
constexpr int PQW = 2048, PEXP = 16384, PTOP = 16, PHEADS = 8, PSEL = PHEADS * PTOP;
constexpr float RMS_EPS = 1e-6f;
constexpr float LOG2E = 1.4426950408889634f;
constexpr float QSCALE = 0.125f * LOG2E;
constexpr int NWAVES = 8, NTHREADS = 512;

namespace pg8 {
#define PG8_LAS __attribute__((address_space(3)))
typedef unsigned short bf16_t;
typedef short bf16x8 __attribute__((ext_vector_type(8)));
typedef float f32x4 __attribute__((ext_vector_type(4)));
typedef unsigned u32x4 __attribute__((ext_vector_type(4)));
constexpr int BM = 256, BK = 64, HALF = 128, HTB = HALF * BK * 2  , STAGE_BYTES = 8 * HTB, NXCD = 8, WGM = 8;

__host__ __device__ __forceinline__ int lds_byte(int r, int c) { const int st = (r >> 4) * 2 + (c >> 5), rr = r & 15, cc = c & 31, ob = rr * 64 + cc * 2; return st * 1024 + (ob ^ (((ob >> 9) & 1) << 5)); }
__host__ __device__ __forceinline__ void stage_rc(int b, int& R, int& C) { const int st = b / 1024, sb = b % 1024, swz = sb ^ (((sb >> 9) & 1) << 5); R = (st >> 1) * 16 + swz / 64; C = (st & 1) * 32 + (swz % 64) / 2; }
__host__ __device__ __forceinline__ int perm32(int rho) { const int n = rho >> 4, i = rho & 15; return 8 * (i >> 2) + 4 * n + (i & 3); }

struct Unit { int pm, pn, part; };
struct Gemm {
    const bf16_t* A0; const bf16_t* A1; const bf16_t* B0; const bf16_t* B1; int lda, ldb, K;
    __device__ __forceinline__ const char* a_ptr(const Unit& u) const { return (const char*)(u.part ? A1 : A0) + (size_t)u.pm * BM * lda * 2; }
    __device__ __forceinline__ const char* b_ptr(const Unit& u) const { return (const char*)(u.part ? B1 : B0) + (size_t)u.pn * BM * ldb * 2; }
};

struct StaticOrder {
    int nM, nN, nwg, G, c;
    __host__ __device__ void init(int M, int N, int G_, int c_) { nM = M / BM; nN = N / BM; nwg = nM * nN; G = G_; c = c_; }
    __host__ __device__ bool tile(long L, Unit& u) const {
        if (L >= nwg) return false;
        int wgid = (int)L; { const int q = nwg / NXCD, r = nwg % NXCD, xcd = wgid % NXCD, off = wgid / NXCD; wgid = (xcd < r ? xcd * (q + 1) : r * (q + 1) + (xcd - r) * q) + off; }
        const int nig = WGM * nN, gid = wgid / nig, fm = gid * WGM, gsz = (nM - fm) < WGM ? (nM - fm) : WGM;
        u.pm = fm + ((wgid % nig) % gsz); u.pn = (wgid % nig) / gsz; u.part = 0; return true;
    }
    __host__ __device__ bool next(int i, Unit& u) const { return tile((long)i * G + c, u); }
    __device__ __forceinline__ void a_ready(const Unit&) const {}
    __device__ __forceinline__ void done(const Unit&) const {}
};
struct DualOrder {
    StaticOrder so;
    __host__ __device__ void init(int M, int N, int G_, int c_) { so.init(M, N, G_, c_); }
    __host__ __device__ bool next(int i, Unit& u) const { if (!so.tile((long)(i >> 1) * so.G + so.c, u)) return false; u.part = i & 1; return true; }
    __device__ __forceinline__ void a_ready(const Unit&) const {}
    __device__ __forceinline__ void done(const Unit&) const {}
};

__device__ __forceinline__ unsigned cvt_pk_bf16(float lo, float hi) { unsigned r; asm volatile("v_cvt_pk_bf16_f32 %0, %1, %2" : "=v"(r) : "v"(lo), "v"(hi)); return r; }
__device__ __forceinline__ float bf_lo(unsigned w) { return __uint_as_float(w << 16); }
__device__ __forceinline__ float bf_hi(unsigned w) { return __uint_as_float(w & 0xffff0000u); }
__device__ __forceinline__ float sigmoidf_(float x) { return __builtin_amdgcn_rcpf(1.0f + __builtin_amdgcn_exp2f(-x * 1.4426950408889634f)); }


struct EpiIn {
    static constexpr bool PERM = true, AFTER_DRAIN = false;
    bf16_t* QKVP; bf16_t* GAB; const float* rstd1; const float* bias1p; float* ksum; unsigned* nrm;
    __device__ __forceinline__ void operator()(const f32x4 (&acc)[2][2][4][2], const Unit& u, int wr, int wc, int fr, int fq) const {
        bf16_t* base; int ldc, col0;
        if (u.pn < 8) { base = QKVP + (size_t)(u.pn >> 1) * T * 512; ldc = 512; col0 = (u.pn & 1) * 256; }
        else { base = GAB + (size_t)((u.pn - 8) >> 2) * T * 1024; ldc = 1024; col0 = ((u.pn - 8) & 3) * 256; }
        const float sc = (u.pn < 2) ? QSCALE : 1.0f;
        const int b = u.pm >> 4;
        const int bcol = u.pn * 256 + wc * 32 + 8 * fq;
        f32x4 bv[2][2];
#pragma unroll
        for (int bj = 0; bj < 2; ++bj)
#pragma unroll
            for (int n = 0; n < 2; ++n) { f32x4 s = (f32x4){0.f, 0.f, 0.f, 0.f};
#pragma unroll
                for (int kc = 0; kc < 8; ++kc) s += *(const f32x4*)(bias1p + (size_t)(kc * 8 + b) * INW + bcol + bj * HALF + 4 * n);
                bv[bj][n] = s; }
        const bool isk = (u.pn == 2 || u.pn == 3); const bool isqk = (u.pn < 4); float nmax[2] = {0.f, 0.f};
        f32x4 ks[2][2];
#pragma unroll
        for (int bj = 0; bj < 2; ++bj)
#pragma unroll
            for (int n = 0; n < 2; ++n) ks[bj][n] = (f32x4){0.f, 0.f, 0.f, 0.f};
        const int row0 = u.pm * BM + wr * 64 + fr;
#pragma unroll
        for (int ai = 0; ai < 2; ++ai)
#pragma unroll
            for (int m = 0; m < 4; ++m) { const int row = row0 + ai * HALF + m * 16; const float rs = rstd1[row];
                bf16_t* rowp = base + (size_t)row * ldc + col0 + wc * 32 + 8 * fq;
#pragma unroll
                for (int bj = 0; bj < 2; ++bj) { f32x4 v0 = acc[ai][bj][m][0] * rs + bv[bj][0], v1 = acc[ai][bj][m][1] * rs + bv[bj][1];
                    ks[bj][0] += v0; ks[bj][1] += v1;
                    v0 = v0 * sc; v1 = v1 * sc;
                    if (isqk) { float ss = (v0[0] * v0[0] + v0[1] * v0[1]) + (v0[2] * v0[2] + v0[3] * v0[3]) + (v1[0] * v1[0] + v1[1] * v1[1]) + (v1[2] * v1[2] + v1[3] * v1[3]); ss += __shfl_xor(ss, 16); ss += __shfl_xor(ss, 32); nmax[bj] = fmaxf(nmax[bj], ss); }
                    u32x4 w; w.x = cvt_pk_bf16(v0[0], v0[1]); w.y = cvt_pk_bf16(v0[2], v0[3]); w.z = cvt_pk_bf16(v1[0], v1[1]); w.w = cvt_pk_bf16(v1[2], v1[3]);
                    *(u32x4*)(rowp + bj * HALF) = w; } }
        if (isqk) {
#pragma unroll
            for (int bj = 0; bj < 2; ++bj) { float v = nmax[bj]; v = fmaxf(v, __shfl_xor(v, 1)); v = fmaxf(v, __shfl_xor(v, 2)); v = fmaxf(v, __shfl_xor(v, 4)); v = fmaxf(v, __shfl_xor(v, 8));
                if (fr == 0 && fq == 0) atomicMax(nrm + (size_t)(b * 2 + (u.pn >> 1)) * 16 + (u.pn & 1) * 8 + bj * 4 + wc, __float_as_uint(v)); }
        }
        if (isk) {
#pragma unroll
            for (int bj = 0; bj < 2; ++bj)
#pragma unroll
                for (int n = 0; n < 2; ++n)
#pragma unroll
                    for (int e = 0; e < 4; ++e) { float v = ks[bj][n][e]; v += __shfl_xor(v, 1); v += __shfl_xor(v, 2); v += __shfl_xor(v, 4); v += __shfl_xor(v, 8); ks[bj][n][e] = v; }
            if (fr == 0) { float* kp = ksum + (size_t)u.pm * 512 + (u.pn - 2) * 256 + wc * 32 + 8 * fq;
#pragma unroll
                for (int bj = 0; bj < 2; ++bj)
#pragma unroll
                    for (int n = 0; n < 2; ++n)
#pragma unroll
                        for (int e = 0; e < 4; ++e) atomicAdd(kp + bj * HALF + 4 * n + e, ks[bj][n][e]); }
        }
    }
};

struct EpiUp {
    static constexpr bool PERM = true, AFTER_DRAIN = false;
    bf16_t* merged; const bf16_t* GAB; const float* bprime;
    __device__ __forceinline__ void operator()(const f32x4 (&acc)[2][2][4][2], const Unit& u, int wr, int wc, int fr, int fq) const {
        const int row0 = u.pm * BM + wr * 64 + fr, colb = u.pn * BM + wc * 32 + 8 * fq;
        const bf16_t* gate = GAB + (size_t)u.part * T * 1024;
        f32x4 bv[2][2];
#pragma unroll
        for (int bj = 0; bj < 2; ++bj)
#pragma unroll
            for (int n = 0; n < 2; ++n) { f32x4 s_ = (f32x4){0.f, 0.f, 0.f, 0.f}; if (u.part) { _Pragma("unroll") for (int g_ = 0; g_ < 4; ++g_) s_ += *(const f32x4*)(bprime + g_ * 1024 + colb + bj * HALF + 4 * n); } bv[bj][n] = s_; }
#pragma unroll
        for (int ai = 0; ai < 2; ++ai) {
            u32x4 gpre[4][2], ppre[4][2];
#pragma unroll
            for (int m = 0; m < 4; ++m) { const size_t off = (size_t)(row0 + ai * HALF + m * 16) * 1024 + colb;
#pragma unroll
                for (int bj = 0; bj < 2; ++bj) { gpre[m][bj] = __builtin_nontemporal_load((const u32x4*)(gate + off + bj * HALF));
                    if (u.part) ppre[m][bj] = __builtin_nontemporal_load((const u32x4*)(merged + off + bj * HALF)); else ppre[m][bj] = (u32x4){0u, 0u, 0u, 0u}; } }
#pragma unroll
            for (int m = 0; m < 4; ++m) { const size_t off = (size_t)(row0 + ai * HALF + m * 16) * 1024 + colb;
#pragma unroll
                for (int bj = 0; bj < 2; ++bj) {
                    const u32x4 gw = gpre[m][bj], pw = ppre[m][bj];
                    f32x4 v0 = acc[ai][bj][m][0] + bv[bj][0], v1 = acc[ai][bj][m][1] + bv[bj][1];
                    v0[0] *= sigmoidf_(bf_lo(gw.x)); v0[1] *= sigmoidf_(bf_hi(gw.x)); v0[2] *= sigmoidf_(bf_lo(gw.y)); v0[3] *= sigmoidf_(bf_hi(gw.y));
                    v1[0] *= sigmoidf_(bf_lo(gw.z)); v1[1] *= sigmoidf_(bf_hi(gw.z)); v1[2] *= sigmoidf_(bf_lo(gw.w)); v1[3] *= sigmoidf_(bf_hi(gw.w));
                    v0[0] += bf_lo(pw.x); v0[1] += bf_hi(pw.x); v0[2] += bf_lo(pw.y); v0[3] += bf_hi(pw.y); v1[0] += bf_lo(pw.z); v1[1] += bf_hi(pw.z); v1[2] += bf_lo(pw.w); v1[3] += bf_hi(pw.w);
                    u32x4 w; w.x = cvt_pk_bf16(v0[0], v0[1]); w.y = cvt_pk_bf16(v0[2], v0[3]); w.z = cvt_pk_bf16(v1[0], v1[1]); w.w = cvt_pk_bf16(v1[2], v1[3]);
                    *(u32x4*)(merged + off + bj * HALF) = w; } }
        }
        if (u.part == 0) asm volatile("s_waitcnt vmcnt(0)" ::: "memory");
    }
};

struct EpiOut {
    static constexpr bool PERM = true, AFTER_DRAIN = false;
    const float* x; float* x1; bf16_t* A2; const float* modf; const float* g2; float* ss2;
    __device__ __forceinline__ void operator()(const f32x4 (&acc)[2][2][4][2], const Unit& u, int wr, int wc, int fr, int fq) const {
        const int row0 = u.pm * BM + wr * 64 + fr, colb = u.pn * BM + wc * 32 + 8 * fq, b = u.pm >> 4;
        f32x4 gt[2][2], gg[2][2];
#pragma unroll
        for (int bj = 0; bj < 2; ++bj)
#pragma unroll
            for (int n = 0; n < 2; ++n) { const int c = colb + bj * HALF + 4 * n; gt[bj][n] = *(const f32x4*)(modf + (size_t)b * 6144 + 2048 + c);
                const f32x4 sc2 = *(const f32x4*)(modf + (size_t)b * 6144 + 4096 + c); gg[bj][n] = *(const f32x4*)(g2 + c) * (sc2 + 1.0f); }
#pragma unroll
        for (int ai = 0; ai < 2; ++ai) {
#pragma unroll
          for (int mh = 0; mh < 2; ++mh) {
            f32x4 xr[2][2][2];
#pragma unroll
            for (int m2 = 0; m2 < 2; ++m2) { const size_t off = (size_t)(row0 + ai * HALF + (2 * mh + m2) * 16) * 1024 + colb;
#pragma unroll
                for (int bj = 0; bj < 2; ++bj) { xr[m2][bj][0] = __builtin_nontemporal_load((const f32x4*)(x + off + bj * HALF)); xr[m2][bj][1] = __builtin_nontemporal_load((const f32x4*)(x + off + bj * HALF + 4)); } }
#pragma unroll
            for (int m2 = 0; m2 < 2; ++m2) { const int m = 2 * mh + m2; const int row = row0 + ai * HALF + m * 16; const size_t off = (size_t)row * 1024 + colb; float ssq = 0.f;
#pragma unroll
                for (int bj = 0; bj < 2; ++bj) {
                    const f32x4 y0 = xr[m2][bj][0] + gt[bj][0] * acc[ai][bj][m][0], y1 = xr[m2][bj][1] + gt[bj][1] * acc[ai][bj][m][1];
                    *(f32x4*)(x1 + off + bj * HALF) = y0; *(f32x4*)(x1 + off + bj * HALF + 4) = y1;
                    ssq += (y0[0] * y0[0] + y0[1] * y0[1]) + (y0[2] * y0[2] + y0[3] * y0[3]) + (y1[0] * y1[0] + y1[1] * y1[1]) + (y1[2] * y1[2] + y1[3] * y1[3]);
                    const f32x4 a0 = y0 * gg[bj][0], a1 = y1 * gg[bj][1];
                    u32x4 w; w.x = cvt_pk_bf16(a0[0], a0[1]); w.y = cvt_pk_bf16(a0[2], a0[3]); w.z = cvt_pk_bf16(a1[0], a1[1]); w.w = cvt_pk_bf16(a1[2], a1[3]);
                    *(u32x4*)(A2 + off + bj * HALF) = w; }
                ssq += __shfl_xor(ssq, 16); ssq += __shfl_xor(ssq, 32);
                if (fq == 0) ss2[(size_t)row * 16 + u.pn * 4 + wc] = ssq; }
          }
        }
    }
};

struct EpiPq {
    static constexpr bool PERM = true, AFTER_DRAIN = false;
    bf16_t* QP; const float* ss2; const float* bias2p;
    __device__ __forceinline__ void operator()(const f32x4 (&acc)[2][2][4][2], const Unit& u, int wr, int wc, int fr, int fq) const {
        const int row0 = u.pm * BM + wr * 64 + fr, colb = u.pn * BM + wc * 32 + 8 * fq, b = u.pm >> 4;
        f32x4 bv[2][2];
#pragma unroll
        for (int bj = 0; bj < 2; ++bj)
#pragma unroll
            for (int n = 0; n < 2; ++n) { f32x4 s = (f32x4){0.f, 0.f, 0.f, 0.f};
#pragma unroll
                for (int kc = 0; kc < 8; ++kc) s += *(const f32x4*)(bias2p + (size_t)(kc * 8 + b) * PQW + colb + bj * HALF + 4 * n);
                bv[bj][n] = s; }
#pragma unroll
        for (int ai = 0; ai < 2; ++ai)
#pragma unroll
            for (int m = 0; m < 4; ++m) { const int row = row0 + ai * HALF + m * 16;
                const f32x4* sp = (const f32x4*)(ss2 + (size_t)row * 16); const f32x4 s4 = (sp[0] + sp[1]) + (sp[2] + sp[3]);
                const float rs = __builtin_amdgcn_rsqf(((s4[0] + s4[1]) + (s4[2] + s4[3])) * (1.0f / D) + RMS_EPS);
                bf16_t* rowp = QP + (size_t)row * PQW + colb;
#pragma unroll
                for (int bj = 0; bj < 2; ++bj) { const f32x4 v0 = acc[ai][bj][m][0] * rs + bv[bj][0], v1 = acc[ai][bj][m][1] * rs + bv[bj][1];
                    u32x4 w; w.x = cvt_pk_bf16(v0[0], v0[1]); w.y = cvt_pk_bf16(v0[2], v0[3]); w.z = cvt_pk_bf16(v1[0], v1[1]); w.w = cvt_pk_bf16(v1[2], v1[3]);
                    *(u32x4*)(rowp + bj * HALF) = w; } }
    }
};

template <class Epi, class Sched, bool ALIGN_EPI = false, bool SP2 = false>
__device__ __forceinline__ void gemm_phase(PG8_LAS unsigned char* lds, const Gemm g, const Sched& S, const Epi& E) {
    int tid_ = threadIdx.x; asm volatile("" : "+v"(tid_));
    const int tid = tid_, wid = __builtin_amdgcn_readfirstlane(tid >> 6), lane = tid & 63, wr = wid >> 2, wc = wid & 3, fr = lane & 15, fq = lane >> 4;
    const int K = g.K, nt = K / BK, lda = g.lda, ldb = g.ldb;
    unsigned voffA[2], voffB[2];
#pragma unroll
    for (int i = 0; i < 2; ++i) { int R, C; stage_rc(tid * 16 + i * 8192, R, C); const int Rb = Epi::PERM ? ((R & ~31) + perm32(R & 31)) : R;
        voffA[i] = (unsigned)(R * lda + C) * 2u; voffB[i] = (unsigned)(Rb * ldb + C) * 2u; }
    const size_t kstep = (size_t)(BK * 2);
    const size_t hstepA = (size_t)HALF * lda * 2, hstepB = (size_t)HALF * ldb * 2;
    const unsigned ldsw = (unsigned)wid * 1024u;
    const int aoff = lds_byte(wr * 64 + fr, fq * 8), boff = lds_byte(wc * 32 + fr, fq * 8);
#define PG8_SA(b, h) (((b) * 2 + (h)) * HTB)
#define PG8_SB(b, h) ((4 + (b) * 2 + (h)) * HTB)
#define PG8_STAGE(bufoff, gbase, voff) do { _Pragma("unroll") for (int _i = 0; _i < 2; ++_i) \
        __builtin_amdgcn_global_load_lds((const unsigned*)((const char*)(gbase) + (voff)[_i]), (PG8_LAS unsigned*)(lds + (bufoff) + ldsw + _i * 8192), 16, 0, 0); } while (0)
#define PG8_LDA(dst, b, h) do { _Pragma("unroll") for (int m = 0; m < 4; ++m) _Pragma("unroll") for (int k = 0; k < 2; ++k) dst[m][k] = *(const PG8_LAS bf16x8*)(lds + PG8_SA(b, h) + aoff + m * 2048 + k * 1024); } while (0)
#define PG8_LDB(dst, b, h) do { _Pragma("unroll") for (int n = 0; n < 2; ++n) _Pragma("unroll") for (int k = 0; k < 2; ++k) dst[n][k] = *(const PG8_LAS bf16x8*)(lds + PG8_SB(b, h) + boff + n * 2048 + k * 1024); } while (0)
#define PG8_MMA(ai, bj, At, Bt) do { __builtin_amdgcn_s_setprio(1); _Pragma("unroll") for (int m = 0; m < 4; ++m) _Pragma("unroll") for (int n = 0; n < 2; ++n) _Pragma("unroll") for (int k = 0; k < 2; ++k) \
        acc[ai][bj][m][n] = __builtin_amdgcn_mfma_f32_16x16x32_bf16(Bt[n][k], At[m][k], acc[ai][bj][m][n], 0, 0, 0); __builtin_amdgcn_s_setprio(0); } while (0)
#define PG8_WAIT_V(n) asm volatile("s_waitcnt vmcnt(" #n ")" ::: "memory")
#define PG8_WAIT_L(n) asm volatile("s_waitcnt lgkmcnt(" #n ")" ::: "memory")
#define PG8_BAR __builtin_amdgcn_s_barrier()
#define PG8_SCHED __builtin_amdgcn_sched_barrier(0)
    Unit cur, nxt; int ui = 0;
    if (!S.next(0, cur)) return;
    f32x4 acc[2][2][4][2];
#pragma unroll
    for (int a = 0; a < 2; ++a)
#pragma unroll
        for (int b = 0; b < 2; ++b)
#pragma unroll
            for (int m = 0; m < 4; ++m)
#pragma unroll
                for (int n = 0; n < 2; ++n) acc[a][b][m][n] = (f32x4){0.f, 0.f, 0.f, 0.f};
    bf16x8 At[4][2], B0[2][2], B1[2][2];
    const char* cA = g.a_ptr(cur); const char* cB = g.b_ptr(cur);
    S.a_ready(cur);
    if constexpr (SP2) {
        PG8_STAGE(PG8_SB(0, 0), cB, voffB); PG8_STAGE(PG8_SB(0, 1), cB + hstepB, voffB); PG8_STAGE(PG8_SA(0, 0), cA, voffA); PG8_STAGE(PG8_SA(0, 1), cA + hstepA, voffA);
        if (wr == 1) PG8_BAR;
        PG8_WAIT_V(2); PG8_BAR;
        PG8_STAGE(PG8_SB(1, 0), cB + kstep, voffB); PG8_STAGE(PG8_SA(1, 0), cA + kstep, voffA); PG8_STAGE(PG8_SB(1, 1), cB + hstepB + kstep, voffB);
        PG8_WAIT_V(6); PG8_BAR;
    } else {
        PG8_STAGE(PG8_SB(0, 0), cB, voffB); PG8_STAGE(PG8_SA(0, 0), cA, voffA); PG8_STAGE(PG8_SB(0, 1), cB + hstepB, voffB); PG8_STAGE(PG8_SA(0, 1), cA + hstepA, voffA);
        if (wr == 1) PG8_BAR;
        PG8_WAIT_V(4); PG8_BAR;
        PG8_STAGE(PG8_SB(1, 0), cB + kstep, voffB); PG8_STAGE(PG8_SA(1, 0), cA + kstep, voffA); PG8_STAGE(PG8_SB(1, 1), cB + hstepB + kstep, voffB);
        PG8_WAIT_V(6); PG8_BAR;
    }
    for (;;) {
        const bool has_next = S.next(ui + 1, nxt);
        const char* nA = has_next ? g.a_ptr(nxt) : cA; const char* nB = has_next ? g.b_ptr(nxt) : cB;
        for (int t = 0; t < nt; t += 2) {
            const bool last = (t == nt - 2);
            const char* a1 = cA + (size_t)(t + 1) * kstep;
            const char* a2 = last ? nA : cA + (size_t)(t + 2) * kstep; const char* b2 = last ? nB : cB + (size_t)(t + 2) * kstep;
            const char* a3 = a2 + kstep; const char* b3 = b2 + kstep;
            if (last && has_next) S.a_ready(nxt);
            if constexpr (SP2) {
            PG8_LDB(B0, 0, 0); PG8_LDB(B1, 0, 1); PG8_SCHED; PG8_LDA(At, 0, 0); PG8_STAGE(PG8_SA(1, 1), a1 + hstepA, voffA);
            PG8_WAIT_V(8); PG8_WAIT_L(0); PG8_BAR; PG8_MMA(0, 0, At, B0); PG8_MMA(0, 1, At, B1); PG8_BAR; PG8_SCHED;
            PG8_LDA(At, 0, 1); PG8_STAGE(PG8_SB(0, 0), b2, voffB); PG8_STAGE(PG8_SB(0, 1), b2 + hstepB, voffB); PG8_STAGE(PG8_SA(0, 0), a2, voffA);
            PG8_WAIT_V(8); PG8_WAIT_L(0); PG8_BAR; PG8_MMA(1, 0, At, B0); PG8_MMA(1, 1, At, B1); PG8_BAR; PG8_SCHED;
            PG8_LDB(B0, 1, 0); PG8_LDB(B1, 1, 1); PG8_SCHED; PG8_LDA(At, 1, 0); PG8_STAGE(PG8_SA(0, 1), a2 + hstepA, voffA);
            PG8_WAIT_V(8); PG8_WAIT_L(0); PG8_BAR; PG8_MMA(0, 0, At, B0); PG8_MMA(0, 1, At, B1); PG8_BAR; PG8_SCHED;
            PG8_LDA(At, 1, 1); PG8_STAGE(PG8_SB(1, 0), b3, voffB); PG8_STAGE(PG8_SB(1, 1), b3 + hstepB, voffB); PG8_STAGE(PG8_SA(1, 0), a3, voffA);
            PG8_WAIT_V(8); PG8_WAIT_L(0); PG8_BAR; PG8_MMA(1, 0, At, B0); PG8_MMA(1, 1, At, B1); PG8_BAR; PG8_SCHED;
            } else {
            PG8_LDB(B0, 0, 0); PG8_SCHED; PG8_LDA(At, 0, 0); PG8_STAGE(PG8_SA(1, 1), a1 + hstepA, voffA);
            PG8_WAIT_L(8); PG8_BAR; PG8_WAIT_L(0); PG8_MMA(0, 0, At, B0); PG8_BAR; PG8_SCHED;
            PG8_LDB(B1, 0, 1); PG8_STAGE(PG8_SB(0, 0), b2, voffB);
            PG8_BAR; PG8_WAIT_L(0); PG8_MMA(0, 1, At, B1); PG8_BAR;
            PG8_LDA(At, 0, 1); PG8_STAGE(PG8_SA(0, 0), a2, voffA);
            PG8_BAR; PG8_WAIT_L(0); PG8_MMA(1, 0, At, B0); PG8_BAR; PG8_SCHED;
            PG8_STAGE(PG8_SB(0, 1), b2 + hstepB, voffB);
            PG8_WAIT_V(6); PG8_BAR; PG8_MMA(1, 1, At, B1); PG8_BAR;
            PG8_LDB(B0, 1, 0); PG8_SCHED; PG8_LDA(At, 1, 0); PG8_STAGE(PG8_SA(0, 1), a2 + hstepA, voffA);
            PG8_WAIT_L(8); PG8_BAR; PG8_WAIT_L(0); PG8_MMA(0, 0, At, B0); PG8_BAR; PG8_SCHED;
            PG8_LDB(B1, 1, 1); PG8_STAGE(PG8_SB(1, 0), b3, voffB);
            PG8_BAR; PG8_WAIT_L(0); PG8_MMA(0, 1, At, B1); PG8_BAR;
            PG8_LDA(At, 1, 1); PG8_STAGE(PG8_SA(1, 0), a3, voffA);
            PG8_BAR; PG8_WAIT_L(0); PG8_MMA(1, 0, At, B0); PG8_BAR; PG8_SCHED;
            PG8_STAGE(PG8_SB(1, 1), b3 + hstepB, voffB);
            PG8_WAIT_V(6); PG8_BAR; PG8_MMA(1, 1, At, B1); PG8_BAR;
            }
        }
        if constexpr (ALIGN_EPI) { if (wr == 0) PG8_BAR; }
        if constexpr (!Epi::AFTER_DRAIN) { E(acc, cur, wr, wc, fr, fq); S.done(cur); }
        if (!has_next) break;
#pragma unroll
        for (int a = 0; a < 2; ++a)
#pragma unroll
            for (int b = 0; b < 2; ++b)
#pragma unroll
                for (int m = 0; m < 4; ++m)
#pragma unroll
                    for (int n = 0; n < 2; ++n) acc[a][b][m][n] = (f32x4){0.f, 0.f, 0.f, 0.f};
        cur = nxt; cA = nA; cB = nB; ++ui;
        if constexpr (ALIGN_EPI) { if (wr == 1) PG8_BAR; }
    }
    PG8_WAIT_V(0);
    if constexpr (!ALIGN_EPI) { if (wr == 0) PG8_BAR; }
    PG8_BAR;
    if constexpr (Epi::AFTER_DRAIN) { E.fused(acc, cur, wr, wc, fr, fq, lds, wid, lane); S.done(cur); }
#undef PG8_SA
#undef PG8_SB
#undef PG8_STAGE
#undef PG8_LDA
#undef PG8_LDB
#undef PG8_MMA
#undef PG8_WAIT_V
#undef PG8_WAIT_L
#undef PG8_BAR
#undef PG8_SCHED
}
}

constexpr size_t MiB = 1u << 20;
constexpr size_t WS_CTL = 0, CTL_ZERO_BYTES = 32 * 1024;
constexpr size_t WS_KSUM = 256 * 1024;
constexpr size_t WS_MODP = 1 * MiB;
constexpr size_t WS_MODF = WS_MODP + 8 * 8 * 6144 * 4;
constexpr size_t WS_BIAS1P = 3 * MiB;
constexpr size_t WS_BIAS2P = 4 * MiB;
constexpr size_t WS_BPRIME = 4 * MiB + 512 * 1024;
constexpr size_t WS_RSTD1 = 5 * MiB;
constexpr size_t WS_SS2 = 6 * MiB;
constexpr size_t WS_SUBK = 8 * MiB;
constexpr size_t WS_WIN = 16 * MiB, WS_WA = 24 * MiB, WS_WP = 25 * MiB, WS_WOUT = 26 * MiB, WS_WQ = 28 * MiB;
constexpr size_t WS_U = 32 * MiB, WS_V = 64 * MiB;
constexpr size_t WS_XG = 96 * MiB;
constexpr size_t WS_H2Q = WS_XG, WS_HS = WS_XG + 32 * MiB;
constexpr size_t WS_QKVP = 160 * MiB;
constexpr size_t WS_GAB = 288 * MiB;
constexpr size_t WS_POOLED = 416 * MiB;
constexpr size_t WS_END = 448 * MiB;
constexpr int CW_TMO = 0, CW_BAR = 4096;
constexpr int CW_NRM = 2048;

constexpr int RING_OFF = 0, RING_BYTES = 131072;
constexpr int LDS_BYTES = 147456;
constexpr int LDSCTL_OFF = LDS_BYTES - 512, MISC_OFF = LDSCTL_OFF + 320;

#define GAS __attribute__((address_space(1)))
#define LAS __attribute__((address_space(3)))
typedef unsigned short bf16;
typedef unsigned v4u __attribute__((ext_vector_type(4)));
typedef unsigned v2u __attribute__((ext_vector_type(2)));
typedef float f32x4 __attribute__((ext_vector_type(4)));
typedef GAS unsigned gu32;
#define RLX_AGENT __ATOMIC_RELAXED, __HIP_MEMORY_SCOPE_AGENT
#define LDS_WAIT() asm volatile("s_waitcnt lgkmcnt(0)" ::: "memory")
#define VM_WAIT() asm volatile("s_waitcnt vmcnt(0)" ::: "memory")
__device__ __forceinline__ unsigned f2bf(float f) { unsigned u = __builtin_bit_cast(unsigned, f); return (u + 0x7fffu + ((u >> 16) & 1u)) >> 16; }
__device__ __forceinline__ unsigned pk2(float lo, float hi) { return f2bf(lo) | (f2bf(hi) << 16); }
__device__ __forceinline__ float bflo(unsigned w) { return __uint_as_float(w << 16); }
__device__ __forceinline__ float bfhi(unsigned w) { return __uint_as_float(w & 0xffff0000u); }
__device__ __forceinline__ float wave_sum(float v) {
#pragma unroll
    for (int o = 1; o < 64; o <<= 1) v += __shfl_xor(v, o);
    return v;
}
__device__ __forceinline__ float wave_max(float v) {
#pragma unroll
    for (int o = 1; o < 64; o <<= 1) v = fmaxf(v, __shfl_xor(v, o));
    return v;
}

#define XB_TMO      128
#define XB_XCNT(j)  (256  + 64 * (j))
#define XB_XSUB(j)  (1280 + 64 * (j))
#define XB_XGEN(j)  (2304 + 64 * (j))
#define XB_TOP      3328
#define XB_TOPGEN   3392
#define XCD_BAR_WORDS 3456
#define XB_SPIN_CAP (1u << 22)

__device__ __forceinline__ unsigned xb_ld(unsigned* p)              { return __hip_atomic_load(p, __ATOMIC_RELAXED, __HIP_MEMORY_SCOPE_AGENT); }
__device__ __forceinline__ unsigned xb_add(unsigned* p, unsigned v) { return __hip_atomic_fetch_add(p, v, __ATOMIC_RELAXED, __HIP_MEMORY_SCOPE_AGENT); }
__device__ __forceinline__ unsigned xb_xcc_id() { return (unsigned)__builtin_amdgcn_s_getreg((3 << 11) | 20) & 0xFu; }
#define XB_SPIN(cond, bar) do { unsigned _sp = 0; while (cond) { __builtin_amdgcn_s_sleep(1); \
    if ((++_sp & 255u) == 0u) { if (xb_ld(&(bar)[XB_TMO])) break; if (_sp > XB_SPIN_CAP) { atomicAdd(&(bar)[XB_TMO], 1u); break; } } } } while (0)

struct XcdBarrier { unsigned* bar; unsigned x; volatile LAS unsigned* st; };

__device__ __forceinline__ XcdBarrier xcd_barrier_post(unsigned* bar, volatile LAS unsigned* st) {
    XcdBarrier b; b.bar = bar; b.x = xb_xcc_id(); b.st = st;
    if (threadIdx.x == 0) (void)xb_add(&bar[XB_XCNT(b.x)], 1u);
    return b;
}
__device__ __forceinline__ void xcd_barrier_complete(unsigned* bar, unsigned x, unsigned& nloc, unsigned& nx) {
    const unsigned G = gridDim.x * gridDim.y * gridDim.z;
    unsigned sum, cnt, mine, sp = 0u;
    for (;;) {
        sum = 0u; cnt = 0u; mine = 0u;
#pragma unroll
        for (unsigned j = 0; j < 16; ++j) { const unsigned c = xb_ld(&bar[XB_XCNT(j)]); sum += c; cnt += (c > 0u) ? 1u : 0u; mine = (j == x) ? c : mine; }
        if (sum == G) break;
        __builtin_amdgcn_s_sleep(1);
        if ((++sp & 255u) == 0u) { if (xb_ld(&bar[XB_TMO])) break; if (sp > XB_SPIN_CAP) { atomicAdd(&bar[XB_TMO], 1u); break; } }
    }
    nloc = mine > 0u ? mine : 1u; nx = cnt > 0u ? cnt : 1u;
}
__device__ __forceinline__ void xcd_barrier(const XcdBarrier& b) {
    asm volatile("s_waitcnt vmcnt(0)" ::: "memory");
    __syncthreads();
    if (threadIdx.x == 0) {
        unsigned* bar = b.bar;
        __builtin_amdgcn_s_waitcnt(0);
        unsigned nloc = b.st[0], nx = b.st[1];
        if (nloc == 0u) { xcd_barrier_complete(bar, b.x, nloc, nx); b.st[0] = nloc; b.st[1] = nx; }
        const unsigned old = xb_add(&bar[XB_XSUB(b.x)], 1u);
        const unsigned gen = old / nloc;
        if (old + 1u == (gen + 1u) * nloc) {
            __builtin_amdgcn_fence(__ATOMIC_RELEASE, "agent");
            asm volatile("s_waitcnt vmcnt(0)" ::: "memory");
            const unsigned og = xb_add(&bar[XB_TOP], 1u);
            const unsigned tg = og / nx;
            if (og + 1u == (tg + 1u) * nx) xb_add(&bar[XB_TOPGEN], 1u);
            else XB_SPIN(xb_ld(&bar[XB_TOPGEN]) == tg, bar);
            __builtin_amdgcn_fence(__ATOMIC_ACQUIRE, "agent");
            xb_add(&bar[XB_XGEN(b.x)], 1u);
            asm volatile("s_waitcnt vmcnt(0)" ::: "memory");
        } else {
            XB_SPIN(xb_ld(&bar[XB_XGEN(b.x)]) == gen, bar);
            __builtin_amdgcn_fence(__ATOMIC_ACQUIRE, "agent");
            asm volatile("s_waitcnt vmcnt(0)" ::: "memory");
        }
    }
    __syncthreads();
}

struct Frame {
    LAS unsigned char* lds;
    volatile LAS unsigned* MISC;
    gu32* ctl;
    int tid, lane, wave;
    int vcu, G;
};
struct Args { const float* in[18]; float* out; unsigned char* ws; };

__device__ __forceinline__ float modp_sum(const float* modp, int idx) {
    float s = 0.f;
#pragma unroll
    for (int kc = 0; kc < 8; ++kc) s += modp[(size_t)kc * 8 * 6144 + idx];
    return s;
}
template <int MODE>
__device__ __forceinline__ void p0_wg_dot(Frame& F, const float* cin, const float* modp, int soff, const float* W, int N, const float* addv, float* outp, int first, int ntask) {
    LAS float* scr = (LAS float*)(F.lds + RING_OFF + F.wave * 16384);
    const int ncn = N / 64;
    for (int it = first; it < ntask; it += F.G) {
        const int kc = it / ncn, nc = it % ncn, k0 = kc * 128 + F.wave * 16, n = nc * 64 + F.lane;
        float w[16];
#pragma unroll
        for (int kk = 0; kk < 16; ++kk) w[kk] = (MODE == 0) ? __builtin_nontemporal_load(W + (size_t)(k0 + kk) * N + n) : W[(size_t)(k0 + kk) * N + n];
#pragma unroll
        for (int j = 0; j < 2; ++j) { const int idx = F.lane + 64 * j, b = idx >> 4, kk = idx & 15;
            float cf; if (MODE == 0) { const float cv = cin[b * 1024 + k0 + kk]; cf = cv / (1.0f + __expf(-cv)); } else cf = modp_sum(modp, b * 6144 + soff + k0 + kk);
            scr[idx] = cf; }
        LDS_WAIT(); asm volatile("" ::: "memory");
#pragma unroll
        for (int b = 0; b < 8; ++b) { float s = 0.f;
#pragma unroll
            for (int kk = 0; kk < 16; ++kk) s += scr[b * 16 + kk] * w[kk];
            scr[256 + b * 64 + F.lane] = s; }
        __syncthreads();
        { const int b = F.wave; float s = (addv != nullptr && kc == 0) ? addv[n] : 0.f;
#pragma unroll
          for (int w8 = 0; w8 < 8; ++w8) s += ((LAS float*)(F.lds + RING_OFF + w8 * 16384))[256 + b * 64 + F.lane];
          outp[(size_t)(kc * 8 + b) * N + n] = s; }
        __syncthreads();
    }
}
__device__ __forceinline__ void p0a_mod(Frame& F, const Args& A) { p0_wg_dot<0>(F, A.in[1], nullptr, 0, A.in[2], 6144, A.in[3], (float*)(A.ws + WS_MODP), F.vcu, 8 * 96); }
__device__ __forceinline__ void p0_wp_task(Frame& F, const Args& A, int r) {
    LAS float* scr = (LAS float*)(F.lds + RING_OFF + F.wave * 16384);
    const int g = r >> 6, kq = (r >> 4) & 3, nc = r & 15, n = nc * 64 + F.lane, d0 = 16 * F.wave;
    const float* wmix = A.in[7] + (size_t)(g * 128 + 32 * kq) * 128 + d0; const float* scale = A.in[9] + g * 128 + d0; const float* wup = A.in[10] + (size_t)(g * 128 + d0) * D + n; const float* bmix = A.in[8] + g * 128 + d0;
    float wu[16];
#pragma unroll
    for (int d = 0; d < 16; ++d) wu[d] = wup[(size_t)d * D];
    float bp = 0.f;
#pragma unroll
    for (int d = 0; d < 16; ++d) { wu[d] *= scale[d]; bp += bmix[d] * wu[d]; }
#pragma unroll
    for (int kk = 0; kk < 32; ++kk) { float s = 0.f;
#pragma unroll
        for (int d = 0; d < 16; ++d) s += wmix[kk * 128 + d] * wu[d];
        scr[kk * 64 + F.lane] = s; }
    scr[2048 + F.lane] = bp;
    __syncthreads();
    { float s[4]; float bs = 0.f;
#pragma unroll
      for (int e = 0; e < 4; ++e) s[e] = 0.f;
#pragma unroll
      for (int w8 = 0; w8 < 8; ++w8) { const LAS float* o = (const LAS float*)(F.lds + RING_OFF + w8 * 16384);
#pragma unroll
          for (int e = 0; e < 4; ++e) s[e] += o[(4 * F.wave + e) * 64 + F.lane];
          bs += o[2048 + F.lane]; }
      v2u w; w.x = pk2(s[0], s[1]); w.y = pk2(s[2], s[3]);
      *(GAS v2u*)((bf16*)(A.ws + WS_WP) + (size_t)n * PW + g * 128 + 32 * kq + 4 * F.wave) = w;
      if (kq == 0 && F.wave == 0) ((float*)(A.ws + WS_BPRIME))[g * 1024 + n] = bs; }
    __syncthreads();
}

__device__ __forceinline__ void p0_transpose_item(const float* W, int K, int N, bf16* WT, int row_off, LAS float* scr, int item, int lane) {
    const int nblk = N / 32, kb = item / nblk, nb = item % nblk, k0 = 64 * kb, n0 = 32 * nb;
#pragma unroll 8
    for (int i = 0; i < 32; ++i) { const int kk = 2 * i + (lane >> 5); scr[kk * 33 + (lane & 31)] = __builtin_nontemporal_load(W + (size_t)(k0 + kk) * N + n0 + (lane & 31)); }
    LDS_WAIT(); asm volatile("" ::: "memory");
    const int c = lane & 7;
#pragma unroll
    for (int j = 0; j < 4; ++j) { const int n = (lane >> 3) + 8 * j; const LAS float* s = scr + (8 * c) * 33 + n;
        v4u o; o.x = pk2(s[0 * 33], s[1 * 33]); o.y = pk2(s[2 * 33], s[3 * 33]); o.z = pk2(s[4 * 33], s[5 * 33]); o.w = pk2(s[6 * 33], s[7 * 33]);
        *(GAS v4u*)(WT + (size_t)(row_off + n0 + n) * K + k0 + 8 * c) = o; }
    LDS_WAIT(); asm volatile("" ::: "memory");
}
__device__ __forceinline__ void p0_table_rows4(const float* const (&src)[4], unsigned char* const (&dst)[4], float* const (&scale_out)[4], int off, int lane) {
    f32x4 v[4][4]; float am[4];
#pragma unroll
    for (int u = 0; u < 4; ++u)
#pragma unroll
        for (int q = 0; q < 4; ++q) v[u][q] = __builtin_nontemporal_load((const f32x4*)(src[u] + 16 * lane + 4 * q));
#pragma unroll
    for (int u = 0; u < 4; ++u) { float a = 0.f;
#pragma unroll
        for (int q = 0; q < 4; ++q) a = fmaxf(fmaxf(a, fmaxf(fabsf(v[u][q][0]), fabsf(v[u][q][1]))), fmaxf(fabsf(v[u][q][2]), fabsf(v[u][q][3])));
        am[u] = a; }
#pragma unroll
    for (int o = 1; o < 64; o <<= 1) {
#pragma unroll
        for (int u = 0; u < 4; ++u) am[u] = fmaxf(am[u], __shfl_xor(am[u], o)); }
#pragma unroll
    for (int u = 0; u < 4; ++u) { const float sc = (am[u] > 0.f) ? am[u] * (1.0f / 127.0f) : 1.0f, inv = 1.0f / sc;
        v4u o;
#pragma unroll
        for (int q = 0; q < 4; ++q) { const int q0 = (int)rintf(v[u][q][0] * inv) + off, q1 = (int)rintf(v[u][q][1] * inv) + off, q2 = (int)rintf(v[u][q][2] * inv) + off, q3 = (int)rintf(v[u][q][3] * inv) + off;
            o[q] = (unsigned)(q0 & 255) | ((unsigned)(q1 & 255) << 8) | ((unsigned)(q2 & 255) << 16) | ((unsigned)q3 << 24); }
        *(GAS v4u*)(dst[u] + ((size_t)(lane >> 3) << 21) + 16 * (lane & 7)) = o;
        if (lane == 0) *scale_out[u] = sc; }
}
template <int STAGE>
__device__ __forceinline__ void p0b_prologue(Frame& F, const Args& A) {
    const int gw = F.vcu * NWAVES + F.wave, NGW = F.G * NWAVES, lane = F.lane;
    const float* modp = (const float*)(A.ws + WS_MODP);
    LAS float* G1 = (LAS float*)(F.lds + 135168);
    if (STAGE == 0) { float* ks = (float*)(A.ws + WS_KSUM); for (int i = F.vcu * NTHREADS + F.tid; i < NB * NBLK * 512; i += F.G * NTHREADS) ks[i] = 0.f; }
    if (STAGE == 0) { for (int r = F.vcu; r < 256; r += F.G) p0_wp_task(F, A, r); }
    else { p0_wg_dot<1>(F, nullptr, modp, 0, A.in[5], INW, nullptr, (float*)(A.ws + WS_BIAS1P), F.vcu, 8 * (INW / 64));
           p0_wg_dot<1>(F, nullptr, modp, 3072, A.in[13], PQW, nullptr, (float*)(A.ws + WS_BIAS2P), F.vcu, 8 * (PQW / 64)); }
    LAS float* scr = (LAS float*)(F.lds + RING_OFF + F.wave * 16384);
    constexpr int I_MODF = 768, I_WIN = (D / 64) * (INW / 32), I_WA = (AW / 64) * (D / 32), I_WOUT = (D / 64) * (D / 32), I_WQ = (D / 64) * (PQW / 32);
    constexpr int I_SUBK = 64;
    constexpr int NITEMS = I_MODF + I_WIN + I_WA + I_WOUT + I_WQ + I_SUBK;
    for (int it = gw; it < NITEMS; it += NGW) {
        int r = it;
        if (r < I_MODF) { if (STAGE != 1) continue; const int idx = r * 64 + lane; ((float*)(A.ws + WS_MODF))[idx] = modp_sum(modp, idx); continue; } r -= I_MODF;
        if (r < I_WIN) { if (STAGE != 0) continue; p0_transpose_item(A.in[5], D, INW, (bf16*)(A.ws + WS_WIN), 0, scr, r, lane); continue; } r -= I_WIN;
        if (r < I_WA) { if (STAGE != 0) continue; p0_transpose_item(A.in[6], AW, D, (bf16*)(A.ws + WS_WA), 0, scr, r, lane); continue; } r -= I_WA;
        if (r < I_WOUT) { if (STAGE != 0) continue; p0_transpose_item(A.in[11], D, D, (bf16*)(A.ws + WS_WOUT), 0, scr, r, lane); continue; } r -= I_WOUT;
        if (r < I_WQ) { if (STAGE != 0) continue; p0_transpose_item(A.in[13], D, PQW, (bf16*)(A.ws + WS_WQ), 0, scr, r, lane); continue; } r -= I_WQ;
        if (r < I_SUBK) { if (STAGE != 0) continue; const float* s = A.in[14] + (size_t)r * 512 + 8 * lane; const f32x4 a = *(const f32x4*)s, b = *(const f32x4*)(s + 4);
            v4u o; o.x = pk2(a[0], a[1]); o.y = pk2(a[2], a[3]); o.z = pk2(b[0], b[1]); o.w = pk2(b[2], b[3]);
            *(GAS v4u*)((bf16*)(A.ws + WS_SUBK) + (size_t)r * 512 + 8 * lane) = o; continue; } r -= I_SUBK;
    }
    auto xg_rows = [&](const int rb) {
        const float* x = A.in[0]; bf16* XG = (bf16*)(A.ws + WS_XG); float* rstd1 = (float*)(A.ws + WS_RSTD1);
            for (int r0 = F.wave; r0 < 128; r0 += 4 * NWAVES) {
                f32x4 v[4][2][2]; float s[4];
#pragma unroll
                for (int u = 0; u < 4; ++u) { const float* xr = x + (size_t)(rb * 128 + r0 + u * NWAVES) * 1024;
#pragma unroll
                    for (int h = 0; h < 2; ++h)
#pragma unroll
                        for (int q = 0; q < 2; ++q) v[u][h][q] = __builtin_nontemporal_load((const f32x4*)(xr + h * 512 + 8 * lane + 4 * q)); }
#pragma unroll
                for (int u = 0; u < 4; ++u) { float t = 0.f;
#pragma unroll
                    for (int h = 0; h < 2; ++h)
#pragma unroll
                        for (int q = 0; q < 2; ++q) t += (v[u][h][q][0] * v[u][h][q][0] + v[u][h][q][1] * v[u][h][q][1]) + (v[u][h][q][2] * v[u][h][q][2] + v[u][h][q][3] * v[u][h][q][3]);
                    s[u] = t; }
#pragma unroll
                for (int o = 1; o < 64; o <<= 1) {
#pragma unroll
                    for (int u = 0; u < 4; ++u) s[u] += __shfl_xor(s[u], o); }
#pragma unroll
                for (int u = 0; u < 4; ++u) { const int row = rb * 128 + r0 + u * NWAVES;
                    if (lane == 0) rstd1[row] = 1.0f / sqrtf(s[u] * (1.0f / D) + RMS_EPS);
#pragma unroll
                    for (int h = 0; h < 2; ++h) { const LAS float* g = G1 + h * 512 + 8 * lane;
                        v4u o; o.x = pk2(v[u][h][0][0] * g[0], v[u][h][0][1] * g[1]); o.y = pk2(v[u][h][0][2] * g[2], v[u][h][0][3] * g[3]); o.z = pk2(v[u][h][1][0] * g[4], v[u][h][1][1] * g[5]); o.w = pk2(v[u][h][1][2] * g[6], v[u][h][1][3] * g[7]);
                        *(GAS v4u*)(XG + (size_t)row * 1024 + h * 512 + 8 * lane) = o; } }
            }
    };
    auto table_rows = [&]() {
    for (int r0 = gw; r0 < 2 * PEXP; r0 += 4 * NGW) {
        const float* src[4]; unsigned char* dst[4]; float* sco[4];
#pragma unroll
        for (int u = 0; u < 4; ++u) { int r = r0 + u * NGW; if (r >= 2 * PEXP) r = r0; const int tb = r / PEXP, e = r % PEXP;
            src[u] = (tb ? A.in[16] : A.in[15]) + (size_t)e * D; dst[u] = A.ws + (tb ? WS_V : WS_U) + (size_t)e * 128; sco[u] = (float*)(A.ws + (tb ? WS_V : WS_U) + 16 * MiB) + e; }
        const int tb0 = r0 / PEXP;
        if ((r0 + 3 * NGW) / PEXP == tb0 && r0 + 3 * NGW < 2 * PEXP) p0_table_rows4(src, dst, sco, tb0 ? 128 : 0, lane);
        else { for (int u = 0; u < 4; ++u) { const int r = r0 + u * NGW; if (r < 2 * PEXP) { const float* s1[4] = {src[u], src[u], src[u], src[u]}; unsigned char* d1[4] = {dst[u], dst[u], dst[u], dst[u]}; float* c1[4] = {sco[u], sco[u], sco[u], sco[u]}; p0_table_rows4(s1, d1, c1, (r / PEXP) ? 128 : 0, lane); } } }
    }
    };
    if (STAGE == 0) table_rows();
    else for (int rb = F.vcu; rb < T / 128; rb += F.G) {
        const float* g1 = A.in[4]; const int b = (rb * 128) / SEQ;
        __syncthreads();
        for (int k = F.tid; k < 1024; k += NTHREADS) G1[k] = g1[k] * (1.0f + modp_sum(modp, b * 6144 + 1024 + k));
        __syncthreads();
        xg_rows(rb);
    }

}
namespace attn_body {
using bf16=__hip_bfloat16;
using bf16x8=__attribute__((ext_vector_type(8)))short;
using s16x4=__attribute__((ext_vector_type(4)))short;
using f32x16=__attribute__((ext_vector_type(16)))float;
using u32x4=__attribute__((ext_vector_type(4)))unsigned;
constexpr int BATCH=8,NHEAD=8,SEQ=4096,D=64,DM=NHEAD*D;
constexpr int NW=8,QBLK=32,QB=QBLK*NW,KVBLK=64,NQB=SEQ/QB;
constexpr int ATTN_PITCH=DM, ATTN_UNIT_ROWS=QB;
__device__ __forceinline__ int crow(int r,int hi){return (r&3)+8*(r>>2)+4*hi;}
#define SBAR() __builtin_amdgcn_sched_barrier(0)
__device__ __forceinline__ void cmask(f32x16&p0,f32x16&p1,int jb,int qrel,int hi){
  const float NEG=-INFINITY; int kb=64*jb+4*hi;
  #pragma unroll
  for(int r=0;r<16;++r){int kv=kb+(r&3)+8*(r>>2); if(kv>qrel)p0[r]=NEG; if(kv+32>qrel)p1[r]=NEG;}
}

constexpr int NSLOT=3, SLOTB=8192;
constexpr int LDS_K=0, LDS_V=NSLOT*SLOTB, LDS_WS=2*NSLOT*SLOTB, LDS_OST=LDS_WS+NW*64*4, LDS_KSL=LDS_OST+NW*4096, LDS_BYTES=LDS_KSL+4096;
constexpr float C2=0.125f*1.4426950408889634f;
__device__ __forceinline__ void glds16(const void*sbase,unsigned voff,unsigned lds_dst){unsigned keep;
  asm volatile("s_mov_b32 %0, m0\n\ts_mov_b32 m0, %3\n\ts_nop 4\n\tglobal_load_lds_dwordx4 %1, %2\n\ts_mov_b32 m0, %0":"=&s"(keep):"v"(voff),"s"(sbase),"s"(lds_dst):"memory");}
__device__ __forceinline__ float max3f(float a,float b,float c){float r;asm("v_max3_f32 %0, %1, %2, %3":"=v"(r):"v"(a),"v"(b),"v"(c));return r;}
__device__ __forceinline__ float max2f(float a,float b){float r;asm("v_max_f32_e32 %0, %1, %2":"=v"(r):"v"(a),"v"(b));return r;}
__device__ __forceinline__ float fadd_s(float a,float b){float r;asm("v_add_f32_e32 %0, %1, %2":"=v"(r):"v"(a),"v"(b));return r;}
__device__ __forceinline__ float fsub_s(float a,float b){float r;asm("v_sub_f32_e32 %0, %1, %2":"=v"(r):"v"(a),"v"(b));return r;}
typedef float f32x2_t __attribute__((ext_vector_type(2))); typedef __bf16 bf16x2_t __attribute__((ext_vector_type(2)));
__device__ __forceinline__ unsigned cvtpk_s(float lo,float hi){f32x2_t v={lo,hi};bf16x2_t b=__builtin_convertvector(v,bf16x2_t);return __builtin_bit_cast(unsigned,b);}
#define WAIT_BAR(N) asm volatile("s_waitcnt vmcnt(" #N ") lgkmcnt(0)\n\ts_barrier":::"memory")

__device__ __forceinline__ void qkt(f32x16&p0,f32x16&p1,const char*Kslot,const bf16x8*qr,const f32x16&negm,int r32,int hi){
  const char*kb=Kslot+hi*1024+r32*16;
  #pragma unroll
  for(int d0=0;d0<4;++d0){
    const bf16x8 b0=*reinterpret_cast<const bf16x8*>(kb+d0*2048);
    const bf16x8 b1=*reinterpret_cast<const bf16x8*>(kb+d0*2048+512);
    if(d0==0){p0=__builtin_amdgcn_mfma_f32_32x32x16_bf16(b0,qr[0],negm,0,0,0);p1=__builtin_amdgcn_mfma_f32_32x32x16_bf16(b1,qr[0],negm,0,0,0);}
    else{p0=__builtin_amdgcn_mfma_f32_32x32x16_bf16(b0,qr[d0],p0,0,0,0);p1=__builtin_amdgcn_mfma_f32_32x32x16_bf16(b1,qr[d0],p1,0,0,0);}}
}
typedef __attribute__((address_space(3))) const char* lds_cptr;
typedef short v4i16_t __attribute__((ext_vector_type(4)));
__device__ __forceinline__ void kload8(bf16x8*kf,lds_cptr kp){
  kf[0]=*(const __attribute__((address_space(3))) bf16x8*)(kp);      kf[1]=*(const __attribute__((address_space(3))) bf16x8*)(kp+512);
  kf[2]=*(const __attribute__((address_space(3))) bf16x8*)(kp+2048); kf[3]=*(const __attribute__((address_space(3))) bf16x8*)(kp+2560);
  kf[4]=*(const __attribute__((address_space(3))) bf16x8*)(kp+4096); kf[5]=*(const __attribute__((address_space(3))) bf16x8*)(kp+4608);
  kf[6]=*(const __attribute__((address_space(3))) bf16x8*)(kp+6144); kf[7]=*(const __attribute__((address_space(3))) bf16x8*)(kp+6656);
}
__device__ __forceinline__ void kload2(bf16x8*kf,lds_cptr kp,int j){ kf[2*j]=*(const __attribute__((address_space(3))) bf16x8*)(kp+j*2048); kf[2*j+1]=*(const __attribute__((address_space(3))) bf16x8*)(kp+j*2048+512); }
__device__ __forceinline__ s16x4 vtr(lds_cptr p){ return __builtin_bit_cast(s16x4,__builtin_amdgcn_ds_read_tr16_b64_v4i16((__attribute__((address_space(3))) v4i16_t*)p)); }
__device__ __forceinline__ float rowmax(const f32x16&p0,const f32x16&p1){
  float a=max3f(p0[0],p0[1],p1[0]),b=max3f(p0[2],p0[3],p1[1]);a=max3f(a,p1[2],p1[3]);
  #pragma unroll
  for(int r=4;r<16;r+=4){a=max3f(a,p0[r],p0[r+1]);b=max3f(b,p0[r+2],p0[r+3]);a=max3f(a,p1[r],p1[r+1]);b=max3f(b,p1[r+2],p1[r+3]);}
  const float m=max2f(a,b);
  auto rr=__builtin_amdgcn_permlane32_swap(__float_as_uint(m),__float_as_uint(m),false,false);
  return max2f(__uint_as_float(rr[0]),__uint_as_float(rr[1]));
}
__device__ __forceinline__ void pv(f32x16*o,int vb,bf16x8 pa0,bf16x8 pa1,bf16x8 pa2,bf16x8 pa3){
  #pragma unroll
  for(int d0=0;d0<2;++d0){s16x4 lo[4],hi[4];
    #pragma unroll
    for(int ks=0;ks<4;++ks){
      asm volatile("ds_read_b64_tr_b16 %0,%1 offset:%c2":"=&v"(lo[ks]):"v"(vb),"i"(d0*4096+ks*1024):"memory");
      asm volatile("ds_read_b64_tr_b16 %0,%1 offset:%c2":"=&v"(hi[ks]):"v"(vb),"i"(d0*4096+ks*1024+512):"memory");}
    asm volatile("s_waitcnt lgkmcnt(0)":::"memory");SBAR();
    #define PK(k) (bf16x8){lo[k][0],lo[k][1],lo[k][2],lo[k][3],hi[k][0],hi[k][1],hi[k][2],hi[k][3]}
    o[d0]=__builtin_amdgcn_mfma_f32_32x32x16_bf16(pa0,PK(0),o[d0],0,0,0);
    o[d0]=__builtin_amdgcn_mfma_f32_32x32x16_bf16(pa1,PK(1),o[d0],0,0,0);
    o[d0]=__builtin_amdgcn_mfma_f32_32x32x16_bf16(pa2,PK(2),o[d0],0,0,0);
    o[d0]=__builtin_amdgcn_mfma_f32_32x32x16_bf16(pa3,PK(3),o[d0],0,0,0);
    #undef PK
  }
}

#ifndef ATTN_STORE16
#define ATTN_STORE16(p,v) (*(u32x4*)(p)=(v))
#endif
template<int THRL> __device__ __forceinline__ void attn_unit(int b,int h,int qb,const bf16*Q,const bf16*__restrict__ K,const bf16*__restrict__ V,bf16*O,const float*ksum,const float*nrm,char*shm){
  int tid_=threadIdx.x; asm volatile("":"+v"(tid_)); const int tid=tid_,lane=tid&63,r32=lane&31,hi=lane>>5; const int wid=__builtin_amdgcn_readfirstlane(tid>>6);
  const long rowbase=(long)b*SEQ; const int q0=qb*QB;
  const bf16*Qw=Q+(rowbase+q0+wid*QBLK)*DM+h*D;
  const bf16*Kh=K+rowbase*DM+h*D,*Vh=V+rowbase*DM+h*D;
  const unsigned lds0=(unsigned)(uintptr_t)shm;
  float*wsf=(float*)(shm+LDS_WS)+wid*64;
  const unsigned kvoff=(unsigned)(lane*DM+wid*8)*2u;
  const unsigned vvoff=(unsigned)((16*(wid&3)+(lane>>2))*DM+(wid>>2)*32+(lane&3)*8)*2u;
  const unsigned kdst=lds0+LDS_K+wid*1024, vdst=lds0+LDS_V+wid*1024;
  #define DMA_K(t,slot) glds16(Kh+(long)(NTF-1-(t))*KVBLK*DM,kvoff,(unsigned)__builtin_amdgcn_readfirstlane(kdst+(slot)))
  #define DMA_V(t,slot) glds16(Vh+(long)(NTF-1-(t))*KVBLK*DM,vvoff,(unsigned)__builtin_amdgcn_readfirstlane(vdst+(slot)))
  const int vb0=(int)(lds0+LDS_V)+((lane>>4)&1)*32+(lane&3)*8+(4*hi+((lane&15)>>2))*64;
  const char*Kbase=shm+LDS_K; bf16x8 kf[8];
  const lds_cptr shm3=(lds_cptr)shm; const lds_cptr kp0=shm3+LDS_K+hi*1024+r32*16; const lds_cptr vp0=shm3+LDS_V+((lane>>4)&1)*32+(lane&3)*8+(4*hi+((lane&15)>>2))*64;
  const int NTF=(q0+QB)/KVBLK;
  int NT=NTF;
  { const float*nq=nrm+(long)(b*2+0)*16+2*h,*nk=nrm+(long)(b*2+1)*16+2*h; const float B=__builtin_sqrtf((nq[0]+nq[1])*(nk[0]+nk[1]))*1.02f+0.5f;
    const float slope2_=__uint_as_float(0x3FB8AA3Bu-((unsigned)(h+1)<<23)); const float dh=(160.f+2.f*B)/slope2_;
    const float tminf=((float)(q0-63)-dh)*(1.f/64.f); int tmin=tminf>0.f?(int)tminf:0;
    tmin=__builtin_amdgcn_readfirstlane(tmin); int nt=NTF-tmin; nt+=nt&1; if(nt>NTF)nt=NTF; if(nt<4)nt=4; NT=nt; }
  { float*ksl=(float*)(shm+LDS_KSL); const float k0=ksum[(long)(b*16+(tid>>6))*512+h*64+(tid&63)],k1=ksum[(long)(b*16+8+(tid>>6))*512+h*64+(tid&63)]; ksl[tid]=k0; ksl[512+tid]=k1; }
  DMA_K(0,0);DMA_V(0,0);DMA_K(1,SLOTB);
  bf16x8 qr[4];
  #pragma unroll
  for(int d0=0;d0<4;++d0)qr[d0]=*reinterpret_cast<const bf16x8*>(&Qw[(long)r32*DM+d0*16+hi*8]);
  float mhat=0.f,l_reg=0.f;f32x16 o[2];o[0]=f32x16{};o[1]=f32x16{};const f32x16 zero16=f32x16{};
  const int qrel=wid*QBLK+r32;
  #define CMASK(P0,P1,t) do{int jb_=3-(t); if(jb_>=0)cmask(P0,P1,jb_,qrel,hi);}while(0)
  const unsigned sl2b=0x3FB8AA3Bu-((unsigned)(h+1)<<23);
  const float slope2=__uint_as_float(sl2b), s2x=__uint_as_float(sl2b+(1u<<23)), s8x=__uint_as_float(sl2b+(3u<<23)), s32=__uint_as_float(sl2b+(5u<<23));
  const float s3x=__uint_as_float((unsigned)__builtin_amdgcn_readfirstlane((int)__float_as_uint(slope2*3.0f)));
  #define NBSEL(r) (((r)>>2)==0?nbb0_:((r)>>2)==1?nbb1_:((r)>>2)==2?nbb2_:nbb3_)
  #define NEGV(r) ((((r)&3)==0)?NBSEL(r):(NBSEL(r)+(((r)&3)==1?slope2:((r)&3)==2?s2x:s3x)))
  #define NBB(nb) const float nbb0_=(nb), nbb1_=nbb0_+s8x, nbb2_=nbb1_+s8x, nbb3_=nbb2_+s8x
  #define NBSELC(r) (((r)>>2)==0?nbc0_:((r)>>2)==1?nbc1_:((r)>>2)==2?nbc2_:nbc3_)
  #define SAV(r) (((r)&3)==1?slope2:((r)&3)==2?s2x:s3x)
  #define BIAS(C0,C1,s) do{ NBB(NBV(s)); const float nbc0_=nbb0_+s32,nbc1_=nbb1_+s32,nbc2_=nbb2_+s32,nbc3_=nbb3_+s32; \
      _Pragma("unroll") for(int r=0;r<16;++r){ if((r&3)==0){C0[r]+=NBSEL(r);C1[r]+=NBSELC(r);} else {C0[r]=(C0[r]+NBSEL(r))+SAV(r);C1[r]=(C1[r]+NBSELC(r))+SAV(r);} } }while(0)
  unsigned sel=0u;
  #define NBV(s) ({ const int tl_=NTF-1-(s); const int tc_=tl_<0?0:tl_; const int bj_=tc_>>2; const float off_=(bj_>=qb||((sel>>bj_)&1u))?0.f:-1.0e30f; \
      __builtin_fmaf(slope2,(float)(64*tl_+4*hi-q0-qrel),off_-mhat); })
  #define CRC(r) ((float)(((r)&3)+8*((r)>>2)))
  bool resc=false;
  #define START(P0,P1) do{ const float rm=rowmax(P0,P1); resc=false; \
    { const float dl=(rm>-1.0e20f)?rm:0.f; mhat=fadd_s(mhat,dl); \
      _Pragma("unroll") for(int r=0;r<16;++r){P0[r]=fsub_s(P0[r],dl);P1[r]=fsub_s(P1[r],dl);} } \
    _Pragma("unroll") for(int r=0;r<16;++r)P0[r]=__builtin_amdgcn_exp2f(P0[r]); }while(0)
  #define RESC() do{ if(resc){ asm volatile("s_waitcnt lgkmcnt(0)":::"memory"); \
      _Pragma("unroll") for(int d_=0;d_<2;++d_) _Pragma("unroll") for(int r=0;r<16;++r)o[d_][r]*=wsf[crow(r,hi)]; } }while(0)
  f32x16 pA0,pA1,pB0,pB1;
  int sl_prev=0,sl_cur=0,sl_next=SLOTB;
  #define ROT() do{sl_prev=sl_cur;sl_cur=sl_next;sl_next=(sl_next==(NSLOT-1)*SLOTB)?0:sl_next+SLOTB;}while(0)
  DMA_K(2,2*SLOTB);
  WAIT_BAR(3);
  if(qb>0){
    float qf[32];
    _Pragma("unroll") for(int d0=0;d0<4;++d0) _Pragma("unroll") for(int e=0;e<8;++e) qf[d0*8+e]=__uint_as_float(((unsigned)(unsigned short)qr[d0][e])<<16);
    const float*ksl=(const float*)(shm+LDS_KSL)+8*hi;
    float b1=-3.0e38f,b2=-3.0e38f,b3=-3.0e38f; int i1=-1,i2=-1,i3=-1;
    for(int j=0;j<qb;++j){ float g=0.f;
      _Pragma("unroll") for(int d0=0;d0<4;++d0) _Pragma("unroll") for(int e=0;e<8;++e) g=__builtin_fmaf(qf[d0*8+e],ksl[j*64+16*d0+e],g);
      { auto rr=__builtin_amdgcn_permlane32_swap(__float_as_uint(g),__float_as_uint(g),false,false); g=__uint_as_float(rr[0])+__uint_as_float(rr[1]); }
      const bool c1=g>b1,c2=g>b2,c3=g>b3;
      b3=c2?b2:(c3?g:b3); i3=c2?i2:(c3?j:i3); b2=c1?b1:(c2?g:b2); i2=c1?i1:(c2?j:i2); b1=c1?g:b1; i1=c1?j:i1; }
    sel=(1u<<i1)|(i2>=0?(1u<<i2):0u)|(i3>=0?(1u<<i3):0u); }
  qkt(pA0,pA1,Kbase,qr,zero16,r32,hi);asm volatile("s_nop 15\n\ts_nop 7":"+v"(pA0),"+v"(pA1));
  BIAS(pA0,pA1,0);
  CMASK(pA0,pA1,0);
  START(pA0,pA1);
  _Pragma("unroll") for(int r=0;r<16;++r)pA1[r]=__builtin_amdgcn_exp2f(pA1[r]);
  WAIT_BAR(0);
  DMA_K(3,0);DMA_V(1,SLOTB);
  ROT();
  kload8(kf,kp0+sl_cur);
  WAIT_BAR(2);
  s16x4 vlo[8],vhi[8]; u32x4 pw0,pw1,pw2,pw3;
  #define PKW(P,B) cvtpk_s(P[B],P[B+1])
  #define PAF(k) __builtin_bit_cast(bf16x8,pw##k)
  #define VFR(i) (bf16x8){vlo[i][0],vlo[i][1],vlo[i][2],vlo[i][3],vhi[i][0],vhi[i][1],vhi[i][2],vhi[i][3]}
  #define PIN(x) asm volatile("":"+v"(x))
  #define MX3(a,b,c) __builtin_fmaxf(__builtin_fmaxf((a),(b)),(c))
  #define GAPA(MF,A0,A1,A2,A3,W0,W1,PW) do{ MF; sacc+=A0; sacc+=A1; sacc+=A2; sacc+=A3; PIN(sacc); W0; W1; PIN(PW); SBAR(); }while(0)
  #define EX(v) __builtin_amdgcn_exp2f(v)
  #define GAPB(MF,X,B) do{ MF; X[B]=EX(X[B]); X[B+1]=EX(X[B+1]); X[B+2]=EX(X[B+2]); X[B+3]=EX(X[B+3]); PIN(X); SBAR(); }while(0)
  #define VRD(i) do{ vlo[i]=vtr(vp_+(((i)>>2)*4096+((i)&3)*1024)); vhi[i]=vtr(vp_+(((i)>>2)*4096+((i)&3)*1024+512)); }while(0)
  #define KRD(G,j) do{ if(G){ kload2(kf,kp0+sl_next,j); SBAR(); } }while(0)
  #define STEP(C0,C1,P0,P1,t,GK,GV,GL) do{ SBAR(); \
    const lds_cptr vp_=vp0+sl_prev; \
    VRD(0); SBAR(); float sacc=(P0[0]+P0[1]); \
    GAPA(C0=__builtin_amdgcn_mfma_f32_32x32x16_bf16(kf[0],qr[0],zero16,0,0,0), P0[2],P0[3],P0[4],P0[5],     pw0[0]=PKW(P0,0), pw0[1]=PKW(P0,2), pw0); \
    VRD(4); SBAR(); GAPA(C1=__builtin_amdgcn_mfma_f32_32x32x16_bf16(kf[1],qr[0],zero16,0,0,0), P0[6],P0[7],P0[8],P0[9],     pw0[2]=PKW(P0,4), pw0[3]=PKW(P0,6), pw0); \
    VRD(1); SBAR(); GAPA(C0=__builtin_amdgcn_mfma_f32_32x32x16_bf16(kf[2],qr[1],C0,0,0,0),   P0[10],P0[11],P0[12],P0[13], pw1[0]=PKW(P0,8), pw1[1]=PKW(P0,10), pw1); \
    VRD(5); SBAR(); GAPA(C1=__builtin_amdgcn_mfma_f32_32x32x16_bf16(kf[3],qr[1],C1,0,0,0),   P0[14],P0[15],P1[0],P1[1],   pw1[2]=PKW(P0,12),pw1[3]=PKW(P0,14), pw1); \
    VRD(2); SBAR(); GAPA(C0=__builtin_amdgcn_mfma_f32_32x32x16_bf16(kf[4],qr[2],C0,0,0,0),   P1[2],P1[3],P1[4],P1[5],     pw2[0]=PKW(P1,0), pw2[1]=PKW(P1,2), pw2); \
    VRD(6); SBAR(); GAPA(C1=__builtin_amdgcn_mfma_f32_32x32x16_bf16(kf[5],qr[2],C1,0,0,0),   P1[6],P1[7],P1[8],P1[9],     pw2[2]=PKW(P1,4), pw2[3]=PKW(P1,6), pw2); \
    VRD(3); SBAR(); GAPA(C0=__builtin_amdgcn_mfma_f32_32x32x16_bf16(kf[6],qr[3],C0,0,0,0),   P1[10],P1[11],P1[12],P1[13], pw3[0]=PKW(P1,8), pw3[1]=PKW(P1,10), pw3); \
    VRD(7); SBAR(); GAPA(C1=__builtin_amdgcn_mfma_f32_32x32x16_bf16(kf[7],qr[3],C1,0,0,0),   P1[14],P1[15],0.f,0.f,       pw3[2]=PKW(P1,12),pw3[3]=PKW(P1,14), pw3); \
    l_reg+=sacc; \
    if(GK){DMA_K((t)+3,sl_cur);} if(GV){DMA_V((t)+1,sl_next);} \
    BIAS(C0,C1,t); \
    CMASK(C0,C1,t); \
    { float a=MX3(C0[0],C0[1],C1[0]),b=MX3(C0[2],C0[3],C1[1]); a=MX3(a,C1[2],C1[3]); \
      _Pragma("unroll") for(int r=4;r<16;r+=4){a=MX3(a,C0[r],C0[r+1]);b=MX3(b,C0[r+2],C0[r+3]);a=MX3(a,C1[r],C1[r+1]);b=MX3(b,C1[r+2],C1[r+3]);} \
      float rm=__builtin_fmaxf(a,b); { auto rr=__builtin_amdgcn_permlane32_swap(__float_as_uint(rm),__float_as_uint(rm),false,false); rm=__builtin_fmaxf(__uint_as_float(rr[0]),__uint_as_float(rr[1])); } \
      resc=false; \
      if(__builtin_expect(__any(rm>(float)THRL),0)){ const float dl=__builtin_fmaxf(rm,0.f); mhat+=dl; \
        _Pragma("unroll") for(int r=0;r<16;++r){C0[r]-=dl;C1[r]-=dl;} \
        const float f=__builtin_amdgcn_exp2f(-dl); l_reg*=f; if(hi==0)wsf[r32]=f; resc=true; } } \
    SBAR(); \
    GAPB(o[0]=__builtin_amdgcn_mfma_f32_32x32x16_bf16(PAF(0),VFR(0),o[0],0,0,0), C0,0); \
    GAPB(o[1]=__builtin_amdgcn_mfma_f32_32x32x16_bf16(PAF(0),VFR(4),o[1],0,0,0), C0,4); \
    KRD(GL,0); GAPB(o[0]=__builtin_amdgcn_mfma_f32_32x32x16_bf16(PAF(1),VFR(1),o[0],0,0,0), C0,8); \
    KRD(GL,1); GAPB(o[1]=__builtin_amdgcn_mfma_f32_32x32x16_bf16(PAF(1),VFR(5),o[1],0,0,0), C0,12); \
    KRD(GL,2); GAPB(o[0]=__builtin_amdgcn_mfma_f32_32x32x16_bf16(PAF(2),VFR(2),o[0],0,0,0), C1,0); \
    KRD(GL,3); GAPB(o[1]=__builtin_amdgcn_mfma_f32_32x32x16_bf16(PAF(2),VFR(6),o[1],0,0,0), C1,4); \
    GAPB(o[0]=__builtin_amdgcn_mfma_f32_32x32x16_bf16(PAF(3),VFR(3),o[0],0,0,0), C1,8); \
    GAPB(o[1]=__builtin_amdgcn_mfma_f32_32x32x16_bf16(PAF(3),VFR(7),o[1],0,0,0), C1,12); \
    }while(0)
  int t=1;
  #define ENDW(tt) do{ if((tt)+3<NT){WAIT_BAR(2);} else if((tt)+2<NT){WAIT_BAR(1);} else {WAIT_BAR(0);} }while(0)
  #define PEELED_PAIR() do{ \
    STEP(pB0,pB1,pA0,pA1,t,(t+3<NT),(t+1<NT),(t+1<NT));       ENDW(t);   RESC(); ROT(); \
    STEP(pA0,pA1,pB0,pB1,t+1,(t+4<NT),(t+2<NT),(t+2<NT));     ENDW(t+1); RESC(); ROT(); }while(0)
  for(;t<5&&t+1<NT;t+=2){ PEELED_PAIR(); }
  #undef CMASK
  #define CMASK(P0,P1,t) do{}while(0)
  for(;t+5<NT;t+=2){
    STEP(pB0,pB1,pA0,pA1,t,true,true,true);     WAIT_BAR(2); RESC(); ROT();
    STEP(pA0,pA1,pB0,pB1,t+1,true,true,true);   WAIT_BAR(2); RESC(); ROT();
  }
  #undef CMASK
  #define CMASK(P0,P1,t) do{int jb_=3-(t); if(jb_>=0)cmask(P0,P1,jb_,qrel,hi);}while(0)
  for(;t+1<NT;t+=2){ PEELED_PAIR(); }
  STEP(pB0,pB1,pA0,pA1,NT-1,false,false,false); RESC();
  { float sacc=pB0[0]+pB0[1]; _Pragma("unroll") for(int r=2;r<16;++r)sacc+=pB0[r]; _Pragma("unroll") for(int r=0;r<16;++r)sacc+=pB1[r]; l_reg+=sacc;
    pw0=(u32x4){PKW(pB0,0),PKW(pB0,2),PKW(pB0,4),PKW(pB0,6)};pw1=(u32x4){PKW(pB0,8),PKW(pB0,10),PKW(pB0,12),PKW(pB0,14)};pw2=(u32x4){PKW(pB1,0),PKW(pB1,2),PKW(pB1,4),PKW(pB1,6)};pw3=(u32x4){PKW(pB1,8),PKW(pB1,10),PKW(pB1,12),PKW(pB1,14)};
    SBAR(); pv(o,vb0+sl_cur,PAF(0),PAF(1),PAF(2),PAF(3)); }
  #undef PKW
  #undef PAF
  #undef VFR
  #undef PIN
  #undef MX3
  #undef GAPA
  #undef GAPB
  #undef EX
  #undef VRD
  #undef KRD
  #undef STEP
  #undef ENDW
  #undef PEELED_PAIR
  #undef NBV
  #undef CRC
  #undef NEGV
  #undef NBSEL
  #undef NBB
  #undef NBSELC
  #undef SAV
  #undef BIAS
  {auto rr=__builtin_amdgcn_permlane32_swap(__float_as_uint(l_reg),__float_as_uint(l_reg),false,false);l_reg=__uint_as_float(rr[0])+__uint_as_float(rr[1]);}
  if(hi==0)wsf[32+r32]=l_reg;asm volatile("s_waitcnt lgkmcnt(0)":::"memory");
  float rli[16];
  #pragma unroll
  for(int r=0;r<16;++r)rli[r]=__builtin_amdgcn_rcpf(wsf[32+crow(r,hi)]);
  bf16*Ow=O+(rowbase+q0+wid*QBLK)*DM+h*D;
  { bf16*stg=(bf16*)(shm+LDS_OST)+wid*2048;
    #pragma unroll
    for(int r=0;r<16;++r){const int orow=crow(r,hi);
      #pragma unroll
      for(int d0=0;d0<2;++d0)stg[orow*64+d0*32+r32]=__float2bfloat16(o[d0][r]*rli[r]);}
    asm volatile("s_waitcnt lgkmcnt(0)":::"memory");
    #pragma unroll
    for(int i=0;i<4;++i){const int row=i*8+(lane>>3),ch=lane&7; const u32x4 v=*(const u32x4*)(stg+row*64+ch*8); ATTN_STORE16(Ow+(long)row*DM+ch*8,v);} }
  asm volatile("s_waitcnt lgkmcnt(0)\n\ts_barrier":::"memory");
  #undef DMA_K
  #undef DMA_V
  #undef CMASK
  #undef START
  #undef RESC
  #undef ROT
}
constexpr int ATTN_LDS_BYTES=LDS_BYTES;
struct AttnTensors { const bf16* Q; const bf16* K; const bf16* V; bf16* O; };
struct AttnUnit { int bh; int qb; };
struct AttnPlan { unsigned char unit[32][12]; unsigned char n[32]; };
constexpr int attn_nominal_cost(int h,int qb){ const int pmax[8]={6,10,19,36,64,64,64,64}; const int past=4*qb<pmax[h]?4*qb:pmax[h]; return 4+past+2; }
constexpr AttnPlan make_attn_plan(){
  AttnPlan p{}; int load[32]={}; bool used[128]={};
  for(int it=0;it<128;++it){ int best=-1,bc=-1; for(int e=0;e<128;++e){ if(used[e])continue; const int c=attn_nominal_cost(e>>4,e&15); if(c>bc){bc=c;best=e;} }
    used[best]=true; int cu=0; for(int c=1;c<32;++c) if(load[c]<load[cu]||(load[c]==load[cu]&&p.n[c]<p.n[cu]))cu=c;
    if(p.n[cu]>=12){ for(int c=0;c<32;++c) if(p.n[c]<12){cu=c;break;} }
    p.unit[cu][p.n[cu]++]=(unsigned char)best; load[cu]+=bc; }
  return p; }
__device__ const AttnPlan g_attn_plan=make_attn_plan();
struct StaticOrder {
  int vcu,G;
  __device__ __forceinline__ explicit StaticOrder(int grid,int vcu_):vcu(vcu_),G(grid){}
  __device__ __forceinline__ bool next(int i,AttnUnit&u)const{
    if(G!=256){ const int id=vcu+i*G; if(id>=BATCH*NHEAD*NQB)return false; u.bh=id>>4; u.qb=id&15; return true; }
    const int c=vcu&31; if(i>=(int)g_attn_plan.n[c])return false; const int e=g_attn_plan.unit[c][i]; u.bh=(vcu>>5)*NHEAD+(e>>4); u.qb=e&15; return true; }
};
template<class Sched,int THRL=8> __device__ __forceinline__ void attn_phase(char*lds,const AttnTensors&T,const float*ksum,const float*nrm,const Sched&S){
  AttnUnit u;
  for(int i=0;S.next(i,u);++i){ attn_unit<THRL>(u.bh/NHEAD,u.bh%NHEAD,u.qb,T.Q,T.K,T.V,T.O,ksum,nrm,lds); }
}
#undef SBAR
#undef WAIT_BAR
}

__device__ __forceinline__ void pooled_phase(Frame& F, const Args& A) {
    const bf16* P = (const bf16*)(A.ws + WS_QKVP) + (size_t)3 * T * 512; bf16* PO = (bf16*)(A.ws + WS_POOLED);
    const int gw = F.vcu * NWAVES + F.wave, NGW = F.G * NWAVES, lane = F.lane, w = 2 << (lane >> 4);
    for (int tk = gw; tk < T / 16; tk += NGW) {
        const int row0 = tk * 16, s0 = row0 & (SEQ - 1);
        v4u rv[31];
#pragma unroll
        for (int i = 0; i < 31; ++i) { const int sidx = s0 - 15 + i; rv[i] = (sidx >= 0) ? *(const v4u*)(P + (size_t)(row0 - 15 + i) * 512 + 8 * lane) : (v4u){0u, 0u, 0u, 0u}; }
#pragma unroll
        for (int i = 0; i < 16; ++i) {
            const int sidx = s0 + i; float acc[8];
#pragma unroll
            for (int e = 0; e < 8; ++e) acc[e] = 0.f;
#pragma unroll
            for (int k = 0; k < 16; ++k) { const bool ok = (k < w) && (sidx - k >= 0); const v4u x = rv[15 + i - k]; const float msk = ok ? 1.0f : 0.0f;
                acc[0] += msk * bflo(x.x); acc[1] += msk * bfhi(x.x); acc[2] += msk * bflo(x.y); acc[3] += msk * bfhi(x.y); acc[4] += msk * bflo(x.z); acc[5] += msk * bfhi(x.z); acc[6] += msk * bflo(x.w); acc[7] += msk * bfhi(x.w); }
            const float inv = 1.0f / (float)min(sidx + 1, w); const v4u x = rv[15 + i];
            v4u o; o.x = pk2(acc[0] * inv - bflo(x.x), acc[1] * inv - bfhi(x.x)); o.y = pk2(acc[2] * inv - bflo(x.y), acc[3] * inv - bfhi(x.y));
            o.z = pk2(acc[4] * inv - bflo(x.z), acc[5] * inv - bfhi(x.z)); o.w = pk2(acc[6] * inv - bflo(x.w), acc[7] * inv - bfhi(x.w));
            *(v4u*)(PO + (size_t)(row0 + i) * 512 + 8 * lane) = o;
        }
    }
}

namespace rt {
typedef float f32x16 __attribute__((ext_vector_type(16)));
typedef short bf16x8 __attribute__((ext_vector_type(8)));
__device__ __forceinline__ void ce(float& hi, float& lo) { const float a = fmaxf(hi, lo), b = fminf(hi, lo); hi = a; lo = b; }
template <int N> __device__ __forceinline__ void sort_desc(float (&v)[N]) {
#pragma unroll
    for (int k = 2; k <= N; k <<= 1)
#pragma unroll
        for (int j = k >> 1; j > 0; j >>= 1)
#pragma unroll
            for (int i = 0; i < N; ++i) { const int l = i ^ j; if (l > i) { if ((i & k) == 0) ce(v[i], v[l]); else ce(v[l], v[i]); } }
}
template <int N> __device__ __forceinline__ void bitonic_merge_desc(float (&v)[N]) {
#pragma unroll
    for (int j = N >> 1; j > 0; j >>= 1)
#pragma unroll
        for (int i = 0; i < N; ++i) { const int l = i ^ j; if (l > i) ce(v[i], v[l]); }
}
__device__ __forceinline__ void merge_top16(float (&a)[16], const float (&b)[16]) {
#pragma unroll
    for (int i = 0; i < 16; ++i) a[i] = fmaxf(a[i], b[15 - i]);
    bitonic_merge_desc<16>(a);
}
template <bool SORT> __device__ __forceinline__ void pair_merge(float (&a)[16], bool hi) {
    float w[16];
#pragma unroll
    for (int i = 0; i < 16; ++i) w[i] = hi ? a[15 - i] : a[i];
#pragma unroll
    for (int i = 0; i < 16; ++i) { const auto rr = __builtin_amdgcn_permlane32_swap(__float_as_uint(w[i]), __float_as_uint(w[i]), false, false); a[i] = fmaxf(__uint_as_float(rr[0]), __uint_as_float(rr[1])); }
    if (SORT) bitonic_merge_desc<16>(a);
}
__device__ __forceinline__ void fold_tile(const f32x16& acc, int kt, int hi, float (&out)[16]) {
    float g[16];
#pragma unroll
    for (int r = 0; r < 16; ++r) { const unsigned key = (unsigned)(32 * kt + (r & 3) + 8 * (r >> 2)); g[r] = __uint_as_float((__float_as_uint(acc[r]) & ~127u) | key | ((unsigned)hi << 2)); }
    sort_desc<16>(g);
    if (kt == 0) {
#pragma unroll
        for (int r = 0; r < 16; ++r) out[r] = g[r];
    } else merge_top16(out, g);
}
}
__device__ __forceinline__ void router_phase(Frame& F, const Args& A) {
    using namespace rt;
    const bf16* QP = (const bf16*)(A.ws + WS_GAB); const bf16* SK = (const bf16*)(A.ws + WS_SUBK);
    unsigned short* IDX = (unsigned short*)(A.ws + WS_POOLED); float* GATE = (float*)(A.ws + WS_POOLED + 16 * MiB);
    const int lane = F.lane, n32 = lane & 31, hi = lane >> 5, gw = F.vcu * NWAVES + F.wave, NGW = F.G * NWAVES;
    __syncthreads();
    for (int i = F.tid; i < 2 * 128 * 16; i += NTHREADS) { const int r = i >> 4, ch = i & 15; *(LAS v4u*)(F.lds + r * 272 + ch * 16) = *(const v4u*)(SK + (size_t)r * 128 + ch * 8); }
    __syncthreads();
    LAS unsigned char* scr = F.lds + 73728 + F.wave * 1024;
    const LAS unsigned char* afrag = F.lds + n32 * 272 + hi * 16;
    bf16x8 qa[8], qb[8];
#define RT_QLOAD(task_, p_, q_) do { const int tq_ = (task_) * 4 + (n32 >> 3); const bf16* qr_ = QP + (size_t)tq_ * PQW + (n32 & 7) * 256 + (p_) * 128 + 8 * hi; \
        _Pragma("unroll") for (int i = 0; i < 8; ++i) q_[i] = __builtin_nontemporal_load((const bf16x8*)(qr_ + 16 * i)); } while (0)
#define RT_HALF(p_, q_, out_) do { _Pragma("unroll") for (int kt = 0; kt < 4; ++kt) { f32x16 acc = f32x16{}; \
        _Pragma("unroll") for (int ks = 0; ks < 8; ++ks) { const bf16x8 kf = *(const LAS bf16x8*)(afrag + ((p_) * 128 + 32 * kt) * 272 + 32 * ks); acc = __builtin_amdgcn_mfma_f32_32x32x16_bf16(kf, q_[ks], acc, 0, 0, 0); } \
        fold_tile(acc, kt, hi, out_); } pair_merge<true>(out_, hi != 0); } while (0)
    if (gw < T * PHEADS / 32) RT_QLOAD(gw, 0, qa);
    for (int task = gw; task < T * PHEADS / 32; task += NGW) {
        const int t = task * 4 + (n32 >> 3), h = n32 & 7;
        float la[16], lb[16];
        RT_QLOAD(task, 1, qb);
        RT_HALF(0, qa, la);
        { const int nxt = task + NGW; if (nxt < T * PHEADS / 32) RT_QLOAD(nxt, 0, qa); }
        RT_HALF(1, qb, lb);
        { unsigned w[4];
#pragma unroll
          for (int q = 0; q < 4; ++q) {
              const unsigned i0 = __float_as_uint(hi ? lb[4 * q] : la[4 * q]) & 127u, i1 = __float_as_uint(hi ? lb[4 * q + 1] : la[4 * q + 1]) & 127u, i2 = __float_as_uint(hi ? lb[4 * q + 2] : la[4 * q + 2]) & 127u, i3 = __float_as_uint(hi ? lb[4 * q + 3] : la[4 * q + 3]) & 127u;
              w[q] = i0 | (i1 << 8) | (i2 << 16) | (i3 << 24); }
          *(LAS v4u*)(scr + n32 * 32 + hi * 16) = (v4u){w[0], w[1], w[2], w[3]}; }
        float x[16], y[16];
#pragma unroll
        for (int i = 0; i < 16; ++i) { const float av = __uint_as_float(__float_as_uint(la[i]) & ~127u), bv = __uint_as_float(__float_as_uint(lb[i]) & ~127u); x[i] = hi ? bv : av; y[i] = hi ? av : bv; }
        float c0[16], c1[16];
        {
            const unsigned hb = (unsigned)hi << 8;
#define RT_CAND(i, j) __uint_as_float(((__float_as_uint(x[i] + y[j]) & ~511u) | (unsigned)((i) * 16 + (j))) | hb)
#define RT_DIAG(i) (hi ? -3.0e38f : RT_CAND(i, i))
            c0[0] = RT_DIAG(0);
#pragma unroll
            for (int j = 1; j < 16; ++j) c0[j] = RT_CAND(0, j);
            c1[0] = RT_DIAG(1);
#pragma unroll
            for (int j = 2; j < 8; ++j) c1[j - 1] = RT_CAND(1, j);
            c1[7] = RT_DIAG(2); c1[8] = RT_CAND(2, 3); c1[9] = RT_CAND(2, 4); c1[10] = RT_DIAG(3);
#pragma unroll
            for (int k = 11; k < 16; ++k) c1[k] = -3.0e38f;
#undef RT_CAND
#undef RT_DIAG
        }
        sort_desc<16>(c0); sort_desc<16>(c1); merge_top16(c0, c1);
        pair_merge<false>(c0, hi != 0);
        float mx = c0[0];
#pragma unroll
        for (int i = 1; i < 16; ++i) mx = fmaxf(mx, c0[i]);
        float ex[16], sm = 0.f;
#pragma unroll
        for (int i = 0; i < 16; ++i) { ex[i] = __expf(__uint_as_float(__float_as_uint(c0[i]) & ~511u) - mx); sm += ex[i]; }
        const float inv = 1.0f / sm;
        asm volatile("s_waitcnt lgkmcnt(0)" ::: "memory");
        int eo[8]; float go[8];
#pragma unroll
        for (int k = 0; k < 8; ++k) { const float wv = hi ? c0[8 + k] : c0[k]; go[k] = (hi ? ex[8 + k] : ex[k]) * inv;
            const unsigned bits = __float_as_uint(wv), fromhi = (bits >> 8) & 1u, xi = (bits >> 4) & 15u, yj = bits & 15u;
            const unsigned ar = fromhi ? yj : xi, br = fromhi ? xi : yj;
            const unsigned e1 = scr[n32 * 32 + ar], e2 = scr[n32 * 32 + 16 + br];
            eo[k] = (int)(e1 * 128u + e2); }
        unsigned short* ip = IDX + (size_t)t * PSEL + h * PTOP + 8 * hi; float* gp = GATE + (size_t)t * PSEL + h * PTOP + 8 * hi;
        *(v4u*)ip = (v4u){(unsigned)eo[0] | ((unsigned)eo[1] << 16), (unsigned)eo[2] | ((unsigned)eo[3] << 16), (unsigned)eo[4] | ((unsigned)eo[5] << 16), (unsigned)eo[6] | ((unsigned)eo[7] << 16)};
        *(f32x4*)gp = (f32x4){go[0], go[1], go[2], go[3]}; *(f32x4*)(gp + 4) = (f32x4){go[4], go[5], go[6], go[7]};
        asm volatile("s_waitcnt lgkmcnt(0)" ::: "memory");
    }
#undef RT_QLOAD
#undef RT_HALF
    __syncthreads();
}

typedef float f32x2 __attribute__((ext_vector_type(2)));
typedef int v4i __attribute__((ext_vector_type(4)));
__device__ __forceinline__ void h2q_token(const Args& A, int t, int lane) {
    const float* modf = (const float*)(A.ws + WS_MODF); const float* ss2 = (const float*)(A.ws + WS_SS2); const float* g2 = A.in[12];
    const int b = t / SEQ; const float* xr = A.out + (size_t)t * D + 16 * lane;
    const f32x4* sp = (const f32x4*)(ss2 + (size_t)t * 16); const f32x4 s4 = (sp[0] + sp[1]) + (sp[2] + sp[3]);
    const float rs = 1.0f / sqrtf(((s4[0] + s4[1]) + (s4[2] + s4[3])) * (1.0f / D) + RMS_EPS);
    float h2[16]; float am = 0.f;
#pragma unroll
    for (int q = 0; q < 4; ++q) { const int c = 16 * lane + 4 * q; const f32x4 xv = *(const f32x4*)(xr + 4 * q), gg = *(const f32x4*)(g2 + c), sc = *(const f32x4*)(modf + (size_t)b * 6144 + 4096 + c), sh = *(const f32x4*)(modf + (size_t)b * 6144 + 3072 + c);
#pragma unroll
        for (int e = 0; e < 4; ++e) { const float h = xv[e] * rs * (gg[e] * (1.0f + sc[e])) + sh[e]; h2[4 * q + e] = h; am = fmaxf(am, fabsf(h)); } }
    am = fmaxf(am, __shfl_xor(am, 1)); am = fmaxf(am, __shfl_xor(am, 2)); am = fmaxf(am, __shfl_xor(am, 4));
    const float hs = (am > 0.f) ? am * (1.0f / 127.0f) : 1.0f, hinv = 1.0f / hs;
    v4u o;
#pragma unroll
    for (int q = 0; q < 4; ++q) { const int q0 = (int)rintf(h2[4 * q] * hinv), q1 = (int)rintf(h2[4 * q + 1] * hinv), q2 = (int)rintf(h2[4 * q + 2] * hinv), q3 = (int)rintf(h2[4 * q + 3] * hinv);
        o[q] = (unsigned)(q0 & 255) | ((unsigned)(q1 & 255) << 8) | ((unsigned)(q2 & 255) << 16) | ((unsigned)q3 << 24); }
    *(v4u*)(A.ws + WS_H2Q + (size_t)t * D + 16 * lane) = o;
    if ((lane & 7) == 0) ((float*)(A.ws + WS_HS))[(size_t)t * 8 + (lane >> 3)] = hs;
}

__device__ __forceinline__ float gelu_tanh(float x) { const float u = 0.7978845608028654f * (x + 0.044715f * x * x * x); return x / (1.0f + __expf(-2.0f * u)); }
__device__ __forceinline__ void peer_sliced_phase(Frame& F, const Args& A) {
    const int lane = F.lane, c8 = lane & 7, g8 = lane >> 3, gw = F.vcu * NWAVES + F.wave, NGW = F.G * NWAVES;
    const float* modf = (const float*)(A.ws + WS_MODF);
    const unsigned char* U8 = A.ws + WS_U; const unsigned char* V8 = A.ws + WS_V;
    const float* SU = (const float*)(A.ws + WS_U + 16 * MiB); const float* SV = (const float*)(A.ws + WS_V + 16 * MiB);
    const unsigned short* IDX = (const unsigned short*)(A.ws + WS_POOLED); const float* GATE = (const float*)(A.ws + WS_POOLED + 16 * MiB);
    const float* gf = A.in[17];
    LAS float* AL = (LAS float*)(F.lds + F.wave * 17664);
    LAS float* SSQ = AL + 2048;
    LAS float* SAV = AL + 3072;
    LAS float* RS2 = AL + 3088;
    LAS float* GS = AL + 3104;
    LAS unsigned short* IDL = (LAS unsigned short*)(AL + 3360);
    for (int tb = gw * 16; tb < T; tb += NGW * 16) {
        for (int i = lane; i < 2048; i += 64) AL[i] = 0.f;
        for (int i = lane; i < 1024; i += 64) SSQ[i] = 0.f;
#pragma unroll
        for (int i = 0; i < 16; ++i) *(LAS unsigned*)(IDL + i * 128 + 2 * lane) = *(const unsigned*)(IDX + (size_t)(tb + i) * PSEL + 2 * lane);
        if (lane < 16) { const f32x4* sp = (const f32x4*)((const float*)(A.ws + WS_SS2) + (size_t)(tb + lane) * 16); const f32x4 s4 = (sp[0] + sp[1]) + (sp[2] + sp[3]);
            RS2[lane] = 1.0f / sqrtf(((s4[0] + s4[1]) + (s4[2] + s4[3])) * (1.0f / D) + RMS_EPS); }
        LDS_WAIT();
        {
            v4i W0[16], W1[16]; f32x4 X0[4], X1[4]; v4i H; float hs;
            const int bU = tb / SEQ; const float* g2 = A.in[12];
#define PU_X(k, X) do { const int k_ = (k) < 128 ? (k) : 127; const int s_ = k_ >> 4, t_ = tb + (k_ & 15); _Pragma("unroll") for (int q = 0; q < 4; ++q) X[q] = *(const f32x4*)(A.out + (size_t)t_ * D + 128 * s_ + 16 * c8 + 4 * q); } while (0)
#define PU_B(k, W) do { const int k_ = (k) < 128 ? (k) : 127; const int s_ = k_ >> 4; const unsigned base_ = ((unsigned)s_ << 21) + 16u * (unsigned)c8; v4u I[2]; I[0] = *(const LAS v4u*)(IDL + (k_ & 15) * 128 + 16 * g8); I[1] = *(const LAS v4u*)(IDL + (k_ & 15) * 128 + 16 * g8 + 8); \
            _Pragma("unroll") for (int j = 0; j < 16; ++j) W[j] = *(const v4i*)(U8 + (base_ + (((I[j >> 3][(j >> 1) & 3] >> (16 * (j & 1))) & 0xffffu) << 7))); \
            } while (0)
#define PU_Q(k, X) do { const int s_ = (k) >> 4, i_ = (k) & 15; \
            if (i_ == 0) { LDS_WAIT(); if (g8 == 0) { _Pragma("unroll") for (int q = 0; q < 4; ++q) { const int cc = 128 * s_ + 16 * c8 + 4 * q; const f32x4 gg = *(const f32x4*)(g2 + cc), sc = *(const f32x4*)(modf + (size_t)bU * 6144 + 4096 + cc), sh = *(const f32x4*)(modf + (size_t)bU * 6144 + 3072 + cc); \
                *(LAS f32x4*)(GS + c8 * 16 + 4 * q) = gg * (sc + 1.0f); *(LAS f32x4*)(GS + 128 + c8 * 16 + 4 * q) = sh; } } LDS_WAIT(); } \
            const float rs_ = RS2[i_]; float h2[16]; float am = 0.f; \
            _Pragma("unroll") for (int q = 0; q < 4; ++q) { const f32x4 gq = *(const LAS f32x4*)(GS + c8 * 16 + 4 * q), sq = *(const LAS f32x4*)(GS + 128 + c8 * 16 + 4 * q); \
                _Pragma("unroll") for (int e = 0; e < 4; ++e) { const float h = X[q][e] * rs_ * gq[e] + sq[e]; h2[4 * q + e] = h; am = fmaxf(am, fabsf(h)); } } \
            am = fmaxf(am, __shfl_xor(am, 1)); am = fmaxf(am, __shfl_xor(am, 2)); am = fmaxf(am, __shfl_xor(am, 4)); \
            hs = (am > 0.f) ? am * (1.0f / 127.0f) : 1.0f; const float hinv = 1.0f / hs; \
            _Pragma("unroll") for (int q = 0; q < 4; ++q) { const int q0 = (int)rintf(h2[4 * q] * hinv), q1 = (int)rintf(h2[4 * q + 1] * hinv), q2 = (int)rintf(h2[4 * q + 2] * hinv), q3 = (int)rintf(h2[4 * q + 3] * hinv); \
                H[q] = (int)((unsigned)(q0 & 255) | ((unsigned)(q1 & 255) << 8) | ((unsigned)(q2 & 255) << 16) | ((unsigned)q3 << 24)); } } while (0)
#define PU_C(k, W) do { int part[16]; \
            _Pragma("unroll") for (int j = 0; j < 16; ++j) part[j] = __builtin_amdgcn_sdot4(W[j].x, H.x, __builtin_amdgcn_sdot4(W[j].y, H.y, __builtin_amdgcn_sdot4(W[j].z, H.z, __builtin_amdgcn_sdot4(W[j].w, H.w, 0, false), false), false), false); \
            _Pragma("unroll") for (int step = 4; step >= 1; step >>= 1) { const bool up = (lane & step) != 0; \
                _Pragma("unroll") for (int i = 0; i < 2 * step; ++i) { const int send = up ? part[i] : part[i + 2 * step], keep = up ? part[i + 2 * step] : part[i]; part[i] = keep + __shfl_xor(send, step); } } \
            LAS f32x2* ap_ = (LAS f32x2*)(AL + ((k) & 15) * 128 + 2 * lane); f32x2 a_ = *ap_; a_.x += hs * (float)part[0]; a_.y += hs * (float)part[1]; *ap_ = a_; } while (0)
            PU_X(0, X0); PU_X(1, X1); PU_B(0, W0);
#pragma unroll 1
            for (int k = 0; k < 128; k += 2) {
                PU_Q(k, X0); PU_B(k + 1, W1); PU_X(k + 2, X0);
                PU_C(k, W0);
                PU_Q(k + 1, X1); PU_B(k + 2, W0); PU_X(k + 3, X1);
                PU_C(k + 1, W1);
            }
#undef PU_X
#undef PU_B
#undef PU_Q
#undef PU_C
        }
        LDS_WAIT();
#pragma unroll 4
        for (int i = 0; i < 16; ++i) {
            const int t = tb + i; const unsigned e01 = *(const LAS unsigned*)(IDL + i * 128 + 2 * lane); const int e0 = (int)(e01 & 0xffffu), e1 = (int)(e01 >> 16);
            const f32x2 gt = *(const f32x2*)(GATE + (size_t)t * PSEL + 2 * lane); const f32x2 a = *(LAS f32x2*)(AL + i * 128 + 2 * lane);
            f32x2 av; av.x = gelu_tanh(a.x * SU[e0]) * gt.x * SV[e0]; av.y = gelu_tanh(a.y * SU[e1]) * gt.y * SV[e1];
            *(LAS f32x2*)(AL + i * 128 + 2 * lane) = av;
            const float sm = wave_sum(av.x + av.y); if (lane == 0) SAV[i] = 128.0f * sm;
        }
        LDS_WAIT();
        {
            v4u W0[16], W1[16]; f32x2 X0, X1, gt2v = (f32x2){0.f, 0.f};
            const int b = tb / SEQ;
#define PV_B(k, W, X) do { const int k_ = (k) < 128 ? (k) : 127; const int s_ = k_ >> 4, t_ = tb + (k_ & 15); const unsigned base_ = ((unsigned)s_ << 21) + 16u * (unsigned)c8; v4u I[2]; I[0] = *(const LAS v4u*)(IDL + (k_ & 15) * 128 + 16 * g8); I[1] = *(const LAS v4u*)(IDL + (k_ & 15) * 128 + 16 * g8 + 8); \
            _Pragma("unroll") for (int j = 0; j < 16; ++j) W[j] = *(const v4u*)(V8 + (base_ + (((I[j >> 3][(j >> 1) & 3] >> (16 * (j & 1))) & 0xffffu) << 7))); \
            X = __builtin_nontemporal_load((const f32x2*)(A.out + (size_t)t_ * D + 128 * s_ + 16 * c8 + 2 * g8)); } while (0)
#define PV_C(k, W, X) do { const int s_ = (k) >> 4, i_ = (k) & 15; \
            if (i_ == 0) gt2v = *(const f32x2*)(modf + (size_t)b * 6144 + 5120 + 128 * s_ + 16 * c8 + 2 * g8); \
            f32x2 acc[8]; _Pragma("unroll") for (int q = 0; q < 8; ++q) acc[q] = (f32x2){0.f, 0.f}; \
            const LAS f32x4* avp_ = (const LAS f32x4*)(AL + i_ * 128 + 16 * g8); \
            _Pragma("unroll") for (int q4 = 0; q4 < 4; ++q4) { const f32x4 a4 = avp_[q4]; \
                _Pragma("unroll") for (int e = 0; e < 4; ++e) { const float a = a4[e]; const v4u w = W[4 * q4 + e]; \
                    acc[0] += (f32x2){(float)(w.x & 255u), (float)((w.x >> 8) & 255u)} * a; acc[1] += (f32x2){(float)((w.x >> 16) & 255u), (float)(w.x >> 24)} * a; \
                    acc[2] += (f32x2){(float)(w.y & 255u), (float)((w.y >> 8) & 255u)} * a; acc[3] += (f32x2){(float)((w.y >> 16) & 255u), (float)(w.y >> 24)} * a; \
                    acc[4] += (f32x2){(float)(w.z & 255u), (float)((w.z >> 8) & 255u)} * a; acc[5] += (f32x2){(float)((w.z >> 16) & 255u), (float)(w.z >> 24)} * a; \
                    acc[6] += (f32x2){(float)(w.w & 255u), (float)((w.w >> 8) & 255u)} * a; acc[7] += (f32x2){(float)((w.w >> 16) & 255u), (float)(w.w >> 24)} * a; } } \
            float pc[16]; _Pragma("unroll") for (int q = 0; q < 8; ++q) { pc[2 * q] = acc[q].x; pc[2 * q + 1] = acc[q].y; } \
            _Pragma("unroll") for (int step = 4; step >= 1; step >>= 1) { const bool up = (g8 & step) != 0; \
                _Pragma("unroll") for (int i = 0; i < 2 * step; ++i) { const float send = up ? pc[i] : pc[i + 2 * step], keep = up ? pc[i + 2 * step] : pc[i]; pc[i] = keep + __shfl_xor(send, 8 * step); } } \
            const float sav_ = SAV[i_]; f32x2 x2_; x2_.x = X.x + gt2v.x * (pc[0] - sav_); x2_.y = X.y + gt2v.y * (pc[1] - sav_); \
            *(f32x2*)(A.out + (size_t)(tb + i_) * D + 128 * s_ + 16 * c8 + 2 * g8) = x2_; \
            SSQ[i_ * 64 + lane] += x2_.x * x2_.x + x2_.y * x2_.y; } while (0)
            PV_B(0, W0, X0);
#pragma unroll 1
            for (int k = 0; k < 128; k += 2) {
                PV_B(k + 1, W1, X1);
                PV_C(k, W0, X0);
                PV_B(k + 2, W0, X0);
                PV_C(k + 1, W1, X1);
            }
#undef PV_B
#undef PV_C
        }
        VM_WAIT(); LDS_WAIT();
#pragma unroll 2
        for (int i = 0; i < 16; ++i) {
            float* xr = A.out + (size_t)(tb + i) * D + 16 * lane;
            f32x4 v[4];
#pragma unroll
            for (int q = 0; q < 4; ++q) v[q] = __builtin_nontemporal_load((const f32x4*)(xr + 4 * q));
            const float rs = 1.0f / sqrtf(wave_sum(SSQ[i * 64 + lane]) * (1.0f / D) + RMS_EPS);
#pragma unroll
            for (int q = 0; q < 4; ++q) *(f32x4*)(xr + 4 * q) = v[q] * rs * *(const f32x4*)(gf + 16 * lane + 4 * q);
        }
        LDS_WAIT();
    }
}

#ifndef PHASE_ONLY
#define PHASE_ONLY -1
#endif
#ifndef PHASE_SKIP
#define PHASE_SKIP -2
#endif
#define PH(n) ((PHASE_ONLY < 0 || PHASE_ONLY == (n)) && PHASE_SKIP != (n))
#ifndef PROBE_DOUBLE
#define PROBE_DOUBLE -1
#endif
#define REPS(n) for (int rep_ = 0; rep_ < ((PROBE_DOUBLE == (n)) ? 2 : 1); ++rep_)
__global__ void __launch_bounds__(NTHREADS, 2) fwd_megakernel(Args A) {
    extern __shared__ __attribute__((aligned(16))) unsigned char lds[];
    Frame F;
    F.lds = (LAS unsigned char*)lds;
    F.MISC = (volatile LAS unsigned*)(F.lds + MISC_OFF);
    F.tid = threadIdx.x; F.lane = F.tid & 63; F.wave = __builtin_amdgcn_readfirstlane(F.tid >> 6);
    F.G = gridDim.x; { const int bx = blockIdx.x; F.vcu = (F.G % 8 == 0) ? (bx % 8) * (F.G / 8) + bx / 8 : bx; }
    F.ctl = (gu32*)(A.ws + WS_CTL);
    for (int u = F.tid; u < (LDS_BYTES - LDSCTL_OFF) / 4; u += NTHREADS) ((LAS unsigned*)(F.lds + LDSCTL_OFF))[u] = 0u;
    __syncthreads();
    XcdBarrier bar = xcd_barrier_post((unsigned*)(F.ctl + CW_BAR), F.MISC + 8);
#define GRID_BAR() do { xcd_barrier(bar); int t_ = threadIdx.x; asm volatile("" : "+v"(t_)); F.tid = t_; F.lane = t_ & 63; F.wave = __builtin_amdgcn_readfirstlane(t_ >> 6); } while (0)
    unsigned char* ws = A.ws;

    REPS(0) if (PH(0)) { p0a_mod(F, A); p0b_prologue<0>(F, A); }
    GRID_BAR();
    REPS(1) if (PH(1)) p0b_prologue<1>(F, A);
    GRID_BAR();
    REPS(2) if (PH(2)) {
        pg8::Gemm g{(const bf16*)(ws + WS_XG), nullptr, (const bf16*)(ws + WS_WIN), nullptr, D, D, D};
        pg8::StaticOrder S; S.init(T, INW, F.G, (int)blockIdx.x);
        pg8::EpiIn E{(bf16*)(ws + WS_QKVP), (bf16*)(ws + WS_GAB), (const float*)(ws + WS_RSTD1), (const float*)(ws + WS_BIAS1P), (float*)(ws + WS_KSUM), (unsigned*)(ws + WS_CTL) + CW_NRM};
        pg8::gemm_phase<pg8::EpiIn, pg8::StaticOrder, true, true>(F.lds + RING_OFF, g, S, E);
    }
    GRID_BAR();
    REPS(3) if (PH(3)) {
        const attn_body::AttnTensors AT{(const attn_body::bf16*)(ws + WS_QKVP), (const attn_body::bf16*)(ws + WS_QKVP) + (size_t)T * 512, (const attn_body::bf16*)(ws + WS_QKVP) + (size_t)2 * T * 512, (PROBE_DOUBLE == 3 && rep_ == 0) ? (attn_body::bf16*)(ws + WS_XG) : (attn_body::bf16*)(ws + WS_QKVP)};
        const attn_body::StaticOrder S((int)F.G, F.vcu);
        attn_body::attn_phase<attn_body::StaticOrder>((char*)lds + RING_OFF, AT, (const float*)(ws + WS_KSUM), (const float*)((const unsigned*)(ws + WS_CTL) + CW_NRM), S);
    }
    REPS(4) if (PH(4)) pooled_phase(F, A);
    GRID_BAR();
    REPS(5) if (PH(5)) {
        pg8::Gemm g{(const bf16*)(ws + WS_QKVP), (const bf16*)(ws + WS_POOLED), (const bf16*)(ws + WS_WA), (const bf16*)(ws + WS_WP), AW, AW, AW};
        pg8::DualOrder S; S.init(T, D, F.G, (int)blockIdx.x);
        pg8::EpiUp E{(bf16*)(ws + WS_XG), (const bf16*)(ws + WS_GAB), (const float*)(ws + WS_BPRIME)};
        pg8::gemm_phase<pg8::EpiUp, pg8::DualOrder, true, true>(F.lds + RING_OFF, g, S, E);
    }
    GRID_BAR();
    REPS(6) if (PH(6)) {
        pg8::Gemm g{(const bf16*)(ws + WS_XG), nullptr, (const bf16*)(ws + WS_WOUT), nullptr, D, D, D};
        pg8::StaticOrder S; S.init(T, D, F.G, (int)blockIdx.x);
        pg8::EpiOut E{A.in[0], A.out, (bf16*)(ws + WS_QKVP), (const float*)(ws + WS_MODF), A.in[12], (float*)(ws + WS_SS2)};
        pg8::gemm_phase<pg8::EpiOut, pg8::StaticOrder, true, true>(F.lds + RING_OFF, g, S, E);
    }
    GRID_BAR();
    REPS(7) if (PH(7)) {
        pg8::Gemm g{(const bf16*)(ws + WS_QKVP), nullptr, (const bf16*)(ws + WS_WQ), nullptr, D, D, D};
        pg8::StaticOrder S; S.init(T, PQW, F.G, (int)blockIdx.x);
        pg8::EpiPq E{(bf16*)(ws + WS_GAB), (const float*)(ws + WS_SS2), (const float*)(ws + WS_BIAS2P)};
        pg8::gemm_phase<pg8::EpiPq, pg8::StaticOrder, true, true>(F.lds + RING_OFF, g, S, E);
    }
    GRID_BAR();
    REPS(8) if (PH(8)) router_phase(F, A);
    GRID_BAR();
    if (PH(9)) peer_sliced_phase(F, A);
}

extern "C" void kernel_launch(void* const* d_in, const int* in_sizes, int n_in, void* d_out, int out_size, void* d_ws, size_t ws_size, hipStream_t stream) {
    static int grid = 0;
    if (grid == 0) {
        if (n_in != 18 || in_sizes[0] != T * D || out_size != T * D || ws_size < WS_END) { fprintf(stderr, "kernel_launch: unexpected shapes (n_in %d, in0 %d, out %d, ws %zu); nothing launched\n", n_in, n_in > 0 ? in_sizes[0] : -1, out_size, ws_size); grid = -1; return; }
        int dev = 0, cus = 0, per_cu = 0;
        if (hipGetDevice(&dev) != hipSuccess || hipDeviceGetAttribute(&cus, hipDeviceAttributeMultiprocessorCount, dev) != hipSuccess) { grid = -1; return; }
        if (hipFuncSetAttribute((const void*)fwd_megakernel, hipFuncAttributeMaxDynamicSharedMemorySize, LDS_BYTES) != hipSuccess) { fprintf(stderr, "kernel_launch: hipFuncSetAttribute failed\n"); grid = -1; return; }
        if (hipOccupancyMaxActiveBlocksPerMultiprocessor(&per_cu, (const void*)fwd_megakernel, NTHREADS, LDS_BYTES) != hipSuccess || per_cu < 1) { fprintf(stderr, "kernel_launch: occupancy query reports %d workgroups per CU\n", per_cu); per_cu = 1; }
        (void)hipGetLastError();
        grid = cus;
    }
    if (grid < 0) return;
    if (hipMemsetAsync((char*)d_ws + WS_CTL, 0, CTL_ZERO_BYTES, stream) != hipSuccess) { fprintf(stderr, "kernel_launch: hipMemsetAsync failed\n"); return; }
    Args a{};
    for (int i = 0; i < 18; ++i) a.in[i] = (const float*)d_in[i];
    a.out = (float*)d_out; a.ws = (unsigned char*)d_ws;
    void* kargs[] = {&a};
    hipError_t e = hipLaunchCooperativeKernel((const void*)fwd_megakernel, dim3(grid), dim3(NTHREADS), kargs, LDS_BYTES, stream);
    if (e != hipSuccess) fprintf(stderr, "kernel_launch: cooperative launch failed: %s (grid %d)\n", hipGetErrorString(e), grid);
}
```

```cpp
#include <hip/hip_runtime.h>
#include <hip/hip_bf16.h>
#include <cstdio>
#include <cstdint>
#include <cmath>

constexpr int NB = 8, SEQ = 4096, T = NB * SEQ, D = 1024;
constexpr int AW = 512, PW = 512, INW = 4096;
constexpr int NH = 8, HD = 64, MBLK = 256, NBLK = SEQ / MBLK;
constexpr int PQW = 2048, PEXP = 16384, PTOP = 16, PHEADS = 8, PSEL = PHEADS * PTOP;
constexpr float RMS_EPS = 1e-6f;
constexpr float LOG2E = 1.4426950408889634f;
constexpr float QSCALE = 0.125f * LOG2E;
constexpr int NWAVES = 8, NTHREADS = 512;

namespace pg8 {
#define PG8_LAS __attribute__((address_space(3)))
typedef unsigned short bf16_t;
typedef short bf16x8 __attribute__((ext_vector_type(8)));
typedef float f32x4 __attribute__((ext_vector_type(4)));
typedef unsigned u32x4 __attribute__((ext_vector_type(4)));
constexpr int BM = 256, BK = 64, HALF = 128, HTB = HALF * BK * 2  , STAGE_BYTES = 8 * HTB, NXCD = 8, WGM = 8;

__host__ __device__ __forceinline__ int lds_byte(int r, int c) { const int st = (r >> 4) * 2 + (c >> 5), rr = r & 15, cc = c & 31, ob = rr * 64 + cc * 2; return st * 1024 + (ob ^ (((ob >> 9) & 1) << 5)); }
__host__ __device__ __forceinline__ void stage_rc(int b, int& R, int& C) { const int st = b / 1024, sb = b % 1024, swz = sb ^ (((sb >> 9) & 1) << 5); R = (st >> 1) * 16 + swz / 64; C = (st & 1) * 32 + (swz % 64) / 2; }
__host__ __device__ __forceinline__ int perm32(int rho) { const int n = rho >> 4, i = rho & 15; return 8 * (i >> 2) + 4 * n + (i & 3); }

struct Unit { int pm, pn, part; };
struct Gemm {
    const bf16_t* A0; const bf16_t* A1; const bf16_t* B0; const bf16_t* B1; int lda, ldb, K;
    __device__ __forceinline__ const char* a_ptr(const Unit& u) const { return (const char*)(u.part ? A1 : A0) + (size_t)u.pm * BM * lda * 2; }
    __device__ __forceinline__ const char* b_ptr(const Unit& u) const { return (const char*)(u.part ? B1 : B0) + (size_t)u.pn * BM * ldb * 2; }
};

struct StaticOrder {
    int nM, nN, nwg, G, c;
    __host__ __device__ void init(int M, int N, int G_, int c_) { nM = M / BM; nN = N / BM; nwg = nM * nN; G = G_; c = c_; }
    __host__ __device__ bool tile(long L, Unit& u) const {
        if (L >= nwg) return false;
        int wgid = (int)L; { const int q = nwg / NXCD, r = nwg % NXCD, xcd = wgid % NXCD, off = wgid / NXCD; wgid = (xcd < r ? xcd * (q + 1) : r * (q + 1) + (xcd - r) * q) + off; }
        const int nig = WGM * nN, gid = wgid / nig, fm = gid * WGM, gsz = (nM - fm) < WGM ? (nM - fm) : WGM;
        u.pm = fm + ((wgid % nig) % gsz); u.pn = (wgid % nig) / gsz; u.part = 0; return true;
    }
    __host__ __device__ bool next(int i, Unit& u) const { return tile((long)i * G + c, u); }
    __device__ __forceinline__ void a_ready(const Unit&) const {}
    __device__ __forceinline__ void done(const Unit&) const {}
};
struct DualOrder {
    StaticOrder so;
    __host__ __device__ void init(int M, int N, int G_, int c_) { so.init(M, N, G_, c_); }
    __host__ __device__ bool next(int i, Unit& u) const { if (!so.tile((long)(i >> 1) * so.G + so.c, u)) return false; u.part = i & 1; return true; }
    __device__ __forceinline__ void a_ready(const Unit&) const {}
    __device__ __forceinline__ void done(const Unit&) const {}
};

__device__ __forceinline__ unsigned cvt_pk_bf16(float lo, float hi) { unsigned r; asm volatile("v_cvt_pk_bf16_f32 %0, %1, %2" : "=v"(r) : "v"(lo), "v"(hi)); return r; }
__device__ __forceinline__ float bf_lo(unsigned w) { return __uint_as_float(w << 16); }
__device__ __forceinline__ float bf_hi(unsigned w) { return __uint_as_float(w & 0xffff0000u); }
__device__ __forceinline__ float sigmoidf_(float x) { return __builtin_amdgcn_rcpf(1.0f + __builtin_amdgcn_exp2f(-x * 1.4426950408889634f)); }


struct EpiIn {
    static constexpr bool PERM = true, AFTER_DRAIN = false;
    bf16_t* QKVP; bf16_t* GAB; const float* rstd1; const float* bias1p; float* ksum; unsigned* nrm;
    __device__ __forceinline__ void operator()(const f32x4 (&acc)[2][2][4][2], const Unit& u, int wr, int wc, int fr, int fq) const {
        bf16_t* base; int ldc, col0;
        if (u.pn < 8) { base = QKVP + (size_t)(u.pn >> 1) * T * 512; ldc = 512; col0 = (u.pn & 1) * 256; }
        else { base = GAB + (size_t)((u.pn - 8) >> 2) * T * 1024; ldc = 1024; col0 = ((u.pn - 8) & 3) * 256; }
        const float sc = (u.pn < 2) ? QSCALE : 1.0f;
        const int b = u.pm >> 4;
        const int bcol = u.pn * 256 + wc * 32 + 8 * fq;
        f32x4 bv[2][2];
#pragma unroll
        for (int bj = 0; bj < 2; ++bj)
#pragma unroll
            for (int n = 0; n < 2; ++n) { f32x4 s = (f32x4){0.f, 0.f, 0.f, 0.f};
#pragma unroll
                for (int kc = 0; kc < 8; ++kc) s += *(const f32x4*)(bias1p + (size_t)(kc * 8 + b) * INW + bcol + bj * HALF + 4 * n);
                bv[bj][n] = s; }
        const bool isk = (u.pn == 2 || u.pn == 3); const bool isqk = (u.pn < 4); float nmax[2] = {0.f, 0.f};
        f32x4 ks[2][2];
#pragma unroll
        for (int bj = 0; bj < 2; ++bj)
#pragma unroll
            for (int n = 0; n < 2; ++n) ks[bj][n] = (f32x4){0.f, 0.f, 0.f, 0.f};
        const int row0 = u.pm * BM + wr * 64 + fr;
#pragma unroll
        for (int ai = 0; ai < 2; ++ai)
#pragma unroll
            for (int m = 0; m < 4; ++m) { const int row = row0 + ai * HALF + m * 16; const float rs = rstd1[row];
                bf16_t* rowp = base + (size_t)row * ldc + col0 + wc * 32 + 8 * fq;
#pragma unroll
                for (int bj = 0; bj < 2; ++bj) { f32x4 v0 = acc[ai][bj][m][0] * rs + bv[bj][0], v1 = acc[ai][bj][m][1] * rs + bv[bj][1];
                    ks[bj][0] += v0; ks[bj][1] += v1;
                    v0 = v0 * sc; v1 = v1 * sc;
                    if (isqk) { float ss = (v0[0] * v0[0] + v0[1] * v0[1]) + (v0[2] * v0[2] + v0[3] * v0[3]) + (v1[0] * v1[0] + v1[1] * v1[1]) + (v1[2] * v1[2] + v1[3] * v1[3]); ss += __shfl_xor(ss, 16); ss += __shfl_xor(ss, 32); nmax[bj] = fmaxf(nmax[bj], ss); }
                    u32x4 w; w.x = cvt_pk_bf16(v0[0], v0[1]); w.y = cvt_pk_bf16(v0[2], v0[3]); w.z = cvt_pk_bf16(v1[0], v1[1]); w.w = cvt_pk_bf16(v1[2], v1[3]);
                    *(u32x4*)(rowp + bj * HALF) = w; } }
        if (isqk) {
#pragma unroll
            for (int bj = 0; bj < 2; ++bj) { float v = nmax[bj]; v = fmaxf(v, __shfl_xor(v, 1)); v = fmaxf(v, __shfl_xor(v, 2)); v = fmaxf(v, __shfl_xor(v, 4)); v = fmaxf(v, __shfl_xor(v, 8));
                if (fr == 0 && fq == 0) atomicMax(nrm + (size_t)(b * 2 + (u.pn >> 1)) * 16 + (u.pn & 1) * 8 + bj * 4 + wc, __float_as_uint(v)); }
        }
        if (isk) {
#pragma unroll
            for (int bj = 0; bj < 2; ++bj)
#pragma unroll
                for (int n = 0; n < 2; ++n)
#pragma unroll
                    for (int e = 0; e < 4; ++e) { float v = ks[bj][n][e]; v += __shfl_xor(v, 1); v += __shfl_xor(v, 2); v += __shfl_xor(v, 4); v += __shfl_xor(v, 8); ks[bj][n][e] = v; }
            if (fr == 0) { float* kp = ksum + (size_t)u.pm * 512 + (u.pn - 2) * 256 + wc * 32 + 8 * fq;
#pragma unroll
                for (int bj = 0; bj < 2; ++bj)
#pragma unroll
                    for (int n = 0; n < 2; ++n)
#pragma unroll
                        for (int e = 0; e < 4; ++e) atomicAdd(kp + bj * HALF + 4 * n + e, ks[bj][n][e]); }
        }
    }
};

struct EpiUp {
    static constexpr bool PERM = true, AFTER_DRAIN = false;
    bf16_t* merged; const bf16_t* GAB; const float* bprime;
    __device__ __forceinline__ void operator()(const f32x4 (&acc)[2][2][4][2], const Unit& u, int wr, int wc, int fr, int fq) const {
        const int row0 = u.pm * BM + wr * 64 + fr, colb = u.pn * BM + wc * 32 + 8 * fq;
        const bf16_t* gate = GAB + (size_t)u.part * T * 1024;
        f32x4 bv[2][2];
#pragma unroll
        for (int bj = 0; bj < 2; ++bj)
#pragma unroll
            for (int n = 0; n < 2; ++n) { f32x4 s_ = (f32x4){0.f, 0.f, 0.f, 0.f}; if (u.part) { _Pragma("unroll") for (int g_ = 0; g_ < 4; ++g_) s_ += *(const f32x4*)(bprime + g_ * 1024 + colb + bj * HALF + 4 * n); } bv[bj][n] = s_; }
#pragma unroll
        for (int ai = 0; ai < 2; ++ai) {
            u32x4 gpre[4][2], ppre[4][2];
#pragma unroll
            for (int m = 0; m < 4; ++m) { const size_t off = (size_t)(row0 + ai * HALF + m * 16) * 1024 + colb;
#pragma unroll
                for (int bj = 0; bj < 2; ++bj) { gpre[m][bj] = __builtin_nontemporal_load((const u32x4*)(gate + off + bj * HALF));
                    if (u.part) ppre[m][bj] = __builtin_nontemporal_load((const u32x4*)(merged + off + bj * HALF)); else ppre[m][bj] = (u32x4){0u, 0u, 0u, 0u}; } }
#pragma unroll
            for (int m = 0; m < 4; ++m) { const size_t off = (size_t)(row0 + ai * HALF + m * 16) * 1024 + colb;
#pragma unroll
                for (int bj = 0; bj < 2; ++bj) {
                    const u32x4 gw = gpre[m][bj], pw = ppre[m][bj];
                    f32x4 v0 = acc[ai][bj][m][0] + bv[bj][0], v1 = acc[ai][bj][m][1] + bv[bj][1];
                    v0[0] *= sigmoidf_(bf_lo(gw.x)); v0[1] *= sigmoidf_(bf_hi(gw.x)); v0[2] *= sigmoidf_(bf_lo(gw.y)); v0[3] *= sigmoidf_(bf_hi(gw.y));
                    v1[0] *= sigmoidf_(bf_lo(gw.z)); v1[1] *= sigmoidf_(bf_hi(gw.z)); v1[2] *= sigmoidf_(bf_lo(gw.w)); v1[3] *= sigmoidf_(bf_hi(gw.w));
                    v0[0] += bf_lo(pw.x); v0[1] += bf_hi(pw.x); v0[2] += bf_lo(pw.y); v0[3] += bf_hi(pw.y); v1[0] += bf_lo(pw.z); v1[1] += bf_hi(pw.z); v1[2] += bf_lo(pw.w); v1[3] += bf_hi(pw.w);
                    u32x4 w; w.x = cvt_pk_bf16(v0[0], v0[1]); w.y = cvt_pk_bf16(v0[2], v0[3]); w.z = cvt_pk_bf16(v1[0], v1[1]); w.w = cvt_pk_bf16(v1[2], v1[3]);
                    *(u32x4*)(merged + off + bj * HALF) = w; } }
        }
        if (u.part == 0) asm volatile("s_waitcnt vmcnt(0)" ::: "memory");
    }
};

struct EpiOut {
    static constexpr bool PERM = true, AFTER_DRAIN = false;
    const float* x; float* x1; bf16_t* A2; const float* modf; const float* g2; float* ss2;
    __device__ __forceinline__ void operator()(const f32x4 (&acc)[2][2][4][2], const Unit& u, int wr, int wc, int fr, int fq) const {
        const int row0 = u.pm * BM + wr * 64 + fr, colb = u.pn * BM + wc * 32 + 8 * fq, b = u.pm >> 4;
        f32x4 gt[2][2], gg[2][2];
#pragma unroll
        for (int bj = 0; bj < 2; ++bj)
#pragma unroll
            for (int n = 0; n < 2; ++n) { const int c = colb + bj * HALF + 4 * n; gt[bj][n] = *(const f32x4*)(modf + (size_t)b * 6144 + 2048 + c);
                const f32x4 sc2 = *(const f32x4*)(modf + (size_t)b * 6144 + 4096 + c); gg[bj][n] = *(const f32x4*)(g2 + c) * (sc2 + 1.0f); }
#pragma unroll
        for (int ai = 0; ai < 2; ++ai) {
#pragma unroll
          for (int mh = 0; mh < 2; ++mh) {
            f32x4 xr[2][2][2];
#pragma unroll
            for (int m2 = 0; m2 < 2; ++m2) { const size_t off = (size_t)(row0 + ai * HALF + (2 * mh + m2) * 16) * 1024 + colb;
#pragma unroll
                for (int bj = 0; bj < 2; ++bj) { xr[m2][bj][0] = __builtin_nontemporal_load((const f32x4*)(x + off + bj * HALF)); xr[m2][bj][1] = __builtin_nontemporal_load((const f32x4*)(x + off + bj * HALF + 4)); } }
#pragma unroll
            for (int m2 = 0; m2 < 2; ++m2) { const int m = 2 * mh + m2; const int row = row0 + ai * HALF + m * 16; const size_t off = (size_t)row * 1024 + colb; float ssq = 0.f;
#pragma unroll
                for (int bj = 0; bj < 2; ++bj) {
                    const f32x4 y0 = xr[m2][bj][0] + gt[bj][0] * acc[ai][bj][m][0], y1 = xr[m2][bj][1] + gt[bj][1] * acc[ai][bj][m][1];
                    *(f32x4*)(x1 + off + bj * HALF) = y0; *(f32x4*)(x1 + off + bj * HALF + 4) = y1;
                    ssq += (y0[0] * y0[0] + y0[1] * y0[1]) + (y0[2] * y0[2] + y0[3] * y0[3]) + (y1[0] * y1[0] + y1[1] * y1[1]) + (y1[2] * y1[2] + y1[3] * y1[3]);
                    const f32x4 a0 = y0 * gg[bj][0], a1 = y1 * gg[bj][1];
                    u32x4 w; w.x = cvt_pk_bf16(a0[0], a0[1]); w.y = cvt_pk_bf16(a0[2], a0[3]); w.z = cvt_pk_bf16(a1[0], a1[1]); w.w = cvt_pk_bf16(a1[2], a1[3]);
                    *(u32x4*)(A2 + off + bj * HALF) = w; }
                ssq += __shfl_xor(ssq, 16); ssq += __shfl_xor(ssq, 32);
                if (fq == 0) ss2[(size_t)row * 16 + u.pn * 4 + wc] = ssq; }
          }
        }
    }
};

struct EpiPq {
    static constexpr bool PERM = true, AFTER_DRAIN = false;
    bf16_t* QP; const float* ss2; const float* bias2p;
    __device__ __forceinline__ void operator()(const f32x4 (&acc)[2][2][4][2], const Unit& u, int wr, int wc, int fr, int fq) const {
        const int row0 = u.pm * BM + wr * 64 + fr, colb = u.pn * BM + wc * 32 + 8 * fq, b = u.pm >> 4;
        f32x4 bv[2][2];
#pragma unroll
        for (int bj = 0; bj < 2; ++bj)
#pragma unroll
            for (int n = 0; n < 2; ++n) { f32x4 s = (f32x4){0.f, 0.f, 0.f, 0.f};
#pragma unroll
                for (int kc = 0; kc < 8; ++kc) s += *(const f32x4*)(bias2p + (size_t)(kc * 8 + b) * PQW + colb + bj * HALF + 4 * n);
                bv[bj][n] = s; }
#pragma unroll
        for (int ai = 0; ai < 2; ++ai)
#pragma unroll
            for (int m = 0; m < 4; ++m) { const int row = row0 + ai * HALF + m * 16;
                const f32x4* sp = (const f32x4*)(ss2 + (size_t)row * 16); const f32x4 s4 = (sp[0] + sp[1]) + (sp[2] + sp[3]);
                const float rs = __builtin_amdgcn_rsqf(((s4[0] + s4[1]) + (s4[2] + s4[3])) * (1.0f / D) + RMS_EPS);
                bf16_t* rowp = QP + (size_t)row * PQW + colb;
#pragma unroll
                for (int bj = 0; bj < 2; ++bj) { const f32x4 v0 = acc[ai][bj][m][0] * rs + bv[bj][0], v1 = acc[ai][bj][m][1] * rs + bv[bj][1];
                    u32x4 w; w.x = cvt_pk_bf16(v0[0], v0[1]); w.y = cvt_pk_bf16(v0[2], v0[3]); w.z = cvt_pk_bf16(v1[0], v1[1]); w.w = cvt_pk_bf16(v1[2], v1[3]);
                    *(u32x4*)(rowp + bj * HALF) = w; } }
    }
};

template <class Epi, class Sched, bool ALIGN_EPI = false, bool SP2 = false>
__device__ __forceinline__ void gemm_phase(PG8_LAS unsigned char* lds, const Gemm g, const Sched& S, const Epi& E) {
    int tid_ = threadIdx.x; asm volatile("" : "+v"(tid_));
    const int tid = tid_, wid = __builtin_amdgcn_readfirstlane(tid >> 6), lane = tid & 63, wr = wid >> 2, wc = wid & 3, fr = lane & 15, fq = lane >> 4;
    const int K = g.K, nt = K / BK, lda = g.lda, ldb = g.ldb;
    unsigned voffA[2], voffB[2];
#pragma unroll
    for (int i = 0; i < 2; ++i) { int R, C; stage_rc(tid * 16 + i * 8192, R, C); const int Rb = Epi::PERM ? ((R & ~31) + perm32(R & 31)) : R;
        voffA[i] = (unsigned)(R * lda + C) * 2u; voffB[i] = (unsigned)(Rb * ldb + C) * 2u; }
    const size_t kstep = (size_t)(BK * 2);
    const size_t hstepA = (size_t)HALF * lda * 2, hstepB = (size_t)HALF * ldb * 2;
    const unsigned ldsw = (unsigned)wid * 1024u;
    const int aoff = lds_byte(wr * 64 + fr, fq * 8), boff = lds_byte(wc * 32 + fr, fq * 8);
#define PG8_SA(b, h) (((b) * 2 + (h)) * HTB)
#define PG8_SB(b, h) ((4 + (b) * 2 + (h)) * HTB)
#define PG8_STAGE(bufoff, gbase, voff) do { _Pragma("unroll") for (int _i = 0; _i < 2; ++_i) \
        __builtin_amdgcn_global_load_lds((const unsigned*)((const char*)(gbase) + (voff)[_i]), (PG8_LAS unsigned*)(lds + (bufoff) + ldsw + _i * 8192), 16, 0, 0); } while (0)
#define PG8_LDA(dst, b, h) do { _Pragma("unroll") for (int m = 0; m < 4; ++m) _Pragma("unroll") for (int k = 0; k < 2; ++k) dst[m][k] = *(const PG8_LAS bf16x8*)(lds + PG8_SA(b, h) + aoff + m * 2048 + k * 1024); } while (0)
#define PG8_LDB(dst, b, h) do { _Pragma("unroll") for (int n = 0; n < 2; ++n) _Pragma("unroll") for (int k = 0; k < 2; ++k) dst[n][k] = *(const PG8_LAS bf16x8*)(lds + PG8_SB(b, h) + boff + n * 2048 + k * 1024); } while (0)
#define PG8_MMA(ai, bj, At, Bt) do { __builtin_amdgcn_s_setprio(1); _Pragma("unroll") for (int m = 0; m < 4; ++m) _Pragma("unroll") for (int n = 0; n < 2; ++n) _Pragma("unroll") for (int k = 0; k < 2; ++k) \
        acc[ai][bj][m][n] = __builtin_amdgcn_mfma_f32_16x16x32_bf16(Bt[n][k], At[m][k], acc[ai][bj][m][n], 0, 0, 0); __builtin_amdgcn_s_setprio(0); } while (0)
#define PG8_WAIT_V(n) asm volatile("s_waitcnt vmcnt(" #n ")" ::: "memory")
#define PG8_WAIT_L(n) asm volatile("s_waitcnt lgkmcnt(" #n ")" ::: "memory")
#define PG8_BAR __builtin_amdgcn_s_barrier()
#define PG8_SCHED __builtin_amdgcn_sched_barrier(0)
    Unit cur, nxt; int ui = 0;
    if (!S.next(0, cur)) return;
    f32x4 acc[2][2][4][2];
#pragma unroll
    for (int a = 0; a < 2; ++a)
#pragma unroll
        for (int b = 0; b < 2; ++b)
#pragma unroll
            for (int m = 0; m < 4; ++m)
#pragma unroll
                for (int n = 0; n < 2; ++n) acc[a][b][m][n] = (f32x4){0.f, 0.f, 0.f, 0.f};
    bf16x8 At[4][2], B0[2][2], B1[2][2];
    const char* cA = g.a_ptr(cur); const char* cB = g.b_ptr(cur);
    S.a_ready(cur);
    if constexpr (SP2) {
        PG8_STAGE(PG8_SB(0, 0), cB, voffB); PG8_STAGE(PG8_SB(0, 1), cB + hstepB, voffB); PG8_STAGE(PG8_SA(0, 0), cA, voffA); PG8_STAGE(PG8_SA(0, 1), cA + hstepA, voffA);
        if (wr == 1) PG8_BAR;
        PG8_WAIT_V(2); PG8_BAR;
        PG8_STAGE(PG8_SB(1, 0), cB + kstep, voffB); PG8_STAGE(PG8_SA(1, 0), cA + kstep, voffA); PG8_STAGE(PG8_SB(1, 1), cB + hstepB + kstep, voffB);
        PG8_WAIT_V(6); PG8_BAR;
    } else {
        PG8_STAGE(PG8_SB(0, 0), cB, voffB); PG8_STAGE(PG8_SA(0, 0), cA, voffA); PG8_STAGE(PG8_SB(0, 1), cB + hstepB, voffB); PG8_STAGE(PG8_SA(0, 1), cA + hstepA, voffA);
        if (wr == 1) PG8_BAR;
        PG8_WAIT_V(4); PG8_BAR;
        PG8_STAGE(PG8_SB(1, 0), cB + kstep, voffB); PG8_STAGE(PG8_SA(1, 0), cA + kstep, voffA); PG8_STAGE(PG8_SB(1, 1), cB + hstepB + kstep, voffB);
        PG8_WAIT_V(6); PG8_BAR;
    }
    for (;;) {
        const bool has_next = S.next(ui + 1, nxt);
        const char* nA = has_next ? g.a_ptr(nxt) : cA; const char* nB = has_next ? g.b_ptr(nxt) : cB;
        for (int t = 0; t < nt; t += 2) {
            const bool last = (t == nt - 2);
            const char* a1 = cA + (size_t)(t + 1) * kstep;
            const char* a2 = last ? nA : cA + (size_t)(t + 2) * kstep; const char* b2 = last ? nB : cB + (size_t)(t + 2) * kstep;
            const char* a3 = a2 + kstep; const char* b3 = b2 + kstep;
            if (last && has_next) S.a_ready(nxt);
            if constexpr (SP2) {
            PG8_LDB(B0, 0, 0); PG8_LDB(B1, 0, 1); PG8_SCHED; PG8_LDA(At, 0, 0); PG8_STAGE(PG8_SA(1, 1), a1 + hstepA, voffA);
            PG8_WAIT_V(8); PG8_WAIT_L(0); PG8_BAR; PG8_MMA(0, 0, At, B0); PG8_MMA(0, 1, At, B1); PG8_BAR; PG8_SCHED;
            PG8_LDA(At, 0, 1); PG8_STAGE(PG8_SB(0, 0), b2, voffB); PG8_STAGE(PG8_SB(0, 1), b2 + hstepB, voffB); PG8_STAGE(PG8_SA(0, 0), a2, voffA);
            PG8_WAIT_V(8); PG8_WAIT_L(0); PG8_BAR; PG8_MMA(1, 0, At, B0); PG8_MMA(1, 1, At, B1); PG8_BAR; PG8_SCHED;
            PG8_LDB(B0, 1, 0); PG8_LDB(B1, 1, 1); PG8_SCHED; PG8_LDA(At, 1, 0); PG8_STAGE(PG8_SA(0, 1), a2 + hstepA, voffA);
            PG8_WAIT_V(8); PG8_WAIT_L(0); PG8_BAR; PG8_MMA(0, 0, At, B0); PG8_MMA(0, 1, At, B1); PG8_BAR; PG8_SCHED;
            PG8_LDA(At, 1, 1); PG8_STAGE(PG8_SB(1, 0), b3, voffB); PG8_STAGE(PG8_SB(1, 1), b3 + hstepB, voffB); PG8_STAGE(PG8_SA(1, 0), a3, voffA);
            PG8_WAIT_V(8); PG8_WAIT_L(0); PG8_BAR; PG8_MMA(1, 0, At, B0); PG8_MMA(1, 1, At, B1); PG8_BAR; PG8_SCHED;
            } else {
            PG8_LDB(B0, 0, 0); PG8_SCHED; PG8_LDA(At, 0, 0); PG8_STAGE(PG8_SA(1, 1), a1 + hstepA, voffA);
            PG8_WAIT_L(8); PG8_BAR; PG8_WAIT_L(0); PG8_MMA(0, 0, At, B0); PG8_BAR; PG8_SCHED;
            PG8_LDB(B1, 0, 1); PG8_STAGE(PG8_SB(0, 0), b2, voffB);
            PG8_BAR; PG8_WAIT_L(0); PG8_MMA(0, 1, At, B1); PG8_BAR;
            PG8_LDA(At, 0, 1); PG8_STAGE(PG8_SA(0, 0), a2, voffA);
            PG8_BAR; PG8_WAIT_L(0); PG8_MMA(1, 0, At, B0); PG8_BAR; PG8_SCHED;
            PG8_STAGE(PG8_SB(0, 1), b2 + hstepB, voffB);
            PG8_WAIT_V(6); PG8_BAR; PG8_MMA(1, 1, At, B1); PG8_BAR;
            PG8_LDB(B0, 1, 0); PG8_SCHED; PG8_LDA(At, 1, 0); PG8_STAGE(PG8_SA(0, 1), a2 + hstepA, voffA);
            PG8_WAIT_L(8); PG8_BAR; PG8_WAIT_L(0); PG8_MMA(0, 0, At, B0); PG8_BAR; PG8_SCHED;
            PG8_LDB(B1, 1, 1); PG8_STAGE(PG8_SB(1, 0), b3, voffB);
            PG8_BAR; PG8_WAIT_L(0); PG8_MMA(0, 1, At, B1); PG8_BAR;
            PG8_LDA(At, 1, 1); PG8_STAGE(PG8_SA(1, 0), a3, voffA);
            PG8_BAR; PG8_WAIT_L(0); PG8_MMA(1, 0, At, B0); PG8_BAR; PG8_SCHED;
            PG8_STAGE(PG8_SB(1, 1), b3 + hstepB, voffB);
            PG8_WAIT_V(6); PG8_BAR; PG8_MMA(1, 1, At, B1); PG8_BAR;
            }
        }
        if constexpr (ALIGN_EPI) { if (wr == 0) PG8_BAR; }
        if constexpr (!Epi::AFTER_DRAIN) { E(acc, cur, wr, wc, fr, fq); S.done(cur); }
        if (!has_next) break;
#pragma unroll
        for (int a = 0; a < 2; ++a)
#pragma unroll
            for (int b = 0; b < 2; ++b)
#pragma unroll
                for (int m = 0; m < 4; ++m)
#pragma unroll
                    for (int n = 0; n < 2; ++n) acc[a][b][m][n] = (f32x4){0.f, 0.f, 0.f, 0.f};
        cur = nxt; cA = nA; cB = nB; ++ui;
        if constexpr (ALIGN_EPI) { if (wr == 1) PG8_BAR; }
    }
    PG8_WAIT_V(0);
    if constexpr (!ALIGN_EPI) { if (wr == 0) PG8_BAR; }
    PG8_BAR;
    if constexpr (Epi::AFTER_DRAIN) { E.fused(acc, cur, wr, wc, fr, fq, lds, wid, lane); S.done(cur); }
#undef PG8_SA
#undef PG8_SB
#undef PG8_STAGE
#undef PG8_LDA
#undef PG8_LDB
#undef PG8_MMA
#undef PG8_WAIT_V
#undef PG8_WAIT_L
#undef PG8_BAR
#undef PG8_SCHED
}
}

constexpr size_t MiB = 1u << 20;
constexpr size_t WS_CTL = 0, CTL_ZERO_BYTES = 32 * 1024;
constexpr size_t WS_KSUM = 256 * 1024;
constexpr size_t WS_MODP = 1 * MiB;
constexpr size_t WS_MODF = WS_MODP + 8 * 8 * 6144 * 4;
constexpr size_t WS_BIAS1P = 3 * MiB;
constexpr size_t WS_BIAS2P = 4 * MiB;
constexpr size_t WS_BPRIME = 4 * MiB + 512 * 1024;
constexpr size_t WS_RSTD1 = 5 * MiB;
constexpr size_t WS_SS2 = 6 * MiB;
constexpr size_t WS_SUBK = 8 * MiB;
constexpr size_t WS_WIN = 16 * MiB, WS_WA = 24 * MiB, WS_WP = 25 * MiB, WS_WOUT = 26 * MiB, WS_WQ = 28 * MiB;
constexpr size_t WS_U = 32 * MiB, WS_V = 64 * MiB;
constexpr size_t WS_XG = 96 * MiB;
constexpr size_t WS_H2Q = WS_XG, WS_HS = WS_XG + 32 * MiB;
constexpr size_t WS_QKVP = 160 * MiB;
constexpr size_t WS_GAB = 288 * MiB;
constexpr size_t WS_POOLED = 416 * MiB;
constexpr size_t WS_END = 448 * MiB;
constexpr int CW_TMO = 0, CW_BAR = 4096;
constexpr int CW_NRM = 2048;

constexpr int RING_OFF = 0, RING_BYTES = 131072;
constexpr int LDS_BYTES = 147456;
constexpr int LDSCTL_OFF = LDS_BYTES - 512, MISC_OFF = LDSCTL_OFF + 320;

#define GAS __attribute__((address_space(1)))
#define LAS __attribute__((address_space(3)))
typedef unsigned short bf16;
typedef unsigned v4u __attribute__((ext_vector_type(4)));
typedef unsigned v2u __attribute__((ext_vector_type(2)));
typedef float f32x4 __attribute__((ext_vector_type(4)));
typedef GAS unsigned gu32;
#define RLX_AGENT __ATOMIC_RELAXED, __HIP_MEMORY_SCOPE_AGENT
#define LDS_WAIT() asm volatile("s_waitcnt lgkmcnt(0)" ::: "memory")
#define VM_WAIT() asm volatile("s_waitcnt vmcnt(0)" ::: "memory")
__device__ __forceinline__ unsigned f2bf(float f) { unsigned u = __builtin_bit_cast(unsigned, f); return (u + 0x7fffu + ((u >> 16) & 1u)) >> 16; }
__device__ __forceinline__ unsigned pk2(float lo, float hi) { return f2bf(lo) | (f2bf(hi) << 16); }
__device__ __forceinline__ float bflo(unsigned w) { return __uint_as_float(w << 16); }
__device__ __forceinline__ float bfhi(unsigned w) { return __uint_as_float(w & 0xffff0000u); }
__device__ __forceinline__ float wave_sum(float v) {
#pragma unroll
    for (int o = 1; o < 64; o <<= 1) v += __shfl_xor(v, o);
    return v;
}
__device__ __forceinline__ float wave_max(float v) {
#pragma unroll
    for (int o = 1; o < 64; o <<= 1) v = fmaxf(v, __shfl_xor(v, o));
    return v;
}

#define XB_TMO      128
#define XB_XCNT(j)  (256  + 64 * (j))
#define XB_XSUB(j)  (1280 + 64 * (j))
#define XB_XGEN(j)  (2304 + 64 * (j))
#define XB_TOP      3328
#define XB_TOPGEN   3392
#define XCD_BAR_WORDS 3456
#define XB_SPIN_CAP (1u << 22)

__device__ __forceinline__ unsigned xb_ld(unsigned* p)              { return __hip_atomic_load(p, __ATOMIC_RELAXED, __HIP_MEMORY_SCOPE_AGENT); }
__device__ __forceinline__ unsigned xb_add(unsigned* p, unsigned v) { return __hip_atomic_fetch_add(p, v, __ATOMIC_RELAXED, __HIP_MEMORY_SCOPE_AGENT); }
__device__ __forceinline__ unsigned xb_xcc_id() { return (unsigned)__builtin_amdgcn_s_getreg((3 << 11) | 20) & 0xFu; }
#define XB_SPIN(cond, bar) do { unsigned _sp = 0; while (cond) { __builtin_amdgcn_s_sleep(1); \
    if ((++_sp & 255u) == 0u) { if (xb_ld(&(bar)[XB_TMO])) break; if (_sp > XB_SPIN_CAP) { atomicAdd(&(bar)[XB_TMO], 1u); break; } } } } while (0)

struct XcdBarrier { unsigned* bar; unsigned x; volatile LAS unsigned* st; };

__device__ __forceinline__ XcdBarrier xcd_barrier_post(unsigned* bar, volatile LAS unsigned* st) {
    XcdBarrier b; b.bar = bar; b.x = xb_xcc_id(); b.st = st;
    if (threadIdx.x == 0) (void)xb_add(&bar[XB_XCNT(b.x)], 1u);
    return b;
}
__device__ __forceinline__ void xcd_barrier_complete(unsigned* bar, unsigned x, unsigned& nloc, unsigned& nx) {
    const unsigned G = gridDim.x * gridDim.y * gridDim.z;
    unsigned sum, cnt, mine, sp = 0u;
    for (;;) {
        sum = 0u; cnt = 0u; mine = 0u;
#pragma unroll
        for (unsigned j = 0; j < 16; ++j) { const unsigned c = xb_ld(&bar[XB_XCNT(j)]); sum += c; cnt += (c > 0u) ? 1u : 0u; mine = (j == x) ? c : mine; }
        if (sum == G) break;
        __builtin_amdgcn_s_sleep(1);
        if ((++sp & 255u) == 0u) { if (xb_ld(&bar[XB_TMO])) break; if (sp > XB_SPIN_CAP) { atomicAdd(&bar[XB_TMO], 1u); break; } }
    }
    nloc = mine > 0u ? mine : 1u; nx = cnt > 0u ? cnt : 1u;
}
__device__ __forceinline__ void xcd_barrier(const XcdBarrier& b) {
    asm volatile("s_waitcnt vmcnt(0)" ::: "memory");
    __syncthreads();
    if (threadIdx.x == 0) {
        unsigned* bar = b.bar;
        __builtin_amdgcn_s_waitcnt(0);
        unsigned nloc = b.st[0], nx = b.st[1];
        if (nloc == 0u) { xcd_barrier_complete(bar, b.x, nloc, nx); b.st[0] = nloc; b.st[1] = nx; }
        const unsigned old = xb_add(&bar[XB_XSUB(b.x)], 1u);
        const unsigned gen = old / nloc;
        if (old + 1u == (gen + 1u) * nloc) {
            __builtin_amdgcn_fence(__ATOMIC_RELEASE, "agent");
            asm volatile("s_waitcnt vmcnt(0)" ::: "memory");
            const unsigned og = xb_add(&bar[XB_TOP], 1u);
            const unsigned tg = og / nx;
            if (og + 1u == (tg + 1u) * nx) xb_add(&bar[XB_TOPGEN], 1u);
            else XB_SPIN(xb_ld(&bar[XB_TOPGEN]) == tg, bar);
            __builtin_amdgcn_fence(__ATOMIC_ACQUIRE, "agent");
            xb_add(&bar[XB_XGEN(b.x)], 1u);
            asm volatile("s_waitcnt vmcnt(0)" ::: "memory");
        } else {
            XB_SPIN(xb_ld(&bar[XB_XGEN(b.x)]) == gen, bar);
            __builtin_amdgcn_fence(__ATOMIC_ACQUIRE, "agent");
            asm volatile("s_waitcnt vmcnt(0)" ::: "memory");
        }
    }
    __syncthreads();
}

struct Frame {
    LAS unsigned char* lds;
    volatile LAS unsigned* MISC;
    gu32* ctl;
    int tid, lane, wave;
    int vcu, G;
};
struct Args { const float* in[18]; float* out; unsigned char* ws; };

__device__ __forceinline__ float modp_sum(const float* modp, int idx) {
    float s = 0.f;
#pragma unroll
    for (int kc = 0; kc < 8; ++kc) s += modp[(size_t)kc * 8 * 6144 + idx];
    return s;
}
template <int MODE>
__device__ __forceinline__ void p0_wg_dot(Frame& F, const float* cin, const float* modp, int soff, const float* W, int N, const float* addv, float* outp, int first, int ntask) {
    LAS float* scr = (LAS float*)(F.lds + RING_OFF + F.wave * 16384);
    const int ncn = N / 64;
    for (int it = first; it < ntask; it += F.G) {
        const int kc = it / ncn, nc = it % ncn, k0 = kc * 128 + F.wave * 16, n = nc * 64 + F.lane;
        float w[16];
#pragma unroll
        for (int kk = 0; kk < 16; ++kk) w[kk] = (MODE == 0) ? __builtin_nontemporal_load(W + (size_t)(k0 + kk) * N + n) : W[(size_t)(k0 + kk) * N + n];
#pragma unroll
        for (int j = 0; j < 2; ++j) { const int idx = F.lane + 64 * j, b = idx >> 4, kk = idx & 15;
            float cf; if (MODE == 0) { const float cv = cin[b * 1024 + k0 + kk]; cf = cv / (1.0f + __expf(-cv)); } else cf = modp_sum(modp, b * 6144 + soff + k0 + kk);
            scr[idx] = cf; }
        LDS_WAIT(); asm volatile("" ::: "memory");
#pragma unroll
        for (int b = 0; b < 8; ++b) { float s = 0.f;
#pragma unroll
            for (int kk = 0; kk < 16; ++kk) s += scr[b * 16 + kk] * w[kk];
            scr[256 + b * 64 + F.lane] = s; }
        __syncthreads();
        { const int b = F.wave; float s = (addv != nullptr && kc == 0) ? addv[n] : 0.f;
#pragma unroll
          for (int w8 = 0; w8 < 8; ++w8) s += ((LAS float*)(F.lds + RING_OFF + w8 * 16384))[256 + b * 64 + F.lane];
          outp[(size_t)(kc * 8 + b) * N + n] = s; }
        __syncthreads();
    }
}
__device__ __forceinline__ void p0a_mod(Frame& F, const Args& A) { p0_wg_dot<0>(F, A.in[1], nullptr, 0, A.in[2], 6144, A.in[3], (float*)(A.ws + WS_MODP), F.vcu, 8 * 96); }
__device__ __forceinline__ void p0_wp_task(Frame& F, const Args& A, int r) {
    LAS float* scr = (LAS float*)(F.lds + RING_OFF + F.wave * 16384);
    const int g = r >> 6, kq = (r >> 4) & 3, nc = r & 15, n = nc * 64 + F.lane, d0 = 16 * F.wave;
    const float* wmix = A.in[7] + (size_t)(g * 128 + 32 * kq) * 128 + d0; const float* scale = A.in[9] + g * 128 + d0; const float* wup = A.in[10] + (size_t)(g * 128 + d0) * D + n; const float* bmix = A.in[8] + g * 128 + d0;
    float wu[16];
#pragma unroll
    for (int d = 0; d < 16; ++d) wu[d] = wup[(size_t)d * D];
    float bp = 0.f;
#pragma unroll
    for (int d = 0; d < 16; ++d) { wu[d] *= scale[d]; bp += bmix[d] * wu[d]; }
#pragma unroll
    for (int kk = 0; kk < 32; ++kk) { float s = 0.f;
#pragma unroll
        for (int d = 0; d < 16; ++d) s += wmix[kk * 128 + d] * wu[d];
        scr[kk * 64 + F.lane] = s; }
    scr[2048 + F.lane] = bp;
    __syncthreads();
    { float s[4]; float bs = 0.f;
#pragma unroll
      for (int e = 0; e < 4; ++e) s[e] = 0.f;
#pragma unroll
      for (int w8 = 0; w8 < 8; ++w8) { const LAS float* o = (const LAS float*)(F.lds + RING_OFF + w8 * 16384);
#pragma unroll
          for (int e = 0; e < 4; ++e) s[e] += o[(4 * F.wave + e) * 64 + F.lane];
          bs += o[2048 + F.lane]; }
      v2u w; w.x = pk2(s[0], s[1]); w.y = pk2(s[2], s[3]);
      *(GAS v2u*)((bf16*)(A.ws + WS_WP) + (size_t)n * PW + g * 128 + 32 * kq + 4 * F.wave) = w;
      if (kq == 0 && F.wave == 0) ((float*)(A.ws + WS_BPRIME))[g * 1024 + n] = bs; }
    __syncthreads();
}

__device__ __forceinline__ void p0_transpose_item(const float* W, int K, int N, bf16* WT, int row_off, LAS float* scr, int item, int lane) {
    const int nblk = N / 32, kb = item / nblk, nb = item % nblk, k0 = 64 * kb, n0 = 32 * nb;
#pragma unroll 8
    for (int i = 0; i < 32; ++i) { const int kk = 2 * i + (lane >> 5); scr[kk * 33 + (lane & 31)] = __builtin_nontemporal_load(W + (size_t)(k0 + kk) * N + n0 + (lane & 31)); }
    LDS_WAIT(); asm volatile("" ::: "memory");
    const int c = lane & 7;
#pragma unroll
    for (int j = 0; j < 4; ++j) { const int n = (lane >> 3) + 8 * j; const LAS float* s = scr + (8 * c) * 33 + n;
        v4u o; o.x = pk2(s[0 * 33], s[1 * 33]); o.y = pk2(s[2 * 33], s[3 * 33]); o.z = pk2(s[4 * 33], s[5 * 33]); o.w = pk2(s[6 * 33], s[7 * 33]);
        *(GAS v4u*)(WT + (size_t)(row_off + n0 + n) * K + k0 + 8 * c) = o; }
    LDS_WAIT(); asm volatile("" ::: "memory");
}
__device__ __forceinline__ void p0_table_rows4(const float* const (&src)[4], unsigned char* const (&dst)[4], float* const (&scale_out)[4], int off, int lane) {
    f32x4 v[4][4]; float am[4];
#pragma unroll
    for (int u = 0; u < 4; ++u)
#pragma unroll
        for (int q = 0; q < 4; ++q) v[u][q] = __builtin_nontemporal_load((const f32x4*)(src[u] + 16 * lane + 4 * q));
#pragma unroll
    for (int u = 0; u < 4; ++u) { float a = 0.f;
#pragma unroll
        for (int q = 0; q < 4; ++q) a = fmaxf(fmaxf(a, fmaxf(fabsf(v[u][q][0]), fabsf(v[u][q][1]))), fmaxf(fabsf(v[u][q][2]), fabsf(v[u][q][3])));
        am[u] = a; }
#pragma unroll
    for (int o = 1; o < 64; o <<= 1) {
#pragma unroll
        for (int u = 0; u < 4; ++u) am[u] = fmaxf(am[u], __shfl_xor(am[u], o)); }
#pragma unroll
    for (int u = 0; u < 4; ++u) { const float sc = (am[u] > 0.f) ? am[u] * (1.0f / 127.0f) : 1.0f, inv = 1.0f / sc;
        v4u o;
#pragma unroll
        for (int q = 0; q < 4; ++q) { const int q0 = (int)rintf(v[u][q][0] * inv) + off, q1 = (int)rintf(v[u][q][1] * inv) + off, q2 = (int)rintf(v[u][q][2] * inv) + off, q3 = (int)rintf(v[u][q][3] * inv) + off;
            o[q] = (unsigned)(q0 & 255) | ((unsigned)(q1 & 255) << 8) | ((unsigned)(q2 & 255) << 16) | ((unsigned)q3 << 24); }
        *(GAS v4u*)(dst[u] + ((size_t)(lane >> 3) << 21) + 16 * (lane & 7)) = o;
        if (lane == 0) *scale_out[u] = sc; }
}
template <int STAGE>
__device__ __forceinline__ void p0b_prologue(Frame& F, const Args& A) {
    const int gw = F.vcu * NWAVES + F.wave, NGW = F.G * NWAVES, lane = F.lane;
    const float* modp = (const float*)(A.ws + WS_MODP);
    LAS float* G1 = (LAS float*)(F.lds + 135168);
    if (STAGE == 0) { float* ks = (float*)(A.ws + WS_KSUM); for (int i = F.vcu * NTHREADS + F.tid; i < NB * NBLK * 512; i += F.G * NTHREADS) ks[i] = 0.f; }
    if (STAGE == 0) { for (int r = F.vcu; r < 256; r += F.G) p0_wp_task(F, A, r); }
    else { p0_wg_dot<1>(F, nullptr, modp, 0, A.in[5], INW, nullptr, (float*)(A.ws + WS_BIAS1P), F.vcu, 8 * (INW / 64));
           p0_wg_dot<1>(F, nullptr, modp, 3072, A.in[13], PQW, nullptr, (float*)(A.ws + WS_BIAS2P), F.vcu, 8 * (PQW / 64)); }
    LAS float* scr = (LAS float*)(F.lds + RING_OFF + F.wave * 16384);
    constexpr int I_MODF = 768, I_WIN = (D / 64) * (INW / 32), I_WA = (AW / 64) * (D / 32), I_WOUT = (D / 64) * (D / 32), I_WQ = (D / 64) * (PQW / 32);
    constexpr int I_SUBK = 64;
    constexpr int NITEMS = I_MODF + I_WIN + I_WA + I_WOUT + I_WQ + I_SUBK;
    for (int it = gw; it < NITEMS; it += NGW) {
        int r = it;
        if (r < I_MODF) { if (STAGE != 1) continue; const int idx = r * 64 + lane; ((float*)(A.ws + WS_MODF))[idx] = modp_sum(modp, idx); continue; } r -= I_MODF;
        if (r < I_WIN) { if (STAGE != 0) continue; p0_transpose_item(A.in[5], D, INW, (bf16*)(A.ws + WS_WIN), 0, scr, r, lane); continue; } r -= I_WIN;
        if (r < I_WA) { if (STAGE != 0) continue; p0_transpose_item(A.in[6], AW, D, (bf16*)(A.ws + WS_WA), 0, scr, r, lane); continue; } r -= I_WA;
        if (r < I_WOUT) { if (STAGE != 0) continue; p0_transpose_item(A.in[11], D, D, (bf16*)(A.ws + WS_WOUT), 0, scr, r, lane); continue; } r -= I_WOUT;
        if (r < I_WQ) { if (STAGE != 0) continue; p0_transpose_item(A.in[13], D, PQW, (bf16*)(A.ws + WS_WQ), 0, scr, r, lane); continue; } r -= I_WQ;
        if (r < I_SUBK) { if (STAGE != 0) continue; const float* s = A.in[14] + (size_t)r * 512 + 8 * lane; const f32x4 a = *(const f32x4*)s, b = *(const f32x4*)(s + 4);
            v4u o; o.x = pk2(a[0], a[1]); o.y = pk2(a[2], a[3]); o.z = pk2(b[0], b[1]); o.w = pk2(b[2], b[3]);
            *(GAS v4u*)((bf16*)(A.ws + WS_SUBK) + (size_t)r * 512 + 8 * lane) = o; continue; } r -= I_SUBK;
    }
    auto xg_rows = [&](const int rb) {
        const float* x = A.in[0]; bf16* XG = (bf16*)(A.ws + WS_XG); float* rstd1 = (float*)(A.ws + WS_RSTD1);
            for (int r0 = F.wave; r0 < 128; r0 += 4 * NWAVES) {
                f32x4 v[4][2][2]; float s[4];
#pragma unroll
                for (int u = 0; u < 4; ++u) { const float* xr = x + (size_t)(rb * 128 + r0 + u * NWAVES) * 1024;
#pragma unroll
                    for (int h = 0; h < 2; ++h)
#pragma unroll
                        for (int q = 0; q < 2; ++q) v[u][h][q] = __builtin_nontemporal_load((const f32x4*)(xr + h * 512 + 8 * lane + 4 * q)); }
#pragma unroll
                for (int u = 0; u < 4; ++u) { float t = 0.f;
#pragma unroll
                    for (int h = 0; h < 2; ++h)
#pragma unroll
                        for (int q = 0; q < 2; ++q) t += (v[u][h][q][0] * v[u][h][q][0] + v[u][h][q][1] * v[u][h][q][1]) + (v[u][h][q][2] * v[u][h][q][2] + v[u][h][q][3] * v[u][h][q][3]);
                    s[u] = t; }
#pragma unroll
                for (int o = 1; o < 64; o <<= 1) {
#pragma unroll
                    for (int u = 0; u < 4; ++u) s[u] += __shfl_xor(s[u], o); }
#pragma unroll
                for (int u = 0; u < 4; ++u) { const int row = rb * 128 + r0 + u * NWAVES;
                    if (lane == 0) rstd1[row] = 1.0f / sqrtf(s[u] * (1.0f / D) + RMS_EPS);
#pragma unroll
                    for (int h = 0; h < 2; ++h) { const LAS float* g = G1 + h * 512 + 8 * lane;
                        v4u o; o.x = pk2(v[u][h][0][0] * g[0], v[u][h][0][1] * g[1]); o.y = pk2(v[u][h][0][2] * g[2], v[u][h][0][3] * g[3]); o.z = pk2(v[u][h][1][0] * g[4], v[u][h][1][1] * g[5]); o.w = pk2(v[u][h][1][2] * g[6], v[u][h][1][3] * g[7]);
                        *(GAS v4u*)(XG + (size_t)row * 1024 + h * 512 + 8 * lane) = o; } }
            }
    };
    auto table_rows = [&]() {
    for (int r0 = gw; r0 < 2 * PEXP; r0 += 4 * NGW) {
        const float* src[4]; unsigned char* dst[4]; float* sco[4];
#pragma unroll
        for (int u = 0; u < 4; ++u) { int r = r0 + u * NGW; if (r >= 2 * PEXP) r = r0; const int tb = r / PEXP, e = r % PEXP;
            src[u] = (tb ? A.in[16] : A.in[15]) + (size_t)e * D; dst[u] = A.ws + (tb ? WS_V : WS_U) + (size_t)e * 128; sco[u] = (float*)(A.ws + (tb ? WS_V : WS_U) + 16 * MiB) + e; }
        const int tb0 = r0 / PEXP;
        if ((r0 + 3 * NGW) / PEXP == tb0 && r0 + 3 * NGW < 2 * PEXP) p0_table_rows4(src, dst, sco, tb0 ? 128 : 0, lane);
        else { for (int u = 0; u < 4; ++u) { const int r = r0 + u * NGW; if (r < 2 * PEXP) { const float* s1[4] = {src[u], src[u], src[u], src[u]}; unsigned char* d1[4] = {dst[u], dst[u], dst[u], dst[u]}; float* c1[4] = {sco[u], sco[u], sco[u], sco[u]}; p0_table_rows4(s1, d1, c1, (r / PEXP) ? 128 : 0, lane); } } }
    }
    };
    if (STAGE == 0) table_rows();
    else for (int rb = F.vcu; rb < T / 128; rb += F.G) {
        const float* g1 = A.in[4]; const int b = (rb * 128) / SEQ;
        __syncthreads();
        for (int k = F.tid; k < 1024; k += NTHREADS) G1[k] = g1[k] * (1.0f + modp_sum(modp, b * 6144 + 1024 + k));
        __syncthreads();
        xg_rows(rb);
    }

}
namespace attn_body {
using bf16=__hip_bfloat16;
using bf16x8=__attribute__((ext_vector_type(8)))short;
using s16x4=__attribute__((ext_vector_type(4)))short;
using f32x16=__attribute__((ext_vector_type(16)))float;
using u32x4=__attribute__((ext_vector_type(4)))unsigned;
constexpr int BATCH=8,NHEAD=8,SEQ=4096,D=64,DM=NHEAD*D;
constexpr int NW=8,QBLK=32,QB=QBLK*NW,KVBLK=64,NQB=SEQ/QB;
constexpr int ATTN_PITCH=DM, ATTN_UNIT_ROWS=QB;
__device__ __forceinline__ int crow(int r,int hi){return (r&3)+8*(r>>2)+4*hi;}
#define SBAR() __builtin_amdgcn_sched_barrier(0)
__device__ __forceinline__ void cmask(f32x16&p0,f32x16&p1,int jb,int qrel,int hi){
  const float NEG=-INFINITY; int kb=64*jb+4*hi;
  #pragma unroll
  for(int r=0;r<16;++r){int kv=kb+(r&3)+8*(r>>2); if(kv>qrel)p0[r]=NEG; if(kv+32>qrel)p1[r]=NEG;}
}

constexpr int NSLOT=3, SLOTB=8192;
constexpr int LDS_K=0, LDS_V=NSLOT*SLOTB, LDS_WS=2*NSLOT*SLOTB, LDS_OST=LDS_WS+NW*64*4, LDS_KSL=LDS_OST+NW*4096, LDS_BYTES=LDS_KSL+4096;
constexpr float C2=0.125f*1.4426950408889634f;
__device__ __forceinline__ void glds16(const void*sbase,unsigned voff,unsigned lds_dst){unsigned keep;
  asm volatile("s_mov_b32 %0, m0\n\ts_mov_b32 m0, %3\n\ts_nop 4\n\tglobal_load_lds_dwordx4 %1, %2\n\ts_mov_b32 m0, %0":"=&s"(keep):"v"(voff),"s"(sbase),"s"(lds_dst):"memory");}
__device__ __forceinline__ float max3f(float a,float b,float c){float r;asm("v_max3_f32 %0, %1, %2, %3":"=v"(r):"v"(a),"v"(b),"v"(c));return r;}
__device__ __forceinline__ float max2f(float a,float b){float r;asm("v_max_f32_e32 %0, %1, %2":"=v"(r):"v"(a),"v"(b));return r;}
__device__ __forceinline__ float fadd_s(float a,float b){float r;asm("v_add_f32_e32 %0, %1, %2":"=v"(r):"v"(a),"v"(b));return r;}
__device__ __forceinline__ float fsub_s(float a,float b){float r;asm("v_sub_f32_e32 %0, %1, %2":"=v"(r):"v"(a),"v"(b));return r;}
typedef float f32x2_t __attribute__((ext_vector_type(2))); typedef __bf16 bf16x2_t __attribute__((ext_vector_type(2)));
__device__ __forceinline__ unsigned cvtpk_s(float lo,float hi){f32x2_t v={lo,hi};bf16x2_t b=__builtin_convertvector(v,bf16x2_t);return __builtin_bit_cast(unsigned,b);}
#define WAIT_BAR(N) asm volatile("s_waitcnt vmcnt(" #N ") lgkmcnt(0)\n\ts_barrier":::"memory")

__device__ __forceinline__ void qkt(f32x16&p0,f32x16&p1,const char*Kslot,const bf16x8*qr,const f32x16&negm,int r32,int hi){
  const char*kb=Kslot+hi*1024+r32*16;
  #pragma unroll
  for(int d0=0;d0<4;++d0){
    const bf16x8 b0=*reinterpret_cast<const bf16x8*>(kb+d0*2048);
    const bf16x8 b1=*reinterpret_cast<const bf16x8*>(kb+d0*2048+512);
    if(d0==0){p0=__builtin_amdgcn_mfma_f32_32x32x16_bf16(b0,qr[0],negm,0,0,0);p1=__builtin_amdgcn_mfma_f32_32x32x16_bf16(b1,qr[0],negm,0,0,0);}
    else{p0=__builtin_amdgcn_mfma_f32_32x32x16_bf16(b0,qr[d0],p0,0,0,0);p1=__builtin_amdgcn_mfma_f32_32x32x16_bf16(b1,qr[d0],p1,0,0,0);}}
}
typedef __attribute__((address_space(3))) const char* lds_cptr;
typedef short v4i16_t __attribute__((ext_vector_type(4)));
__device__ __forceinline__ void kload8(bf16x8*kf,lds_cptr kp){
  kf[0]=*(const __attribute__((address_space(3))) bf16x8*)(kp);      kf[1]=*(const __attribute__((address_space(3))) bf16x8*)(kp+512);
  kf[2]=*(const __attribute__((address_space(3))) bf16x8*)(kp+2048); kf[3]=*(const __attribute__((address_space(3))) bf16x8*)(kp+2560);
  kf[4]=*(const __attribute__((address_space(3))) bf16x8*)(kp+4096); kf[5]=*(const __attribute__((address_space(3))) bf16x8*)(kp+4608);
  kf[6]=*(const __attribute__((address_space(3))) bf16x8*)(kp+6144); kf[7]=*(const __attribute__((address_space(3))) bf16x8*)(kp+6656);
}
__device__ __forceinline__ void kload2(bf16x8*kf,lds_cptr kp,int j){ kf[2*j]=*(const __attribute__((address_space(3))) bf16x8*)(kp+j*2048); kf[2*j+1]=*(const __attribute__((address_space(3))) bf16x8*)(kp+j*2048+512); }
__device__ __forceinline__ s16x4 vtr(lds_cptr p){ return __builtin_bit_cast(s16x4,__builtin_amdgcn_ds_read_tr16_b64_v4i16((__attribute__((address_space(3))) v4i16_t*)p)); }
__device__ __forceinline__ float rowmax(const f32x16&p0,const f32x16&p1){
  float a=max3f(p0[0],p0[1],p1[0]),b=max3f(p0[2],p0[3],p1[1]);a=max3f(a,p1[2],p1[3]);
  #pragma unroll
  for(int r=4;r<16;r+=4){a=max3f(a,p0[r],p0[r+1]);b=max3f(b,p0[r+2],p0[r+3]);a=max3f(a,p1[r],p1[r+1]);b=max3f(b,p1[r+2],p1[r+3]);}
  const float m=max2f(a,b);
  auto rr=__builtin_amdgcn_permlane32_swap(__float_as_uint(m),__float_as_uint(m),false,false);
  return max2f(__uint_as_float(rr[0]),__uint_as_float(rr[1]));
}
__device__ __forceinline__ void pv(f32x16*o,int vb,bf16x8 pa0,bf16x8 pa1,bf16x8 pa2,bf16x8 pa3){
  #pragma unroll
  for(int d0=0;d0<2;++d0){s16x4 lo[4],hi[4];
    #pragma unroll
    for(int ks=0;ks<4;++ks){
      asm volatile("ds_read_b64_tr_b16 %0,%1 offset:%c2":"=&v"(lo[ks]):"v"(vb),"i"(d0*4096+ks*1024):"memory");
      asm volatile("ds_read_b64_tr_b16 %0,%1 offset:%c2":"=&v"(hi[ks]):"v"(vb),"i"(d0*4096+ks*1024+512):"memory");}
    asm volatile("s_waitcnt lgkmcnt(0)":::"memory");SBAR();
    #define PK(k) (bf16x8){lo[k][0],lo[k][1],lo[k][2],lo[k][3],hi[k][0],hi[k][1],hi[k][2],hi[k][3]}
    o[d0]=__builtin_amdgcn_mfma_f32_32x32x16_bf16(pa0,PK(0),o[d0],0,0,0);
    o[d0]=__builtin_amdgcn_mfma_f32_32x32x16_bf16(pa1,PK(1),o[d0],0,0,0);
    o[d0]=__builtin_amdgcn_mfma_f32_32x32x16_bf16(pa2,PK(2),o[d0],0,0,0);
    o[d0]=__builtin_amdgcn_mfma_f32_32x32x16_bf16(pa3,PK(3),o[d0],0,0,0);
    #undef PK
  }
}

#ifndef ATTN_STORE16
#define ATTN_STORE16(p,v) (*(u32x4*)(p)=(v))
#endif
template<int THRL> __device__ __forceinline__ void attn_unit(int b,int h,int qb,const bf16*Q,const bf16*__restrict__ K,const bf16*__restrict__ V,bf16*O,const float*ksum,const float*nrm,char*shm){
  int tid_=threadIdx.x; asm volatile("":"+v"(tid_)); const int tid=tid_,lane=tid&63,r32=lane&31,hi=lane>>5; const int wid=__builtin_amdgcn_readfirstlane(tid>>6);
  const long rowbase=(long)b*SEQ; const int q0=qb*QB;
  const bf16*Qw=Q+(rowbase+q0+wid*QBLK)*DM+h*D;
  const bf16*Kh=K+rowbase*DM+h*D,*Vh=V+rowbase*DM+h*D;
  const unsigned lds0=(unsigned)(uintptr_t)shm;
  float*wsf=(float*)(shm+LDS_WS)+wid*64;
  const unsigned kvoff=(unsigned)(lane*DM+wid*8)*2u;
  const unsigned vvoff=(unsigned)((16*(wid&3)+(lane>>2))*DM+(wid>>2)*32+(lane&3)*8)*2u;
  const unsigned kdst=lds0+LDS_K+wid*1024, vdst=lds0+LDS_V+wid*1024;
  #define DMA_K(t,slot) glds16(Kh+(long)(NTF-1-(t))*KVBLK*DM,kvoff,(unsigned)__builtin_amdgcn_readfirstlane(kdst+(slot)))
  #define DMA_V(t,slot) glds16(Vh+(long)(NTF-1-(t))*KVBLK*DM,vvoff,(unsigned)__builtin_amdgcn_readfirstlane(vdst+(slot)))
  const int vb0=(int)(lds0+LDS_V)+((lane>>4)&1)*32+(lane&3)*8+(4*hi+((lane&15)>>2))*64;
  const char*Kbase=shm+LDS_K; bf16x8 kf[8];
  const lds_cptr shm3=(lds_cptr)shm; const lds_cptr kp0=shm3+LDS_K+hi*1024+r32*16; const lds_cptr vp0=shm3+LDS_V+((lane>>4)&1)*32+(lane&3)*8+(4*hi+((lane&15)>>2))*64;
  const int NTF=(q0+QB)/KVBLK;
  int NT=NTF;
  { const float*nq=nrm+(long)(b*2+0)*16+2*h,*nk=nrm+(long)(b*2+1)*16+2*h; const float B=__builtin_sqrtf((nq[0]+nq[1])*(nk[0]+nk[1]))*1.02f+0.5f;
    const float slope2_=__uint_as_float(0x3FB8AA3Bu-((unsigned)(h+1)<<23)); const float dh=(160.f+2.f*B)/slope2_;
    const float tminf=((float)(q0-63)-dh)*(1.f/64.f); int tmin=tminf>0.f?(int)tminf:0;
    tmin=__builtin_amdgcn_readfirstlane(tmin); int nt=NTF-tmin; nt+=nt&1; if(nt>NTF)nt=NTF; if(nt<4)nt=4; NT=nt; }
  { float*ksl=(float*)(shm+LDS_KSL); const float k0=ksum[(long)(b*16+(tid>>6))*512+h*64+(tid&63)],k1=ksum[(long)(b*16+8+(tid>>6))*512+h*64+(tid&63)]; ksl[tid]=k0; ksl[512+tid]=k1; }
  DMA_K(0,0);DMA_V(0,0);DMA_K(1,SLOTB);
  bf16x8 qr[4];
  #pragma unroll
  for(int d0=0;d0<4;++d0)qr[d0]=*reinterpret_cast<const bf16x8*>(&Qw[(long)r32*DM+d0*16+hi*8]);
  float mhat=0.f,l_reg=0.f;f32x16 o[2];o[0]=f32x16{};o[1]=f32x16{};const f32x16 zero16=f32x16{};
  const int qrel=wid*QBLK+r32;
  #define CMASK(P0,P1,t) do{int jb_=3-(t); if(jb_>=0)cmask(P0,P1,jb_,qrel,hi);}while(0)
  const unsigned sl2b=0x3FB8AA3Bu-((unsigned)(h+1)<<23);
  const float slope2=__uint_as_float(sl2b), s2x=__uint_as_float(sl2b+(1u<<23)), s8x=__uint_as_float(sl2b+(3u<<23)), s32=__uint_as_float(sl2b+(5u<<23));
  const float s3x=__uint_as_float((unsigned)__builtin_amdgcn_readfirstlane((int)__float_as_uint(slope2*3.0f)));
  #define NBSEL(r) (((r)>>2)==0?nbb0_:((r)>>2)==1?nbb1_:((r)>>2)==2?nbb2_:nbb3_)
  #define NEGV(r) ((((r)&3)==0)?NBSEL(r):(NBSEL(r)+(((r)&3)==1?slope2:((r)&3)==2?s2x:s3x)))
  #define NBB(nb) const float nbb0_=(nb), nbb1_=nbb0_+s8x, nbb2_=nbb1_+s8x, nbb3_=nbb2_+s8x
  #define NBSELC(r) (((r)>>2)==0?nbc0_:((r)>>2)==1?nbc1_:((r)>>2)==2?nbc2_:nbc3_)
  #define SAV(r) (((r)&3)==1?slope2:((r)&3)==2?s2x:s3x)
  #define BIAS(C0,C1,s) do{ NBB(NBV(s)); const float nbc0_=nbb0_+s32,nbc1_=nbb1_+s32,nbc2_=nbb2_+s32,nbc3_=nbb3_+s32; \
      _Pragma("unroll") for(int r=0;r<16;++r){ if((r&3)==0){C0[r]+=NBSEL(r);C1[r]+=NBSELC(r);} else {C0[r]=(C0[r]+NBSEL(r))+SAV(r);C1[r]=(C1[r]+NBSELC(r))+SAV(r);} } }while(0)
  unsigned sel=0u;
  #define NBV(s) ({ const int tl_=NTF-1-(s); const int tc_=tl_<0?0:tl_; const int bj_=tc_>>2; const float off_=(bj_>=qb||((sel>>bj_)&1u))?0.f:-1.0e30f; \
      __builtin_fmaf(slope2,(float)(64*tl_+4*hi-q0-qrel),off_-mhat); })
  #define CRC(r) ((float)(((r)&3)+8*((r)>>2)))
  bool resc=false;
  #define START(P0,P1) do{ const float rm=rowmax(P0,P1); resc=false; \
    { const float dl=(rm>-1.0e20f)?rm:0.f; mhat=fadd_s(mhat,dl); \
      _Pragma("unroll") for(int r=0;r<16;++r){P0[r]=fsub_s(P0[r],dl);P1[r]=fsub_s(P1[r],dl);} } \
    _Pragma("unroll") for(int r=0;r<16;++r)P0[r]=__builtin_amdgcn_exp2f(P0[r]); }while(0)
  #define RESC() do{ if(resc){ asm volatile("s_waitcnt lgkmcnt(0)":::"memory"); \
      _Pragma("unroll") for(int d_=0;d_<2;++d_) _Pragma("unroll") for(int r=0;r<16;++r)o[d_][r]*=wsf[crow(r,hi)]; } }while(0)
  f32x16 pA0,pA1,pB0,pB1;
  int sl_prev=0,sl_cur=0,sl_next=SLOTB;
  #define ROT() do{sl_prev=sl_cur;sl_cur=sl_next;sl_next=(sl_next==(NSLOT-1)*SLOTB)?0:sl_next+SLOTB;}while(0)
  DMA_K(2,2*SLOTB);
  WAIT_BAR(3);
  if(qb>0){
    float qf[32];
    _Pragma("unroll") for(int d0=0;d0<4;++d0) _Pragma("unroll") for(int e=0;e<8;++e) qf[d0*8+e]=__uint_as_float(((unsigned)(unsigned short)qr[d0][e])<<16);
    const float*ksl=(const float*)(shm+LDS_KSL)+8*hi;
    float b1=-3.0e38f,b2=-3.0e38f,b3=-3.0e38f; int i1=-1,i2=-1,i3=-1;
    for(int j=0;j<qb;++j){ float g=0.f;
      _Pragma("unroll") for(int d0=0;d0<4;++d0) _Pragma("unroll") for(int e=0;e<8;++e) g=__builtin_fmaf(qf[d0*8+e],ksl[j*64+16*d0+e],g);
      { auto rr=__builtin_amdgcn_permlane32_swap(__float_as_uint(g),__float_as_uint(g),false,false); g=__uint_as_float(rr[0])+__uint_as_float(rr[1]); }
      const bool c1=g>b1,c2=g>b2,c3=g>b3;
      b3=c2?b2:(c3?g:b3); i3=c2?i2:(c3?j:i3); b2=c1?b1:(c2?g:b2); i2=c1?i1:(c2?j:i2); b1=c1?g:b1; i1=c1?j:i1; }
    sel=(1u<<i1)|(i2>=0?(1u<<i2):0u)|(i3>=0?(1u<<i3):0u); }
  qkt(pA0,pA1,Kbase,qr,zero16,r32,hi);asm volatile("s_nop 15\n\ts_nop 7":"+v"(pA0),"+v"(pA1));
  BIAS(pA0,pA1,0);
  CMASK(pA0,pA1,0);
  START(pA0,pA1);
  _Pragma("unroll") for(int r=0;r<16;++r)pA1[r]=__builtin_amdgcn_exp2f(pA1[r]);
  WAIT_BAR(0);
  DMA_K(3,0);DMA_V(1,SLOTB);
  ROT();
  kload8(kf,kp0+sl_cur);
  WAIT_BAR(2);
  s16x4 vlo[8],vhi[8]; u32x4 pw0,pw1,pw2,pw3;
  #define PKW(P,B) cvtpk_s(P[B],P[B+1])
  #define PAF(k) __builtin_bit_cast(bf16x8,pw##k)
  #define VFR(i) (bf16x8){vlo[i][0],vlo[i][1],vlo[i][2],vlo[i][3],vhi[i][0],vhi[i][1],vhi[i][2],vhi[i][3]}
  #define PIN(x) asm volatile("":"+v"(x))
  #define MX3(a,b,c) __builtin_fmaxf(__builtin_fmaxf((a),(b)),(c))
  #define GAPA(MF,A0,A1,A2,A3,W0,W1,PW) do{ MF; sacc+=A0; sacc+=A1; sacc+=A2; sacc+=A3; PIN(sacc); W0; W1; PIN(PW); SBAR(); }while(0)
  #define EX(v) __builtin_amdgcn_exp2f(v)
  #define GAPB(MF,X,B) do{ MF; X[B]=EX(X[B]); X[B+1]=EX(X[B+1]); X[B+2]=EX(X[B+2]); X[B+3]=EX(X[B+3]); PIN(X); SBAR(); }while(0)
  #define VRD(i) do{ vlo[i]=vtr(vp_+(((i)>>2)*4096+((i)&3)*1024)); vhi[i]=vtr(vp_+(((i)>>2)*4096+((i)&3)*1024+512)); }while(0)
  #define KRD(G,j) do{ if(G){ kload2(kf,kp0+sl_next,j); SBAR(); } }while(0)
  #define STEP(C0,C1,P0,P1,t,GK,GV,GL) do{ SBAR(); \
    const lds_cptr vp_=vp0+sl_prev; \
    VRD(0); SBAR(); float sacc=(P0[0]+P0[1]); \
    GAPA(C0=__builtin_amdgcn_mfma_f32_32x32x16_bf16(kf[0],qr[0],zero16,0,0,0), P0[2],P0[3],P0[4],P0[5],     pw0[0]=PKW(P0,0), pw0[1]=PKW(P0,2), pw0); \
    VRD(4); SBAR(); GAPA(C1=__builtin_amdgcn_mfma_f32_32x32x16_bf16(kf[1],qr[0],zero16,0,0,0), P0[6],P0[7],P0[8],P0[9],     pw0[2]=PKW(P0,4), pw0[3]=PKW(P0,6), pw0); \
    VRD(1); SBAR(); GAPA(C0=__builtin_amdgcn_mfma_f32_32x32x16_bf16(kf[2],qr[1],C0,0,0,0),   P0[10],P0[11],P0[12],P0[13], pw1[0]=PKW(P0,8), pw1[1]=PKW(P0,10), pw1); \
    VRD(5); SBAR(); GAPA(C1=__builtin_amdgcn_mfma_f32_32x32x16_bf16(kf[3],qr[1],C1,0,0,0),   P0[14],P0[15],P1[0],P1[1],   pw1[2]=PKW(P0,12),pw1[3]=PKW(P0,14), pw1); \
    VRD(2); SBAR(); GAPA(C0=__builtin_amdgcn_mfma_f32_32x32x16_bf16(kf[4],qr[2],C0,0,0,0),   P1[2],P1[3],P1[4],P1[5],     pw2[0]=PKW(P1,0), pw2[1]=PKW(P1,2), pw2); \
    VRD(6); SBAR(); GAPA(C1=__builtin_amdgcn_mfma_f32_32x32x16_bf16(kf[5],qr[2],C1,0,0,0),   P1[6],P1[7],P1[8],P1[9],     pw2[2]=PKW(P1,4), pw2[3]=PKW(P1,6), pw2); \
    VRD(3); SBAR(); GAPA(C0=__builtin_amdgcn_mfma_f32_32x32x16_bf16(kf[6],qr[3],C0,0,0,0),   P1[10],P1[11],P1[12],P1[13], pw3[0]=PKW(P1,8), pw3[1]=PKW(P1,10), pw3); \
    VRD(7); SBAR(); GAPA(C1=__builtin_amdgcn_mfma_f32_32x32x16_bf16(kf[7],qr[3],C1,0,0,0),   P1[14],P1[15],0.f,0.f,       pw3[2]=PKW(P1,12),pw3[3]=PKW(P1,14), pw3); \
    l_reg+=sacc; \
    if(GK){DMA_K((t)+3,sl_cur);} if(GV){DMA_V((t)+1,sl_next);} \
    BIAS(C0,C1,t); \
    CMASK(C0,C1,t); \
    { float a=MX3(C0[0],C0[1],C1[0]),b=MX3(C0[2],C0[3],C1[1]); a=MX3(a,C1[2],C1[3]); \
      _Pragma("unroll") for(int r=4;r<16;r+=4){a=MX3(a,C0[r],C0[r+1]);b=MX3(b,C0[r+2],C0[r+3]);a=MX3(a,C1[r],C1[r+1]);b=MX3(b,C1[r+2],C1[r+3]);} \
      float rm=__builtin_fmaxf(a,b); { auto rr=__builtin_amdgcn_permlane32_swap(__float_as_uint(rm),__float_as_uint(rm),false,false); rm=__builtin_fmaxf(__uint_as_float(rr[0]),__uint_as_float(rr[1])); } \
      resc=false; \
      if(__builtin_expect(__any(rm>(float)THRL),0)){ const float dl=__builtin_fmaxf(rm,0.f); mhat+=dl; \
        _Pragma("unroll") for(int r=0;r<16;++r){C0[r]-=dl;C1[r]-=dl;} \
        const float f=__builtin_amdgcn_exp2f(-dl); l_reg*=f; if(hi==0)wsf[r32]=f; resc=true; } } \
    SBAR(); \
    GAPB(o[0]=__builtin_amdgcn_mfma_f32_32x32x16_bf16(PAF(0),VFR(0),o[0],0,0,0), C0,0); \
    GAPB(o[1]=__builtin_amdgcn_mfma_f32_32x32x16_bf16(PAF(0),VFR(4),o[1],0,0,0), C0,4); \
    KRD(GL,0); GAPB(o[0]=__builtin_amdgcn_mfma_f32_32x32x16_bf16(PAF(1),VFR(1),o[0],0,0,0), C0,8); \
    KRD(GL,1); GAPB(o[1]=__builtin_amdgcn_mfma_f32_32x32x16_bf16(PAF(1),VFR(5),o[1],0,0,0), C0,12); \
    KRD(GL,2); GAPB(o[0]=__builtin_amdgcn_mfma_f32_32x32x16_bf16(PAF(2),VFR(2),o[0],0,0,0), C1,0); \
    KRD(GL,3); GAPB(o[1]=__builtin_amdgcn_mfma_f32_32x32x16_bf16(PAF(2),VFR(6),o[1],0,0,0), C1,4); \
    GAPB(o[0]=__builtin_amdgcn_mfma_f32_32x32x16_bf16(PAF(3),VFR(3),o[0],0,0,0), C1,8); \
    GAPB(o[1]=__builtin_amdgcn_mfma_f32_32x32x16_bf16(PAF(3),VFR(7),o[1],0,0,0), C1,12); \
    }while(0)
  int t=1;
  #define ENDW(tt) do{ if((tt)+3<NT){WAIT_BAR(2);} else if((tt)+2<NT){WAIT_BAR(1);} else {WAIT_BAR(0);} }while(0)
  #define PEELED_PAIR() do{ \
    STEP(pB0,pB1,pA0,pA1,t,(t+3<NT),(t+1<NT),(t+1<NT));       ENDW(t);   RESC(); ROT(); \
    STEP(pA0,pA1,pB0,pB1,t+1,(t+4<NT),(t+2<NT),(t+2<NT));     ENDW(t+1); RESC(); ROT(); }while(0)
  for(;t<5&&t+1<NT;t+=2){ PEELED_PAIR(); }
  #undef CMASK
  #define CMASK(P0,P1,t) do{}while(0)
  for(;t+5<NT;t+=2){
    STEP(pB0,pB1,pA0,pA1,t,true,true,true);     WAIT_BAR(2); RESC(); ROT();
    STEP(pA0,pA1,pB0,pB1,t+1,true,true,true);   WAIT_BAR(2); RESC(); ROT();
  }
  #undef CMASK
  #define CMASK(P0,P1,t) do{int jb_=3-(t); if(jb_>=0)cmask(P0,P1,jb_,qrel,hi);}while(0)
  for(;t+1<NT;t+=2){ PEELED_PAIR(); }
  STEP(pB0,pB1,pA0,pA1,NT-1,false,false,false); RESC();
  { float sacc=pB0[0]+pB0[1]; _Pragma("unroll") for(int r=2;r<16;++r)sacc+=pB0[r]; _Pragma("unroll") for(int r=0;r<16;++r)sacc+=pB1[r]; l_reg+=sacc;
    pw0=(u32x4){PKW(pB0,0),PKW(pB0,2),PKW(pB0,4),PKW(pB0,6)};pw1=(u32x4){PKW(pB0,8),PKW(pB0,10),PKW(pB0,12),PKW(pB0,14)};pw2=(u32x4){PKW(pB1,0),PKW(pB1,2),PKW(pB1,4),PKW(pB1,6)};pw3=(u32x4){PKW(pB1,8),PKW(pB1,10),PKW(pB1,12),PKW(pB1,14)};
    SBAR(); pv(o,vb0+sl_cur,PAF(0),PAF(1),PAF(2),PAF(3)); }
  #undef PKW
  #undef PAF
  #undef VFR
  #undef PIN
  #undef MX3
  #undef GAPA
  #undef GAPB
  #undef EX
  #undef VRD
  #undef KRD
  #undef STEP
  #undef ENDW
  #undef PEELED_PAIR
  #undef NBV
  #undef CRC
  #undef NEGV
  #undef NBSEL
  #undef NBB
  #undef NBSELC
  #undef SAV
  #undef BIAS
  {auto rr=__builtin_amdgcn_permlane32_swap(__float_as_uint(l_reg),__float_as_uint(l_reg),false,false);l_reg=__uint_as_float(rr[0])+__uint_as_float(rr[1]);}
  if(hi==0)wsf[32+r32]=l_reg;asm volatile("s_waitcnt lgkmcnt(0)":::"memory");
  float rli[16];
  #pragma unroll
  for(int r=0;r<16;++r)rli[r]=__builtin_amdgcn_rcpf(wsf[32+crow(r,hi)]);
  bf16*Ow=O+(rowbase+q0+wid*QBLK)*DM+h*D;
  { bf16*stg=(bf16*)(shm+LDS_OST)+wid*2048;
    #pragma unroll
    for(int r=0;r<16;++r){const int orow=crow(r,hi);
      #pragma unroll
      for(int d0=0;d0<2;++d0)stg[orow*64+d0*32+r32]=__float2bfloat16(o[d0][r]*rli[r]);}
    asm volatile("s_waitcnt lgkmcnt(0)":::"memory");
    #pragma unroll
    for(int i=0;i<4;++i){const int row=i*8+(lane>>3),ch=lane&7; const u32x4 v=*(const u32x4*)(stg+row*64+ch*8); ATTN_STORE16(Ow+(long)row*DM+ch*8,v);} }
  asm volatile("s_waitcnt lgkmcnt(0)\n\ts_barrier":::"memory");
  #undef DMA_K
  #undef DMA_V
  #undef CMASK
  #undef START
  #undef RESC
  #undef ROT
}
constexpr int ATTN_LDS_BYTES=LDS_BYTES;
struct AttnTensors { const bf16* Q; const bf16* K; const bf16* V; bf16* O; };
struct AttnUnit { int bh; int qb; };
struct AttnPlan { unsigned char unit[32][12]; unsigned char n[32]; };
constexpr int attn_nominal_cost(int h,int qb){ const int pmax[8]={7,12,22,41,64,64,64,64}; const int past=4*qb<pmax[h]?4*qb:pmax[h]; return 4+past+2; }
constexpr AttnPlan make_attn_plan(){
  AttnPlan p{}; int load[32]={}; bool used[128]={};
  for(int it=0;it<128;++it){ int best=-1,bc=-1; for(int e=0;e<128;++e){ if(used[e])continue; const int c=attn_nominal_cost(e>>4,e&15); if(c>bc){bc=c;best=e;} }
    used[best]=true; int cu=0; for(int c=1;c<32;++c) if(load[c]<load[cu]||(load[c]==load[cu]&&p.n[c]<p.n[cu]))cu=c;
    if(p.n[cu]>=12){ for(int c=0;c<32;++c) if(p.n[c]<12){cu=c;break;} }
    p.unit[cu][p.n[cu]++]=(unsigned char)best; load[cu]+=bc; }
  return p; }
__device__ const AttnPlan g_attn_plan=make_attn_plan();
struct StaticOrder {
  int vcu,G;
  __device__ __forceinline__ explicit StaticOrder(int grid,int vcu_):vcu(vcu_),G(grid){}
  __device__ __forceinline__ bool next(int i,AttnUnit&u)const{
    if(G!=256){ const int id=vcu+i*G; if(id>=BATCH*NHEAD*NQB)return false; u.bh=id>>4; u.qb=id&15; return true; }
    const int c=vcu&31; if(i>=(int)g_attn_plan.n[c])return false; const int e=g_attn_plan.unit[c][i]; u.bh=(vcu>>5)*NHEAD+(e>>4); u.qb=e&15; return true; }
};
template<class Sched,int THRL=8> __device__ __forceinline__ void attn_phase(char*lds,const AttnTensors&T,const float*ksum,const float*nrm,const Sched&S){
  AttnUnit u;
  for(int i=0;S.next(i,u);++i){ attn_unit<THRL>(u.bh/NHEAD,u.bh%NHEAD,u.qb,T.Q,T.K,T.V,T.O,ksum,nrm,lds); }
}
#undef SBAR
#undef WAIT_BAR
}

__device__ __forceinline__ void pooled_phase(Frame& F, const Args& A) {
    const bf16* P = (const bf16*)(A.ws + WS_QKVP) + (size_t)3 * T * 512; bf16* PO = (bf16*)(A.ws + WS_POOLED);
    const int gw = F.vcu * NWAVES + F.wave, NGW = F.G * NWAVES, lane = F.lane, w = 2 << (lane >> 4);
    for (int tk = gw; tk < T / 16; tk += NGW) {
        const int row0 = tk * 16, s0 = row0 & (SEQ - 1);
        v4u rv[31];
#pragma unroll
        for (int i = 0; i < 31; ++i) { const int sidx = s0 - 15 + i; rv[i] = (sidx >= 0) ? *(const v4u*)(P + (size_t)(row0 - 15 + i) * 512 + 8 * lane) : (v4u){0u, 0u, 0u, 0u}; }
#pragma unroll
        for (int i = 0; i < 16; ++i) {
            const int sidx = s0 + i; float acc[8];
#pragma unroll
            for (int e = 0; e < 8; ++e) acc[e] = 0.f;
#pragma unroll
            for (int k = 0; k < 16; ++k) { const bool ok = (k < w) && (sidx - k >= 0); const v4u x = rv[15 + i - k]; const float msk = ok ? 1.0f : 0.0f;
                acc[0] += msk * bflo(x.x); acc[1] += msk * bfhi(x.x); acc[2] += msk * bflo(x.y); acc[3] += msk * bfhi(x.y); acc[4] += msk * bflo(x.z); acc[5] += msk * bfhi(x.z); acc[6] += msk * bflo(x.w); acc[7] += msk * bfhi(x.w); }
            const float inv = 1.0f / (float)min(sidx + 1, w); const v4u x = rv[15 + i];
            v4u o; o.x = pk2(acc[0] * inv - bflo(x.x), acc[1] * inv - bfhi(x.x)); o.y = pk2(acc[2] * inv - bflo(x.y), acc[3] * inv - bfhi(x.y));
            o.z = pk2(acc[4] * inv - bflo(x.z), acc[5] * inv - bfhi(x.z)); o.w = pk2(acc[6] * inv - bflo(x.w), acc[7] * inv - bfhi(x.w));
            *(v4u*)(PO + (size_t)(row0 + i) * 512 + 8 * lane) = o;
        }
    }
}

namespace rt {
typedef float f32x16 __attribute__((ext_vector_type(16)));
typedef short bf16x8 __attribute__((ext_vector_type(8)));
__device__ __forceinline__ void ce(float& hi, float& lo) { const float a = fmaxf(hi, lo), b = fminf(hi, lo); hi = a; lo = b; }
template <int N> __device__ __forceinline__ void sort_desc(float (&v)[N]) {
#pragma unroll
    for (int k = 2; k <= N; k <<= 1)
#pragma unroll
        for (int j = k >> 1; j > 0; j >>= 1)
#pragma unroll
            for (int i = 0; i < N; ++i) { const int l = i ^ j; if (l > i) { if ((i & k) == 0) ce(v[i], v[l]); else ce(v[l], v[i]); } }
}
template <int N> __device__ __forceinline__ void bitonic_merge_desc(float (&v)[N]) {
#pragma unroll
    for (int j = N >> 1; j > 0; j >>= 1)
#pragma unroll
        for (int i = 0; i < N; ++i) { const int l = i ^ j; if (l > i) ce(v[i], v[l]); }
}
__device__ __forceinline__ void merge_top16(float (&a)[16], const float (&b)[16]) {
#pragma unroll
    for (int i = 0; i < 16; ++i) a[i] = fmaxf(a[i], b[15 - i]);
    bitonic_merge_desc<16>(a);
}
template <bool SORT> __device__ __forceinline__ void pair_merge(float (&a)[16], bool hi) {
    float w[16];
#pragma unroll
    for (int i = 0; i < 16; ++i) w[i] = hi ? a[15 - i] : a[i];
#pragma unroll
    for (int i = 0; i < 16; ++i) { const auto rr = __builtin_amdgcn_permlane32_swap(__float_as_uint(w[i]), __float_as_uint(w[i]), false, false); a[i] = fmaxf(__uint_as_float(rr[0]), __uint_as_float(rr[1])); }
    if (SORT) bitonic_merge_desc<16>(a);
}
__device__ __forceinline__ void fold_tile(const f32x16& acc, int kt, int hi, float (&out)[16]) {
    float g[16];
#pragma unroll
    for (int r = 0; r < 16; ++r) { const unsigned key = (unsigned)(32 * kt + (r & 3) + 8 * (r >> 2)); g[r] = __uint_as_float((__float_as_uint(acc[r]) & ~127u) | key | ((unsigned)hi << 2)); }
    sort_desc<16>(g);
    if (kt == 0) {
#pragma unroll
        for (int r = 0; r < 16; ++r) out[r] = g[r];
    } else merge_top16(out, g);
}
}
__device__ __forceinline__ void router_phase(Frame& F, const Args& A) {
    using namespace rt;
    const bf16* QP = (const bf16*)(A.ws + WS_GAB); const bf16* SK = (const bf16*)(A.ws + WS_SUBK);
    unsigned short* IDX = (unsigned short*)(A.ws + WS_POOLED); float* GATE = (float*)(A.ws + WS_POOLED + 16 * MiB);
    const int lane = F.lane, n32 = lane & 31, hi = lane >> 5, gw = F.vcu * NWAVES + F.wave, NGW = F.G * NWAVES;
    __syncthreads();
    for (int i = F.tid; i < 2 * 128 * 16; i += NTHREADS) { const int r = i >> 4, ch = i & 15; *(LAS v4u*)(F.lds + r * 272 + ch * 16) = *(const v4u*)(SK + (size_t)r * 128 + ch * 8); }
    __syncthreads();
    LAS unsigned char* scr = F.lds + 73728 + F.wave * 1024;
    const LAS unsigned char* afrag = F.lds + n32 * 272 + hi * 16;
    bf16x8 qa[8], qb[8];
#define RT_QLOAD(task_, p_, q_) do { const int tq_ = (task_) * 4 + (n32 >> 3); const bf16* qr_ = QP + (size_t)tq_ * PQW + (n32 & 7) * 256 + (p_) * 128 + 8 * hi; \
        _Pragma("unroll") for (int i = 0; i < 8; ++i) q_[i] = __builtin_nontemporal_load((const bf16x8*)(qr_ + 16 * i)); } while (0)
#define RT_HALF(p_, q_, out_) do { _Pragma("unroll") for (int kt = 0; kt < 4; ++kt) { f32x16 acc = f32x16{}; \
        _Pragma("unroll") for (int ks = 0; ks < 8; ++ks) { const bf16x8 kf = *(const LAS bf16x8*)(afrag + ((p_) * 128 + 32 * kt) * 272 + 32 * ks); acc = __builtin_amdgcn_mfma_f32_32x32x16_bf16(kf, q_[ks], acc, 0, 0, 0); } \
        fold_tile(acc, kt, hi, out_); } pair_merge<true>(out_, hi != 0); } while (0)
    if (gw < T * PHEADS / 32) RT_QLOAD(gw, 0, qa);
    for (int task = gw; task < T * PHEADS / 32; task += NGW) {
        const int t = task * 4 + (n32 >> 3), h = n32 & 7;
        float la[16], lb[16];
        RT_QLOAD(task, 1, qb);
        RT_HALF(0, qa, la);
        { const int nxt = task + NGW; if (nxt < T * PHEADS / 32) RT_QLOAD(nxt, 0, qa); }
        RT_HALF(1, qb, lb);
        { unsigned w[4];
#pragma unroll
          for (int q = 0; q < 4; ++q) {
              const unsigned i0 = __float_as_uint(hi ? lb[4 * q] : la[4 * q]) & 127u, i1 = __float_as_uint(hi ? lb[4 * q + 1] : la[4 * q + 1]) & 127u, i2 = __float_as_uint(hi ? lb[4 * q + 2] : la[4 * q + 2]) & 127u, i3 = __float_as_uint(hi ? lb[4 * q + 3] : la[4 * q + 3]) & 127u;
              w[q] = i0 | (i1 << 8) | (i2 << 16) | (i3 << 24); }
          *(LAS v4u*)(scr + n32 * 32 + hi * 16) = (v4u){w[0], w[1], w[2], w[3]}; }
        float x[16], y[16];
#pragma unroll
        for (int i = 0; i < 16; ++i) { const float av = __uint_as_float(__float_as_uint(la[i]) & ~127u), bv = __uint_as_float(__float_as_uint(lb[i]) & ~127u); x[i] = hi ? bv : av; y[i] = hi ? av : bv; }
        float c0[16], c1[16];
        {
            const unsigned hb = (unsigned)hi << 8;
#define RT_CAND(i, j) __uint_as_float(((__float_as_uint(x[i] + y[j]) & ~511u) | (unsigned)((i) * 16 + (j))) | hb)
#define RT_DIAG(i) (hi ? -3.0e38f : RT_CAND(i, i))
            c0[0] = RT_DIAG(0);
#pragma unroll
            for (int j = 1; j < 16; ++j) c0[j] = RT_CAND(0, j);
            c1[0] = RT_DIAG(1);
#pragma unroll
            for (int j = 2; j < 8; ++j) c1[j - 1] = RT_CAND(1, j);
            c1[7] = RT_DIAG(2); c1[8] = RT_CAND(2, 3); c1[9] = RT_CAND(2, 4); c1[10] = RT_DIAG(3);
#pragma unroll
            for (int k = 11; k < 16; ++k) c1[k] = -3.0e38f;
#undef RT_CAND
#undef RT_DIAG
        }
        sort_desc<16>(c0); sort_desc<16>(c1); merge_top16(c0, c1);
        pair_merge<false>(c0, hi != 0);
        float mx = c0[0];
#pragma unroll
        for (int i = 1; i < 16; ++i) mx = fmaxf(mx, c0[i]);
        float ex[16], sm = 0.f;
#pragma unroll
        for (int i = 0; i < 16; ++i) { ex[i] = __expf(__uint_as_float(__float_as_uint(c0[i]) & ~511u) - mx); sm += ex[i]; }
        const float inv = 1.0f / sm;
        asm volatile("s_waitcnt lgkmcnt(0)" ::: "memory");
        int eo[8]; float go[8];
#pragma unroll
        for (int k = 0; k < 8; ++k) { const float wv = hi ? c0[8 + k] : c0[k]; go[k] = (hi ? ex[8 + k] : ex[k]) * inv;
            const unsigned bits = __float_as_uint(wv), fromhi = (bits >> 8) & 1u, xi = (bits >> 4) & 15u, yj = bits & 15u;
            const unsigned ar = fromhi ? yj : xi, br = fromhi ? xi : yj;
            const unsigned e1 = scr[n32 * 32 + ar], e2 = scr[n32 * 32 + 16 + br];
            eo[k] = (int)(e1 * 128u + e2); }
        unsigned short* ip = IDX + (size_t)t * PSEL + h * PTOP + 8 * hi; float* gp = GATE + (size_t)t * PSEL + h * PTOP + 8 * hi;
        *(v4u*)ip = (v4u){(unsigned)eo[0] | ((unsigned)eo[1] << 16), (unsigned)eo[2] | ((unsigned)eo[3] << 16), (unsigned)eo[4] | ((unsigned)eo[5] << 16), (unsigned)eo[6] | ((unsigned)eo[7] << 16)};
        *(f32x4*)gp = (f32x4){go[0], go[1], go[2], go[3]}; *(f32x4*)(gp + 4) = (f32x4){go[4], go[5], go[6], go[7]};
        asm volatile("s_waitcnt lgkmcnt(0)" ::: "memory");
    }
#undef RT_QLOAD
#undef RT_HALF
    __syncthreads();
}

typedef float f32x2 __attribute__((ext_vector_type(2)));
typedef int v4i __attribute__((ext_vector_type(4)));
__device__ __forceinline__ void h2q_token(const Args& A, int t, int lane) {
    const float* modf = (const float*)(A.ws + WS_MODF); const float* ss2 = (const float*)(A.ws + WS_SS2); const float* g2 = A.in[12];
    const int b = t / SEQ; const float* xr = A.out + (size_t)t * D + 16 * lane;
    const f32x4* sp = (const f32x4*)(ss2 + (size_t)t * 16); const f32x4 s4 = (sp[0] + sp[1]) + (sp[2] + sp[3]);
    const float rs = 1.0f / sqrtf(((s4[0] + s4[1]) + (s4[2] + s4[3])) * (1.0f / D) + RMS_EPS);
    float h2[16]; float am = 0.f;
#pragma unroll
    for (int q = 0; q < 4; ++q) { const int c = 16 * lane + 4 * q; const f32x4 xv = *(const f32x4*)(xr + 4 * q), gg = *(const f32x4*)(g2 + c), sc = *(const f32x4*)(modf + (size_t)b * 6144 + 4096 + c), sh = *(const f32x4*)(modf + (size_t)b * 6144 + 3072 + c);
#pragma unroll
        for (int e = 0; e < 4; ++e) { const float h = xv[e] * rs * (gg[e] * (1.0f + sc[e])) + sh[e]; h2[4 * q + e] = h; am = fmaxf(am, fabsf(h)); } }
    am = fmaxf(am, __shfl_xor(am, 1)); am = fmaxf(am, __shfl_xor(am, 2)); am = fmaxf(am, __shfl_xor(am, 4));
    const float hs = (am > 0.f) ? am * (1.0f / 127.0f) : 1.0f, hinv = 1.0f / hs;
    v4u o;
#pragma unroll
    for (int q = 0; q < 4; ++q) { const int q0 = (int)rintf(h2[4 * q] * hinv), q1 = (int)rintf(h2[4 * q + 1] * hinv), q2 = (int)rintf(h2[4 * q + 2] * hinv), q3 = (int)rintf(h2[4 * q + 3] * hinv);
        o[q] = (unsigned)(q0 & 255) | ((unsigned)(q1 & 255) << 8) | ((unsigned)(q2 & 255) << 16) | ((unsigned)q3 << 24); }
    *(v4u*)(A.ws + WS_H2Q + (size_t)t * D + 16 * lane) = o;
    if ((lane & 7) == 0) ((float*)(A.ws + WS_HS))[(size_t)t * 8 + (lane >> 3)] = hs;
}

__device__ __forceinline__ float gelu_tanh(float x) { const float u = 0.7978845608028654f * (x + 0.044715f * x * x * x); return x / (1.0f + __expf(-2.0f * u)); }
__device__ __forceinline__ void peer_sliced_phase(Frame& F, const Args& A) {
    const int lane = F.lane, c8 = lane & 7, g8 = lane >> 3, gw = F.vcu * NWAVES + F.wave, NGW = F.G * NWAVES;
    const float* modf = (const float*)(A.ws + WS_MODF);
    const unsigned char* U8 = A.ws + WS_U; const unsigned char* V8 = A.ws + WS_V;
    const float* SU = (const float*)(A.ws + WS_U + 16 * MiB); const float* SV = (const float*)(A.ws + WS_V + 16 * MiB);
    const unsigned short* IDX = (const unsigned short*)(A.ws + WS_POOLED); const float* GATE = (const float*)(A.ws + WS_POOLED + 16 * MiB);
    const float* gf = A.in[17];
    LAS float* AL = (LAS float*)(F.lds + F.wave * 17664);
    LAS float* SSQ = AL + 2048;
    LAS float* SAV = AL + 3072;
    LAS float* RS2 = AL + 3088;
    LAS float* GS = AL + 3104;
    LAS unsigned short* IDL = (LAS unsigned short*)(AL + 3360);
    for (int tb = gw * 16; tb < T; tb += NGW * 16) {
        for (int i = lane; i < 2048; i += 64) AL[i] = 0.f;
        for (int i = lane; i < 1024; i += 64) SSQ[i] = 0.f;
#pragma unroll
        for (int i = 0; i < 16; ++i) *(LAS unsigned*)(IDL + i * 128 + 2 * lane) = *(const unsigned*)(IDX + (size_t)(tb + i) * PSEL + 2 * lane);
        if (lane < 16) { const f32x4* sp = (const f32x4*)((const float*)(A.ws + WS_SS2) + (size_t)(tb + lane) * 16); const f32x4 s4 = (sp[0] + sp[1]) + (sp[2] + sp[3]);
            RS2[lane] = 1.0f / sqrtf(((s4[0] + s4[1]) + (s4[2] + s4[3])) * (1.0f / D) + RMS_EPS); }
        LDS_WAIT();
        {
            v4i W0[16], W1[16]; f32x4 X0[4], X1[4]; v4i H; float hs;
            const int bU = tb / SEQ; const float* g2 = A.in[12];
#define PU_X(k, X) do { const int k_ = (k) < 128 ? (k) : 127; const int s_ = k_ >> 4, t_ = tb + (k_ & 15); _Pragma("unroll") for (int q = 0; q < 4; ++q) X[q] = *(const f32x4*)(A.out + (size_t)t_ * D + 128 * s_ + 16 * c8 + 4 * q); } while (0)
#define PU_B(k, W) do { const int k_ = (k) < 128 ? (k) : 127; const int s_ = k_ >> 4; const unsigned base_ = ((unsigned)s_ << 21) + 16u * (unsigned)c8; v4u I[2]; I[0] = *(const LAS v4u*)(IDL + (k_ & 15) * 128 + 16 * g8); I[1] = *(const LAS v4u*)(IDL + (k_ & 15) * 128 + 16 * g8 + 8); \
            _Pragma("unroll") for (int j = 0; j < 16; ++j) W[j] = *(const v4i*)(U8 + (base_ + (((I[j >> 3][(j >> 1) & 3] >> (16 * (j & 1))) & 0xffffu) << 7))); \
            } while (0)
#define PU_Q(k, X) do { const int s_ = (k) >> 4, i_ = (k) & 15; \
            if (i_ == 0) { LDS_WAIT(); if (g8 == 0) { _Pragma("unroll") for (int q = 0; q < 4; ++q) { const int cc = 128 * s_ + 16 * c8 + 4 * q; const f32x4 gg = *(const f32x4*)(g2 + cc), sc = *(const f32x4*)(modf + (size_t)bU * 6144 + 4096 + cc), sh = *(const f32x4*)(modf + (size_t)bU * 6144 + 3072 + cc); \
                *(LAS f32x4*)(GS + c8 * 16 + 4 * q) = gg * (sc + 1.0f); *(LAS f32x4*)(GS + 128 + c8 * 16 + 4 * q) = sh; } } LDS_WAIT(); } \
            const float rs_ = RS2[i_]; float h2[16]; float am = 0.f; \
            _Pragma("unroll") for (int q = 0; q < 4; ++q) { const f32x4 gq = *(const LAS f32x4*)(GS + c8 * 16 + 4 * q), sq = *(const LAS f32x4*)(GS + 128 + c8 * 16 + 4 * q); \
                _Pragma("unroll") for (int e = 0; e < 4; ++e) { const float h = X[q][e] * rs_ * gq[e] + sq[e]; h2[4 * q + e] = h; am = fmaxf(am, fabsf(h)); } } \
            am = fmaxf(am, __shfl_xor(am, 1)); am = fmaxf(am, __shfl_xor(am, 2)); am = fmaxf(am, __shfl_xor(am, 4)); \
            hs = (am > 0.f) ? am * (1.0f / 127.0f) : 1.0f; const float hinv = 1.0f / hs; \
            _Pragma("unroll") for (int q = 0; q < 4; ++q) { const int q0 = (int)rintf(h2[4 * q] * hinv), q1 = (int)rintf(h2[4 * q + 1] * hinv), q2 = (int)rintf(h2[4 * q + 2] * hinv), q3 = (int)rintf(h2[4 * q + 3] * hinv); \
                H[q] = (int)((unsigned)(q0 & 255) | ((unsigned)(q1 & 255) << 8) | ((unsigned)(q2 & 255) << 16) | ((unsigned)q3 << 24)); } } while (0)
#define PU_C(k, W) do { int part[16]; \
            _Pragma("unroll") for (int j = 0; j < 16; ++j) part[j] = __builtin_amdgcn_sdot4(W[j].x, H.x, __builtin_amdgcn_sdot4(W[j].y, H.y, __builtin_amdgcn_sdot4(W[j].z, H.z, __builtin_amdgcn_sdot4(W[j].w, H.w, 0, false), false), false), false); \
            _Pragma("unroll") for (int step = 4; step >= 1; step >>= 1) { const bool up = (lane & step) != 0; \
                _Pragma("unroll") for (int i = 0; i < 2 * step; ++i) { const int send = up ? part[i] : part[i + 2 * step], keep = up ? part[i + 2 * step] : part[i]; part[i] = keep + __shfl_xor(send, step); } } \
            LAS f32x2* ap_ = (LAS f32x2*)(AL + ((k) & 15) * 128 + 2 * lane); f32x2 a_ = *ap_; a_.x += hs * (float)part[0]; a_.y += hs * (float)part[1]; *ap_ = a_; } while (0)
            PU_X(0, X0); PU_X(1, X1); PU_B(0, W0);
#pragma unroll 1
            for (int k = 0; k < 128; k += 2) {
                PU_Q(k, X0); PU_B(k + 1, W1); PU_X(k + 2, X0);
                PU_C(k, W0);
                PU_Q(k + 1, X1); PU_B(k + 2, W0); PU_X(k + 3, X1);
                PU_C(k + 1, W1);
            }
#undef PU_X
#undef PU_B
#undef PU_Q
#undef PU_C
        }
        LDS_WAIT();
#pragma unroll 4
        for (int i = 0; i < 16; ++i) {
            const int t = tb + i; const unsigned e01 = *(const LAS unsigned*)(IDL + i * 128 + 2 * lane); const int e0 = (int)(e01 & 0xffffu), e1 = (int)(e01 >> 16);
            const f32x2 gt = *(const f32x2*)(GATE + (size_t)t * PSEL + 2 * lane); const f32x2 a = *(LAS f32x2*)(AL + i * 128 + 2 * lane);
            f32x2 av; av.x = gelu_tanh(a.x * SU[e0]) * gt.x * SV[e0]; av.y = gelu_tanh(a.y * SU[e1]) * gt.y * SV[e1];
            *(LAS f32x2*)(AL + i * 128 + 2 * lane) = av;
            const float sm = wave_sum(av.x + av.y); if (lane == 0) SAV[i] = 128.0f * sm;
        }
        LDS_WAIT();
        {
            v4u W0[16], W1[16]; f32x2 X0, X1, gt2v = (f32x2){0.f, 0.f};
            const int b = tb / SEQ;
#define PV_B(k, W, X) do { const int k_ = (k) < 128 ? (k) : 127; const int s_ = k_ >> 4, t_ = tb + (k_ & 15); const unsigned base_ = ((unsigned)s_ << 21) + 16u * (unsigned)c8; v4u I[2]; I[0] = *(const LAS v4u*)(IDL + (k_ & 15) * 128 + 16 * g8); I[1] = *(const LAS v4u*)(IDL + (k_ & 15) * 128 + 16 * g8 + 8); \
            _Pragma("unroll") for (int j = 0; j < 16; ++j) W[j] = *(const v4u*)(V8 + (base_ + (((I[j >> 3][(j >> 1) & 3] >> (16 * (j & 1))) & 0xffffu) << 7))); \
            X = __builtin_nontemporal_load((const f32x2*)(A.out + (size_t)t_ * D + 128 * s_ + 16 * c8 + 2 * g8)); } while (0)
#define PV_C(k, W, X) do { const int s_ = (k) >> 4, i_ = (k) & 15; \
            if (i_ == 0) gt2v = *(const f32x2*)(modf + (size_t)b * 6144 + 5120 + 128 * s_ + 16 * c8 + 2 * g8); \
            f32x2 acc[8]; _Pragma("unroll") for (int q = 0; q < 8; ++q) acc[q] = (f32x2){0.f, 0.f}; \
            const LAS f32x4* avp_ = (const LAS f32x4*)(AL + i_ * 128 + 16 * g8); \
            _Pragma("unroll") for (int q4 = 0; q4 < 4; ++q4) { const f32x4 a4 = avp_[q4]; \
                _Pragma("unroll") for (int e = 0; e < 4; ++e) { const float a = a4[e]; const v4u w = W[4 * q4 + e]; \
                    acc[0] += (f32x2){(float)(w.x & 255u), (float)((w.x >> 8) & 255u)} * a; acc[1] += (f32x2){(float)((w.x >> 16) & 255u), (float)(w.x >> 24)} * a; \
                    acc[2] += (f32x2){(float)(w.y & 255u), (float)((w.y >> 8) & 255u)} * a; acc[3] += (f32x2){(float)((w.y >> 16) & 255u), (float)(w.y >> 24)} * a; \
                    acc[4] += (f32x2){(float)(w.z & 255u), (float)((w.z >> 8) & 255u)} * a; acc[5] += (f32x2){(float)((w.z >> 16) & 255u), (float)(w.z >> 24)} * a; \
                    acc[6] += (f32x2){(float)(w.w & 255u), (float)((w.w >> 8) & 255u)} * a; acc[7] += (f32x2){(float)((w.w >> 16) & 255u), (float)(w.w >> 24)} * a; } } \
            float pc[16]; _Pragma("unroll") for (int q = 0; q < 8; ++q) { pc[2 * q] = acc[q].x; pc[2 * q + 1] = acc[q].y; } \
            _Pragma("unroll") for (int step = 4; step >= 1; step >>= 1) { const bool up = (g8 & step) != 0; \
                _Pragma("unroll") for (int i = 0; i < 2 * step; ++i) { const float send = up ? pc[i] : pc[i + 2 * step], keep = up ? pc[i + 2 * step] : pc[i]; pc[i] = keep + __shfl_xor(send, 8 * step); } } \
            const float sav_ = SAV[i_]; f32x2 x2_; x2_.x = X.x + gt2v.x * (pc[0] - sav_); x2_.y = X.y + gt2v.y * (pc[1] - sav_); \
            *(f32x2*)(A.out + (size_t)(tb + i_) * D + 128 * s_ + 16 * c8 + 2 * g8) = x2_; \
            SSQ[i_ * 64 + lane] += x2_.x * x2_.x + x2_.y * x2_.y; } while (0)
            PV_B(0, W0, X0);
#pragma unroll 1
            for (int k = 0; k < 128; k += 2) {
                PV_B(k + 1, W1, X1);
                PV_C(k, W0, X0);
                PV_B(k + 2, W0, X0);
                PV_C(k + 1, W1, X1);
            }
#undef PV_B
#undef PV_C
        }
        VM_WAIT(); LDS_WAIT();
#pragma unroll 2
        for (int i = 0; i < 16; ++i) {
            float* xr = A.out + (size_t)(tb + i) * D + 16 * lane;
            f32x4 v[4];
#pragma unroll
            for (int q = 0; q < 4; ++q) v[q] = __builtin_nontemporal_load((const f32x4*)(xr + 4 * q));
            const float rs = 1.0f / sqrtf(wave_sum(SSQ[i * 64 + lane]) * (1.0f / D) + RMS_EPS);
#pragma unroll
            for (int q = 0; q < 4; ++q) *(f32x4*)(xr + 4 * q) = v[q] * rs * *(const f32x4*)(gf + 16 * lane + 4 * q);
        }
        LDS_WAIT();
    }
}

#ifndef PHASE_ONLY
#define PHASE_ONLY -1
#endif
#ifndef PHASE_SKIP
#define PHASE_SKIP -2
#endif
#define PH(n) ((PHASE_ONLY < 0 || PHASE_ONLY == (n)) && PHASE_SKIP != (n))
#ifndef PROBE_DOUBLE
#define PROBE_DOUBLE -1
#endif
#define REPS(n) for (int rep_ = 0; rep_ < ((PROBE_DOUBLE == (n)) ? 2 : 1); ++rep_)
__global__ void __launch_bounds__(NTHREADS, 2) fwd_megakernel(Args A) {
    extern __shared__ __attribute__((aligned(16))) unsigned char lds[];
    Frame F;
    F.lds = (LAS unsigned char*)lds;
    F.MISC = (volatile LAS unsigned*)(F.lds + MISC_OFF);
    F.tid = threadIdx.x; F.lane = F.tid & 63; F.wave = __builtin_amdgcn_readfirstlane(F.tid >> 6);
    F.G = gridDim.x; { const int bx = blockIdx.x; F.vcu = (F.G % 8 == 0) ? (bx % 8) * (F.G / 8) + bx / 8 : bx; }
    F.ctl = (gu32*)(A.ws + WS_CTL);
    for (int u = F.tid; u < (LDS_BYTES - LDSCTL_OFF) / 4; u += NTHREADS) ((LAS unsigned*)(F.lds + LDSCTL_OFF))[u] = 0u;
    __syncthreads();
    XcdBarrier bar = xcd_barrier_post((unsigned*)(F.ctl + CW_BAR), F.MISC + 8);
#define GRID_BAR() do { xcd_barrier(bar); int t_ = threadIdx.x; asm volatile("" : "+v"(t_)); F.tid = t_; F.lane = t_ & 63; F.wave = __builtin_amdgcn_readfirstlane(t_ >> 6); } while (0)
    unsigned char* ws = A.ws;

    REPS(0) if (PH(0)) { p0a_mod(F, A); p0b_prologue<0>(F, A); }
    GRID_BAR();
    REPS(1) if (PH(1)) p0b_prologue<1>(F, A);
    GRID_BAR();
    REPS(2) if (PH(2)) {
        pg8::Gemm g{(const bf16*)(ws + WS_XG), nullptr, (const bf16*)(ws + WS_WIN), nullptr, D, D, D};
        pg8::StaticOrder S; S.init(T, INW, F.G, (int)blockIdx.x);
        pg8::EpiIn E{(bf16*)(ws + WS_QKVP), (bf16*)(ws + WS_GAB), (const float*)(ws + WS_RSTD1), (const float*)(ws + WS_BIAS1P), (float*)(ws + WS_KSUM), (unsigned*)(ws + WS_CTL) + CW_NRM};
        pg8::gemm_phase<pg8::EpiIn, pg8::StaticOrder, true, true>(F.lds + RING_OFF, g, S, E);
    }
    GRID_BAR();
    REPS(3) if (PH(3)) {
        const attn_body::AttnTensors AT{(const attn_body::bf16*)(ws + WS_QKVP), (const attn_body::bf16*)(ws + WS_QKVP) + (size_t)T * 512, (const attn_body::bf16*)(ws + WS_QKVP) + (size_t)2 * T * 512, (PROBE_DOUBLE == 3 && rep_ == 0) ? (attn_body::bf16*)(ws + WS_XG) : (attn_body::bf16*)(ws + WS_QKVP)};
        const attn_body::StaticOrder S((int)F.G, F.vcu);
        attn_body::attn_phase<attn_body::StaticOrder>((char*)lds + RING_OFF, AT, (const float*)(ws + WS_KSUM), (const float*)((const unsigned*)(ws + WS_CTL) + CW_NRM), S);
    }
    REPS(4) if (PH(4)) pooled_phase(F, A);
    GRID_BAR();
    REPS(5) if (PH(5)) {
        pg8::Gemm g{(const bf16*)(ws + WS_QKVP), (const bf16*)(ws + WS_POOLED), (const bf16*)(ws + WS_WA), (const bf16*)(ws + WS_WP), AW, AW, AW};
        pg8::DualOrder S; S.init(T, D, F.G, (int)blockIdx.x);
        pg8::EpiUp E{(bf16*)(ws + WS_XG), (const bf16*)(ws + WS_GAB), (const float*)(ws + WS_BPRIME)};
        pg8::gemm_phase<pg8::EpiUp, pg8::DualOrder, true, true>(F.lds + RING_OFF, g, S, E);
    }
    GRID_BAR();
    REPS(6) if (PH(6)) {
        pg8::Gemm g{(const bf16*)(ws + WS_XG), nullptr, (const bf16*)(ws + WS_WOUT), nullptr, D, D, D};
        pg8::StaticOrder S; S.init(T, D, F.G, (int)blockIdx.x);
        pg8::EpiOut E{A.in[0], A.out, (bf16*)(ws + WS_QKVP), (const float*)(ws + WS_MODF), A.in[12], (float*)(ws + WS_SS2)};
        pg8::gemm_phase<pg8::EpiOut, pg8::StaticOrder, true, true>(F.lds + RING_OFF, g, S, E);
    }
    GRID_BAR();
    REPS(7) if (PH(7)) {
        pg8::Gemm g{(const bf16*)(ws + WS_QKVP), nullptr, (const bf16*)(ws + WS_WQ), nullptr, D, D, D};
        pg8::StaticOrder S; S.init(T, PQW, F.G, (int)blockIdx.x);
        pg8::EpiPq E{(bf16*)(ws + WS_GAB), (const float*)(ws + WS_SS2), (const float*)(ws + WS_BIAS2P)};
        pg8::gemm_phase<pg8::EpiPq, pg8::StaticOrder, true, true>(F.lds + RING_OFF, g, S, E);
    }
    GRID_BAR();
    REPS(8) if (PH(8)) router_phase(F, A);
    GRID_BAR();
    if (PH(9)) peer_sliced_phase(F, A);
}

extern "C" void kernel_launch(void* const* d_in, const int* in_sizes, int n_in, void* d_out, int out_size, void* d_ws, size_t ws_size, hipStream_t stream) {
    static int grid = 0;
    if (grid == 0) {
        if (n_in != 18 || in_sizes[0] != T * D || out_size != T * D || ws_size < WS_END) { fprintf(stderr, "kernel_launch: unexpected shapes (n_in %d, in0 %d, out %d, ws %zu); nothing launched\n", n_in, n_in > 0 ? in_sizes[0] : -1, out_size, ws_size); grid = -1; return; }
        int dev = 0, cus = 0, per_cu = 0;
        if (hipGetDevice(&dev) != hipSuccess || hipDeviceGetAttribute(&cus, hipDeviceAttributeMultiprocessorCount, dev) != hipSuccess) { grid = -1; return; }
        if (hipFuncSetAttribute((const void*)fwd_megakernel, hipFuncAttributeMaxDynamicSharedMemorySize, LDS_BYTES) != hipSuccess) { fprintf(stderr, "kernel_launch: hipFuncSetAttribute failed\n"); grid = -1; return; }
        if (hipOccupancyMaxActiveBlocksPerMultiprocessor(&per_cu, (const void*)fwd_megakernel, NTHREADS, LDS_BYTES) != hipSuccess || per_cu < 1) { fprintf(stderr, "kernel_launch: occupancy query reports %d workgroups per CU\n", per_cu); per_cu = 1; }
        (void)hipGetLastError();
        grid = cus;
    }
    if (grid < 0) return;
    if (hipMemsetAsync((char*)d_ws + WS_CTL, 0, CTL_ZERO_BYTES, stream) != hipSuccess) { fprintf(stderr, "kernel_launch: hipMemsetAsync failed\n"); return; }
    Args a{};
    for (int i = 0; i < 18; ++i) a.in[i] = (const float*)d_in[i];
    a.out = (float*)d_out; a.ws = (unsigned char*)d_ws;
    void* kargs[] = {&a};
    hipError_t e = hipLaunchCooperativeKernel((const void*)fwd_megakernel, dim3(grid), dim3(NTHREADS), kargs, LDS_BYTES, stream);
    if (e != hipSuccess) fprintf(stderr, "kernel_launch: cooperative launch failed: %s (grid %d)\n", hipGetErrorString(e), grid);
}
```

```cpp
#define TABLES_IN_ROUTER 1
#include <hip/hip_runtime.h>
#include <hip/hip_bf16.h>
#include <cstdio>
#include <cstdint>
#include <cmath>

constexpr int NB = 8, SEQ = 4096, T = NB * SEQ, D = 1024;
constexpr int AW = 512, PW = 512, INW = 4096;
constexpr int NH = 8, HD = 64, MBLK = 256, NBLK = SEQ / MBLK;
constexpr int PQW = 2048, PEXP = 16384, PTOP = 16, PHEADS = 8, PSEL = PHEADS * PTOP;
constexpr float RMS_EPS = 1e-6f;
constexpr float LOG2E = 1.4426950408889634f;
constexpr float QSCALE = 0.125f * LOG2E;
constexpr int NWAVES = 8, NTHREADS = 512;

namespace pg8 {
#define PG8_LAS __attribute__((address_space(3)))
typedef unsigned short bf16_t;
typedef short bf16x8 __attribute__((ext_vector_type(8)));
typedef float f32x4 __attribute__((ext_vector_type(4)));
typedef unsigned u32x4 __attribute__((ext_vector_type(4)));
constexpr int BM = 256, BK = 64, HALF = 128, HTB = HALF * BK * 2  , STAGE_BYTES = 8 * HTB, NXCD = 8, WGM = 8;

__host__ __device__ __forceinline__ int lds_byte(int r, int c) { const int st = (r >> 4) * 2 + (c >> 5), rr = r & 15, cc = c & 31, ob = rr * 64 + cc * 2; return st * 1024 + (ob ^ (((ob >> 9) & 1) << 5)); }
__host__ __device__ __forceinline__ void stage_rc(int b, int& R, int& C) { const int st = b / 1024, sb = b % 1024, swz = sb ^ (((sb >> 9) & 1) << 5); R = (st >> 1) * 16 + swz / 64; C = (st & 1) * 32 + (swz % 64) / 2; }
__host__ __device__ __forceinline__ int perm32(int rho) { const int n = rho >> 4, i = rho & 15; return 8 * (i >> 2) + 4 * n + (i & 3); }

struct Unit { int pm, pn, part; };
struct Gemm {
    const bf16_t* A0; const bf16_t* A1; const bf16_t* B0; const bf16_t* B1; int lda, ldb, K;
    __device__ __forceinline__ const char* a_ptr(const Unit& u) const { return (const char*)(u.part ? A1 : A0) + (size_t)u.pm * BM * lda * 2; }
    __device__ __forceinline__ const char* b_ptr(const Unit& u) const { return (const char*)(u.part ? B1 : B0) + (size_t)u.pn * BM * ldb * 2; }
};

struct StaticOrder {
    int nM, nN, nwg, G, c;
    __host__ __device__ void init(int M, int N, int G_, int c_) { nM = M / BM; nN = N / BM; nwg = nM * nN; G = G_; c = c_; }
    __host__ __device__ bool tile(long L, Unit& u) const {
        if (L >= nwg) return false;
        int wgid = (int)L; { const int q = nwg / NXCD, r = nwg % NXCD, xcd = wgid % NXCD, off = wgid / NXCD; wgid = (xcd < r ? xcd * (q + 1) : r * (q + 1) + (xcd - r) * q) + off; }
        const int nig = WGM * nN, gid = wgid / nig, fm = gid * WGM, gsz = (nM - fm) < WGM ? (nM - fm) : WGM;
        u.pm = fm + ((wgid % nig) % gsz); u.pn = (wgid % nig) / gsz; u.part = 0; return true;
    }
    __host__ __device__ bool next(int i, Unit& u) const { return tile((long)i * G + c, u); }
    __device__ __forceinline__ void a_ready(const Unit&) const {}
    __device__ __forceinline__ void done(const Unit&) const {}
};
struct DualOrder {
    StaticOrder so;
    __host__ __device__ void init(int M, int N, int G_, int c_) { so.init(M, N, G_, c_); }
    __host__ __device__ bool next(int i, Unit& u) const { if (!so.tile((long)(i >> 1) * so.G + so.c, u)) return false; u.part = i & 1; return true; }
    __device__ __forceinline__ void a_ready(const Unit&) const {}
    __device__ __forceinline__ void done(const Unit&) const {}
};

__device__ __forceinline__ unsigned cvt_pk_bf16(float lo, float hi) { unsigned r; asm volatile("v_cvt_pk_bf16_f32 %0, %1, %2" : "=v"(r) : "v"(lo), "v"(hi)); return r; }
__device__ __forceinline__ float bf_lo(unsigned w) { return __uint_as_float(w << 16); }
__device__ __forceinline__ float bf_hi(unsigned w) { return __uint_as_float(w & 0xffff0000u); }
__device__ __forceinline__ float sigmoidf_(float x) { return __builtin_amdgcn_rcpf(1.0f + __builtin_amdgcn_exp2f(-x * 1.4426950408889634f)); }


struct EpiIn {
    static constexpr bool PERM = true, AFTER_DRAIN = false;
    bf16_t* QKVP; bf16_t* GAB; const float* rstd1; const float* bias1p; float* ksum; unsigned* nrm;
    __device__ __forceinline__ void operator()(const f32x4 (&acc)[2][2][4][2], const Unit& u, int wr, int wc, int fr, int fq) const {
        bf16_t* base; int ldc, col0;
        if (u.pn < 8) { base = QKVP + (size_t)(u.pn >> 1) * T * 512; ldc = 512; col0 = (u.pn & 1) * 256; }
        else { base = GAB + (size_t)((u.pn - 8) >> 2) * T * 1024; ldc = 1024; col0 = ((u.pn - 8) & 3) * 256; }
        const float sc = (u.pn < 2) ? QSCALE : 1.0f;
        const int b = u.pm >> 4;
        const int bcol = u.pn * 256 + wc * 32 + 8 * fq;
        f32x4 bv[2][2];
#pragma unroll
        for (int bj = 0; bj < 2; ++bj)
#pragma unroll
            for (int n = 0; n < 2; ++n) { f32x4 s = (f32x4){0.f, 0.f, 0.f, 0.f};
#pragma unroll
                for (int kc = 0; kc < 8; ++kc) s += *(const f32x4*)(bias1p + (size_t)(kc * 8 + b) * INW + bcol + bj * HALF + 4 * n);
                bv[bj][n] = s; }
        const bool isk = (u.pn == 2 || u.pn == 3); const bool isqk = (u.pn < 4); float nmax[2] = {0.f, 0.f};
        f32x4 ks[2][2];
#pragma unroll
        for (int bj = 0; bj < 2; ++bj)
#pragma unroll
            for (int n = 0; n < 2; ++n) ks[bj][n] = (f32x4){0.f, 0.f, 0.f, 0.f};
        const int row0 = u.pm * BM + wr * 64 + fr;
#pragma unroll
        for (int ai = 0; ai < 2; ++ai)
#pragma unroll
            for (int m = 0; m < 4; ++m) { const int row = row0 + ai * HALF + m * 16; const float rs = rstd1[row];
                bf16_t* rowp = base + (size_t)row * ldc + col0 + wc * 32 + 8 * fq;
#pragma unroll
                for (int bj = 0; bj < 2; ++bj) { f32x4 v0 = acc[ai][bj][m][0] * rs + bv[bj][0], v1 = acc[ai][bj][m][1] * rs + bv[bj][1];
                    ks[bj][0] += v0; ks[bj][1] += v1;
                    v0 = v0 * sc; v1 = v1 * sc;
                    if (isqk) { float ss = (v0[0] * v0[0] + v0[1] * v0[1]) + (v0[2] * v0[2] + v0[3] * v0[3]) + (v1[0] * v1[0] + v1[1] * v1[1]) + (v1[2] * v1[2] + v1[3] * v1[3]); ss += __shfl_xor(ss, 16); ss += __shfl_xor(ss, 32); nmax[bj] = fmaxf(nmax[bj], ss); }
                    u32x4 w; w.x = cvt_pk_bf16(v0[0], v0[1]); w.y = cvt_pk_bf16(v0[2], v0[3]); w.z = cvt_pk_bf16(v1[0], v1[1]); w.w = cvt_pk_bf16(v1[2], v1[3]);
                    *(u32x4*)(rowp + bj * HALF) = w; } }
        if (isqk) {
#pragma unroll
            for (int bj = 0; bj < 2; ++bj) { float v = nmax[bj]; v = fmaxf(v, __shfl_xor(v, 1)); v = fmaxf(v, __shfl_xor(v, 2)); v = fmaxf(v, __shfl_xor(v, 4)); v = fmaxf(v, __shfl_xor(v, 8));
                if (fr == 0 && fq == 0) atomicMax(nrm + (size_t)(b * 2 + (u.pn >> 1)) * 16 + (u.pn & 1) * 8 + bj * 4 + wc, __float_as_uint(v)); }
        }
        if (isk) {
#pragma unroll
            for (int bj = 0; bj < 2; ++bj)
#pragma unroll
                for (int n = 0; n < 2; ++n)
#pragma unroll
                    for (int e = 0; e < 4; ++e) { float v = ks[bj][n][e]; v += __shfl_xor(v, 1); v += __shfl_xor(v, 2); v += __shfl_xor(v, 4); v += __shfl_xor(v, 8); ks[bj][n][e] = v; }
            if (fr == 0) { float* kp = ksum + (size_t)u.pm * 512 + (u.pn - 2) * 256 + wc * 32 + 8 * fq;
#pragma unroll
                for (int bj = 0; bj < 2; ++bj)
#pragma unroll
                    for (int n = 0; n < 2; ++n)
#pragma unroll
                        for (int e = 0; e < 4; ++e) atomicAdd(kp + bj * HALF + 4 * n + e, ks[bj][n][e]); }
        }
    }
};

struct EpiUp {
    static constexpr bool PERM = true, AFTER_DRAIN = false;
    bf16_t* merged; const bf16_t* GAB; const float* bprime;
    __device__ __forceinline__ void operator()(const f32x4 (&acc)[2][2][4][2], const Unit& u, int wr, int wc, int fr, int fq) const {
        const int row0 = u.pm * BM + wr * 64 + fr, colb = u.pn * BM + wc * 32 + 8 * fq;
        const bf16_t* gate = GAB + (size_t)u.part * T * 1024;
        f32x4 bv[2][2];
#pragma unroll
        for (int bj = 0; bj < 2; ++bj)
#pragma unroll
            for (int n = 0; n < 2; ++n) { f32x4 s_ = (f32x4){0.f, 0.f, 0.f, 0.f}; if (u.part) { _Pragma("unroll") for (int g_ = 0; g_ < 4; ++g_) s_ += *(const f32x4*)(bprime + g_ * 1024 + colb + bj * HALF + 4 * n); } bv[bj][n] = s_; }
#pragma unroll
        for (int ai = 0; ai < 2; ++ai) {
            u32x4 gpre[4][2], ppre[4][2];
#pragma unroll
            for (int m = 0; m < 4; ++m) { const size_t off = (size_t)(row0 + ai * HALF + m * 16) * 1024 + colb;
#pragma unroll
                for (int bj = 0; bj < 2; ++bj) { gpre[m][bj] = __builtin_nontemporal_load((const u32x4*)(gate + off + bj * HALF));
                    if (u.part) ppre[m][bj] = __builtin_nontemporal_load((const u32x4*)(merged + off + bj * HALF)); else ppre[m][bj] = (u32x4){0u, 0u, 0u, 0u}; } }
#pragma unroll
            for (int m = 0; m < 4; ++m) { const size_t off = (size_t)(row0 + ai * HALF + m * 16) * 1024 + colb;
#pragma unroll
                for (int bj = 0; bj < 2; ++bj) {
                    const u32x4 gw = gpre[m][bj], pw = ppre[m][bj];
                    f32x4 v0 = acc[ai][bj][m][0] + bv[bj][0], v1 = acc[ai][bj][m][1] + bv[bj][1];
                    v0[0] *= sigmoidf_(bf_lo(gw.x)); v0[1] *= sigmoidf_(bf_hi(gw.x)); v0[2] *= sigmoidf_(bf_lo(gw.y)); v0[3] *= sigmoidf_(bf_hi(gw.y));
                    v1[0] *= sigmoidf_(bf_lo(gw.z)); v1[1] *= sigmoidf_(bf_hi(gw.z)); v1[2] *= sigmoidf_(bf_lo(gw.w)); v1[3] *= sigmoidf_(bf_hi(gw.w));
                    v0[0] += bf_lo(pw.x); v0[1] += bf_hi(pw.x); v0[2] += bf_lo(pw.y); v0[3] += bf_hi(pw.y); v1[0] += bf_lo(pw.z); v1[1] += bf_hi(pw.z); v1[2] += bf_lo(pw.w); v1[3] += bf_hi(pw.w);
                    u32x4 w; w.x = cvt_pk_bf16(v0[0], v0[1]); w.y = cvt_pk_bf16(v0[2], v0[3]); w.z = cvt_pk_bf16(v1[0], v1[1]); w.w = cvt_pk_bf16(v1[2], v1[3]);
                    *(u32x4*)(merged + off + bj * HALF) = w; } }
        }
        if (u.part == 0) asm volatile("s_waitcnt vmcnt(0)" ::: "memory");
    }
};

struct EpiOut {
    static constexpr bool PERM = true, AFTER_DRAIN = false;
    const float* x; float* x1; bf16_t* A2; const float* modf; const float* g2; float* ss2;
    __device__ __forceinline__ void operator()(const f32x4 (&acc)[2][2][4][2], const Unit& u, int wr, int wc, int fr, int fq) const {
        const int row0 = u.pm * BM + wr * 64 + fr, colb = u.pn * BM + wc * 32 + 8 * fq, b = u.pm >> 4;
        f32x4 gt[2][2], gg[2][2];
#pragma unroll
        for (int bj = 0; bj < 2; ++bj)
#pragma unroll
            for (int n = 0; n < 2; ++n) { const int c = colb + bj * HALF + 4 * n; gt[bj][n] = *(const f32x4*)(modf + (size_t)b * 6144 + 2048 + c);
                const f32x4 sc2 = *(const f32x4*)(modf + (size_t)b * 6144 + 4096 + c); gg[bj][n] = *(const f32x4*)(g2 + c) * (sc2 + 1.0f); }
#pragma unroll
        for (int ai = 0; ai < 2; ++ai) {
#pragma unroll
          for (int mh = 0; mh < 2; ++mh) {
            f32x4 xr[2][2][2];
#pragma unroll
            for (int m2 = 0; m2 < 2; ++m2) { const size_t off = (size_t)(row0 + ai * HALF + (2 * mh + m2) * 16) * 1024 + colb;
#pragma unroll
                for (int bj = 0; bj < 2; ++bj) { xr[m2][bj][0] = __builtin_nontemporal_load((const f32x4*)(x + off + bj * HALF)); xr[m2][bj][1] = __builtin_nontemporal_load((const f32x4*)(x + off + bj * HALF + 4)); } }
#pragma unroll
            for (int m2 = 0; m2 < 2; ++m2) { const int m = 2 * mh + m2; const int row = row0 + ai * HALF + m * 16; const size_t off = (size_t)row * 1024 + colb; float ssq = 0.f;
#pragma unroll
                for (int bj = 0; bj < 2; ++bj) {
                    const f32x4 y0 = xr[m2][bj][0] + gt[bj][0] * acc[ai][bj][m][0], y1 = xr[m2][bj][1] + gt[bj][1] * acc[ai][bj][m][1];
                    *(f32x4*)(x1 + off + bj * HALF) = y0; *(f32x4*)(x1 + off + bj * HALF + 4) = y1;
                    ssq += (y0[0] * y0[0] + y0[1] * y0[1]) + (y0[2] * y0[2] + y0[3] * y0[3]) + (y1[0] * y1[0] + y1[1] * y1[1]) + (y1[2] * y1[2] + y1[3] * y1[3]);
                    const f32x4 a0 = y0 * gg[bj][0], a1 = y1 * gg[bj][1];
                    u32x4 w; w.x = cvt_pk_bf16(a0[0], a0[1]); w.y = cvt_pk_bf16(a0[2], a0[3]); w.z = cvt_pk_bf16(a1[0], a1[1]); w.w = cvt_pk_bf16(a1[2], a1[3]);
                    *(u32x4*)(A2 + off + bj * HALF) = w; }
                ssq += __shfl_xor(ssq, 16); ssq += __shfl_xor(ssq, 32);
                if (fq == 0) ss2[(size_t)row * 16 + u.pn * 4 + wc] = ssq; }
          }
        }
    }
};

struct EpiPq {
    static constexpr bool PERM = true, AFTER_DRAIN = false;
    bf16_t* QP; const float* ss2; const float* bias2p;
    __device__ __forceinline__ void operator()(const f32x4 (&acc)[2][2][4][2], const Unit& u, int wr, int wc, int fr, int fq) const {
        const int row0 = u.pm * BM + wr * 64 + fr, colb = u.pn * BM + wc * 32 + 8 * fq, b = u.pm >> 4;
        f32x4 bv[2][2];
#pragma unroll
        for (int bj = 0; bj < 2; ++bj)
#pragma unroll
            for (int n = 0; n < 2; ++n) { f32x4 s = (f32x4){0.f, 0.f, 0.f, 0.f};
#pragma unroll
                for (int kc = 0; kc < 8; ++kc) s += *(const f32x4*)(bias2p + (size_t)(kc * 8 + b) * PQW + colb + bj * HALF + 4 * n);
                bv[bj][n] = s; }
#pragma unroll
        for (int ai = 0; ai < 2; ++ai)
#pragma unroll
            for (int m = 0; m < 4; ++m) { const int row = row0 + ai * HALF + m * 16;
                const f32x4* sp = (const f32x4*)(ss2 + (size_t)row * 16); const f32x4 s4 = (sp[0] + sp[1]) + (sp[2] + sp[3]);
                const float rs = __builtin_amdgcn_rsqf(((s4[0] + s4[1]) + (s4[2] + s4[3])) * (1.0f / D) + RMS_EPS);
                bf16_t* rowp = QP + (size_t)row * PQW + colb;
#pragma unroll
                for (int bj = 0; bj < 2; ++bj) { const f32x4 v0 = acc[ai][bj][m][0] * rs + bv[bj][0], v1 = acc[ai][bj][m][1] * rs + bv[bj][1];
                    u32x4 w; w.x = cvt_pk_bf16(v0[0], v0[1]); w.y = cvt_pk_bf16(v0[2], v0[3]); w.z = cvt_pk_bf16(v1[0], v1[1]); w.w = cvt_pk_bf16(v1[2], v1[3]);
                    *(u32x4*)(rowp + bj * HALF) = w; } }
    }
};

template <class Epi, class Sched, bool ALIGN_EPI = false, bool SP2 = false>
__device__ __forceinline__ void gemm_phase(PG8_LAS unsigned char* lds, const Gemm g, const Sched& S, const Epi& E) {
    int tid_ = threadIdx.x; asm volatile("" : "+v"(tid_));
    const int tid = tid_, wid = __builtin_amdgcn_readfirstlane(tid >> 6), lane = tid & 63, wr = wid >> 2, wc = wid & 3, fr = lane & 15, fq = lane >> 4;
    const int K = g.K, nt = K / BK, lda = g.lda, ldb = g.ldb;
    unsigned voffA[2], voffB[2];
#pragma unroll
    for (int i = 0; i < 2; ++i) { int R, C; stage_rc(tid * 16 + i * 8192, R, C); const int Rb = Epi::PERM ? ((R & ~31) + perm32(R & 31)) : R;
        voffA[i] = (unsigned)(R * lda + C) * 2u; voffB[i] = (unsigned)(Rb * ldb + C) * 2u; }
    const size_t kstep = (size_t)(BK * 2);
    const size_t hstepA = (size_t)HALF * lda * 2, hstepB = (size_t)HALF * ldb * 2;
    const unsigned ldsw = (unsigned)wid * 1024u;
    const int aoff = lds_byte(wr * 64 + fr, fq * 8), boff = lds_byte(wc * 32 + fr, fq * 8);
#define PG8_SA(b, h) (((b) * 2 + (h)) * HTB)
#define PG8_SB(b, h) ((4 + (b) * 2 + (h)) * HTB)
#define PG8_STAGE(bufoff, gbase, voff) do { _Pragma("unroll") for (int _i = 0; _i < 2; ++_i) \
        __builtin_amdgcn_global_load_lds((const unsigned*)((const char*)(gbase) + (voff)[_i]), (PG8_LAS unsigned*)(lds + (bufoff) + ldsw + _i * 8192), 16, 0, 0); } while (0)
#define PG8_LDA(dst, b, h) do { _Pragma("unroll") for (int m = 0; m < 4; ++m) _Pragma("unroll") for (int k = 0; k < 2; ++k) dst[m][k] = *(const PG8_LAS bf16x8*)(lds + PG8_SA(b, h) + aoff + m * 2048 + k * 1024); } while (0)
#define PG8_LDB(dst, b, h) do { _Pragma("unroll") for (int n = 0; n < 2; ++n) _Pragma("unroll") for (int k = 0; k < 2; ++k) dst[n][k] = *(const PG8_LAS bf16x8*)(lds + PG8_SB(b, h) + boff + n * 2048 + k * 1024); } while (0)
#define PG8_MMA(ai, bj, At, Bt) do { __builtin_amdgcn_s_setprio(1); _Pragma("unroll") for (int m = 0; m < 4; ++m) _Pragma("unroll") for (int n = 0; n < 2; ++n) _Pragma("unroll") for (int k = 0; k < 2; ++k) \
        acc[ai][bj][m][n] = __builtin_amdgcn_mfma_f32_16x16x32_bf16(Bt[n][k], At[m][k], acc[ai][bj][m][n], 0, 0, 0); __builtin_amdgcn_s_setprio(0); } while (0)
#define PG8_WAIT_V(n) asm volatile("s_waitcnt vmcnt(" #n ")" ::: "memory")
#define PG8_WAIT_L(n) asm volatile("s_waitcnt lgkmcnt(" #n ")" ::: "memory")
#define PG8_BAR __builtin_amdgcn_s_barrier()
#define PG8_SCHED __builtin_amdgcn_sched_barrier(0)
    Unit cur, nxt; int ui = 0;
    if (!S.next(0, cur)) return;
    f32x4 acc[2][2][4][2];
#pragma unroll
    for (int a = 0; a < 2; ++a)
#pragma unroll
        for (int b = 0; b < 2; ++b)
#pragma unroll
            for (int m = 0; m < 4; ++m)
#pragma unroll
                for (int n = 0; n < 2; ++n) acc[a][b][m][n] = (f32x4){0.f, 0.f, 0.f, 0.f};
    bf16x8 At[4][2], B0[2][2], B1[2][2];
    const char* cA = g.a_ptr(cur); const char* cB = g.b_ptr(cur);
    S.a_ready(cur);
    if constexpr (SP2) {
        PG8_STAGE(PG8_SB(0, 0), cB, voffB); PG8_STAGE(PG8_SB(0, 1), cB + hstepB, voffB); PG8_STAGE(PG8_SA(0, 0), cA, voffA); PG8_STAGE(PG8_SA(0, 1), cA + hstepA, voffA);
        if (wr == 1) PG8_BAR;
        PG8_WAIT_V(2); PG8_BAR;
        PG8_STAGE(PG8_SB(1, 0), cB + kstep, voffB); PG8_STAGE(PG8_SA(1, 0), cA + kstep, voffA); PG8_STAGE(PG8_SB(1, 1), cB + hstepB + kstep, voffB);
        PG8_WAIT_V(6); PG8_BAR;
    } else {
        PG8_STAGE(PG8_SB(0, 0), cB, voffB); PG8_STAGE(PG8_SA(0, 0), cA, voffA); PG8_STAGE(PG8_SB(0, 1), cB + hstepB, voffB); PG8_STAGE(PG8_SA(0, 1), cA + hstepA, voffA);
        if (wr == 1) PG8_BAR;
        PG8_WAIT_V(4); PG8_BAR;
        PG8_STAGE(PG8_SB(1, 0), cB + kstep, voffB); PG8_STAGE(PG8_SA(1, 0), cA + kstep, voffA); PG8_STAGE(PG8_SB(1, 1), cB + hstepB + kstep, voffB);
        PG8_WAIT_V(6); PG8_BAR;
    }
    for (;;) {
        const bool has_next = S.next(ui + 1, nxt);
        const char* nA = has_next ? g.a_ptr(nxt) : cA; const char* nB = has_next ? g.b_ptr(nxt) : cB;
        for (int t = 0; t < nt; t += 2) {
            const bool last = (t == nt - 2);
            const char* a1 = cA + (size_t)(t + 1) * kstep;
            const char* a2 = last ? nA : cA + (size_t)(t + 2) * kstep; const char* b2 = last ? nB : cB + (size_t)(t + 2) * kstep;
            const char* a3 = a2 + kstep; const char* b3 = b2 + kstep;
            if (last && has_next) S.a_ready(nxt);
            if constexpr (SP2) {
            PG8_LDB(B0, 0, 0); PG8_LDB(B1, 0, 1); PG8_SCHED; PG8_LDA(At, 0, 0); PG8_STAGE(PG8_SA(1, 1), a1 + hstepA, voffA);
            PG8_WAIT_V(8); PG8_WAIT_L(0); PG8_BAR; PG8_MMA(0, 0, At, B0); PG8_MMA(0, 1, At, B1); PG8_BAR; PG8_SCHED;
            PG8_LDA(At, 0, 1); PG8_STAGE(PG8_SB(0, 0), b2, voffB); PG8_STAGE(PG8_SB(0, 1), b2 + hstepB, voffB); PG8_STAGE(PG8_SA(0, 0), a2, voffA);
            PG8_WAIT_V(8); PG8_WAIT_L(0); PG8_BAR; PG8_MMA(1, 0, At, B0); PG8_MMA(1, 1, At, B1); PG8_BAR; PG8_SCHED;
            PG8_LDB(B0, 1, 0); PG8_LDB(B1, 1, 1); PG8_SCHED; PG8_LDA(At, 1, 0); PG8_STAGE(PG8_SA(0, 1), a2 + hstepA, voffA);
            PG8_WAIT_V(8); PG8_WAIT_L(0); PG8_BAR; PG8_MMA(0, 0, At, B0); PG8_MMA(0, 1, At, B1); PG8_BAR; PG8_SCHED;
            PG8_LDA(At, 1, 1); PG8_STAGE(PG8_SB(1, 0), b3, voffB); PG8_STAGE(PG8_SB(1, 1), b3 + hstepB, voffB); PG8_STAGE(PG8_SA(1, 0), a3, voffA);
            PG8_WAIT_V(8); PG8_WAIT_L(0); PG8_BAR; PG8_MMA(1, 0, At, B0); PG8_MMA(1, 1, At, B1); PG8_BAR; PG8_SCHED;
            } else {
            PG8_LDB(B0, 0, 0); PG8_SCHED; PG8_LDA(At, 0, 0); PG8_STAGE(PG8_SA(1, 1), a1 + hstepA, voffA);
            PG8_WAIT_L(8); PG8_BAR; PG8_WAIT_L(0); PG8_MMA(0, 0, At, B0); PG8_BAR; PG8_SCHED;
            PG8_LDB(B1, 0, 1); PG8_STAGE(PG8_SB(0, 0), b2, voffB);
            PG8_BAR; PG8_WAIT_L(0); PG8_MMA(0, 1, At, B1); PG8_BAR;
            PG8_LDA(At, 0, 1); PG8_STAGE(PG8_SA(0, 0), a2, voffA);
            PG8_BAR; PG8_WAIT_L(0); PG8_MMA(1, 0, At, B0); PG8_BAR; PG8_SCHED;
            PG8_STAGE(PG8_SB(0, 1), b2 + hstepB, voffB);
            PG8_WAIT_V(6); PG8_BAR; PG8_MMA(1, 1, At, B1); PG8_BAR;
            PG8_LDB(B0, 1, 0); PG8_SCHED; PG8_LDA(At, 1, 0); PG8_STAGE(PG8_SA(0, 1), a2 + hstepA, voffA);
            PG8_WAIT_L(8); PG8_BAR; PG8_WAIT_L(0); PG8_MMA(0, 0, At, B0); PG8_BAR; PG8_SCHED;
            PG8_LDB(B1, 1, 1); PG8_STAGE(PG8_SB(1, 0), b3, voffB);
            PG8_BAR; PG8_WAIT_L(0); PG8_MMA(0, 1, At, B1); PG8_BAR;
            PG8_LDA(At, 1, 1); PG8_STAGE(PG8_SA(1, 0), a3, voffA);
            PG8_BAR; PG8_WAIT_L(0); PG8_MMA(1, 0, At, B0); PG8_BAR; PG8_SCHED;
            PG8_STAGE(PG8_SB(1, 1), b3 + hstepB, voffB);
            PG8_WAIT_V(6); PG8_BAR; PG8_MMA(1, 1, At, B1); PG8_BAR;
            }
        }
        if constexpr (ALIGN_EPI) { if (wr == 0) PG8_BAR; }
        if constexpr (!Epi::AFTER_DRAIN) { E(acc, cur, wr, wc, fr, fq); S.done(cur); }
        if (!has_next) break;
#pragma unroll
        for (int a = 0; a < 2; ++a)
#pragma unroll
            for (int b = 0; b < 2; ++b)
#pragma unroll
                for (int m = 0; m < 4; ++m)
#pragma unroll
                    for (int n = 0; n < 2; ++n) acc[a][b][m][n] = (f32x4){0.f, 0.f, 0.f, 0.f};
        cur = nxt; cA = nA; cB = nB; ++ui;
        if constexpr (ALIGN_EPI) { if (wr == 1) PG8_BAR; }
    }
    PG8_WAIT_V(0);
    if constexpr (!ALIGN_EPI) { if (wr == 0) PG8_BAR; }
    PG8_BAR;
    if constexpr (Epi::AFTER_DRAIN) { E.fused(acc, cur, wr, wc, fr, fq, lds, wid, lane); S.done(cur); }
#undef PG8_SA
#undef PG8_SB
#undef PG8_STAGE
#undef PG8_LDA
#undef PG8_LDB
#undef PG8_MMA
#undef PG8_WAIT_V
#undef PG8_WAIT_L
#undef PG8_BAR
#undef PG8_SCHED
}
}

constexpr size_t MiB = 1u << 20;
constexpr size_t WS_CTL = 0, CTL_ZERO_BYTES = 32 * 1024;
constexpr size_t WS_KSUM = 256 * 1024;
constexpr size_t WS_MODP = 1 * MiB;
constexpr size_t WS_MODF = WS_MODP + 8 * 8 * 6144 * 4;
constexpr size_t WS_BIAS1P = 3 * MiB;
constexpr size_t WS_BIAS2P = 4 * MiB;
constexpr size_t WS_BPRIME = 4 * MiB + 512 * 1024;
constexpr size_t WS_RSTD1 = 5 * MiB;
constexpr size_t WS_SS2 = 6 * MiB;
constexpr size_t WS_SUBK = 8 * MiB;
constexpr size_t WS_WIN = 16 * MiB, WS_WA = 24 * MiB, WS_WP = 25 * MiB, WS_WOUT = 26 * MiB, WS_WQ = 28 * MiB;
constexpr size_t WS_U = 32 * MiB, WS_V = 64 * MiB;
constexpr size_t WS_XG = 96 * MiB;
constexpr size_t WS_H2Q = WS_XG, WS_HS = WS_XG + 32 * MiB;
constexpr size_t WS_QKVP = 160 * MiB;
constexpr size_t WS_GAB = 288 * MiB;
constexpr size_t WS_POOLED = 416 * MiB;
constexpr size_t WS_END = 448 * MiB;
constexpr int CW_TMO = 0, CW_BAR = 4096;
constexpr int CW_NRM = 2048;

constexpr int RING_OFF = 0, RING_BYTES = 131072;
constexpr int LDS_BYTES = 147456;
constexpr int LDSCTL_OFF = LDS_BYTES - 512, MISC_OFF = LDSCTL_OFF + 320;

#define GAS __attribute__((address_space(1)))
#define LAS __attribute__((address_space(3)))
typedef unsigned short bf16;
typedef unsigned v4u __attribute__((ext_vector_type(4)));
typedef unsigned v2u __attribute__((ext_vector_type(2)));
typedef float f32x4 __attribute__((ext_vector_type(4)));
typedef GAS unsigned gu32;
#define RLX_AGENT __ATOMIC_RELAXED, __HIP_MEMORY_SCOPE_AGENT
#define LDS_WAIT() asm volatile("s_waitcnt lgkmcnt(0)" ::: "memory")
#define VM_WAIT() asm volatile("s_waitcnt vmcnt(0)" ::: "memory")
__device__ __forceinline__ unsigned f2bf(float f) { unsigned u = __builtin_bit_cast(unsigned, f); return (u + 0x7fffu + ((u >> 16) & 1u)) >> 16; }
__device__ __forceinline__ unsigned pk2(float lo, float hi) { return f2bf(lo) | (f2bf(hi) << 16); }
__device__ __forceinline__ float bflo(unsigned w) { return __uint_as_float(w << 16); }
__device__ __forceinline__ float bfhi(unsigned w) { return __uint_as_float(w & 0xffff0000u); }
__device__ __forceinline__ float wave_sum(float v) {
#pragma unroll
    for (int o = 1; o < 64; o <<= 1) v += __shfl_xor(v, o);
    return v;
}
__device__ __forceinline__ float wave_max(float v) {
#pragma unroll
    for (int o = 1; o < 64; o <<= 1) v = fmaxf(v, __shfl_xor(v, o));
    return v;
}

#define XB_TMO      128
#define XB_XCNT(j)  (256  + 64 * (j))
#define XB_XSUB(j)  (1280 + 64 * (j))
#define XB_XGEN(j)  (2304 + 64 * (j))
#define XB_TOP      3328
#define XB_TOPGEN   3392
#define XCD_BAR_WORDS 3456
#define XB_SPIN_CAP (1u << 22)

__device__ __forceinline__ unsigned xb_ld(unsigned* p)              { return __hip_atomic_load(p, __ATOMIC_RELAXED, __HIP_MEMORY_SCOPE_AGENT); }
__device__ __forceinline__ unsigned xb_add(unsigned* p, unsigned v) { return __hip_atomic_fetch_add(p, v, __ATOMIC_RELAXED, __HIP_MEMORY_SCOPE_AGENT); }
__device__ __forceinline__ unsigned xb_xcc_id() { return (unsigned)__builtin_amdgcn_s_getreg((3 << 11) | 20) & 0xFu; }
#define XB_SPIN(cond, bar) do { unsigned _sp = 0; while (cond) { __builtin_amdgcn_s_sleep(1); \
    if ((++_sp & 255u) == 0u) { if (xb_ld(&(bar)[XB_TMO])) break; if (_sp > XB_SPIN_CAP) { atomicAdd(&(bar)[XB_TMO], 1u); break; } } } } while (0)

struct XcdBarrier { unsigned* bar; unsigned x; volatile LAS unsigned* st; };

__device__ __forceinline__ XcdBarrier xcd_barrier_post(unsigned* bar, volatile LAS unsigned* st) {
    XcdBarrier b; b.bar = bar; b.x = xb_xcc_id(); b.st = st;
    if (threadIdx.x == 0) (void)xb_add(&bar[XB_XCNT(b.x)], 1u);
    return b;
}
__device__ __forceinline__ void xcd_barrier_complete(unsigned* bar, unsigned x, unsigned& nloc, unsigned& nx) {
    const unsigned G = gridDim.x * gridDim.y * gridDim.z;
    unsigned sum, cnt, mine, sp = 0u;
    for (;;) {
        sum = 0u; cnt = 0u; mine = 0u;
#pragma unroll
        for (unsigned j = 0; j < 16; ++j) { const unsigned c = xb_ld(&bar[XB_XCNT(j)]); sum += c; cnt += (c > 0u) ? 1u : 0u; mine = (j == x) ? c : mine; }
        if (sum == G) break;
        __builtin_amdgcn_s_sleep(1);
        if ((++sp & 255u) == 0u) { if (xb_ld(&bar[XB_TMO])) break; if (sp > XB_SPIN_CAP) { atomicAdd(&bar[XB_TMO], 1u); break; } }
    }
    nloc = mine > 0u ? mine : 1u; nx = cnt > 0u ? cnt : 1u;
}
__device__ __forceinline__ void xcd_barrier(const XcdBarrier& b) {
    asm volatile("s_waitcnt vmcnt(0)" ::: "memory");
    __syncthreads();
    if (threadIdx.x == 0) {
        unsigned* bar = b.bar;
        __builtin_amdgcn_s_waitcnt(0);
        unsigned nloc = b.st[0], nx = b.st[1];
        if (nloc == 0u) { xcd_barrier_complete(bar, b.x, nloc, nx); b.st[0] = nloc; b.st[1] = nx; }
        const unsigned old = xb_add(&bar[XB_XSUB(b.x)], 1u);
        const unsigned gen = old / nloc;
        if (old + 1u == (gen + 1u) * nloc) {
            __builtin_amdgcn_fence(__ATOMIC_RELEASE, "agent");
            asm volatile("s_waitcnt vmcnt(0)" ::: "memory");
            const unsigned og = xb_add(&bar[XB_TOP], 1u);
            const unsigned tg = og / nx;
            if (og + 1u == (tg + 1u) * nx) xb_add(&bar[XB_TOPGEN], 1u);
            else XB_SPIN(xb_ld(&bar[XB_TOPGEN]) == tg, bar);
            __builtin_amdgcn_fence(__ATOMIC_ACQUIRE, "agent");
            xb_add(&bar[XB_XGEN(b.x)], 1u);
            asm volatile("s_waitcnt vmcnt(0)" ::: "memory");
        } else {
            XB_SPIN(xb_ld(&bar[XB_XGEN(b.x)]) == gen, bar);
            __builtin_amdgcn_fence(__ATOMIC_ACQUIRE, "agent");
            asm volatile("s_waitcnt vmcnt(0)" ::: "memory");
        }
    }
    __syncthreads();
}

struct Frame {
    LAS unsigned char* lds;
    volatile LAS unsigned* MISC;
    gu32* ctl;
    int tid, lane, wave;
    int vcu, G;
};
struct Args { const float* in[18]; float* out; unsigned char* ws; };

__device__ __forceinline__ float modp_sum(const float* modp, int idx) {
    float s = 0.f;
#pragma unroll
    for (int kc = 0; kc < 8; ++kc) s += modp[(size_t)kc * 8 * 6144 + idx];
    return s;
}
template <int MODE>
__device__ __forceinline__ void p0_wg_dot(Frame& F, const float* cin, const float* modp, int soff, const float* W, int N, const float* addv, float* outp, int first, int ntask) {
    LAS float* scr = (LAS float*)(F.lds + RING_OFF + F.wave * 16384);
    const int ncn = N / 64;
    for (int it = first; it < ntask; it += F.G) {
        const int kc = it / ncn, nc = it % ncn, k0 = kc * 128 + F.wave * 16, n = nc * 64 + F.lane;
        float w[16];
#pragma unroll
        for (int kk = 0; kk < 16; ++kk) w[kk] = (MODE == 0) ? __builtin_nontemporal_load(W + (size_t)(k0 + kk) * N + n) : W[(size_t)(k0 + kk) * N + n];
#pragma unroll
        for (int j = 0; j < 2; ++j) { const int idx = F.lane + 64 * j, b = idx >> 4, kk = idx & 15;
            float cf; if (MODE == 0) { const float cv = cin[b * 1024 + k0 + kk]; cf = cv / (1.0f + __expf(-cv)); } else cf = modp_sum(modp, b * 6144 + soff + k0 + kk);
            scr[idx] = cf; }
        LDS_WAIT(); asm volatile("" ::: "memory");
#pragma unroll
        for (int b = 0; b < 8; ++b) { float s = 0.f;
#pragma unroll
            for (int kk = 0; kk < 16; ++kk) s += scr[b * 16 + kk] * w[kk];
            scr[256 + b * 64 + F.lane] = s; }
        __syncthreads();
        { const int b = F.wave; float s = (addv != nullptr && kc == 0) ? addv[n] : 0.f;
#pragma unroll
          for (int w8 = 0; w8 < 8; ++w8) s += ((LAS float*)(F.lds + RING_OFF + w8 * 16384))[256 + b * 64 + F.lane];
          outp[(size_t)(kc * 8 + b) * N + n] = s; }
        __syncthreads();
    }
}
__device__ __forceinline__ void p0a_mod(Frame& F, const Args& A) { p0_wg_dot<0>(F, A.in[1], nullptr, 0, A.in[2], 6144, A.in[3], (float*)(A.ws + WS_MODP), F.vcu, 8 * 96); }
__device__ __forceinline__ void p0_wp_task(Frame& F, const Args& A, int r) {
    LAS float* scr = (LAS float*)(F.lds + RING_OFF + F.wave * 16384);
    const int g = r >> 6, kq = (r >> 4) & 3, nc = r & 15, n = nc * 64 + F.lane, d0 = 16 * F.wave;
    const float* wmix = A.in[7] + (size_t)(g * 128 + 32 * kq) * 128 + d0; const float* scale = A.in[9] + g * 128 + d0; const float* wup = A.in[10] + (size_t)(g * 128 + d0) * D + n; const float* bmix = A.in[8] + g * 128 + d0;
    float wu[16];
#pragma unroll
    for (int d = 0; d < 16; ++d) wu[d] = wup[(size_t)d * D];
    float bp = 0.f;
#pragma unroll
    for (int d = 0; d < 16; ++d) { wu[d] *= scale[d]; bp += bmix[d] * wu[d]; }
#pragma unroll
    for (int kk = 0; kk < 32; ++kk) { float s = 0.f;
#pragma unroll
        for (int d = 0; d < 16; ++d) s += wmix[kk * 128 + d] * wu[d];
        scr[kk * 64 + F.lane] = s; }
    scr[2048 + F.lane] = bp;
    __syncthreads();
    { float s[4]; float bs = 0.f;
#pragma unroll
      for (int e = 0; e < 4; ++e) s[e] = 0.f;
#pragma unroll
      for (int w8 = 0; w8 < 8; ++w8) { const LAS float* o = (const LAS float*)(F.lds + RING_OFF + w8 * 16384);
#pragma unroll
          for (int e = 0; e < 4; ++e) s[e] += o[(4 * F.wave + e) * 64 + F.lane];
          bs += o[2048 + F.lane]; }
      v2u w; w.x = pk2(s[0], s[1]); w.y = pk2(s[2], s[3]);
      *(GAS v2u*)((bf16*)(A.ws + WS_WP) + (size_t)n * PW + g * 128 + 32 * kq + 4 * F.wave) = w;
      if (kq == 0 && F.wave == 0) ((float*)(A.ws + WS_BPRIME))[g * 1024 + n] = bs; }
    __syncthreads();
}

__device__ __forceinline__ void p0_transpose_item(const float* W, int K, int N, bf16* WT, int row_off, LAS float* scr, int item, int lane) {
    const int nblk = N / 32, kb = item / nblk, nb = item % nblk, k0 = 64 * kb, n0 = 32 * nb;
#pragma unroll 8
    for (int i = 0; i < 32; ++i) { const int kk = 2 * i + (lane >> 5); scr[kk * 33 + (lane & 31)] = __builtin_nontemporal_load(W + (size_t)(k0 + kk) * N + n0 + (lane & 31)); }
    LDS_WAIT(); asm volatile("" ::: "memory");
    const int c = lane & 7;
#pragma unroll
    for (int j = 0; j < 4; ++j) { const int n = (lane >> 3) + 8 * j; const LAS float* s = scr + (8 * c) * 33 + n;
        v4u o; o.x = pk2(s[0 * 33], s[1 * 33]); o.y = pk2(s[2 * 33], s[3 * 33]); o.z = pk2(s[4 * 33], s[5 * 33]); o.w = pk2(s[6 * 33], s[7 * 33]);
        *(GAS v4u*)(WT + (size_t)(row_off + n0 + n) * K + k0 + 8 * c) = o; }
    LDS_WAIT(); asm volatile("" ::: "memory");
}
__device__ __forceinline__ void p0_table_rows4(const float* const (&src)[4], unsigned char* const (&dst)[4], float* const (&scale_out)[4], int off, int lane) {
    f32x4 v[4][4]; float am[4];
#pragma unroll
    for (int u = 0; u < 4; ++u)
#pragma unroll
        for (int q = 0; q < 4; ++q) v[u][q] = __builtin_nontemporal_load((const f32x4*)(src[u] + 16 * lane + 4 * q));
#pragma unroll
    for (int u = 0; u < 4; ++u) { float a = 0.f;
#pragma unroll
        for (int q = 0; q < 4; ++q) a = fmaxf(fmaxf(a, fmaxf(fabsf(v[u][q][0]), fabsf(v[u][q][1]))), fmaxf(fabsf(v[u][q][2]), fabsf(v[u][q][3])));
        am[u] = a; }
#pragma unroll
    for (int o = 1; o < 64; o <<= 1) {
#pragma unroll
        for (int u = 0; u < 4; ++u) am[u] = fmaxf(am[u], __shfl_xor(am[u], o)); }
#pragma unroll
    for (int u = 0; u < 4; ++u) { const float sc = (am[u] > 0.f) ? am[u] * (1.0f / 127.0f) : 1.0f, inv = 1.0f / sc;
        v4u o;
#pragma unroll
        for (int q = 0; q < 4; ++q) { const int q0 = (int)rintf(v[u][q][0] * inv) + off, q1 = (int)rintf(v[u][q][1] * inv) + off, q2 = (int)rintf(v[u][q][2] * inv) + off, q3 = (int)rintf(v[u][q][3] * inv) + off;
            o[q] = (unsigned)(q0 & 255) | ((unsigned)(q1 & 255) << 8) | ((unsigned)(q2 & 255) << 16) | ((unsigned)q3 << 24); }
        *(GAS v4u*)(dst[u] + ((size_t)(lane >> 3) << 21) + 16 * (lane & 7)) = o;
        if (lane == 0) *scale_out[u] = sc; }
}
__device__ __forceinline__ void p0_table_trip(const Args& A, int r0, int NGW, int lane) {
    const float* src[4]; unsigned char* dst[4]; float* sco[4];
#pragma unroll
    for (int u = 0; u < 4; ++u) { int r = r0 + u * NGW; if (r >= 2 * PEXP) r = r0; const int tb = r / PEXP, e = r % PEXP;
        src[u] = (tb ? A.in[16] : A.in[15]) + (size_t)e * D; dst[u] = A.ws + (tb ? WS_V : WS_U) + (size_t)e * 128; sco[u] = (float*)(A.ws + (tb ? WS_V : WS_U) + 16 * MiB) + e; }
    const int tb0 = r0 / PEXP;
    if ((r0 + 3 * NGW) / PEXP == tb0 && r0 + 3 * NGW < 2 * PEXP) p0_table_rows4(src, dst, sco, tb0 ? 128 : 0, lane);
    else { for (int u = 0; u < 4; ++u) { const int r = r0 + u * NGW; if (r < 2 * PEXP) { const float* s1[4] = {src[u], src[u], src[u], src[u]}; unsigned char* d1[4] = {dst[u], dst[u], dst[u], dst[u]}; float* c1[4] = {sco[u], sco[u], sco[u], sco[u]}; p0_table_rows4(s1, d1, c1, (r / PEXP) ? 128 : 0, lane); } } }
}
template <int STAGE>
__device__ __forceinline__ void p0b_prologue(Frame& F, const Args& A) {
    const int gw = F.vcu * NWAVES + F.wave, NGW = F.G * NWAVES, lane = F.lane;
    const float* modp = (const float*)(A.ws + WS_MODP);
    LAS float* G1 = (LAS float*)(F.lds + 135168);
    if (STAGE == 0) { float* ks = (float*)(A.ws + WS_KSUM); for (int i = F.vcu * NTHREADS + F.tid; i < NB * NBLK * 512; i += F.G * NTHREADS) ks[i] = 0.f; }
    if (STAGE == 0) { for (int r = F.vcu; r < 256; r += F.G) p0_wp_task(F, A, r); }
    else { p0_wg_dot<1>(F, nullptr, modp, 0, A.in[5], INW, nullptr, (float*)(A.ws + WS_BIAS1P), F.vcu, 8 * (INW / 64));
           p0_wg_dot<1>(F, nullptr, modp, 3072, A.in[13], PQW, nullptr, (float*)(A.ws + WS_BIAS2P), F.vcu, 8 * (PQW / 64)); }
    LAS float* scr = (LAS float*)(F.lds + RING_OFF + F.wave * 16384);
    constexpr int I_MODF = 768, I_WIN = (D / 64) * (INW / 32), I_WA = (AW / 64) * (D / 32), I_WOUT = (D / 64) * (D / 32), I_WQ = (D / 64) * (PQW / 32);
    constexpr int I_SUBK = 64;
    constexpr int NITEMS = I_MODF + I_WIN + I_WA + I_WOUT + I_WQ + I_SUBK;
    for (int it = gw; it < NITEMS; it += NGW) {
        int r = it;
        if (r < I_MODF) { if (STAGE != 1) continue; const int idx = r * 64 + lane; ((float*)(A.ws + WS_MODF))[idx] = modp_sum(modp, idx); continue; } r -= I_MODF;
        if (r < I_WIN) { if (STAGE != 0) continue; p0_transpose_item(A.in[5], D, INW, (bf16*)(A.ws + WS_WIN), 0, scr, r, lane); continue; } r -= I_WIN;
        if (r < I_WA) { if (STAGE != 0) continue; p0_transpose_item(A.in[6], AW, D, (bf16*)(A.ws + WS_WA), 0, scr, r, lane); continue; } r -= I_WA;
        if (r < I_WOUT) { if (STAGE != 0) continue; p0_transpose_item(A.in[11], D, D, (bf16*)(A.ws + WS_WOUT), 0, scr, r, lane); continue; } r -= I_WOUT;
        if (r < I_WQ) { if (STAGE != 0) continue; p0_transpose_item(A.in[13], D, PQW, (bf16*)(A.ws + WS_WQ), 0, scr, r, lane); continue; } r -= I_WQ;
        if (r < I_SUBK) { if (STAGE != 0) continue; const float* s = A.in[14] + (size_t)r * 512 + 8 * lane; const f32x4 a = *(const f32x4*)s, b = *(const f32x4*)(s + 4);
            v4u o; o.x = pk2(a[0], a[1]); o.y = pk2(a[2], a[3]); o.z = pk2(b[0], b[1]); o.w = pk2(b[2], b[3]);
            *(GAS v4u*)((bf16*)(A.ws + WS_SUBK) + (size_t)r * 512 + 8 * lane) = o; continue; } r -= I_SUBK;
    }
    auto xg_rows = [&](const int rb) {
        const float* x = A.in[0]; bf16* XG = (bf16*)(A.ws + WS_XG); float* rstd1 = (float*)(A.ws + WS_RSTD1);
            for (int r0 = F.wave; r0 < 128; r0 += 4 * NWAVES) {
                f32x4 v[4][2][2]; float s[4];
#pragma unroll
                for (int u = 0; u < 4; ++u) { const float* xr = x + (size_t)(rb * 128 + r0 + u * NWAVES) * 1024;
#pragma unroll
                    for (int h = 0; h < 2; ++h)
#pragma unroll
                        for (int q = 0; q < 2; ++q) v[u][h][q] = __builtin_nontemporal_load((const f32x4*)(xr + h * 512 + 8 * lane + 4 * q)); }
#pragma unroll
                for (int u = 0; u < 4; ++u) { float t = 0.f;
#pragma unroll
                    for (int h = 0; h < 2; ++h)
#pragma unroll
                        for (int q = 0; q < 2; ++q) t += (v[u][h][q][0] * v[u][h][q][0] + v[u][h][q][1] * v[u][h][q][1]) + (v[u][h][q][2] * v[u][h][q][2] + v[u][h][q][3] * v[u][h][q][3]);
                    s[u] = t; }
#pragma unroll
                for (int o = 1; o < 64; o <<= 1) {
#pragma unroll
                    for (int u = 0; u < 4; ++u) s[u] += __shfl_xor(s[u], o); }
#pragma unroll
                for (int u = 0; u < 4; ++u) { const int row = rb * 128 + r0 + u * NWAVES;
                    if (lane == 0) rstd1[row] = 1.0f / sqrtf(s[u] * (1.0f / D) + RMS_EPS);
#pragma unroll
                    for (int h = 0; h < 2; ++h) { const LAS float* g = G1 + h * 512 + 8 * lane;
                        v4u o; o.x = pk2(v[u][h][0][0] * g[0], v[u][h][0][1] * g[1]); o.y = pk2(v[u][h][0][2] * g[2], v[u][h][0][3] * g[3]); o.z = pk2(v[u][h][1][0] * g[4], v[u][h][1][1] * g[5]); o.w = pk2(v[u][h][1][2] * g[6], v[u][h][1][3] * g[7]);
                        *(GAS v4u*)(XG + (size_t)row * 1024 + h * 512 + 8 * lane) = o; } }
            }
    };
#ifndef TABLES_IN_ROUTER
    if (STAGE == 0) { for (int r0 = gw; r0 < 2 * PEXP; r0 += 4 * NGW) p0_table_trip(A, r0, NGW, lane); }
    else
#else
    if (STAGE == 1)
#endif
    for (int rb = F.vcu; rb < T / 128; rb += F.G) {
        const float* g1 = A.in[4]; const int b = (rb * 128) / SEQ;
        __syncthreads();
        for (int k = F.tid; k < 1024; k += NTHREADS) G1[k] = g1[k] * (1.0f + modp_sum(modp, b * 6144 + 1024 + k));
        __syncthreads();
        xg_rows(rb);
    }

}
namespace attn_body {
using bf16=__hip_bfloat16;
using bf16x8=__attribute__((ext_vector_type(8)))short;
using s16x4=__attribute__((ext_vector_type(4)))short;
using f32x16=__attribute__((ext_vector_type(16)))float;
using u32x4=__attribute__((ext_vector_type(4)))unsigned;
constexpr int BATCH=8,NHEAD=8,SEQ=4096,D=64,DM=NHEAD*D;
constexpr int NW=8,QBLK=32,QB=QBLK*NW,KVBLK=64,NQB=SEQ/QB;
constexpr int ATTN_PITCH=DM, ATTN_UNIT_ROWS=QB;
__device__ __forceinline__ int crow(int r,int hi){return (r&3)+8*(r>>2)+4*hi;}
#define SBAR() __builtin_amdgcn_sched_barrier(0)
__device__ __forceinline__ void cmask(f32x16&p0,f32x16&p1,int jb,int qrel,int hi){
  const float NEG=-INFINITY; int kb=64*jb+4*hi;
  #pragma unroll
  for(int r=0;r<16;++r){int kv=kb+(r&3)+8*(r>>2); if(kv>qrel)p0[r]=NEG; if(kv+32>qrel)p1[r]=NEG;}
}

constexpr int NSLOT=3, SLOTB=8192;
constexpr int LDS_K=0, LDS_V=NSLOT*SLOTB, LDS_WS=2*NSLOT*SLOTB, LDS_OST=LDS_WS+NW*64*4, LDS_KSL=LDS_OST+NW*4096, LDS_BYTES=LDS_KSL+4096;
constexpr float C2=0.125f*1.4426950408889634f;
__device__ __forceinline__ void glds16(const void*sbase,unsigned voff,unsigned lds_dst){unsigned keep;
  asm volatile("s_mov_b32 %0, m0\n\ts_mov_b32 m0, %3\n\ts_nop 4\n\tglobal_load_lds_dwordx4 %1, %2\n\ts_mov_b32 m0, %0":"=&s"(keep):"v"(voff),"s"(sbase),"s"(lds_dst):"memory");}
__device__ __forceinline__ float max3f(float a,float b,float c){float r;asm("v_max3_f32 %0, %1, %2, %3":"=v"(r):"v"(a),"v"(b),"v"(c));return r;}
__device__ __forceinline__ float max2f(float a,float b){float r;asm("v_max_f32_e32 %0, %1, %2":"=v"(r):"v"(a),"v"(b));return r;}
__device__ __forceinline__ float fadd_s(float a,float b){float r;asm("v_add_f32_e32 %0, %1, %2":"=v"(r):"v"(a),"v"(b));return r;}
__device__ __forceinline__ float fsub_s(float a,float b){float r;asm("v_sub_f32_e32 %0, %1, %2":"=v"(r):"v"(a),"v"(b));return r;}
typedef float f32x2_t __attribute__((ext_vector_type(2))); typedef __bf16 bf16x2_t __attribute__((ext_vector_type(2)));
__device__ __forceinline__ unsigned cvtpk_s(float lo,float hi){f32x2_t v={lo,hi};bf16x2_t b=__builtin_convertvector(v,bf16x2_t);return __builtin_bit_cast(unsigned,b);}
#define WAIT_BAR(N) asm volatile("s_waitcnt vmcnt(" #N ") lgkmcnt(0)\n\ts_barrier":::"memory")

__device__ __forceinline__ void qkt(f32x16&p0,f32x16&p1,const char*Kslot,const bf16x8*qr,const f32x16&negm,int r32,int hi){
  const char*kb=Kslot+hi*1024+r32*16;
  #pragma unroll
  for(int d0=0;d0<4;++d0){
    const bf16x8 b0=*reinterpret_cast<const bf16x8*>(kb+d0*2048);
    const bf16x8 b1=*reinterpret_cast<const bf16x8*>(kb+d0*2048+512);
    if(d0==0){p0=__builtin_amdgcn_mfma_f32_32x32x16_bf16(b0,qr[0],negm,0,0,0);p1=__builtin_amdgcn_mfma_f32_32x32x16_bf16(b1,qr[0],negm,0,0,0);}
    else{p0=__builtin_amdgcn_mfma_f32_32x32x16_bf16(b0,qr[d0],p0,0,0,0);p1=__builtin_amdgcn_mfma_f32_32x32x16_bf16(b1,qr[d0],p1,0,0,0);}}
}
typedef __attribute__((address_space(3))) const char* lds_cptr;
typedef short v4i16_t __attribute__((ext_vector_type(4)));
__device__ __forceinline__ void kload8(bf16x8*kf,lds_cptr kp){
  kf[0]=*(const __attribute__((address_space(3))) bf16x8*)(kp);      kf[1]=*(const __attribute__((address_space(3))) bf16x8*)(kp+512);
  kf[2]=*(const __attribute__((address_space(3))) bf16x8*)(kp+2048); kf[3]=*(const __attribute__((address_space(3))) bf16x8*)(kp+2560);
  kf[4]=*(const __attribute__((address_space(3))) bf16x8*)(kp+4096); kf[5]=*(const __attribute__((address_space(3))) bf16x8*)(kp+4608);
  kf[6]=*(const __attribute__((address_space(3))) bf16x8*)(kp+6144); kf[7]=*(const __attribute__((address_space(3))) bf16x8*)(kp+6656);
}
__device__ __forceinline__ void kload2(bf16x8*kf,lds_cptr kp,int j){ kf[2*j]=*(const __attribute__((address_space(3))) bf16x8*)(kp+j*2048); kf[2*j+1]=*(const __attribute__((address_space(3))) bf16x8*)(kp+j*2048+512); }
__device__ __forceinline__ s16x4 vtr(lds_cptr p){ return __builtin_bit_cast(s16x4,__builtin_amdgcn_ds_read_tr16_b64_v4i16((__attribute__((address_space(3))) v4i16_t*)p)); }
__device__ __forceinline__ float rowmax(const f32x16&p0,const f32x16&p1){
  float a=max3f(p0[0],p0[1],p1[0]),b=max3f(p0[2],p0[3],p1[1]);a=max3f(a,p1[2],p1[3]);
  #pragma unroll
  for(int r=4;r<16;r+=4){a=max3f(a,p0[r],p0[r+1]);b=max3f(b,p0[r+2],p0[r+3]);a=max3f(a,p1[r],p1[r+1]);b=max3f(b,p1[r+2],p1[r+3]);}
  const float m=max2f(a,b);
  auto rr=__builtin_amdgcn_permlane32_swap(__float_as_uint(m),__float_as_uint(m),false,false);
  return max2f(__uint_as_float(rr[0]),__uint_as_float(rr[1]));
}
__device__ __forceinline__ void pv(f32x16*o,int vb,bf16x8 pa0,bf16x8 pa1,bf16x8 pa2,bf16x8 pa3){
  #pragma unroll
  for(int d0=0;d0<2;++d0){s16x4 lo[4],hi[4];
    #pragma unroll
    for(int ks=0;ks<4;++ks){
      asm volatile("ds_read_b64_tr_b16 %0,%1 offset:%c2":"=&v"(lo[ks]):"v"(vb),"i"(d0*4096+ks*1024):"memory");
      asm volatile("ds_read_b64_tr_b16 %0,%1 offset:%c2":"=&v"(hi[ks]):"v"(vb),"i"(d0*4096+ks*1024+512):"memory");}
    asm volatile("s_waitcnt lgkmcnt(0)":::"memory");SBAR();
    #define PK(k) (bf16x8){lo[k][0],lo[k][1],lo[k][2],lo[k][3],hi[k][0],hi[k][1],hi[k][2],hi[k][3]}
    o[d0]=__builtin_amdgcn_mfma_f32_32x32x16_bf16(pa0,PK(0),o[d0],0,0,0);
    o[d0]=__builtin_amdgcn_mfma_f32_32x32x16_bf16(pa1,PK(1),o[d0],0,0,0);
    o[d0]=__builtin_amdgcn_mfma_f32_32x32x16_bf16(pa2,PK(2),o[d0],0,0,0);
    o[d0]=__builtin_amdgcn_mfma_f32_32x32x16_bf16(pa3,PK(3),o[d0],0,0,0);
    #undef PK
  }
}

#ifndef ATTN_STORE16
#define ATTN_STORE16(p,v) (*(u32x4*)(p)=(v))
#endif
template<int THRL> __device__ __forceinline__ void attn_unit(int b,int h,int qb,const bf16*Q,const bf16*__restrict__ K,const bf16*__restrict__ V,bf16*O,const float*ksum,const float*nrm,char*shm){
  int tid_=threadIdx.x; asm volatile("":"+v"(tid_)); const int tid=tid_,lane=tid&63,r32=lane&31,hi=lane>>5; const int wid=__builtin_amdgcn_readfirstlane(tid>>6);
  const long rowbase=(long)b*SEQ; const int q0=qb*QB;
  const bf16*Qw=Q+(rowbase+q0+wid*QBLK)*DM+h*D;
  const bf16*Kh=K+rowbase*DM+h*D,*Vh=V+rowbase*DM+h*D;
  const unsigned lds0=(unsigned)(uintptr_t)shm;
  float*wsf=(float*)(shm+LDS_WS)+wid*64;
  const unsigned kvoff=(unsigned)(lane*DM+wid*8)*2u;
  const unsigned vvoff=(unsigned)((16*(wid&3)+(lane>>2))*DM+(wid>>2)*32+(lane&3)*8)*2u;
  const unsigned kdst=lds0+LDS_K+wid*1024, vdst=lds0+LDS_V+wid*1024;
  #define DMA_K(t,slot) glds16(Kh+(long)(NTF-1-(t))*KVBLK*DM,kvoff,(unsigned)__builtin_amdgcn_readfirstlane(kdst+(slot)))
  #define DMA_V(t,slot) glds16(Vh+(long)(NTF-1-(t))*KVBLK*DM,vvoff,(unsigned)__builtin_amdgcn_readfirstlane(vdst+(slot)))
  const int vb0=(int)(lds0+LDS_V)+((lane>>4)&1)*32+(lane&3)*8+(4*hi+((lane&15)>>2))*64;
  const char*Kbase=shm+LDS_K; bf16x8 kf[8];
  const lds_cptr shm3=(lds_cptr)shm; const lds_cptr kp0=shm3+LDS_K+hi*1024+r32*16; const lds_cptr vp0=shm3+LDS_V+((lane>>4)&1)*32+(lane&3)*8+(4*hi+((lane&15)>>2))*64;
  const int NTF=(q0+QB)/KVBLK;
  int NT=NTF;
  { const float*nq=nrm+(long)(b*2+0)*16+2*h,*nk=nrm+(long)(b*2+1)*16+2*h; const float B=__builtin_sqrtf((nq[0]+nq[1])*(nk[0]+nk[1]))*1.02f+0.5f;
    const float slope2_=__uint_as_float(0x3FB8AA3Bu-((unsigned)(h+1)<<23)); const float dh=(160.f+2.f*B)/slope2_;
    const float tminf=((float)(q0-63)-dh)*(1.f/64.f); int tmin=tminf>0.f?(int)tminf:0;
    tmin=__builtin_amdgcn_readfirstlane(tmin); int nt=NTF-tmin; nt+=nt&1; if(nt>NTF)nt=NTF; if(nt<4)nt=4; NT=nt; }
  { float*ksl=(float*)(shm+LDS_KSL); const float k0=ksum[(long)(b*16+(tid>>6))*512+h*64+(tid&63)],k1=ksum[(long)(b*16+8+(tid>>6))*512+h*64+(tid&63)]; ksl[tid]=k0; ksl[512+tid]=k1; }
  DMA_K(0,0);DMA_V(0,0);DMA_K(1,SLOTB);
  bf16x8 qr[4];
  #pragma unroll
  for(int d0=0;d0<4;++d0)qr[d0]=*reinterpret_cast<const bf16x8*>(&Qw[(long)r32*DM+d0*16+hi*8]);
  float mhat=0.f,l_reg=0.f;f32x16 o[2];o[0]=f32x16{};o[1]=f32x16{};const f32x16 zero16=f32x16{};
  const int qrel=wid*QBLK+r32;
  #define CMASK(P0,P1,t) do{int jb_=3-(t); if(jb_>=0)cmask(P0,P1,jb_,qrel,hi);}while(0)
  const unsigned sl2b=0x3FB8AA3Bu-((unsigned)(h+1)<<23);
  const float slope2=__uint_as_float(sl2b), s2x=__uint_as_float(sl2b+(1u<<23)), s8x=__uint_as_float(sl2b+(3u<<23)), s32=__uint_as_float(sl2b+(5u<<23));
  const float s3x=__uint_as_float((unsigned)__builtin_amdgcn_readfirstlane((int)__float_as_uint(slope2*3.0f)));
  #define NBSEL(r) (((r)>>2)==0?nbb0_:((r)>>2)==1?nbb1_:((r)>>2)==2?nbb2_:nbb3_)
  #define NEGV(r) ((((r)&3)==0)?NBSEL(r):(NBSEL(r)+(((r)&3)==1?slope2:((r)&3)==2?s2x:s3x)))
  #define NBB(nb) const float nbb0_=(nb), nbb1_=nbb0_+s8x, nbb2_=nbb1_+s8x, nbb3_=nbb2_+s8x
  #define NBSELC(r) (((r)>>2)==0?nbc0_:((r)>>2)==1?nbc1_:((r)>>2)==2?nbc2_:nbc3_)
  #define SAV(r) (((r)&3)==1?slope2:((r)&3)==2?s2x:s3x)
  #define BIAS(C0,C1,s) do{ NBB(NBV(s)); const float nbc0_=nbb0_+s32,nbc1_=nbb1_+s32,nbc2_=nbb2_+s32,nbc3_=nbb3_+s32; \
      _Pragma("unroll") for(int r=0;r<16;++r){ if((r&3)==0){C0[r]+=NBSEL(r);C1[r]+=NBSELC(r);} else {C0[r]=(C0[r]+NBSEL(r))+SAV(r);C1[r]=(C1[r]+NBSELC(r))+SAV(r);} } }while(0)
  unsigned sel=0u;
  #define NBV(s) ({ const int tl_=NTF-1-(s); const int tc_=tl_<0?0:tl_; const int bj_=tc_>>2; const float off_=(bj_>=qb||((sel>>bj_)&1u))?0.f:-1.0e30f; \
      __builtin_fmaf(slope2,(float)(64*tl_+4*hi-q0-qrel),off_-mhat); })
  #define CRC(r) ((float)(((r)&3)+8*((r)>>2)))
  bool resc=false;
  #define START(P0,P1) do{ const float rm=rowmax(P0,P1); resc=false; \
    { const float dl=(rm>-1.0e20f)?rm:0.f; mhat=fadd_s(mhat,dl); \
      _Pragma("unroll") for(int r=0;r<16;++r){P0[r]=fsub_s(P0[r],dl);P1[r]=fsub_s(P1[r],dl);} } \
    _Pragma("unroll") for(int r=0;r<16;++r)P0[r]=__builtin_amdgcn_exp2f(P0[r]); }while(0)
  #define RESC() do{ if(resc){ asm volatile("s_waitcnt lgkmcnt(0)":::"memory"); \
      _Pragma("unroll") for(int d_=0;d_<2;++d_) _Pragma("unroll") for(int r=0;r<16;++r)o[d_][r]*=wsf[crow(r,hi)]; } }while(0)
  f32x16 pA0,pA1,pB0,pB1;
  int sl_prev=0,sl_cur=0,sl_next=SLOTB;
  #define ROT() do{sl_prev=sl_cur;sl_cur=sl_next;sl_next=(sl_next==(NSLOT-1)*SLOTB)?0:sl_next+SLOTB;}while(0)
  DMA_K(2,2*SLOTB);
  WAIT_BAR(3);
  if(qb>0){
    float qf[32];
    _Pragma("unroll") for(int d0=0;d0<4;++d0) _Pragma("unroll") for(int e=0;e<8;++e) qf[d0*8+e]=__uint_as_float(((unsigned)(unsigned short)qr[d0][e])<<16);
    const float*ksl=(const float*)(shm+LDS_KSL)+8*hi;
    float b1=-3.0e38f,b2=-3.0e38f,b3=-3.0e38f; int i1=-1,i2=-1,i3=-1;
    for(int j=0;j<qb;++j){ float g=0.f;
      _Pragma("unroll") for(int d0=0;d0<4;++d0) _Pragma("unroll") for(int e=0;e<8;++e) g=__builtin_fmaf(qf[d0*8+e],ksl[j*64+16*d0+e],g);
      { auto rr=__builtin_amdgcn_permlane32_swap(__float_as_uint(g),__float_as_uint(g),false,false); g=__uint_as_float(rr[0])+__uint_as_float(rr[1]); }
      const bool c1=g>b1,c2=g>b2,c3=g>b3;
      b3=c2?b2:(c3?g:b3); i3=c2?i2:(c3?j:i3); b2=c1?b1:(c2?g:b2); i2=c1?i1:(c2?j:i2); b1=c1?g:b1; i1=c1?j:i1; }
    sel=(1u<<i1)|(i2>=0?(1u<<i2):0u)|(i3>=0?(1u<<i3):0u); }
  qkt(pA0,pA1,Kbase,qr,zero16,r32,hi);asm volatile("s_nop 15\n\ts_nop 7":"+v"(pA0),"+v"(pA1));
  BIAS(pA0,pA1,0);
  CMASK(pA0,pA1,0);
  START(pA0,pA1);
  _Pragma("unroll") for(int r=0;r<16;++r)pA1[r]=__builtin_amdgcn_exp2f(pA1[r]);
  WAIT_BAR(0);
  DMA_K(3,0);DMA_V(1,SLOTB);
  ROT();
  kload8(kf,kp0+sl_cur);
  WAIT_BAR(2);
  s16x4 vlo[8],vhi[8]; u32x4 pw0,pw1,pw2,pw3;
  #define PKW(P,B) cvtpk_s(P[B],P[B+1])
  #define PAF(k) __builtin_bit_cast(bf16x8,pw##k)
  #define VFR(i) (bf16x8){vlo[i][0],vlo[i][1],vlo[i][2],vlo[i][3],vhi[i][0],vhi[i][1],vhi[i][2],vhi[i][3]}
  #define PIN(x) asm volatile("":"+v"(x))
  #define MX3(a,b,c) __builtin_fmaxf(__builtin_fmaxf((a),(b)),(c))
  #define GAPA(MF,A0,A1,A2,A3,W0,W1,PW) do{ MF; sacc+=A0; sacc+=A1; sacc+=A2; sacc+=A3; PIN(sacc); W0; W1; PIN(PW); SBAR(); }while(0)
  #define EX(v) __builtin_amdgcn_exp2f(v)
  #define GAPB(MF,X,B) do{ MF; X[B]=EX(X[B]); X[B+1]=EX(X[B+1]); X[B+2]=EX(X[B+2]); X[B+3]=EX(X[B+3]); PIN(X); SBAR(); }while(0)
  #define VRD(i) do{ vlo[i]=vtr(vp_+(((i)>>2)*4096+((i)&3)*1024)); vhi[i]=vtr(vp_+(((i)>>2)*4096+((i)&3)*1024+512)); }while(0)
  #define KRD(G,j) do{ if(G){ kload2(kf,kp0+sl_next,j); SBAR(); } }while(0)
  #define STEP(C0,C1,P0,P1,t,GK,GV,GL) do{ SBAR(); \
    const lds_cptr vp_=vp0+sl_prev; \
    VRD(0); SBAR(); float sacc=(P0[0]+P0[1]); \
    GAPA(C0=__builtin_amdgcn_mfma_f32_32x32x16_bf16(kf[0],qr[0],zero16,0,0,0), P0[2],P0[3],P0[4],P0[5],     pw0[0]=PKW(P0,0), pw0[1]=PKW(P0,2), pw0); \
    VRD(4); SBAR(); GAPA(C1=__builtin_amdgcn_mfma_f32_32x32x16_bf16(kf[1],qr[0],zero16,0,0,0), P0[6],P0[7],P0[8],P0[9],     pw0[2]=PKW(P0,4), pw0[3]=PKW(P0,6), pw0); \
    VRD(1); SBAR(); GAPA(C0=__builtin_amdgcn_mfma_f32_32x32x16_bf16(kf[2],qr[1],C0,0,0,0),   P0[10],P0[11],P0[12],P0[13], pw1[0]=PKW(P0,8), pw1[1]=PKW(P0,10), pw1); \
    VRD(5); SBAR(); GAPA(C1=__builtin_amdgcn_mfma_f32_32x32x16_bf16(kf[3],qr[1],C1,0,0,0),   P0[14],P0[15],P1[0],P1[1],   pw1[2]=PKW(P0,12),pw1[3]=PKW(P0,14), pw1); \
    VRD(2); SBAR(); GAPA(C0=__builtin_amdgcn_mfma_f32_32x32x16_bf16(kf[4],qr[2],C0,0,0,0),   P1[2],P1[3],P1[4],P1[5],     pw2[0]=PKW(P1,0), pw2[1]=PKW(P1,2), pw2); \
    VRD(6); SBAR(); GAPA(C1=__builtin_amdgcn_mfma_f32_32x32x16_bf16(kf[5],qr[2],C1,0,0,0),   P1[6],P1[7],P1[8],P1[9],     pw2[2]=PKW(P1,4), pw2[3]=PKW(P1,6), pw2); \
    VRD(3); SBAR(); GAPA(C0=__builtin_amdgcn_mfma_f32_32x32x16_bf16(kf[6],qr[3],C0,0,0,0),   P1[10],P1[11],P1[12],P1[13], pw3[0]=PKW(P1,8), pw3[1]=PKW(P1,10), pw3); \
    VRD(7); SBAR(); GAPA(C1=__builtin_amdgcn_mfma_f32_32x32x16_bf16(kf[7],qr[3],C1,0,0,0),   P1[14],P1[15],0.f,0.f,       pw3[2]=PKW(P1,12),pw3[3]=PKW(P1,14), pw3); \
    l_reg+=sacc; \
    if(GK){DMA_K((t)+3,sl_cur);} if(GV){DMA_V((t)+1,sl_next);} \
    BIAS(C0,C1,t); \
    CMASK(C0,C1,t); \
    { float a=MX3(C0[0],C0[1],C1[0]),b=MX3(C0[2],C0[3],C1[1]); a=MX3(a,C1[2],C1[3]); \
      _Pragma("unroll") for(int r=4;r<16;r+=4){a=MX3(a,C0[r],C0[r+1]);b=MX3(b,C0[r+2],C0[r+3]);a=MX3(a,C1[r],C1[r+1]);b=MX3(b,C1[r+2],C1[r+3]);} \
      float rm=__builtin_fmaxf(a,b); { auto rr=__builtin_amdgcn_permlane32_swap(__float_as_uint(rm),__float_as_uint(rm),false,false); rm=__builtin_fmaxf(__uint_as_float(rr[0]),__uint_as_float(rr[1])); } \
      resc=false; \
      if(__builtin_expect(__any(rm>(float)THRL),0)){ const float dl=__builtin_fmaxf(rm,0.f); mhat+=dl; \
        _Pragma("unroll") for(int r=0;r<16;++r){C0[r]-=dl;C1[r]-=dl;} \
        const float f=__builtin_amdgcn_exp2f(-dl); l_reg*=f; if(hi==0)wsf[r32]=f; resc=true; } } \
    SBAR(); \
    GAPB(o[0]=__builtin_amdgcn_mfma_f32_32x32x16_bf16(PAF(0),VFR(0),o[0],0,0,0), C0,0); \
    GAPB(o[1]=__builtin_amdgcn_mfma_f32_32x32x16_bf16(PAF(0),VFR(4),o[1],0,0,0), C0,4); \
    KRD(GL,0); GAPB(o[0]=__builtin_amdgcn_mfma_f32_32x32x16_bf16(PAF(1),VFR(1),o[0],0,0,0), C0,8); \
    KRD(GL,1); GAPB(o[1]=__builtin_amdgcn_mfma_f32_32x32x16_bf16(PAF(1),VFR(5),o[1],0,0,0), C0,12); \
    KRD(GL,2); GAPB(o[0]=__builtin_amdgcn_mfma_f32_32x32x16_bf16(PAF(2),VFR(2),o[0],0,0,0), C1,0); \
    KRD(GL,3); GAPB(o[1]=__builtin_amdgcn_mfma_f32_32x32x16_bf16(PAF(2),VFR(6),o[1],0,0,0), C1,4); \
    GAPB(o[0]=__builtin_amdgcn_mfma_f32_32x32x16_bf16(PAF(3),VFR(3),o[0],0,0,0), C1,8); \
    GAPB(o[1]=__builtin_amdgcn_mfma_f32_32x32x16_bf16(PAF(3),VFR(7),o[1],0,0,0), C1,12); \
    }while(0)
  int t=1;
  #define ENDW(tt) do{ if((tt)+3<NT){WAIT_BAR(2);} else if((tt)+2<NT){WAIT_BAR(1);} else {WAIT_BAR(0);} }while(0)
  #define PEELED_PAIR() do{ \
    STEP(pB0,pB1,pA0,pA1,t,(t+3<NT),(t+1<NT),(t+1<NT));       ENDW(t);   RESC(); ROT(); \
    STEP(pA0,pA1,pB0,pB1,t+1,(t+4<NT),(t+2<NT),(t+2<NT));     ENDW(t+1); RESC(); ROT(); }while(0)
  for(;t<5&&t+1<NT;t+=2){ PEELED_PAIR(); }
  #undef CMASK
  #define CMASK(P0,P1,t) do{}while(0)
  for(;t+5<NT;t+=2){
    STEP(pB0,pB1,pA0,pA1,t,true,true,true);     WAIT_BAR(2); RESC(); ROT();
    STEP(pA0,pA1,pB0,pB1,t+1,true,true,true);   WAIT_BAR(2); RESC(); ROT();
  }
  #undef CMASK
  #define CMASK(P0,P1,t) do{int jb_=3-(t); if(jb_>=0)cmask(P0,P1,jb_,qrel,hi);}while(0)
  for(;t+1<NT;t+=2){ PEELED_PAIR(); }
  STEP(pB0,pB1,pA0,pA1,NT-1,false,false,false); RESC();
  { float sacc=pB0[0]+pB0[1]; _Pragma("unroll") for(int r=2;r<16;++r)sacc+=pB0[r]; _Pragma("unroll") for(int r=0;r<16;++r)sacc+=pB1[r]; l_reg+=sacc;
    pw0=(u32x4){PKW(pB0,0),PKW(pB0,2),PKW(pB0,4),PKW(pB0,6)};pw1=(u32x4){PKW(pB0,8),PKW(pB0,10),PKW(pB0,12),PKW(pB0,14)};pw2=(u32x4){PKW(pB1,0),PKW(pB1,2),PKW(pB1,4),PKW(pB1,6)};pw3=(u32x4){PKW(pB1,8),PKW(pB1,10),PKW(pB1,12),PKW(pB1,14)};
    SBAR(); pv(o,vb0+sl_cur,PAF(0),PAF(1),PAF(2),PAF(3)); }
  #undef PKW
  #undef PAF
  #undef VFR
  #undef PIN
  #undef MX3
  #undef GAPA
  #undef GAPB
  #undef EX
  #undef VRD
  #undef KRD
  #undef STEP
  #undef ENDW
  #undef PEELED_PAIR
  #undef NBV
  #undef CRC
  #undef NEGV
  #undef NBSEL
  #undef NBB
  #undef NBSELC
  #undef SAV
  #undef BIAS
  {auto rr=__builtin_amdgcn_permlane32_swap(__float_as_uint(l_reg),__float_as_uint(l_reg),false,false);l_reg=__uint_as_float(rr[0])+__uint_as_float(rr[1]);}
  if(hi==0)wsf[32+r32]=l_reg;asm volatile("s_waitcnt lgkmcnt(0)":::"memory");
  float rli[16];
  #pragma unroll
  for(int r=0;r<16;++r)rli[r]=__builtin_amdgcn_rcpf(wsf[32+crow(r,hi)]);
  bf16*Ow=O+(rowbase+q0+wid*QBLK)*DM+h*D;
  { bf16*stg=(bf16*)(shm+LDS_OST)+wid*2048;
    #pragma unroll
    for(int r=0;r<16;++r){const int orow=crow(r,hi);
      #pragma unroll
      for(int d0=0;d0<2;++d0)stg[orow*64+d0*32+r32]=__float2bfloat16(o[d0][r]*rli[r]);}
    asm volatile("s_waitcnt lgkmcnt(0)":::"memory");
    #pragma unroll
    for(int i=0;i<4;++i){const int row=i*8+(lane>>3),ch=lane&7; const u32x4 v=*(const u32x4*)(stg+row*64+ch*8); ATTN_STORE16(Ow+(long)row*DM+ch*8,v);} }
  asm volatile("s_waitcnt lgkmcnt(0)\n\ts_barrier":::"memory");
  #undef DMA_K
  #undef DMA_V
  #undef CMASK
  #undef START
  #undef RESC
  #undef ROT
}
constexpr int ATTN_LDS_BYTES=LDS_BYTES;
struct AttnTensors { const bf16* Q; const bf16* K; const bf16* V; bf16* O; };
struct AttnUnit { int bh; int qb; };
struct AttnPlan { unsigned char unit[32][12]; unsigned char n[32]; };
constexpr int attn_nominal_cost(int h,int qb){ const int pmax[8]={7,12,22,41,64,64,64,64}; const int past=4*qb<pmax[h]?4*qb:pmax[h]; return 4+past+2; }
constexpr AttnPlan make_attn_plan(){
  AttnPlan p{}; int load[32]={}; bool used[128]={};
  for(int it=0;it<128;++it){ int best=-1,bc=-1; for(int e=0;e<128;++e){ if(used[e])continue; const int c=attn_nominal_cost(e>>4,e&15); if(c>bc){bc=c;best=e;} }
    used[best]=true; int cu=0; for(int c=1;c<32;++c) if(load[c]<load[cu]||(load[c]==load[cu]&&p.n[c]<p.n[cu]))cu=c;
    if(p.n[cu]>=12){ for(int c=0;c<32;++c) if(p.n[c]<12){cu=c;break;} }
    p.unit[cu][p.n[cu]++]=(unsigned char)best; load[cu]+=bc; }
  return p; }
__device__ const AttnPlan g_attn_plan=make_attn_plan();
struct StaticOrder {
  int vcu,G;
  __device__ __forceinline__ explicit StaticOrder(int grid,int vcu_):vcu(vcu_),G(grid){}
  __device__ __forceinline__ bool next(int i,AttnUnit&u)const{
    if(G!=256){ const int id=vcu+i*G; if(id>=BATCH*NHEAD*NQB)return false; u.bh=id>>4; u.qb=id&15; return true; }
    const int c=vcu&31; if(i>=(int)g_attn_plan.n[c])return false; const int e=g_attn_plan.unit[c][i]; u.bh=(vcu>>5)*NHEAD+(e>>4); u.qb=e&15; return true; }
};
template<class Sched,int THRL=8> __device__ __forceinline__ void attn_phase(char*lds,const AttnTensors&T,const float*ksum,const float*nrm,const Sched&S){
  AttnUnit u;
  for(int i=0;S.next(i,u);++i){ attn_unit<THRL>(u.bh/NHEAD,u.bh%NHEAD,u.qb,T.Q,T.K,T.V,T.O,ksum,nrm,lds); }
}
#undef SBAR
#undef WAIT_BAR
}

__device__ __forceinline__ void pooled_phase(Frame& F, const Args& A) {
    const bf16* P = (const bf16*)(A.ws + WS_QKVP) + (size_t)3 * T * 512; bf16* PO = (bf16*)(A.ws + WS_POOLED);
    const int gw = F.vcu * NWAVES + F.wave, NGW = F.G * NWAVES, lane = F.lane, w = 2 << (lane >> 4);
    for (int tk = gw; tk < T / 16; tk += NGW) {
        const int row0 = tk * 16, s0 = row0 & (SEQ - 1);
        v4u rv[31];
#pragma unroll
        for (int i = 0; i < 31; ++i) { const int sidx = s0 - 15 + i; rv[i] = (sidx >= 0) ? *(const v4u*)(P + (size_t)(row0 - 15 + i) * 512 + 8 * lane) : (v4u){0u, 0u, 0u, 0u}; }
#pragma unroll
        for (int i = 0; i < 16; ++i) {
            const int sidx = s0 + i; float acc[8];
#pragma unroll
            for (int e = 0; e < 8; ++e) acc[e] = 0.f;
#pragma unroll
            for (int k = 0; k < 16; ++k) { const bool ok = (k < w) && (sidx - k >= 0); const v4u x = rv[15 + i - k]; const float msk = ok ? 1.0f : 0.0f;
                acc[0] += msk * bflo(x.x); acc[1] += msk * bfhi(x.x); acc[2] += msk * bflo(x.y); acc[3] += msk * bfhi(x.y); acc[4] += msk * bflo(x.z); acc[5] += msk * bfhi(x.z); acc[6] += msk * bflo(x.w); acc[7] += msk * bfhi(x.w); }
            const float inv = 1.0f / (float)min(sidx + 1, w); const v4u x = rv[15 + i];
            v4u o; o.x = pk2(acc[0] * inv - bflo(x.x), acc[1] * inv - bfhi(x.x)); o.y = pk2(acc[2] * inv - bflo(x.y), acc[3] * inv - bfhi(x.y));
            o.z = pk2(acc[4] * inv - bflo(x.z), acc[5] * inv - bfhi(x.z)); o.w = pk2(acc[6] * inv - bflo(x.w), acc[7] * inv - bfhi(x.w));
            *(v4u*)(PO + (size_t)(row0 + i) * 512 + 8 * lane) = o;
        }
    }
}

namespace rt {
typedef float f32x16 __attribute__((ext_vector_type(16)));
typedef short bf16x8 __attribute__((ext_vector_type(8)));
__device__ __forceinline__ void ce(float& hi, float& lo) { const float a = fmaxf(hi, lo), b = fminf(hi, lo); hi = a; lo = b; }
template <int N> __device__ __forceinline__ void sort_desc(float (&v)[N]) {
#pragma unroll
    for (int k = 2; k <= N; k <<= 1)
#pragma unroll
        for (int j = k >> 1; j > 0; j >>= 1)
#pragma unroll
            for (int i = 0; i < N; ++i) { const int l = i ^ j; if (l > i) { if ((i & k) == 0) ce(v[i], v[l]); else ce(v[l], v[i]); } }
}
template <int N> __device__ __forceinline__ void bitonic_merge_desc(float (&v)[N]) {
#pragma unroll
    for (int j = N >> 1; j > 0; j >>= 1)
#pragma unroll
        for (int i = 0; i < N; ++i) { const int l = i ^ j; if (l > i) ce(v[i], v[l]); }
}
__device__ __forceinline__ void merge_top16(float (&a)[16], const float (&b)[16]) {
#pragma unroll
    for (int i = 0; i < 16; ++i) a[i] = fmaxf(a[i], b[15 - i]);
    bitonic_merge_desc<16>(a);
}
template <bool SORT> __device__ __forceinline__ void pair_merge(float (&a)[16], bool hi) {
    float w[16];
#pragma unroll
    for (int i = 0; i < 16; ++i) w[i] = hi ? a[15 - i] : a[i];
#pragma unroll
    for (int i = 0; i < 16; ++i) { const auto rr = __builtin_amdgcn_permlane32_swap(__float_as_uint(w[i]), __float_as_uint(w[i]), false, false); a[i] = fmaxf(__uint_as_float(rr[0]), __uint_as_float(rr[1])); }
    if (SORT) bitonic_merge_desc<16>(a);
}
__device__ __forceinline__ void fold_tile(const f32x16& acc, int kt, int hi, float (&out)[16]) {
    float g[16];
#pragma unroll
    for (int r = 0; r < 16; ++r) { const unsigned key = (unsigned)(32 * kt + (r & 3) + 8 * (r >> 2)); g[r] = __uint_as_float((__float_as_uint(acc[r]) & ~127u) | key | ((unsigned)hi << 2)); }
    sort_desc<16>(g);
    if (kt == 0) {
#pragma unroll
        for (int r = 0; r < 16; ++r) out[r] = g[r];
    } else merge_top16(out, g);
}
}
__device__ __forceinline__ void router_phase(Frame& F, const Args& A) {
    using namespace rt;
    const bf16* QP = (const bf16*)(A.ws + WS_GAB); const bf16* SK = (const bf16*)(A.ws + WS_SUBK);
    unsigned short* IDX = (unsigned short*)(A.ws + WS_POOLED); float* GATE = (float*)(A.ws + WS_POOLED + 16 * MiB);
    const int lane = F.lane, n32 = lane & 31, hi = lane >> 5, gw = F.vcu * NWAVES + F.wave, NGW = F.G * NWAVES;
    __syncthreads();
    for (int i = F.tid; i < 2 * 128 * 16; i += NTHREADS) { const int r = i >> 4, ch = i & 15; *(LAS v4u*)(F.lds + r * 272 + ch * 16) = *(const v4u*)(SK + (size_t)r * 128 + ch * 8); }
    __syncthreads();
    LAS unsigned char* scr = F.lds + 73728 + F.wave * 1024;
    const LAS unsigned char* afrag = F.lds + n32 * 272 + hi * 16;
    bf16x8 qa[8], qb[8];
#define RT_QLOAD(task_, p_, q_) do { const int tq_ = (task_) * 4 + (n32 >> 3); const bf16* qr_ = QP + (size_t)tq_ * PQW + (n32 & 7) * 256 + (p_) * 128 + 8 * hi; \
        _Pragma("unroll") for (int i = 0; i < 8; ++i) q_[i] = __builtin_nontemporal_load((const bf16x8*)(qr_ + 16 * i)); } while (0)
#define RT_HALF(p_, q_, out_) do { _Pragma("unroll") for (int kt = 0; kt < 4; ++kt) { f32x16 acc = f32x16{}; \
        _Pragma("unroll") for (int ks = 0; ks < 8; ++ks) { const bf16x8 kf = *(const LAS bf16x8*)(afrag + ((p_) * 128 + 32 * kt) * 272 + 32 * ks); acc = __builtin_amdgcn_mfma_f32_32x32x16_bf16(kf, q_[ks], acc, 0, 0, 0); } \
        fold_tile(acc, kt, hi, out_); } pair_merge<true>(out_, hi != 0); } while (0)
    if (gw < T * PHEADS / 32) RT_QLOAD(gw, 0, qa);
#ifdef TABLES_IN_ROUTER
    int tr0 = gw; const bool late_trip = F.wave >= 4;
#define RT_TABLE_TRIP(cond_) do { if ((cond_) && tr0 < 2 * PEXP) { asm volatile("" ::: "memory"); p0_table_trip(A, tr0, NGW, lane); tr0 += 4 * NGW; asm volatile("" ::: "memory"); } } while (0)
#else
#define RT_TABLE_TRIP(cond_) do { } while (0)
#endif
    for (int task = gw; task < T * PHEADS / 32; task += NGW) {
        const int t = task * 4 + (n32 >> 3), h = n32 & 7;
        float la[16], lb[16];
        RT_TABLE_TRIP(!late_trip);
        RT_QLOAD(task, 1, qb);
        RT_HALF(0, qa, la);
        { const int nxt = task + NGW; if (nxt < T * PHEADS / 32) RT_QLOAD(nxt, 0, qa); }
        RT_HALF(1, qb, lb);
        { unsigned w[4];
#pragma unroll
          for (int q = 0; q < 4; ++q) {
              const unsigned i0 = __float_as_uint(hi ? lb[4 * q] : la[4 * q]) & 127u, i1 = __float_as_uint(hi ? lb[4 * q + 1] : la[4 * q + 1]) & 127u, i2 = __float_as_uint(hi ? lb[4 * q + 2] : la[4 * q + 2]) & 127u, i3 = __float_as_uint(hi ? lb[4 * q + 3] : la[4 * q + 3]) & 127u;
              w[q] = i0 | (i1 << 8) | (i2 << 16) | (i3 << 24); }
          *(LAS v4u*)(scr + n32 * 32 + hi * 16) = (v4u){w[0], w[1], w[2], w[3]}; }
        float x[16], y[16];
#pragma unroll
        for (int i = 0; i < 16; ++i) { const float av = __uint_as_float(__float_as_uint(la[i]) & ~127u), bv = __uint_as_float(__float_as_uint(lb[i]) & ~127u); x[i] = hi ? bv : av; y[i] = hi ? av : bv; }
        float c0[16], c1[16];
        {
            const unsigned hb = (unsigned)hi << 8;
#define RT_CAND(i, j) __uint_as_float(((__float_as_uint(x[i] + y[j]) & ~511u) | (unsigned)((i) * 16 + (j))) | hb)
#define RT_DIAG(i) (hi ? -3.0e38f : RT_CAND(i, i))
            c0[0] = RT_DIAG(0);
#pragma unroll
            for (int j = 1; j < 16; ++j) c0[j] = RT_CAND(0, j);
            c1[0] = RT_DIAG(1);
#pragma unroll
            for (int j = 2; j < 8; ++j) c1[j - 1] = RT_CAND(1, j);
            c1[7] = RT_DIAG(2); c1[8] = RT_CAND(2, 3); c1[9] = RT_CAND(2, 4); c1[10] = RT_DIAG(3);
#pragma unroll
            for (int k = 11; k < 16; ++k) c1[k] = -3.0e38f;
#undef RT_CAND
#undef RT_DIAG
        }
        sort_desc<16>(c0); sort_desc<16>(c1); merge_top16(c0, c1);
        pair_merge<false>(c0, hi != 0);
        float mx = c0[0];
#pragma unroll
        for (int i = 1; i < 16; ++i) mx = fmaxf(mx, c0[i]);
        float ex[16], sm = 0.f;
#pragma unroll
        for (int i = 0; i < 16; ++i) { ex[i] = __expf(__uint_as_float(__float_as_uint(c0[i]) & ~511u) - mx); sm += ex[i]; }
        const float inv = 1.0f / sm;
        asm volatile("s_waitcnt lgkmcnt(0)" ::: "memory");
        int eo[8]; float go[8];
#pragma unroll
        for (int k = 0; k < 8; ++k) { const float wv = hi ? c0[8 + k] : c0[k]; go[k] = (hi ? ex[8 + k] : ex[k]) * inv;
            const unsigned bits = __float_as_uint(wv), fromhi = (bits >> 8) & 1u, xi = (bits >> 4) & 15u, yj = bits & 15u;
            const unsigned ar = fromhi ? yj : xi, br = fromhi ? xi : yj;
            const unsigned e1 = scr[n32 * 32 + ar], e2 = scr[n32 * 32 + 16 + br];
            eo[k] = (int)(e1 * 128u + e2); }
        unsigned short* ip = IDX + (size_t)t * PSEL + h * PTOP + 8 * hi; float* gp = GATE + (size_t)t * PSEL + h * PTOP + 8 * hi;
        *(v4u*)ip = (v4u){(unsigned)eo[0] | ((unsigned)eo[1] << 16), (unsigned)eo[2] | ((unsigned)eo[3] << 16), (unsigned)eo[4] | ((unsigned)eo[5] << 16), (unsigned)eo[6] | ((unsigned)eo[7] << 16)};
        *(f32x4*)gp = (f32x4){go[0], go[1], go[2], go[3]}; *(f32x4*)(gp + 4) = (f32x4){go[4], go[5], go[6], go[7]};
        asm volatile("s_waitcnt lgkmcnt(0)" ::: "memory");
        RT_TABLE_TRIP(late_trip);
    }
#ifdef TABLES_IN_ROUTER
    while (tr0 < 2 * PEXP) { p0_table_trip(A, tr0, NGW, lane); tr0 += 4 * NGW; }
#endif
#undef RT_TABLE_TRIP
#undef RT_QLOAD
#undef RT_HALF
    __syncthreads();
}

typedef float f32x2 __attribute__((ext_vector_type(2)));
typedef int v4i __attribute__((ext_vector_type(4)));
__device__ __forceinline__ void h2q_token(const Args& A, int t, int lane) {
    const float* modf = (const float*)(A.ws + WS_MODF); const float* ss2 = (const float*)(A.ws + WS_SS2); const float* g2 = A.in[12];
    const int b = t / SEQ; const float* xr = A.out + (size_t)t * D + 16 * lane;
    const f32x4* sp = (const f32x4*)(ss2 + (size_t)t * 16); const f32x4 s4 = (sp[0] + sp[1]) + (sp[2] + sp[3]);
    const float rs = 1.0f / sqrtf(((s4[0] + s4[1]) + (s4[2] + s4[3])) * (1.0f / D) + RMS_EPS);
    float h2[16]; float am = 0.f;
#pragma unroll
    for (int q = 0; q < 4; ++q) { const int c = 16 * lane + 4 * q; const f32x4 xv = *(const f32x4*)(xr + 4 * q), gg = *(const f32x4*)(g2 + c), sc = *(const f32x4*)(modf + (size_t)b * 6144 + 4096 + c), sh = *(const f32x4*)(modf + (size_t)b * 6144 + 3072 + c);
#pragma unroll
        for (int e = 0; e < 4; ++e) { const float h = xv[e] * rs * (gg[e] * (1.0f + sc[e])) + sh[e]; h2[4 * q + e] = h; am = fmaxf(am, fabsf(h)); } }
    am = fmaxf(am, __shfl_xor(am, 1)); am = fmaxf(am, __shfl_xor(am, 2)); am = fmaxf(am, __shfl_xor(am, 4));
    const float hs = (am > 0.f) ? am * (1.0f / 127.0f) : 1.0f, hinv = 1.0f / hs;
    v4u o;
#pragma unroll
    for (int q = 0; q < 4; ++q) { const int q0 = (int)rintf(h2[4 * q] * hinv), q1 = (int)rintf(h2[4 * q + 1] * hinv), q2 = (int)rintf(h2[4 * q + 2] * hinv), q3 = (int)rintf(h2[4 * q + 3] * hinv);
        o[q] = (unsigned)(q0 & 255) | ((unsigned)(q1 & 255) << 8) | ((unsigned)(q2 & 255) << 16) | ((unsigned)q3 << 24); }
    *(v4u*)(A.ws + WS_H2Q + (size_t)t * D + 16 * lane) = o;
    if ((lane & 7) == 0) ((float*)(A.ws + WS_HS))[(size_t)t * 8 + (lane >> 3)] = hs;
}

__device__ __forceinline__ float gelu_tanh(float x) { const float u = 0.7978845608028654f * (x + 0.044715f * x * x * x); return x / (1.0f + __expf(-2.0f * u)); }
__device__ __forceinline__ void peer_sliced_phase(Frame& F, const Args& A) {
    const int lane = F.lane, c8 = lane & 7, g8 = lane >> 3, gw = F.vcu * NWAVES + F.wave, NGW = F.G * NWAVES;
    const float* modf = (const float*)(A.ws + WS_MODF);
    const unsigned char* U8 = A.ws + WS_U; const unsigned char* V8 = A.ws + WS_V;
    const float* SU = (const float*)(A.ws + WS_U + 16 * MiB); const float* SV = (const float*)(A.ws + WS_V + 16 * MiB);
    const unsigned short* IDX = (const unsigned short*)(A.ws + WS_POOLED); const float* GATE = (const float*)(A.ws + WS_POOLED + 16 * MiB);
    const float* gf = A.in[17];
    LAS float* AL = (LAS float*)(F.lds + F.wave * 17664);
    LAS float* SSQ = AL + 2048;
    LAS float* SAV = AL + 3072;
    LAS float* RS2 = AL + 3088;
    LAS float* GS = AL + 3104;
    LAS unsigned short* IDL = (LAS unsigned short*)(AL + 3360);
    for (int tb = gw * 16; tb < T; tb += NGW * 16) {
        for (int i = lane; i < 2048; i += 64) AL[i] = 0.f;
        for (int i = lane; i < 1024; i += 64) SSQ[i] = 0.f;
#pragma unroll
        for (int i = 0; i < 16; ++i) *(LAS unsigned*)(IDL + i * 128 + 2 * lane) = *(const unsigned*)(IDX + (size_t)(tb + i) * PSEL + 2 * lane);
        if (lane < 16) { const f32x4* sp = (const f32x4*)((const float*)(A.ws + WS_SS2) + (size_t)(tb + lane) * 16); const f32x4 s4 = (sp[0] + sp[1]) + (sp[2] + sp[3]);
            RS2[lane] = 1.0f / sqrtf(((s4[0] + s4[1]) + (s4[2] + s4[3])) * (1.0f / D) + RMS_EPS); }
        LDS_WAIT();
        {
            v4i W0[16], W1[16]; f32x4 X0[4], X1[4]; v4i H; float hs;
            const int bU = tb / SEQ; const float* g2 = A.in[12];
#define PU_X(k, X) do { const int k_ = (k) < 128 ? (k) : 127; const int s_ = k_ >> 4, t_ = tb + (k_ & 15); _Pragma("unroll") for (int q = 0; q < 4; ++q) X[q] = *(const f32x4*)(A.out + (size_t)t_ * D + 128 * s_ + 16 * c8 + 4 * q); } while (0)
#define PU_B(k, W) do { const int k_ = (k) < 128 ? (k) : 127; const int s_ = k_ >> 4; const unsigned base_ = ((unsigned)s_ << 21) + 16u * (unsigned)c8; v4u I[2]; I[0] = *(const LAS v4u*)(IDL + (k_ & 15) * 128 + 16 * g8); I[1] = *(const LAS v4u*)(IDL + (k_ & 15) * 128 + 16 * g8 + 8); \
            _Pragma("unroll") for (int j = 0; j < 16; ++j) W[j] = *(const v4i*)(U8 + (base_ + (((I[j >> 3][(j >> 1) & 3] >> (16 * (j & 1))) & 0xffffu) << 7))); \
            } while (0)
#define PU_Q(k, X) do { const int s_ = (k) >> 4, i_ = (k) & 15; \
            if (i_ == 0) { LDS_WAIT(); if (g8 == 0) { _Pragma("unroll") for (int q = 0; q < 4; ++q) { const int cc = 128 * s_ + 16 * c8 + 4 * q; const f32x4 gg = *(const f32x4*)(g2 + cc), sc = *(const f32x4*)(modf + (size_t)bU * 6144 + 4096 + cc), sh = *(const f32x4*)(modf + (size_t)bU * 6144 + 3072 + cc); \
                *(LAS f32x4*)(GS + c8 * 16 + 4 * q) = gg * (sc + 1.0f); *(LAS f32x4*)(GS + 128 + c8 * 16 + 4 * q) = sh; } } LDS_WAIT(); } \
            const float rs_ = RS2[i_]; float h2[16]; float am = 0.f; \
            _Pragma("unroll") for (int q = 0; q < 4; ++q) { const f32x4 gq = *(const LAS f32x4*)(GS + c8 * 16 + 4 * q), sq = *(const LAS f32x4*)(GS + 128 + c8 * 16 + 4 * q); \
                _Pragma("unroll") for (int e = 0; e < 4; ++e) { const float h = X[q][e] * rs_ * gq[e] + sq[e]; h2[4 * q + e] = h; am = fmaxf(am, fabsf(h)); } } \
            am = fmaxf(am, __shfl_xor(am, 1)); am = fmaxf(am, __shfl_xor(am, 2)); am = fmaxf(am, __shfl_xor(am, 4)); \
            hs = (am > 0.f) ? am * (1.0f / 127.0f) : 1.0f; const float hinv = 1.0f / hs; \
            _Pragma("unroll") for (int q = 0; q < 4; ++q) { const int q0 = (int)rintf(h2[4 * q] * hinv), q1 = (int)rintf(h2[4 * q + 1] * hinv), q2 = (int)rintf(h2[4 * q + 2] * hinv), q3 = (int)rintf(h2[4 * q + 3] * hinv); \
                H[q] = (int)((unsigned)(q0 & 255) | ((unsigned)(q1 & 255) << 8) | ((unsigned)(q2 & 255) << 16) | ((unsigned)q3 << 24)); } } while (0)
#define PU_C(k, W) do { int part[16]; \
            _Pragma("unroll") for (int j = 0; j < 16; ++j) part[j] = __builtin_amdgcn_sdot4(W[j].x, H.x, __builtin_amdgcn_sdot4(W[j].y, H.y, __builtin_amdgcn_sdot4(W[j].z, H.z, __builtin_amdgcn_sdot4(W[j].w, H.w, 0, false), false), false), false); \
            _Pragma("unroll") for (int step = 4; step >= 1; step >>= 1) { const bool up = (lane & step) != 0; \
                _Pragma("unroll") for (int i = 0; i < 2 * step; ++i) { const int send = up ? part[i] : part[i + 2 * step], keep = up ? part[i + 2 * step] : part[i]; part[i] = keep + __shfl_xor(send, step); } } \
            LAS f32x2* ap_ = (LAS f32x2*)(AL + ((k) & 15) * 128 + 2 * lane); f32x2 a_ = *ap_; a_.x += hs * (float)part[0]; a_.y += hs * (float)part[1]; *ap_ = a_; } while (0)
            PU_X(0, X0); PU_X(1, X1); PU_B(0, W0);
#pragma unroll 1
            for (int k = 0; k < 128; k += 2) {
                PU_Q(k, X0); PU_B(k + 1, W1); PU_X(k + 2, X0);
                PU_C(k, W0);
                PU_Q(k + 1, X1); PU_B(k + 2, W0); PU_X(k + 3, X1);
                PU_C(k + 1, W1);
            }
#undef PU_X
#undef PU_B
#undef PU_Q
#undef PU_C
        }
        LDS_WAIT();
#pragma unroll 4
        for (int i = 0; i < 16; ++i) {
            const int t = tb + i; const unsigned e01 = *(const LAS unsigned*)(IDL + i * 128 + 2 * lane); const int e0 = (int)(e01 & 0xffffu), e1 = (int)(e01 >> 16);
            const f32x2 gt = *(const f32x2*)(GATE + (size_t)t * PSEL + 2 * lane); const f32x2 a = *(LAS f32x2*)(AL + i * 128 + 2 * lane);
            f32x2 av; av.x = gelu_tanh(a.x * SU[e0]) * gt.x * SV[e0]; av.y = gelu_tanh(a.y * SU[e1]) * gt.y * SV[e1];
            *(LAS f32x2*)(AL + i * 128 + 2 * lane) = av;
            const float sm = wave_sum(av.x + av.y); if (lane == 0) SAV[i] = 128.0f * sm;
        }
        LDS_WAIT();
        {
            v4u W0[16], W1[16]; f32x2 X0, X1, gt2v = (f32x2){0.f, 0.f};
            const int b = tb / SEQ;
#define PV_B(k, W, X) do { const int k_ = (k) < 128 ? (k) : 127; const int s_ = k_ >> 4, t_ = tb + (k_ & 15); const unsigned base_ = ((unsigned)s_ << 21) + 16u * (unsigned)c8; v4u I[2]; I[0] = *(const LAS v4u*)(IDL + (k_ & 15) * 128 + 16 * g8); I[1] = *(const LAS v4u*)(IDL + (k_ & 15) * 128 + 16 * g8 + 8); \
            _Pragma("unroll") for (int j = 0; j < 16; ++j) W[j] = *(const v4u*)(V8 + (base_ + (((I[j >> 3][(j >> 1) & 3] >> (16 * (j & 1))) & 0xffffu) << 7))); \
            X = __builtin_nontemporal_load((const f32x2*)(A.out + (size_t)t_ * D + 128 * s_ + 16 * c8 + 2 * g8)); } while (0)
#define PV_C(k, W, X) do { const int s_ = (k) >> 4, i_ = (k) & 15; \
            if (i_ == 0) gt2v = *(const f32x2*)(modf + (size_t)b * 6144 + 5120 + 128 * s_ + 16 * c8 + 2 * g8); \
            f32x2 acc[8]; _Pragma("unroll") for (int q = 0; q < 8; ++q) acc[q] = (f32x2){0.f, 0.f}; \
            const LAS f32x4* avp_ = (const LAS f32x4*)(AL + i_ * 128 + 16 * g8); \
            _Pragma("unroll") for (int q4 = 0; q4 < 4; ++q4) { const f32x4 a4 = avp_[q4]; \
                _Pragma("unroll") for (int e = 0; e < 4; ++e) { const float a = a4[e]; const v4u w = W[4 * q4 + e]; \
                    acc[0] += (f32x2){(float)(w.x & 255u), (float)((w.x >> 8) & 255u)} * a; acc[1] += (f32x2){(float)((w.x >> 16) & 255u), (float)(w.x >> 24)} * a; \
                    acc[2] += (f32x2){(float)(w.y & 255u), (float)((w.y >> 8) & 255u)} * a; acc[3] += (f32x2){(float)((w.y >> 16) & 255u), (float)(w.y >> 24)} * a; \
                    acc[4] += (f32x2){(float)(w.z & 255u), (float)((w.z >> 8) & 255u)} * a; acc[5] += (f32x2){(float)((w.z >> 16) & 255u), (float)(w.z >> 24)} * a; \
                    acc[6] += (f32x2){(float)(w.w & 255u), (float)((w.w >> 8) & 255u)} * a; acc[7] += (f32x2){(float)((w.w >> 16) & 255u), (float)(w.w >> 24)} * a; } } \
            float pc[16]; _Pragma("unroll") for (int q = 0; q < 8; ++q) { pc[2 * q] = acc[q].x; pc[2 * q + 1] = acc[q].y; } \
            _Pragma("unroll") for (int step = 4; step >= 1; step >>= 1) { const bool up = (g8 & step) != 0; \
                _Pragma("unroll") for (int i = 0; i < 2 * step; ++i) { const float send = up ? pc[i] : pc[i + 2 * step], keep = up ? pc[i + 2 * step] : pc[i]; pc[i] = keep + __shfl_xor(send, 8 * step); } } \
            const float sav_ = SAV[i_]; f32x2 x2_; x2_.x = X.x + gt2v.x * (pc[0] - sav_); x2_.y = X.y + gt2v.y * (pc[1] - sav_); \
            *(f32x2*)(A.out + (size_t)(tb + i_) * D + 128 * s_ + 16 * c8 + 2 * g8) = x2_; \
            SSQ[i_ * 64 + lane] += x2_.x * x2_.x + x2_.y * x2_.y; } while (0)
            PV_B(0, W0, X0);
#pragma unroll 1
            for (int k = 0; k < 128; k += 2) {
                PV_B(k + 1, W1, X1);
                PV_C(k, W0, X0);
                PV_B(k + 2, W0, X0);
                PV_C(k + 1, W1, X1);
            }
#undef PV_B
#undef PV_C
        }
        VM_WAIT(); LDS_WAIT();
#pragma unroll 2
        for (int i = 0; i < 16; ++i) {
            float* xr = A.out + (size_t)(tb + i) * D + 16 * lane;
            f32x4 v[4];
#pragma unroll
            for (int q = 0; q < 4; ++q) v[q] = __builtin_nontemporal_load((const f32x4*)(xr + 4 * q));
            const float rs = 1.0f / sqrtf(wave_sum(SSQ[i * 64 + lane]) * (1.0f / D) + RMS_EPS);
#pragma unroll
            for (int q = 0; q < 4; ++q) *(f32x4*)(xr + 4 * q) = v[q] * rs * *(const f32x4*)(gf + 16 * lane + 4 * q);
        }
        LDS_WAIT();
    }
}

#ifndef PHASE_ONLY
#define PHASE_ONLY -1
#endif
#ifndef PHASE_SKIP
#define PHASE_SKIP -2
#endif
#define PH(n) ((PHASE_ONLY < 0 || PHASE_ONLY == (n)) && PHASE_SKIP != (n))
#ifndef PROBE_DOUBLE
#define PROBE_DOUBLE -1
#endif
#define REPS(n) for (int rep_ = 0; rep_ < ((PROBE_DOUBLE == (n)) ? 2 : 1); ++rep_)
__global__ void __launch_bounds__(NTHREADS, 2) fwd_megakernel(Args A) {
    extern __shared__ __attribute__((aligned(16))) unsigned char lds[];
    Frame F;
    F.lds = (LAS unsigned char*)lds;
    F.MISC = (volatile LAS unsigned*)(F.lds + MISC_OFF);
    F.tid = threadIdx.x; F.lane = F.tid & 63; F.wave = __builtin_amdgcn_readfirstlane(F.tid >> 6);
    F.G = gridDim.x; { const int bx = blockIdx.x; F.vcu = (F.G % 8 == 0) ? (bx % 8) * (F.G / 8) + bx / 8 : bx; }
    F.ctl = (gu32*)(A.ws + WS_CTL);
    for (int u = F.tid; u < (LDS_BYTES - LDSCTL_OFF) / 4; u += NTHREADS) ((LAS unsigned*)(F.lds + LDSCTL_OFF))[u] = 0u;
    __syncthreads();
    XcdBarrier bar = xcd_barrier_post((unsigned*)(F.ctl + CW_BAR), F.MISC + 8);
#define GRID_BAR() do { xcd_barrier(bar); int t_ = threadIdx.x; asm volatile("" : "+v"(t_)); F.tid = t_; F.lane = t_ & 63; F.wave = __builtin_amdgcn_readfirstlane(t_ >> 6); } while (0)
    unsigned char* ws = A.ws;

    REPS(0) if (PH(0)) { p0a_mod(F, A); p0b_prologue<0>(F, A); }
    GRID_BAR();
    REPS(1) if (PH(1)) p0b_prologue<1>(F, A);
    GRID_BAR();
    REPS(2) if (PH(2)) {
        pg8::Gemm g{(const bf16*)(ws + WS_XG), nullptr, (const bf16*)(ws + WS_WIN), nullptr, D, D, D};
        pg8::StaticOrder S; S.init(T, INW, F.G, (int)blockIdx.x);
        pg8::EpiIn E{(bf16*)(ws + WS_QKVP), (bf16*)(ws + WS_GAB), (const float*)(ws + WS_RSTD1), (const float*)(ws + WS_BIAS1P), (float*)(ws + WS_KSUM), (unsigned*)(ws + WS_CTL) + CW_NRM};
        pg8::gemm_phase<pg8::EpiIn, pg8::StaticOrder, true, true>(F.lds + RING_OFF, g, S, E);
    }
    GRID_BAR();
    REPS(3) if (PH(3)) {
        const attn_body::AttnTensors AT{(const attn_body::bf16*)(ws + WS_QKVP), (const attn_body::bf16*)(ws + WS_QKVP) + (size_t)T * 512, (const attn_body::bf16*)(ws + WS_QKVP) + (size_t)2 * T * 512, (PROBE_DOUBLE == 3 && rep_ == 0) ? (attn_body::bf16*)(ws + WS_XG) : (attn_body::bf16*)(ws + WS_QKVP)};
        const attn_body::StaticOrder S((int)F.G, F.vcu);
        attn_body::attn_phase<attn_body::StaticOrder>((char*)lds + RING_OFF, AT, (const float*)(ws + WS_KSUM), (const float*)((const unsigned*)(ws + WS_CTL) + CW_NRM), S);
    }
    REPS(4) if (PH(4)) pooled_phase(F, A);
    GRID_BAR();
    REPS(5) if (PH(5)) {
        pg8::Gemm g{(const bf16*)(ws + WS_QKVP), (const bf16*)(ws + WS_POOLED), (const bf16*)(ws + WS_WA), (const bf16*)(ws + WS_WP), AW, AW, AW};
        pg8::DualOrder S; S.init(T, D, F.G, (int)blockIdx.x);
        pg8::EpiUp E{(bf16*)(ws + WS_XG), (const bf16*)(ws + WS_GAB), (const float*)(ws + WS_BPRIME)};
        pg8::gemm_phase<pg8::EpiUp, pg8::DualOrder, true, true>(F.lds + RING_OFF, g, S, E);
    }
    GRID_BAR();
    REPS(6) if (PH(6)) {
        pg8::Gemm g{(const bf16*)(ws + WS_XG), nullptr, (const bf16*)(ws + WS_WOUT), nullptr, D, D, D};
        pg8::StaticOrder S; S.init(T, D, F.G, (int)blockIdx.x);
        pg8::EpiOut E{A.in[0], A.out, (bf16*)(ws + WS_QKVP), (const float*)(ws + WS_MODF), A.in[12], (float*)(ws + WS_SS2)};
        pg8::gemm_phase<pg8::EpiOut, pg8::StaticOrder, true, true>(F.lds + RING_OFF, g, S, E);
    }
    GRID_BAR();
    REPS(7) if (PH(7)) {
        pg8::Gemm g{(const bf16*)(ws + WS_QKVP), nullptr, (const bf16*)(ws + WS_WQ), nullptr, D, D, D};
        pg8::StaticOrder S; S.init(T, PQW, F.G, (int)blockIdx.x);
        pg8::EpiPq E{(bf16*)(ws + WS_GAB), (const float*)(ws + WS_SS2), (const float*)(ws + WS_BIAS2P)};
        pg8::gemm_phase<pg8::EpiPq, pg8::StaticOrder, true, true>(F.lds + RING_OFF, g, S, E);
    }
    GRID_BAR();
    REPS(8) if (PH(8)) router_phase(F, A);
    GRID_BAR();
    if (PH(9)) peer_sliced_phase(F, A);
}

extern "C" void kernel_launch(void* const* d_in, const int* in_sizes, int n_in, void* d_out, int out_size, void* d_ws, size_t ws_size, hipStream_t stream) {
    static int grid = 0;
    if (grid == 0) {
        if (n_in != 18 || in_sizes[0] != T * D || out_size != T * D || ws_size < WS_END) { fprintf(stderr, "kernel_launch: unexpected shapes (n_in %d, in0 %d, out %d, ws %zu); nothing launched\n", n_in, n_in > 0 ? in_sizes[0] : -1, out_size, ws_size); grid = -1; return; }
        int dev = 0, cus = 0, per_cu = 0;
        if (hipGetDevice(&dev) != hipSuccess || hipDeviceGetAttribute(&cus, hipDeviceAttributeMultiprocessorCount, dev) != hipSuccess) { grid = -1; return; }
        if (hipFuncSetAttribute((const void*)fwd_megakernel, hipFuncAttributeMaxDynamicSharedMemorySize, LDS_BYTES) != hipSuccess) { fprintf(stderr, "kernel_launch: hipFuncSetAttribute failed\n"); grid = -1; return; }
        if (hipOccupancyMaxActiveBlocksPerMultiprocessor(&per_cu, (const void*)fwd_megakernel, NTHREADS, LDS_BYTES) != hipSuccess || per_cu < 1) { fprintf(stderr, "kernel_launch: occupancy query reports %d workgroups per CU\n", per_cu); per_cu = 1; }
        (void)hipGetLastError();
        grid = cus;
    }
    if (grid < 0) return;
    if (hipMemsetAsync((char*)d_ws + WS_CTL, 0, CTL_ZERO_BYTES, stream) != hipSuccess) { fprintf(stderr, "kernel_launch: hipMemsetAsync failed\n"); return; }
    Args a{};
    for (int i = 0; i < 18; ++i) a.in[i] = (const float*)d_in[i];
    a.out = (float*)d_out; a.ws = (unsigned char*)d_ws;
    void* kargs[] = {&a};
    hipError_t e = hipLaunchCooperativeKernel((const void*)fwd_megakernel, dim3(grid), dim3(NTHREADS), kargs, LDS_BYTES, stream);
    if (e != hipSuccess) fprintf(stderr, "kernel_launch: cooperative launch failed: %s (grid %d)\n", hipGetErrorString(e), grid);
}
```

```cpp
#define TABLES_IN_ROUTER 1
#include <hip/hip_runtime.h>
#include <hip/hip_bf16.h>
#include <cstdio>
#include <cstdint>
#include <cmath>

constexpr int NB = 8, SEQ = 4096, T = NB * SEQ, D = 1024;
constexpr int AW = 512, PW = 512, INW = 4096;
constexpr int NH = 8, HD = 64, MBLK = 256, NBLK = SEQ / MBLK;
constexpr int PQW = 2048, PEXP = 16384, PTOP = 16, PHEADS = 8, PSEL = PHEADS * PTOP;
constexpr float RMS_EPS = 1e-6f;
constexpr float LOG2E = 1.4426950408889634f;
constexpr float QSCALE = 0.125f * LOG2E;
constexpr int NWAVES = 8, NTHREADS = 512;

namespace pg8 {
#define PG8_LAS __attribute__((address_space(3)))
typedef unsigned short bf16_t;
typedef short bf16x8 __attribute__((ext_vector_type(8)));
typedef float f32x4 __attribute__((ext_vector_type(4)));
typedef unsigned u32x4 __attribute__((ext_vector_type(4)));
constexpr int BM = 256, BK = 64, HALF = 128, HTB = HALF * BK * 2  , STAGE_BYTES = 8 * HTB, NXCD = 8, WGM = 8;

__host__ __device__ __forceinline__ int lds_byte(int r, int c) { const int st = (r >> 4) * 2 + (c >> 5), rr = r & 15, cc = c & 31, ob = rr * 64 + cc * 2; return st * 1024 + (ob ^ (((ob >> 9) & 1) << 5)); }
__host__ __device__ __forceinline__ void stage_rc(int b, int& R, int& C) { const int st = b / 1024, sb = b % 1024, swz = sb ^ (((sb >> 9) & 1) << 5); R = (st >> 1) * 16 + swz / 64; C = (st & 1) * 32 + (swz % 64) / 2; }
__host__ __device__ __forceinline__ int perm32(int rho) { const int n = rho >> 4, i = rho & 15; return 8 * (i >> 2) + 4 * n + (i & 3); }

struct Unit { int pm, pn, part; };
struct Gemm {
    const bf16_t* A0; const bf16_t* A1; const bf16_t* B0; const bf16_t* B1; int lda, ldb, K;
    __device__ __forceinline__ const char* a_ptr(const Unit& u) const { return (const char*)(u.part ? A1 : A0) + (size_t)u.pm * BM * lda * 2; }
    __device__ __forceinline__ const char* b_ptr(const Unit& u) const { return (const char*)(u.part ? B1 : B0) + (size_t)u.pn * BM * ldb * 2; }
};

struct StaticOrder {
    int nM, nN, nwg, G, c;
    __host__ __device__ void init(int M, int N, int G_, int c_) { nM = M / BM; nN = N / BM; nwg = nM * nN; G = G_; c = c_; }
    __host__ __device__ bool tile(long L, Unit& u) const {
        if (L >= nwg) return false;
        int wgid = (int)L; { const int q = nwg / NXCD, r = nwg % NXCD, xcd = wgid % NXCD, off = wgid / NXCD; wgid = (xcd < r ? xcd * (q + 1) : r * (q + 1) + (xcd - r) * q) + off; }
        const int nig = WGM * nN, gid = wgid / nig, fm = gid * WGM, gsz = (nM - fm) < WGM ? (nM - fm) : WGM;
        u.pm = fm + ((wgid % nig) % gsz); u.pn = (wgid % nig) / gsz; u.part = 0; return true;
    }
    __host__ __device__ bool next(int i, Unit& u) const { return tile((long)i * G + c, u); }
    __device__ __forceinline__ void a_ready(const Unit&) const {}
    __device__ __forceinline__ void done(const Unit&) const {}
};
struct DualOrder {
    StaticOrder so;
    __host__ __device__ void init(int M, int N, int G_, int c_) { so.init(M, N, G_, c_); }
    __host__ __device__ bool next(int i, Unit& u) const { if (!so.tile((long)(i >> 1) * so.G + so.c, u)) return false; u.part = i & 1; return true; }
    __device__ __forceinline__ void a_ready(const Unit&) const {}
    __device__ __forceinline__ void done(const Unit&) const {}
};

__device__ __forceinline__ unsigned cvt_pk_bf16(float lo, float hi) { unsigned r; asm volatile("v_cvt_pk_bf16_f32 %0, %1, %2" : "=v"(r) : "v"(lo), "v"(hi)); return r; }
__device__ __forceinline__ float bf_lo(unsigned w) { return __uint_as_float(w << 16); }
__device__ __forceinline__ float bf_hi(unsigned w) { return __uint_as_float(w & 0xffff0000u); }
__device__ __forceinline__ float sigmoidf_(float x) { return __builtin_amdgcn_rcpf(1.0f + __builtin_amdgcn_exp2f(-x * 1.4426950408889634f)); }


struct EpiIn {
    static constexpr bool PERM = true, AFTER_DRAIN = false;
    bf16_t* QKVP; bf16_t* GAB; const float* rstd1; const float* bias1p; float* ksum; unsigned* nrm;
    __device__ __forceinline__ void operator()(const f32x4 (&acc)[2][2][4][2], const Unit& u, int wr, int wc, int fr, int fq) const {
        bf16_t* base; int ldc, col0;
        if (u.pn < 8) { base = QKVP + (size_t)(u.pn >> 1) * T * 512; ldc = 512; col0 = (u.pn & 1) * 256; }
        else { base = GAB + (size_t)((u.pn - 8) >> 2) * T * 1024; ldc = 1024; col0 = ((u.pn - 8) & 3) * 256; }
        const float sc = (u.pn < 2) ? QSCALE : 1.0f;
        const int b = u.pm >> 4;
        const int bcol = u.pn * 256 + wc * 32 + 8 * fq;
        f32x4 bv[2][2];
#pragma unroll
        for (int bj = 0; bj < 2; ++bj)
#pragma unroll
            for (int n = 0; n < 2; ++n) { f32x4 s = (f32x4){0.f, 0.f, 0.f, 0.f};
#pragma unroll
                for (int kc = 0; kc < 8; ++kc) s += *(const f32x4*)(bias1p + (size_t)(kc * 8 + b) * INW + bcol + bj * HALF + 4 * n);
                bv[bj][n] = s; }
        const bool isk = (u.pn == 2 || u.pn == 3); const bool isqk = (u.pn < 4); float nmax[2] = {0.f, 0.f};
        f32x4 ks[2][2];
#pragma unroll
        for (int bj = 0; bj < 2; ++bj)
#pragma unroll
            for (int n = 0; n < 2; ++n) ks[bj][n] = (f32x4){0.f, 0.f, 0.f, 0.f};
        const int row0 = u.pm * BM + wr * 64 + fr;
#pragma unroll
        for (int ai = 0; ai < 2; ++ai)
#pragma unroll
            for (int m = 0; m < 4; ++m) { const int row = row0 + ai * HALF + m * 16; const float rs = rstd1[row];
                bf16_t* rowp = base + (size_t)row * ldc + col0 + wc * 32 + 8 * fq;
#pragma unroll
                for (int bj = 0; bj < 2; ++bj) { f32x4 v0 = acc[ai][bj][m][0] * rs + bv[bj][0], v1 = acc[ai][bj][m][1] * rs + bv[bj][1];
                    ks[bj][0] += v0; ks[bj][1] += v1;
                    v0 = v0 * sc; v1 = v1 * sc;
                    if (isqk) { float ss = (v0[0] * v0[0] + v0[1] * v0[1]) + (v0[2] * v0[2] + v0[3] * v0[3]) + (v1[0] * v1[0] + v1[1] * v1[1]) + (v1[2] * v1[2] + v1[3] * v1[3]); ss += __shfl_xor(ss, 16); ss += __shfl_xor(ss, 32); nmax[bj] = fmaxf(nmax[bj], ss); }
                    u32x4 w; w.x = cvt_pk_bf16(v0[0], v0[1]); w.y = cvt_pk_bf16(v0[2], v0[3]); w.z = cvt_pk_bf16(v1[0], v1[1]); w.w = cvt_pk_bf16(v1[2], v1[3]);
                    *(u32x4*)(rowp + bj * HALF) = w; } }
        if (isqk) {
#pragma unroll
            for (int bj = 0; bj < 2; ++bj) { float v = nmax[bj]; v = fmaxf(v, __shfl_xor(v, 1)); v = fmaxf(v, __shfl_xor(v, 2)); v = fmaxf(v, __shfl_xor(v, 4)); v = fmaxf(v, __shfl_xor(v, 8));
                if (fr == 0 && fq == 0) atomicMax(nrm + (size_t)(b * 2 + (u.pn >> 1)) * 16 + (u.pn & 1) * 8 + bj * 4 + wc, __float_as_uint(v)); }
        }
        if (isk) {
#pragma unroll
            for (int bj = 0; bj < 2; ++bj)
#pragma unroll
                for (int n = 0; n < 2; ++n)
#pragma unroll
                    for (int e = 0; e < 4; ++e) { float v = ks[bj][n][e]; v += __shfl_xor(v, 1); v += __shfl_xor(v, 2); v += __shfl_xor(v, 4); v += __shfl_xor(v, 8); ks[bj][n][e] = v; }
            if (fr == 0) { float* kp = ksum + (size_t)u.pm * 512 + (u.pn - 2) * 256 + wc * 32 + 8 * fq;
#pragma unroll
                for (int bj = 0; bj < 2; ++bj)
#pragma unroll
                    for (int n = 0; n < 2; ++n)
#pragma unroll
                        for (int e = 0; e < 4; ++e) atomicAdd(kp + bj * HALF + 4 * n + e, ks[bj][n][e]); }
        }
    }
};

struct EpiUp {
    static constexpr bool PERM = true, AFTER_DRAIN = false;
    bf16_t* merged; const bf16_t* GAB; const float* bprime;
    __device__ __forceinline__ void operator()(const f32x4 (&acc)[2][2][4][2], const Unit& u, int wr, int wc, int fr, int fq) const {
        const int row0 = u.pm * BM + wr * 64 + fr, colb = u.pn * BM + wc * 32 + 8 * fq;
        const bf16_t* gate = GAB + (size_t)u.part * T * 1024;
        f32x4 bv[2][2];
#pragma unroll
        for (int bj = 0; bj < 2; ++bj)
#pragma unroll
            for (int n = 0; n < 2; ++n) { f32x4 s_ = (f32x4){0.f, 0.f, 0.f, 0.f}; if (u.part) { _Pragma("unroll") for (int g_ = 0; g_ < 4; ++g_) s_ += *(const f32x4*)(bprime + g_ * 1024 + colb + bj * HALF + 4 * n); } bv[bj][n] = s_; }
#pragma unroll
        for (int ai = 0; ai < 2; ++ai) {
            u32x4 gpre[4][2], ppre[4][2];
#pragma unroll
            for (int m = 0; m < 4; ++m) { const size_t off = (size_t)(row0 + ai * HALF + m * 16) * 1024 + colb;
#pragma unroll
                for (int bj = 0; bj < 2; ++bj) { gpre[m][bj] = __builtin_nontemporal_load((const u32x4*)(gate + off + bj * HALF));
                    if (u.part) ppre[m][bj] = __builtin_nontemporal_load((const u32x4*)(merged + off + bj * HALF)); else ppre[m][bj] = (u32x4){0u, 0u, 0u, 0u}; } }
#pragma unroll
            for (int m = 0; m < 4; ++m) { const size_t off = (size_t)(row0 + ai * HALF + m * 16) * 1024 + colb;
#pragma unroll
                for (int bj = 0; bj < 2; ++bj) {
                    const u32x4 gw = gpre[m][bj], pw = ppre[m][bj];
                    f32x4 v0 = acc[ai][bj][m][0] + bv[bj][0], v1 = acc[ai][bj][m][1] + bv[bj][1];
                    v0[0] *= sigmoidf_(bf_lo(gw.x)); v0[1] *= sigmoidf_(bf_hi(gw.x)); v0[2] *= sigmoidf_(bf_lo(gw.y)); v0[3] *= sigmoidf_(bf_hi(gw.y));
                    v1[0] *= sigmoidf_(bf_lo(gw.z)); v1[1] *= sigmoidf_(bf_hi(gw.z)); v1[2] *= sigmoidf_(bf_lo(gw.w)); v1[3] *= sigmoidf_(bf_hi(gw.w));
                    v0[0] += bf_lo(pw.x); v0[1] += bf_hi(pw.x); v0[2] += bf_lo(pw.y); v0[3] += bf_hi(pw.y); v1[0] += bf_lo(pw.z); v1[1] += bf_hi(pw.z); v1[2] += bf_lo(pw.w); v1[3] += bf_hi(pw.w);
                    u32x4 w; w.x = cvt_pk_bf16(v0[0], v0[1]); w.y = cvt_pk_bf16(v0[2], v0[3]); w.z = cvt_pk_bf16(v1[0], v1[1]); w.w = cvt_pk_bf16(v1[2], v1[3]);
                    *(u32x4*)(merged + off + bj * HALF) = w; } }
        }
        if (u.part == 0) asm volatile("s_waitcnt vmcnt(0)" ::: "memory");
    }
};

struct EpiOut {
    static constexpr bool PERM = true, AFTER_DRAIN = false;
    const float* x; float* x1; bf16_t* A2; const float* modf; const float* g2; float* ss2;
    __device__ __forceinline__ void operator()(const f32x4 (&acc)[2][2][4][2], const Unit& u, int wr, int wc, int fr, int fq) const {
        const int row0 = u.pm * BM + wr * 64 + fr, colb = u.pn * BM + wc * 32 + 8 * fq, b = u.pm >> 4;
        f32x4 gt[2][2], gg[2][2];
#pragma unroll
        for (int bj = 0; bj < 2; ++bj)
#pragma unroll
            for (int n = 0; n < 2; ++n) { const int c = colb + bj * HALF + 4 * n; gt[bj][n] = *(const f32x4*)(modf + (size_t)b * 6144 + 2048 + c);
                const f32x4 sc2 = *(const f32x4*)(modf + (size_t)b * 6144 + 4096 + c); gg[bj][n] = *(const f32x4*)(g2 + c) * (sc2 + 1.0f); }
#pragma unroll
        for (int ai = 0; ai < 2; ++ai) {
#pragma unroll
          for (int mh = 0; mh < 2; ++mh) {
            f32x4 xr[2][2][2];
#pragma unroll
            for (int m2 = 0; m2 < 2; ++m2) { const size_t off = (size_t)(row0 + ai * HALF + (2 * mh + m2) * 16) * 1024 + colb;
#pragma unroll
                for (int bj = 0; bj < 2; ++bj) { xr[m2][bj][0] = __builtin_nontemporal_load((const f32x4*)(x + off + bj * HALF)); xr[m2][bj][1] = __builtin_nontemporal_load((const f32x4*)(x + off + bj * HALF + 4)); } }
#pragma unroll
            for (int m2 = 0; m2 < 2; ++m2) { const int m = 2 * mh + m2; const int row = row0 + ai * HALF + m * 16; const size_t off = (size_t)row * 1024 + colb; float ssq = 0.f;
#pragma unroll
                for (int bj = 0; bj < 2; ++bj) {
                    const f32x4 y0 = xr[m2][bj][0] + gt[bj][0] * acc[ai][bj][m][0], y1 = xr[m2][bj][1] + gt[bj][1] * acc[ai][bj][m][1];
                    *(f32x4*)(x1 + off + bj * HALF) = y0; *(f32x4*)(x1 + off + bj * HALF + 4) = y1;
                    ssq += (y0[0] * y0[0] + y0[1] * y0[1]) + (y0[2] * y0[2] + y0[3] * y0[3]) + (y1[0] * y1[0] + y1[1] * y1[1]) + (y1[2] * y1[2] + y1[3] * y1[3]);
                    const f32x4 a0 = y0 * gg[bj][0], a1 = y1 * gg[bj][1];
                    u32x4 w; w.x = cvt_pk_bf16(a0[0], a0[1]); w.y = cvt_pk_bf16(a0[2], a0[3]); w.z = cvt_pk_bf16(a1[0], a1[1]); w.w = cvt_pk_bf16(a1[2], a1[3]);
                    *(u32x4*)(A2 + off + bj * HALF) = w; }
                ssq += __shfl_xor(ssq, 16); ssq += __shfl_xor(ssq, 32);
                if (fq == 0) ss2[(size_t)row * 16 + u.pn * 4 + wc] = ssq; }
          }
        }
    }
};

struct EpiPq {
    static constexpr bool PERM = true, AFTER_DRAIN = false;
    bf16_t* QP; const float* ss2; const float* bias2p;
    __device__ __forceinline__ void operator()(const f32x4 (&acc)[2][2][4][2], const Unit& u, int wr, int wc, int fr, int fq) const {
        const int row0 = u.pm * BM + wr * 64 + fr, colb = u.pn * BM + wc * 32 + 8 * fq, b = u.pm >> 4;
        f32x4 bv[2][2];
#pragma unroll
        for (int bj = 0; bj < 2; ++bj)
#pragma unroll
            for (int n = 0; n < 2; ++n) { f32x4 s = (f32x4){0.f, 0.f, 0.f, 0.f};
#pragma unroll
                for (int kc = 0; kc < 8; ++kc) s += *(const f32x4*)(bias2p + (size_t)(kc * 8 + b) * PQW + colb + bj * HALF + 4 * n);
                bv[bj][n] = s; }
#pragma unroll
        for (int ai = 0; ai < 2; ++ai)
#pragma unroll
            for (int m = 0; m < 4; ++m) { const int row = row0 + ai * HALF + m * 16;
                const f32x4* sp = (const f32x4*)(ss2 + (size_t)row * 16); const f32x4 s4 = (sp[0] + sp[1]) + (sp[2] + sp[3]);
                const float rs = __builtin_amdgcn_rsqf(((s4[0] + s4[1]) + (s4[2] + s4[3])) * (1.0f / D) + RMS_EPS);
                bf16_t* rowp = QP + (size_t)row * PQW + colb;
#pragma unroll
                for (int bj = 0; bj < 2; ++bj) { const f32x4 v0 = acc[ai][bj][m][0] * rs + bv[bj][0], v1 = acc[ai][bj][m][1] * rs + bv[bj][1];
                    u32x4 w; w.x = cvt_pk_bf16(v0[0], v0[1]); w.y = cvt_pk_bf16(v0[2], v0[3]); w.z = cvt_pk_bf16(v1[0], v1[1]); w.w = cvt_pk_bf16(v1[2], v1[3]);
                    *(u32x4*)(rowp + bj * HALF) = w; } }
    }
};

template <class Epi, class Sched, bool ALIGN_EPI = false, bool SP2 = false>
__device__ __forceinline__ void gemm_phase(PG8_LAS unsigned char* lds, const Gemm g, const Sched& S, const Epi& E) {
    int tid_ = threadIdx.x; asm volatile("" : "+v"(tid_));
    const int tid = tid_, wid = __builtin_amdgcn_readfirstlane(tid >> 6), lane = tid & 63, wr = wid >> 2, wc = wid & 3, fr = lane & 15, fq = lane >> 4;
    const int K = g.K, nt = K / BK, lda = g.lda, ldb = g.ldb;
    unsigned voffA[2], voffB[2];
#pragma unroll
    for (int i = 0; i < 2; ++i) { int R, C; stage_rc(tid * 16 + i * 8192, R, C); const int Rb = Epi::PERM ? ((R & ~31) + perm32(R & 31)) : R;
        voffA[i] = (unsigned)(R * lda + C) * 2u; voffB[i] = (unsigned)(Rb * ldb + C) * 2u; }
    const size_t kstep = (size_t)(BK * 2);
    const size_t hstepA = (size_t)HALF * lda * 2, hstepB = (size_t)HALF * ldb * 2;
    const unsigned ldsw = (unsigned)wid * 1024u;
    const int aoff = lds_byte(wr * 64 + fr, fq * 8), boff = lds_byte(wc * 32 + fr, fq * 8);
#define PG8_SA(b, h) (((b) * 2 + (h)) * HTB)
#define PG8_SB(b, h) ((4 + (b) * 2 + (h)) * HTB)
#define PG8_STAGE(bufoff, gbase, voff) do { _Pragma("unroll") for (int _i = 0; _i < 2; ++_i) \
        __builtin_amdgcn_global_load_lds((const unsigned*)((const char*)(gbase) + (voff)[_i]), (PG8_LAS unsigned*)(lds + (bufoff) + ldsw + _i * 8192), 16, 0, 0); } while (0)
#define PG8_LDA(dst, b, h) do { _Pragma("unroll") for (int m = 0; m < 4; ++m) _Pragma("unroll") for (int k = 0; k < 2; ++k) dst[m][k] = *(const PG8_LAS bf16x8*)(lds + PG8_SA(b, h) + aoff + m * 2048 + k * 1024); } while (0)
#define PG8_LDB(dst, b, h) do { _Pragma("unroll") for (int n = 0; n < 2; ++n) _Pragma("unroll") for (int k = 0; k < 2; ++k) dst[n][k] = *(const PG8_LAS bf16x8*)(lds + PG8_SB(b, h) + boff + n * 2048 + k * 1024); } while (0)
#define PG8_MMA(ai, bj, At, Bt) do { __builtin_amdgcn_s_setprio(1); _Pragma("unroll") for (int m = 0; m < 4; ++m) _Pragma("unroll") for (int n = 0; n < 2; ++n) _Pragma("unroll") for (int k = 0; k < 2; ++k) \
        acc[ai][bj][m][n] = __builtin_amdgcn_mfma_f32_16x16x32_bf16(Bt[n][k], At[m][k], acc[ai][bj][m][n], 0, 0, 0); __builtin_amdgcn_s_setprio(0); } while (0)
#define PG8_WAIT_V(n) asm volatile("s_waitcnt vmcnt(" #n ")" ::: "memory")
#define PG8_WAIT_L(n) asm volatile("s_waitcnt lgkmcnt(" #n ")" ::: "memory")
#define PG8_BAR __builtin_amdgcn_s_barrier()
#define PG8_SCHED __builtin_amdgcn_sched_barrier(0)
    Unit cur, nxt; int ui = 0;
    if (!S.next(0, cur)) return;
    f32x4 acc[2][2][4][2];
#pragma unroll
    for (int a = 0; a < 2; ++a)
#pragma unroll
        for (int b = 0; b < 2; ++b)
#pragma unroll
            for (int m = 0; m < 4; ++m)
#pragma unroll
                for (int n = 0; n < 2; ++n) acc[a][b][m][n] = (f32x4){0.f, 0.f, 0.f, 0.f};
    bf16x8 At[4][2], B0[2][2], B1[2][2];
    const char* cA = g.a_ptr(cur); const char* cB = g.b_ptr(cur);
    S.a_ready(cur);
    if constexpr (SP2) {
        PG8_STAGE(PG8_SB(0, 0), cB, voffB); PG8_STAGE(PG8_SB(0, 1), cB + hstepB, voffB); PG8_STAGE(PG8_SA(0, 0), cA, voffA); PG8_STAGE(PG8_SA(0, 1), cA + hstepA, voffA);
        if (wr == 1) PG8_BAR;
        PG8_WAIT_V(2); PG8_BAR;
        PG8_STAGE(PG8_SB(1, 0), cB + kstep, voffB); PG8_STAGE(PG8_SA(1, 0), cA + kstep, voffA); PG8_STAGE(PG8_SB(1, 1), cB + hstepB + kstep, voffB);
        PG8_WAIT_V(6); PG8_BAR;
    } else {
        PG8_STAGE(PG8_SB(0, 0), cB, voffB); PG8_STAGE(PG8_SA(0, 0), cA, voffA); PG8_STAGE(PG8_SB(0, 1), cB + hstepB, voffB); PG8_STAGE(PG8_SA(0, 1), cA + hstepA, voffA);
        if (wr == 1) PG8_BAR;
        PG8_WAIT_V(4); PG8_BAR;
        PG8_STAGE(PG8_SB(1, 0), cB + kstep, voffB); PG8_STAGE(PG8_SA(1, 0), cA + kstep, voffA); PG8_STAGE(PG8_SB(1, 1), cB + hstepB + kstep, voffB);
        PG8_WAIT_V(6); PG8_BAR;
    }
    for (;;) {
        const bool has_next = S.next(ui + 1, nxt);
        const char* nA = has_next ? g.a_ptr(nxt) : cA; const char* nB = has_next ? g.b_ptr(nxt) : cB;
        for (int t = 0; t < nt; t += 2) {
            const bool last = (t == nt - 2);
            const char* a1 = cA + (size_t)(t + 1) * kstep;
            const char* a2 = last ? nA : cA + (size_t)(t + 2) * kstep; const char* b2 = last ? nB : cB + (size_t)(t + 2) * kstep;
            const char* a3 = a2 + kstep; const char* b3 = b2 + kstep;
            if (last && has_next) S.a_ready(nxt);
            if constexpr (SP2) {
            PG8_LDB(B0, 0, 0); PG8_LDB(B1, 0, 1); PG8_SCHED; PG8_LDA(At, 0, 0); PG8_STAGE(PG8_SA(1, 1), a1 + hstepA, voffA);
            PG8_WAIT_V(8); PG8_WAIT_L(0); PG8_BAR; PG8_MMA(0, 0, At, B0); PG8_MMA(0, 1, At, B1); PG8_BAR; PG8_SCHED;
            PG8_LDA(At, 0, 1); PG8_STAGE(PG8_SB(0, 0), b2, voffB); PG8_STAGE(PG8_SB(0, 1), b2 + hstepB, voffB); PG8_STAGE(PG8_SA(0, 0), a2, voffA);
            PG8_WAIT_V(8); PG8_WAIT_L(0); PG8_BAR; PG8_MMA(1, 0, At, B0); PG8_MMA(1, 1, At, B1); PG8_BAR; PG8_SCHED;
            PG8_LDB(B0, 1, 0); PG8_LDB(B1, 1, 1); PG8_SCHED; PG8_LDA(At, 1, 0); PG8_STAGE(PG8_SA(0, 1), a2 + hstepA, voffA);
            PG8_WAIT_V(8); PG8_WAIT_L(0); PG8_BAR; PG8_MMA(0, 0, At, B0); PG8_MMA(0, 1, At, B1); PG8_BAR; PG8_SCHED;
            PG8_LDA(At, 1, 1); PG8_STAGE(PG8_SB(1, 0), b3, voffB); PG8_STAGE(PG8_SB(1, 1), b3 + hstepB, voffB); PG8_STAGE(PG8_SA(1, 0), a3, voffA);
            PG8_WAIT_V(8); PG8_WAIT_L(0); PG8_BAR; PG8_MMA(1, 0, At, B0); PG8_MMA(1, 1, At, B1); PG8_BAR; PG8_SCHED;
            } else {
            PG8_LDB(B0, 0, 0); PG8_SCHED; PG8_LDA(At, 0, 0); PG8_STAGE(PG8_SA(1, 1), a1 + hstepA, voffA);
            PG8_WAIT_L(8); PG8_BAR; PG8_WAIT_L(0); PG8_MMA(0, 0, At, B0); PG8_BAR; PG8_SCHED;
            PG8_LDB(B1, 0, 1); PG8_STAGE(PG8_SB(0, 0), b2, voffB);
            PG8_BAR; PG8_WAIT_L(0); PG8_MMA(0, 1, At, B1); PG8_BAR;
            PG8_LDA(At, 0, 1); PG8_STAGE(PG8_SA(0, 0), a2, voffA);
            PG8_BAR; PG8_WAIT_L(0); PG8_MMA(1, 0, At, B0); PG8_BAR; PG8_SCHED;
            PG8_STAGE(PG8_SB(0, 1), b2 + hstepB, voffB);
            PG8_WAIT_V(6); PG8_BAR; PG8_MMA(1, 1, At, B1); PG8_BAR;
            PG8_LDB(B0, 1, 0); PG8_SCHED; PG8_LDA(At, 1, 0); PG8_STAGE(PG8_SA(0, 1), a2 + hstepA, voffA);
            PG8_WAIT_L(8); PG8_BAR; PG8_WAIT_L(0); PG8_MMA(0, 0, At, B0); PG8_BAR; PG8_SCHED;
            PG8_LDB(B1, 1, 1); PG8_STAGE(PG8_SB(1, 0), b3, voffB);
            PG8_BAR; PG8_WAIT_L(0); PG8_MMA(0, 1, At, B1); PG8_BAR;
            PG8_LDA(At, 1, 1); PG8_STAGE(PG8_SA(1, 0), a3, voffA);
            PG8_BAR; PG8_WAIT_L(0); PG8_MMA(1, 0, At, B0); PG8_BAR; PG8_SCHED;
            PG8_STAGE(PG8_SB(1, 1), b3 + hstepB, voffB);
            PG8_WAIT_V(6); PG8_BAR; PG8_MMA(1, 1, At, B1); PG8_BAR;
            }
        }
        if constexpr (ALIGN_EPI) { if (wr == 0) PG8_BAR; }
        if constexpr (!Epi::AFTER_DRAIN) { E(acc, cur, wr, wc, fr, fq); S.done(cur); }
        if (!has_next) break;
#pragma unroll
        for (int a = 0; a < 2; ++a)
#pragma unroll
            for (int b = 0; b < 2; ++b)
#pragma unroll
                for (int m = 0; m < 4; ++m)
#pragma unroll
                    for (int n = 0; n < 2; ++n) acc[a][b][m][n] = (f32x4){0.f, 0.f, 0.f, 0.f};
        cur = nxt; cA = nA; cB = nB; ++ui;
        if constexpr (ALIGN_EPI) { if (wr == 1) PG8_BAR; }
    }
    PG8_WAIT_V(0);
    if constexpr (!ALIGN_EPI) { if (wr == 0) PG8_BAR; }
    PG8_BAR;
    if constexpr (Epi::AFTER_DRAIN) { E.fused(acc, cur, wr, wc, fr, fq, lds, wid, lane); S.done(cur); }
#undef PG8_SA
#undef PG8_SB
#undef PG8_STAGE
#undef PG8_LDA
#undef PG8_LDB
#undef PG8_MMA
#undef PG8_WAIT_V
#undef PG8_WAIT_L
#undef PG8_BAR
#undef PG8_SCHED
}
}

constexpr size_t MiB = 1u << 20;
constexpr size_t WS_CTL = 0, CTL_ZERO_BYTES = 32 * 1024;
constexpr size_t WS_KSUM = 256 * 1024;
constexpr size_t WS_MODP = 1 * MiB;
constexpr size_t WS_MODF = WS_MODP + 8 * 8 * 6144 * 4;
constexpr size_t WS_BIAS1P = 3 * MiB;
constexpr size_t WS_BIAS2P = 4 * MiB;
constexpr size_t WS_BPRIME = 4 * MiB + 512 * 1024;
constexpr size_t WS_RSTD1 = 5 * MiB;
constexpr size_t WS_SS2 = 6 * MiB;
constexpr size_t WS_SUBK = 8 * MiB;
constexpr size_t WS_WIN = 16 * MiB, WS_WA = 24 * MiB, WS_WP = 25 * MiB, WS_WOUT = 26 * MiB, WS_WQ = 28 * MiB;
constexpr size_t WS_U = 32 * MiB, WS_V = 64 * MiB;
constexpr size_t WS_XG = 96 * MiB;
constexpr size_t WS_H2Q = WS_XG, WS_HS = WS_XG + 32 * MiB;
constexpr size_t WS_QKVP = 160 * MiB;
constexpr size_t WS_GAB = 288 * MiB;
constexpr size_t WS_POOLED = 416 * MiB;
constexpr size_t WS_END = 448 * MiB;
constexpr int CW_TMO = 0, CW_BAR = 4096;
constexpr int CW_NRM = 2048;

constexpr int RING_OFF = 0, RING_BYTES = 131072;
constexpr int LDS_BYTES = 147456;
constexpr int LDSCTL_OFF = LDS_BYTES - 512, MISC_OFF = LDSCTL_OFF + 320;

#define GAS __attribute__((address_space(1)))
#define LAS __attribute__((address_space(3)))
typedef unsigned short bf16;
typedef unsigned v4u __attribute__((ext_vector_type(4)));
typedef unsigned v2u __attribute__((ext_vector_type(2)));
typedef float f32x4 __attribute__((ext_vector_type(4)));
typedef GAS unsigned gu32;
#define RLX_AGENT __ATOMIC_RELAXED, __HIP_MEMORY_SCOPE_AGENT
#define LDS_WAIT() asm volatile("s_waitcnt lgkmcnt(0)" ::: "memory")
#define VM_WAIT() asm volatile("s_waitcnt vmcnt(0)" ::: "memory")
__device__ __forceinline__ unsigned f2bf(float f) { unsigned u = __builtin_bit_cast(unsigned, f); return (u + 0x7fffu + ((u >> 16) & 1u)) >> 16; }
__device__ __forceinline__ unsigned pk2(float lo, float hi) { return f2bf(lo) | (f2bf(hi) << 16); }
__device__ __forceinline__ float bflo(unsigned w) { return __uint_as_float(w << 16); }
__device__ __forceinline__ float bfhi(unsigned w) { return __uint_as_float(w & 0xffff0000u); }
__device__ __forceinline__ float wave_sum(float v) {
#pragma unroll
    for (int o = 1; o < 64; o <<= 1) v += __shfl_xor(v, o);
    return v;
}
__device__ __forceinline__ float wave_max(float v) {
#pragma unroll
    for (int o = 1; o < 64; o <<= 1) v = fmaxf(v, __shfl_xor(v, o));
    return v;
}

#define XB_TMO      128
#define XB_XCNT(j)  (256  + 64 * (j))
#define XB_XSUB(j)  (1280 + 64 * (j))
#define XB_XGEN(j)  (2304 + 64 * (j))
#define XB_TOP      3328
#define XB_TOPGEN   3392
#define XCD_BAR_WORDS 3456
#define XB_SPIN_CAP (1u << 22)

__device__ __forceinline__ unsigned xb_ld(unsigned* p)              { return __hip_atomic_load(p, __ATOMIC_RELAXED, __HIP_MEMORY_SCOPE_AGENT); }
__device__ __forceinline__ unsigned xb_add(unsigned* p, unsigned v) { return __hip_atomic_fetch_add(p, v, __ATOMIC_RELAXED, __HIP_MEMORY_SCOPE_AGENT); }
__device__ __forceinline__ unsigned xb_xcc_id() { return (unsigned)__builtin_amdgcn_s_getreg((3 << 11) | 20) & 0xFu; }
#define XB_SPIN(cond, bar) do { unsigned _sp = 0; while (cond) { __builtin_amdgcn_s_sleep(1); \
    if ((++_sp & 255u) == 0u) { if (xb_ld(&(bar)[XB_TMO])) break; if (_sp > XB_SPIN_CAP) { atomicAdd(&(bar)[XB_TMO], 1u); break; } } } } while (0)

struct XcdBarrier { unsigned* bar; unsigned x; volatile LAS unsigned* st; };

__device__ __forceinline__ XcdBarrier xcd_barrier_post(unsigned* bar, volatile LAS unsigned* st) {
    XcdBarrier b; b.bar = bar; b.x = xb_xcc_id(); b.st = st;
    if (threadIdx.x == 0) (void)xb_add(&bar[XB_XCNT(b.x)], 1u);
    return b;
}
__device__ __forceinline__ void xcd_barrier_complete(unsigned* bar, unsigned x, unsigned& nloc, unsigned& nx) {
    const unsigned G = gridDim.x * gridDim.y * gridDim.z;
    unsigned sum, cnt, mine, sp = 0u;
    for (;;) {
        sum = 0u; cnt = 0u; mine = 0u;
#pragma unroll
        for (unsigned j = 0; j < 16; ++j) { const unsigned c = xb_ld(&bar[XB_XCNT(j)]); sum += c; cnt += (c > 0u) ? 1u : 0u; mine = (j == x) ? c : mine; }
        if (sum == G) break;
        __builtin_amdgcn_s_sleep(1);
        if ((++sp & 255u) == 0u) { if (xb_ld(&bar[XB_TMO])) break; if (sp > XB_SPIN_CAP) { atomicAdd(&bar[XB_TMO], 1u); break; } }
    }
    nloc = mine > 0u ? mine : 1u; nx = cnt > 0u ? cnt : 1u;
}
__device__ __forceinline__ void xcd_barrier(const XcdBarrier& b) {
    asm volatile("s_waitcnt vmcnt(0)" ::: "memory");
    __syncthreads();
    if (threadIdx.x == 0) {
        unsigned* bar = b.bar;
        __builtin_amdgcn_s_waitcnt(0);
        unsigned nloc = b.st[0], nx = b.st[1];
        if (nloc == 0u) { xcd_barrier_complete(bar, b.x, nloc, nx); b.st[0] = nloc; b.st[1] = nx; }
        const unsigned old = xb_add(&bar[XB_XSUB(b.x)], 1u);
        const unsigned gen = old / nloc;
        if (old + 1u == (gen + 1u) * nloc) {
            __builtin_amdgcn_fence(__ATOMIC_RELEASE, "agent");
            asm volatile("s_waitcnt vmcnt(0)" ::: "memory");
            const unsigned og = xb_add(&bar[XB_TOP], 1u);
            const unsigned tg = og / nx;
            if (og + 1u == (tg + 1u) * nx) xb_add(&bar[XB_TOPGEN], 1u);
            else XB_SPIN(xb_ld(&bar[XB_TOPGEN]) == tg, bar);
            __builtin_amdgcn_fence(__ATOMIC_ACQUIRE, "agent");
            xb_add(&bar[XB_XGEN(b.x)], 1u);
            asm volatile("s_waitcnt vmcnt(0)" ::: "memory");
        } else {
            XB_SPIN(xb_ld(&bar[XB_XGEN(b.x)]) == gen, bar);
            __builtin_amdgcn_fence(__ATOMIC_ACQUIRE, "agent");
            asm volatile("s_waitcnt vmcnt(0)" ::: "memory");
        }
    }
    __syncthreads();
}

struct Frame {
    LAS unsigned char* lds;
    volatile LAS unsigned* MISC;
    gu32* ctl;
    int tid, lane, wave;
    int vcu, G;
};
struct Args { const float* in[18]; float* out; unsigned char* ws; };

__device__ __forceinline__ float modp_sum(const float* modp, int idx) {
    float s = 0.f;
#pragma unroll
    for (int kc = 0; kc < 8; ++kc) s += modp[(size_t)kc * 8 * 6144 + idx];
    return s;
}
template <int MODE>
__device__ __forceinline__ void p0_wg_dot(Frame& F, const float* cin, const float* modp, int soff, const float* W, int N, const float* addv, float* outp, int first, int ntask) {
    LAS float* scr = (LAS float*)(F.lds + RING_OFF + F.wave * 16384);
    const int ncn = N / 64;
    for (int it = first; it < ntask; it += F.G) {
        const int kc = it / ncn, nc = it % ncn, k0 = kc * 128 + F.wave * 16, n = nc * 64 + F.lane;
        float w[16];
#pragma unroll
        for (int kk = 0; kk < 16; ++kk) w[kk] = (MODE == 0) ? __builtin_nontemporal_load(W + (size_t)(k0 + kk) * N + n) : W[(size_t)(k0 + kk) * N + n];
#pragma unroll
        for (int j = 0; j < 2; ++j) { const int idx = F.lane + 64 * j, b = idx >> 4, kk = idx & 15;
            float cf; if (MODE == 0) { const float cv = cin[b * 1024 + k0 + kk]; cf = cv / (1.0f + __expf(-cv)); } else cf = modp_sum(modp, b * 6144 + soff + k0 + kk);
            scr[idx] = cf; }
        LDS_WAIT(); asm volatile("" ::: "memory");
#pragma unroll
        for (int b = 0; b < 8; ++b) { float s = 0.f;
#pragma unroll
            for (int kk = 0; kk < 16; ++kk) s += scr[b * 16 + kk] * w[kk];
            scr[256 + b * 64 + F.lane] = s; }
        __syncthreads();
        { const int b = F.wave; float s = (addv != nullptr && kc == 0) ? addv[n] : 0.f;
#pragma unroll
          for (int w8 = 0; w8 < 8; ++w8) s += ((LAS float*)(F.lds + RING_OFF + w8 * 16384))[256 + b * 64 + F.lane];
          outp[(size_t)(kc * 8 + b) * N + n] = s; }
        __syncthreads();
    }
}
__device__ __forceinline__ void p0a_mod(Frame& F, const Args& A) { p0_wg_dot<0>(F, A.in[1], nullptr, 0, A.in[2], 6144, A.in[3], (float*)(A.ws + WS_MODP), F.vcu, 8 * 96); }
__device__ __forceinline__ void p0_wp_task(Frame& F, const Args& A, int r) {
    LAS float* scr = (LAS float*)(F.lds + RING_OFF + F.wave * 16384);
    const int g = r >> 6, kq = (r >> 4) & 3, nc = r & 15, n = nc * 64 + F.lane, d0 = 16 * F.wave;
    const float* wmix = A.in[7] + (size_t)(g * 128 + 32 * kq) * 128 + d0; const float* scale = A.in[9] + g * 128 + d0; const float* wup = A.in[10] + (size_t)(g * 128 + d0) * D + n; const float* bmix = A.in[8] + g * 128 + d0;
    float wu[16];
#pragma unroll
    for (int d = 0; d < 16; ++d) wu[d] = wup[(size_t)d * D];
    float bp = 0.f;
#pragma unroll
    for (int d = 0; d < 16; ++d) { wu[d] *= scale[d]; bp += bmix[d] * wu[d]; }
#pragma unroll
    for (int kk = 0; kk < 32; ++kk) { float s = 0.f;
#pragma unroll
        for (int d = 0; d < 16; ++d) s += wmix[kk * 128 + d] * wu[d];
        scr[kk * 64 + F.lane] = s; }
    scr[2048 + F.lane] = bp;
    __syncthreads();
    { float s[4]; float bs = 0.f;
#pragma unroll
      for (int e = 0; e < 4; ++e) s[e] = 0.f;
#pragma unroll
      for (int w8 = 0; w8 < 8; ++w8) { const LAS float* o = (const LAS float*)(F.lds + RING_OFF + w8 * 16384);
#pragma unroll
          for (int e = 0; e < 4; ++e) s[e] += o[(4 * F.wave + e) * 64 + F.lane];
          bs += o[2048 + F.lane]; }
      v2u w; w.x = pk2(s[0], s[1]); w.y = pk2(s[2], s[3]);
      *(GAS v2u*)((bf16*)(A.ws + WS_WP) + (size_t)n * PW + g * 128 + 32 * kq + 4 * F.wave) = w;
      if (kq == 0 && F.wave == 0) ((float*)(A.ws + WS_BPRIME))[g * 1024 + n] = bs; }
    __syncthreads();
}

__device__ __forceinline__ void p0_transpose_item(const float* W, int K, int N, bf16* WT, int row_off, LAS float* scr, int item, int lane) {
    const int nblk = N / 32, kb = item / nblk, nb = item % nblk, k0 = 64 * kb, n0 = 32 * nb;
#pragma unroll 8
    for (int i = 0; i < 32; ++i) { const int kk = 2 * i + (lane >> 5); scr[kk * 33 + (lane & 31)] = __builtin_nontemporal_load(W + (size_t)(k0 + kk) * N + n0 + (lane & 31)); }
    LDS_WAIT(); asm volatile("" ::: "memory");
    const int c = lane & 7;
#pragma unroll
    for (int j = 0; j < 4; ++j) { const int n = (lane >> 3) + 8 * j; const LAS float* s = scr + (8 * c) * 33 + n;
        v4u o; o.x = pk2(s[0 * 33], s[1 * 33]); o.y = pk2(s[2 * 33], s[3 * 33]); o.z = pk2(s[4 * 33], s[5 * 33]); o.w = pk2(s[6 * 33], s[7 * 33]);
        *(GAS v4u*)(WT + (size_t)(row_off + n0 + n) * K + k0 + 8 * c) = o; }
    LDS_WAIT(); asm volatile("" ::: "memory");
}
__device__ __forceinline__ void p0_table_rows4(const float* const (&src)[4], unsigned char* const (&dst)[4], float* const (&scale_out)[4], int off, int lane) {
    f32x4 v[4][4]; float am[4];
#pragma unroll
    for (int u = 0; u < 4; ++u)
#pragma unroll
        for (int q = 0; q < 4; ++q) v[u][q] = __builtin_nontemporal_load((const f32x4*)(src[u] + 16 * lane + 4 * q));
#pragma unroll
    for (int u = 0; u < 4; ++u) { float a = 0.f;
#pragma unroll
        for (int q = 0; q < 4; ++q) a = fmaxf(fmaxf(a, fmaxf(fabsf(v[u][q][0]), fabsf(v[u][q][1]))), fmaxf(fabsf(v[u][q][2]), fabsf(v[u][q][3])));
        am[u] = a; }
#pragma unroll
    for (int o = 1; o < 64; o <<= 1) {
#pragma unroll
        for (int u = 0; u < 4; ++u) am[u] = fmaxf(am[u], __shfl_xor(am[u], o)); }
#pragma unroll
    for (int u = 0; u < 4; ++u) { const float sc = (am[u] > 0.f) ? am[u] * (1.0f / 127.0f) : 1.0f, inv = 1.0f / sc;
        v4u o;
#pragma unroll
        for (int q = 0; q < 4; ++q) { const int q0 = (int)rintf(v[u][q][0] * inv) + off, q1 = (int)rintf(v[u][q][1] * inv) + off, q2 = (int)rintf(v[u][q][2] * inv) + off, q3 = (int)rintf(v[u][q][3] * inv) + off;
            o[q] = (unsigned)(q0 & 255) | ((unsigned)(q1 & 255) << 8) | ((unsigned)(q2 & 255) << 16) | ((unsigned)q3 << 24); }
        *(GAS v4u*)(dst[u] + ((size_t)(lane >> 3) << 21) + 16 * (lane & 7)) = o;
        if (lane == 0) *scale_out[u] = sc; }
}
__device__ __forceinline__ void p0_table_trip(const Args& A, int r0, int NGW, int lane) {
    const float* src[4]; unsigned char* dst[4]; float* sco[4];
#pragma unroll
    for (int u = 0; u < 4; ++u) { int r = r0 + u * NGW; if (r >= 2 * PEXP) r = r0; const int tb = r / PEXP, e = r % PEXP;
        src[u] = (tb ? A.in[16] : A.in[15]) + (size_t)e * D; dst[u] = A.ws + (tb ? WS_V : WS_U) + (size_t)e * 128; sco[u] = (float*)(A.ws + (tb ? WS_V : WS_U) + 16 * MiB) + e; }
    const int tb0 = r0 / PEXP;
    if ((r0 + 3 * NGW) / PEXP == tb0 && r0 + 3 * NGW < 2 * PEXP) p0_table_rows4(src, dst, sco, tb0 ? 128 : 0, lane);
    else { for (int u = 0; u < 4; ++u) { const int r = r0 + u * NGW; if (r < 2 * PEXP) { const float* s1[4] = {src[u], src[u], src[u], src[u]}; unsigned char* d1[4] = {dst[u], dst[u], dst[u], dst[u]}; float* c1[4] = {sco[u], sco[u], sco[u], sco[u]}; p0_table_rows4(s1, d1, c1, (r / PEXP) ? 128 : 0, lane); } } }
}
template <int STAGE>
__device__ __forceinline__ void p0b_prologue(Frame& F, const Args& A) {
    const int gw = F.vcu * NWAVES + F.wave, NGW = F.G * NWAVES, lane = F.lane;
    const float* modp = (const float*)(A.ws + WS_MODP);
    LAS float* G1 = (LAS float*)(F.lds + 135168);
    if (STAGE == 0) { float* ks = (float*)(A.ws + WS_KSUM); for (int i = F.vcu * NTHREADS + F.tid; i < NB * NBLK * 512; i += F.G * NTHREADS) ks[i] = 0.f; }
    if (STAGE == 0) { for (int r = F.vcu; r < 256; r += F.G) p0_wp_task(F, A, r); }
    else { p0_wg_dot<1>(F, nullptr, modp, 0, A.in[5], INW, nullptr, (float*)(A.ws + WS_BIAS1P), F.vcu, 8 * (INW / 64));
           p0_wg_dot<1>(F, nullptr, modp, 3072, A.in[13], PQW, nullptr, (float*)(A.ws + WS_BIAS2P), F.vcu, 8 * (PQW / 64)); }
    LAS float* scr = (LAS float*)(F.lds + RING_OFF + F.wave * 16384);
    constexpr int I_MODF = 768, I_WIN = (D / 64) * (INW / 32), I_WA = (AW / 64) * (D / 32), I_WOUT = (D / 64) * (D / 32), I_WQ = (D / 64) * (PQW / 32);
    constexpr int I_SUBK = 64;
    constexpr int NITEMS = I_MODF + I_WIN + I_WA + I_WOUT + I_WQ + I_SUBK;
    for (int it = gw; it < NITEMS; it += NGW) {
        int r = it;
        if (r < I_MODF) { if (STAGE != 1) continue; const int idx = r * 64 + lane; ((float*)(A.ws + WS_MODF))[idx] = modp_sum(modp, idx); continue; } r -= I_MODF;
        if (r < I_WIN) { if (STAGE != 0) continue; p0_transpose_item(A.in[5], D, INW, (bf16*)(A.ws + WS_WIN), 0, scr, r, lane); continue; } r -= I_WIN;
        if (r < I_WA) { if (STAGE != 0) continue; p0_transpose_item(A.in[6], AW, D, (bf16*)(A.ws + WS_WA), 0, scr, r, lane); continue; } r -= I_WA;
        if (r < I_WOUT) { if (STAGE != 0) continue; p0_transpose_item(A.in[11], D, D, (bf16*)(A.ws + WS_WOUT), 0, scr, r, lane); continue; } r -= I_WOUT;
        if (r < I_WQ) { if (STAGE != 0) continue; p0_transpose_item(A.in[13], D, PQW, (bf16*)(A.ws + WS_WQ), 0, scr, r, lane); continue; } r -= I_WQ;
        if (r < I_SUBK) { if (STAGE != 0) continue; const float* s = A.in[14] + (size_t)r * 512 + 8 * lane; const f32x4 a = *(const f32x4*)s, b = *(const f32x4*)(s + 4);
            v4u o; o.x = pk2(a[0], a[1]); o.y = pk2(a[2], a[3]); o.z = pk2(b[0], b[1]); o.w = pk2(b[2], b[3]);
            *(GAS v4u*)((bf16*)(A.ws + WS_SUBK) + (size_t)r * 512 + 8 * lane) = o; continue; } r -= I_SUBK;
    }
    auto xg_rows = [&](const int rb) {
        const float* x = A.in[0]; bf16* XG = (bf16*)(A.ws + WS_XG); float* rstd1 = (float*)(A.ws + WS_RSTD1);
            for (int r0 = F.wave; r0 < 128; r0 += 4 * NWAVES) {
                f32x4 v[4][2][2]; float s[4];
#pragma unroll
                for (int u = 0; u < 4; ++u) { const float* xr = x + (size_t)(rb * 128 + r0 + u * NWAVES) * 1024;
#pragma unroll
                    for (int h = 0; h < 2; ++h)
#pragma unroll
                        for (int q = 0; q < 2; ++q) v[u][h][q] = __builtin_nontemporal_load((const f32x4*)(xr + h * 512 + 8 * lane + 4 * q)); }
#pragma unroll
                for (int u = 0; u < 4; ++u) { float t = 0.f;
#pragma unroll
                    for (int h = 0; h < 2; ++h)
#pragma unroll
                        for (int q = 0; q < 2; ++q) t += (v[u][h][q][0] * v[u][h][q][0] + v[u][h][q][1] * v[u][h][q][1]) + (v[u][h][q][2] * v[u][h][q][2] + v[u][h][q][3] * v[u][h][q][3]);
                    s[u] = t; }
#pragma unroll
                for (int o = 1; o < 64; o <<= 1) {
#pragma unroll
                    for (int u = 0; u < 4; ++u) s[u] += __shfl_xor(s[u], o); }
#pragma unroll
                for (int u = 0; u < 4; ++u) { const int row = rb * 128 + r0 + u * NWAVES;
                    if (lane == 0) rstd1[row] = 1.0f / sqrtf(s[u] * (1.0f / D) + RMS_EPS);
#pragma unroll
                    for (int h = 0; h < 2; ++h) { const LAS float* g = G1 + h * 512 + 8 * lane;
                        v4u o; o.x = pk2(v[u][h][0][0] * g[0], v[u][h][0][1] * g[1]); o.y = pk2(v[u][h][0][2] * g[2], v[u][h][0][3] * g[3]); o.z = pk2(v[u][h][1][0] * g[4], v[u][h][1][1] * g[5]); o.w = pk2(v[u][h][1][2] * g[6], v[u][h][1][3] * g[7]);
                        *(GAS v4u*)(XG + (size_t)row * 1024 + h * 512 + 8 * lane) = o; } }
            }
    };
#ifndef TABLES_IN_ROUTER
    if (STAGE == 0) { for (int r0 = gw; r0 < 2 * PEXP; r0 += 4 * NGW) p0_table_trip(A, r0, NGW, lane); }
    else
#else
    if (STAGE == 1)
#endif
    for (int rb = F.vcu; rb < T / 128; rb += F.G) {
        const float* g1 = A.in[4]; const int b = (rb * 128) / SEQ;
        __syncthreads();
        for (int k = F.tid; k < 1024; k += NTHREADS) G1[k] = g1[k] * (1.0f + modp_sum(modp, b * 6144 + 1024 + k));
        __syncthreads();
        xg_rows(rb);
    }

}
namespace attn_body {
using bf16=__hip_bfloat16;
using bf16x8=__attribute__((ext_vector_type(8)))short;
using s16x4=__attribute__((ext_vector_type(4)))short;
using f32x16=__attribute__((ext_vector_type(16)))float;
using u32x4=__attribute__((ext_vector_type(4)))unsigned;
constexpr int BATCH=8,NHEAD=8,SEQ=4096,D=64,DM=NHEAD*D;
constexpr int NW=8,QBLK=32,QB=QBLK*NW,KVBLK=64,NQB=SEQ/QB;
constexpr int ATTN_PITCH=DM, ATTN_UNIT_ROWS=QB;
__device__ __forceinline__ int crow(int r,int hi){return (r&3)+8*(r>>2)+4*hi;}
#define SBAR() __builtin_amdgcn_sched_barrier(0)
__device__ __forceinline__ void cmask(f32x16&p0,f32x16&p1,int jb,int qrel,int hi){
  const float NEG=-INFINITY; int kb=64*jb+4*hi;
  #pragma unroll
  for(int r=0;r<16;++r){int kv=kb+(r&3)+8*(r>>2); if(kv>qrel)p0[r]=NEG; if(kv+32>qrel)p1[r]=NEG;}
}

constexpr int NSLOT=3, SLOTB=8192;
constexpr int LDS_K=0, LDS_V=NSLOT*SLOTB, LDS_WS=2*NSLOT*SLOTB, LDS_OST=LDS_WS+NW*64*4, LDS_KSL=LDS_OST+NW*4096, LDS_BYTES=LDS_KSL+4096;
constexpr float C2=0.125f*1.4426950408889634f;
__device__ __forceinline__ void glds16(const void*sbase,unsigned voff,unsigned lds_dst){unsigned keep;
  asm volatile("s_mov_b32 %0, m0\n\ts_mov_b32 m0, %3\n\ts_nop 4\n\tglobal_load_lds_dwordx4 %1, %2\n\ts_mov_b32 m0, %0":"=&s"(keep):"v"(voff),"s"(sbase),"s"(lds_dst):"memory");}
__device__ __forceinline__ float max3f(float a,float b,float c){float r;asm("v_max3_f32 %0, %1, %2, %3":"=v"(r):"v"(a),"v"(b),"v"(c));return r;}
__device__ __forceinline__ float max2f(float a,float b){float r;asm("v_max_f32_e32 %0, %1, %2":"=v"(r):"v"(a),"v"(b));return r;}
__device__ __forceinline__ float fadd_s(float a,float b){float r;asm("v_add_f32_e32 %0, %1, %2":"=v"(r):"v"(a),"v"(b));return r;}
__device__ __forceinline__ float fsub_s(float a,float b){float r;asm("v_sub_f32_e32 %0, %1, %2":"=v"(r):"v"(a),"v"(b));return r;}
typedef float f32x2_t __attribute__((ext_vector_type(2))); typedef __bf16 bf16x2_t __attribute__((ext_vector_type(2)));
__device__ __forceinline__ unsigned cvtpk_s(float lo,float hi){f32x2_t v={lo,hi};bf16x2_t b=__builtin_convertvector(v,bf16x2_t);return __builtin_bit_cast(unsigned,b);}
#define WAIT_BAR(N) asm volatile("s_waitcnt vmcnt(" #N ") lgkmcnt(0)\n\ts_barrier":::"memory")

__device__ __forceinline__ void qkt(f32x16&p0,f32x16&p1,const char*Kslot,const bf16x8*qr,const f32x16&negm,int r32,int hi){
  const char*kb=Kslot+hi*1024+r32*16;
  #pragma unroll
  for(int d0=0;d0<4;++d0){
    const bf16x8 b0=*reinterpret_cast<const bf16x8*>(kb+d0*2048);
    const bf16x8 b1=*reinterpret_cast<const bf16x8*>(kb+d0*2048+512);
    if(d0==0){p0=__builtin_amdgcn_mfma_f32_32x32x16_bf16(b0,qr[0],negm,0,0,0);p1=__builtin_amdgcn_mfma_f32_32x32x16_bf16(b1,qr[0],negm,0,0,0);}
    else{p0=__builtin_amdgcn_mfma_f32_32x32x16_bf16(b0,qr[d0],p0,0,0,0);p1=__builtin_amdgcn_mfma_f32_32x32x16_bf16(b1,qr[d0],p1,0,0,0);}}
}
typedef __attribute__((address_space(3))) const char* lds_cptr;
typedef short v4i16_t __attribute__((ext_vector_type(4)));
__device__ __forceinline__ void kload8(bf16x8*kf,lds_cptr kp){
  kf[0]=*(const __attribute__((address_space(3))) bf16x8*)(kp);      kf[1]=*(const __attribute__((address_space(3))) bf16x8*)(kp+512);
  kf[2]=*(const __attribute__((address_space(3))) bf16x8*)(kp+2048); kf[3]=*(const __attribute__((address_space(3))) bf16x8*)(kp+2560);
  kf[4]=*(const __attribute__((address_space(3))) bf16x8*)(kp+4096); kf[5]=*(const __attribute__((address_space(3))) bf16x8*)(kp+4608);
  kf[6]=*(const __attribute__((address_space(3))) bf16x8*)(kp+6144); kf[7]=*(const __attribute__((address_space(3))) bf16x8*)(kp+6656);
}
__device__ __forceinline__ void kload2(bf16x8*kf,lds_cptr kp,int j){ kf[2*j]=*(const __attribute__((address_space(3))) bf16x8*)(kp+j*2048); kf[2*j+1]=*(const __attribute__((address_space(3))) bf16x8*)(kp+j*2048+512); }
__device__ __forceinline__ s16x4 vtr(lds_cptr p){ return __builtin_bit_cast(s16x4,__builtin_amdgcn_ds_read_tr16_b64_v4i16((__attribute__((address_space(3))) v4i16_t*)p)); }
__device__ __forceinline__ float rowmax(const f32x16&p0,const f32x16&p1){
  float a=max3f(p0[0],p0[1],p1[0]),b=max3f(p0[2],p0[3],p1[1]);a=max3f(a,p1[2],p1[3]);
  #pragma unroll
  for(int r=4;r<16;r+=4){a=max3f(a,p0[r],p0[r+1]);b=max3f(b,p0[r+2],p0[r+3]);a=max3f(a,p1[r],p1[r+1]);b=max3f(b,p1[r+2],p1[r+3]);}
  const float m=max2f(a,b);
  auto rr=__builtin_amdgcn_permlane32_swap(__float_as_uint(m),__float_as_uint(m),false,false);
  return max2f(__uint_as_float(rr[0]),__uint_as_float(rr[1]));
}
__device__ __forceinline__ void pv(f32x16*o,int vb,bf16x8 pa0,bf16x8 pa1,bf16x8 pa2,bf16x8 pa3){
  #pragma unroll
  for(int d0=0;d0<2;++d0){s16x4 lo[4],hi[4];
    #pragma unroll
    for(int ks=0;ks<4;++ks){
      asm volatile("ds_read_b64_tr_b16 %0,%1 offset:%c2":"=&v"(lo[ks]):"v"(vb),"i"(d0*4096+ks*1024):"memory");
      asm volatile("ds_read_b64_tr_b16 %0,%1 offset:%c2":"=&v"(hi[ks]):"v"(vb),"i"(d0*4096+ks*1024+512):"memory");}
    asm volatile("s_waitcnt lgkmcnt(0)":::"memory");SBAR();
    #define PK(k) (bf16x8){lo[k][0],lo[k][1],lo[k][2],lo[k][3],hi[k][0],hi[k][1],hi[k][2],hi[k][3]}
    o[d0]=__builtin_amdgcn_mfma_f32_32x32x16_bf16(pa0,PK(0),o[d0],0,0,0);
    o[d0]=__builtin_amdgcn_mfma_f32_32x32x16_bf16(pa1,PK(1),o[d0],0,0,0);
    o[d0]=__builtin_amdgcn_mfma_f32_32x32x16_bf16(pa2,PK(2),o[d0],0,0,0);
    o[d0]=__builtin_amdgcn_mfma_f32_32x32x16_bf16(pa3,PK(3),o[d0],0,0,0);
    #undef PK
  }
}

#ifndef ATTN_STORE16
#define ATTN_STORE16(p,v) (*(u32x4*)(p)=(v))
#endif
template<int THRL> __device__ __forceinline__ void attn_unit(int b,int h,int qb,const bf16*Q,const bf16*__restrict__ K,const bf16*__restrict__ V,bf16*O,const float*ksum,const float*nrm,char*shm){
  int tid_=threadIdx.x; asm volatile("":"+v"(tid_)); const int tid=tid_,lane=tid&63,r32=lane&31,hi=lane>>5; const int wid=__builtin_amdgcn_readfirstlane(tid>>6);
  const long rowbase=(long)b*SEQ; const int q0=qb*QB;
  const bf16*Qw=Q+(rowbase+q0+wid*QBLK)*DM+h*D;
  const bf16*Kh=K+rowbase*DM+h*D,*Vh=V+rowbase*DM+h*D;
  const unsigned lds0=(unsigned)(uintptr_t)shm;
  float*wsf=(float*)(shm+LDS_WS)+wid*64;
  const unsigned kvoff=(unsigned)(lane*DM+wid*8)*2u;
  const unsigned vvoff=(unsigned)((16*(wid&3)+(lane>>2))*DM+(wid>>2)*32+(lane&3)*8)*2u;
  const unsigned kdst=lds0+LDS_K+wid*1024, vdst=lds0+LDS_V+wid*1024;
  #define DMA_K(t,slot) glds16(Kh+(long)(NTF-1-(t))*KVBLK*DM,kvoff,(unsigned)__builtin_amdgcn_readfirstlane(kdst+(slot)))
  #define DMA_V(t,slot) glds16(Vh+(long)(NTF-1-(t))*KVBLK*DM,vvoff,(unsigned)__builtin_amdgcn_readfirstlane(vdst+(slot)))
  const int vb0=(int)(lds0+LDS_V)+((lane>>4)&1)*32+(lane&3)*8+(4*hi+((lane&15)>>2))*64;
  const char*Kbase=shm+LDS_K; bf16x8 kf[8];
  const lds_cptr shm3=(lds_cptr)shm; const lds_cptr kp0=shm3+LDS_K+hi*1024+r32*16; const lds_cptr vp0=shm3+LDS_V+((lane>>4)&1)*32+(lane&3)*8+(4*hi+((lane&15)>>2))*64;
  const int NTF=(q0+QB)/KVBLK;
  int NT=NTF;
  { const float*nq=nrm+(long)(b*2+0)*16+2*h,*nk=nrm+(long)(b*2+1)*16+2*h; const float B=__builtin_sqrtf((nq[0]+nq[1])*(nk[0]+nk[1]))*1.02f+0.5f;
    const float slope2_=__uint_as_float(0x3FB8AA3Bu-((unsigned)(h+1)<<23)); const float dh=(160.f+2.f*B)/slope2_;
    const float tminf=((float)(q0-63)-dh)*(1.f/64.f); int tmin=tminf>0.f?(int)tminf:0;
    tmin=__builtin_amdgcn_readfirstlane(tmin); int nt=NTF-tmin; nt+=nt&1; if(nt>NTF)nt=NTF; if(nt<4)nt=4; NT=nt; }
  { float*ksl=(float*)(shm+LDS_KSL); const float k0=ksum[(long)(b*16+(tid>>6))*512+h*64+(tid&63)],k1=ksum[(long)(b*16+8+(tid>>6))*512+h*64+(tid&63)]; ksl[tid]=k0; ksl[512+tid]=k1; }
  DMA_K(0,0);DMA_V(0,0);DMA_K(1,SLOTB);
  bf16x8 qr[4];
  #pragma unroll
  for(int d0=0;d0<4;++d0)qr[d0]=*reinterpret_cast<const bf16x8*>(&Qw[(long)r32*DM+d0*16+hi*8]);
  float mhat=0.f,l_reg=0.f;f32x16 o[2];o[0]=f32x16{};o[1]=f32x16{};const f32x16 zero16=f32x16{};
  const int qrel=wid*QBLK+r32;
  #define CMASK(P0,P1,t) do{int jb_=3-(t); if(jb_>=0)cmask(P0,P1,jb_,qrel,hi);}while(0)
  const unsigned sl2b=0x3FB8AA3Bu-((unsigned)(h+1)<<23);
  const float slope2=__uint_as_float(sl2b), s2x=__uint_as_float(sl2b+(1u<<23)), s8x=__uint_as_float(sl2b+(3u<<23)), s32=__uint_as_float(sl2b+(5u<<23));
  const float s3x=__uint_as_float((unsigned)__builtin_amdgcn_readfirstlane((int)__float_as_uint(slope2*3.0f)));
  #define NBSEL(r) (((r)>>2)==0?nbb0_:((r)>>2)==1?nbb1_:((r)>>2)==2?nbb2_:nbb3_)
  #define NEGV(r) ((((r)&3)==0)?NBSEL(r):(NBSEL(r)+(((r)&3)==1?slope2:((r)&3)==2?s2x:s3x)))
  #define NBB(nb) const float nbb0_=(nb), nbb1_=nbb0_+s8x, nbb2_=nbb1_+s8x, nbb3_=nbb2_+s8x
  #define NBSELC(r) (((r)>>2)==0?nbc0_:((r)>>2)==1?nbc1_:((r)>>2)==2?nbc2_:nbc3_)
  #define SAV(r) (((r)&3)==1?slope2:((r)&3)==2?s2x:s3x)
  #define BIAS(C0,C1,s) do{ NBB(NBV(s)); const float nbc0_=nbb0_+s32,nbc1_=nbb1_+s32,nbc2_=nbb2_+s32,nbc3_=nbb3_+s32; \
      _Pragma("unroll") for(int r=0;r<16;++r){ if((r&3)==0){C0[r]+=NBSEL(r);C1[r]+=NBSELC(r);} else {C0[r]=(C0[r]+NBSEL(r))+SAV(r);C1[r]=(C1[r]+NBSELC(r))+SAV(r);} } }while(0)
  unsigned sel=0u;
  #define NBV(s) ({ const int tl_=NTF-1-(s); const int tc_=tl_<0?0:tl_; const int bj_=tc_>>2; const float off_=(bj_>=qb||((sel>>bj_)&1u))?0.f:-1.0e30f; \
      __builtin_fmaf(slope2,(float)(64*tl_+4*hi-q0-qrel),off_-mhat); })
  #define CRC(r) ((float)(((r)&3)+8*((r)>>2)))
  bool resc=false;
  #define START(P0,P1) do{ const float rm=rowmax(P0,P1); resc=false; \
    { const float dl=(rm>-1.0e20f)?rm:0.f; mhat=fadd_s(mhat,dl); \
      _Pragma("unroll") for(int r=0;r<16;++r){P0[r]=fsub_s(P0[r],dl);P1[r]=fsub_s(P1[r],dl);} } \
    _Pragma("unroll") for(int r=0;r<16;++r)P0[r]=__builtin_amdgcn_exp2f(P0[r]); }while(0)
  #define RESC() do{ if(resc){ asm volatile("s_waitcnt lgkmcnt(0)":::"memory"); \
      _Pragma("unroll") for(int d_=0;d_<2;++d_) _Pragma("unroll") for(int r=0;r<16;++r)o[d_][r]*=wsf[crow(r,hi)]; } }while(0)
  f32x16 pA0,pA1,pB0,pB1;
  int sl_prev=0,sl_cur=0,sl_next=SLOTB;
  #define ROT() do{sl_prev=sl_cur;sl_cur=sl_next;sl_next=(sl_next==(NSLOT-1)*SLOTB)?0:sl_next+SLOTB;}while(0)
  DMA_K(2,2*SLOTB);
  WAIT_BAR(3);
  if(qb>0){
    float qf[32];
    _Pragma("unroll") for(int d0=0;d0<4;++d0) _Pragma("unroll") for(int e=0;e<8;++e) qf[d0*8+e]=__uint_as_float(((unsigned)(unsigned short)qr[d0][e])<<16);
    const float*ksl=(const float*)(shm+LDS_KSL)+8*hi;
    float b1=-3.0e38f,b2=-3.0e38f,b3=-3.0e38f; int i1=-1,i2=-1,i3=-1;
    for(int j=0;j<qb;++j){ float g=0.f;
      _Pragma("unroll") for(int d0=0;d0<4;++d0) _Pragma("unroll") for(int e=0;e<8;++e) g=__builtin_fmaf(qf[d0*8+e],ksl[j*64+16*d0+e],g);
      { auto rr=__builtin_amdgcn_permlane32_swap(__float_as_uint(g),__float_as_uint(g),false,false); g=__uint_as_float(rr[0])+__uint_as_float(rr[1]); }
      const bool c1=g>b1,c2=g>b2,c3=g>b3;
      b3=c2?b2:(c3?g:b3); i3=c2?i2:(c3?j:i3); b2=c1?b1:(c2?g:b2); i2=c1?i1:(c2?j:i2); b1=c1?g:b1; i1=c1?j:i1; }
    sel=(1u<<i1)|(i2>=0?(1u<<i2):0u)|(i3>=0?(1u<<i3):0u); }
  qkt(pA0,pA1,Kbase,qr,zero16,r32,hi);asm volatile("s_nop 15\n\ts_nop 7":"+v"(pA0),"+v"(pA1));
  BIAS(pA0,pA1,0);
  CMASK(pA0,pA1,0);
  START(pA0,pA1);
  _Pragma("unroll") for(int r=0;r<16;++r)pA1[r]=__builtin_amdgcn_exp2f(pA1[r]);
  WAIT_BAR(0);
  DMA_K(3,0);DMA_V(1,SLOTB);
  ROT();
  kload8(kf,kp0+sl_cur);
  WAIT_BAR(2);
  s16x4 vlo[8],vhi[8]; u32x4 pw0,pw1,pw2,pw3;
  #define PKW(P,B) cvtpk_s(P[B],P[B+1])
  #define PAF(k) __builtin_bit_cast(bf16x8,pw##k)
  #define VFR(i) (bf16x8){vlo[i][0],vlo[i][1],vlo[i][2],vlo[i][3],vhi[i][0],vhi[i][1],vhi[i][2],vhi[i][3]}
  #define PIN(x) asm volatile("":"+v"(x))
  #define MX3(a,b,c) __builtin_fmaxf(__builtin_fmaxf((a),(b)),(c))
  #define GAPA(MF,A0,A1,A2,A3,W0,W1,PW) do{ MF; sacc+=A0; sacc+=A1; sacc+=A2; sacc+=A3; PIN(sacc); W0; W1; PIN(PW); SBAR(); }while(0)
  #define EX(v) __builtin_amdgcn_exp2f(v)
  #define GAPB(MF,X,B) do{ MF; X[B]=EX(X[B]); X[B+1]=EX(X[B+1]); X[B+2]=EX(X[B+2]); X[B+3]=EX(X[B+3]); PIN(X); SBAR(); }while(0)
  #define VRD(i) do{ vlo[i]=vtr(vp_+(((i)>>2)*4096+((i)&3)*1024)); vhi[i]=vtr(vp_+(((i)>>2)*4096+((i)&3)*1024+512)); }while(0)
  #define KRD(G,j) do{ if(G){ kload2(kf,kp0+sl_next,j); SBAR(); } }while(0)
  #define STEP(C0,C1,P0,P1,t,GK,GV,GL) do{ SBAR(); \
    const lds_cptr vp_=vp0+sl_prev; \
    VRD(0); SBAR(); float sacc=(P0[0]+P0[1]); \
    GAPA(C0=__builtin_amdgcn_mfma_f32_32x32x16_bf16(kf[0],qr[0],zero16,0,0,0), P0[2],P0[3],P0[4],P0[5],     pw0[0]=PKW(P0,0), pw0[1]=PKW(P0,2), pw0); \
    VRD(4); SBAR(); GAPA(C1=__builtin_amdgcn_mfma_f32_32x32x16_bf16(kf[1],qr[0],zero16,0,0,0), P0[6],P0[7],P0[8],P0[9],     pw0[2]=PKW(P0,4), pw0[3]=PKW(P0,6), pw0); \
    VRD(1); SBAR(); GAPA(C0=__builtin_amdgcn_mfma_f32_32x32x16_bf16(kf[2],qr[1],C0,0,0,0),   P0[10],P0[11],P0[12],P0[13], pw1[0]=PKW(P0,8), pw1[1]=PKW(P0,10), pw1); \
    VRD(5); SBAR(); GAPA(C1=__builtin_amdgcn_mfma_f32_32x32x16_bf16(kf[3],qr[1],C1,0,0,0),   P0[14],P0[15],P1[0],P1[1],   pw1[2]=PKW(P0,12),pw1[3]=PKW(P0,14), pw1); \
    VRD(2); SBAR(); GAPA(C0=__builtin_amdgcn_mfma_f32_32x32x16_bf16(kf[4],qr[2],C0,0,0,0),   P1[2],P1[3],P1[4],P1[5],     pw2[0]=PKW(P1,0), pw2[1]=PKW(P1,2), pw2); \
    VRD(6); SBAR(); GAPA(C1=__builtin_amdgcn_mfma_f32_32x32x16_bf16(kf[5],qr[2],C1,0,0,0),   P1[6],P1[7],P1[8],P1[9],     pw2[2]=PKW(P1,4), pw2[3]=PKW(P1,6), pw2); \
    VRD(3); SBAR(); GAPA(C0=__builtin_amdgcn_mfma_f32_32x32x16_bf16(kf[6],qr[3],C0,0,0,0),   P1[10],P1[11],P1[12],P1[13], pw3[0]=PKW(P1,8), pw3[1]=PKW(P1,10), pw3); \
    VRD(7); SBAR(); GAPA(C1=__builtin_amdgcn_mfma_f32_32x32x16_bf16(kf[7],qr[3],C1,0,0,0),   P1[14],P1[15],0.f,0.f,       pw3[2]=PKW(P1,12),pw3[3]=PKW(P1,14), pw3); \
    l_reg+=sacc; \
    if(GK){DMA_K((t)+3,sl_cur);} if(GV){DMA_V((t)+1,sl_next);} \
    BIAS(C0,C1,t); \
    CMASK(C0,C1,t); \
    { float a=MX3(C0[0],C0[1],C1[0]),b=MX3(C0[2],C0[3],C1[1]); a=MX3(a,C1[2],C1[3]); \
      _Pragma("unroll") for(int r=4;r<16;r+=4){a=MX3(a,C0[r],C0[r+1]);b=MX3(b,C0[r+2],C0[r+3]);a=MX3(a,C1[r],C1[r+1]);b=MX3(b,C1[r+2],C1[r+3]);} \
      float rm=__builtin_fmaxf(a,b); { auto rr=__builtin_amdgcn_permlane32_swap(__float_as_uint(rm),__float_as_uint(rm),false,false); rm=__builtin_fmaxf(__uint_as_float(rr[0]),__uint_as_float(rr[1])); } \
      resc=false; \
      if(__builtin_expect(__any(rm>(float)THRL),0)){ const float dl=__builtin_fmaxf(rm,0.f); mhat+=dl; \
        _Pragma("unroll") for(int r=0;r<16;++r){C0[r]-=dl;C1[r]-=dl;} \
        const float f=__builtin_amdgcn_exp2f(-dl); l_reg*=f; if(hi==0)wsf[r32]=f; resc=true; } } \
    SBAR(); \
    GAPB(o[0]=__builtin_amdgcn_mfma_f32_32x32x16_bf16(PAF(0),VFR(0),o[0],0,0,0), C0,0); \
    GAPB(o[1]=__builtin_amdgcn_mfma_f32_32x32x16_bf16(PAF(0),VFR(4),o[1],0,0,0), C0,4); \
    KRD(GL,0); GAPB(o[0]=__builtin_amdgcn_mfma_f32_32x32x16_bf16(PAF(1),VFR(1),o[0],0,0,0), C0,8); \
    KRD(GL,1); GAPB(o[1]=__builtin_amdgcn_mfma_f32_32x32x16_bf16(PAF(1),VFR(5),o[1],0,0,0), C0,12); \
    KRD(GL,2); GAPB(o[0]=__builtin_amdgcn_mfma_f32_32x32x16_bf16(PAF(2),VFR(2),o[0],0,0,0), C1,0); \
    KRD(GL,3); GAPB(o[1]=__builtin_amdgcn_mfma_f32_32x32x16_bf16(PAF(2),VFR(6),o[1],0,0,0), C1,4); \
    GAPB(o[0]=__builtin_amdgcn_mfma_f32_32x32x16_bf16(PAF(3),VFR(3),o[0],0,0,0), C1,8); \
    GAPB(o[1]=__builtin_amdgcn_mfma_f32_32x32x16_bf16(PAF(3),VFR(7),o[1],0,0,0), C1,12); \
    }while(0)
  int t=1;
  #define ENDW(tt) do{ if((tt)+3<NT){WAIT_BAR(2);} else if((tt)+2<NT){WAIT_BAR(1);} else {WAIT_BAR(0);} }while(0)
  #define PEELED_PAIR() do{ \
    STEP(pB0,pB1,pA0,pA1,t,(t+3<NT),(t+1<NT),(t+1<NT));       ENDW(t);   RESC(); ROT(); \
    STEP(pA0,pA1,pB0,pB1,t+1,(t+4<NT),(t+2<NT),(t+2<NT));     ENDW(t+1); RESC(); ROT(); }while(0)
  for(;t<5&&t+1<NT;t+=2){ PEELED_PAIR(); }
  #undef CMASK
  #define CMASK(P0,P1,t) do{}while(0)
  for(;t+5<NT;t+=2){
    STEP(pB0,pB1,pA0,pA1,t,true,true,true);     WAIT_BAR(2); RESC(); ROT();
    STEP(pA0,pA1,pB0,pB1,t+1,true,true,true);   WAIT_BAR(2); RESC(); ROT();
  }
  #undef CMASK
  #define CMASK(P0,P1,t) do{int jb_=3-(t); if(jb_>=0)cmask(P0,P1,jb_,qrel,hi);}while(0)
  for(;t+1<NT;t+=2){ PEELED_PAIR(); }
  STEP(pB0,pB1,pA0,pA1,NT-1,false,false,false); RESC();
  { float sacc=pB0[0]+pB0[1]; _Pragma("unroll") for(int r=2;r<16;++r)sacc+=pB0[r]; _Pragma("unroll") for(int r=0;r<16;++r)sacc+=pB1[r]; l_reg+=sacc;
    pw0=(u32x4){PKW(pB0,0),PKW(pB0,2),PKW(pB0,4),PKW(pB0,6)};pw1=(u32x4){PKW(pB0,8),PKW(pB0,10),PKW(pB0,12),PKW(pB0,14)};pw2=(u32x4){PKW(pB1,0),PKW(pB1,2),PKW(pB1,4),PKW(pB1,6)};pw3=(u32x4){PKW(pB1,8),PKW(pB1,10),PKW(pB1,12),PKW(pB1,14)};
    SBAR(); pv(o,vb0+sl_cur,PAF(0),PAF(1),PAF(2),PAF(3)); }
  #undef PKW
  #undef PAF
  #undef VFR
  #undef PIN
  #undef MX3
  #undef GAPA
  #undef GAPB
  #undef EX
  #undef VRD
  #undef KRD
  #undef STEP
  #undef ENDW
  #undef PEELED_PAIR
  #undef NBV
  #undef CRC
  #undef NEGV
  #undef NBSEL
  #undef NBB
  #undef NBSELC
  #undef SAV
  #undef BIAS
  {auto rr=__builtin_amdgcn_permlane32_swap(__float_as_uint(l_reg),__float_as_uint(l_reg),false,false);l_reg=__uint_as_float(rr[0])+__uint_as_float(rr[1]);}
  if(hi==0)wsf[32+r32]=l_reg;asm volatile("s_waitcnt lgkmcnt(0)":::"memory");
  float rli[16];
  #pragma unroll
  for(int r=0;r<16;++r)rli[r]=__builtin_amdgcn_rcpf(wsf[32+crow(r,hi)]);
  bf16*Ow=O+(rowbase+q0+wid*QBLK)*DM+h*D;
  { bf16*stg=(bf16*)(shm+LDS_OST)+wid*2048;
    #pragma unroll
    for(int r=0;r<16;++r){const int orow=crow(r,hi);
      #pragma unroll
      for(int d0=0;d0<2;++d0)stg[orow*64+d0*32+r32]=__float2bfloat16(o[d0][r]*rli[r]);}
    asm volatile("s_waitcnt lgkmcnt(0)":::"memory");
    #pragma unroll
    for(int i=0;i<4;++i){const int row=i*8+(lane>>3),ch=lane&7; const u32x4 v=*(const u32x4*)(stg+row*64+ch*8); ATTN_STORE16(Ow+(long)row*DM+ch*8,v);} }
  asm volatile("s_waitcnt lgkmcnt(0)\n\ts_barrier":::"memory");
  #undef DMA_K
  #undef DMA_V
  #undef CMASK
  #undef START
  #undef RESC
  #undef ROT
}
constexpr int ATTN_LDS_BYTES=LDS_BYTES;
struct AttnTensors { const bf16* Q; const bf16* K; const bf16* V; bf16* O; };
struct AttnUnit { int bh; int qb; };
struct AttnPlan { unsigned char unit[32][12]; unsigned char n[32]; };
constexpr int attn_nominal_cost(int h,int qb){ const int pmax[8]={7,12,22,41,64,64,64,64}; const int past=4*qb<pmax[h]?4*qb:pmax[h]; return 4+past+2; }
constexpr AttnPlan make_attn_plan(){
  AttnPlan p{}; int load[32]={}; bool used[128]={};
  for(int it=0;it<128;++it){ int best=-1,bc=-1; for(int e=0;e<128;++e){ if(used[e])continue; const int c=attn_nominal_cost(e>>4,e&15); if(c>bc){bc=c;best=e;} }
    used[best]=true; int cu=0; for(int c=1;c<32;++c) if(load[c]<load[cu]||(load[c]==load[cu]&&p.n[c]<p.n[cu]))cu=c;
    if(p.n[cu]>=12){ for(int c=0;c<32;++c) if(p.n[c]<12){cu=c;break;} }
    p.unit[cu][p.n[cu]++]=(unsigned char)best; load[cu]+=bc; }
  return p; }
__device__ const AttnPlan g_attn_plan=make_attn_plan();
struct StaticOrder {
  int vcu,G;
  __device__ __forceinline__ explicit StaticOrder(int grid,int vcu_):vcu(vcu_),G(grid){}
  __device__ __forceinline__ bool next(int i,AttnUnit&u)const{
    if(G!=256){ const int id=vcu+i*G; if(id>=BATCH*NHEAD*NQB)return false; u.bh=id>>4; u.qb=id&15; return true; }
    const int c=vcu&31; if(i>=(int)g_attn_plan.n[c])return false; const int e=g_attn_plan.unit[c][i]; u.bh=(vcu>>5)*NHEAD+(e>>4); u.qb=e&15; return true; }
};
template<class Sched,int THRL=8> __device__ __forceinline__ void attn_phase(char*lds,const AttnTensors&T,const float*ksum,const float*nrm,const Sched&S){
  AttnUnit u;
  for(int i=0;S.next(i,u);++i){ attn_unit<THRL>(u.bh/NHEAD,u.bh%NHEAD,u.qb,T.Q,T.K,T.V,T.O,ksum,nrm,lds); }
}
#undef SBAR
#undef WAIT_BAR
}

__device__ __forceinline__ void pooled_phase(Frame& F, const Args& A) {
    const bf16* P = (const bf16*)(A.ws + WS_QKVP) + (size_t)3 * T * 512; bf16* PO = (bf16*)(A.ws + WS_POOLED);
    const int gw = F.vcu * NWAVES + F.wave, NGW = F.G * NWAVES, lane = F.lane, w = 2 << (lane >> 4);
    for (int tk = gw; tk < T / 16; tk += NGW) {
        const int row0 = tk * 16, s0 = row0 & (SEQ - 1);
        v4u rv[31];
#pragma unroll
        for (int i = 0; i < 31; ++i) { const int sidx = s0 - 15 + i; rv[i] = (sidx >= 0) ? *(const v4u*)(P + (size_t)(row0 - 15 + i) * 512 + 8 * lane) : (v4u){0u, 0u, 0u, 0u}; }
#pragma unroll
        for (int i = 0; i < 16; ++i) {
            const int sidx = s0 + i; float acc[8];
#pragma unroll
            for (int e = 0; e < 8; ++e) acc[e] = 0.f;
#pragma unroll
            for (int k = 0; k < 16; ++k) { const bool ok = (k < w) && (sidx - k >= 0); const v4u x = rv[15 + i - k]; const float msk = ok ? 1.0f : 0.0f;
                acc[0] += msk * bflo(x.x); acc[1] += msk * bfhi(x.x); acc[2] += msk * bflo(x.y); acc[3] += msk * bfhi(x.y); acc[4] += msk * bflo(x.z); acc[5] += msk * bfhi(x.z); acc[6] += msk * bflo(x.w); acc[7] += msk * bfhi(x.w); }
            const float inv = 1.0f / (float)min(sidx + 1, w); const v4u x = rv[15 + i];
            v4u o; o.x = pk2(acc[0] * inv - bflo(x.x), acc[1] * inv - bfhi(x.x)); o.y = pk2(acc[2] * inv - bflo(x.y), acc[3] * inv - bfhi(x.y));
            o.z = pk2(acc[4] * inv - bflo(x.z), acc[5] * inv - bfhi(x.z)); o.w = pk2(acc[6] * inv - bflo(x.w), acc[7] * inv - bfhi(x.w));
            *(v4u*)(PO + (size_t)(row0 + i) * 512 + 8 * lane) = o;
        }
    }
}

typedef float f32x2 __attribute__((ext_vector_type(2)));
typedef int v4i __attribute__((ext_vector_type(4)));
__device__ __forceinline__ void h2q_rows4(const Args& A, int t0, int lane) {
    const float* modf = (const float*)(A.ws + WS_MODF); const float* ss2 = (const float*)(A.ws + WS_SS2); const float* g2 = A.in[12];
    const int b = t0 / SEQ;
    f32x4 xv[4][4];
#pragma unroll
    for (int u = 0; u < 4; ++u)
#pragma unroll
        for (int q = 0; q < 4; ++q) xv[u][q] = *(const f32x4*)(A.out + (size_t)(t0 + u) * D + 16 * lane + 4 * q);
    f32x4 G[4], S[4];
#pragma unroll
    for (int q = 0; q < 4; ++q) { const int c = 16 * lane + 4 * q; G[q] = *(const f32x4*)(g2 + c) * (*(const f32x4*)(modf + (size_t)b * 6144 + 4096 + c) + 1.0f); S[q] = *(const f32x4*)(modf + (size_t)b * 6144 + 3072 + c); }
#pragma unroll
    for (int u = 0; u < 4; ++u) {
        const f32x4* sp = (const f32x4*)(ss2 + (size_t)(t0 + u) * 16); const f32x4 s4 = (sp[0] + sp[1]) + (sp[2] + sp[3]);
        const float rs = 1.0f / sqrtf(((s4[0] + s4[1]) + (s4[2] + s4[3])) * (1.0f / D) + RMS_EPS);
        float h2[16]; float am = 0.f;
#pragma unroll
        for (int q = 0; q < 4; ++q)
#pragma unroll
            for (int e = 0; e < 4; ++e) { const float h = xv[u][q][e] * rs * G[q][e] + S[q][e]; h2[4 * q + e] = h; am = fmaxf(am, fabsf(h)); }
        am = fmaxf(am, __shfl_xor(am, 1)); am = fmaxf(am, __shfl_xor(am, 2)); am = fmaxf(am, __shfl_xor(am, 4));
        const float hs = (am > 0.f) ? am * (1.0f / 127.0f) : 1.0f, hinv = 1.0f / hs;
        v4u o;
#pragma unroll
        for (int q = 0; q < 4; ++q) { const int q0 = (int)rintf(h2[4 * q] * hinv), q1 = (int)rintf(h2[4 * q + 1] * hinv), q2 = (int)rintf(h2[4 * q + 2] * hinv), q3 = (int)rintf(h2[4 * q + 3] * hinv);
            o[q] = (unsigned)(q0 & 255) | ((unsigned)(q1 & 255) << 8) | ((unsigned)(q2 & 255) << 16) | ((unsigned)q3 << 24); }
        *(v4u*)(A.ws + WS_H2Q + (size_t)(t0 + u) * D + 16 * lane) = o;
        if ((lane & 7) == 0) ((float*)(A.ws + WS_HS))[(size_t)(t0 + u) * 8 + (lane >> 3)] = hs;
    }
}

namespace rt {
typedef float f32x16 __attribute__((ext_vector_type(16)));
typedef short bf16x8 __attribute__((ext_vector_type(8)));
__device__ __forceinline__ void ce(float& hi, float& lo) { const float a = fmaxf(hi, lo), b = fminf(hi, lo); hi = a; lo = b; }
template <int N> __device__ __forceinline__ void sort_desc(float (&v)[N]) {
#pragma unroll
    for (int k = 2; k <= N; k <<= 1)
#pragma unroll
        for (int j = k >> 1; j > 0; j >>= 1)
#pragma unroll
            for (int i = 0; i < N; ++i) { const int l = i ^ j; if (l > i) { if ((i & k) == 0) ce(v[i], v[l]); else ce(v[l], v[i]); } }
}
template <int N> __device__ __forceinline__ void bitonic_merge_desc(float (&v)[N]) {
#pragma unroll
    for (int j = N >> 1; j > 0; j >>= 1)
#pragma unroll
        for (int i = 0; i < N; ++i) { const int l = i ^ j; if (l > i) ce(v[i], v[l]); }
}
__device__ __forceinline__ void merge_top16(float (&a)[16], const float (&b)[16]) {
#pragma unroll
    for (int i = 0; i < 16; ++i) a[i] = fmaxf(a[i], b[15 - i]);
    bitonic_merge_desc<16>(a);
}
template <bool SORT> __device__ __forceinline__ void pair_merge(float (&a)[16], bool hi) {
    float w[16];
#pragma unroll
    for (int i = 0; i < 16; ++i) w[i] = hi ? a[15 - i] : a[i];
#pragma unroll
    for (int i = 0; i < 16; ++i) { const auto rr = __builtin_amdgcn_permlane32_swap(__float_as_uint(w[i]), __float_as_uint(w[i]), false, false); a[i] = fmaxf(__uint_as_float(rr[0]), __uint_as_float(rr[1])); }
    if (SORT) bitonic_merge_desc<16>(a);
}
__device__ __forceinline__ void fold_tile(const f32x16& acc, int kt, int hi, float (&out)[16]) {
    float g[16];
#pragma unroll
    for (int r = 0; r < 16; ++r) { const unsigned key = (unsigned)(32 * kt + (r & 3) + 8 * (r >> 2)); g[r] = __uint_as_float((__float_as_uint(acc[r]) & ~127u) | key | ((unsigned)hi << 2)); }
    sort_desc<16>(g);
    if (kt == 0) {
#pragma unroll
        for (int r = 0; r < 16; ++r) out[r] = g[r];
    } else merge_top16(out, g);
}
}
__device__ __forceinline__ void router_phase(Frame& F, const Args& A) {
    using namespace rt;
    const bf16* QP = (const bf16*)(A.ws + WS_GAB); const bf16* SK = (const bf16*)(A.ws + WS_SUBK);
    unsigned short* IDX = (unsigned short*)(A.ws + WS_POOLED); float* GATE = (float*)(A.ws + WS_POOLED + 16 * MiB);
    const int lane = F.lane, n32 = lane & 31, hi = lane >> 5, gw = F.vcu * NWAVES + F.wave, NGW = F.G * NWAVES;
    __syncthreads();
    for (int i = F.tid; i < 2 * 128 * 16; i += NTHREADS) { const int r = i >> 4, ch = i & 15; *(LAS v4u*)(F.lds + r * 272 + ch * 16) = *(const v4u*)(SK + (size_t)r * 128 + ch * 8); }
    __syncthreads();
    LAS unsigned char* scr = F.lds + 73728 + F.wave * 1024;
    const LAS unsigned char* afrag = F.lds + n32 * 272 + hi * 16;
    bf16x8 qa[8], qb[8];
#define RT_QLOAD(task_, p_, q_) do { const int tq_ = (task_) * 4 + (n32 >> 3); const bf16* qr_ = QP + (size_t)tq_ * PQW + (n32 & 7) * 256 + (p_) * 128 + 8 * hi; \
        _Pragma("unroll") for (int i = 0; i < 8; ++i) q_[i] = __builtin_nontemporal_load((const bf16x8*)(qr_ + 16 * i)); } while (0)
#define RT_HALF(p_, q_, out_) do { _Pragma("unroll") for (int kt = 0; kt < 4; ++kt) { f32x16 acc = f32x16{}; \
        _Pragma("unroll") for (int ks = 0; ks < 8; ++ks) { const bf16x8 kf = *(const LAS bf16x8*)(afrag + ((p_) * 128 + 32 * kt) * 272 + 32 * ks); acc = __builtin_amdgcn_mfma_f32_32x32x16_bf16(kf, q_[ks], acc, 0, 0, 0); } \
        fold_tile(acc, kt, hi, out_); } pair_merge<true>(out_, hi != 0); } while (0)
    if (gw < T * PHEADS / 32) RT_QLOAD(gw, 0, qa);
#ifdef TABLES_IN_ROUTER
    int tr0 = gw; const bool late_trip = F.wave >= 4;
#define RT_TABLE_TRIP(cond_) do { if (cond_) { asm volatile("" ::: "memory"); if (tr0 < 2 * PEXP) { p0_table_trip(A, tr0, NGW, lane); tr0 += 4 * NGW; } asm volatile("" ::: "memory"); h2q_rows4(A, task * 4, lane); asm volatile("" ::: "memory"); } } while (0)
#else
#define RT_TABLE_TRIP(cond_) do { } while (0)
#endif
    for (int task = gw; task < T * PHEADS / 32; task += NGW) {
        const int t = task * 4 + (n32 >> 3), h = n32 & 7;
        float la[16], lb[16];
        RT_TABLE_TRIP(!late_trip);
        RT_QLOAD(task, 1, qb);
        RT_HALF(0, qa, la);
        { const int nxt = task + NGW; if (nxt < T * PHEADS / 32) RT_QLOAD(nxt, 0, qa); }
        RT_HALF(1, qb, lb);
        { unsigned w[4];
#pragma unroll
          for (int q = 0; q < 4; ++q) {
              const unsigned i0 = __float_as_uint(hi ? lb[4 * q] : la[4 * q]) & 127u, i1 = __float_as_uint(hi ? lb[4 * q + 1] : la[4 * q + 1]) & 127u, i2 = __float_as_uint(hi ? lb[4 * q + 2] : la[4 * q + 2]) & 127u, i3 = __float_as_uint(hi ? lb[4 * q + 3] : la[4 * q + 3]) & 127u;
              w[q] = i0 | (i1 << 8) | (i2 << 16) | (i3 << 24); }
          *(LAS v4u*)(scr + n32 * 32 + hi * 16) = (v4u){w[0], w[1], w[2], w[3]}; }
        float x[16], y[16];
#pragma unroll
        for (int i = 0; i < 16; ++i) { const float av = __uint_as_float(__float_as_uint(la[i]) & ~127u), bv = __uint_as_float(__float_as_uint(lb[i]) & ~127u); x[i] = hi ? bv : av; y[i] = hi ? av : bv; }
        float c0[16], c1[16];
        {
            const unsigned hb = (unsigned)hi << 8;
#define RT_CAND(i, j) __uint_as_float(((__float_as_uint(x[i] + y[j]) & ~511u) | (unsigned)((i) * 16 + (j))) | hb)
#define RT_DIAG(i) (hi ? -3.0e38f : RT_CAND(i, i))
            c0[0] = RT_DIAG(0);
#pragma unroll
            for (int j = 1; j < 16; ++j) c0[j] = RT_CAND(0, j);
            c1[0] = RT_DIAG(1);
#pragma unroll
            for (int j = 2; j < 8; ++j) c1[j - 1] = RT_CAND(1, j);
            c1[7] = RT_DIAG(2); c1[8] = RT_CAND(2, 3); c1[9] = RT_CAND(2, 4); c1[10] = RT_DIAG(3);
#pragma unroll
            for (int k = 11; k < 16; ++k) c1[k] = -3.0e38f;
#undef RT_CAND
#undef RT_DIAG
        }
        sort_desc<16>(c0); sort_desc<16>(c1); merge_top16(c0, c1);
        pair_merge<false>(c0, hi != 0);
        float mx = c0[0];
#pragma unroll
        for (int i = 1; i < 16; ++i) mx = fmaxf(mx, c0[i]);
        float ex[16], sm = 0.f;
#pragma unroll
        for (int i = 0; i < 16; ++i) { ex[i] = __expf(__uint_as_float(__float_as_uint(c0[i]) & ~511u) - mx); sm += ex[i]; }
        const float inv = 1.0f / sm;
        asm volatile("s_waitcnt lgkmcnt(0)" ::: "memory");
        int eo[8]; float go[8];
#pragma unroll
        for (int k = 0; k < 8; ++k) { const float wv = hi ? c0[8 + k] : c0[k]; go[k] = (hi ? ex[8 + k] : ex[k]) * inv;
            const unsigned bits = __float_as_uint(wv), fromhi = (bits >> 8) & 1u, xi = (bits >> 4) & 15u, yj = bits & 15u;
            const unsigned ar = fromhi ? yj : xi, br = fromhi ? xi : yj;
            const unsigned e1 = scr[n32 * 32 + ar], e2 = scr[n32 * 32 + 16 + br];
            eo[k] = (int)(e1 * 128u + e2); }
        unsigned short* ip = IDX + (size_t)t * PSEL + h * PTOP + 8 * hi; float* gp = GATE + (size_t)t * PSEL + h * PTOP + 8 * hi;
        *(v4u*)ip = (v4u){(unsigned)eo[0] | ((unsigned)eo[1] << 16), (unsigned)eo[2] | ((unsigned)eo[3] << 16), (unsigned)eo[4] | ((unsigned)eo[5] << 16), (unsigned)eo[6] | ((unsigned)eo[7] << 16)};
        *(f32x4*)gp = (f32x4){go[0], go[1], go[2], go[3]}; *(f32x4*)(gp + 4) = (f32x4){go[4], go[5], go[6], go[7]};
        asm volatile("s_waitcnt lgkmcnt(0)" ::: "memory");
        RT_TABLE_TRIP(late_trip);
    }
#ifdef TABLES_IN_ROUTER
    while (tr0 < 2 * PEXP) { p0_table_trip(A, tr0, NGW, lane); tr0 += 4 * NGW; }
#endif
#undef RT_TABLE_TRIP
#undef RT_QLOAD
#undef RT_HALF
    __syncthreads();
}

__device__ __forceinline__ float gelu_tanh(float x) { const float u = 0.7978845608028654f * (x + 0.044715f * x * x * x); return x / (1.0f + __expf(-2.0f * u)); }
__device__ __forceinline__ void peer_sliced_phase(Frame& F, const Args& A) {
    const int lane = F.lane, c8 = lane & 7, g8 = lane >> 3, gw = F.vcu * NWAVES + F.wave, NGW = F.G * NWAVES;
    const float* modf = (const float*)(A.ws + WS_MODF);
    const unsigned char* U8 = A.ws + WS_U; const unsigned char* V8 = A.ws + WS_V;
    const float* SU = (const float*)(A.ws + WS_U + 16 * MiB); const float* SV = (const float*)(A.ws + WS_V + 16 * MiB);
    const unsigned short* IDX = (const unsigned short*)(A.ws + WS_POOLED); const float* GATE = (const float*)(A.ws + WS_POOLED + 16 * MiB);
    const float* gf = A.in[17];
    LAS float* AL = (LAS float*)(F.lds + F.wave * 17664);
    LAS float* SSQ = AL + 2048;
    LAS float* SAV = AL + 3072;
    LAS float* RS2 = AL + 3088;
    LAS float* GS = AL + 3104;
    LAS unsigned short* IDL = (LAS unsigned short*)(AL + 3360);
    for (int tb = gw * 16; tb < T; tb += NGW * 16) {
        for (int i = lane; i < 2048; i += 64) AL[i] = 0.f;
        for (int i = lane; i < 1024; i += 64) SSQ[i] = 0.f;
#pragma unroll
        for (int i = 0; i < 16; ++i) *(LAS unsigned*)(IDL + i * 128 + 2 * lane) = *(const unsigned*)(IDX + (size_t)(tb + i) * PSEL + 2 * lane);
        LDS_WAIT();
        {
            v4i W0[16], W1[16], H0, H1, H; float hs0, hs1, hs;
            const unsigned char* H2Q = A.ws + WS_H2Q; const float* HS = (const float*)(A.ws + WS_HS);
#define PU_X(k, Hx, hx) do { const int k_ = (k) < 128 ? (k) : 127; const int s_ = k_ >> 4, t_ = tb + (k_ & 15); Hx = *(const v4i*)(H2Q + (size_t)t_ * D + 128 * s_ + 16 * c8); hx = HS[(size_t)t_ * 8 + s_]; } while (0)
#define PU_B(k, W) do { const int k_ = (k) < 128 ? (k) : 127; const int s_ = k_ >> 4; const unsigned base_ = ((unsigned)s_ << 21) + 16u * (unsigned)c8; v4u I[2]; I[0] = *(const LAS v4u*)(IDL + (k_ & 15) * 128 + 16 * g8); I[1] = *(const LAS v4u*)(IDL + (k_ & 15) * 128 + 16 * g8 + 8); \
            _Pragma("unroll") for (int j = 0; j < 16; ++j) W[j] = *(const v4i*)(U8 + (base_ + (((I[j >> 3][(j >> 1) & 3] >> (16 * (j & 1))) & 0xffffu) << 7))); \
            } while (0)
#define PU_Q(k, Hx, hx) do { H = Hx; hs = hx; } while (0)
#define PU_C(k, W) do { int part[16]; \
            _Pragma("unroll") for (int j = 0; j < 16; ++j) part[j] = __builtin_amdgcn_sdot4(W[j].x, H.x, __builtin_amdgcn_sdot4(W[j].y, H.y, __builtin_amdgcn_sdot4(W[j].z, H.z, __builtin_amdgcn_sdot4(W[j].w, H.w, 0, false), false), false), false); \
            _Pragma("unroll") for (int step = 4; step >= 1; step >>= 1) { const bool up = (lane & step) != 0; \
                _Pragma("unroll") for (int i = 0; i < 2 * step; ++i) { const int send = up ? part[i] : part[i + 2 * step], keep = up ? part[i + 2 * step] : part[i]; part[i] = keep + __shfl_xor(send, step); } } \
            LAS f32x2* ap_ = (LAS f32x2*)(AL + ((k) & 15) * 128 + 2 * lane); f32x2 a_ = *ap_; a_.x += hs * (float)part[0]; a_.y += hs * (float)part[1]; *ap_ = a_; } while (0)
            PU_X(0, H0, hs0); PU_X(1, H1, hs1); PU_B(0, W0);
#pragma unroll 1
            for (int k = 0; k < 128; k += 2) {
                PU_Q(k, H0, hs0); PU_B(k + 1, W1); PU_X(k + 2, H0, hs0);
                PU_C(k, W0);
                PU_Q(k + 1, H1, hs1); PU_B(k + 2, W0); PU_X(k + 3, H1, hs1);
                PU_C(k + 1, W1);
            }
#undef PU_X
#undef PU_B
#undef PU_Q
#undef PU_C
        }
        LDS_WAIT();
#pragma unroll 4
        for (int i = 0; i < 16; ++i) {
            const int t = tb + i; const unsigned e01 = *(const LAS unsigned*)(IDL + i * 128 + 2 * lane); const int e0 = (int)(e01 & 0xffffu), e1 = (int)(e01 >> 16);
            const f32x2 gt = *(const f32x2*)(GATE + (size_t)t * PSEL + 2 * lane); const f32x2 a = *(LAS f32x2*)(AL + i * 128 + 2 * lane);
            f32x2 av; av.x = gelu_tanh(a.x * SU[e0]) * gt.x * SV[e0]; av.y = gelu_tanh(a.y * SU[e1]) * gt.y * SV[e1];
            *(LAS f32x2*)(AL + i * 128 + 2 * lane) = av;
            const float sm = wave_sum(av.x + av.y); if (lane == 0) SAV[i] = 128.0f * sm;
        }
        LDS_WAIT();
        {
            v4u W0[16], W1[16]; f32x2 X0, X1, gt2v = (f32x2){0.f, 0.f};
            const int b = tb / SEQ;
#define PV_B(k, W, X) do { const int k_ = (k) < 128 ? (k) : 127; const int s_ = k_ >> 4, t_ = tb + (k_ & 15); const unsigned base_ = ((unsigned)s_ << 21) + 16u * (unsigned)c8; v4u I[2]; I[0] = *(const LAS v4u*)(IDL + (k_ & 15) * 128 + 16 * g8); I[1] = *(const LAS v4u*)(IDL + (k_ & 15) * 128 + 16 * g8 + 8); \
            _Pragma("unroll") for (int j = 0; j < 16; ++j) W[j] = *(const v4u*)(V8 + (base_ + (((I[j >> 3][(j >> 1) & 3] >> (16 * (j & 1))) & 0xffffu) << 7))); \
            X = __builtin_nontemporal_load((const f32x2*)(A.out + (size_t)t_ * D + 128 * s_ + 16 * c8 + 2 * g8)); } while (0)
#define PV_C(k, W, X) do { const int s_ = (k) >> 4, i_ = (k) & 15; \
            if (i_ == 0) gt2v = *(const f32x2*)(modf + (size_t)b * 6144 + 5120 + 128 * s_ + 16 * c8 + 2 * g8); \
            f32x2 acc[8]; _Pragma("unroll") for (int q = 0; q < 8; ++q) acc[q] = (f32x2){0.f, 0.f}; \
            const LAS f32x4* avp_ = (const LAS f32x4*)(AL + i_ * 128 + 16 * g8); \
            _Pragma("unroll") for (int q4 = 0; q4 < 4; ++q4) { const f32x4 a4 = avp_[q4]; \
                _Pragma("unroll") for (int e = 0; e < 4; ++e) { const float a = a4[e]; const v4u w = W[4 * q4 + e]; \
                    acc[0] += (f32x2){(float)(w.x & 255u), (float)((w.x >> 8) & 255u)} * a; acc[1] += (f32x2){(float)((w.x >> 16) & 255u), (float)(w.x >> 24)} * a; \
                    acc[2] += (f32x2){(float)(w.y & 255u), (float)((w.y >> 8) & 255u)} * a; acc[3] += (f32x2){(float)((w.y >> 16) & 255u), (float)(w.y >> 24)} * a; \
                    acc[4] += (f32x2){(float)(w.z & 255u), (float)((w.z >> 8) & 255u)} * a; acc[5] += (f32x2){(float)((w.z >> 16) & 255u), (float)(w.z >> 24)} * a; \
                    acc[6] += (f32x2){(float)(w.w & 255u), (float)((w.w >> 8) & 255u)} * a; acc[7] += (f32x2){(float)((w.w >> 16) & 255u), (float)(w.w >> 24)} * a; } } \
            float pc[16]; _Pragma("unroll") for (int q = 0; q < 8; ++q) { pc[2 * q] = acc[q].x; pc[2 * q + 1] = acc[q].y; } \
            _Pragma("unroll") for (int step = 4; step >= 1; step >>= 1) { const bool up = (g8 & step) != 0; \
                _Pragma("unroll") for (int i = 0; i < 2 * step; ++i) { const float send = up ? pc[i] : pc[i + 2 * step], keep = up ? pc[i + 2 * step] : pc[i]; pc[i] = keep + __shfl_xor(send, 8 * step); } } \
            const float sav_ = SAV[i_]; f32x2 x2_; x2_.x = X.x + gt2v.x * (pc[0] - sav_); x2_.y = X.y + gt2v.y * (pc[1] - sav_); \
            *(f32x2*)(A.out + (size_t)(tb + i_) * D + 128 * s_ + 16 * c8 + 2 * g8) = x2_; \
            SSQ[i_ * 64 + lane] += x2_.x * x2_.x + x2_.y * x2_.y; } while (0)
            PV_B(0, W0, X0);
#pragma unroll 1
            for (int k = 0; k < 128; k += 2) {
                PV_B(k + 1, W1, X1);
                PV_C(k, W0, X0);
                PV_B(k + 2, W0, X0);
                PV_C(k + 1, W1, X1);
            }
#undef PV_B
#undef PV_C
        }
        VM_WAIT(); LDS_WAIT();
#pragma unroll 2
        for (int i = 0; i < 16; ++i) {
            float* xr = A.out + (size_t)(tb + i) * D + 16 * lane;
            f32x4 v[4];
#pragma unroll
            for (int q = 0; q < 4; ++q) v[q] = __builtin_nontemporal_load((const f32x4*)(xr + 4 * q));
            const float rs = 1.0f / sqrtf(wave_sum(SSQ[i * 64 + lane]) * (1.0f / D) + RMS_EPS);
#pragma unroll
            for (int q = 0; q < 4; ++q) *(f32x4*)(xr + 4 * q) = v[q] * rs * *(const f32x4*)(gf + 16 * lane + 4 * q);
        }
        LDS_WAIT();
    }
}

#ifndef PHASE_ONLY
#define PHASE_ONLY -1
#endif
#ifndef PHASE_SKIP
#define PHASE_SKIP -2
#endif
#define PH(n) ((PHASE_ONLY < 0 || PHASE_ONLY == (n)) && PHASE_SKIP != (n))
#ifndef PROBE_DOUBLE
#define PROBE_DOUBLE -1
#endif
#define REPS(n) for (int rep_ = 0; rep_ < ((PROBE_DOUBLE == (n)) ? 2 : 1); ++rep_)
__global__ void __launch_bounds__(NTHREADS, 2) fwd_megakernel(Args A) {
    extern __shared__ __attribute__((aligned(16))) unsigned char lds[];
    Frame F;
    F.lds = (LAS unsigned char*)lds;
    F.MISC = (volatile LAS unsigned*)(F.lds + MISC_OFF);
    F.tid = threadIdx.x; F.lane = F.tid & 63; F.wave = __builtin_amdgcn_readfirstlane(F.tid >> 6);
    F.G = gridDim.x; { const int bx = blockIdx.x; F.vcu = (F.G % 8 == 0) ? (bx % 8) * (F.G / 8) + bx / 8 : bx; }
    F.ctl = (gu32*)(A.ws + WS_CTL);
    for (int u = F.tid; u < (LDS_BYTES - LDSCTL_OFF) / 4; u += NTHREADS) ((LAS unsigned*)(F.lds + LDSCTL_OFF))[u] = 0u;
    __syncthreads();
    XcdBarrier bar = xcd_barrier_post((unsigned*)(F.ctl + CW_BAR), F.MISC + 8);
#define GRID_BAR() do { xcd_barrier(bar); int t_ = threadIdx.x; asm volatile("" : "+v"(t_)); F.tid = t_; F.lane = t_ & 63; F.wave = __builtin_amdgcn_readfirstlane(t_ >> 6); } while (0)
    unsigned char* ws = A.ws;

    REPS(0) if (PH(0)) { p0a_mod(F, A); p0b_prologue<0>(F, A); }
    GRID_BAR();
    REPS(1) if (PH(1)) p0b_prologue<1>(F, A);
    GRID_BAR();
    REPS(2) if (PH(2)) {
        pg8::Gemm g{(const bf16*)(ws + WS_XG), nullptr, (const bf16*)(ws + WS_WIN), nullptr, D, D, D};
        pg8::StaticOrder S; S.init(T, INW, F.G, (int)blockIdx.x);
        pg8::EpiIn E{(bf16*)(ws + WS_QKVP), (bf16*)(ws + WS_GAB), (const float*)(ws + WS_RSTD1), (const float*)(ws + WS_BIAS1P), (float*)(ws + WS_KSUM), (unsigned*)(ws + WS_CTL) + CW_NRM};
        pg8::gemm_phase<pg8::EpiIn, pg8::StaticOrder, true, true>(F.lds + RING_OFF, g, S, E);
    }
    GRID_BAR();
    REPS(3) if (PH(3)) {
        const attn_body::AttnTensors AT{(const attn_body::bf16*)(ws + WS_QKVP), (const attn_body::bf16*)(ws + WS_QKVP) + (size_t)T * 512, (const attn_body::bf16*)(ws + WS_QKVP) + (size_t)2 * T * 512, (PROBE_DOUBLE == 3 && rep_ == 0) ? (attn_body::bf16*)(ws + WS_XG) : (attn_body::bf16*)(ws + WS_QKVP)};
        const attn_body::StaticOrder S((int)F.G, F.vcu);
        attn_body::attn_phase<attn_body::StaticOrder>((char*)lds + RING_OFF, AT, (const float*)(ws + WS_KSUM), (const float*)((const unsigned*)(ws + WS_CTL) + CW_NRM), S);
    }
    REPS(4) if (PH(4)) pooled_phase(F, A);
    GRID_BAR();
    REPS(5) if (PH(5)) {
        pg8::Gemm g{(const bf16*)(ws + WS_QKVP), (const bf16*)(ws + WS_POOLED), (const bf16*)(ws + WS_WA), (const bf16*)(ws + WS_WP), AW, AW, AW};
        pg8::DualOrder S; S.init(T, D, F.G, (int)blockIdx.x);
        pg8::EpiUp E{(bf16*)(ws + WS_XG), (const bf16*)(ws + WS_GAB), (const float*)(ws + WS_BPRIME)};
        pg8::gemm_phase<pg8::EpiUp, pg8::DualOrder, true, true>(F.lds + RING_OFF, g, S, E);
    }
    GRID_BAR();
    REPS(6) if (PH(6)) {
        pg8::Gemm g{(const bf16*)(ws + WS_XG), nullptr, (const bf16*)(ws + WS_WOUT), nullptr, D, D, D};
        pg8::StaticOrder S; S.init(T, D, F.G, (int)blockIdx.x);
        pg8::EpiOut E{A.in[0], A.out, (bf16*)(ws + WS_QKVP), (const float*)(ws + WS_MODF), A.in[12], (float*)(ws + WS_SS2)};
        pg8::gemm_phase<pg8::EpiOut, pg8::StaticOrder, true, true>(F.lds + RING_OFF, g, S, E);
    }
    GRID_BAR();
    REPS(7) if (PH(7)) {
        pg8::Gemm g{(const bf16*)(ws + WS_QKVP), nullptr, (const bf16*)(ws + WS_WQ), nullptr, D, D, D};
        pg8::StaticOrder S; S.init(T, PQW, F.G, (int)blockIdx.x);
        pg8::EpiPq E{(bf16*)(ws + WS_GAB), (const float*)(ws + WS_SS2), (const float*)(ws + WS_BIAS2P)};
        pg8::gemm_phase<pg8::EpiPq, pg8::StaticOrder, true, true>(F.lds + RING_OFF, g, S, E);
    }
    GRID_BAR();
    REPS(8) if (PH(8)) router_phase(F, A);
    GRID_BAR();
    if (PH(9)) peer_sliced_phase(F, A);
}

extern "C" void kernel_launch(void* const* d_in, const int* in_sizes, int n_in, void* d_out, int out_size, void* d_ws, size_t ws_size, hipStream_t stream) {
    static int grid = 0;
    if (grid == 0) {
        if (n_in != 18 || in_sizes[0] != T * D || out_size != T * D || ws_size < WS_END) { fprintf(stderr, "kernel_launch: unexpected shapes (n_in %d, in0 %d, out %d, ws %zu); nothing launched\n", n_in, n_in > 0 ? in_sizes[0] : -1, out_size, ws_size); grid = -1; return; }
        int dev = 0, cus = 0, per_cu = 0;
        if (hipGetDevice(&dev) != hipSuccess || hipDeviceGetAttribute(&cus, hipDeviceAttributeMultiprocessorCount, dev) != hipSuccess) { grid = -1; return; }
        if (hipFuncSetAttribute((const void*)fwd_megakernel, hipFuncAttributeMaxDynamicSharedMemorySize, LDS_BYTES) != hipSuccess) { fprintf(stderr, "kernel_launch: hipFuncSetAttribute failed\n"); grid = -1; return; }
        if (hipOccupancyMaxActiveBlocksPerMultiprocessor(&per_cu, (const void*)fwd_megakernel, NTHREADS, LDS_BYTES) != hipSuccess || per_cu < 1) { fprintf(stderr, "kernel_launch: occupancy query reports %d workgroups per CU\n", per_cu); per_cu = 1; }
        (void)hipGetLastError();
        grid = cus;
    }
    if (grid < 0) return;
    if (hipMemsetAsync((char*)d_ws + WS_CTL, 0, CTL_ZERO_BYTES, stream) != hipSuccess) { fprintf(stderr, "kernel_launch: hipMemsetAsync failed\n"); return; }
    Args a{};
    for (int i = 0; i < 18; ++i) a.in[i] = (const float*)d_in[i];
    a.out = (float*)d_out; a.ws = (unsigned char*)d_ws;
    void* kargs[] = {&a};
    hipError_t e = hipLaunchCooperativeKernel((const void*)fwd_megakernel, dim3(grid), dim3(NTHREADS), kargs, LDS_BYTES, stream);
    if (e != hipSuccess) fprintf(stderr, "kernel_launch: cooperative launch failed: %s (grid %d)\n", hipGetErrorString(e), grid);
}
```

```cpp
#define TABLES_IN_ROUTER 1
#include <hip/hip_runtime.h>
#include <hip/hip_bf16.h>
#include <cstdio>
#include <cstdint>
#include <cmath>

constexpr int NB = 8, SEQ = 4096, T = NB * SEQ, D = 1024;
constexpr int AW = 512, PW = 512, INW = 4096;
constexpr int NH = 8, HD = 64, MBLK = 256, NBLK = SEQ / MBLK;
constexpr int PQW = 2048, PEXP = 16384, PTOP = 16, PHEADS = 8, PSEL = PHEADS * PTOP;
constexpr float RMS_EPS = 1e-6f;
constexpr float LOG2E = 1.4426950408889634f;
constexpr float QSCALE = 0.125f * LOG2E;
constexpr int NWAVES = 8, NTHREADS = 512;

namespace pg8 {
#define PG8_LAS __attribute__((address_space(3)))
typedef unsigned short bf16_t;
typedef short bf16x8 __attribute__((ext_vector_type(8)));
typedef float f32x4 __attribute__((ext_vector_type(4)));
typedef unsigned u32x4 __attribute__((ext_vector_type(4)));
constexpr int BM = 256, BK = 64, HALF = 128, HTB = HALF * BK * 2  , STAGE_BYTES = 8 * HTB, NXCD = 8, WGM = 8;

__host__ __device__ __forceinline__ int lds_byte(int r, int c) { const int st = (r >> 4) * 2 + (c >> 5), rr = r & 15, cc = c & 31, ob = rr * 64 + cc * 2; return st * 1024 + (ob ^ (((ob >> 9) & 1) << 5)); }
__host__ __device__ __forceinline__ void stage_rc(int b, int& R, int& C) { const int st = b / 1024, sb = b % 1024, swz = sb ^ (((sb >> 9) & 1) << 5); R = (st >> 1) * 16 + swz / 64; C = (st & 1) * 32 + (swz % 64) / 2; }
__host__ __device__ __forceinline__ int perm32(int rho) { const int n = rho >> 4, i = rho & 15; return 8 * (i >> 2) + 4 * n + (i & 3); }

struct Unit { int pm, pn, part; };
struct Gemm {
    const bf16_t* A0; const bf16_t* A1; const bf16_t* B0; const bf16_t* B1; int lda, ldb, K;
    __device__ __forceinline__ const char* a_ptr(const Unit& u) const { return (const char*)(u.part ? A1 : A0) + (size_t)u.pm * BM * lda * 2; }
    __device__ __forceinline__ const char* b_ptr(const Unit& u) const { return (const char*)(u.part ? B1 : B0) + (size_t)u.pn * BM * ldb * 2; }
};

struct StaticOrder {
    int nM, nN, nwg, G, c;
    __host__ __device__ void init(int M, int N, int G_, int c_) { nM = M / BM; nN = N / BM; nwg = nM * nN; G = G_; c = c_; }
    __host__ __device__ bool tile(long L, Unit& u) const {
        if (L >= nwg) return false;
        int wgid = (int)L; { const int q = nwg / NXCD, r = nwg % NXCD, xcd = wgid % NXCD, off = wgid / NXCD; wgid = (xcd < r ? xcd * (q + 1) : r * (q + 1) + (xcd - r) * q) + off; }
        const int nig = WGM * nN, gid = wgid / nig, fm = gid * WGM, gsz = (nM - fm) < WGM ? (nM - fm) : WGM;
        u.pm = fm + ((wgid % nig) % gsz); u.pn = (wgid % nig) / gsz; u.part = 0; return true;
    }
    __host__ __device__ bool next(int i, Unit& u) const { return tile((long)i * G + c, u); }
    __device__ __forceinline__ void a_ready(const Unit&) const {}
    __device__ __forceinline__ void done(const Unit&) const {}
};
struct DualOrder {
    StaticOrder so;
    __host__ __device__ void init(int M, int N, int G_, int c_) { so.init(M, N, G_, c_); }
    __host__ __device__ bool next(int i, Unit& u) const { if (!so.tile((long)(i >> 1) * so.G + so.c, u)) return false; u.part = i & 1; return true; }
    __device__ __forceinline__ void a_ready(const Unit&) const {}
    __device__ __forceinline__ void done(const Unit&) const {}
};

__device__ __forceinline__ unsigned cvt_pk_bf16(float lo, float hi) { unsigned r; asm volatile("v_cvt_pk_bf16_f32 %0, %1, %2" : "=v"(r) : "v"(lo), "v"(hi)); return r; }
__device__ __forceinline__ float bf_lo(unsigned w) { return __uint_as_float(w << 16); }
__device__ __forceinline__ float bf_hi(unsigned w) { return __uint_as_float(w & 0xffff0000u); }
__device__ __forceinline__ float sigmoidf_(float x) { return __builtin_amdgcn_rcpf(1.0f + __builtin_amdgcn_exp2f(-x * 1.4426950408889634f)); }


struct EpiIn {
    static constexpr bool PERM = true, AFTER_DRAIN = false;
    bf16_t* QKVP; bf16_t* GAB; const float* rstd1; const float* bias1p; float* ksum; unsigned* nrm;
    __device__ __forceinline__ void operator()(const f32x4 (&acc)[2][2][4][2], const Unit& u, int wr, int wc, int fr, int fq) const {
        bf16_t* base; int ldc, col0;
        if (u.pn < 8) { base = QKVP + (size_t)(u.pn >> 1) * T * 512; ldc = 512; col0 = (u.pn & 1) * 256; }
        else { base = GAB + (size_t)((u.pn - 8) >> 2) * T * 1024; ldc = 1024; col0 = ((u.pn - 8) & 3) * 256; }
        const float sc = (u.pn < 2) ? QSCALE : 1.0f;
        const int b = u.pm >> 4;
        const int bcol = u.pn * 256 + wc * 32 + 8 * fq;
        f32x4 bv[2][2];
#pragma unroll
        for (int bj = 0; bj < 2; ++bj)
#pragma unroll
            for (int n = 0; n < 2; ++n) { f32x4 s = (f32x4){0.f, 0.f, 0.f, 0.f};
#pragma unroll
                for (int kc = 0; kc < 8; ++kc) s += *(const f32x4*)(bias1p + (size_t)(kc * 8 + b) * INW + bcol + bj * HALF + 4 * n);
                bv[bj][n] = s; }
        const bool isk = (u.pn == 2 || u.pn == 3); const bool isqk = (u.pn < 4); float nmax[2] = {0.f, 0.f};
        f32x4 ks[2][2];
#pragma unroll
        for (int bj = 0; bj < 2; ++bj)
#pragma unroll
            for (int n = 0; n < 2; ++n) ks[bj][n] = (f32x4){0.f, 0.f, 0.f, 0.f};
        const int row0 = u.pm * BM + wr * 64 + fr;
#pragma unroll
        for (int ai = 0; ai < 2; ++ai)
#pragma unroll
            for (int m = 0; m < 4; ++m) { const int row = row0 + ai * HALF + m * 16; const float rs = rstd1[row];
                bf16_t* rowp = base + (size_t)row * ldc + col0 + wc * 32 + 8 * fq;
#pragma unroll
                for (int bj = 0; bj < 2; ++bj) { f32x4 v0 = acc[ai][bj][m][0] * rs + bv[bj][0], v1 = acc[ai][bj][m][1] * rs + bv[bj][1];
                    ks[bj][0] += v0; ks[bj][1] += v1;
                    v0 = v0 * sc; v1 = v1 * sc;
                    if (isqk) { float ss = (v0[0] * v0[0] + v0[1] * v0[1]) + (v0[2] * v0[2] + v0[3] * v0[3]) + (v1[0] * v1[0] + v1[1] * v1[1]) + (v1[2] * v1[2] + v1[3] * v1[3]); ss += __shfl_xor(ss, 16); ss += __shfl_xor(ss, 32); nmax[bj] = fmaxf(nmax[bj], ss); }
                    u32x4 w; w.x = cvt_pk_bf16(v0[0], v0[1]); w.y = cvt_pk_bf16(v0[2], v0[3]); w.z = cvt_pk_bf16(v1[0], v1[1]); w.w = cvt_pk_bf16(v1[2], v1[3]);
                    *(u32x4*)(rowp + bj * HALF) = w; } }
        if (isqk) {
#pragma unroll
            for (int bj = 0; bj < 2; ++bj) { float v = nmax[bj]; v = fmaxf(v, __shfl_xor(v, 1)); v = fmaxf(v, __shfl_xor(v, 2)); v = fmaxf(v, __shfl_xor(v, 4)); v = fmaxf(v, __shfl_xor(v, 8));
                if (fr == 0 && fq == 0) atomicMax(nrm + (size_t)(b * 2 + (u.pn >> 1)) * 16 + (u.pn & 1) * 8 + bj * 4 + wc, __float_as_uint(v)); }
        }
        if (isk) {
#pragma unroll
            for (int bj = 0; bj < 2; ++bj)
#pragma unroll
                for (int n = 0; n < 2; ++n)
#pragma unroll
                    for (int e = 0; e < 4; ++e) { float v = ks[bj][n][e]; v += __shfl_xor(v, 1); v += __shfl_xor(v, 2); v += __shfl_xor(v, 4); v += __shfl_xor(v, 8); ks[bj][n][e] = v; }
            if (fr == 0) { float* kp = ksum + (size_t)u.pm * 512 + (u.pn - 2) * 256 + wc * 32 + 8 * fq;
#pragma unroll
                for (int bj = 0; bj < 2; ++bj)
#pragma unroll
                    for (int n = 0; n < 2; ++n)
#pragma unroll
                        for (int e = 0; e < 4; ++e) atomicAdd(kp + bj * HALF + 4 * n + e, ks[bj][n][e]); }
        }
    }
};

struct EpiUp {
    static constexpr bool PERM = true, AFTER_DRAIN = false;
    bf16_t* merged; const bf16_t* GAB; const float* bprime;
    __device__ __forceinline__ void operator()(const f32x4 (&acc)[2][2][4][2], const Unit& u, int wr, int wc, int fr, int fq) const {
        const int row0 = u.pm * BM + wr * 64 + fr, colb = u.pn * BM + wc * 32 + 8 * fq;
        const bf16_t* gate = GAB + (size_t)u.part * T * 1024;
        f32x4 bv[2][2];
#pragma unroll
        for (int bj = 0; bj < 2; ++bj)
#pragma unroll
            for (int n = 0; n < 2; ++n) { f32x4 s_ = (f32x4){0.f, 0.f, 0.f, 0.f}; if (u.part) { _Pragma("unroll") for (int g_ = 0; g_ < 4; ++g_) s_ += *(const f32x4*)(bprime + g_ * 1024 + colb + bj * HALF + 4 * n); } bv[bj][n] = s_; }
#pragma unroll
        for (int ai = 0; ai < 2; ++ai) {
            u32x4 gpre[4][2], ppre[4][2];
#pragma unroll
            for (int m = 0; m < 4; ++m) { const size_t off = (size_t)(row0 + ai * HALF + m * 16) * 1024 + colb;
#pragma unroll
                for (int bj = 0; bj < 2; ++bj) { gpre[m][bj] = __builtin_nontemporal_load((const u32x4*)(gate + off + bj * HALF));
                    if (u.part) ppre[m][bj] = __builtin_nontemporal_load((const u32x4*)(merged + off + bj * HALF)); else ppre[m][bj] = (u32x4){0u, 0u, 0u, 0u}; } }
#pragma unroll
            for (int m = 0; m < 4; ++m) { const size_t off = (size_t)(row0 + ai * HALF + m * 16) * 1024 + colb;
#pragma unroll
                for (int bj = 0; bj < 2; ++bj) {
                    const u32x4 gw = gpre[m][bj], pw = ppre[m][bj];
                    f32x4 v0 = acc[ai][bj][m][0] + bv[bj][0], v1 = acc[ai][bj][m][1] + bv[bj][1];
                    v0[0] *= sigmoidf_(bf_lo(gw.x)); v0[1] *= sigmoidf_(bf_hi(gw.x)); v0[2] *= sigmoidf_(bf_lo(gw.y)); v0[3] *= sigmoidf_(bf_hi(gw.y));
                    v1[0] *= sigmoidf_(bf_lo(gw.z)); v1[1] *= sigmoidf_(bf_hi(gw.z)); v1[2] *= sigmoidf_(bf_lo(gw.w)); v1[3] *= sigmoidf_(bf_hi(gw.w));
                    v0[0] += bf_lo(pw.x); v0[1] += bf_hi(pw.x); v0[2] += bf_lo(pw.y); v0[3] += bf_hi(pw.y); v1[0] += bf_lo(pw.z); v1[1] += bf_hi(pw.z); v1[2] += bf_lo(pw.w); v1[3] += bf_hi(pw.w);
                    u32x4 w; w.x = cvt_pk_bf16(v0[0], v0[1]); w.y = cvt_pk_bf16(v0[2], v0[3]); w.z = cvt_pk_bf16(v1[0], v1[1]); w.w = cvt_pk_bf16(v1[2], v1[3]);
                    *(u32x4*)(merged + off + bj * HALF) = w; } }
        }
        if (u.part == 0) asm volatile("s_waitcnt vmcnt(0)" ::: "memory");
    }
};

struct EpiOut {
    static constexpr bool PERM = true, AFTER_DRAIN = false;
    const float* x; float* x1; bf16_t* A2; const float* modf; const float* g2; float* ss2;
    __device__ __forceinline__ void operator()(const f32x4 (&acc)[2][2][4][2], const Unit& u, int wr, int wc, int fr, int fq) const {
        const int row0 = u.pm * BM + wr * 64 + fr, colb = u.pn * BM + wc * 32 + 8 * fq, b = u.pm >> 4;
        f32x4 gt[2][2], gg[2][2];
#pragma unroll
        for (int bj = 0; bj < 2; ++bj)
#pragma unroll
            for (int n = 0; n < 2; ++n) { const int c = colb + bj * HALF + 4 * n; gt[bj][n] = *(const f32x4*)(modf + (size_t)b * 6144 + 2048 + c);
                const f32x4 sc2 = *(const f32x4*)(modf + (size_t)b * 6144 + 4096 + c); gg[bj][n] = *(const f32x4*)(g2 + c) * (sc2 + 1.0f); }
#pragma unroll
        for (int ai = 0; ai < 2; ++ai) {
#pragma unroll
          for (int mh = 0; mh < 2; ++mh) {
            f32x4 xr[2][2][2];
#pragma unroll
            for (int m2 = 0; m2 < 2; ++m2) { const size_t off = (size_t)(row0 + ai * HALF + (2 * mh + m2) * 16) * 1024 + colb;
#pragma unroll
                for (int bj = 0; bj < 2; ++bj) { xr[m2][bj][0] = __builtin_nontemporal_load((const f32x4*)(x + off + bj * HALF)); xr[m2][bj][1] = __builtin_nontemporal_load((const f32x4*)(x + off + bj * HALF + 4)); } }
#pragma unroll
            for (int m2 = 0; m2 < 2; ++m2) { const int m = 2 * mh + m2; const int row = row0 + ai * HALF + m * 16; const size_t off = (size_t)row * 1024 + colb; float ssq = 0.f;
#pragma unroll
                for (int bj = 0; bj < 2; ++bj) {
                    const f32x4 y0 = xr[m2][bj][0] + gt[bj][0] * acc[ai][bj][m][0], y1 = xr[m2][bj][1] + gt[bj][1] * acc[ai][bj][m][1];
                    *(f32x4*)(x1 + off + bj * HALF) = y0; *(f32x4*)(x1 + off + bj * HALF + 4) = y1;
                    ssq += (y0[0] * y0[0] + y0[1] * y0[1]) + (y0[2] * y0[2] + y0[3] * y0[3]) + (y1[0] * y1[0] + y1[1] * y1[1]) + (y1[2] * y1[2] + y1[3] * y1[3]);
                    const f32x4 a0 = y0 * gg[bj][0], a1 = y1 * gg[bj][1];
                    u32x4 w; w.x = cvt_pk_bf16(a0[0], a0[1]); w.y = cvt_pk_bf16(a0[2], a0[3]); w.z = cvt_pk_bf16(a1[0], a1[1]); w.w = cvt_pk_bf16(a1[2], a1[3]);
                    *(u32x4*)(A2 + off + bj * HALF) = w; }
                ssq += __shfl_xor(ssq, 16); ssq += __shfl_xor(ssq, 32);
                if (fq == 0) ss2[(size_t)row * 16 + u.pn * 4 + wc] = ssq; }
          }
        }
    }
};

struct EpiPq {
    static constexpr bool PERM = true, AFTER_DRAIN = false;
    bf16_t* QP; const float* ss2; const float* bias2p;
    __device__ __forceinline__ void operator()(const f32x4 (&acc)[2][2][4][2], const Unit& u, int wr, int wc, int fr, int fq) const {
        const int row0 = u.pm * BM + wr * 64 + fr, colb = u.pn * BM + wc * 32 + 8 * fq, b = u.pm >> 4;
        f32x4 bv[2][2];
#pragma unroll
        for (int bj = 0; bj < 2; ++bj)
#pragma unroll
            for (int n = 0; n < 2; ++n) { f32x4 s = (f32x4){0.f, 0.f, 0.f, 0.f};
#pragma unroll
                for (int kc = 0; kc < 8; ++kc) s += *(const f32x4*)(bias2p + (size_t)(kc * 8 + b) * PQW + colb + bj * HALF + 4 * n);
                bv[bj][n] = s; }
#pragma unroll
        for (int ai = 0; ai < 2; ++ai)
#pragma unroll
            for (int m = 0; m < 4; ++m) { const int row = row0 + ai * HALF + m * 16;
                const f32x4* sp = (const f32x4*)(ss2 + (size_t)row * 16); const f32x4 s4 = (sp[0] + sp[1]) + (sp[2] + sp[3]);
                const float rs = __builtin_amdgcn_rsqf(((s4[0] + s4[1]) + (s4[2] + s4[3])) * (1.0f / D) + RMS_EPS);
                bf16_t* rowp = QP + (size_t)row * PQW + colb;
#pragma unroll
                for (int bj = 0; bj < 2; ++bj) { const f32x4 v0 = acc[ai][bj][m][0] * rs + bv[bj][0], v1 = acc[ai][bj][m][1] * rs + bv[bj][1];
                    u32x4 w; w.x = cvt_pk_bf16(v0[0], v0[1]); w.y = cvt_pk_bf16(v0[2], v0[3]); w.z = cvt_pk_bf16(v1[0], v1[1]); w.w = cvt_pk_bf16(v1[2], v1[3]);
                    *(u32x4*)(rowp + bj * HALF) = w; } }
    }
};

template <class Epi, class Sched, bool ALIGN_EPI = false, bool SP2 = false>
__device__ __forceinline__ void gemm_phase(PG8_LAS unsigned char* lds, const Gemm g, const Sched& S, const Epi& E) {
    int tid_ = threadIdx.x; asm volatile("" : "+v"(tid_));
    const int tid = tid_, wid = __builtin_amdgcn_readfirstlane(tid >> 6), lane = tid & 63, wr = wid >> 2, wc = wid & 3, fr = lane & 15, fq = lane >> 4;
    const int K = g.K, nt = K / BK, lda = g.lda, ldb = g.ldb;
    unsigned voffA[2], voffB[2];
#pragma unroll
    for (int i = 0; i < 2; ++i) { int R, C; stage_rc(tid * 16 + i * 8192, R, C); const int Rb = Epi::PERM ? ((R & ~31) + perm32(R & 31)) : R;
        voffA[i] = (unsigned)(R * lda + C) * 2u; voffB[i] = (unsigned)(Rb * ldb + C) * 2u; }
    const size_t kstep = (size_t)(BK * 2);
    const size_t hstepA = (size_t)HALF * lda * 2, hstepB = (size_t)HALF * ldb * 2;
    const unsigned ldsw = (unsigned)wid * 1024u;
    const int aoff = lds_byte(wr * 64 + fr, fq * 8), boff = lds_byte(wc * 32 + fr, fq * 8);
#define PG8_SA(b, h) (((b) * 2 + (h)) * HTB)
#define PG8_SB(b, h) ((4 + (b) * 2 + (h)) * HTB)
#define PG8_STAGE(bufoff, gbase, voff) do { _Pragma("unroll") for (int _i = 0; _i < 2; ++_i) \
        __builtin_amdgcn_global_load_lds((const unsigned*)((const char*)(gbase) + (voff)[_i]), (PG8_LAS unsigned*)(lds + (bufoff) + ldsw + _i * 8192), 16, 0, 0); } while (0)
#define PG8_LDA(dst, b, h) do { _Pragma("unroll") for (int m = 0; m < 4; ++m) _Pragma("unroll") for (int k = 0; k < 2; ++k) dst[m][k] = *(const PG8_LAS bf16x8*)(lds + PG8_SA(b, h) + aoff + m * 2048 + k * 1024); } while (0)
#define PG8_LDB(dst, b, h) do { _Pragma("unroll") for (int n = 0; n < 2; ++n) _Pragma("unroll") for (int k = 0; k < 2; ++k) dst[n][k] = *(const PG8_LAS bf16x8*)(lds + PG8_SB(b, h) + boff + n * 2048 + k * 1024); } while (0)
#define PG8_MMA(ai, bj, At, Bt) do { __builtin_amdgcn_s_setprio(1); _Pragma("unroll") for (int m = 0; m < 4; ++m) _Pragma("unroll") for (int n = 0; n < 2; ++n) _Pragma("unroll") for (int k = 0; k < 2; ++k) \
        acc[ai][bj][m][n] = __builtin_amdgcn_mfma_f32_16x16x32_bf16(Bt[n][k], At[m][k], acc[ai][bj][m][n], 0, 0, 0); __builtin_amdgcn_s_setprio(0); } while (0)
#define PG8_WAIT_V(n) asm volatile("s_waitcnt vmcnt(" #n ")" ::: "memory")
#define PG8_WAIT_L(n) asm volatile("s_waitcnt lgkmcnt(" #n ")" ::: "memory")
#define PG8_BAR __builtin_amdgcn_s_barrier()
#define PG8_SCHED __builtin_amdgcn_sched_barrier(0)
    Unit cur, nxt; int ui = 0;
    if (!S.next(0, cur)) return;
    f32x4 acc[2][2][4][2];
#pragma unroll
    for (int a = 0; a < 2; ++a)
#pragma unroll
        for (int b = 0; b < 2; ++b)
#pragma unroll
            for (int m = 0; m < 4; ++m)
#pragma unroll
                for (int n = 0; n < 2; ++n) acc[a][b][m][n] = (f32x4){0.f, 0.f, 0.f, 0.f};
    bf16x8 At[4][2], B0[2][2], B1[2][2];
    const char* cA = g.a_ptr(cur); const char* cB = g.b_ptr(cur);
    S.a_ready(cur);
    if constexpr (SP2) {
        PG8_STAGE(PG8_SB(0, 0), cB, voffB); PG8_STAGE(PG8_SB(0, 1), cB + hstepB, voffB); PG8_STAGE(PG8_SA(0, 0), cA, voffA); PG8_STAGE(PG8_SA(0, 1), cA + hstepA, voffA);
        if (wr == 1) PG8_BAR;
        PG8_WAIT_V(2); PG8_BAR;
        PG8_STAGE(PG8_SB(1, 0), cB + kstep, voffB); PG8_STAGE(PG8_SA(1, 0), cA + kstep, voffA); PG8_STAGE(PG8_SB(1, 1), cB + hstepB + kstep, voffB);
        PG8_WAIT_V(6); PG8_BAR;
    } else {
        PG8_STAGE(PG8_SB(0, 0), cB, voffB); PG8_STAGE(PG8_SA(0, 0), cA, voffA); PG8_STAGE(PG8_SB(0, 1), cB + hstepB, voffB); PG8_STAGE(PG8_SA(0, 1), cA + hstepA, voffA);
        if (wr == 1) PG8_BAR;
        PG8_WAIT_V(4); PG8_BAR;
        PG8_STAGE(PG8_SB(1, 0), cB + kstep, voffB); PG8_STAGE(PG8_SA(1, 0), cA + kstep, voffA); PG8_STAGE(PG8_SB(1, 1), cB + hstepB + kstep, voffB);
        PG8_WAIT_V(6); PG8_BAR;
    }
    for (;;) {
        const bool has_next = S.next(ui + 1, nxt);
        const char* nA = has_next ? g.a_ptr(nxt) : cA; const char* nB = has_next ? g.b_ptr(nxt) : cB;
        for (int t = 0; t < nt; t += 2) {
            const bool last = (t == nt - 2);
            const char* a1 = cA + (size_t)(t + 1) * kstep;
            const char* a2 = last ? nA : cA + (size_t)(t + 2) * kstep; const char* b2 = last ? nB : cB + (size_t)(t + 2) * kstep;
            const char* a3 = a2 + kstep; const char* b3 = b2 + kstep;
            if (last && has_next) S.a_ready(nxt);
            if constexpr (SP2) {
            PG8_LDB(B0, 0, 0); PG8_LDB(B1, 0, 1); PG8_SCHED; PG8_LDA(At, 0, 0); PG8_STAGE(PG8_SA(1, 1), a1 + hstepA, voffA);
            PG8_WAIT_V(8); PG8_WAIT_L(0); PG8_BAR; PG8_MMA(0, 0, At, B0); PG8_MMA(0, 1, At, B1); PG8_BAR; PG8_SCHED;
            PG8_LDA(At, 0, 1); PG8_STAGE(PG8_SB(0, 0), b2, voffB); PG8_STAGE(PG8_SB(0, 1), b2 + hstepB, voffB); PG8_STAGE(PG8_SA(0, 0), a2, voffA);
            PG8_WAIT_V(8); PG8_WAIT_L(0); PG8_BAR; PG8_MMA(1, 0, At, B0); PG8_MMA(1, 1, At, B1); PG8_BAR; PG8_SCHED;
            PG8_LDB(B0, 1, 0); PG8_LDB(B1, 1, 1); PG8_SCHED; PG8_LDA(At, 1, 0); PG8_STAGE(PG8_SA(0, 1), a2 + hstepA, voffA);
            PG8_WAIT_V(8); PG8_WAIT_L(0); PG8_BAR; PG8_MMA(0, 0, At, B0); PG8_MMA(0, 1, At, B1); PG8_BAR; PG8_SCHED;
            PG8_LDA(At, 1, 1); PG8_STAGE(PG8_SB(1, 0), b3, voffB); PG8_STAGE(PG8_SB(1, 1), b3 + hstepB, voffB); PG8_STAGE(PG8_SA(1, 0), a3, voffA);
            PG8_WAIT_V(8); PG8_WAIT_L(0); PG8_BAR; PG8_MMA(1, 0, At, B0); PG8_MMA(1, 1, At, B1); PG8_BAR; PG8_SCHED;
            } else {
            PG8_LDB(B0, 0, 0); PG8_SCHED; PG8_LDA(At, 0, 0); PG8_STAGE(PG8_SA(1, 1), a1 + hstepA, voffA);
            PG8_WAIT_L(8); PG8_BAR; PG8_WAIT_L(0); PG8_MMA(0, 0, At, B0); PG8_BAR; PG8_SCHED;
            PG8_LDB(B1, 0, 1); PG8_STAGE(PG8_SB(0, 0), b2, voffB);
            PG8_BAR; PG8_WAIT_L(0); PG8_MMA(0, 1, At, B1); PG8_BAR;
            PG8_LDA(At, 0, 1); PG8_STAGE(PG8_SA(0, 0), a2, voffA);
            PG8_BAR; PG8_WAIT_L(0); PG8_MMA(1, 0, At, B0); PG8_BAR; PG8_SCHED;
            PG8_STAGE(PG8_SB(0, 1), b2 + hstepB, voffB);
            PG8_WAIT_V(6); PG8_BAR; PG8_MMA(1, 1, At, B1); PG8_BAR;
            PG8_LDB(B0, 1, 0); PG8_SCHED; PG8_LDA(At, 1, 0); PG8_STAGE(PG8_SA(0, 1), a2 + hstepA, voffA);
            PG8_WAIT_L(8); PG8_BAR; PG8_WAIT_L(0); PG8_MMA(0, 0, At, B0); PG8_BAR; PG8_SCHED;
            PG8_LDB(B1, 1, 1); PG8_STAGE(PG8_SB(1, 0), b3, voffB);
            PG8_BAR; PG8_WAIT_L(0); PG8_MMA(0, 1, At, B1); PG8_BAR;
            PG8_LDA(At, 1, 1); PG8_STAGE(PG8_SA(1, 0), a3, voffA);
            PG8_BAR; PG8_WAIT_L(0); PG8_MMA(1, 0, At, B0); PG8_BAR; PG8_SCHED;
            PG8_STAGE(PG8_SB(1, 1), b3 + hstepB, voffB);
            PG8_WAIT_V(6); PG8_BAR; PG8_MMA(1, 1, At, B1); PG8_BAR;
            }
        }
        if constexpr (ALIGN_EPI) { if (wr == 0) PG8_BAR; }
        if constexpr (!Epi::AFTER_DRAIN) { E(acc, cur, wr, wc, fr, fq); S.done(cur); }
        if (!has_next) break;
#pragma unroll
        for (int a = 0; a < 2; ++a)
#pragma unroll
            for (int b = 0; b < 2; ++b)
#pragma unroll
                for (int m = 0; m < 4; ++m)
#pragma unroll
                    for (int n = 0; n < 2; ++n) acc[a][b][m][n] = (f32x4){0.f, 0.f, 0.f, 0.f};
        cur = nxt; cA = nA; cB = nB; ++ui;
        if constexpr (ALIGN_EPI) { if (wr == 1) PG8_BAR; }
    }
    PG8_WAIT_V(0);
    if constexpr (!ALIGN_EPI) { if (wr == 0) PG8_BAR; }
    PG8_BAR;
    if constexpr (Epi::AFTER_DRAIN) { E.fused(acc, cur, wr, wc, fr, fq, lds, wid, lane); S.done(cur); }
#undef PG8_SA
#undef PG8_SB
#undef PG8_STAGE
#undef PG8_LDA
#undef PG8_LDB
#undef PG8_MMA
#undef PG8_WAIT_V
#undef PG8_WAIT_L
#undef PG8_BAR
#undef PG8_SCHED
}
}

constexpr size_t MiB = 1u << 20;
constexpr size_t WS_CTL = 0, CTL_ZERO_BYTES = 32 * 1024;
constexpr size_t WS_KSUM = 256 * 1024;
constexpr size_t WS_MODP = 1 * MiB;
constexpr size_t WS_MODF = WS_MODP + 8 * 8 * 6144 * 4;
constexpr size_t WS_BIAS1P = 3 * MiB;
constexpr size_t WS_BIAS2P = 4 * MiB;
constexpr size_t WS_BPRIME = 4 * MiB + 512 * 1024;
constexpr size_t WS_RSTD1 = 5 * MiB;
constexpr size_t WS_SS2 = 6 * MiB;
constexpr size_t WS_SUBK = 8 * MiB;
constexpr size_t WS_WIN = 16 * MiB, WS_WA = 24 * MiB, WS_WP = 25 * MiB, WS_WOUT = 26 * MiB, WS_WQ = 28 * MiB;
constexpr size_t WS_U = 32 * MiB, WS_V = 64 * MiB;
constexpr size_t WS_XG = 96 * MiB;
constexpr size_t WS_H2Q = WS_XG, WS_HS = WS_XG + 32 * MiB;
constexpr size_t WS_QKVP = 160 * MiB;
constexpr size_t WS_GAB = 288 * MiB;
constexpr size_t WS_POOLED = 416 * MiB;
constexpr size_t WS_END = 448 * MiB;
constexpr int CW_TMO = 0, CW_BAR = 4096;
constexpr int CW_NRM = 2048;

constexpr int RING_OFF = 0, RING_BYTES = 131072;
constexpr int LDS_BYTES = 147456;
constexpr int LDSCTL_OFF = LDS_BYTES - 512, MISC_OFF = LDSCTL_OFF + 320;

#define GAS __attribute__((address_space(1)))
#define LAS __attribute__((address_space(3)))
typedef unsigned short bf16;
typedef unsigned v4u __attribute__((ext_vector_type(4)));
typedef unsigned v2u __attribute__((ext_vector_type(2)));
typedef float f32x4 __attribute__((ext_vector_type(4)));
typedef GAS unsigned gu32;
#define RLX_AGENT __ATOMIC_RELAXED, __HIP_MEMORY_SCOPE_AGENT
#define LDS_WAIT() asm volatile("s_waitcnt lgkmcnt(0)" ::: "memory")
#define VM_WAIT() asm volatile("s_waitcnt vmcnt(0)" ::: "memory")
__device__ __forceinline__ unsigned f2bf(float f) { unsigned u = __builtin_bit_cast(unsigned, f); return (u + 0x7fffu + ((u >> 16) & 1u)) >> 16; }
__device__ __forceinline__ unsigned pk2(float lo, float hi) { return f2bf(lo) | (f2bf(hi) << 16); }
__device__ __forceinline__ float bflo(unsigned w) { return __uint_as_float(w << 16); }
__device__ __forceinline__ float bfhi(unsigned w) { return __uint_as_float(w & 0xffff0000u); }
__device__ __forceinline__ float wave_sum(float v) {
#pragma unroll
    for (int o = 1; o < 64; o <<= 1) v += __shfl_xor(v, o);
    return v;
}
__device__ __forceinline__ float wave_max(float v) {
#pragma unroll
    for (int o = 1; o < 64; o <<= 1) v = fmaxf(v, __shfl_xor(v, o));
    return v;
}

#define XB_TMO      128
#define XB_XCNT(j)  (256  + 64 * (j))
#define XB_XSUB(j)  (1280 + 64 * (j))
#define XB_XGEN(j)  (2304 + 64 * (j))
#define XB_TOP      3328
#define XB_TOPGEN   3392
#define XCD_BAR_WORDS 3456
#define XB_SPIN_CAP (1u << 22)

__device__ __forceinline__ unsigned xb_ld(unsigned* p)              { return __hip_atomic_load(p, __ATOMIC_RELAXED, __HIP_MEMORY_SCOPE_AGENT); }
__device__ __forceinline__ unsigned xb_add(unsigned* p, unsigned v) { return __hip_atomic_fetch_add(p, v, __ATOMIC_RELAXED, __HIP_MEMORY_SCOPE_AGENT); }
__device__ __forceinline__ unsigned xb_xcc_id() { return (unsigned)__builtin_amdgcn_s_getreg((3 << 11) | 20) & 0xFu; }
#define XB_SPIN(cond, bar) do { unsigned _sp = 0; while (cond) { __builtin_amdgcn_s_sleep(1); \
    if ((++_sp & 255u) == 0u) { if (xb_ld(&(bar)[XB_TMO])) break; if (_sp > XB_SPIN_CAP) { atomicAdd(&(bar)[XB_TMO], 1u); break; } } } } while (0)

struct XcdBarrier { unsigned* bar; unsigned x; volatile LAS unsigned* st; };

__device__ __forceinline__ XcdBarrier xcd_barrier_post(unsigned* bar, volatile LAS unsigned* st) {
    XcdBarrier b; b.bar = bar; b.x = xb_xcc_id(); b.st = st;
    if (threadIdx.x == 0) (void)xb_add(&bar[XB_XCNT(b.x)], 1u);
    return b;
}
__device__ __forceinline__ void xcd_barrier_complete(unsigned* bar, unsigned x, unsigned& nloc, unsigned& nx) {
    const unsigned G = gridDim.x * gridDim.y * gridDim.z;
    unsigned sum, cnt, mine, sp = 0u;
    for (;;) {
        sum = 0u; cnt = 0u; mine = 0u;
#pragma unroll
        for (unsigned j = 0; j < 16; ++j) { const unsigned c = xb_ld(&bar[XB_XCNT(j)]); sum += c; cnt += (c > 0u) ? 1u : 0u; mine = (j == x) ? c : mine; }
        if (sum == G) break;
        __builtin_amdgcn_s_sleep(1);
        if ((++sp & 255u) == 0u) { if (xb_ld(&bar[XB_TMO])) break; if (sp > XB_SPIN_CAP) { atomicAdd(&bar[XB_TMO], 1u); break; } }
    }
    nloc = mine > 0u ? mine : 1u; nx = cnt > 0u ? cnt : 1u;
}
__device__ __forceinline__ void xcd_barrier(const XcdBarrier& b) {
    asm volatile("s_waitcnt vmcnt(0)" ::: "memory");
    __syncthreads();
    if (threadIdx.x == 0) {
        unsigned* bar = b.bar;
        __builtin_amdgcn_s_waitcnt(0);
        unsigned nloc = b.st[0], nx = b.st[1];
        if (nloc == 0u) { xcd_barrier_complete(bar, b.x, nloc, nx); b.st[0] = nloc; b.st[1] = nx; }
        const unsigned old = xb_add(&bar[XB_XSUB(b.x)], 1u);
        const unsigned gen = old / nloc;
        if (old + 1u == (gen + 1u) * nloc) {
            __builtin_amdgcn_fence(__ATOMIC_RELEASE, "agent");
            asm volatile("s_waitcnt vmcnt(0)" ::: "memory");
            const unsigned og = xb_add(&bar[XB_TOP], 1u);
            const unsigned tg = og / nx;
            if (og + 1u == (tg + 1u) * nx) xb_add(&bar[XB_TOPGEN], 1u);
            else XB_SPIN(xb_ld(&bar[XB_TOPGEN]) == tg, bar);
            __builtin_amdgcn_fence(__ATOMIC_ACQUIRE, "agent");
            xb_add(&bar[XB_XGEN(b.x)], 1u);
            asm volatile("s_waitcnt vmcnt(0)" ::: "memory");
        } else {
            XB_SPIN(xb_ld(&bar[XB_XGEN(b.x)]) == gen, bar);
            __builtin_amdgcn_fence(__ATOMIC_ACQUIRE, "agent");
            asm volatile("s_waitcnt vmcnt(0)" ::: "memory");
        }
    }
    __syncthreads();
}

struct Frame {
    LAS unsigned char* lds;
    volatile LAS unsigned* MISC;
    gu32* ctl;
    int tid, lane, wave;
    int vcu, G;
};
struct Args { const float* in[18]; float* out; unsigned char* ws; };

__device__ __forceinline__ float modp_sum(const float* modp, int idx) {
    float s = 0.f;
#pragma unroll
    for (int kc = 0; kc < 8; ++kc) s += modp[(size_t)kc * 8 * 6144 + idx];
    return s;
}
template <int MODE>
__device__ __forceinline__ void p0_wg_dot(Frame& F, const float* cin, const float* modp, int soff, const float* W, int N, const float* addv, float* outp, int first, int ntask) {
    LAS float* scr = (LAS float*)(F.lds + RING_OFF + F.wave * 16384);
    const int ncn = N / 64;
    for (int it = first; it < ntask; it += F.G) {
        const int kc = it / ncn, nc = it % ncn, k0 = kc * 128 + F.wave * 16, n = nc * 64 + F.lane;
        float w[16];
#pragma unroll
        for (int kk = 0; kk < 16; ++kk) w[kk] = (MODE == 0) ? __builtin_nontemporal_load(W + (size_t)(k0 + kk) * N + n) : W[(size_t)(k0 + kk) * N + n];
#pragma unroll
        for (int j = 0; j < 2; ++j) { const int idx = F.lane + 64 * j, b = idx >> 4, kk = idx & 15;
            float cf; if (MODE == 0) { const float cv = cin[b * 1024 + k0 + kk]; cf = cv / (1.0f + __expf(-cv)); } else cf = modp_sum(modp, b * 6144 + soff + k0 + kk);
            scr[idx] = cf; }
        LDS_WAIT(); asm volatile("" ::: "memory");
#pragma unroll
        for (int b = 0; b < 8; ++b) { float s = 0.f;
#pragma unroll
            for (int kk = 0; kk < 16; ++kk) s += scr[b * 16 + kk] * w[kk];
            scr[256 + b * 64 + F.lane] = s; }
        __syncthreads();
        { const int b = F.wave; float s = (addv != nullptr && kc == 0) ? addv[n] : 0.f;
#pragma unroll
          for (int w8 = 0; w8 < 8; ++w8) s += ((LAS float*)(F.lds + RING_OFF + w8 * 16384))[256 + b * 64 + F.lane];
          outp[(size_t)(kc * 8 + b) * N + n] = s; }
        __syncthreads();
    }
}
__device__ __forceinline__ void p0a_mod(Frame& F, const Args& A) { p0_wg_dot<0>(F, A.in[1], nullptr, 0, A.in[2], 6144, A.in[3], (float*)(A.ws + WS_MODP), F.vcu, 8 * 96); }
__device__ __forceinline__ void p0_wp_task(Frame& F, const Args& A, int r) {
    LAS float* scr = (LAS float*)(F.lds + RING_OFF + F.wave * 16384);
    const int g = r >> 6, kq = (r >> 4) & 3, nc = r & 15, n = nc * 64 + F.lane, d0 = 16 * F.wave;
    const float* wmix = A.in[7] + (size_t)(g * 128 + 32 * kq) * 128 + d0; const float* scale = A.in[9] + g * 128 + d0; const float* wup = A.in[10] + (size_t)(g * 128 + d0) * D + n; const float* bmix = A.in[8] + g * 128 + d0;
    float wu[16];
#pragma unroll
    for (int d = 0; d < 16; ++d) wu[d] = wup[(size_t)d * D];
    float bp = 0.f;
#pragma unroll
    for (int d = 0; d < 16; ++d) { wu[d] *= scale[d]; bp += bmix[d] * wu[d]; }
#pragma unroll
    for (int kk = 0; kk < 32; ++kk) { float s = 0.f;
#pragma unroll
        for (int d = 0; d < 16; ++d) s += wmix[kk * 128 + d] * wu[d];
        scr[kk * 64 + F.lane] = s; }
    scr[2048 + F.lane] = bp;
    __syncthreads();
    { float s[4]; float bs = 0.f;
#pragma unroll
      for (int e = 0; e < 4; ++e) s[e] = 0.f;
#pragma unroll
      for (int w8 = 0; w8 < 8; ++w8) { const LAS float* o = (const LAS float*)(F.lds + RING_OFF + w8 * 16384);
#pragma unroll
          for (int e = 0; e < 4; ++e) s[e] += o[(4 * F.wave + e) * 64 + F.lane];
          bs += o[2048 + F.lane]; }
      v2u w; w.x = pk2(s[0], s[1]); w.y = pk2(s[2], s[3]);
      *(GAS v2u*)((bf16*)(A.ws + WS_WP) + (size_t)n * PW + g * 128 + 32 * kq + 4 * F.wave) = w;
      if (kq == 0 && F.wave == 0) ((float*)(A.ws + WS_BPRIME))[g * 1024 + n] = bs; }
    __syncthreads();
}

__device__ __forceinline__ void p0_transpose_item(const float* W, int K, int N, bf16* WT, int row_off, LAS float* scr, int item, int lane) {
    const int nblk = N / 32, kb = item / nblk, nb = item % nblk, k0 = 64 * kb, n0 = 32 * nb;
#pragma unroll 8
    for (int i = 0; i < 32; ++i) { const int kk = 2 * i + (lane >> 5); scr[kk * 33 + (lane & 31)] = __builtin_nontemporal_load(W + (size_t)(k0 + kk) * N + n0 + (lane & 31)); }
    LDS_WAIT(); asm volatile("" ::: "memory");
    const int c = lane & 7;
#pragma unroll
    for (int j = 0; j < 4; ++j) { const int n = (lane >> 3) + 8 * j; const LAS float* s = scr + (8 * c) * 33 + n;
        v4u o; o.x = pk2(s[0 * 33], s[1 * 33]); o.y = pk2(s[2 * 33], s[3 * 33]); o.z = pk2(s[4 * 33], s[5 * 33]); o.w = pk2(s[6 * 33], s[7 * 33]);
        *(GAS v4u*)(WT + (size_t)(row_off + n0 + n) * K + k0 + 8 * c) = o; }
    LDS_WAIT(); asm volatile("" ::: "memory");
}
__device__ __forceinline__ void p0_table_rows4(const float* const (&src)[4], unsigned char* const (&dst)[4], float* const (&scale_out)[4], int off, int lane) {
    f32x4 v[4][4]; float am[4];
#pragma unroll
    for (int u = 0; u < 4; ++u)
#pragma unroll
        for (int q = 0; q < 4; ++q) v[u][q] = __builtin_nontemporal_load((const f32x4*)(src[u] + 16 * lane + 4 * q));
#pragma unroll
    for (int u = 0; u < 4; ++u) { float a = 0.f;
#pragma unroll
        for (int q = 0; q < 4; ++q) a = fmaxf(fmaxf(a, fmaxf(fabsf(v[u][q][0]), fabsf(v[u][q][1]))), fmaxf(fabsf(v[u][q][2]), fabsf(v[u][q][3])));
        am[u] = a; }
#pragma unroll
    for (int o = 1; o < 64; o <<= 1) {
#pragma unroll
        for (int u = 0; u < 4; ++u) am[u] = fmaxf(am[u], __shfl_xor(am[u], o)); }
#pragma unroll
    for (int u = 0; u < 4; ++u) { const float sc = (am[u] > 0.f) ? am[u] * (1.0f / 127.0f) : 1.0f, inv = 1.0f / sc;
        v4u o;
#pragma unroll
        for (int q = 0; q < 4; ++q) { const int q0 = (int)rintf(v[u][q][0] * inv) + off, q1 = (int)rintf(v[u][q][1] * inv) + off, q2 = (int)rintf(v[u][q][2] * inv) + off, q3 = (int)rintf(v[u][q][3] * inv) + off;
            o[q] = (unsigned)(q0 & 255) | ((unsigned)(q1 & 255) << 8) | ((unsigned)(q2 & 255) << 16) | ((unsigned)q3 << 24); }
        *(GAS v4u*)(dst[u] + ((size_t)(lane >> 3) << 21) + 16 * (lane & 7)) = o;
        if (lane == 0) *scale_out[u] = sc; }
}
__device__ __forceinline__ void p0_table_trip(const Args& A, int r0, int NGW, int lane) {
    const float* src[4]; unsigned char* dst[4]; float* sco[4];
#pragma unroll
    for (int u = 0; u < 4; ++u) { int r = r0 + u * NGW; if (r >= 2 * PEXP) r = r0; const int tb = r / PEXP, e = r % PEXP;
        src[u] = (tb ? A.in[16] : A.in[15]) + (size_t)e * D; dst[u] = A.ws + (tb ? WS_V : WS_U) + (size_t)e * 128; sco[u] = (float*)(A.ws + (tb ? WS_V : WS_U) + 16 * MiB) + e; }
    const int tb0 = r0 / PEXP;
    if ((r0 + 3 * NGW) / PEXP == tb0 && r0 + 3 * NGW < 2 * PEXP) p0_table_rows4(src, dst, sco, tb0 ? 128 : 0, lane);
    else { for (int u = 0; u < 4; ++u) { const int r = r0 + u * NGW; if (r < 2 * PEXP) { const float* s1[4] = {src[u], src[u], src[u], src[u]}; unsigned char* d1[4] = {dst[u], dst[u], dst[u], dst[u]}; float* c1[4] = {sco[u], sco[u], sco[u], sco[u]}; p0_table_rows4(s1, d1, c1, (r / PEXP) ? 128 : 0, lane); } } }
}
template <int STAGE>
__device__ __forceinline__ void p0b_prologue(Frame& F, const Args& A) {
    const int gw = F.vcu * NWAVES + F.wave, NGW = F.G * NWAVES, lane = F.lane;
    const float* modp = (const float*)(A.ws + WS_MODP);
    LAS float* G1 = (LAS float*)(F.lds + 135168);
    if (STAGE == 0) { float* ks = (float*)(A.ws + WS_KSUM); for (int i = F.vcu * NTHREADS + F.tid; i < NB * NBLK * 512; i += F.G * NTHREADS) ks[i] = 0.f; }
    if (STAGE == 0) { for (int r = F.vcu; r < 256; r += F.G) p0_wp_task(F, A, r); }
    else { p0_wg_dot<1>(F, nullptr, modp, 0, A.in[5], INW, nullptr, (float*)(A.ws + WS_BIAS1P), F.vcu, 8 * (INW / 64));
           p0_wg_dot<1>(F, nullptr, modp, 3072, A.in[13], PQW, nullptr, (float*)(A.ws + WS_BIAS2P), F.vcu, 8 * (PQW / 64)); }
    LAS float* scr = (LAS float*)(F.lds + RING_OFF + F.wave * 16384);
    constexpr int I_MODF = 768, I_WIN = (D / 64) * (INW / 32), I_WA = (AW / 64) * (D / 32), I_WOUT = (D / 64) * (D / 32), I_WQ = (D / 64) * (PQW / 32);
    constexpr int I_SUBK = 64;
    constexpr int NITEMS = I_MODF + I_WIN + I_WA + I_WOUT + I_WQ + I_SUBK;
    for (int it = gw; it < NITEMS; it += NGW) {
        int r = it;
        if (r < I_MODF) { if (STAGE != 1) continue; const int idx = r * 64 + lane; ((float*)(A.ws + WS_MODF))[idx] = modp_sum(modp, idx); continue; } r -= I_MODF;
        if (r < I_WIN) { if (STAGE != 0) continue; p0_transpose_item(A.in[5], D, INW, (bf16*)(A.ws + WS_WIN), 0, scr, r, lane); continue; } r -= I_WIN;
        if (r < I_WA) { if (STAGE != 0) continue; p0_transpose_item(A.in[6], AW, D, (bf16*)(A.ws + WS_WA), 0, scr, r, lane); continue; } r -= I_WA;
        if (r < I_WOUT) { if (STAGE != 0) continue; p0_transpose_item(A.in[11], D, D, (bf16*)(A.ws + WS_WOUT), 0, scr, r, lane); continue; } r -= I_WOUT;
        if (r < I_WQ) { if (STAGE != 0) continue; p0_transpose_item(A.in[13], D, PQW, (bf16*)(A.ws + WS_WQ), 0, scr, r, lane); continue; } r -= I_WQ;
        if (r < I_SUBK) { if (STAGE != 0) continue; const float* s = A.in[14] + (size_t)r * 512 + 8 * lane; const f32x4 a = *(const f32x4*)s, b = *(const f32x4*)(s + 4);
            v4u o; o.x = pk2(a[0], a[1]); o.y = pk2(a[2], a[3]); o.z = pk2(b[0], b[1]); o.w = pk2(b[2], b[3]);
            *(GAS v4u*)((bf16*)(A.ws + WS_SUBK) + (size_t)r * 512 + 8 * lane) = o; continue; } r -= I_SUBK;
    }
    auto xg_rows = [&](const int rb) {
        const float* x = A.in[0]; bf16* XG = (bf16*)(A.ws + WS_XG); float* rstd1 = (float*)(A.ws + WS_RSTD1);
            for (int r0 = F.wave; r0 < 128; r0 += 4 * NWAVES) {
                f32x4 v[4][2][2]; float s[4];
#pragma unroll
                for (int u = 0; u < 4; ++u) { const float* xr = x + (size_t)(rb * 128 + r0 + u * NWAVES) * 1024;
#pragma unroll
                    for (int h = 0; h < 2; ++h)
#pragma unroll
                        for (int q = 0; q < 2; ++q) v[u][h][q] = __builtin_nontemporal_load((const f32x4*)(xr + h * 512 + 8 * lane + 4 * q)); }
#pragma unroll
                for (int u = 0; u < 4; ++u) { float t = 0.f;
#pragma unroll
                    for (int h = 0; h < 2; ++h)
#pragma unroll
                        for (int q = 0; q < 2; ++q) t += (v[u][h][q][0] * v[u][h][q][0] + v[u][h][q][1] * v[u][h][q][1]) + (v[u][h][q][2] * v[u][h][q][2] + v[u][h][q][3] * v[u][h][q][3]);
                    s[u] = t; }
#pragma unroll
                for (int o = 1; o < 64; o <<= 1) {
#pragma unroll
                    for (int u = 0; u < 4; ++u) s[u] += __shfl_xor(s[u], o); }
#pragma unroll
                for (int u = 0; u < 4; ++u) { const int row = rb * 128 + r0 + u * NWAVES;
                    if (lane == 0) rstd1[row] = 1.0f / sqrtf(s[u] * (1.0f / D) + RMS_EPS);
#pragma unroll
                    for (int h = 0; h < 2; ++h) { const LAS float* g = G1 + h * 512 + 8 * lane;
                        v4u o; o.x = pk2(v[u][h][0][0] * g[0], v[u][h][0][1] * g[1]); o.y = pk2(v[u][h][0][2] * g[2], v[u][h][0][3] * g[3]); o.z = pk2(v[u][h][1][0] * g[4], v[u][h][1][1] * g[5]); o.w = pk2(v[u][h][1][2] * g[6], v[u][h][1][3] * g[7]);
                        *(GAS v4u*)(XG + (size_t)row * 1024 + h * 512 + 8 * lane) = o; } }
            }
    };
#ifndef TABLES_IN_ROUTER
    if (STAGE == 0) { for (int r0 = gw; r0 < 2 * PEXP; r0 += 4 * NGW) p0_table_trip(A, r0, NGW, lane); }
    else
#else
    if (STAGE == 1)
#endif
    for (int rb = F.vcu; rb < T / 128; rb += F.G) {
        const float* g1 = A.in[4]; const int b = (rb * 128) / SEQ;
        __syncthreads();
        for (int k = F.tid; k < 1024; k += NTHREADS) G1[k] = g1[k] * (1.0f + modp_sum(modp, b * 6144 + 1024 + k));
        __syncthreads();
        xg_rows(rb);
    }

}
namespace attn_body {
using bf16=__hip_bfloat16;
using bf16x8=__attribute__((ext_vector_type(8)))short;
using s16x4=__attribute__((ext_vector_type(4)))short;
using f32x16=__attribute__((ext_vector_type(16)))float;
using u32x4=__attribute__((ext_vector_type(4)))unsigned;
constexpr int BATCH=8,NHEAD=8,SEQ=4096,D=64,DM=NHEAD*D;
constexpr int NW=8,QBLK=32,QB=QBLK*NW,KVBLK=64,NQB=SEQ/QB;
constexpr int ATTN_PITCH=DM, ATTN_UNIT_ROWS=QB;
__device__ __forceinline__ int crow(int r,int hi){return (r&3)+8*(r>>2)+4*hi;}
#define SBAR() __builtin_amdgcn_sched_barrier(0)
__device__ __forceinline__ void cmask(f32x16&p0,f32x16&p1,int jb,int qrel,int hi){
  const float NEG=-INFINITY; int kb=64*jb+4*hi;
  #pragma unroll
  for(int r=0;r<16;++r){int kv=kb+(r&3)+8*(r>>2); if(kv>qrel)p0[r]=NEG; if(kv+32>qrel)p1[r]=NEG;}
}

constexpr int NSLOT=3, SLOTB=8192;
constexpr int LDS_K=0, LDS_V=NSLOT*SLOTB, LDS_WS=2*NSLOT*SLOTB, LDS_OST=LDS_WS+NW*64*4, LDS_KSL=LDS_OST+NW*4096, LDS_BYTES=LDS_KSL+4096;
constexpr float C2=0.125f*1.4426950408889634f;
__device__ __forceinline__ void glds16(const void*sbase,unsigned voff,unsigned lds_dst){unsigned keep;
  asm volatile("s_mov_b32 %0, m0\n\ts_mov_b32 m0, %3\n\ts_nop 4\n\tglobal_load_lds_dwordx4 %1, %2\n\ts_mov_b32 m0, %0":"=&s"(keep):"v"(voff),"s"(sbase),"s"(lds_dst):"memory");}
__device__ __forceinline__ float max3f(float a,float b,float c){float r;asm("v_max3_f32 %0, %1, %2, %3":"=v"(r):"v"(a),"v"(b),"v"(c));return r;}
__device__ __forceinline__ float max2f(float a,float b){float r;asm("v_max_f32_e32 %0, %1, %2":"=v"(r):"v"(a),"v"(b));return r;}
__device__ __forceinline__ float fadd_s(float a,float b){float r;asm("v_add_f32_e32 %0, %1, %2":"=v"(r):"v"(a),"v"(b));return r;}
__device__ __forceinline__ float fsub_s(float a,float b){float r;asm("v_sub_f32_e32 %0, %1, %2":"=v"(r):"v"(a),"v"(b));return r;}
typedef float f32x2_t __attribute__((ext_vector_type(2))); typedef __bf16 bf16x2_t __attribute__((ext_vector_type(2)));
__device__ __forceinline__ unsigned cvtpk_s(float lo,float hi){f32x2_t v={lo,hi};bf16x2_t b=__builtin_convertvector(v,bf16x2_t);return __builtin_bit_cast(unsigned,b);}
#define WAIT_BAR(N) asm volatile("s_waitcnt vmcnt(" #N ") lgkmcnt(0)\n\ts_barrier":::"memory")

__device__ __forceinline__ void qkt(f32x16&p0,f32x16&p1,const char*Kslot,const bf16x8*qr,const f32x16&negm,int r32,int hi){
  const char*kb=Kslot+hi*1024+r32*16;
  #pragma unroll
  for(int d0=0;d0<4;++d0){
    const bf16x8 b0=*reinterpret_cast<const bf16x8*>(kb+d0*2048);
    const bf16x8 b1=*reinterpret_cast<const bf16x8*>(kb+d0*2048+512);
    if(d0==0){p0=__builtin_amdgcn_mfma_f32_32x32x16_bf16(b0,qr[0],negm,0,0,0);p1=__builtin_amdgcn_mfma_f32_32x32x16_bf16(b1,qr[0],negm,0,0,0);}
    else{p0=__builtin_amdgcn_mfma_f32_32x32x16_bf16(b0,qr[d0],p0,0,0,0);p1=__builtin_amdgcn_mfma_f32_32x32x16_bf16(b1,qr[d0],p1,0,0,0);}}
}
typedef __attribute__((address_space(3))) const char* lds_cptr;
typedef short v4i16_t __attribute__((ext_vector_type(4)));
__device__ __forceinline__ void kload8(bf16x8*kf,lds_cptr kp){
  kf[0]=*(const __attribute__((address_space(3))) bf16x8*)(kp);      kf[1]=*(const __attribute__((address_space(3))) bf16x8*)(kp+512);
  kf[2]=*(const __attribute__((address_space(3))) bf16x8*)(kp+2048); kf[3]=*(const __attribute__((address_space(3))) bf16x8*)(kp+2560);
  kf[4]=*(const __attribute__((address_space(3))) bf16x8*)(kp+4096); kf[5]=*(const __attribute__((address_space(3))) bf16x8*)(kp+4608);
  kf[6]=*(const __attribute__((address_space(3))) bf16x8*)(kp+6144); kf[7]=*(const __attribute__((address_space(3))) bf16x8*)(kp+6656);
}
__device__ __forceinline__ void kload2(bf16x8*kf,lds_cptr kp,int j){ kf[2*j]=*(const __attribute__((address_space(3))) bf16x8*)(kp+j*2048); kf[2*j+1]=*(const __attribute__((address_space(3))) bf16x8*)(kp+j*2048+512); }
__device__ __forceinline__ s16x4 vtr(lds_cptr p){ return __builtin_bit_cast(s16x4,__builtin_amdgcn_ds_read_tr16_b64_v4i16((__attribute__((address_space(3))) v4i16_t*)p)); }
__device__ __forceinline__ float rowmax(const f32x16&p0,const f32x16&p1){
  float a=max3f(p0[0],p0[1],p1[0]),b=max3f(p0[2],p0[3],p1[1]);a=max3f(a,p1[2],p1[3]);
  #pragma unroll
  for(int r=4;r<16;r+=4){a=max3f(a,p0[r],p0[r+1]);b=max3f(b,p0[r+2],p0[r+3]);a=max3f(a,p1[r],p1[r+1]);b=max3f(b,p1[r+2],p1[r+3]);}
  const float m=max2f(a,b);
  auto rr=__builtin_amdgcn_permlane32_swap(__float_as_uint(m),__float_as_uint(m),false,false);
  return max2f(__uint_as_float(rr[0]),__uint_as_float(rr[1]));
}
__device__ __forceinline__ void pv(f32x16*o,int vb,bf16x8 pa0,bf16x8 pa1,bf16x8 pa2,bf16x8 pa3){
  #pragma unroll
  for(int d0=0;d0<2;++d0){s16x4 lo[4],hi[4];
    #pragma unroll
    for(int ks=0;ks<4;++ks){
      asm volatile("ds_read_b64_tr_b16 %0,%1 offset:%c2":"=&v"(lo[ks]):"v"(vb),"i"(d0*4096+ks*1024):"memory");
      asm volatile("ds_read_b64_tr_b16 %0,%1 offset:%c2":"=&v"(hi[ks]):"v"(vb),"i"(d0*4096+ks*1024+512):"memory");}
    asm volatile("s_waitcnt lgkmcnt(0)":::"memory");SBAR();
    #define PK(k) (bf16x8){lo[k][0],lo[k][1],lo[k][2],lo[k][3],hi[k][0],hi[k][1],hi[k][2],hi[k][3]}
    o[d0]=__builtin_amdgcn_mfma_f32_32x32x16_bf16(pa0,PK(0),o[d0],0,0,0);
    o[d0]=__builtin_amdgcn_mfma_f32_32x32x16_bf16(pa1,PK(1),o[d0],0,0,0);
    o[d0]=__builtin_amdgcn_mfma_f32_32x32x16_bf16(pa2,PK(2),o[d0],0,0,0);
    o[d0]=__builtin_amdgcn_mfma_f32_32x32x16_bf16(pa3,PK(3),o[d0],0,0,0);
    #undef PK
  }
}

#ifndef ATTN_STORE16
#define ATTN_STORE16(p,v) (*(u32x4*)(p)=(v))
#endif
template<int THRL> __device__ __forceinline__ void attn_unit(int b,int h,int qb,const bf16*Q,const bf16*__restrict__ K,const bf16*__restrict__ V,bf16*O,const float*ksum,const float*nrm,char*shm){
  int tid_=threadIdx.x; asm volatile("":"+v"(tid_)); const int tid=tid_,lane=tid&63,r32=lane&31,hi=lane>>5; const int wid=__builtin_amdgcn_readfirstlane(tid>>6);
  const long rowbase=(long)b*SEQ; const int q0=qb*QB;
  const bf16*Qw=Q+(rowbase+q0+wid*QBLK)*DM+h*D;
  const bf16*Kh=K+rowbase*DM+h*D,*Vh=V+rowbase*DM+h*D;
  const unsigned lds0=(unsigned)(uintptr_t)shm;
  float*wsf=(float*)(shm+LDS_WS)+wid*64;
  const unsigned kvoff=(unsigned)(lane*DM+wid*8)*2u;
  const unsigned vvoff=(unsigned)((16*(wid&3)+(lane>>2))*DM+(wid>>2)*32+(lane&3)*8)*2u;
  const unsigned kdst=lds0+LDS_K+wid*1024, vdst=lds0+LDS_V+wid*1024;
  #define DMA_K(t,slot) glds16(Kh+(long)(NTF-1-(t))*KVBLK*DM,kvoff,(unsigned)__builtin_amdgcn_readfirstlane(kdst+(slot)))
  #define DMA_V(t,slot) glds16(Vh+(long)(NTF-1-(t))*KVBLK*DM,vvoff,(unsigned)__builtin_amdgcn_readfirstlane(vdst+(slot)))
  const int vb0=(int)(lds0+LDS_V)+((lane>>4)&1)*32+(lane&3)*8+(4*hi+((lane&15)>>2))*64;
  const char*Kbase=shm+LDS_K; bf16x8 kf[8];
  const lds_cptr shm3=(lds_cptr)shm; const lds_cptr kp0=shm3+LDS_K+hi*1024+r32*16; const lds_cptr vp0=shm3+LDS_V+((lane>>4)&1)*32+(lane&3)*8+(4*hi+((lane&15)>>2))*64;
  const int NTF=(q0+QB)/KVBLK;
  int NT=NTF;
  { const float*nq=nrm+(long)(b*2+0)*16+2*h,*nk=nrm+(long)(b*2+1)*16+2*h; const float B=__builtin_sqrtf((nq[0]+nq[1])*(nk[0]+nk[1]))*1.02f+0.5f;
    const float slope2_=__uint_as_float(0x3FB8AA3Bu-((unsigned)(h+1)<<23)); const float dh=(160.f+2.f*B)/slope2_;
    const float tminf=((float)(q0-63)-dh)*(1.f/64.f); int tmin=tminf>0.f?(int)tminf:0;
    tmin=__builtin_amdgcn_readfirstlane(tmin); int nt=NTF-tmin; nt+=nt&1; if(nt>NTF)nt=NTF; if(nt<4)nt=4; NT=nt; }
  { float*ksl=(float*)(shm+LDS_KSL); const float k0=ksum[(long)(b*16+(tid>>6))*512+h*64+(tid&63)],k1=ksum[(long)(b*16+8+(tid>>6))*512+h*64+(tid&63)]; ksl[tid]=k0; ksl[512+tid]=k1; }
  DMA_K(0,0);DMA_V(0,0);DMA_K(1,SLOTB);
  bf16x8 qr[4];
  #pragma unroll
  for(int d0=0;d0<4;++d0)qr[d0]=*reinterpret_cast<const bf16x8*>(&Qw[(long)r32*DM+d0*16+hi*8]);
  float mhat=0.f,l_reg=0.f;f32x16 o[2];o[0]=f32x16{};o[1]=f32x16{};const f32x16 zero16=f32x16{};
  const int qrel=wid*QBLK+r32;
  #define CMASK(P0,P1,t) do{int jb_=3-(t); if(jb_>=0)cmask(P0,P1,jb_,qrel,hi);}while(0)
  const unsigned sl2b=0x3FB8AA3Bu-((unsigned)(h+1)<<23);
  const float slope2=__uint_as_float(sl2b), s2x=__uint_as_float(sl2b+(1u<<23)), s8x=__uint_as_float(sl2b+(3u<<23)), s32=__uint_as_float(sl2b+(5u<<23));
  const float s3x=__uint_as_float((unsigned)__builtin_amdgcn_readfirstlane((int)__float_as_uint(slope2*3.0f)));
  #define NBSEL(r) (((r)>>2)==0?nbb0_:((r)>>2)==1?nbb1_:((r)>>2)==2?nbb2_:nbb3_)
  #define NEGV(r) ((((r)&3)==0)?NBSEL(r):(NBSEL(r)+(((r)&3)==1?slope2:((r)&3)==2?s2x:s3x)))
  #define NBB(nb) const float nbb0_=(nb), nbb1_=nbb0_+s8x, nbb2_=nbb1_+s8x, nbb3_=nbb2_+s8x
  #define NBSELC(r) (((r)>>2)==0?nbc0_:((r)>>2)==1?nbc1_:((r)>>2)==2?nbc2_:nbc3_)
  #define SAV(r) (((r)&3)==1?slope2:((r)&3)==2?s2x:s3x)
  #define BIAS(C0,C1,s) do{ NBB(NBV(s)); const float nbc0_=nbb0_+s32,nbc1_=nbb1_+s32,nbc2_=nbb2_+s32,nbc3_=nbb3_+s32; \
      _Pragma("unroll") for(int r=0;r<16;++r){ if((r&3)==0){C0[r]+=NBSEL(r);C1[r]+=NBSELC(r);} else {C0[r]=(C0[r]+NBSEL(r))+SAV(r);C1[r]=(C1[r]+NBSELC(r))+SAV(r);} } }while(0)
  unsigned sel=0u;
  #define NBV(s) ({ const int tl_=NTF-1-(s); const int tc_=tl_<0?0:tl_; const int bj_=tc_>>2; const float off_=(bj_>=qb||((sel>>bj_)&1u))?0.f:-1.0e30f; \
      __builtin_fmaf(slope2,(float)(64*tl_+4*hi-q0-qrel),off_-mhat); })
  #define CRC(r) ((float)(((r)&3)+8*((r)>>2)))
  bool resc=false;
  #define START(P0,P1) do{ const float rm=rowmax(P0,P1); resc=false; \
    { const float dl=(rm>-1.0e20f)?rm:0.f; mhat=fadd_s(mhat,dl); \
      _Pragma("unroll") for(int r=0;r<16;++r){P0[r]=fsub_s(P0[r],dl);P1[r]=fsub_s(P1[r],dl);} } \
    _Pragma("unroll") for(int r=0;r<16;++r)P0[r]=__builtin_amdgcn_exp2f(P0[r]); }while(0)
  #define RESC() do{ if(resc){ asm volatile("s_waitcnt lgkmcnt(0)":::"memory"); \
      _Pragma("unroll") for(int d_=0;d_<2;++d_) _Pragma("unroll") for(int r=0;r<16;++r)o[d_][r]*=wsf[crow(r,hi)]; } }while(0)
  f32x16 pA0,pA1,pB0,pB1;
  int sl_prev=0,sl_cur=0,sl_next=SLOTB;
  #define ROT() do{sl_prev=sl_cur;sl_cur=sl_next;sl_next=(sl_next==(NSLOT-1)*SLOTB)?0:sl_next+SLOTB;}while(0)
  DMA_K(2,2*SLOTB);
  WAIT_BAR(3);
  if(qb>0){
    float qf[32];
    _Pragma("unroll") for(int d0=0;d0<4;++d0) _Pragma("unroll") for(int e=0;e<8;++e) qf[d0*8+e]=__uint_as_float(((unsigned)(unsigned short)qr[d0][e])<<16);
    const float*ksl=(const float*)(shm+LDS_KSL)+8*hi;
    float b1=-3.0e38f,b2=-3.0e38f,b3=-3.0e38f; int i1=-1,i2=-1,i3=-1;
    for(int j=0;j<qb;++j){ float g=0.f;
      _Pragma("unroll") for(int d0=0;d0<4;++d0) _Pragma("unroll") for(int e=0;e<8;++e) g=__builtin_fmaf(qf[d0*8+e],ksl[j*64+16*d0+e],g);
      { auto rr=__builtin_amdgcn_permlane32_swap(__float_as_uint(g),__float_as_uint(g),false,false); g=__uint_as_float(rr[0])+__uint_as_float(rr[1]); }
      const bool c1=g>b1,c2=g>b2,c3=g>b3;
      b3=c2?b2:(c3?g:b3); i3=c2?i2:(c3?j:i3); b2=c1?b1:(c2?g:b2); i2=c1?i1:(c2?j:i2); b1=c1?g:b1; i1=c1?j:i1; }
    sel=(1u<<i1)|(i2>=0?(1u<<i2):0u)|(i3>=0?(1u<<i3):0u); }
  qkt(pA0,pA1,Kbase,qr,zero16,r32,hi);asm volatile("s_nop 15\n\ts_nop 7":"+v"(pA0),"+v"(pA1));
  BIAS(pA0,pA1,0);
  CMASK(pA0,pA1,0);
  START(pA0,pA1);
  _Pragma("unroll") for(int r=0;r<16;++r)pA1[r]=__builtin_amdgcn_exp2f(pA1[r]);
  WAIT_BAR(0);
  DMA_K(3,0);DMA_V(1,SLOTB);
  ROT();
  kload8(kf,kp0+sl_cur);
  WAIT_BAR(2);
  s16x4 vlo[8],vhi[8]; u32x4 pw0,pw1,pw2,pw3;
  #define PKW(P,B) cvtpk_s(P[B],P[B+1])
  #define PAF(k) __builtin_bit_cast(bf16x8,pw##k)
  #define VFR(i) (bf16x8){vlo[i][0],vlo[i][1],vlo[i][2],vlo[i][3],vhi[i][0],vhi[i][1],vhi[i][2],vhi[i][3]}
  #define PIN(x) asm volatile("":"+v"(x))
  #define MX3(a,b,c) __builtin_fmaxf(__builtin_fmaxf((a),(b)),(c))
  #define GAPA(MF,A0,A1,A2,A3,W0,W1,PW) do{ MF; sacc+=A0; sacc+=A1; sacc+=A2; sacc+=A3; PIN(sacc); W0; W1; PIN(PW); SBAR(); }while(0)
  #define EX(v) __builtin_amdgcn_exp2f(v)
  #define GAPB(MF,X,B) do{ MF; X[B]=EX(X[B]); X[B+1]=EX(X[B+1]); X[B+2]=EX(X[B+2]); X[B+3]=EX(X[B+3]); PIN(X); SBAR(); }while(0)
  #define VRD(i) do{ vlo[i]=vtr(vp_+(((i)>>2)*4096+((i)&3)*1024)); vhi[i]=vtr(vp_+(((i)>>2)*4096+((i)&3)*1024+512)); }while(0)
  #define KRD(G,j) do{ if(G){ kload2(kf,kp0+sl_next,j); SBAR(); } }while(0)
  #define STEP(C0,C1,P0,P1,t,GK,GV,GL) do{ SBAR(); \
    const lds_cptr vp_=vp0+sl_prev; \
    VRD(0); SBAR(); float sacc=(P0[0]+P0[1]); \
    GAPA(C0=__builtin_amdgcn_mfma_f32_32x32x16_bf16(kf[0],qr[0],zero16,0,0,0), P0[2],P0[3],P0[4],P0[5],     pw0[0]=PKW(P0,0), pw0[1]=PKW(P0,2), pw0); \
    VRD(4); SBAR(); GAPA(C1=__builtin_amdgcn_mfma_f32_32x32x16_bf16(kf[1],qr[0],zero16,0,0,0), P0[6],P0[7],P0[8],P0[9],     pw0[2]=PKW(P0,4), pw0[3]=PKW(P0,6), pw0); \
    VRD(1); SBAR(); GAPA(C0=__builtin_amdgcn_mfma_f32_32x32x16_bf16(kf[2],qr[1],C0,0,0,0),   P0[10],P0[11],P0[12],P0[13], pw1[0]=PKW(P0,8), pw1[1]=PKW(P0,10), pw1); \
    VRD(5); SBAR(); GAPA(C1=__builtin_amdgcn_mfma_f32_32x32x16_bf16(kf[3],qr[1],C1,0,0,0),   P0[14],P0[15],P1[0],P1[1],   pw1[2]=PKW(P0,12),pw1[3]=PKW(P0,14), pw1); \
    VRD(2); SBAR(); GAPA(C0=__builtin_amdgcn_mfma_f32_32x32x16_bf16(kf[4],qr[2],C0,0,0,0),   P1[2],P1[3],P1[4],P1[5],     pw2[0]=PKW(P1,0), pw2[1]=PKW(P1,2), pw2); \
    VRD(6); SBAR(); GAPA(C1=__builtin_amdgcn_mfma_f32_32x32x16_bf16(kf[5],qr[2],C1,0,0,0),   P1[6],P1[7],P1[8],P1[9],     pw2[2]=PKW(P1,4), pw2[3]=PKW(P1,6), pw2); \
    VRD(3); SBAR(); GAPA(C0=__builtin_amdgcn_mfma_f32_32x32x16_bf16(kf[6],qr[3],C0,0,0,0),   P1[10],P1[11],P1[12],P1[13], pw3[0]=PKW(P1,8), pw3[1]=PKW(P1,10), pw3); \
    VRD(7); SBAR(); GAPA(C1=__builtin_amdgcn_mfma_f32_32x32x16_bf16(kf[7],qr[3],C1,0,0,0),   P1[14],P1[15],0.f,0.f,       pw3[2]=PKW(P1,12),pw3[3]=PKW(P1,14), pw3); \
    l_reg+=sacc; \
    if(GK){DMA_K((t)+3,sl_cur);} if(GV){DMA_V((t)+1,sl_next);} \
    BIAS(C0,C1,t); \
    CMASK(C0,C1,t); \
    { float a=MX3(C0[0],C0[1],C1[0]),b=MX3(C0[2],C0[3],C1[1]); a=MX3(a,C1[2],C1[3]); \
      _Pragma("unroll") for(int r=4;r<16;r+=4){a=MX3(a,C0[r],C0[r+1]);b=MX3(b,C0[r+2],C0[r+3]);a=MX3(a,C1[r],C1[r+1]);b=MX3(b,C1[r+2],C1[r+3]);} \
      float rm=__builtin_fmaxf(a,b); { auto rr=__builtin_amdgcn_permlane32_swap(__float_as_uint(rm),__float_as_uint(rm),false,false); rm=__builtin_fmaxf(__uint_as_float(rr[0]),__uint_as_float(rr[1])); } \
      resc=false; \
      if(__builtin_expect(__any(rm>(float)THRL),0)){ const float dl=__builtin_fmaxf(rm,0.f); mhat+=dl; \
        _Pragma("unroll") for(int r=0;r<16;++r){C0[r]-=dl;C1[r]-=dl;} \
        const float f=__builtin_amdgcn_exp2f(-dl); l_reg*=f; if(hi==0)wsf[r32]=f; resc=true; } } \
    SBAR(); \
    GAPB(o[0]=__builtin_amdgcn_mfma_f32_32x32x16_bf16(PAF(0),VFR(0),o[0],0,0,0), C0,0); \
    GAPB(o[1]=__builtin_amdgcn_mfma_f32_32x32x16_bf16(PAF(0),VFR(4),o[1],0,0,0), C0,4); \
    KRD(GL,0); GAPB(o[0]=__builtin_amdgcn_mfma_f32_32x32x16_bf16(PAF(1),VFR(1),o[0],0,0,0), C0,8); \
    KRD(GL,1); GAPB(o[1]=__builtin_amdgcn_mfma_f32_32x32x16_bf16(PAF(1),VFR(5),o[1],0,0,0), C0,12); \
    KRD(GL,2); GAPB(o[0]=__builtin_amdgcn_mfma_f32_32x32x16_bf16(PAF(2),VFR(2),o[0],0,0,0), C1,0); \
    KRD(GL,3); GAPB(o[1]=__builtin_amdgcn_mfma_f32_32x32x16_bf16(PAF(2),VFR(6),o[1],0,0,0), C1,4); \
    GAPB(o[0]=__builtin_amdgcn_mfma_f32_32x32x16_bf16(PAF(3),VFR(3),o[0],0,0,0), C1,8); \
    GAPB(o[1]=__builtin_amdgcn_mfma_f32_32x32x16_bf16(PAF(3),VFR(7),o[1],0,0,0), C1,12); \
    }while(0)
  int t=1;
  #define ENDW(tt) do{ if((tt)+3<NT){WAIT_BAR(2);} else if((tt)+2<NT){WAIT_BAR(1);} else {WAIT_BAR(0);} }while(0)
  #define PEELED_PAIR() do{ \
    STEP(pB0,pB1,pA0,pA1,t,(t+3<NT),(t+1<NT),(t+1<NT));       ENDW(t);   RESC(); ROT(); \
    STEP(pA0,pA1,pB0,pB1,t+1,(t+4<NT),(t+2<NT),(t+2<NT));     ENDW(t+1); RESC(); ROT(); }while(0)
  for(;t<5&&t+1<NT;t+=2){ PEELED_PAIR(); }
  #undef CMASK
  #define CMASK(P0,P1,t) do{}while(0)
  for(;t+5<NT;t+=2){
    STEP(pB0,pB1,pA0,pA1,t,true,true,true);     WAIT_BAR(2); RESC(); ROT();
    STEP(pA0,pA1,pB0,pB1,t+1,true,true,true);   WAIT_BAR(2); RESC(); ROT();
  }
  #undef CMASK
  #define CMASK(P0,P1,t) do{int jb_=3-(t); if(jb_>=0)cmask(P0,P1,jb_,qrel,hi);}while(0)
  for(;t+1<NT;t+=2){ PEELED_PAIR(); }
  STEP(pB0,pB1,pA0,pA1,NT-1,false,false,false); RESC();
  { float sacc=pB0[0]+pB0[1]; _Pragma("unroll") for(int r=2;r<16;++r)sacc+=pB0[r]; _Pragma("unroll") for(int r=0;r<16;++r)sacc+=pB1[r]; l_reg+=sacc;
    pw0=(u32x4){PKW(pB0,0),PKW(pB0,2),PKW(pB0,4),PKW(pB0,6)};pw1=(u32x4){PKW(pB0,8),PKW(pB0,10),PKW(pB0,12),PKW(pB0,14)};pw2=(u32x4){PKW(pB1,0),PKW(pB1,2),PKW(pB1,4),PKW(pB1,6)};pw3=(u32x4){PKW(pB1,8),PKW(pB1,10),PKW(pB1,12),PKW(pB1,14)};
    SBAR(); pv(o,vb0+sl_cur,PAF(0),PAF(1),PAF(2),PAF(3)); }
  #undef PKW
  #undef PAF
  #undef VFR
  #undef PIN
  #undef MX3
  #undef GAPA
  #undef GAPB
  #undef EX
  #undef VRD
  #undef KRD
  #undef STEP
  #undef ENDW
  #undef PEELED_PAIR
  #undef NBV
  #undef CRC
  #undef NEGV
  #undef NBSEL
  #undef NBB
  #undef NBSELC
  #undef SAV
  #undef BIAS
  {auto rr=__builtin_amdgcn_permlane32_swap(__float_as_uint(l_reg),__float_as_uint(l_reg),false,false);l_reg=__uint_as_float(rr[0])+__uint_as_float(rr[1]);}
  if(hi==0)wsf[32+r32]=l_reg;asm volatile("s_waitcnt lgkmcnt(0)":::"memory");
  float rli[16];
  #pragma unroll
  for(int r=0;r<16;++r)rli[r]=__builtin_amdgcn_rcpf(wsf[32+crow(r,hi)]);
  bf16*Ow=O+(rowbase+q0+wid*QBLK)*DM+h*D;
  { bf16*stg=(bf16*)(shm+LDS_OST)+wid*2048;
    #pragma unroll
    for(int r=0;r<16;++r){const int orow=crow(r,hi);
      #pragma unroll
      for(int d0=0;d0<2;++d0)stg[orow*64+d0*32+r32]=__float2bfloat16(o[d0][r]*rli[r]);}
    asm volatile("s_waitcnt lgkmcnt(0)":::"memory");
    #pragma unroll
    for(int i=0;i<4;++i){const int row=i*8+(lane>>3),ch=lane&7; const u32x4 v=*(const u32x4*)(stg+row*64+ch*8); ATTN_STORE16(Ow+(long)row*DM+ch*8,v);} }
  asm volatile("s_waitcnt lgkmcnt(0)\n\ts_barrier":::"memory");
  #undef DMA_K
  #undef DMA_V
  #undef CMASK
  #undef START
  #undef RESC
  #undef ROT
}
constexpr int ATTN_LDS_BYTES=LDS_BYTES;
struct AttnTensors { const bf16* Q; const bf16* K; const bf16* V; bf16* O; };
struct AttnUnit { int bh; int qb; };
struct AttnPlan { unsigned char unit[32][12]; unsigned char n[32]; };
constexpr int attn_nominal_cost(int h,int qb){ const int pmax[8]={7,12,22,41,64,64,64,64}; const int past=4*qb<pmax[h]?4*qb:pmax[h]; return 4+past+2; }
constexpr AttnPlan make_attn_plan(){
  AttnPlan p{}; int load[32]={}; bool used[128]={};
  for(int it=0;it<128;++it){ int best=-1,bc=-1; for(int e=0;e<128;++e){ if(used[e])continue; const int c=attn_nominal_cost(e>>4,e&15); if(c>bc){bc=c;best=e;} }
    used[best]=true; int cu=0; for(int c=1;c<32;++c) if(load[c]<load[cu]||(load[c]==load[cu]&&p.n[c]<p.n[cu]))cu=c;
    if(p.n[cu]>=12){ for(int c=0;c<32;++c) if(p.n[c]<12){cu=c;break;} }
    p.unit[cu][p.n[cu]++]=(unsigned char)best; load[cu]+=bc; }
  return p; }
__device__ const AttnPlan g_attn_plan=make_attn_plan();
struct StaticOrder {
  int vcu,G;
  __device__ __forceinline__ explicit StaticOrder(int grid,int vcu_):vcu(vcu_),G(grid){}
  __device__ __forceinline__ bool next(int i,AttnUnit&u)const{
    if(G!=256){ const int id=vcu+i*G; if(id>=BATCH*NHEAD*NQB)return false; u.bh=id>>4; u.qb=id&15; return true; }
    const int c=vcu&31; if(i>=(int)g_attn_plan.n[c])return false; const int e=g_attn_plan.unit[c][i]; u.bh=(vcu>>5)*NHEAD+(e>>4); u.qb=e&15; return true; }
};
template<class Sched,int THRL=8> __device__ __forceinline__ void attn_phase(char*lds,const AttnTensors&T,const float*ksum,const float*nrm,const Sched&S){
  AttnUnit u;
  for(int i=0;S.next(i,u);++i){ attn_unit<THRL>(u.bh/NHEAD,u.bh%NHEAD,u.qb,T.Q,T.K,T.V,T.O,ksum,nrm,lds); }
}
#undef SBAR
#undef WAIT_BAR
}

__device__ __forceinline__ void pooled_phase(Frame& F, const Args& A) {
    const bf16* P = (const bf16*)(A.ws + WS_QKVP) + (size_t)3 * T * 512; bf16* PO = (bf16*)(A.ws + WS_POOLED);
    const int gw = F.vcu * NWAVES + F.wave, NGW = F.G * NWAVES, lane = F.lane, w = 2 << (lane >> 4);
    for (int tk = gw; tk < T / 16; tk += NGW) {
        const int row0 = tk * 16, s0 = row0 & (SEQ - 1);
        v4u rv[31];
#pragma unroll
        for (int i = 0; i < 31; ++i) { const int sidx = s0 - 15 + i; rv[i] = (sidx >= 0) ? *(const v4u*)(P + (size_t)(row0 - 15 + i) * 512 + 8 * lane) : (v4u){0u, 0u, 0u, 0u}; }
#pragma unroll
        for (int i = 0; i < 16; ++i) {
            const int sidx = s0 + i; float acc[8];
#pragma unroll
            for (int e = 0; e < 8; ++e) acc[e] = 0.f;
#pragma unroll
            for (int k = 0; k < 16; ++k) { const bool ok = (k < w) && (sidx - k >= 0); const v4u x = rv[15 + i - k]; const float msk = ok ? 1.0f : 0.0f;
                acc[0] += msk * bflo(x.x); acc[1] += msk * bfhi(x.x); acc[2] += msk * bflo(x.y); acc[3] += msk * bfhi(x.y); acc[4] += msk * bflo(x.z); acc[5] += msk * bfhi(x.z); acc[6] += msk * bflo(x.w); acc[7] += msk * bfhi(x.w); }
            const float inv = 1.0f / (float)min(sidx + 1, w); const v4u x = rv[15 + i];
            v4u o; o.x = pk2(acc[0] * inv - bflo(x.x), acc[1] * inv - bfhi(x.x)); o.y = pk2(acc[2] * inv - bflo(x.y), acc[3] * inv - bfhi(x.y));
            o.z = pk2(acc[4] * inv - bflo(x.z), acc[5] * inv - bfhi(x.z)); o.w = pk2(acc[6] * inv - bflo(x.w), acc[7] * inv - bfhi(x.w));
            *(v4u*)(PO + (size_t)(row0 + i) * 512 + 8 * lane) = o;
        }
    }
}

typedef float f32x2 __attribute__((ext_vector_type(2)));
typedef int v4i __attribute__((ext_vector_type(4)));
__device__ __forceinline__ void h2q_rows4(const Args& A, int t0, int lane) {
    const float* modf = (const float*)(A.ws + WS_MODF); const float* ss2 = (const float*)(A.ws + WS_SS2); const float* g2 = A.in[12];
    const int b = t0 / SEQ;
    f32x4 xv[4][4];
#pragma unroll
    for (int u = 0; u < 4; ++u)
#pragma unroll
        for (int q = 0; q < 4; ++q) xv[u][q] = *(const f32x4*)(A.out + (size_t)(t0 + u) * D + 16 * lane + 4 * q);
    f32x4 G[4], S[4];
#pragma unroll
    for (int q = 0; q < 4; ++q) { const int c = 16 * lane + 4 * q; G[q] = *(const f32x4*)(g2 + c) * (*(const f32x4*)(modf + (size_t)b * 6144 + 4096 + c) + 1.0f); S[q] = *(const f32x4*)(modf + (size_t)b * 6144 + 3072 + c); }
#pragma unroll
    for (int u = 0; u < 4; ++u) {
        const f32x4* sp = (const f32x4*)(ss2 + (size_t)(t0 + u) * 16); const f32x4 s4 = (sp[0] + sp[1]) + (sp[2] + sp[3]);
        const float rs = 1.0f / sqrtf(((s4[0] + s4[1]) + (s4[2] + s4[3])) * (1.0f / D) + RMS_EPS);
        float h2[16]; float am = 0.f;
#pragma unroll
        for (int q = 0; q < 4; ++q)
#pragma unroll
            for (int e = 0; e < 4; ++e) { const float h = xv[u][q][e] * rs * G[q][e] + S[q][e]; h2[4 * q + e] = h; am = fmaxf(am, fabsf(h)); }
        am = fmaxf(am, __shfl_xor(am, 1)); am = fmaxf(am, __shfl_xor(am, 2)); am = fmaxf(am, __shfl_xor(am, 4));
        const float hs = (am > 0.f) ? am * (1.0f / 127.0f) : 1.0f, hinv = 1.0f / hs;
        v4u o;
#pragma unroll
        for (int q = 0; q < 4; ++q) { const int q0 = (int)rintf(h2[4 * q] * hinv), q1 = (int)rintf(h2[4 * q + 1] * hinv), q2 = (int)rintf(h2[4 * q + 2] * hinv), q3 = (int)rintf(h2[4 * q + 3] * hinv);
            o[q] = (unsigned)(q0 & 255) | ((unsigned)(q1 & 255) << 8) | ((unsigned)(q2 & 255) << 16) | ((unsigned)q3 << 24); }
        *(v4u*)(A.ws + WS_H2Q + (size_t)(t0 + u) * D + 16 * lane) = o;
        if ((lane & 7) == 0) ((float*)(A.ws + WS_HS))[(size_t)(t0 + u) * 8 + (lane >> 3)] = hs;
    }
}

namespace rt {
typedef float f32x16 __attribute__((ext_vector_type(16)));
typedef short bf16x8 __attribute__((ext_vector_type(8)));
__device__ __forceinline__ void ce(float& hi, float& lo) { const float a = fmaxf(hi, lo), b = fminf(hi, lo); hi = a; lo = b; }
template <int N> __device__ __forceinline__ void sort_desc(float (&v)[N]) {
#pragma unroll
    for (int k = 2; k <= N; k <<= 1)
#pragma unroll
        for (int j = k >> 1; j > 0; j >>= 1)
#pragma unroll
            for (int i = 0; i < N; ++i) { const int l = i ^ j; if (l > i) { if ((i & k) == 0) ce(v[i], v[l]); else ce(v[l], v[i]); } }
}
__device__ __forceinline__ void sort16_desc(float (&v)[16]) {
    ce(v[0], v[13]); ce(v[1], v[12]); ce(v[2], v[15]); ce(v[3], v[14]); ce(v[4], v[8]); ce(v[5], v[6]); ce(v[7], v[11]); ce(v[9], v[10]);
    ce(v[0], v[5]); ce(v[1], v[7]); ce(v[2], v[9]); ce(v[3], v[4]); ce(v[6], v[13]); ce(v[8], v[14]); ce(v[10], v[15]); ce(v[11], v[12]);
    ce(v[0], v[1]); ce(v[2], v[3]); ce(v[4], v[5]); ce(v[6], v[8]); ce(v[7], v[9]); ce(v[10], v[11]); ce(v[12], v[13]); ce(v[14], v[15]);
    ce(v[0], v[2]); ce(v[1], v[3]); ce(v[4], v[10]); ce(v[5], v[11]); ce(v[6], v[7]); ce(v[8], v[9]); ce(v[12], v[14]); ce(v[13], v[15]);
    ce(v[1], v[2]); ce(v[3], v[12]); ce(v[4], v[6]); ce(v[5], v[7]); ce(v[8], v[10]); ce(v[9], v[11]); ce(v[13], v[14]);
    ce(v[1], v[4]); ce(v[2], v[6]); ce(v[5], v[8]); ce(v[7], v[10]); ce(v[9], v[13]); ce(v[11], v[14]);
    ce(v[2], v[4]); ce(v[3], v[6]); ce(v[9], v[12]); ce(v[11], v[13]);
    ce(v[3], v[5]); ce(v[6], v[8]); ce(v[7], v[9]); ce(v[10], v[12]);
    ce(v[3], v[4]); ce(v[5], v[6]); ce(v[7], v[8]); ce(v[9], v[10]); ce(v[11], v[12]);
    ce(v[6], v[7]); ce(v[8], v[9]);
}
template <int N> __device__ __forceinline__ void bitonic_merge_desc(float (&v)[N]) {
#pragma unroll
    for (int j = N >> 1; j > 0; j >>= 1)
#pragma unroll
        for (int i = 0; i < N; ++i) { const int l = i ^ j; if (l > i) ce(v[i], v[l]); }
}
__device__ __forceinline__ void merge_top16(float (&a)[16], const float (&b)[16]) {
#pragma unroll
    for (int i = 0; i < 16; ++i) a[i] = fmaxf(a[i], b[15 - i]);
    bitonic_merge_desc<16>(a);
}
template <bool SORT> __device__ __forceinline__ void pair_merge(float (&a)[16], bool hi) {
    float w[16];
#pragma unroll
    for (int i = 0; i < 16; ++i) w[i] = hi ? a[15 - i] : a[i];
#pragma unroll
    for (int i = 0; i < 16; ++i) { const auto rr = __builtin_amdgcn_permlane32_swap(__float_as_uint(w[i]), __float_as_uint(w[i]), false, false); a[i] = fmaxf(__uint_as_float(rr[0]), __uint_as_float(rr[1])); }
    if (SORT) bitonic_merge_desc<16>(a);
}
__device__ __forceinline__ void fold_tile(const f32x16& acc, int kt, int hi, float (&out)[16]) {
    float g[16];
#pragma unroll
    for (int r = 0; r < 16; ++r) { const unsigned key = (unsigned)(32 * kt + (r & 3) + 8 * (r >> 2)); g[r] = __uint_as_float((__float_as_uint(acc[r]) & ~127u) | key | ((unsigned)hi << 2)); }
    sort16_desc(g);
    if (kt == 0) {
#pragma unroll
        for (int r = 0; r < 16; ++r) out[r] = g[r];
    } else merge_top16(out, g);
}
}
__device__ __forceinline__ void router_phase(Frame& F, const Args& A) {
    using namespace rt;
    const bf16* QP = (const bf16*)(A.ws + WS_GAB); const bf16* SK = (const bf16*)(A.ws + WS_SUBK);
    unsigned short* IDX = (unsigned short*)(A.ws + WS_POOLED); float* GATE = (float*)(A.ws + WS_POOLED + 16 * MiB);
    const int lane = F.lane, n32 = lane & 31, hi = lane >> 5, gw = F.vcu * NWAVES + F.wave, NGW = F.G * NWAVES;
    __syncthreads();
    for (int i = F.tid; i < 2 * 128 * 16; i += NTHREADS) { const int r = i >> 4, ch = i & 15; *(LAS v4u*)(F.lds + r * 272 + ch * 16) = *(const v4u*)(SK + (size_t)r * 128 + ch * 8); }
    __syncthreads();
    LAS unsigned char* scr = F.lds + 73728 + F.wave * 1024;
    const LAS unsigned char* afrag = F.lds + n32 * 272 + hi * 16;
    bf16x8 qa[8], qb[8];
#define RT_QLOAD(task_, p_, q_) do { const int tq_ = (task_) * 4 + (n32 >> 3); const bf16* qr_ = QP + (size_t)tq_ * PQW + (n32 & 7) * 256 + (p_) * 128 + 8 * hi; \
        _Pragma("unroll") for (int i = 0; i < 8; ++i) q_[i] = __builtin_nontemporal_load((const bf16x8*)(qr_ + 16 * i)); } while (0)
#define RT_HALF(p_, q_, out_) do { _Pragma("unroll") for (int kt = 0; kt < 4; ++kt) { f32x16 acc = f32x16{}; \
        _Pragma("unroll") for (int ks = 0; ks < 8; ++ks) { const bf16x8 kf = *(const LAS bf16x8*)(afrag + ((p_) * 128 + 32 * kt) * 272 + 32 * ks); acc = __builtin_amdgcn_mfma_f32_32x32x16_bf16(kf, q_[ks], acc, 0, 0, 0); } \
        fold_tile(acc, kt, hi, out_); } pair_merge<true>(out_, hi != 0); } while (0)
    if (gw < T * PHEADS / 32) RT_QLOAD(gw, 0, qa);
#ifdef TABLES_IN_ROUTER
    int tr0 = gw; const bool late_trip = F.wave >= 4;
#define RT_TABLE_TRIP(cond_) do { if (cond_) { asm volatile("" ::: "memory"); if (tr0 < 2 * PEXP) { p0_table_trip(A, tr0, NGW, lane); tr0 += 4 * NGW; } asm volatile("" ::: "memory"); h2q_rows4(A, task * 4, lane); asm volatile("" ::: "memory"); } } while (0)
#else
#define RT_TABLE_TRIP(cond_) do { } while (0)
#endif
    for (int task = gw; task < T * PHEADS / 32; task += NGW) {
        const int t = task * 4 + (n32 >> 3), h = n32 & 7;
        float la[16], lb[16];
        RT_TABLE_TRIP(!late_trip);
        RT_QLOAD(task, 1, qb);
        RT_HALF(0, qa, la);
        { const int nxt = task + NGW; if (nxt < T * PHEADS / 32) RT_QLOAD(nxt, 0, qa); }
        RT_HALF(1, qb, lb);
        { unsigned w[4];
#pragma unroll
          for (int q = 0; q < 4; ++q) {
              const unsigned i0 = __float_as_uint(hi ? lb[4 * q] : la[4 * q]) & 127u, i1 = __float_as_uint(hi ? lb[4 * q + 1] : la[4 * q + 1]) & 127u, i2 = __float_as_uint(hi ? lb[4 * q + 2] : la[4 * q + 2]) & 127u, i3 = __float_as_uint(hi ? lb[4 * q + 3] : la[4 * q + 3]) & 127u;
              w[q] = i0 | (i1 << 8) | (i2 << 16) | (i3 << 24); }
          *(LAS v4u*)(scr + n32 * 32 + hi * 16) = (v4u){w[0], w[1], w[2], w[3]}; }
        float x[16], y[16];
#pragma unroll
        for (int i = 0; i < 16; ++i) { const float av = __uint_as_float(__float_as_uint(la[i]) & ~127u), bv = __uint_as_float(__float_as_uint(lb[i]) & ~127u); x[i] = hi ? bv : av; y[i] = hi ? av : bv; }
        float c0[16], c1[16];
        {
            const unsigned hb = (unsigned)hi << 8;
#define RT_CAND(i, j) __uint_as_float(((__float_as_uint(x[i] + y[j]) & ~511u) | (unsigned)((i) * 16 + (j))) | hb)
#define RT_DIAG(i) (hi ? -3.0e38f : RT_CAND(i, i))
            c0[0] = RT_DIAG(0);
#pragma unroll
            for (int j = 1; j < 16; ++j) c0[j] = RT_CAND(0, j);
            c1[0] = RT_DIAG(1);
#pragma unroll
            for (int j = 2; j < 8; ++j) c1[j - 1] = RT_CAND(1, j);
            c1[7] = RT_DIAG(2); c1[8] = RT_CAND(2, 3); c1[9] = RT_CAND(2, 4); c1[10] = RT_DIAG(3);
#pragma unroll
            for (int k = 11; k < 16; ++k) c1[k] = -3.0e38f;
#undef RT_CAND
#undef RT_DIAG
        }
        sort16_desc(c0); sort16_desc(c1); merge_top16(c0, c1);
        pair_merge<false>(c0, hi != 0);
        float mx = c0[0];
#pragma unroll
        for (int i = 1; i < 16; ++i) mx = fmaxf(mx, c0[i]);
        float ex[16], sm = 0.f;
#pragma unroll
        for (int i = 0; i < 16; ++i) { ex[i] = __expf(__uint_as_float(__float_as_uint(c0[i]) & ~511u) - mx); sm += ex[i]; }
        const float inv = 1.0f / sm;
        asm volatile("s_waitcnt lgkmcnt(0)" ::: "memory");
        int eo[8]; float go[8];
#pragma unroll
        for (int k = 0; k < 8; ++k) { const float wv = hi ? c0[8 + k] : c0[k]; go[k] = (hi ? ex[8 + k] : ex[k]) * inv;
            const unsigned bits = __float_as_uint(wv), fromhi = (bits >> 8) & 1u, xi = (bits >> 4) & 15u, yj = bits & 15u;
            const unsigned ar = fromhi ? yj : xi, br = fromhi ? xi : yj;
            const unsigned e1 = scr[n32 * 32 + ar], e2 = scr[n32 * 32 + 16 + br];
            eo[k] = (int)(e1 * 128u + e2); }
        unsigned short* ip = IDX + (size_t)t * PSEL + h * PTOP + 8 * hi; float* gp = GATE + (size_t)t * PSEL + h * PTOP + 8 * hi;
        *(v4u*)ip = (v4u){(unsigned)eo[0] | ((unsigned)eo[1] << 16), (unsigned)eo[2] | ((unsigned)eo[3] << 16), (unsigned)eo[4] | ((unsigned)eo[5] << 16), (unsigned)eo[6] | ((unsigned)eo[7] << 16)};
        *(f32x4*)gp = (f32x4){go[0], go[1], go[2], go[3]}; *(f32x4*)(gp + 4) = (f32x4){go[4], go[5], go[6], go[7]};
        asm volatile("s_waitcnt lgkmcnt(0)" ::: "memory");
        RT_TABLE_TRIP(late_trip);
    }
#ifdef TABLES_IN_ROUTER
    while (tr0 < 2 * PEXP) { p0_table_trip(A, tr0, NGW, lane); tr0 += 4 * NGW; }
#endif
#undef RT_TABLE_TRIP
#undef RT_QLOAD
#undef RT_HALF
    __syncthreads();
}

__device__ __forceinline__ float gelu_tanh(float x) { const float u = 0.7978845608028654f * (x + 0.044715f * x * x * x); return x / (1.0f + __expf(-2.0f * u)); }
__device__ __forceinline__ void peer_sliced_phase(Frame& F, const Args& A) {
    const int lane = F.lane, c8 = lane & 7, g8 = lane >> 3, gw = F.vcu * NWAVES + F.wave, NGW = F.G * NWAVES;
    const float* modf = (const float*)(A.ws + WS_MODF);
    const unsigned char* U8 = A.ws + WS_U; const unsigned char* V8 = A.ws + WS_V;
    const float* SU = (const float*)(A.ws + WS_U + 16 * MiB); const float* SV = (const float*)(A.ws + WS_V + 16 * MiB);
    const unsigned short* IDX = (const unsigned short*)(A.ws + WS_POOLED); const float* GATE = (const float*)(A.ws + WS_POOLED + 16 * MiB);
    const float* gf = A.in[17];
    LAS float* AL = (LAS float*)(F.lds + F.wave * 17664);
    LAS float* SSQ = AL + 2048;
    LAS float* SAV = AL + 3072;
    LAS float* RS2 = AL + 3088;
    LAS float* GS = AL + 3104;
    LAS unsigned short* IDL = (LAS unsigned short*)(AL + 3360);
    for (int tb = gw * 16; tb < T; tb += NGW * 16) {
        for (int i = lane; i < 2048; i += 64) AL[i] = 0.f;
        for (int i = lane; i < 1024; i += 64) SSQ[i] = 0.f;
#pragma unroll
        for (int i = 0; i < 16; ++i) *(LAS unsigned*)(IDL + i * 128 + 2 * lane) = *(const unsigned*)(IDX + (size_t)(tb + i) * PSEL + 2 * lane);
        LDS_WAIT();
        {
            v4i W0[16], W1[16], H0, H1, H; float hs0, hs1, hs;
            const unsigned char* H2Q = A.ws + WS_H2Q; const float* HS = (const float*)(A.ws + WS_HS);
#define PU_X(k, Hx, hx) do { const int k_ = (k) < 128 ? (k) : 127; const int s_ = k_ >> 4, t_ = tb + (k_ & 15); Hx = *(const v4i*)(H2Q + (size_t)t_ * D + 128 * s_ + 16 * c8); hx = HS[(size_t)t_ * 8 + s_]; } while (0)
#define PU_B(k, W) do { const int k_ = (k) < 128 ? (k) : 127; const int s_ = k_ >> 4; const unsigned base_ = ((unsigned)s_ << 21) + 16u * (unsigned)c8; v4u I[2]; I[0] = *(const LAS v4u*)(IDL + (k_ & 15) * 128 + 16 * g8); I[1] = *(const LAS v4u*)(IDL + (k_ & 15) * 128 + 16 * g8 + 8); \
            _Pragma("unroll") for (int j = 0; j < 16; ++j) W[j] = *(const v4i*)(U8 + (base_ + (((I[j >> 3][(j >> 1) & 3] >> (16 * (j & 1))) & 0xffffu) << 7))); \
            } while (0)
#define PU_Q(k, Hx, hx) do { H = Hx; hs = hx; } while (0)
#define PU_C(k, W) do { int part[16]; \
            _Pragma("unroll") for (int j = 0; j < 16; ++j) part[j] = __builtin_amdgcn_sdot4(W[j].x, H.x, __builtin_amdgcn_sdot4(W[j].y, H.y, __builtin_amdgcn_sdot4(W[j].z, H.z, __builtin_amdgcn_sdot4(W[j].w, H.w, 0, false), false), false), false); \
            _Pragma("unroll") for (int step = 4; step >= 1; step >>= 1) { const bool up = (lane & step) != 0; \
                _Pragma("unroll") for (int i = 0; i < 2 * step; ++i) { const int send = up ? part[i] : part[i + 2 * step], keep = up ? part[i + 2 * step] : part[i]; part[i] = keep + __shfl_xor(send, step); } } \
            LAS f32x2* ap_ = (LAS f32x2*)(AL + ((k) & 15) * 128 + 2 * lane); f32x2 a_ = *ap_; a_.x += hs * (float)part[0]; a_.y += hs * (float)part[1]; *ap_ = a_; } while (0)
            PU_X(0, H0, hs0); PU_X(1, H1, hs1); PU_B(0, W0);
#pragma unroll 1
            for (int k = 0; k < 128; k += 2) {
                PU_Q(k, H0, hs0); PU_B(k + 1, W1); PU_X(k + 2, H0, hs0);
                PU_C(k, W0);
                PU_Q(k + 1, H1, hs1); PU_B(k + 2, W0); PU_X(k + 3, H1, hs1);
                PU_C(k + 1, W1);
            }
#undef PU_X
#undef PU_B
#undef PU_Q
#undef PU_C
        }
        LDS_WAIT();
#pragma unroll 4
        for (int i = 0; i < 16; ++i) {
            const int t = tb + i; const unsigned e01 = *(const LAS unsigned*)(IDL + i * 128 + 2 * lane); const int e0 = (int)(e01 & 0xffffu), e1 = (int)(e01 >> 16);
            const f32x2 gt = *(const f32x2*)(GATE + (size_t)t * PSEL + 2 * lane); const f32x2 a = *(LAS f32x2*)(AL + i * 128 + 2 * lane);
            f32x2 av; av.x = gelu_tanh(a.x * SU[e0]) * gt.x * SV[e0]; av.y = gelu_tanh(a.y * SU[e1]) * gt.y * SV[e1];
            *(LAS f32x2*)(AL + i * 128 + 2 * lane) = av;
            const float sm = wave_sum(av.x + av.y); if (lane == 0) SAV[i] = 128.0f * sm;
        }
        LDS_WAIT();
        {
            v4u W0[16], W1[16]; f32x2 X0, X1, gt2v = (f32x2){0.f, 0.f};
            const int b = tb / SEQ;
#define PV_B(k, W, X) do { const int k_ = (k) < 128 ? (k) : 127; const int s_ = k_ >> 4, t_ = tb + (k_ & 15); const unsigned base_ = ((unsigned)s_ << 21) + 16u * (unsigned)c8; v4u I[2]; I[0] = *(const LAS v4u*)(IDL + (k_ & 15) * 128 + 16 * g8); I[1] = *(const LAS v4u*)(IDL + (k_ & 15) * 128 + 16 * g8 + 8); \
            _Pragma("unroll") for (int j = 0; j < 16; ++j) W[j] = *(const v4u*)(V8 + (base_ + (((I[j >> 3][(j >> 1) & 3] >> (16 * (j & 1))) & 0xffffu) << 7))); \
            X = __builtin_nontemporal_load((const f32x2*)(A.out + (size_t)t_ * D + 128 * s_ + 16 * c8 + 2 * g8)); } while (0)
#define PV_C(k, W, X) do { const int s_ = (k) >> 4, i_ = (k) & 15; \
            if (i_ == 0) gt2v = *(const f32x2*)(modf + (size_t)b * 6144 + 5120 + 128 * s_ + 16 * c8 + 2 * g8); \
            f32x2 acc[8]; _Pragma("unroll") for (int q = 0; q < 8; ++q) acc[q] = (f32x2){0.f, 0.f}; \
            const LAS f32x4* avp_ = (const LAS f32x4*)(AL + i_ * 128 + 16 * g8); \
            _Pragma("unroll") for (int q4 = 0; q4 < 4; ++q4) { const f32x4 a4 = avp_[q4]; \
                _Pragma("unroll") for (int e = 0; e < 4; ++e) { const float a = a4[e]; const v4u w = W[4 * q4 + e]; \
                    acc[0] += (f32x2){(float)(w.x & 255u), (float)((w.x >> 8) & 255u)} * a; acc[1] += (f32x2){(float)((w.x >> 16) & 255u), (float)(w.x >> 24)} * a; \
                    acc[2] += (f32x2){(float)(w.y & 255u), (float)((w.y >> 8) & 255u)} * a; acc[3] += (f32x2){(float)((w.y >> 16) & 255u), (float)(w.y >> 24)} * a; \
                    acc[4] += (f32x2){(float)(w.z & 255u), (float)((w.z >> 8) & 255u)} * a; acc[5] += (f32x2){(float)((w.z >> 16) & 255u), (float)(w.z >> 24)} * a; \
                    acc[6] += (f32x2){(float)(w.w & 255u), (float)((w.w >> 8) & 255u)} * a; acc[7] += (f32x2){(float)((w.w >> 16) & 255u), (float)(w.w >> 24)} * a; } } \
            float pc[16]; _Pragma("unroll") for (int q = 0; q < 8; ++q) { pc[2 * q] = acc[q].x; pc[2 * q + 1] = acc[q].y; } \
            _Pragma("unroll") for (int step = 4; step >= 1; step >>= 1) { const bool up = (g8 & step) != 0; \
                _Pragma("unroll") for (int i = 0; i < 2 * step; ++i) { const float send = up ? pc[i] : pc[i + 2 * step], keep = up ? pc[i + 2 * step] : pc[i]; pc[i] = keep + __shfl_xor(send, 8 * step); } } \
            const float sav_ = SAV[i_]; f32x2 x2_; x2_.x = X.x + gt2v.x * (pc[0] - sav_); x2_.y = X.y + gt2v.y * (pc[1] - sav_); \
            *(f32x2*)(A.out + (size_t)(tb + i_) * D + 128 * s_ + 16 * c8 + 2 * g8) = x2_; \
            SSQ[i_ * 64 + lane] += x2_.x * x2_.x + x2_.y * x2_.y; } while (0)
            PV_B(0, W0, X0);
#pragma unroll 1
            for (int k = 0; k < 128; k += 2) {
                PV_B(k + 1, W1, X1);
                PV_C(k, W0, X0);
                PV_B(k + 2, W0, X0);
                PV_C(k + 1, W1, X1);
            }
#undef PV_B
#undef PV_C
        }
        VM_WAIT(); LDS_WAIT();
#pragma unroll 2
        for (int i = 0; i < 16; ++i) {
            float* xr = A.out + (size_t)(tb + i) * D + 16 * lane;
            f32x4 v[4];
#pragma unroll
            for (int q = 0; q < 4; ++q) v[q] = __builtin_nontemporal_load((const f32x4*)(xr + 4 * q));
            const float rs = 1.0f / sqrtf(wave_sum(SSQ[i * 64 + lane]) * (1.0f / D) + RMS_EPS);
#pragma unroll
            for (int q = 0; q < 4; ++q) *(f32x4*)(xr + 4 * q) = v[q] * rs * *(const f32x4*)(gf + 16 * lane + 4 * q);
        }
        LDS_WAIT();
    }
}

#ifndef PHASE_ONLY
#define PHASE_ONLY -1
#endif
#ifndef PHASE_SKIP
#define PHASE_SKIP -2
#endif
#define PH(n) ((PHASE_ONLY < 0 || PHASE_ONLY == (n)) && PHASE_SKIP != (n))
#ifndef PROBE_DOUBLE
#define PROBE_DOUBLE -1
#endif
#define REPS(n) for (int rep_ = 0; rep_ < ((PROBE_DOUBLE == (n)) ? 2 : 1); ++rep_)
__global__ void __launch_bounds__(NTHREADS, 2) fwd_megakernel(Args A) {
    extern __shared__ __attribute__((aligned(16))) unsigned char lds[];
    Frame F;
    F.lds = (LAS unsigned char*)lds;
    F.MISC = (volatile LAS unsigned*)(F.lds + MISC_OFF);
    F.tid = threadIdx.x; F.lane = F.tid & 63; F.wave = __builtin_amdgcn_readfirstlane(F.tid >> 6);
    F.G = gridDim.x; { const int bx = blockIdx.x; F.vcu = (F.G % 8 == 0) ? (bx % 8) * (F.G / 8) + bx / 8 : bx; }
    F.ctl = (gu32*)(A.ws + WS_CTL);
    for (int u = F.tid; u < (LDS_BYTES - LDSCTL_OFF) / 4; u += NTHREADS) ((LAS unsigned*)(F.lds + LDSCTL_OFF))[u] = 0u;
    __syncthreads();
    XcdBarrier bar = xcd_barrier_post((unsigned*)(F.ctl + CW_BAR), F.MISC + 8);
#define GRID_BAR() do { xcd_barrier(bar); int t_ = threadIdx.x; asm volatile("" : "+v"(t_)); F.tid = t_; F.lane = t_ & 63; F.wave = __builtin_amdgcn_readfirstlane(t_ >> 6); } while (0)
    unsigned char* ws = A.ws;

    REPS(0) if (PH(0)) { p0a_mod(F, A); p0b_prologue<0>(F, A); }
    GRID_BAR();
    REPS(1) if (PH(1)) p0b_prologue<1>(F, A);
    GRID_BAR();
    REPS(2) if (PH(2)) {
        pg8::Gemm g{(const bf16*)(ws + WS_XG), nullptr, (const bf16*)(ws + WS_WIN), nullptr, D, D, D};
        pg8::StaticOrder S; S.init(T, INW, F.G, (int)blockIdx.x);
        pg8::EpiIn E{(bf16*)(ws + WS_QKVP), (bf16*)(ws + WS_GAB), (const float*)(ws + WS_RSTD1), (const float*)(ws + WS_BIAS1P), (float*)(ws + WS_KSUM), (unsigned*)(ws + WS_CTL) + CW_NRM};
        pg8::gemm_phase<pg8::EpiIn, pg8::StaticOrder, true, true>(F.lds + RING_OFF, g, S, E);
    }
    GRID_BAR();
    REPS(3) if (PH(3)) {
        const attn_body::AttnTensors AT{(const attn_body::bf16*)(ws + WS_QKVP), (const attn_body::bf16*)(ws + WS_QKVP) + (size_t)T * 512, (const attn_body::bf16*)(ws + WS_QKVP) + (size_t)2 * T * 512, (PROBE_DOUBLE == 3 && rep_ == 0) ? (attn_body::bf16*)(ws + WS_XG) : (attn_body::bf16*)(ws + WS_QKVP)};
        const attn_body::StaticOrder S((int)F.G, F.vcu);
        attn_body::attn_phase<attn_body::StaticOrder>((char*)lds + RING_OFF, AT, (const float*)(ws + WS_KSUM), (const float*)((const unsigned*)(ws + WS_CTL) + CW_NRM), S);
    }
    REPS(4) if (PH(4)) pooled_phase(F, A);
    GRID_BAR();
    REPS(5) if (PH(5)) {
        pg8::Gemm g{(const bf16*)(ws + WS_QKVP), (const bf16*)(ws + WS_POOLED), (const bf16*)(ws + WS_WA), (const bf16*)(ws + WS_WP), AW, AW, AW};
        pg8::DualOrder S; S.init(T, D, F.G, (int)blockIdx.x);
        pg8::EpiUp E{(bf16*)(ws + WS_XG), (const bf16*)(ws + WS_GAB), (const float*)(ws + WS_BPRIME)};
        pg8::gemm_phase<pg8::EpiUp, pg8::DualOrder, true, true>(F.lds + RING_OFF, g, S, E);
    }
    GRID_BAR();
    REPS(6) if (PH(6)) {
        pg8::Gemm g{(const bf16*)(ws + WS_XG), nullptr, (const bf16*)(ws + WS_WOUT), nullptr, D, D, D};
        pg8::StaticOrder S; S.init(T, D, F.G, (int)blockIdx.x);
        pg8::EpiOut E{A.in[0], A.out, (bf16*)(ws + WS_QKVP), (const float*)(ws + WS_MODF), A.in[12], (float*)(ws + WS_SS2)};
        pg8::gemm_phase<pg8::EpiOut, pg8::StaticOrder, true, true>(F.lds + RING_OFF, g, S, E);
    }
    GRID_BAR();
    REPS(7) if (PH(7)) {
        pg8::Gemm g{(const bf16*)(ws + WS_QKVP), nullptr, (const bf16*)(ws + WS_WQ), nullptr, D, D, D};
        pg8::StaticOrder S; S.init(T, PQW, F.G, (int)blockIdx.x);
        pg8::EpiPq E{(bf16*)(ws + WS_GAB), (const float*)(ws + WS_SS2), (const float*)(ws + WS_BIAS2P)};
        pg8::gemm_phase<pg8::EpiPq, pg8::StaticOrder, true, true>(F.lds + RING_OFF, g, S, E);
    }
    GRID_BAR();
    REPS(8) if (PH(8)) router_phase(F, A);
    GRID_BAR();
    if (PH(9)) peer_sliced_phase(F, A);
}

extern "C" void kernel_launch(void* const* d_in, const int* in_sizes, int n_in, void* d_out, int out_size, void* d_ws, size_t ws_size, hipStream_t stream) {
    static int grid = 0;
    if (grid == 0) {
        if (n_in != 18 || in_sizes[0] != T * D || out_size != T * D || ws_size < WS_END) { fprintf(stderr, "kernel_launch: unexpected shapes (n_in %d, in0 %d, out %d, ws %zu); nothing launched\n", n_in, n_in > 0 ? in_sizes[0] : -1, out_size, ws_size); grid = -1; return; }
        int dev = 0, cus = 0, per_cu = 0;
        if (hipGetDevice(&dev) != hipSuccess || hipDeviceGetAttribute(&cus, hipDeviceAttributeMultiprocessorCount, dev) != hipSuccess) { grid = -1; return; }
        if (hipFuncSetAttribute((const void*)fwd_megakernel, hipFuncAttributeMaxDynamicSharedMemorySize, LDS_BYTES) != hipSuccess) { fprintf(stderr, "kernel_launch: hipFuncSetAttribute failed\n"); grid = -1; return; }
        if (hipOccupancyMaxActiveBlocksPerMultiprocessor(&per_cu, (const void*)fwd_megakernel, NTHREADS, LDS_BYTES) != hipSuccess || per_cu < 1) { fprintf(stderr, "kernel_launch: occupancy query reports %d workgroups per CU\n", per_cu); per_cu = 1; }
        (void)hipGetLastError();
        grid = cus;
    }
    if (grid < 0) return;
    if (hipMemsetAsync((char*)d_ws + WS_CTL, 0, CTL_ZERO_BYTES, stream) != hipSuccess) { fprintf(stderr, "kernel_launch: hipMemsetAsync failed\n"); return; }
    Args a{};
    for (int i = 0; i < 18; ++i) a.in[i] = (const float*)d_in[i];
    a.out = (float*)d_out; a.ws = (unsigned char*)d_ws;
    void* kargs[] = {&a};
    hipError_t e = hipLaunchCooperativeKernel((const void*)fwd_megakernel, dim3(grid), dim3(NTHREADS), kargs, LDS_BYTES, stream);
    if (e != hipSuccess) fprintf(stderr, "kernel_launch: cooperative launch failed: %s (grid %d)\n", hipGetErrorString(e), grid);
}
```

```cpp
#define TABLES_IN_ROUTER 1
#include <hip/hip_runtime.h>
#include <hip/hip_bf16.h>
#include <cstdio>
#include <cstdint>
#include <cmath>

constexpr int NB = 8, SEQ = 4096, T = NB * SEQ, D = 1024;
constexpr int AW = 512, PW = 512, INW = 4096;
constexpr int NH = 8, HD = 64, MBLK = 256, NBLK = SEQ / MBLK;
constexpr int PQW = 2048, PEXP = 16384, PTOP = 16, PHEADS = 8, PSEL = PHEADS * PTOP;
constexpr float RMS_EPS = 1e-6f;
constexpr float LOG2E = 1.4426950408889634f;
constexpr float QSCALE = 0.125f * LOG2E;
constexpr int NWAVES = 8, NTHREADS = 512;

namespace pg8 {
#define PG8_LAS __attribute__((address_space(3)))
typedef unsigned short bf16_t;
typedef short bf16x8 __attribute__((ext_vector_type(8)));
typedef float f32x4 __attribute__((ext_vector_type(4)));
typedef unsigned u32x4 __attribute__((ext_vector_type(4)));
constexpr int BM = 256, BK = 64, HALF = 128, HTB = HALF * BK * 2  , STAGE_BYTES = 8 * HTB, NXCD = 8, WGM = 8;

__host__ __device__ __forceinline__ int lds_byte(int r, int c) { const int st = (r >> 4) * 2 + (c >> 5), rr = r & 15, cc = c & 31, ob = rr * 64 + cc * 2; return st * 1024 + (ob ^ (((ob >> 9) & 1) << 5)); }
__host__ __device__ __forceinline__ void stage_rc(int b, int& R, int& C) { const int st = b / 1024, sb = b % 1024, swz = sb ^ (((sb >> 9) & 1) << 5); R = (st >> 1) * 16 + swz / 64; C = (st & 1) * 32 + (swz % 64) / 2; }
__host__ __device__ __forceinline__ int perm32(int rho) { const int n = rho >> 4, i = rho & 15; return 8 * (i >> 2) + 4 * n + (i & 3); }

struct Unit { int pm, pn, part; };
struct Gemm {
    const bf16_t* A0; const bf16_t* A1; const bf16_t* B0; const bf16_t* B1; int lda, ldb, K;
    __device__ __forceinline__ const char* a_ptr(const Unit& u) const { return (const char*)(u.part ? A1 : A0) + (size_t)u.pm * BM * lda * 2; }
    __device__ __forceinline__ const char* b_ptr(const Unit& u) const { return (const char*)(u.part ? B1 : B0) + (size_t)u.pn * BM * ldb * 2; }
};

struct StaticOrder {
    int nM, nN, nwg, G, c;
    __host__ __device__ void init(int M, int N, int G_, int c_) { nM = M / BM; nN = N / BM; nwg = nM * nN; G = G_; c = c_; }
    __host__ __device__ bool tile(long L, Unit& u) const {
        if (L >= nwg) return false;
        int wgid = (int)L; { const int q = nwg / NXCD, r = nwg % NXCD, xcd = wgid % NXCD, off = wgid / NXCD; wgid = (xcd < r ? xcd * (q + 1) : r * (q + 1) + (xcd - r) * q) + off; }
        const int nig = WGM * nN, gid = wgid / nig, fm = gid * WGM, gsz = (nM - fm) < WGM ? (nM - fm) : WGM;
        u.pm = fm + ((wgid % nig) % gsz); u.pn = (wgid % nig) / gsz; u.part = 0; return true;
    }
    __host__ __device__ bool next(int i, Unit& u) const { return tile((long)i * G + c, u); }
    __device__ __forceinline__ void a_ready(const Unit&) const {}
    __device__ __forceinline__ void done(const Unit&) const {}
};
struct DualOrder {
    StaticOrder so;
    __host__ __device__ void init(int M, int N, int G_, int c_) { so.init(M, N, G_, c_); }
    __host__ __device__ bool next(int i, Unit& u) const { if (!so.tile((long)(i >> 1) * so.G + so.c, u)) return false; u.part = i & 1; return true; }
    __device__ __forceinline__ void a_ready(const Unit&) const {}
    __device__ __forceinline__ void done(const Unit&) const {}
};

__device__ __forceinline__ unsigned cvt_pk_bf16(float lo, float hi) { unsigned r; asm volatile("v_cvt_pk_bf16_f32 %0, %1, %2" : "=v"(r) : "v"(lo), "v"(hi)); return r; }
__device__ __forceinline__ float bf_lo(unsigned w) { return __uint_as_float(w << 16); }
__device__ __forceinline__ float bf_hi(unsigned w) { return __uint_as_float(w & 0xffff0000u); }
__device__ __forceinline__ float sigmoidf_(float x) { return __builtin_amdgcn_rcpf(1.0f + __builtin_amdgcn_exp2f(-x * 1.4426950408889634f)); }


struct EpiIn {
    static constexpr bool PERM = true, AFTER_DRAIN = false;
    bf16_t* QKVP; bf16_t* GAB; const float* rstd1; const float* bias1p; float* ksum; unsigned* nrm;
    __device__ __forceinline__ void operator()(const f32x4 (&acc)[2][2][4][2], const Unit& u, int wr, int wc, int fr, int fq) const {
        bf16_t* base; int ldc, col0;
        if (u.pn < 8) { base = QKVP + (size_t)(u.pn >> 1) * T * 512; ldc = 512; col0 = (u.pn & 1) * 256; }
        else { base = GAB + (size_t)((u.pn - 8) >> 2) * T * 1024; ldc = 1024; col0 = ((u.pn - 8) & 3) * 256; }
        const float sc = (u.pn < 2) ? QSCALE : 1.0f;
        const int b = u.pm >> 4;
        const int bcol = u.pn * 256 + wc * 32 + 8 * fq;
        f32x4 bv[2][2];
#pragma unroll
        for (int bj = 0; bj < 2; ++bj)
#pragma unroll
            for (int n = 0; n < 2; ++n) { f32x4 s = (f32x4){0.f, 0.f, 0.f, 0.f};
#pragma unroll
                for (int kc = 0; kc < 8; ++kc) s += *(const f32x4*)(bias1p + (size_t)(kc * 8 + b) * INW + bcol + bj * HALF + 4 * n);
                bv[bj][n] = s; }
        const bool isk = (u.pn == 2 || u.pn == 3); const bool isqk = (u.pn < 4); float nmax[2] = {0.f, 0.f};
        f32x4 ks[2][2];
#pragma unroll
        for (int bj = 0; bj < 2; ++bj)
#pragma unroll
            for (int n = 0; n < 2; ++n) ks[bj][n] = (f32x4){0.f, 0.f, 0.f, 0.f};
        const int row0 = u.pm * BM + wr * 64 + fr;
#pragma unroll
        for (int ai = 0; ai < 2; ++ai)
#pragma unroll
            for (int m = 0; m < 4; ++m) { const int row = row0 + ai * HALF + m * 16; const float rs = rstd1[row];
                bf16_t* rowp = base + (size_t)row * ldc + col0 + wc * 32 + 8 * fq;
#pragma unroll
                for (int bj = 0; bj < 2; ++bj) { f32x4 v0 = acc[ai][bj][m][0] * rs + bv[bj][0], v1 = acc[ai][bj][m][1] * rs + bv[bj][1];
                    ks[bj][0] += v0; ks[bj][1] += v1;
                    v0 = v0 * sc; v1 = v1 * sc;
                    if (isqk) { float ss = (v0[0] * v0[0] + v0[1] * v0[1]) + (v0[2] * v0[2] + v0[3] * v0[3]) + (v1[0] * v1[0] + v1[1] * v1[1]) + (v1[2] * v1[2] + v1[3] * v1[3]); ss += __shfl_xor(ss, 16); ss += __shfl_xor(ss, 32); nmax[bj] = fmaxf(nmax[bj], ss); }
                    u32x4 w; w.x = cvt_pk_bf16(v0[0], v0[1]); w.y = cvt_pk_bf16(v0[2], v0[3]); w.z = cvt_pk_bf16(v1[0], v1[1]); w.w = cvt_pk_bf16(v1[2], v1[3]);
                    *(u32x4*)(rowp + bj * HALF) = w; } }
        if (isqk) {
#pragma unroll
            for (int bj = 0; bj < 2; ++bj) { float v = nmax[bj]; v = fmaxf(v, __shfl_xor(v, 1)); v = fmaxf(v, __shfl_xor(v, 2)); v = fmaxf(v, __shfl_xor(v, 4)); v = fmaxf(v, __shfl_xor(v, 8));
                if (fr == 0 && fq == 0) atomicMax(nrm + (size_t)(b * 2 + (u.pn >> 1)) * 16 + (u.pn & 1) * 8 + bj * 4 + wc, __float_as_uint(v)); }
        }
        if (isk) {
#pragma unroll
            for (int bj = 0; bj < 2; ++bj)
#pragma unroll
                for (int n = 0; n < 2; ++n)
#pragma unroll
                    for (int e = 0; e < 4; ++e) { float v = ks[bj][n][e]; v += __shfl_xor(v, 1); v += __shfl_xor(v, 2); v += __shfl_xor(v, 4); v += __shfl_xor(v, 8); ks[bj][n][e] = v; }
            if (fr == 0) { float* kp = ksum + (size_t)u.pm * 512 + (u.pn - 2) * 256 + wc * 32 + 8 * fq;
#pragma unroll
                for (int bj = 0; bj < 2; ++bj)
#pragma unroll
                    for (int n = 0; n < 2; ++n)
#pragma unroll
                        for (int e = 0; e < 4; ++e) atomicAdd(kp + bj * HALF + 4 * n + e, ks[bj][n][e]); }
        }
    }
};

struct EpiUp {
    static constexpr bool PERM = true, AFTER_DRAIN = false;
    bf16_t* merged; const bf16_t* GAB; const float* bprime;
    __device__ __forceinline__ void operator()(const f32x4 (&acc)[2][2][4][2], const Unit& u, int wr, int wc, int fr, int fq) const {
        const int row0 = u.pm * BM + wr * 64 + fr, colb = u.pn * BM + wc * 32 + 8 * fq;
        const bf16_t* gate = GAB + (size_t)u.part * T * 1024;
        f32x4 bv[2][2];
#pragma unroll
        for (int bj = 0; bj < 2; ++bj)
#pragma unroll
            for (int n = 0; n < 2; ++n) { f32x4 s_ = (f32x4){0.f, 0.f, 0.f, 0.f}; if (u.part) { _Pragma("unroll") for (int g_ = 0; g_ < 4; ++g_) s_ += *(const f32x4*)(bprime + g_ * 1024 + colb + bj * HALF + 4 * n); } bv[bj][n] = s_; }
#pragma unroll
        for (int ai = 0; ai < 2; ++ai) {
            u32x4 gpre[4][2], ppre[4][2];
#pragma unroll
            for (int m = 0; m < 4; ++m) { const size_t off = (size_t)(row0 + ai * HALF + m * 16) * 1024 + colb;
#pragma unroll
                for (int bj = 0; bj < 2; ++bj) { gpre[m][bj] = __builtin_nontemporal_load((const u32x4*)(gate + off + bj * HALF));
                    if (u.part) ppre[m][bj] = __builtin_nontemporal_load((const u32x4*)(merged + off + bj * HALF)); else ppre[m][bj] = (u32x4){0u, 0u, 0u, 0u}; } }
#pragma unroll
            for (int m = 0; m < 4; ++m) { const size_t off = (size_t)(row0 + ai * HALF + m * 16) * 1024 + colb;
#pragma unroll
                for (int bj = 0; bj < 2; ++bj) {
                    const u32x4 gw = gpre[m][bj], pw = ppre[m][bj];
                    f32x4 v0 = acc[ai][bj][m][0] + bv[bj][0], v1 = acc[ai][bj][m][1] + bv[bj][1];
                    v0[0] *= sigmoidf_(bf_lo(gw.x)); v0[1] *= sigmoidf_(bf_hi(gw.x)); v0[2] *= sigmoidf_(bf_lo(gw.y)); v0[3] *= sigmoidf_(bf_hi(gw.y));
                    v1[0] *= sigmoidf_(bf_lo(gw.z)); v1[1] *= sigmoidf_(bf_hi(gw.z)); v1[2] *= sigmoidf_(bf_lo(gw.w)); v1[3] *= sigmoidf_(bf_hi(gw.w));
                    v0[0] += bf_lo(pw.x); v0[1] += bf_hi(pw.x); v0[2] += bf_lo(pw.y); v0[3] += bf_hi(pw.y); v1[0] += bf_lo(pw.z); v1[1] += bf_hi(pw.z); v1[2] += bf_lo(pw.w); v1[3] += bf_hi(pw.w);
                    u32x4 w; w.x = cvt_pk_bf16(v0[0], v0[1]); w.y = cvt_pk_bf16(v0[2], v0[3]); w.z = cvt_pk_bf16(v1[0], v1[1]); w.w = cvt_pk_bf16(v1[2], v1[3]);
                    *(u32x4*)(merged + off + bj * HALF) = w; } }
        }
        if (u.part == 0) asm volatile("s_waitcnt vmcnt(0)" ::: "memory");
    }
};

struct EpiOut {
    static constexpr bool PERM = true, AFTER_DRAIN = false;
    const float* x; float* x1; bf16_t* A2; const float* modf; const float* g2; float* ss2;
    __device__ __forceinline__ void operator()(const f32x4 (&acc)[2][2][4][2], const Unit& u, int wr, int wc, int fr, int fq) const {
        const int row0 = u.pm * BM + wr * 64 + fr, colb = u.pn * BM + wc * 32 + 8 * fq, b = u.pm >> 4;
        f32x4 gt[2][2], gg[2][2];
#pragma unroll
        for (int bj = 0; bj < 2; ++bj)
#pragma unroll
            for (int n = 0; n < 2; ++n) { const int c = colb + bj * HALF + 4 * n; gt[bj][n] = *(const f32x4*)(modf + (size_t)b * 6144 + 2048 + c);
                const f32x4 sc2 = *(const f32x4*)(modf + (size_t)b * 6144 + 4096 + c); gg[bj][n] = *(const f32x4*)(g2 + c) * (sc2 + 1.0f); }
#pragma unroll
        for (int ai = 0; ai < 2; ++ai) {
#pragma unroll
          for (int mh = 0; mh < 2; ++mh) {
            f32x4 xr[2][2][2];
#pragma unroll
            for (int m2 = 0; m2 < 2; ++m2) { const size_t off = (size_t)(row0 + ai * HALF + (2 * mh + m2) * 16) * 1024 + colb;
#pragma unroll
                for (int bj = 0; bj < 2; ++bj) { xr[m2][bj][0] = __builtin_nontemporal_load((const f32x4*)(x + off + bj * HALF)); xr[m2][bj][1] = __builtin_nontemporal_load((const f32x4*)(x + off + bj * HALF + 4)); } }
#pragma unroll
            for (int m2 = 0; m2 < 2; ++m2) { const int m = 2 * mh + m2; const int row = row0 + ai * HALF + m * 16; const size_t off = (size_t)row * 1024 + colb; float ssq = 0.f;
#pragma unroll
                for (int bj = 0; bj < 2; ++bj) {
                    const f32x4 y0 = xr[m2][bj][0] + gt[bj][0] * acc[ai][bj][m][0], y1 = xr[m2][bj][1] + gt[bj][1] * acc[ai][bj][m][1];
                    *(f32x4*)(x1 + off + bj * HALF) = y0; *(f32x4*)(x1 + off + bj * HALF + 4) = y1;
                    ssq += (y0[0] * y0[0] + y0[1] * y0[1]) + (y0[2] * y0[2] + y0[3] * y0[3]) + (y1[0] * y1[0] + y1[1] * y1[1]) + (y1[2] * y1[2] + y1[3] * y1[3]);
                    const f32x4 a0 = y0 * gg[bj][0], a1 = y1 * gg[bj][1];
                    u32x4 w; w.x = cvt_pk_bf16(a0[0], a0[1]); w.y = cvt_pk_bf16(a0[2], a0[3]); w.z = cvt_pk_bf16(a1[0], a1[1]); w.w = cvt_pk_bf16(a1[2], a1[3]);
                    *(u32x4*)(A2 + off + bj * HALF) = w; }
                ssq += __shfl_xor(ssq, 16); ssq += __shfl_xor(ssq, 32);
                if (fq == 0) ss2[(size_t)row * 16 + u.pn * 4 + wc] = ssq; }
          }
        }
    }
};

struct EpiPq {
    static constexpr bool PERM = true, AFTER_DRAIN = false;
    bf16_t* QP; const float* ss2; const float* bias2p;
    __device__ __forceinline__ void operator()(const f32x4 (&acc)[2][2][4][2], const Unit& u, int wr, int wc, int fr, int fq) const {
        const int row0 = u.pm * BM + wr * 64 + fr, colb = u.pn * BM + wc * 32 + 8 * fq, b = u.pm >> 4;
        f32x4 bv[2][2];
#pragma unroll
        for (int bj = 0; bj < 2; ++bj)
#pragma unroll
            for (int n = 0; n < 2; ++n) { f32x4 s = (f32x4){0.f, 0.f, 0.f, 0.f};
#pragma unroll
                for (int kc = 0; kc < 8; ++kc) s += *(const f32x4*)(bias2p + (size_t)(kc * 8 + b) * PQW + colb + bj * HALF + 4 * n);
                bv[bj][n] = s; }
#pragma unroll
        for (int ai = 0; ai < 2; ++ai)
#pragma unroll
            for (int m = 0; m < 4; ++m) { const int row = row0 + ai * HALF + m * 16;
                const f32x4* sp = (const f32x4*)(ss2 + (size_t)row * 16); const f32x4 s4 = (sp[0] + sp[1]) + (sp[2] + sp[3]);
                const float rs = __builtin_amdgcn_rsqf(((s4[0] + s4[1]) + (s4[2] + s4[3])) * (1.0f / D) + RMS_EPS);
                bf16_t* rowp = QP + (size_t)row * PQW + colb;
#pragma unroll
                for (int bj = 0; bj < 2; ++bj) { const f32x4 v0 = acc[ai][bj][m][0] * rs + bv[bj][0], v1 = acc[ai][bj][m][1] * rs + bv[bj][1];
                    u32x4 w; w.x = cvt_pk_bf16(v0[0], v0[1]); w.y = cvt_pk_bf16(v0[2], v0[3]); w.z = cvt_pk_bf16(v1[0], v1[1]); w.w = cvt_pk_bf16(v1[2], v1[3]);
                    *(u32x4*)(rowp + bj * HALF) = w; } }
    }
};

template <class Epi, class Sched, bool ALIGN_EPI = false, bool SP2 = false>
__device__ __forceinline__ void gemm_phase(PG8_LAS unsigned char* lds, const Gemm g, const Sched& S, const Epi& E) {
    int tid_ = threadIdx.x; asm volatile("" : "+v"(tid_));
    const int tid = tid_, wid = __builtin_amdgcn_readfirstlane(tid >> 6), lane = tid & 63, wr = wid >> 2, wc = wid & 3, fr = lane & 15, fq = lane >> 4;
    const int K = g.K, nt = K / BK, lda = g.lda, ldb = g.ldb;
    unsigned voffA[2], voffB[2];
#pragma unroll
    for (int i = 0; i < 2; ++i) { int R, C; stage_rc(tid * 16 + i * 8192, R, C); const int Rb = Epi::PERM ? ((R & ~31) + perm32(R & 31)) : R;
        voffA[i] = (unsigned)(R * lda + C) * 2u; voffB[i] = (unsigned)(Rb * ldb + C) * 2u; }
    const size_t kstep = (size_t)(BK * 2);
    const size_t hstepA = (size_t)HALF * lda * 2, hstepB = (size_t)HALF * ldb * 2;
    const unsigned ldsw = (unsigned)wid * 1024u;
    const int aoff = lds_byte(wr * 64 + fr, fq * 8), boff = lds_byte(wc * 32 + fr, fq * 8);
#define PG8_SA(b, h) (((b) * 2 + (h)) * HTB)
#define PG8_SB(b, h) ((4 + (b) * 2 + (h)) * HTB)
#define PG8_STAGE(bufoff, gbase, voff) do { _Pragma("unroll") for (int _i = 0; _i < 2; ++_i) \
        __builtin_amdgcn_global_load_lds((const unsigned*)((const char*)(gbase) + (voff)[_i]), (PG8_LAS unsigned*)(lds + (bufoff) + ldsw + _i * 8192), 16, 0, 0); } while (0)
#define PG8_LDA(dst, b, h) do { _Pragma("unroll") for (int m = 0; m < 4; ++m) _Pragma("unroll") for (int k = 0; k < 2; ++k) dst[m][k] = *(const PG8_LAS bf16x8*)(lds + PG8_SA(b, h) + aoff + m * 2048 + k * 1024); } while (0)
#define PG8_LDB(dst, b, h) do { _Pragma("unroll") for (int n = 0; n < 2; ++n) _Pragma("unroll") for (int k = 0; k < 2; ++k) dst[n][k] = *(const PG8_LAS bf16x8*)(lds + PG8_SB(b, h) + boff + n * 2048 + k * 1024); } while (0)
#define PG8_MMA(ai, bj, At, Bt) do { __builtin_amdgcn_s_setprio(1); _Pragma("unroll") for (int m = 0; m < 4; ++m) _Pragma("unroll") for (int n = 0; n < 2; ++n) _Pragma("unroll") for (int k = 0; k < 2; ++k) \
        acc[ai][bj][m][n] = __builtin_amdgcn_mfma_f32_16x16x32_bf16(Bt[n][k], At[m][k], acc[ai][bj][m][n], 0, 0, 0); __builtin_amdgcn_s_setprio(0); } while (0)
#define PG8_WAIT_V(n) asm volatile("s_waitcnt vmcnt(" #n ")" ::: "memory")
#define PG8_WAIT_L(n) asm volatile("s_waitcnt lgkmcnt(" #n ")" ::: "memory")
#define PG8_BAR __builtin_amdgcn_s_barrier()
#define PG8_SCHED __builtin_amdgcn_sched_barrier(0)
    Unit cur, nxt; int ui = 0;
    if (!S.next(0, cur)) return;
    f32x4 acc[2][2][4][2];
#pragma unroll
    for (int a = 0; a < 2; ++a)
#pragma unroll
        for (int b = 0; b < 2; ++b)
#pragma unroll
            for (int m = 0; m < 4; ++m)
#pragma unroll
                for (int n = 0; n < 2; ++n) acc[a][b][m][n] = (f32x4){0.f, 0.f, 0.f, 0.f};
    bf16x8 At[4][2], B0[2][2], B1[2][2];
    const char* cA = g.a_ptr(cur); const char* cB = g.b_ptr(cur);
    S.a_ready(cur);
    if constexpr (SP2) {
        PG8_STAGE(PG8_SB(0, 0), cB, voffB); PG8_STAGE(PG8_SB(0, 1), cB + hstepB, voffB); PG8_STAGE(PG8_SA(0, 0), cA, voffA); PG8_STAGE(PG8_SA(0, 1), cA + hstepA, voffA);
        if (wr == 1) PG8_BAR;
        PG8_WAIT_V(2); PG8_BAR;
        PG8_STAGE(PG8_SB(1, 0), cB + kstep, voffB); PG8_STAGE(PG8_SA(1, 0), cA + kstep, voffA); PG8_STAGE(PG8_SB(1, 1), cB + hstepB + kstep, voffB);
        PG8_WAIT_V(6); PG8_BAR;
    } else {
        PG8_STAGE(PG8_SB(0, 0), cB, voffB); PG8_STAGE(PG8_SA(0, 0), cA, voffA); PG8_STAGE(PG8_SB(0, 1), cB + hstepB, voffB); PG8_STAGE(PG8_SA(0, 1), cA + hstepA, voffA);
        if (wr == 1) PG8_BAR;
        PG8_WAIT_V(4); PG8_BAR;
        PG8_STAGE(PG8_SB(1, 0), cB + kstep, voffB); PG8_STAGE(PG8_SA(1, 0), cA + kstep, voffA); PG8_STAGE(PG8_SB(1, 1), cB + hstepB + kstep, voffB);
        PG8_WAIT_V(6); PG8_BAR;
    }
    for (;;) {
        const bool has_next = S.next(ui + 1, nxt);
        const char* nA = has_next ? g.a_ptr(nxt) : cA; const char* nB = has_next ? g.b_ptr(nxt) : cB;
        for (int t = 0; t < nt; t += 2) {
            const bool last = (t == nt - 2);
            const char* a1 = cA + (size_t)(t + 1) * kstep;
            const char* a2 = last ? nA : cA + (size_t)(t + 2) * kstep; const char* b2 = last ? nB : cB + (size_t)(t + 2) * kstep;
            const char* a3 = a2 + kstep; const char* b3 = b2 + kstep;
            if (last && has_next) S.a_ready(nxt);
            if constexpr (SP2) {
            PG8_LDB(B0, 0, 0); PG8_LDB(B1, 0, 1); PG8_SCHED; PG8_LDA(At, 0, 0); PG8_STAGE(PG8_SA(1, 1), a1 + hstepA, voffA);
            PG8_WAIT_V(8); PG8_WAIT_L(0); PG8_BAR; PG8_MMA(0, 0, At, B0); PG8_MMA(0, 1, At, B1); PG8_BAR; PG8_SCHED;
            PG8_LDA(At, 0, 1); PG8_STAGE(PG8_SB(0, 0), b2, voffB); PG8_STAGE(PG8_SB(0, 1), b2 + hstepB, voffB); PG8_STAGE(PG8_SA(0, 0), a2, voffA);
            PG8_WAIT_V(8); PG8_WAIT_L(0); PG8_BAR; PG8_MMA(1, 0, At, B0); PG8_MMA(1, 1, At, B1); PG8_BAR; PG8_SCHED;
            PG8_LDB(B0, 1, 0); PG8_LDB(B1, 1, 1); PG8_SCHED; PG8_LDA(At, 1, 0); PG8_STAGE(PG8_SA(0, 1), a2 + hstepA, voffA);
            PG8_WAIT_V(8); PG8_WAIT_L(0); PG8_BAR; PG8_MMA(0, 0, At, B0); PG8_MMA(0, 1, At, B1); PG8_BAR; PG8_SCHED;
            PG8_LDA(At, 1, 1); PG8_STAGE(PG8_SB(1, 0), b3, voffB); PG8_STAGE(PG8_SB(1, 1), b3 + hstepB, voffB); PG8_STAGE(PG8_SA(1, 0), a3, voffA);
            PG8_WAIT_V(8); PG8_WAIT_L(0); PG8_BAR; PG8_MMA(1, 0, At, B0); PG8_MMA(1, 1, At, B1); PG8_BAR; PG8_SCHED;
            } else {
            PG8_LDB(B0, 0, 0); PG8_SCHED; PG8_LDA(At, 0, 0); PG8_STAGE(PG8_SA(1, 1), a1 + hstepA, voffA);
            PG8_WAIT_L(8); PG8_BAR; PG8_WAIT_L(0); PG8_MMA(0, 0, At, B0); PG8_BAR; PG8_SCHED;
            PG8_LDB(B1, 0, 1); PG8_STAGE(PG8_SB(0, 0), b2, voffB);
            PG8_BAR; PG8_WAIT_L(0); PG8_MMA(0, 1, At, B1); PG8_BAR;
            PG8_LDA(At, 0, 1); PG8_STAGE(PG8_SA(0, 0), a2, voffA);
            PG8_BAR; PG8_WAIT_L(0); PG8_MMA(1, 0, At, B0); PG8_BAR; PG8_SCHED;
            PG8_STAGE(PG8_SB(0, 1), b2 + hstepB, voffB);
            PG8_WAIT_V(6); PG8_BAR; PG8_MMA(1, 1, At, B1); PG8_BAR;
            PG8_LDB(B0, 1, 0); PG8_SCHED; PG8_LDA(At, 1, 0); PG8_STAGE(PG8_SA(0, 1), a2 + hstepA, voffA);
            PG8_WAIT_L(8); PG8_BAR; PG8_WAIT_L(0); PG8_MMA(0, 0, At, B0); PG8_BAR; PG8_SCHED;
            PG8_LDB(B1, 1, 1); PG8_STAGE(PG8_SB(1, 0), b3, voffB);
            PG8_BAR; PG8_WAIT_L(0); PG8_MMA(0, 1, At, B1); PG8_BAR;
            PG8_LDA(At, 1, 1); PG8_STAGE(PG8_SA(1, 0), a3, voffA);
            PG8_BAR; PG8_WAIT_L(0); PG8_MMA(1, 0, At, B0); PG8_BAR; PG8_SCHED;
            PG8_STAGE(PG8_SB(1, 1), b3 + hstepB, voffB);
            PG8_WAIT_V(6); PG8_BAR; PG8_MMA(1, 1, At, B1); PG8_BAR;
            }
        }
        if constexpr (ALIGN_EPI) { if (wr == 0) PG8_BAR; }
        if constexpr (!Epi::AFTER_DRAIN) { E(acc, cur, wr, wc, fr, fq); S.done(cur); }
        if (!has_next) break;
#pragma unroll
        for (int a = 0; a < 2; ++a)
#pragma unroll
            for (int b = 0; b < 2; ++b)
#pragma unroll
                for (int m = 0; m < 4; ++m)
#pragma unroll
                    for (int n = 0; n < 2; ++n) acc[a][b][m][n] = (f32x4){0.f, 0.f, 0.f, 0.f};
        cur = nxt; cA = nA; cB = nB; ++ui;
        if constexpr (ALIGN_EPI) { if (wr == 1) PG8_BAR; }
    }
    PG8_WAIT_V(0);
    if constexpr (!ALIGN_EPI) { if (wr == 0) PG8_BAR; }
    PG8_BAR;
    if constexpr (Epi::AFTER_DRAIN) { E.fused(acc, cur, wr, wc, fr, fq, lds, wid, lane); S.done(cur); }
#undef PG8_SA
#undef PG8_SB
#undef PG8_STAGE
#undef PG8_LDA
#undef PG8_LDB
#undef PG8_MMA
#undef PG8_WAIT_V
#undef PG8_WAIT_L
#undef PG8_BAR
#undef PG8_SCHED
}
}

constexpr size_t MiB = 1u << 20;
constexpr size_t WS_CTL = 0, CTL_ZERO_BYTES = 32 * 1024;
constexpr size_t WS_KSUM = 256 * 1024;
constexpr size_t WS_MODP = 1 * MiB;
constexpr size_t WS_MODF = WS_MODP + 8 * 8 * 6144 * 4;
constexpr size_t WS_BIAS1P = 3 * MiB;
constexpr size_t WS_BIAS2P = 4 * MiB;
constexpr size_t WS_BPRIME = 4 * MiB + 512 * 1024;
constexpr size_t WS_RSTD1 = 5 * MiB;
constexpr size_t WS_SS2 = 6 * MiB;
constexpr size_t WS_SUBK = 8 * MiB;
constexpr size_t WS_WIN = 16 * MiB, WS_WA = 24 * MiB, WS_WP = 25 * MiB, WS_WOUT = 26 * MiB, WS_WQ = 28 * MiB;
constexpr size_t WS_U = 32 * MiB, WS_V = 64 * MiB;
constexpr size_t WS_XG = 96 * MiB;
constexpr size_t WS_H2Q = WS_XG, WS_HS = WS_XG + 32 * MiB;
constexpr size_t WS_QKVP = 160 * MiB;
constexpr size_t WS_GAB = 288 * MiB;
constexpr size_t WS_POOLED = 416 * MiB;
constexpr size_t WS_END = 448 * MiB;
constexpr int CW_TMO = 0, CW_BAR = 4096;
constexpr int CW_NRM = 2048;

constexpr int RING_OFF = 0, RING_BYTES = 131072;
constexpr int LDS_BYTES = 147456;
constexpr int LDSCTL_OFF = LDS_BYTES - 512, MISC_OFF = LDSCTL_OFF + 320;

#define GAS __attribute__((address_space(1)))
#define LAS __attribute__((address_space(3)))
typedef unsigned short bf16;
typedef unsigned v4u __attribute__((ext_vector_type(4)));
typedef unsigned v2u __attribute__((ext_vector_type(2)));
typedef float f32x4 __attribute__((ext_vector_type(4)));
typedef GAS unsigned gu32;
#define RLX_AGENT __ATOMIC_RELAXED, __HIP_MEMORY_SCOPE_AGENT
#define LDS_WAIT() asm volatile("s_waitcnt lgkmcnt(0)" ::: "memory")
#define VM_WAIT() asm volatile("s_waitcnt vmcnt(0)" ::: "memory")
__device__ __forceinline__ unsigned f2bf(float f) { unsigned u = __builtin_bit_cast(unsigned, f); return (u + 0x7fffu + ((u >> 16) & 1u)) >> 16; }
__device__ __forceinline__ unsigned pk2(float lo, float hi) { return f2bf(lo) | (f2bf(hi) << 16); }
__device__ __forceinline__ float bflo(unsigned w) { return __uint_as_float(w << 16); }
__device__ __forceinline__ float bfhi(unsigned w) { return __uint_as_float(w & 0xffff0000u); }
__device__ __forceinline__ float wave_sum(float v) {
#pragma unroll
    for (int o = 1; o < 64; o <<= 1) v += __shfl_xor(v, o);
    return v;
}
__device__ __forceinline__ float wave_max(float v) {
#pragma unroll
    for (int o = 1; o < 64; o <<= 1) v = fmaxf(v, __shfl_xor(v, o));
    return v;
}

#define XB_TMO      128
#define XB_XCNT(j)  (256  + 64 * (j))
#define XB_XSUB(j)  (1280 + 64 * (j))
#define XB_XGEN(j)  (2304 + 64 * (j))
#define XB_TOP      3328
#define XB_TOPGEN   3392
#define XCD_BAR_WORDS 3456
#define XB_SPIN_CAP (1u << 22)

__device__ __forceinline__ unsigned xb_ld(unsigned* p)              { return __hip_atomic_load(p, __ATOMIC_RELAXED, __HIP_MEMORY_SCOPE_AGENT); }
__device__ __forceinline__ unsigned xb_add(unsigned* p, unsigned v) { return __hip_atomic_fetch_add(p, v, __ATOMIC_RELAXED, __HIP_MEMORY_SCOPE_AGENT); }
__device__ __forceinline__ unsigned xb_xcc_id() { return (unsigned)__builtin_amdgcn_s_getreg((3 << 11) | 20) & 0xFu; }
#define XB_SPIN(cond, bar) do { unsigned _sp = 0; while (cond) { __builtin_amdgcn_s_sleep(1); \
    if ((++_sp & 255u) == 0u) { if (xb_ld(&(bar)[XB_TMO])) break; if (_sp > XB_SPIN_CAP) { atomicAdd(&(bar)[XB_TMO], 1u); break; } } } } while (0)

struct XcdBarrier { unsigned* bar; unsigned x; volatile LAS unsigned* st; };

__device__ __forceinline__ XcdBarrier xcd_barrier_post(unsigned* bar, volatile LAS unsigned* st) {
    XcdBarrier b; b.bar = bar; b.x = xb_xcc_id(); b.st = st;
    if (threadIdx.x == 0) (void)xb_add(&bar[XB_XCNT(b.x)], 1u);
    return b;
}
__device__ __forceinline__ void xcd_barrier_complete(unsigned* bar, unsigned x, unsigned& nloc, unsigned& nx) {
    const unsigned G = gridDim.x * gridDim.y * gridDim.z;
    unsigned sum, cnt, mine, sp = 0u;
    for (;;) {
        sum = 0u; cnt = 0u; mine = 0u;
#pragma unroll
        for (unsigned j = 0; j < 16; ++j) { const unsigned c = xb_ld(&bar[XB_XCNT(j)]); sum += c; cnt += (c > 0u) ? 1u : 0u; mine = (j == x) ? c : mine; }
        if (sum == G) break;
        __builtin_amdgcn_s_sleep(1);
        if ((++sp & 255u) == 0u) { if (xb_ld(&bar[XB_TMO])) break; if (sp > XB_SPIN_CAP) { atomicAdd(&bar[XB_TMO], 1u); break; } }
    }
    nloc = mine > 0u ? mine : 1u; nx = cnt > 0u ? cnt : 1u;
}
__device__ __forceinline__ void xcd_barrier(const XcdBarrier& b) {
    asm volatile("s_waitcnt vmcnt(0)" ::: "memory");
    __syncthreads();
    if (threadIdx.x == 0) {
        unsigned* bar = b.bar;
        __builtin_amdgcn_s_waitcnt(0);
        unsigned nloc = b.st[0], nx = b.st[1];
        if (nloc == 0u) { xcd_barrier_complete(bar, b.x, nloc, nx); b.st[0] = nloc; b.st[1] = nx; }
        const unsigned old = xb_add(&bar[XB_XSUB(b.x)], 1u);
        const unsigned gen = old / nloc;
        if (old + 1u == (gen + 1u) * nloc) {
            __builtin_amdgcn_fence(__ATOMIC_RELEASE, "agent");
            asm volatile("s_waitcnt vmcnt(0)" ::: "memory");
            const unsigned og = xb_add(&bar[XB_TOP], 1u);
            const unsigned tg = og / nx;
            if (og + 1u == (tg + 1u) * nx) xb_add(&bar[XB_TOPGEN], 1u);
            else XB_SPIN(xb_ld(&bar[XB_TOPGEN]) == tg, bar);
            __builtin_amdgcn_fence(__ATOMIC_ACQUIRE, "agent");
            xb_add(&bar[XB_XGEN(b.x)], 1u);
            asm volatile("s_waitcnt vmcnt(0)" ::: "memory");
        } else {
            XB_SPIN(xb_ld(&bar[XB_XGEN(b.x)]) == gen, bar);
            __builtin_amdgcn_fence(__ATOMIC_ACQUIRE, "agent");
            asm volatile("s_waitcnt vmcnt(0)" ::: "memory");
        }
    }
    __syncthreads();
}

struct Frame {
    LAS unsigned char* lds;
    volatile LAS unsigned* MISC;
    gu32* ctl;
    int tid, lane, wave;
    int vcu, G;
};
struct Args { const float* in[18]; float* out; unsigned char* ws; };

__device__ __forceinline__ float modp_sum(const float* modp, int idx) {
    float s = 0.f;
#pragma unroll
    for (int kc = 0; kc < 8; ++kc) s += modp[(size_t)kc * 8 * 6144 + idx];
    return s;
}
template <int MODE>
__device__ __forceinline__ void p0_wg_dot(Frame& F, const float* cin, const float* modp, int soff, const float* W, int N, const float* addv, float* outp, int first, int ntask) {
    LAS float* scr = (LAS float*)(F.lds + RING_OFF + F.wave * 16384);
    const int ncn = N / 64;
    for (int it = first; it < ntask; it += F.G) {
        const int kc = it / ncn, nc = it % ncn, k0 = kc * 128 + F.wave * 16, n = nc * 64 + F.lane;
        float w[16];
#pragma unroll
        for (int kk = 0; kk < 16; ++kk) w[kk] = (MODE == 0) ? __builtin_nontemporal_load(W + (size_t)(k0 + kk) * N + n) : W[(size_t)(k0 + kk) * N + n];
#pragma unroll
        for (int j = 0; j < 2; ++j) { const int idx = F.lane + 64 * j, b = idx >> 4, kk = idx & 15;
            float cf; if (MODE == 0) { const float cv = cin[b * 1024 + k0 + kk]; cf = cv / (1.0f + __expf(-cv)); } else cf = modp_sum(modp, b * 6144 + soff + k0 + kk);
            scr[idx] = cf; }
        LDS_WAIT(); asm volatile("" ::: "memory");
#pragma unroll
        for (int b = 0; b < 8; ++b) { float s = 0.f;
#pragma unroll
            for (int kk = 0; kk < 16; ++kk) s += scr[b * 16 + kk] * w[kk];
            scr[256 + b * 64 + F.lane] = s; }
        __syncthreads();
        { const int b = F.wave; float s = (addv != nullptr && kc == 0) ? addv[n] : 0.f;
#pragma unroll
          for (int w8 = 0; w8 < 8; ++w8) s += ((LAS float*)(F.lds + RING_OFF + w8 * 16384))[256 + b * 64 + F.lane];
          outp[(size_t)(kc * 8 + b) * N + n] = s; }
        __syncthreads();
    }
}
__device__ __forceinline__ void p0a_mod(Frame& F, const Args& A) { p0_wg_dot<0>(F, A.in[1], nullptr, 0, A.in[2], 6144, A.in[3], (float*)(A.ws + WS_MODP), F.vcu, 8 * 96); }
__device__ __forceinline__ void p0_wp_task(Frame& F, const Args& A, int r) {
    LAS float* scr = (LAS float*)(F.lds + RING_OFF + F.wave * 16384);
    const int g = r >> 6, kq = (r >> 4) & 3, nc = r & 15, n = nc * 64 + F.lane, d0 = 16 * F.wave;
    const float* wmix = A.in[7] + (size_t)(g * 128 + 32 * kq) * 128 + d0; const float* scale = A.in[9] + g * 128 + d0; const float* wup = A.in[10] + (size_t)(g * 128 + d0) * D + n; const float* bmix = A.in[8] + g * 128 + d0;
    float wu[16];
#pragma unroll
    for (int d = 0; d < 16; ++d) wu[d] = wup[(size_t)d * D];
    float bp = 0.f;
#pragma unroll
    for (int d = 0; d < 16; ++d) { wu[d] *= scale[d]; bp += bmix[d] * wu[d]; }
#pragma unroll
    for (int kk = 0; kk < 32; ++kk) { float s = 0.f;
#pragma unroll
        for (int d = 0; d < 16; ++d) s += wmix[kk * 128 + d] * wu[d];
        scr[kk * 64 + F.lane] = s; }
    scr[2048 + F.lane] = bp;
    __syncthreads();
    { float s[4]; float bs = 0.f;
#pragma unroll
      for (int e = 0; e < 4; ++e) s[e] = 0.f;
#pragma unroll
      for (int w8 = 0; w8 < 8; ++w8) { const LAS float* o = (const LAS float*)(F.lds + RING_OFF + w8 * 16384);
#pragma unroll
          for (int e = 0; e < 4; ++e) s[e] += o[(4 * F.wave + e) * 64 + F.lane];
          bs += o[2048 + F.lane]; }
      v2u w; w.x = pk2(s[0], s[1]); w.y = pk2(s[2], s[3]);
      *(GAS v2u*)((bf16*)(A.ws + WS_WP) + (size_t)n * PW + g * 128 + 32 * kq + 4 * F.wave) = w;
      if (kq == 0 && F.wave == 0) ((float*)(A.ws + WS_BPRIME))[g * 1024 + n] = bs; }
    __syncthreads();
}

__device__ __forceinline__ void p0_transpose_item(const float* W, int K, int N, bf16* WT, int row_off, LAS float* scr, int item, int lane) {
    const int nblk = N / 32, kb = item / nblk, nb = item % nblk, k0 = 64 * kb, n0 = 32 * nb;
#pragma unroll 8
    for (int i = 0; i < 32; ++i) { const int kk = 2 * i + (lane >> 5); scr[kk * 33 + (lane & 31)] = __builtin_nontemporal_load(W + (size_t)(k0 + kk) * N + n0 + (lane & 31)); }
    LDS_WAIT(); asm volatile("" ::: "memory");
    const int c = lane & 7;
#pragma unroll
    for (int j = 0; j < 4; ++j) { const int n = (lane >> 3) + 8 * j; const LAS float* s = scr + (8 * c) * 33 + n;
        v4u o; o.x = pk2(s[0 * 33], s[1 * 33]); o.y = pk2(s[2 * 33], s[3 * 33]); o.z = pk2(s[4 * 33], s[5 * 33]); o.w = pk2(s[6 * 33], s[7 * 33]);
        *(GAS v4u*)(WT + (size_t)(row_off + n0 + n) * K + k0 + 8 * c) = o; }
    LDS_WAIT(); asm volatile("" ::: "memory");
}
__device__ __forceinline__ void p0_table_rows4(const float* const (&src)[4], unsigned char* const (&dst)[4], float* const (&scale_out)[4], int off, int lane) {
    f32x4 v[4][4]; float am[4];
#pragma unroll
    for (int u = 0; u < 4; ++u)
#pragma unroll
        for (int q = 0; q < 4; ++q) v[u][q] = __builtin_nontemporal_load((const f32x4*)(src[u] + 16 * lane + 4 * q));
#pragma unroll
    for (int u = 0; u < 4; ++u) { float a = 0.f;
#pragma unroll
        for (int q = 0; q < 4; ++q) a = fmaxf(fmaxf(a, fmaxf(fabsf(v[u][q][0]), fabsf(v[u][q][1]))), fmaxf(fabsf(v[u][q][2]), fabsf(v[u][q][3])));
        am[u] = a; }
#pragma unroll
    for (int o = 1; o < 64; o <<= 1) {
#pragma unroll
        for (int u = 0; u < 4; ++u) am[u] = fmaxf(am[u], __shfl_xor(am[u], o)); }
#pragma unroll
    for (int u = 0; u < 4; ++u) { const float sc = (am[u] > 0.f) ? am[u] * (1.0f / 127.0f) : 1.0f, inv = 1.0f / sc;
        v4u o;
#pragma unroll
        for (int q = 0; q < 4; ++q) { const int q0 = (int)rintf(v[u][q][0] * inv) + off, q1 = (int)rintf(v[u][q][1] * inv) + off, q2 = (int)rintf(v[u][q][2] * inv) + off, q3 = (int)rintf(v[u][q][3] * inv) + off;
            o[q] = (unsigned)(q0 & 255) | ((unsigned)(q1 & 255) << 8) | ((unsigned)(q2 & 255) << 16) | ((unsigned)q3 << 24); }
        *(GAS v4u*)(dst[u] + ((size_t)(lane >> 3) << 21) + 16 * (lane & 7)) = o;
        if (lane == 0) *scale_out[u] = sc; }
}
__device__ __forceinline__ void p0_table_trip(const Args& A, int r0, int NGW, int lane) {
    const float* src[4]; unsigned char* dst[4]; float* sco[4];
#pragma unroll
    for (int u = 0; u < 4; ++u) { int r = r0 + u * NGW; if (r >= 2 * PEXP) r = r0; const int tb = r / PEXP, e = r % PEXP;
        src[u] = (tb ? A.in[16] : A.in[15]) + (size_t)e * D; dst[u] = A.ws + (tb ? WS_V : WS_U) + (size_t)e * 128; sco[u] = (float*)(A.ws + WS_U + 16 * MiB) + 2 * e + tb; }
    const int tb0 = r0 / PEXP;
    if ((r0 + 3 * NGW) / PEXP == tb0 && r0 + 3 * NGW < 2 * PEXP) p0_table_rows4(src, dst, sco, tb0 ? 128 : 0, lane);
    else { for (int u = 0; u < 4; ++u) { const int r = r0 + u * NGW; if (r < 2 * PEXP) { const float* s1[4] = {src[u], src[u], src[u], src[u]}; unsigned char* d1[4] = {dst[u], dst[u], dst[u], dst[u]}; float* c1[4] = {sco[u], sco[u], sco[u], sco[u]}; p0_table_rows4(s1, d1, c1, (r / PEXP) ? 128 : 0, lane); } } }
}
template <int STAGE>
__device__ __forceinline__ void p0b_prologue(Frame& F, const Args& A) {
    const int gw = F.vcu * NWAVES + F.wave, NGW = F.G * NWAVES, lane = F.lane;
    const float* modp = (const float*)(A.ws + WS_MODP);
    LAS float* G1 = (LAS float*)(F.lds + 135168);
    if (STAGE == 0) { float* ks = (float*)(A.ws + WS_KSUM); for (int i = F.vcu * NTHREADS + F.tid; i < NB * NBLK * 512; i += F.G * NTHREADS) ks[i] = 0.f; }
    if (STAGE == 0) { for (int r = F.vcu; r < 256; r += F.G) p0_wp_task(F, A, r); }
    else { p0_wg_dot<1>(F, nullptr, modp, 0, A.in[5], INW, nullptr, (float*)(A.ws + WS_BIAS1P), F.vcu, 8 * (INW / 64));
           p0_wg_dot<1>(F, nullptr, modp, 3072, A.in[13], PQW, nullptr, (float*)(A.ws + WS_BIAS2P), F.vcu, 8 * (PQW / 64)); }
    LAS float* scr = (LAS float*)(F.lds + RING_OFF + F.wave * 16384);
    constexpr int I_MODF = 768, I_WIN = (D / 64) * (INW / 32), I_WA = (AW / 64) * (D / 32), I_WOUT = (D / 64) * (D / 32), I_WQ = (D / 64) * (PQW / 32);
    constexpr int I_SUBK = 64;
    constexpr int NITEMS = I_MODF + I_WIN + I_WA + I_WOUT + I_WQ + I_SUBK;
    for (int it = gw; it < NITEMS; it += NGW) {
        int r = it;
        if (r < I_MODF) { if (STAGE != 1) continue; const int idx = r * 64 + lane; ((float*)(A.ws + WS_MODF))[idx] = modp_sum(modp, idx); continue; } r -= I_MODF;
        if (r < I_WIN) { if (STAGE != 0) continue; p0_transpose_item(A.in[5], D, INW, (bf16*)(A.ws + WS_WIN), 0, scr, r, lane); continue; } r -= I_WIN;
        if (r < I_WA) { if (STAGE != 0) continue; p0_transpose_item(A.in[6], AW, D, (bf16*)(A.ws + WS_WA), 0, scr, r, lane); continue; } r -= I_WA;
        if (r < I_WOUT) { if (STAGE != 0) continue; p0_transpose_item(A.in[11], D, D, (bf16*)(A.ws + WS_WOUT), 0, scr, r, lane); continue; } r -= I_WOUT;
        if (r < I_WQ) { if (STAGE != 0) continue; p0_transpose_item(A.in[13], D, PQW, (bf16*)(A.ws + WS_WQ), 0, scr, r, lane); continue; } r -= I_WQ;
        if (r < I_SUBK) { if (STAGE != 0) continue; const float* s = A.in[14] + (size_t)r * 512 + 8 * lane; const f32x4 a = *(const f32x4*)s, b = *(const f32x4*)(s + 4);
            v4u o; o.x = pk2(a[0], a[1]); o.y = pk2(a[2], a[3]); o.z = pk2(b[0], b[1]); o.w = pk2(b[2], b[3]);
            *(GAS v4u*)((bf16*)(A.ws + WS_SUBK) + (size_t)r * 512 + 8 * lane) = o; continue; } r -= I_SUBK;
    }
    auto xg_rows = [&](const int rb) {
        const float* x = A.in[0]; bf16* XG = (bf16*)(A.ws + WS_XG); float* rstd1 = (float*)(A.ws + WS_RSTD1);
            for (int r0 = F.wave; r0 < 128; r0 += 4 * NWAVES) {
                f32x4 v[4][2][2]; float s[4];
#pragma unroll
                for (int u = 0; u < 4; ++u) { const float* xr = x + (size_t)(rb * 128 + r0 + u * NWAVES) * 1024;
#pragma unroll
                    for (int h = 0; h < 2; ++h)
#pragma unroll
                        for (int q = 0; q < 2; ++q) v[u][h][q] = __builtin_nontemporal_load((const f32x4*)(xr + h * 512 + 8 * lane + 4 * q)); }
#pragma unroll
                for (int u = 0; u < 4; ++u) { float t = 0.f;
#pragma unroll
                    for (int h = 0; h < 2; ++h)
#pragma unroll
                        for (int q = 0; q < 2; ++q) t += (v[u][h][q][0] * v[u][h][q][0] + v[u][h][q][1] * v[u][h][q][1]) + (v[u][h][q][2] * v[u][h][q][2] + v[u][h][q][3] * v[u][h][q][3]);
                    s[u] = t; }
#pragma unroll
                for (int o = 1; o < 64; o <<= 1) {
#pragma unroll
                    for (int u = 0; u < 4; ++u) s[u] += __shfl_xor(s[u], o); }
#pragma unroll
                for (int u = 0; u < 4; ++u) { const int row = rb * 128 + r0 + u * NWAVES;
                    if (lane == 0) rstd1[row] = 1.0f / sqrtf(s[u] * (1.0f / D) + RMS_EPS);
#pragma unroll
                    for (int h = 0; h < 2; ++h) { const LAS float* g = G1 + h * 512 + 8 * lane;
                        v4u o; o.x = pk2(v[u][h][0][0] * g[0], v[u][h][0][1] * g[1]); o.y = pk2(v[u][h][0][2] * g[2], v[u][h][0][3] * g[3]); o.z = pk2(v[u][h][1][0] * g[4], v[u][h][1][1] * g[5]); o.w = pk2(v[u][h][1][2] * g[6], v[u][h][1][3] * g[7]);
                        *(GAS v4u*)(XG + (size_t)row * 1024 + h * 512 + 8 * lane) = o; } }
            }
    };
#ifndef TABLES_IN_ROUTER
    if (STAGE == 0) { for (int r0 = gw; r0 < 2 * PEXP; r0 += 4 * NGW) p0_table_trip(A, r0, NGW, lane); }
    else
#else
    if (STAGE == 1)
#endif
    for (int rb = F.vcu; rb < T / 128; rb += F.G) {
        const float* g1 = A.in[4]; const int b = (rb * 128) / SEQ;
        __syncthreads();
        for (int k = F.tid; k < 1024; k += NTHREADS) G1[k] = g1[k] * (1.0f + modp_sum(modp, b * 6144 + 1024 + k));
        __syncthreads();
        xg_rows(rb);
    }

}
namespace attn_body {
using bf16=__hip_bfloat16;
using bf16x8=__attribute__((ext_vector_type(8)))short;
using s16x4=__attribute__((ext_vector_type(4)))short;
using f32x16=__attribute__((ext_vector_type(16)))float;
using u32x4=__attribute__((ext_vector_type(4)))unsigned;
constexpr int BATCH=8,NHEAD=8,SEQ=4096,D=64,DM=NHEAD*D;
constexpr int NW=8,QBLK=32,QB=QBLK*NW,KVBLK=64,NQB=SEQ/QB;
constexpr int ATTN_PITCH=DM, ATTN_UNIT_ROWS=QB;
__device__ __forceinline__ int crow(int r,int hi){return (r&3)+8*(r>>2)+4*hi;}
#define SBAR() __builtin_amdgcn_sched_barrier(0)
__device__ __forceinline__ void cmask(f32x16&p0,f32x16&p1,int jb,int qrel,int hi){
  const float NEG=-INFINITY; int kb=64*jb+4*hi;
  #pragma unroll
  for(int r=0;r<16;++r){int kv=kb+(r&3)+8*(r>>2); if(kv>qrel)p0[r]=NEG; if(kv+32>qrel)p1[r]=NEG;}
}

constexpr int NSLOT=3, SLOTB=8192;
constexpr int LDS_K=0, LDS_V=NSLOT*SLOTB, LDS_WS=2*NSLOT*SLOTB, LDS_OST=LDS_WS+NW*64*4, LDS_KSL=LDS_OST+NW*4096, LDS_BYTES=LDS_KSL+4096;
constexpr float C2=0.125f*1.4426950408889634f;
__device__ __forceinline__ void glds16(const void*sbase,unsigned voff,unsigned lds_dst){unsigned keep;
  asm volatile("s_mov_b32 %0, m0\n\ts_mov_b32 m0, %3\n\ts_nop 4\n\tglobal_load_lds_dwordx4 %1, %2\n\ts_mov_b32 m0, %0":"=&s"(keep):"v"(voff),"s"(sbase),"s"(lds_dst):"memory");}
__device__ __forceinline__ float max3f(float a,float b,float c){float r;asm("v_max3_f32 %0, %1, %2, %3":"=v"(r):"v"(a),"v"(b),"v"(c));return r;}
__device__ __forceinline__ float max2f(float a,float b){float r;asm("v_max_f32_e32 %0, %1, %2":"=v"(r):"v"(a),"v"(b));return r;}
__device__ __forceinline__ float fadd_s(float a,float b){float r;asm("v_add_f32_e32 %0, %1, %2":"=v"(r):"v"(a),"v"(b));return r;}
__device__ __forceinline__ float fsub_s(float a,float b){float r;asm("v_sub_f32_e32 %0, %1, %2":"=v"(r):"v"(a),"v"(b));return r;}
typedef float f32x2_t __attribute__((ext_vector_type(2))); typedef __bf16 bf16x2_t __attribute__((ext_vector_type(2)));
__device__ __forceinline__ unsigned cvtpk_s(float lo,float hi){f32x2_t v={lo,hi};bf16x2_t b=__builtin_convertvector(v,bf16x2_t);return __builtin_bit_cast(unsigned,b);}
#define WAIT_BAR(N) asm volatile("s_waitcnt vmcnt(" #N ") lgkmcnt(0)\n\ts_barrier":::"memory")

__device__ __forceinline__ void qkt(f32x16&p0,f32x16&p1,const char*Kslot,const bf16x8*qr,const f32x16&negm,int r32,int hi){
  const char*kb=Kslot+hi*1024+r32*16;
  #pragma unroll
  for(int d0=0;d0<4;++d0){
    const bf16x8 b0=*reinterpret_cast<const bf16x8*>(kb+d0*2048);
    const bf16x8 b1=*reinterpret_cast<const bf16x8*>(kb+d0*2048+512);
    if(d0==0){p0=__builtin_amdgcn_mfma_f32_32x32x16_bf16(b0,qr[0],negm,0,0,0);p1=__builtin_amdgcn_mfma_f32_32x32x16_bf16(b1,qr[0],negm,0,0,0);}
    else{p0=__builtin_amdgcn_mfma_f32_32x32x16_bf16(b0,qr[d0],p0,0,0,0);p1=__builtin_amdgcn_mfma_f32_32x32x16_bf16(b1,qr[d0],p1,0,0,0);}}
}
typedef __attribute__((address_space(3))) const char* lds_cptr;
typedef short v4i16_t __attribute__((ext_vector_type(4)));
__device__ __forceinline__ void kload8(bf16x8*kf,lds_cptr kp){
  kf[0]=*(const __attribute__((address_space(3))) bf16x8*)(kp);      kf[1]=*(const __attribute__((address_space(3))) bf16x8*)(kp+512);
  kf[2]=*(const __attribute__((address_space(3))) bf16x8*)(kp+2048); kf[3]=*(const __attribute__((address_space(3))) bf16x8*)(kp+2560);
  kf[4]=*(const __attribute__((address_space(3))) bf16x8*)(kp+4096); kf[5]=*(const __attribute__((address_space(3))) bf16x8*)(kp+4608);
  kf[6]=*(const __attribute__((address_space(3))) bf16x8*)(kp+6144); kf[7]=*(const __attribute__((address_space(3))) bf16x8*)(kp+6656);
}
__device__ __forceinline__ void kload2(bf16x8*kf,lds_cptr kp,int j){ kf[2*j]=*(const __attribute__((address_space(3))) bf16x8*)(kp+j*2048); kf[2*j+1]=*(const __attribute__((address_space(3))) bf16x8*)(kp+j*2048+512); }
__device__ __forceinline__ s16x4 vtr(lds_cptr p){ return __builtin_bit_cast(s16x4,__builtin_amdgcn_ds_read_tr16_b64_v4i16((__attribute__((address_space(3))) v4i16_t*)p)); }
__device__ __forceinline__ float rowmax(const f32x16&p0,const f32x16&p1){
  float a=max3f(p0[0],p0[1],p1[0]),b=max3f(p0[2],p0[3],p1[1]);a=max3f(a,p1[2],p1[3]);
  #pragma unroll
  for(int r=4;r<16;r+=4){a=max3f(a,p0[r],p0[r+1]);b=max3f(b,p0[r+2],p0[r+3]);a=max3f(a,p1[r],p1[r+1]);b=max3f(b,p1[r+2],p1[r+3]);}
  const float m=max2f(a,b);
  auto rr=__builtin_amdgcn_permlane32_swap(__float_as_uint(m),__float_as_uint(m),false,false);
  return max2f(__uint_as_float(rr[0]),__uint_as_float(rr[1]));
}
__device__ __forceinline__ void pv(f32x16*o,int vb,bf16x8 pa0,bf16x8 pa1,bf16x8 pa2,bf16x8 pa3){
  #pragma unroll
  for(int d0=0;d0<2;++d0){s16x4 lo[4],hi[4];
    #pragma unroll
    for(int ks=0;ks<4;++ks){
      asm volatile("ds_read_b64_tr_b16 %0,%1 offset:%c2":"=&v"(lo[ks]):"v"(vb),"i"(d0*4096+ks*1024):"memory");
      asm volatile("ds_read_b64_tr_b16 %0,%1 offset:%c2":"=&v"(hi[ks]):"v"(vb),"i"(d0*4096+ks*1024+512):"memory");}
    asm volatile("s_waitcnt lgkmcnt(0)":::"memory");SBAR();
    #define PK(k) (bf16x8){lo[k][0],lo[k][1],lo[k][2],lo[k][3],hi[k][0],hi[k][1],hi[k][2],hi[k][3]}
    o[d0]=__builtin_amdgcn_mfma_f32_32x32x16_bf16(pa0,PK(0),o[d0],0,0,0);
    o[d0]=__builtin_amdgcn_mfma_f32_32x32x16_bf16(pa1,PK(1),o[d0],0,0,0);
    o[d0]=__builtin_amdgcn_mfma_f32_32x32x16_bf16(pa2,PK(2),o[d0],0,0,0);
    o[d0]=__builtin_amdgcn_mfma_f32_32x32x16_bf16(pa3,PK(3),o[d0],0,0,0);
    #undef PK
  }
}

#ifndef ATTN_STORE16
#define ATTN_STORE16(p,v) (*(u32x4*)(p)=(v))
#endif
template<int THRL> __device__ __forceinline__ void attn_unit(int b,int h,int qb,const bf16*Q,const bf16*__restrict__ K,const bf16*__restrict__ V,bf16*O,const float*ksum,const float*nrm,char*shm){
  int tid_=threadIdx.x; asm volatile("":"+v"(tid_)); const int tid=tid_,lane=tid&63,r32=lane&31,hi=lane>>5; const int wid=__builtin_amdgcn_readfirstlane(tid>>6);
  const long rowbase=(long)b*SEQ; const int q0=qb*QB;
  const bf16*Qw=Q+(rowbase+q0+wid*QBLK)*DM+h*D;
  const bf16*Kh=K+rowbase*DM+h*D,*Vh=V+rowbase*DM+h*D;
  const unsigned lds0=(unsigned)(uintptr_t)shm;
  float*wsf=(float*)(shm+LDS_WS)+wid*64;
  const unsigned kvoff=(unsigned)(lane*DM+wid*8)*2u;
  const unsigned vvoff=(unsigned)((16*(wid&3)+(lane>>2))*DM+(wid>>2)*32+(lane&3)*8)*2u;
  const unsigned kdst=lds0+LDS_K+wid*1024, vdst=lds0+LDS_V+wid*1024;
  #define DMA_K(t,slot) glds16(Kh+(long)(NTF-1-(t))*KVBLK*DM,kvoff,(unsigned)__builtin_amdgcn_readfirstlane(kdst+(slot)))
  #define DMA_V(t,slot) glds16(Vh+(long)(NTF-1-(t))*KVBLK*DM,vvoff,(unsigned)__builtin_amdgcn_readfirstlane(vdst+(slot)))
  const int vb0=(int)(lds0+LDS_V)+((lane>>4)&1)*32+(lane&3)*8+(4*hi+((lane&15)>>2))*64;
  const char*Kbase=shm+LDS_K; bf16x8 kf[8];
  const lds_cptr shm3=(lds_cptr)shm; const lds_cptr kp0=shm3+LDS_K+hi*1024+r32*16; const lds_cptr vp0=shm3+LDS_V+((lane>>4)&1)*32+(lane&3)*8+(4*hi+((lane&15)>>2))*64;
  const int NTF=(q0+QB)/KVBLK;
  int NT=NTF;
  { const float*nq=nrm+(long)(b*2+0)*16+2*h,*nk=nrm+(long)(b*2+1)*16+2*h; const float B=__builtin_sqrtf((nq[0]+nq[1])*(nk[0]+nk[1]))*1.02f+0.5f;
    const float slope2_=__uint_as_float(0x3FB8AA3Bu-((unsigned)(h+1)<<23)); const float dh=(160.f+2.f*B)/slope2_;
    const float tminf=((float)(q0-63)-dh)*(1.f/64.f); int tmin=tminf>0.f?(int)tminf:0;
    tmin=__builtin_amdgcn_readfirstlane(tmin); int nt=NTF-tmin; nt+=nt&1; if(nt>NTF)nt=NTF; if(nt<4)nt=4; NT=nt; }
  { float*ksl=(float*)(shm+LDS_KSL); const float k0=ksum[(long)(b*16+(tid>>6))*512+h*64+(tid&63)],k1=ksum[(long)(b*16+8+(tid>>6))*512+h*64+(tid&63)]; ksl[tid]=k0; ksl[512+tid]=k1; }
  DMA_K(0,0);DMA_V(0,0);DMA_K(1,SLOTB);
  bf16x8 qr[4];
  #pragma unroll
  for(int d0=0;d0<4;++d0)qr[d0]=*reinterpret_cast<const bf16x8*>(&Qw[(long)r32*DM+d0*16+hi*8]);
  float mhat=0.f,l_reg=0.f;f32x16 o[2];o[0]=f32x16{};o[1]=f32x16{};const f32x16 zero16=f32x16{};
  const int qrel=wid*QBLK+r32;
  #define CMASK(P0,P1,t) do{int jb_=3-(t); if(jb_>=0)cmask(P0,P1,jb_,qrel,hi);}while(0)
  const unsigned sl2b=0x3FB8AA3Bu-((unsigned)(h+1)<<23);
  const float slope2=__uint_as_float(sl2b), s2x=__uint_as_float(sl2b+(1u<<23)), s8x=__uint_as_float(sl2b+(3u<<23)), s32=__uint_as_float(sl2b+(5u<<23));
  const float s3x=__uint_as_float((unsigned)__builtin_amdgcn_readfirstlane((int)__float_as_uint(slope2*3.0f)));
  #define NBSEL(r) (((r)>>2)==0?nbb0_:((r)>>2)==1?nbb1_:((r)>>2)==2?nbb2_:nbb3_)
  #define NEGV(r) ((((r)&3)==0)?NBSEL(r):(NBSEL(r)+(((r)&3)==1?slope2:((r)&3)==2?s2x:s3x)))
  #define NBB(nb) const float nbb0_=(nb), nbb1_=nbb0_+s8x, nbb2_=nbb1_+s8x, nbb3_=nbb2_+s8x
  #define NBSELC(r) (((r)>>2)==0?nbc0_:((r)>>2)==1?nbc1_:((r)>>2)==2?nbc2_:nbc3_)
  #define SAV(r) (((r)&3)==1?slope2:((r)&3)==2?s2x:s3x)
  #define BIAS(C0,C1,s) do{ NBB(NBV(s)); const float nbc0_=nbb0_+s32,nbc1_=nbb1_+s32,nbc2_=nbb2_+s32,nbc3_=nbb3_+s32; \
      _Pragma("unroll") for(int r=0;r<16;++r){ if((r&3)==0){C0[r]+=NBSEL(r);C1[r]+=NBSELC(r);} else {C0[r]=(C0[r]+NBSEL(r))+SAV(r);C1[r]=(C1[r]+NBSELC(r))+SAV(r);} } }while(0)
  unsigned sel=0u;
  #define NBV(s) ({ const int tl_=NTF-1-(s); const int tc_=tl_<0?0:tl_; const int bj_=tc_>>2; const float off_=(bj_>=qb||((sel>>bj_)&1u))?0.f:-1.0e30f; \
      __builtin_fmaf(slope2,(float)(64*tl_+4*hi-q0-qrel),off_-mhat); })
  #define CRC(r) ((float)(((r)&3)+8*((r)>>2)))
  bool resc=false;
  #define START(P0,P1) do{ const float rm=rowmax(P0,P1); resc=false; \
    { const float dl=(rm>-1.0e20f)?rm:0.f; mhat=fadd_s(mhat,dl); \
      _Pragma("unroll") for(int r=0;r<16;++r){P0[r]=fsub_s(P0[r],dl);P1[r]=fsub_s(P1[r],dl);} } \
    _Pragma("unroll") for(int r=0;r<16;++r)P0[r]=__builtin_amdgcn_exp2f(P0[r]); }while(0)
  #define RESC() do{ if(resc){ asm volatile("s_waitcnt lgkmcnt(0)":::"memory"); \
      _Pragma("unroll") for(int d_=0;d_<2;++d_) _Pragma("unroll") for(int r=0;r<16;++r)o[d_][r]*=wsf[crow(r,hi)]; } }while(0)
  f32x16 pA0,pA1,pB0,pB1;
  int sl_prev=0,sl_cur=0,sl_next=SLOTB;
  #define ROT() do{sl_prev=sl_cur;sl_cur=sl_next;sl_next=(sl_next==(NSLOT-1)*SLOTB)?0:sl_next+SLOTB;}while(0)
  DMA_K(2,2*SLOTB);
  WAIT_BAR(3);
  if(qb>0){
    float qf[32];
    _Pragma("unroll") for(int d0=0;d0<4;++d0) _Pragma("unroll") for(int e=0;e<8;++e) qf[d0*8+e]=__uint_as_float(((unsigned)(unsigned short)qr[d0][e])<<16);
    const float*ksl=(const float*)(shm+LDS_KSL)+8*hi;
    float b1=-3.0e38f,b2=-3.0e38f,b3=-3.0e38f; int i1=-1,i2=-1,i3=-1;
    for(int j=0;j<qb;++j){ float g=0.f;
      _Pragma("unroll") for(int d0=0;d0<4;++d0) _Pragma("unroll") for(int e=0;e<8;++e) g=__builtin_fmaf(qf[d0*8+e],ksl[j*64+16*d0+e],g);
      { auto rr=__builtin_amdgcn_permlane32_swap(__float_as_uint(g),__float_as_uint(g),false,false); g=__uint_as_float(rr[0])+__uint_as_float(rr[1]); }
      const bool c1=g>b1,c2=g>b2,c3=g>b3;
      b3=c2?b2:(c3?g:b3); i3=c2?i2:(c3?j:i3); b2=c1?b1:(c2?g:b2); i2=c1?i1:(c2?j:i2); b1=c1?g:b1; i1=c1?j:i1; }
    sel=(1u<<i1)|(i2>=0?(1u<<i2):0u)|(i3>=0?(1u<<i3):0u); }
  qkt(pA0,pA1,Kbase,qr,zero16,r32,hi);asm volatile("s_nop 15\n\ts_nop 7":"+v"(pA0),"+v"(pA1));
  BIAS(pA0,pA1,0);
  CMASK(pA0,pA1,0);
  START(pA0,pA1);
  _Pragma("unroll") for(int r=0;r<16;++r)pA1[r]=__builtin_amdgcn_exp2f(pA1[r]);
  WAIT_BAR(0);
  DMA_K(3,0);DMA_V(1,SLOTB);
  ROT();
  kload8(kf,kp0+sl_cur);
  WAIT_BAR(2);
  s16x4 vlo[8],vhi[8]; u32x4 pw0,pw1,pw2,pw3;
  #define PKW(P,B) cvtpk_s(P[B],P[B+1])
  #define PAF(k) __builtin_bit_cast(bf16x8,pw##k)
  #define VFR(i) (bf16x8){vlo[i][0],vlo[i][1],vlo[i][2],vlo[i][3],vhi[i][0],vhi[i][1],vhi[i][2],vhi[i][3]}
  #define PIN(x) asm volatile("":"+v"(x))
  #define MX3(a,b,c) __builtin_fmaxf(__builtin_fmaxf((a),(b)),(c))
  #define GAPA(MF,A0,A1,A2,A3,W0,W1,PW) do{ MF; sacc+=A0; sacc+=A1; sacc+=A2; sacc+=A3; PIN(sacc); W0; W1; PIN(PW); SBAR(); }while(0)
  #define EX(v) __builtin_amdgcn_exp2f(v)
  #define GAPB(MF,X,B) do{ MF; X[B]=EX(X[B]); X[B+1]=EX(X[B+1]); X[B+2]=EX(X[B+2]); X[B+3]=EX(X[B+3]); PIN(X); SBAR(); }while(0)
  #define VRD(i) do{ vlo[i]=vtr(vp_+(((i)>>2)*4096+((i)&3)*1024)); vhi[i]=vtr(vp_+(((i)>>2)*4096+((i)&3)*1024+512)); }while(0)
  #define KRD(G,j) do{ if(G){ kload2(kf,kp0+sl_next,j); SBAR(); } }while(0)
  #define STEP(C0,C1,P0,P1,t,GK,GV,GL) do{ SBAR(); \
    const lds_cptr vp_=vp0+sl_prev; \
    VRD(0); SBAR(); float sacc=(P0[0]+P0[1]); \
    GAPA(C0=__builtin_amdgcn_mfma_f32_32x32x16_bf16(kf[0],qr[0],zero16,0,0,0), P0[2],P0[3],P0[4],P0[5],     pw0[0]=PKW(P0,0), pw0[1]=PKW(P0,2), pw0); \
    VRD(4); SBAR(); GAPA(C1=__builtin_amdgcn_mfma_f32_32x32x16_bf16(kf[1],qr[0],zero16,0,0,0), P0[6],P0[7],P0[8],P0[9],     pw0[2]=PKW(P0,4), pw0[3]=PKW(P0,6), pw0); \
    VRD(1); SBAR(); GAPA(C0=__builtin_amdgcn_mfma_f32_32x32x16_bf16(kf[2],qr[1],C0,0,0,0),   P0[10],P0[11],P0[12],P0[13], pw1[0]=PKW(P0,8), pw1[1]=PKW(P0,10), pw1); \
    VRD(5); SBAR(); GAPA(C1=__builtin_amdgcn_mfma_f32_32x32x16_bf16(kf[3],qr[1],C1,0,0,0),   P0[14],P0[15],P1[0],P1[1],   pw1[2]=PKW(P0,12),pw1[3]=PKW(P0,14), pw1); \
    VRD(2); SBAR(); GAPA(C0=__builtin_amdgcn_mfma_f32_32x32x16_bf16(kf[4],qr[2],C0,0,0,0),   P1[2],P1[3],P1[4],P1[5],     pw2[0]=PKW(P1,0), pw2[1]=PKW(P1,2), pw2); \
    VRD(6); SBAR(); GAPA(C1=__builtin_amdgcn_mfma_f32_32x32x16_bf16(kf[5],qr[2],C1,0,0,0),   P1[6],P1[7],P1[8],P1[9],     pw2[2]=PKW(P1,4), pw2[3]=PKW(P1,6), pw2); \
    VRD(3); SBAR(); GAPA(C0=__builtin_amdgcn_mfma_f32_32x32x16_bf16(kf[6],qr[3],C0,0,0,0),   P1[10],P1[11],P1[12],P1[13], pw3[0]=PKW(P1,8), pw3[1]=PKW(P1,10), pw3); \
    VRD(7); SBAR(); GAPA(C1=__builtin_amdgcn_mfma_f32_32x32x16_bf16(kf[7],qr[3],C1,0,0,0),   P1[14],P1[15],0.f,0.f,       pw3[2]=PKW(P1,12),pw3[3]=PKW(P1,14), pw3); \
    l_reg+=sacc; \
    if(GK){DMA_K((t)+3,sl_cur);} if(GV){DMA_V((t)+1,sl_next);} \
    BIAS(C0,C1,t); \
    CMASK(C0,C1,t); \
    { float a=MX3(C0[0],C0[1],C1[0]),b=MX3(C0[2],C0[3],C1[1]); a=MX3(a,C1[2],C1[3]); \
      _Pragma("unroll") for(int r=4;r<16;r+=4){a=MX3(a,C0[r],C0[r+1]);b=MX3(b,C0[r+2],C0[r+3]);a=MX3(a,C1[r],C1[r+1]);b=MX3(b,C1[r+2],C1[r+3]);} \
      float rm=__builtin_fmaxf(a,b); { auto rr=__builtin_amdgcn_permlane32_swap(__float_as_uint(rm),__float_as_uint(rm),false,false); rm=__builtin_fmaxf(__uint_as_float(rr[0]),__uint_as_float(rr[1])); } \
      resc=false; \
      if(__builtin_expect(__any(rm>(float)THRL),0)){ const float dl=__builtin_fmaxf(rm,0.f); mhat+=dl; \
        _Pragma("unroll") for(int r=0;r<16;++r){C0[r]-=dl;C1[r]-=dl;} \
        const float f=__builtin_amdgcn_exp2f(-dl); l_reg*=f; if(hi==0)wsf[r32]=f; resc=true; } } \
    SBAR(); \
    GAPB(o[0]=__builtin_amdgcn_mfma_f32_32x32x16_bf16(PAF(0),VFR(0),o[0],0,0,0), C0,0); \
    GAPB(o[1]=__builtin_amdgcn_mfma_f32_32x32x16_bf16(PAF(0),VFR(4),o[1],0,0,0), C0,4); \
    KRD(GL,0); GAPB(o[0]=__builtin_amdgcn_mfma_f32_32x32x16_bf16(PAF(1),VFR(1),o[0],0,0,0), C0,8); \
    KRD(GL,1); GAPB(o[1]=__builtin_amdgcn_mfma_f32_32x32x16_bf16(PAF(1),VFR(5),o[1],0,0,0), C0,12); \
    KRD(GL,2); GAPB(o[0]=__builtin_amdgcn_mfma_f32_32x32x16_bf16(PAF(2),VFR(2),o[0],0,0,0), C1,0); \
    KRD(GL,3); GAPB(o[1]=__builtin_amdgcn_mfma_f32_32x32x16_bf16(PAF(2),VFR(6),o[1],0,0,0), C1,4); \
    GAPB(o[0]=__builtin_amdgcn_mfma_f32_32x32x16_bf16(PAF(3),VFR(3),o[0],0,0,0), C1,8); \
    GAPB(o[1]=__builtin_amdgcn_mfma_f32_32x32x16_bf16(PAF(3),VFR(7),o[1],0,0,0), C1,12); \
    }while(0)
  int t=1;
  #define ENDW(tt) do{ if((tt)+3<NT){WAIT_BAR(2);} else if((tt)+2<NT){WAIT_BAR(1);} else {WAIT_BAR(0);} }while(0)
  #define PEELED_PAIR() do{ \
    STEP(pB0,pB1,pA0,pA1,t,(t+3<NT),(t+1<NT),(t+1<NT));       ENDW(t);   RESC(); ROT(); \
    STEP(pA0,pA1,pB0,pB1,t+1,(t+4<NT),(t+2<NT),(t+2<NT));     ENDW(t+1); RESC(); ROT(); }while(0)
  for(;t<5&&t+1<NT;t+=2){ PEELED_PAIR(); }
  #undef CMASK
  #define CMASK(P0,P1,t) do{}while(0)
  for(;t+5<NT;t+=2){
    STEP(pB0,pB1,pA0,pA1,t,true,true,true);     WAIT_BAR(2); RESC(); ROT();
    STEP(pA0,pA1,pB0,pB1,t+1,true,true,true);   WAIT_BAR(2); RESC(); ROT();
  }
  #undef CMASK
  #define CMASK(P0,P1,t) do{int jb_=3-(t); if(jb_>=0)cmask(P0,P1,jb_,qrel,hi);}while(0)
  for(;t+1<NT;t+=2){ PEELED_PAIR(); }
  STEP(pB0,pB1,pA0,pA1,NT-1,false,false,false); RESC();
  { float sacc=pB0[0]+pB0[1]; _Pragma("unroll") for(int r=2;r<16;++r)sacc+=pB0[r]; _Pragma("unroll") for(int r=0;r<16;++r)sacc+=pB1[r]; l_reg+=sacc;
    pw0=(u32x4){PKW(pB0,0),PKW(pB0,2),PKW(pB0,4),PKW(pB0,6)};pw1=(u32x4){PKW(pB0,8),PKW(pB0,10),PKW(pB0,12),PKW(pB0,14)};pw2=(u32x4){PKW(pB1,0),PKW(pB1,2),PKW(pB1,4),PKW(pB1,6)};pw3=(u32x4){PKW(pB1,8),PKW(pB1,10),PKW(pB1,12),PKW(pB1,14)};
    SBAR(); pv(o,vb0+sl_cur,PAF(0),PAF(1),PAF(2),PAF(3)); }
  #undef PKW
  #undef PAF
  #undef VFR
  #undef PIN
  #undef MX3
  #undef GAPA
  #undef GAPB
  #undef EX
  #undef VRD
  #undef KRD
  #undef STEP
  #undef ENDW
  #undef PEELED_PAIR
  #undef NBV
  #undef CRC
  #undef NEGV
  #undef NBSEL
  #undef NBB
  #undef NBSELC
  #undef SAV
  #undef BIAS
  {auto rr=__builtin_amdgcn_permlane32_swap(__float_as_uint(l_reg),__float_as_uint(l_reg),false,false);l_reg=__uint_as_float(rr[0])+__uint_as_float(rr[1]);}
  if(hi==0)wsf[32+r32]=l_reg;asm volatile("s_waitcnt lgkmcnt(0)":::"memory");
  float rli[16];
  #pragma unroll
  for(int r=0;r<16;++r)rli[r]=__builtin_amdgcn_rcpf(wsf[32+crow(r,hi)]);
  bf16*Ow=O+(rowbase+q0+wid*QBLK)*DM+h*D;
  { bf16*stg=(bf16*)(shm+LDS_OST)+wid*2048;
    #pragma unroll
    for(int r=0;r<16;++r){const int orow=crow(r,hi);
      #pragma unroll
      for(int d0=0;d0<2;++d0)stg[orow*64+d0*32+r32]=__float2bfloat16(o[d0][r]*rli[r]);}
    asm volatile("s_waitcnt lgkmcnt(0)":::"memory");
    #pragma unroll
    for(int i=0;i<4;++i){const int row=i*8+(lane>>3),ch=lane&7; const u32x4 v=*(const u32x4*)(stg+row*64+ch*8); ATTN_STORE16(Ow+(long)row*DM+ch*8,v);} }
  asm volatile("s_waitcnt lgkmcnt(0)\n\ts_barrier":::"memory");
  #undef DMA_K
  #undef DMA_V
  #undef CMASK
  #undef START
  #undef RESC
  #undef ROT
}
constexpr int ATTN_LDS_BYTES=LDS_BYTES;
struct AttnTensors { const bf16* Q; const bf16* K; const bf16* V; bf16* O; };
struct AttnUnit { int bh; int qb; };
struct AttnPlan { unsigned char unit[32][12]; unsigned char n[32]; };
constexpr int attn_nominal_cost(int h,int qb){ const int pmax[8]={7,12,22,41,64,64,64,64}; const int past=4*qb<pmax[h]?4*qb:pmax[h]; return 4+past+2; }
constexpr AttnPlan make_attn_plan(){
  AttnPlan p{}; int load[32]={}; bool used[128]={};
  for(int it=0;it<128;++it){ int best=-1,bc=-1; for(int e=0;e<128;++e){ if(used[e])continue; const int c=attn_nominal_cost(e>>4,e&15); if(c>bc){bc=c;best=e;} }
    used[best]=true; int cu=0; for(int c=1;c<32;++c) if(load[c]<load[cu]||(load[c]==load[cu]&&p.n[c]<p.n[cu]))cu=c;
    if(p.n[cu]>=12){ for(int c=0;c<32;++c) if(p.n[c]<12){cu=c;break;} }
    p.unit[cu][p.n[cu]++]=(unsigned char)best; load[cu]+=bc; }
  return p; }
__device__ const AttnPlan g_attn_plan=make_attn_plan();
struct StaticOrder {
  int vcu,G;
  __device__ __forceinline__ explicit StaticOrder(int grid,int vcu_):vcu(vcu_),G(grid){}
  __device__ __forceinline__ bool next(int i,AttnUnit&u)const{
    if(G!=256){ const int id=vcu+i*G; if(id>=BATCH*NHEAD*NQB)return false; u.bh=id>>4; u.qb=id&15; return true; }
    const int c=vcu&31; if(i>=(int)g_attn_plan.n[c])return false; const int e=g_attn_plan.unit[c][i]; u.bh=(vcu>>5)*NHEAD+(e>>4); u.qb=e&15; return true; }
};
template<class Sched,int THRL=8> __device__ __forceinline__ void attn_phase(char*lds,const AttnTensors&T,const float*ksum,const float*nrm,const Sched&S){
  AttnUnit u;
  for(int i=0;S.next(i,u);++i){ attn_unit<THRL>(u.bh/NHEAD,u.bh%NHEAD,u.qb,T.Q,T.K,T.V,T.O,ksum,nrm,lds); }
}
#undef SBAR
#undef WAIT_BAR
}

__device__ __forceinline__ void pooled_phase(Frame& F, const Args& A) {
    const bf16* P = (const bf16*)(A.ws + WS_QKVP) + (size_t)3 * T * 512; bf16* PO = (bf16*)(A.ws + WS_POOLED);
    const int gw = F.vcu * NWAVES + F.wave, NGW = F.G * NWAVES, lane = F.lane, w = 2 << (lane >> 4);
    for (int tk = gw; tk < T / 16; tk += NGW) {
        const int row0 = tk * 16, s0 = row0 & (SEQ - 1);
        v4u rv[31];
#pragma unroll
        for (int i = 0; i < 31; ++i) { const int sidx = s0 - 15 + i; rv[i] = (sidx >= 0) ? *(const v4u*)(P + (size_t)(row0 - 15 + i) * 512 + 8 * lane) : (v4u){0u, 0u, 0u, 0u}; }
#pragma unroll
        for (int i = 0; i < 16; ++i) {
            const int sidx = s0 + i; float acc[8];
#pragma unroll
            for (int e = 0; e < 8; ++e) acc[e] = 0.f;
#pragma unroll
            for (int k = 0; k < 16; ++k) { const bool ok = (k < w) && (sidx - k >= 0); const v4u x = rv[15 + i - k]; const float msk = ok ? 1.0f : 0.0f;
                acc[0] += msk * bflo(x.x); acc[1] += msk * bfhi(x.x); acc[2] += msk * bflo(x.y); acc[3] += msk * bfhi(x.y); acc[4] += msk * bflo(x.z); acc[5] += msk * bfhi(x.z); acc[6] += msk * bflo(x.w); acc[7] += msk * bfhi(x.w); }
            const float inv = 1.0f / (float)min(sidx + 1, w); const v4u x = rv[15 + i];
            v4u o; o.x = pk2(acc[0] * inv - bflo(x.x), acc[1] * inv - bfhi(x.x)); o.y = pk2(acc[2] * inv - bflo(x.y), acc[3] * inv - bfhi(x.y));
            o.z = pk2(acc[4] * inv - bflo(x.z), acc[5] * inv - bfhi(x.z)); o.w = pk2(acc[6] * inv - bflo(x.w), acc[7] * inv - bfhi(x.w));
            *(v4u*)(PO + (size_t)(row0 + i) * 512 + 8 * lane) = o;
        }
    }
}

typedef float f32x2 __attribute__((ext_vector_type(2)));
typedef int v4i __attribute__((ext_vector_type(4)));
__device__ __forceinline__ void h2q_rows4(const Args& A, int t0, int lane) {
    const float* modf = (const float*)(A.ws + WS_MODF); const float* ss2 = (const float*)(A.ws + WS_SS2); const float* g2 = A.in[12];
    const int b = t0 / SEQ;
    f32x4 xv[4][4];
#pragma unroll
    for (int u = 0; u < 4; ++u)
#pragma unroll
        for (int q = 0; q < 4; ++q) xv[u][q] = *(const f32x4*)(A.out + (size_t)(t0 + u) * D + 16 * lane + 4 * q);
    f32x4 G[4], S[4];
#pragma unroll
    for (int q = 0; q < 4; ++q) { const int c = 16 * lane + 4 * q; G[q] = *(const f32x4*)(g2 + c) * (*(const f32x4*)(modf + (size_t)b * 6144 + 4096 + c) + 1.0f); S[q] = *(const f32x4*)(modf + (size_t)b * 6144 + 3072 + c); }
#pragma unroll
    for (int u = 0; u < 4; ++u) {
        const f32x4* sp = (const f32x4*)(ss2 + (size_t)(t0 + u) * 16); const f32x4 s4 = (sp[0] + sp[1]) + (sp[2] + sp[3]);
        const float rs = 1.0f / sqrtf(((s4[0] + s4[1]) + (s4[2] + s4[3])) * (1.0f / D) + RMS_EPS);
        float h2[16]; float am = 0.f;
#pragma unroll
        for (int q = 0; q < 4; ++q)
#pragma unroll
            for (int e = 0; e < 4; ++e) { const float h = xv[u][q][e] * rs * G[q][e] + S[q][e]; h2[4 * q + e] = h; am = fmaxf(am, fabsf(h)); }
        am = fmaxf(am, __shfl_xor(am, 1)); am = fmaxf(am, __shfl_xor(am, 2)); am = fmaxf(am, __shfl_xor(am, 4));
        const float hs = (am > 0.f) ? am * (1.0f / 127.0f) : 1.0f, hinv = 1.0f / hs;
        v4u o;
#pragma unroll
        for (int q = 0; q < 4; ++q) { const int q0 = (int)rintf(h2[4 * q] * hinv), q1 = (int)rintf(h2[4 * q + 1] * hinv), q2 = (int)rintf(h2[4 * q + 2] * hinv), q3 = (int)rintf(h2[4 * q + 3] * hinv);
            o[q] = (unsigned)(q0 & 255) | ((unsigned)(q1 & 255) << 8) | ((unsigned)(q2 & 255) << 16) | ((unsigned)q3 << 24); }
        *(v4u*)(A.ws + WS_H2Q + (size_t)(t0 + u) * D + 16 * lane) = o;
        if ((lane & 7) == 0) ((float*)(A.ws + WS_HS))[(size_t)(t0 + u) * 8 + (lane >> 3)] = hs;
    }
}

namespace rt {
typedef float f32x16 __attribute__((ext_vector_type(16)));
typedef short bf16x8 __attribute__((ext_vector_type(8)));
__device__ __forceinline__ void ce(float& hi, float& lo) { const float a = fmaxf(hi, lo), b = fminf(hi, lo); hi = a; lo = b; }
template <int N> __device__ __forceinline__ void sort_desc(float (&v)[N]) {
#pragma unroll
    for (int k = 2; k <= N; k <<= 1)
#pragma unroll
        for (int j = k >> 1; j > 0; j >>= 1)
#pragma unroll
            for (int i = 0; i < N; ++i) { const int l = i ^ j; if (l > i) { if ((i & k) == 0) ce(v[i], v[l]); else ce(v[l], v[i]); } }
}
__device__ __forceinline__ void sort16_desc(float (&v)[16]) {
    ce(v[0], v[13]); ce(v[1], v[12]); ce(v[2], v[15]); ce(v[3], v[14]); ce(v[4], v[8]); ce(v[5], v[6]); ce(v[7], v[11]); ce(v[9], v[10]);
    ce(v[0], v[5]); ce(v[1], v[7]); ce(v[2], v[9]); ce(v[3], v[4]); ce(v[6], v[13]); ce(v[8], v[14]); ce(v[10], v[15]); ce(v[11], v[12]);
    ce(v[0], v[1]); ce(v[2], v[3]); ce(v[4], v[5]); ce(v[6], v[8]); ce(v[7], v[9]); ce(v[10], v[11]); ce(v[12], v[13]); ce(v[14], v[15]);
    ce(v[0], v[2]); ce(v[1], v[3]); ce(v[4], v[10]); ce(v[5], v[11]); ce(v[6], v[7]); ce(v[8], v[9]); ce(v[12], v[14]); ce(v[13], v[15]);
    ce(v[1], v[2]); ce(v[3], v[12]); ce(v[4], v[6]); ce(v[5], v[7]); ce(v[8], v[10]); ce(v[9], v[11]); ce(v[13], v[14]);
    ce(v[1], v[4]); ce(v[2], v[6]); ce(v[5], v[8]); ce(v[7], v[10]); ce(v[9], v[13]); ce(v[11], v[14]);
    ce(v[2], v[4]); ce(v[3], v[6]); ce(v[9], v[12]); ce(v[11], v[13]);
    ce(v[3], v[5]); ce(v[6], v[8]); ce(v[7], v[9]); ce(v[10], v[12]);
    ce(v[3], v[4]); ce(v[5], v[6]); ce(v[7], v[8]); ce(v[9], v[10]); ce(v[11], v[12]);
    ce(v[6], v[7]); ce(v[8], v[9]);
}
template <int N> __device__ __forceinline__ void bitonic_merge_desc(float (&v)[N]) {
#pragma unroll
    for (int j = N >> 1; j > 0; j >>= 1)
#pragma unroll
        for (int i = 0; i < N; ++i) { const int l = i ^ j; if (l > i) ce(v[i], v[l]); }
}
__device__ __forceinline__ void merge_top16(float (&a)[16], const float (&b)[16]) {
#pragma unroll
    for (int i = 0; i < 16; ++i) a[i] = fmaxf(a[i], b[15 - i]);
    bitonic_merge_desc<16>(a);
}
template <bool SORT> __device__ __forceinline__ void pair_merge(float (&a)[16], bool hi) {
    float w[16];
#pragma unroll
    for (int i = 0; i < 16; ++i) w[i] = hi ? a[15 - i] : a[i];
#pragma unroll
    for (int i = 0; i < 16; ++i) { const auto rr = __builtin_amdgcn_permlane32_swap(__float_as_uint(w[i]), __float_as_uint(w[i]), false, false); a[i] = fmaxf(__uint_as_float(rr[0]), __uint_as_float(rr[1])); }
    if (SORT) bitonic_merge_desc<16>(a);
}
__device__ __forceinline__ void fold_tile(const f32x16& acc, int kt, int hi, float (&out)[16]) {
    float g[16];
#pragma unroll
    for (int r = 0; r < 16; ++r) { const unsigned key = (unsigned)(32 * kt + (r & 3) + 8 * (r >> 2)); g[r] = __uint_as_float((__float_as_uint(acc[r]) & ~127u) | key | ((unsigned)hi << 2)); }
    sort16_desc(g);
    if (kt == 0) {
#pragma unroll
        for (int r = 0; r < 16; ++r) out[r] = g[r];
    } else merge_top16(out, g);
}
}
__device__ __forceinline__ void router_phase(Frame& F, const Args& A) {
    using namespace rt;
    const bf16* QP = (const bf16*)(A.ws + WS_GAB); const bf16* SK = (const bf16*)(A.ws + WS_SUBK);
    unsigned short* IDX = (unsigned short*)(A.ws + WS_POOLED); float* GATE = (float*)(A.ws + WS_POOLED + 16 * MiB);
    const int lane = F.lane, n32 = lane & 31, hi = lane >> 5, gw = F.vcu * NWAVES + F.wave, NGW = F.G * NWAVES;
    __syncthreads();
    for (int i = F.tid; i < 2 * 128 * 16; i += NTHREADS) { const int r = i >> 4, ch = i & 15; *(LAS v4u*)(F.lds + r * 272 + ch * 16) = *(const v4u*)(SK + (size_t)r * 128 + ch * 8); }
    __syncthreads();
    LAS unsigned char* scr = F.lds + 73728 + F.wave * 1024;
    const LAS unsigned char* afrag = F.lds + n32 * 272 + hi * 16;
    bf16x8 qa[8], qb[8];
#define RT_QLOAD(task_, p_, q_) do { const int tq_ = (task_) * 4 + (n32 >> 3); const bf16* qr_ = QP + (size_t)tq_ * PQW + (n32 & 7) * 256 + (p_) * 128 + 8 * hi; \
        _Pragma("unroll") for (int i = 0; i < 8; ++i) q_[i] = __builtin_nontemporal_load((const bf16x8*)(qr_ + 16 * i)); } while (0)
#define RT_HALF(p_, q_, out_) do { _Pragma("unroll") for (int kt = 0; kt < 4; ++kt) { f32x16 acc = f32x16{}; \
        _Pragma("unroll") for (int ks = 0; ks < 8; ++ks) { const bf16x8 kf = *(const LAS bf16x8*)(afrag + ((p_) * 128 + 32 * kt) * 272 + 32 * ks); acc = __builtin_amdgcn_mfma_f32_32x32x16_bf16(kf, q_[ks], acc, 0, 0, 0); } \
        fold_tile(acc, kt, hi, out_); } pair_merge<true>(out_, hi != 0); } while (0)
    if (gw < T * PHEADS / 32) RT_QLOAD(gw, 0, qa);
#ifdef TABLES_IN_ROUTER
    int tr0 = gw; const bool late_trip = F.wave >= 4;
#define RT_TABLE_TRIP(cond_) do { if (cond_) { asm volatile("" ::: "memory"); if (tr0 < 2 * PEXP) { p0_table_trip(A, tr0, NGW, lane); tr0 += 4 * NGW; } asm volatile("" ::: "memory"); h2q_rows4(A, task * 4, lane); asm volatile("" ::: "memory"); } } while (0)
#else
#define RT_TABLE_TRIP(cond_) do { } while (0)
#endif
    for (int task = gw; task < T * PHEADS / 32; task += NGW) {
        const int t = task * 4 + (n32 >> 3), h = n32 & 7;
        float la[16], lb[16];
        RT_TABLE_TRIP(!late_trip);
        RT_QLOAD(task, 1, qb);
        RT_HALF(0, qa, la);
        { const int nxt = task + NGW; if (nxt < T * PHEADS / 32) RT_QLOAD(nxt, 0, qa); }
        RT_HALF(1, qb, lb);
        { unsigned w[4];
#pragma unroll
          for (int q = 0; q < 4; ++q) {
              const unsigned i0 = __float_as_uint(hi ? lb[4 * q] : la[4 * q]) & 127u, i1 = __float_as_uint(hi ? lb[4 * q + 1] : la[4 * q + 1]) & 127u, i2 = __float_as_uint(hi ? lb[4 * q + 2] : la[4 * q + 2]) & 127u, i3 = __float_as_uint(hi ? lb[4 * q + 3] : la[4 * q + 3]) & 127u;
              w[q] = i0 | (i1 << 8) | (i2 << 16) | (i3 << 24); }
          *(LAS v4u*)(scr + n32 * 32 + hi * 16) = (v4u){w[0], w[1], w[2], w[3]}; }
        float x[16], y[16];
#pragma unroll
        for (int i = 0; i < 16; ++i) { const float av = __uint_as_float(__float_as_uint(la[i]) & ~127u), bv = __uint_as_float(__float_as_uint(lb[i]) & ~127u); x[i] = hi ? bv : av; y[i] = hi ? av : bv; }
        float c0[16], c1[16];
        {
            const unsigned hb = (unsigned)hi << 8;
#define RT_CAND(i, j) __uint_as_float(((__float_as_uint(x[i] + y[j]) & ~511u) | (unsigned)((i) * 16 + (j))) | hb)
#define RT_DIAG(i) (hi ? -3.0e38f : RT_CAND(i, i))
            c0[0] = RT_DIAG(0);
#pragma unroll
            for (int j = 1; j < 16; ++j) c0[j] = RT_CAND(0, j);
            c1[0] = RT_DIAG(1);
#pragma unroll
            for (int j = 2; j < 8; ++j) c1[j - 1] = RT_CAND(1, j);
            c1[7] = RT_DIAG(2); c1[8] = RT_CAND(2, 3); c1[9] = RT_CAND(2, 4); c1[10] = RT_DIAG(3);
#pragma unroll
            for (int k = 11; k < 16; ++k) c1[k] = -3.0e38f;
#undef RT_CAND
#undef RT_DIAG
        }
        sort16_desc(c0); sort16_desc(c1); merge_top16(c0, c1);
        pair_merge<false>(c0, hi != 0);
        float mx = c0[0];
#pragma unroll
        for (int i = 1; i < 16; ++i) mx = fmaxf(mx, c0[i]);
        float ex[16], sm = 0.f;
#pragma unroll
        for (int i = 0; i < 16; ++i) { ex[i] = __expf(__uint_as_float(__float_as_uint(c0[i]) & ~511u) - mx); sm += ex[i]; }
        const float inv = 1.0f / sm;
        asm volatile("s_waitcnt lgkmcnt(0)" ::: "memory");
        int eo[8]; float go[8];
#pragma unroll
        for (int k = 0; k < 8; ++k) { const float wv = hi ? c0[8 + k] : c0[k]; go[k] = (hi ? ex[8 + k] : ex[k]) * inv;
            const unsigned bits = __float_as_uint(wv), fromhi = (bits >> 8) & 1u, xi = (bits >> 4) & 15u, yj = bits & 15u;
            const unsigned ar = fromhi ? yj : xi, br = fromhi ? xi : yj;
            const unsigned e1 = scr[n32 * 32 + ar], e2 = scr[n32 * 32 + 16 + br];
            eo[k] = (int)(e1 * 128u + e2); }
        unsigned short* ip = IDX + (size_t)t * PSEL + h * PTOP + 8 * hi; float* gp = GATE + (size_t)t * PSEL + h * PTOP + 8 * hi;
        *(v4u*)ip = (v4u){(unsigned)eo[0] | ((unsigned)eo[1] << 16), (unsigned)eo[2] | ((unsigned)eo[3] << 16), (unsigned)eo[4] | ((unsigned)eo[5] << 16), (unsigned)eo[6] | ((unsigned)eo[7] << 16)};
        *(f32x4*)gp = (f32x4){go[0], go[1], go[2], go[3]}; *(f32x4*)(gp + 4) = (f32x4){go[4], go[5], go[6], go[7]};
        asm volatile("s_waitcnt lgkmcnt(0)" ::: "memory");
        RT_TABLE_TRIP(late_trip);
    }
#ifdef TABLES_IN_ROUTER
    while (tr0 < 2 * PEXP) { p0_table_trip(A, tr0, NGW, lane); tr0 += 4 * NGW; }
#endif
#undef RT_TABLE_TRIP
#undef RT_QLOAD
#undef RT_HALF
    __syncthreads();
}

__device__ __forceinline__ float gelu_tanh(float x) { const float u = 0.7978845608028654f * (x + 0.044715f * x * x * x); return x / (1.0f + __expf(-2.0f * u)); }
__device__ __forceinline__ void peer_sliced_phase(Frame& F, const Args& A) {
    const int lane = F.lane, c8 = lane & 7, g8 = lane >> 3, gw = F.vcu * NWAVES + F.wave, NGW = F.G * NWAVES;
    const float* modf = (const float*)(A.ws + WS_MODF);
    const unsigned char* U8 = A.ws + WS_U; const unsigned char* V8 = A.ws + WS_V;
    const f32x2* SUV = (const f32x2*)(A.ws + WS_U + 16 * MiB);
    const unsigned short* IDX = (const unsigned short*)(A.ws + WS_POOLED); const float* GATE = (const float*)(A.ws + WS_POOLED + 16 * MiB);
    const float* gf = A.in[17];
    LAS float* AL = (LAS float*)(F.lds + F.wave * 17664);
    LAS float* SSQ = AL + 2048;
    LAS float* SAV = AL + 3072;
    LAS float* RS2 = AL + 3088;
    LAS float* GS = AL + 3104;
    LAS unsigned short* IDL = (LAS unsigned short*)(AL + 3360);
    for (int tb = gw * 16; tb < T; tb += NGW * 16) {
        for (int i = lane; i < 2048; i += 64) AL[i] = 0.f;
        for (int i = lane; i < 1024; i += 64) SSQ[i] = 0.f;
#pragma unroll
        for (int i = 0; i < 16; ++i) *(LAS unsigned*)(IDL + i * 128 + 2 * lane) = *(const unsigned*)(IDX + (size_t)(tb + i) * PSEL + 2 * lane);
        LDS_WAIT();
        {
            v4i W0[16], W1[16], H0, H1, H; float hs0, hs1, hs;
            const unsigned char* H2Q = A.ws + WS_H2Q; const float* HS = (const float*)(A.ws + WS_HS);
#define PU_X(k, Hx, hx) do { const int k_ = (k) < 128 ? (k) : 127; const int s_ = k_ >> 4, t_ = tb + (k_ & 15); Hx = *(const v4i*)(H2Q + (size_t)t_ * D + 128 * s_ + 16 * c8); hx = HS[(size_t)t_ * 8 + s_]; } while (0)
#define PU_B(k, W) do { const int k_ = (k) < 128 ? (k) : 127; const int s_ = k_ >> 4; const unsigned base_ = ((unsigned)s_ << 21) + 16u * (unsigned)c8; v4u I[2]; I[0] = *(const LAS v4u*)(IDL + (k_ & 15) * 128 + 16 * g8); I[1] = *(const LAS v4u*)(IDL + (k_ & 15) * 128 + 16 * g8 + 8); \
            _Pragma("unroll") for (int j = 0; j < 16; ++j) W[j] = *(const v4i*)(U8 + (base_ + (((I[j >> 3][(j >> 1) & 3] >> (16 * (j & 1))) & 0xffffu) << 7))); \
            } while (0)
#define PU_Q(k, Hx, hx) do { H = Hx; hs = hx; } while (0)
#define PU_C(k, W) do { int part[16]; \
            _Pragma("unroll") for (int j = 0; j < 16; ++j) part[j] = __builtin_amdgcn_sdot4(W[j].x, H.x, __builtin_amdgcn_sdot4(W[j].y, H.y, __builtin_amdgcn_sdot4(W[j].z, H.z, __builtin_amdgcn_sdot4(W[j].w, H.w, 0, false), false), false), false); \
            _Pragma("unroll") for (int step = 4; step >= 1; step >>= 1) { const bool up = (lane & step) != 0; \
                _Pragma("unroll") for (int i = 0; i < 2 * step; ++i) { const int send = up ? part[i] : part[i + 2 * step], keep = up ? part[i + 2 * step] : part[i]; part[i] = keep + __shfl_xor(send, step); } } \
            LAS f32x2* ap_ = (LAS f32x2*)(AL + ((k) & 15) * 128 + 2 * lane); f32x2 a_ = *ap_; a_.x += hs * (float)part[0]; a_.y += hs * (float)part[1]; *ap_ = a_; } while (0)
            PU_X(0, H0, hs0); PU_X(1, H1, hs1); PU_B(0, W0);
#pragma unroll 1
            for (int k = 0; k < 128; k += 2) {
                PU_Q(k, H0, hs0); PU_B(k + 1, W1); PU_X(k + 2, H0, hs0);
                PU_C(k, W0);
                PU_Q(k + 1, H1, hs1); PU_B(k + 2, W0); PU_X(k + 3, H1, hs1);
                PU_C(k + 1, W1);
            }
#undef PU_X
#undef PU_B
#undef PU_Q
#undef PU_C
        }
        LDS_WAIT();
#pragma unroll 4
        for (int i = 0; i < 16; ++i) {
            const int t = tb + i; const unsigned e01 = *(const LAS unsigned*)(IDL + i * 128 + 2 * lane); const int e0 = (int)(e01 & 0xffffu), e1 = (int)(e01 >> 16);
            const f32x2 gt = *(const f32x2*)(GATE + (size_t)t * PSEL + 2 * lane); const f32x2 a = *(LAS f32x2*)(AL + i * 128 + 2 * lane);
            const f32x2 s0 = SUV[e0], s1 = SUV[e1];
            f32x2 av; av.x = gelu_tanh(a.x * s0.x) * gt.x * s0.y; av.y = gelu_tanh(a.y * s1.x) * gt.y * s1.y;
            *(LAS f32x2*)(AL + i * 128 + 2 * lane) = av;
            const float sm = wave_sum(av.x + av.y); if (lane == 0) SAV[i] = 128.0f * sm;
        }
        LDS_WAIT();
        {
            v4u W0[16], W1[16]; f32x2 X0, X1, gt2v = (f32x2){0.f, 0.f};
            const int b = tb / SEQ;
#define PV_B(k, W, X) do { const int k_ = (k) < 128 ? (k) : 127; const int s_ = k_ >> 4, t_ = tb + (k_ & 15); const unsigned base_ = ((unsigned)s_ << 21) + 16u * (unsigned)c8; v4u I[2]; I[0] = *(const LAS v4u*)(IDL + (k_ & 15) * 128 + 16 * g8); I[1] = *(const LAS v4u*)(IDL + (k_ & 15) * 128 + 16 * g8 + 8); \
            _Pragma("unroll") for (int j = 0; j < 16; ++j) W[j] = *(const v4u*)(V8 + (base_ + (((I[j >> 3][(j >> 1) & 3] >> (16 * (j & 1))) & 0xffffu) << 7))); \
            X = __builtin_nontemporal_load((const f32x2*)(A.out + (size_t)t_ * D + 128 * s_ + 16 * c8 + 2 * g8)); } while (0)
#define PV_C(k, W, X) do { const int s_ = (k) >> 4, i_ = (k) & 15; \
            if (i_ == 0) gt2v = *(const f32x2*)(modf + (size_t)b * 6144 + 5120 + 128 * s_ + 16 * c8 + 2 * g8); \
            f32x2 acc[8]; _Pragma("unroll") for (int q = 0; q < 8; ++q) acc[q] = (f32x2){0.f, 0.f}; \
            const LAS f32x4* avp_ = (const LAS f32x4*)(AL + i_ * 128 + 16 * g8); \
            _Pragma("unroll") for (int q4 = 0; q4 < 4; ++q4) { const f32x4 a4 = avp_[q4]; \
                _Pragma("unroll") for (int e = 0; e < 4; ++e) { const float a = a4[e]; const v4u w = W[4 * q4 + e]; \
                    acc[0] += (f32x2){(float)(w.x & 255u), (float)((w.x >> 8) & 255u)} * a; acc[1] += (f32x2){(float)((w.x >> 16) & 255u), (float)(w.x >> 24)} * a; \
                    acc[2] += (f32x2){(float)(w.y & 255u), (float)((w.y >> 8) & 255u)} * a; acc[3] += (f32x2){(float)((w.y >> 16) & 255u), (float)(w.y >> 24)} * a; \
                    acc[4] += (f32x2){(float)(w.z & 255u), (float)((w.z >> 8) & 255u)} * a; acc[5] += (f32x2){(float)((w.z >> 16) & 255u), (float)(w.z >> 24)} * a; \
                    acc[6] += (f32x2){(float)(w.w & 255u), (float)((w.w >> 8) & 255u)} * a; acc[7] += (f32x2){(float)((w.w >> 16) & 255u), (float)(w.w >> 24)} * a; } } \
            float pc[16]; _Pragma("unroll") for (int q = 0; q < 8; ++q) { pc[2 * q] = acc[q].x; pc[2 * q + 1] = acc[q].y; } \
            _Pragma("unroll") for (int step = 4; step >= 1; step >>= 1) { const bool up = (g8 & step) != 0; \
                _Pragma("unroll") for (int i = 0; i < 2 * step; ++i) { const float send = up ? pc[i] : pc[i + 2 * step], keep = up ? pc[i + 2 * step] : pc[i]; pc[i] = keep + __shfl_xor(send, 8 * step); } } \
            const float sav_ = SAV[i_]; f32x2 x2_; x2_.x = X.x + gt2v.x * (pc[0] - sav_); x2_.y = X.y + gt2v.y * (pc[1] - sav_); \
            *(f32x2*)(A.out + (size_t)(tb + i_) * D + 128 * s_ + 16 * c8 + 2 * g8) = x2_; \
            SSQ[i_ * 64 + lane] += x2_.x * x2_.x + x2_.y * x2_.y; } while (0)
            PV_B(0, W0, X0);
#pragma unroll 1
            for (int k = 0; k < 128; k += 2) {
                PV_B(k + 1, W1, X1);
                PV_C(k, W0, X0);
                PV_B(k + 2, W0, X0);
                PV_C(k + 1, W1, X1);
            }
#undef PV_B
#undef PV_C
        }
        VM_WAIT(); LDS_WAIT();
#pragma unroll 2
        for (int i = 0; i < 16; ++i) {
            float* xr = A.out + (size_t)(tb + i) * D + 16 * lane;
            f32x4 v[4];
#pragma unroll
            for (int q = 0; q < 4; ++q) v[q] = __builtin_nontemporal_load((const f32x4*)(xr + 4 * q));
            const float rs = 1.0f / sqrtf(wave_sum(SSQ[i * 64 + lane]) * (1.0f / D) + RMS_EPS);
#pragma unroll
            for (int q = 0; q < 4; ++q) *(f32x4*)(xr + 4 * q) = v[q] * rs * *(const f32x4*)(gf + 16 * lane + 4 * q);
        }
        LDS_WAIT();
    }
}

#ifndef PHASE_ONLY
#define PHASE_ONLY -1
#endif
#ifndef PHASE_SKIP
#define PHASE_SKIP -2
#endif
#define PH(n) ((PHASE_ONLY < 0 || PHASE_ONLY == (n)) && PHASE_SKIP != (n))
#ifndef PROBE_DOUBLE
#define PROBE_DOUBLE -1
#endif
#define REPS(n) for (int rep_ = 0; rep_ < ((PROBE_DOUBLE == (n)) ? 2 : 1); ++rep_)
__global__ void __launch_bounds__(NTHREADS, 2) fwd_megakernel(Args A) {
    extern __shared__ __attribute__((aligned(16))) unsigned char lds[];
    Frame F;
    F.lds = (LAS unsigned char*)lds;
    F.MISC = (volatile LAS unsigned*)(F.lds + MISC_OFF);
    F.tid = threadIdx.x; F.lane = F.tid & 63; F.wave = __builtin_amdgcn_readfirstlane(F.tid >> 6);
    F.G = gridDim.x; { const int bx = blockIdx.x; F.vcu = (F.G % 8 == 0) ? (bx % 8) * (F.G / 8) + bx / 8 : bx; }
    F.ctl = (gu32*)(A.ws + WS_CTL);
    for (int u = F.tid; u < (LDS_BYTES - LDSCTL_OFF) / 4; u += NTHREADS) ((LAS unsigned*)(F.lds + LDSCTL_OFF))[u] = 0u;
    __syncthreads();
    XcdBarrier bar = xcd_barrier_post((unsigned*)(F.ctl + CW_BAR), F.MISC + 8);
#define GRID_BAR() do { xcd_barrier(bar); int t_ = threadIdx.x; asm volatile("" : "+v"(t_)); F.tid = t_; F.lane = t_ & 63; F.wave = __builtin_amdgcn_readfirstlane(t_ >> 6); } while (0)
    unsigned char* ws = A.ws;

    REPS(0) if (PH(0)) { p0a_mod(F, A); p0b_prologue<0>(F, A); }
    GRID_BAR();
    REPS(1) if (PH(1)) p0b_prologue<1>(F, A);
    GRID_BAR();
    REPS(2) if (PH(2)) {
        pg8::Gemm g{(const bf16*)(ws + WS_XG), nullptr, (const bf16*)(ws + WS_WIN), nullptr, D, D, D};
        pg8::StaticOrder S; S.init(T, INW, F.G, (int)blockIdx.x);
        pg8::EpiIn E{(bf16*)(ws + WS_QKVP), (bf16*)(ws + WS_GAB), (const float*)(ws + WS_RSTD1), (const float*)(ws + WS_BIAS1P), (float*)(ws + WS_KSUM), (unsigned*)(ws + WS_CTL) + CW_NRM};
        pg8::gemm_phase<pg8::EpiIn, pg8::StaticOrder, true, true>(F.lds + RING_OFF, g, S, E);
    }
    GRID_BAR();
    REPS(3) if (PH(3)) {
        const attn_body::AttnTensors AT{(const attn_body::bf16*)(ws + WS_QKVP), (const attn_body::bf16*)(ws + WS_QKVP) + (size_t)T * 512, (const attn_body::bf16*)(ws + WS_QKVP) + (size_t)2 * T * 512, (PROBE_DOUBLE == 3 && rep_ == 0) ? (attn_body::bf16*)(ws + WS_XG) : (attn_body::bf16*)(ws + WS_QKVP)};
        const attn_body::StaticOrder S((int)F.G, F.vcu);
        attn_body::attn_phase<attn_body::StaticOrder>((char*)lds + RING_OFF, AT, (const float*)(ws + WS_KSUM), (const float*)((const unsigned*)(ws + WS_CTL) + CW_NRM), S);
    }
    REPS(4) if (PH(4)) pooled_phase(F, A);
    GRID_BAR();
    REPS(5) if (PH(5)) {
        pg8::Gemm g{(const bf16*)(ws + WS_QKVP), (const bf16*)(ws + WS_POOLED), (const bf16*)(ws + WS_WA), (const bf16*)(ws + WS_WP), AW, AW, AW};
        pg8::DualOrder S; S.init(T, D, F.G, (int)blockIdx.x);
        pg8::EpiUp E{(bf16*)(ws + WS_XG), (const bf16*)(ws + WS_GAB), (const float*)(ws + WS_BPRIME)};
        pg8::gemm_phase<pg8::EpiUp, pg8::DualOrder, true, true>(F.lds + RING_OFF, g, S, E);
    }
    GRID_BAR();
    REPS(6) if (PH(6)) {
        pg8::Gemm g{(const bf16*)(ws + WS_XG), nullptr, (const bf16*)(ws + WS_WOUT), nullptr, D, D, D};
        pg8::StaticOrder S; S.init(T, D, F.G, (int)blockIdx.x);
        pg8::EpiOut E{A.in[0], A.out, (bf16*)(ws + WS_QKVP), (const float*)(ws + WS_MODF), A.in[12], (float*)(ws + WS_SS2)};
        pg8::gemm_phase<pg8::EpiOut, pg8::StaticOrder, true, true>(F.lds + RING_OFF, g, S, E);
    }
    GRID_BAR();
    REPS(7) if (PH(7)) {
        pg8::Gemm g{(const bf16*)(ws + WS_QKVP), nullptr, (const bf16*)(ws + WS_WQ), nullptr, D, D, D};
        pg8::StaticOrder S; S.init(T, PQW, F.G, (int)blockIdx.x);
        pg8::EpiPq E{(bf16*)(ws + WS_GAB), (const float*)(ws + WS_SS2), (const float*)(ws + WS_BIAS2P)};
        pg8::gemm_phase<pg8::EpiPq, pg8::StaticOrder, true, true>(F.lds + RING_OFF, g, S, E);
    }
    GRID_BAR();
    REPS(8) if (PH(8)) router_phase(F, A);
    GRID_BAR();
    if (PH(9)) peer_sliced_phase(F, A);
}

extern "C" void kernel_launch(void* const* d_in, const int* in_sizes, int n_in, void* d_out, int out_size, void* d_ws, size_t ws_size, hipStream_t stream) {
    static int grid = 0;
    if (grid == 0) {
        if (n_in != 18 || in_sizes[0] != T * D || out_size != T * D || ws_size < WS_END) { fprintf(stderr, "kernel_launch: unexpected shapes (n_in %d, in0 %d, out %d, ws %zu); nothing launched\n", n_in, n_in > 0 ? in_sizes[0] : -1, out_size, ws_size); grid = -1; return; }
        int dev = 0, cus = 0, per_cu = 0;
        if (hipGetDevice(&dev) != hipSuccess || hipDeviceGetAttribute(&cus, hipDeviceAttributeMultiprocessorCount, dev) != hipSuccess) { grid = -1; return; }
        if (hipFuncSetAttribute((const void*)fwd_megakernel, hipFuncAttributeMaxDynamicSharedMemorySize, LDS_BYTES) != hipSuccess) { fprintf(stderr, "kernel_launch: hipFuncSetAttribute failed\n"); grid = -1; return; }
        if (hipOccupancyMaxActiveBlocksPerMultiprocessor(&per_cu, (const void*)fwd_megakernel, NTHREADS, LDS_BYTES) != hipSuccess || per_cu < 1) { fprintf(stderr, "kernel_launch: occupancy query reports %d workgroups per CU\n", per_cu); per_cu = 1; }
        (void)hipGetLastError();
        grid = cus;
    }
    if (grid < 0) return;
    if (hipMemsetAsync((char*)d_ws + WS_CTL, 0, CTL_ZERO_BYTES, stream) != hipSuccess) { fprintf(stderr, "kernel_launch: hipMemsetAsync failed\n"); return; }
    Args a{};
    for (int i = 0; i < 18; ++i) a.in[i] = (const float*)d_in[i];
    a.out = (float*)d_out; a.ws = (unsigned char*)d_ws;
    void* kargs[] = {&a};
    hipError_t e = hipLaunchCooperativeKernel((const void*)fwd_megakernel, dim3(grid), dim3(NTHREADS), kargs, LDS_BYTES, stream);
    if (e != hipSuccess) fprintf(stderr, "kernel_launch: cooperative launch failed: %s (grid %d)\n", hipGetErrorString(e), grid);
}
```

```cpp
#define TABLES_IN_ROUTER 1
#include <hip/hip_runtime.h>
#include <hip/hip_bf16.h>
#include <cstdio>
#include <cstdint>
#include <cmath>

constexpr int NB = 8, SEQ = 4096, T = NB * SEQ, D = 1024;
constexpr int AW = 512, PW = 512, INW = 4096;
constexpr int NH = 8, HD = 64, MBLK = 256, NBLK = SEQ / MBLK;
constexpr int PQW = 2048, PEXP = 16384, PTOP = 16, PHEADS = 8, PSEL = PHEADS * PTOP;
constexpr float RMS_EPS = 1e-6f;
constexpr float LOG2E = 1.4426950408889634f;
constexpr float QSCALE = 0.125f * LOG2E;
constexpr int NWAVES = 8, NTHREADS = 512;

namespace pg8 {
#define PG8_LAS __attribute__((address_space(3)))
typedef unsigned short bf16_t;
typedef short bf16x8 __attribute__((ext_vector_type(8)));
typedef float f32x4 __attribute__((ext_vector_type(4)));
typedef unsigned u32x4 __attribute__((ext_vector_type(4)));
constexpr int BM = 256, BK = 64, HALF = 128, HTB = HALF * BK * 2  , STAGE_BYTES = 8 * HTB, NXCD = 8, WGM = 8;

__host__ __device__ __forceinline__ int lds_byte(int r, int c) { const int st = (r >> 4) * 2 + (c >> 5), rr = r & 15, cc = c & 31, ob = rr * 64 + cc * 2; return st * 1024 + (ob ^ (((ob >> 9) & 1) << 5)); }
__host__ __device__ __forceinline__ void stage_rc(int b, int& R, int& C) { const int st = b / 1024, sb = b % 1024, swz = sb ^ (((sb >> 9) & 1) << 5); R = (st >> 1) * 16 + swz / 64; C = (st & 1) * 32 + (swz % 64) / 2; }
__host__ __device__ __forceinline__ int perm32(int rho) { const int n = rho >> 4, i = rho & 15; return 8 * (i >> 2) + 4 * n + (i & 3); }

struct Unit { int pm, pn, part; };
struct Gemm {
    const bf16_t* A0; const bf16_t* A1; const bf16_t* B0; const bf16_t* B1; int lda, ldb, K;
    __device__ __forceinline__ const char* a_ptr(const Unit& u) const { return (const char*)(u.part ? A1 : A0) + (size_t)u.pm * BM * lda * 2; }
    __device__ __forceinline__ const char* b_ptr(const Unit& u) const { return (const char*)(u.part ? B1 : B0) + (size_t)u.pn * BM * ldb * 2; }
};

struct StaticOrder {
    int nM, nN, nwg, G, c;
    __host__ __device__ void init(int M, int N, int G_, int c_) { nM = M / BM; nN = N / BM; nwg = nM * nN; G = G_; c = c_; }
    __host__ __device__ bool tile(long L, Unit& u) const {
        if (L >= nwg) return false;
        int wgid = (int)L; { const int q = nwg / NXCD, r = nwg % NXCD, xcd = wgid % NXCD, off = wgid / NXCD; wgid = (xcd < r ? xcd * (q + 1) : r * (q + 1) + (xcd - r) * q) + off; }
        const int nig = WGM * nN, gid = wgid / nig, fm = gid * WGM, gsz = (nM - fm) < WGM ? (nM - fm) : WGM;
        u.pm = fm + ((wgid % nig) % gsz); u.pn = (wgid % nig) / gsz; u.part = 0; return true;
    }
    __host__ __device__ bool next(int i, Unit& u) const { return tile((long)i * G + c, u); }
    __device__ __forceinline__ void a_ready(const Unit&) const {}
    __device__ __forceinline__ void done(const Unit&) const {}
};
struct DualOrder {
    StaticOrder so;
    __host__ __device__ void init(int M, int N, int G_, int c_) { so.init(M, N, G_, c_); }
    __host__ __device__ bool next(int i, Unit& u) const { if (!so.tile((long)(i >> 1) * so.G + so.c, u)) return false; u.part = i & 1; return true; }
    __device__ __forceinline__ void a_ready(const Unit&) const {}
    __device__ __forceinline__ void done(const Unit&) const {}
};

__device__ __forceinline__ unsigned cvt_pk_bf16(float lo, float hi) { unsigned r; asm volatile("v_cvt_pk_bf16_f32 %0, %1, %2" : "=v"(r) : "v"(lo), "v"(hi)); return r; }
__device__ __forceinline__ float bf_lo(unsigned w) { return __uint_as_float(w << 16); }
__device__ __forceinline__ float bf_hi(unsigned w) { return __uint_as_float(w & 0xffff0000u); }
__device__ __forceinline__ float sigmoidf_(float x) { return __builtin_amdgcn_rcpf(1.0f + __builtin_amdgcn_exp2f(-x * 1.4426950408889634f)); }


struct EpiIn {
    static constexpr bool PERM = true, AFTER_DRAIN = false;
    bf16_t* QKVP; bf16_t* GAB; const float* rstd1; const float* bias1p; float* ksum; unsigned* nrm;
    __device__ __forceinline__ void operator()(const f32x4 (&acc)[2][2][4][2], const Unit& u, int wr, int wc, int fr, int fq) const {
        bf16_t* base; int ldc, col0;
        if (u.pn < 8) { base = QKVP + (size_t)(u.pn >> 1) * T * 512; ldc = 512; col0 = (u.pn & 1) * 256; }
        else { base = GAB + (size_t)((u.pn - 8) >> 2) * T * 1024; ldc = 1024; col0 = ((u.pn - 8) & 3) * 256; }
        const float sc = (u.pn < 2) ? QSCALE : 1.0f;
        const int b = u.pm >> 4;
        const int bcol = u.pn * 256 + wc * 32 + 8 * fq;
        f32x4 bv[2][2];
#pragma unroll
        for (int bj = 0; bj < 2; ++bj)
#pragma unroll
            for (int n = 0; n < 2; ++n) { f32x4 s = (f32x4){0.f, 0.f, 0.f, 0.f};
#pragma unroll
                for (int kc = 0; kc < 8; ++kc) s += *(const f32x4*)(bias1p + (size_t)(kc * 8 + b) * INW + bcol + bj * HALF + 4 * n);
                bv[bj][n] = s; }
        const bool isk = (u.pn == 2 || u.pn == 3); const bool isqk = (u.pn < 4); float nmax[2] = {0.f, 0.f};
        f32x4 ks[2][2];
#pragma unroll
        for (int bj = 0; bj < 2; ++bj)
#pragma unroll
            for (int n = 0; n < 2; ++n) ks[bj][n] = (f32x4){0.f, 0.f, 0.f, 0.f};
        const int row0 = u.pm * BM + wr * 64 + fr;
#pragma unroll
        for (int ai = 0; ai < 2; ++ai)
#pragma unroll
            for (int m = 0; m < 4; ++m) { const int row = row0 + ai * HALF + m * 16; const float rs = rstd1[row];
                bf16_t* rowp = base + (size_t)row * ldc + col0 + wc * 32 + 8 * fq;
#pragma unroll
                for (int bj = 0; bj < 2; ++bj) { f32x4 v0 = acc[ai][bj][m][0] * rs + bv[bj][0], v1 = acc[ai][bj][m][1] * rs + bv[bj][1];
                    ks[bj][0] += v0; ks[bj][1] += v1;
                    v0 = v0 * sc; v1 = v1 * sc;
                    if (isqk) { float ss = (v0[0] * v0[0] + v0[1] * v0[1]) + (v0[2] * v0[2] + v0[3] * v0[3]) + (v1[0] * v1[0] + v1[1] * v1[1]) + (v1[2] * v1[2] + v1[3] * v1[3]); ss += __shfl_xor(ss, 16); ss += __shfl_xor(ss, 32); nmax[bj] = fmaxf(nmax[bj], ss); }
                    u32x4 w; w.x = cvt_pk_bf16(v0[0], v0[1]); w.y = cvt_pk_bf16(v0[2], v0[3]); w.z = cvt_pk_bf16(v1[0], v1[1]); w.w = cvt_pk_bf16(v1[2], v1[3]);
                    *(u32x4*)(rowp + bj * HALF) = w; } }
        if (isqk) {
#pragma unroll
            for (int bj = 0; bj < 2; ++bj) { float v = nmax[bj]; v = fmaxf(v, __shfl_xor(v, 1)); v = fmaxf(v, __shfl_xor(v, 2)); v = fmaxf(v, __shfl_xor(v, 4)); v = fmaxf(v, __shfl_xor(v, 8));
                if (fr == 0 && fq == 0) atomicMax(nrm + (size_t)(b * 2 + (u.pn >> 1)) * 16 + (u.pn & 1) * 8 + bj * 4 + wc, __float_as_uint(v)); }
        }
        if (isk) {
#pragma unroll
            for (int bj = 0; bj < 2; ++bj)
#pragma unroll
                for (int n = 0; n < 2; ++n)
#pragma unroll
                    for (int e = 0; e < 4; ++e) { float v = ks[bj][n][e]; v += __shfl_xor(v, 1); v += __shfl_xor(v, 2); v += __shfl_xor(v, 4); v += __shfl_xor(v, 8); ks[bj][n][e] = v; }
            if (fr == 0) { float* kp = ksum + (size_t)u.pm * 512 + (u.pn - 2) * 256 + wc * 32 + 8 * fq;
#pragma unroll
                for (int bj = 0; bj < 2; ++bj)
#pragma unroll
                    for (int n = 0; n < 2; ++n)
#pragma unroll
                        for (int e = 0; e < 4; ++e) atomicAdd(kp + bj * HALF + 4 * n + e, ks[bj][n][e]); }
        }
    }
};

struct EpiUp {
    static constexpr bool PERM = true, AFTER_DRAIN = false;
    bf16_t* merged; const bf16_t* GAB; const float* bprime;
    __device__ __forceinline__ void operator()(const f32x4 (&acc)[2][2][4][2], const Unit& u, int wr, int wc, int fr, int fq) const {
        const int row0 = u.pm * BM + wr * 64 + fr, colb = u.pn * BM + wc * 32 + 8 * fq;
        const bf16_t* gate = GAB + (size_t)u.part * T * 1024;
        f32x4 bv[2][2];
#pragma unroll
        for (int bj = 0; bj < 2; ++bj)
#pragma unroll
            for (int n = 0; n < 2; ++n) { f32x4 s_ = (f32x4){0.f, 0.f, 0.f, 0.f}; if (u.part) { _Pragma("unroll") for (int g_ = 0; g_ < 4; ++g_) s_ += *(const f32x4*)(bprime + g_ * 1024 + colb + bj * HALF + 4 * n); } bv[bj][n] = s_; }
#pragma unroll
        for (int ai = 0; ai < 2; ++ai) {
            u32x4 gpre[4][2], ppre[4][2];
#pragma unroll
            for (int m = 0; m < 4; ++m) { const size_t off = (size_t)(row0 + ai * HALF + m * 16) * 1024 + colb;
#pragma unroll
                for (int bj = 0; bj < 2; ++bj) { gpre[m][bj] = __builtin_nontemporal_load((const u32x4*)(gate + off + bj * HALF));
                    if (u.part) ppre[m][bj] = __builtin_nontemporal_load((const u32x4*)(merged + off + bj * HALF)); else ppre[m][bj] = (u32x4){0u, 0u, 0u, 0u}; } }
#pragma unroll
            for (int m = 0; m < 4; ++m) { const size_t off = (size_t)(row0 + ai * HALF + m * 16) * 1024 + colb;
#pragma unroll
                for (int bj = 0; bj < 2; ++bj) {
                    const u32x4 gw = gpre[m][bj], pw = ppre[m][bj];
                    f32x4 v0 = acc[ai][bj][m][0] + bv[bj][0], v1 = acc[ai][bj][m][1] + bv[bj][1];
                    v0[0] *= sigmoidf_(bf_lo(gw.x)); v0[1] *= sigmoidf_(bf_hi(gw.x)); v0[2] *= sigmoidf_(bf_lo(gw.y)); v0[3] *= sigmoidf_(bf_hi(gw.y));
                    v1[0] *= sigmoidf_(bf_lo(gw.z)); v1[1] *= sigmoidf_(bf_hi(gw.z)); v1[2] *= sigmoidf_(bf_lo(gw.w)); v1[3] *= sigmoidf_(bf_hi(gw.w));
                    v0[0] += bf_lo(pw.x); v0[1] += bf_hi(pw.x); v0[2] += bf_lo(pw.y); v0[3] += bf_hi(pw.y); v1[0] += bf_lo(pw.z); v1[1] += bf_hi(pw.z); v1[2] += bf_lo(pw.w); v1[3] += bf_hi(pw.w);
                    u32x4 w; w.x = cvt_pk_bf16(v0[0], v0[1]); w.y = cvt_pk_bf16(v0[2], v0[3]); w.z = cvt_pk_bf16(v1[0], v1[1]); w.w = cvt_pk_bf16(v1[2], v1[3]);
                    *(u32x4*)(merged + off + bj * HALF) = w; } }
        }
        if (u.part == 0) asm volatile("s_waitcnt vmcnt(0)" ::: "memory");
    }
};

struct EpiOut {
    static constexpr bool PERM = true, AFTER_DRAIN = false;
    const float* x; float* x1; bf16_t* A2; const float* modf; const float* g2; float* ss2;
    __device__ __forceinline__ void operator()(const f32x4 (&acc)[2][2][4][2], const Unit& u, int wr, int wc, int fr, int fq) const {
        const int row0 = u.pm * BM + wr * 64 + fr, colb = u.pn * BM + wc * 32 + 8 * fq, b = u.pm >> 4;
        f32x4 gt[2][2], gg[2][2];
#pragma unroll
        for (int bj = 0; bj < 2; ++bj)
#pragma unroll
            for (int n = 0; n < 2; ++n) { const int c = colb + bj * HALF + 4 * n; gt[bj][n] = *(const f32x4*)(modf + (size_t)b * 6144 + 2048 + c);
                const f32x4 sc2 = *(const f32x4*)(modf + (size_t)b * 6144 + 4096 + c); gg[bj][n] = *(const f32x4*)(g2 + c) * (sc2 + 1.0f); }
#pragma unroll
        for (int ai = 0; ai < 2; ++ai) {
#pragma unroll
          for (int mh = 0; mh < 2; ++mh) {
            f32x4 xr[2][2][2];
#pragma unroll
            for (int m2 = 0; m2 < 2; ++m2) { const size_t off = (size_t)(row0 + ai * HALF + (2 * mh + m2) * 16) * 1024 + colb;
#pragma unroll
                for (int bj = 0; bj < 2; ++bj) { xr[m2][bj][0] = __builtin_nontemporal_load((const f32x4*)(x + off + bj * HALF)); xr[m2][bj][1] = __builtin_nontemporal_load((const f32x4*)(x + off + bj * HALF + 4)); } }
#pragma unroll
            for (int m2 = 0; m2 < 2; ++m2) { const int m = 2 * mh + m2; const int row = row0 + ai * HALF + m * 16; const size_t off = (size_t)row * 1024 + colb; float ssq = 0.f;
#pragma unroll
                for (int bj = 0; bj < 2; ++bj) {
                    const f32x4 y0 = xr[m2][bj][0] + gt[bj][0] * acc[ai][bj][m][0], y1 = xr[m2][bj][1] + gt[bj][1] * acc[ai][bj][m][1];
                    *(f32x4*)(x1 + off + bj * HALF) = y0; *(f32x4*)(x1 + off + bj * HALF + 4) = y1;
                    ssq += (y0[0] * y0[0] + y0[1] * y0[1]) + (y0[2] * y0[2] + y0[3] * y0[3]) + (y1[0] * y1[0] + y1[1] * y1[1]) + (y1[2] * y1[2] + y1[3] * y1[3]);
                    const f32x4 a0 = y0 * gg[bj][0], a1 = y1 * gg[bj][1];
                    u32x4 w; w.x = cvt_pk_bf16(a0[0], a0[1]); w.y = cvt_pk_bf16(a0[2], a0[3]); w.z = cvt_pk_bf16(a1[0], a1[1]); w.w = cvt_pk_bf16(a1[2], a1[3]);
                    *(u32x4*)(A2 + off + bj * HALF) = w; }
                ssq += __shfl_xor(ssq, 16); ssq += __shfl_xor(ssq, 32);
                if (fq == 0) ss2[(size_t)row * 16 + u.pn * 4 + wc] = ssq; }
          }
        }
    }
};

struct EpiPq {
    static constexpr bool PERM = true, AFTER_DRAIN = false;
    bf16_t* QP; const float* ss2; const float* bias2p;
    __device__ __forceinline__ void operator()(const f32x4 (&acc)[2][2][4][2], const Unit& u, int wr, int wc, int fr, int fq) const {
        const int row0 = u.pm * BM + wr * 64 + fr, colb = u.pn * BM + wc * 32 + 8 * fq, b = u.pm >> 4;
        f32x4 bv[2][2];
#pragma unroll
        for (int bj = 0; bj < 2; ++bj)
#pragma unroll
            for (int n = 0; n < 2; ++n) { f32x4 s = (f32x4){0.f, 0.f, 0.f, 0.f};
#pragma unroll
                for (int kc = 0; kc < 8; ++kc) s += *(const f32x4*)(bias2p + (size_t)(kc * 8 + b) * PQW + colb + bj * HALF + 4 * n);
                bv[bj][n] = s; }
#pragma unroll
        for (int ai = 0; ai < 2; ++ai)
#pragma unroll
            for (int m = 0; m < 4; ++m) { const int row = row0 + ai * HALF + m * 16;
                const f32x4* sp = (const f32x4*)(ss2 + (size_t)row * 16); const f32x4 s4 = (sp[0] + sp[1]) + (sp[2] + sp[3]);
                const float rs = __builtin_amdgcn_rsqf(((s4[0] + s4[1]) + (s4[2] + s4[3])) * (1.0f / D) + RMS_EPS);
                bf16_t* rowp = QP + (size_t)row * PQW + colb;
#pragma unroll
                for (int bj = 0; bj < 2; ++bj) { const f32x4 v0 = acc[ai][bj][m][0] * rs + bv[bj][0], v1 = acc[ai][bj][m][1] * rs + bv[bj][1];
                    u32x4 w; w.x = cvt_pk_bf16(v0[0], v0[1]); w.y = cvt_pk_bf16(v0[2], v0[3]); w.z = cvt_pk_bf16(v1[0], v1[1]); w.w = cvt_pk_bf16(v1[2], v1[3]);
                    *(u32x4*)(rowp + bj * HALF) = w; } }
    }
};

template <class Epi, class Sched, bool ALIGN_EPI = false, bool SP2 = false>
__device__ __forceinline__ void gemm_phase(PG8_LAS unsigned char* lds, const Gemm g, const Sched& S, const Epi& E) {
    int tid_ = threadIdx.x; asm volatile("" : "+v"(tid_));
    const int tid = tid_, wid = __builtin_amdgcn_readfirstlane(tid >> 6), lane = tid & 63, wr = wid >> 2, wc = wid & 3, fr = lane & 15, fq = lane >> 4;
    const int K = g.K, nt = K / BK, lda = g.lda, ldb = g.ldb;
    unsigned voffA[2], voffB[2];
#pragma unroll
    for (int i = 0; i < 2; ++i) { int R, C; stage_rc(tid * 16 + i * 8192, R, C); const int Rb = Epi::PERM ? ((R & ~31) + perm32(R & 31)) : R;
        voffA[i] = (unsigned)(R * lda + C) * 2u; voffB[i] = (unsigned)(Rb * ldb + C) * 2u; }
    const size_t kstep = (size_t)(BK * 2);
    const size_t hstepA = (size_t)HALF * lda * 2, hstepB = (size_t)HALF * ldb * 2;
    const unsigned ldsw = (unsigned)wid * 1024u;
    const int aoff = lds_byte(wr * 64 + fr, fq * 8), boff = lds_byte(wc * 32 + fr, fq * 8);
#define PG8_SA(b, h) (((b) * 2 + (h)) * HTB)
#define PG8_SB(b, h) ((4 + (b) * 2 + (h)) * HTB)
#define PG8_STAGE(bufoff, gbase, voff) do { _Pragma("unroll") for (int _i = 0; _i < 2; ++_i) \
        __builtin_amdgcn_global_load_lds((const unsigned*)((const char*)(gbase) + (voff)[_i]), (PG8_LAS unsigned*)(lds + (bufoff) + ldsw + _i * 8192), 16, 0, 0); } while (0)
#define PG8_LDA(dst, b, h) do { _Pragma("unroll") for (int m = 0; m < 4; ++m) _Pragma("unroll") for (int k = 0; k < 2; ++k) dst[m][k] = *(const PG8_LAS bf16x8*)(lds + PG8_SA(b, h) + aoff + m * 2048 + k * 1024); } while (0)
#define PG8_LDB(dst, b, h) do { _Pragma("unroll") for (int n = 0; n < 2; ++n) _Pragma("unroll") for (int k = 0; k < 2; ++k) dst[n][k] = *(const PG8_LAS bf16x8*)(lds + PG8_SB(b, h) + boff + n * 2048 + k * 1024); } while (0)
#define PG8_MMA(ai, bj, At, Bt) do { __builtin_amdgcn_s_setprio(1); _Pragma("unroll") for (int m = 0; m < 4; ++m) _Pragma("unroll") for (int n = 0; n < 2; ++n) _Pragma("unroll") for (int k = 0; k < 2; ++k) \
        acc[ai][bj][m][n] = __builtin_amdgcn_mfma_f32_16x16x32_bf16(Bt[n][k], At[m][k], acc[ai][bj][m][n], 0, 0, 0); __builtin_amdgcn_s_setprio(0); } while (0)
#define PG8_WAIT_V(n) asm volatile("s_waitcnt vmcnt(" #n ")" ::: "memory")
#define PG8_WAIT_L(n) asm volatile("s_waitcnt lgkmcnt(" #n ")" ::: "memory")
#define PG8_BAR __builtin_amdgcn_s_barrier()
#define PG8_SCHED __builtin_amdgcn_sched_barrier(0)
    Unit cur, nxt; int ui = 0;
    if (!S.next(0, cur)) return;
    f32x4 acc[2][2][4][2];
#pragma unroll
    for (int a = 0; a < 2; ++a)
#pragma unroll
        for (int b = 0; b < 2; ++b)
#pragma unroll
            for (int m = 0; m < 4; ++m)
#pragma unroll
                for (int n = 0; n < 2; ++n) acc[a][b][m][n] = (f32x4){0.f, 0.f, 0.f, 0.f};
    bf16x8 At[4][2], B0[2][2], B1[2][2];
    const char* cA = g.a_ptr(cur); const char* cB = g.b_ptr(cur);
    S.a_ready(cur);
    if constexpr (SP2) {
        PG8_STAGE(PG8_SB(0, 0), cB, voffB); PG8_STAGE(PG8_SB(0, 1), cB + hstepB, voffB); PG8_STAGE(PG8_SA(0, 0), cA, voffA); PG8_STAGE(PG8_SA(0, 1), cA + hstepA, voffA);
        if (wr == 1) PG8_BAR;
        PG8_WAIT_V(2); PG8_BAR;
        PG8_STAGE(PG8_SB(1, 0), cB + kstep, voffB); PG8_STAGE(PG8_SA(1, 0), cA + kstep, voffA); PG8_STAGE(PG8_SB(1, 1), cB + hstepB + kstep, voffB);
        PG8_WAIT_V(6); PG8_BAR;
    } else {
        PG8_STAGE(PG8_SB(0, 0), cB, voffB); PG8_STAGE(PG8_SA(0, 0), cA, voffA); PG8_STAGE(PG8_SB(0, 1), cB + hstepB, voffB); PG8_STAGE(PG8_SA(0, 1), cA + hstepA, voffA);
        if (wr == 1) PG8_BAR;
        PG8_WAIT_V(4); PG8_BAR;
        PG8_STAGE(PG8_SB(1, 0), cB + kstep, voffB); PG8_STAGE(PG8_SA(1, 0), cA + kstep, voffA); PG8_STAGE(PG8_SB(1, 1), cB + hstepB + kstep, voffB);
        PG8_WAIT_V(6); PG8_BAR;
    }
    for (;;) {
        const bool has_next = S.next(ui + 1, nxt);
        const char* nA = has_next ? g.a_ptr(nxt) : cA; const char* nB = has_next ? g.b_ptr(nxt) : cB;
        for (int t = 0; t < nt; t += 2) {
            const bool last = (t == nt - 2);
            const char* a1 = cA + (size_t)(t + 1) * kstep;
            const char* a2 = last ? nA : cA + (size_t)(t + 2) * kstep; const char* b2 = last ? nB : cB + (size_t)(t + 2) * kstep;
            const char* a3 = a2 + kstep; const char* b3 = b2 + kstep;
            if (last && has_next) S.a_ready(nxt);
            if constexpr (SP2) {
            PG8_LDB(B0, 0, 0); PG8_LDB(B1, 0, 1); PG8_SCHED; PG8_LDA(At, 0, 0); PG8_STAGE(PG8_SA(1, 1), a1 + hstepA, voffA);
            PG8_WAIT_V(8); PG8_WAIT_L(0); PG8_BAR; PG8_MMA(0, 0, At, B0); PG8_MMA(0, 1, At, B1); PG8_BAR; PG8_SCHED;
            PG8_LDA(At, 0, 1); PG8_STAGE(PG8_SB(0, 0), b2, voffB); PG8_STAGE(PG8_SB(0, 1), b2 + hstepB, voffB); PG8_STAGE(PG8_SA(0, 0), a2, voffA);
            PG8_WAIT_V(8); PG8_WAIT_L(0); PG8_BAR; PG8_MMA(1, 0, At, B0); PG8_MMA(1, 1, At, B1); PG8_BAR; PG8_SCHED;
            PG8_LDB(B0, 1, 0); PG8_LDB(B1, 1, 1); PG8_SCHED; PG8_LDA(At, 1, 0); PG8_STAGE(PG8_SA(0, 1), a2 + hstepA, voffA);
            PG8_WAIT_V(8); PG8_WAIT_L(0); PG8_BAR; PG8_MMA(0, 0, At, B0); PG8_MMA(0, 1, At, B1); PG8_BAR; PG8_SCHED;
            PG8_LDA(At, 1, 1); PG8_STAGE(PG8_SB(1, 0), b3, voffB); PG8_STAGE(PG8_SB(1, 1), b3 + hstepB, voffB); PG8_STAGE(PG8_SA(1, 0), a3, voffA);
            PG8_WAIT_V(8); PG8_WAIT_L(0); PG8_BAR; PG8_MMA(1, 0, At, B0); PG8_MMA(1, 1, At, B1); PG8_BAR; PG8_SCHED;
            } else {
            PG8_LDB(B0, 0, 0); PG8_SCHED; PG8_LDA(At, 0, 0); PG8_STAGE(PG8_SA(1, 1), a1 + hstepA, voffA);
            PG8_WAIT_L(8); PG8_BAR; PG8_WAIT_L(0); PG8_MMA(0, 0, At, B0); PG8_BAR; PG8_SCHED;
            PG8_LDB(B1, 0, 1); PG8_STAGE(PG8_SB(0, 0), b2, voffB);
            PG8_BAR; PG8_WAIT_L(0); PG8_MMA(0, 1, At, B1); PG8_BAR;
            PG8_LDA(At, 0, 1); PG8_STAGE(PG8_SA(0, 0), a2, voffA);
            PG8_BAR; PG8_WAIT_L(0); PG8_MMA(1, 0, At, B0); PG8_BAR; PG8_SCHED;
            PG8_STAGE(PG8_SB(0, 1), b2 + hstepB, voffB);
            PG8_WAIT_V(6); PG8_BAR; PG8_MMA(1, 1, At, B1); PG8_BAR;
            PG8_LDB(B0, 1, 0); PG8_SCHED; PG8_LDA(At, 1, 0); PG8_STAGE(PG8_SA(0, 1), a2 + hstepA, voffA);
            PG8_WAIT_L(8); PG8_BAR; PG8_WAIT_L(0); PG8_MMA(0, 0, At, B0); PG8_BAR; PG8_SCHED;
            PG8_LDB(B1, 1, 1); PG8_STAGE(PG8_SB(1, 0), b3, voffB);
            PG8_BAR; PG8_WAIT_L(0); PG8_MMA(0, 1, At, B1); PG8_BAR;
            PG8_LDA(At, 1, 1); PG8_STAGE(PG8_SA(1, 0), a3, voffA);
            PG8_BAR; PG8_WAIT_L(0); PG8_MMA(1, 0, At, B0); PG8_BAR; PG8_SCHED;
            PG8_STAGE(PG8_SB(1, 1), b3 + hstepB, voffB);
            PG8_WAIT_V(6); PG8_BAR; PG8_MMA(1, 1, At, B1); PG8_BAR;
            }
        }
        if constexpr (ALIGN_EPI) { if (wr == 0) PG8_BAR; }
        if constexpr (!Epi::AFTER_DRAIN) { E(acc, cur, wr, wc, fr, fq); S.done(cur); }
        if (!has_next) break;
#pragma unroll
        for (int a = 0; a < 2; ++a)
#pragma unroll
            for (int b = 0; b < 2; ++b)
#pragma unroll
                for (int m = 0; m < 4; ++m)
#pragma unroll
                    for (int n = 0; n < 2; ++n) acc[a][b][m][n] = (f32x4){0.f, 0.f, 0.f, 0.f};
        cur = nxt; cA = nA; cB = nB; ++ui;
        if constexpr (ALIGN_EPI) { if (wr == 1) PG8_BAR; }
    }
    PG8_WAIT_V(0);
    if constexpr (!ALIGN_EPI) { if (wr == 0) PG8_BAR; }
    PG8_BAR;
    if constexpr (Epi::AFTER_DRAIN) { E.fused(acc, cur, wr, wc, fr, fq, lds, wid, lane); S.done(cur); }
#undef PG8_SA
#undef PG8_SB
#undef PG8_STAGE
#undef PG8_LDA
#undef PG8_LDB
#undef PG8_MMA
#undef PG8_WAIT_V
#undef PG8_WAIT_L
#undef PG8_BAR
#undef PG8_SCHED
}
}

constexpr size_t MiB = 1u << 20;
constexpr size_t WS_CTL = 0, CTL_ZERO_BYTES = 32 * 1024;
constexpr size_t WS_KSUM = 256 * 1024;
constexpr size_t WS_MODP = 1 * MiB;
constexpr size_t WS_MODF = WS_MODP + 8 * 8 * 6144 * 4;
constexpr size_t WS_BIAS1P = 3 * MiB;
constexpr size_t WS_BIAS2P = 4 * MiB;
constexpr size_t WS_BPRIME = 4 * MiB + 512 * 1024;
constexpr size_t WS_RSTD1 = 5 * MiB;
constexpr size_t WS_SS2 = 6 * MiB;
constexpr size_t WS_SUBK = 8 * MiB;
constexpr size_t WS_WIN = 16 * MiB, WS_WA = 24 * MiB, WS_WP = 25 * MiB, WS_WOUT = 26 * MiB, WS_WQ = 28 * MiB;
constexpr size_t WS_U = 32 * MiB, WS_V = 64 * MiB;
constexpr size_t WS_XG = 96 * MiB;
constexpr size_t WS_H2Q = WS_XG, WS_HS = WS_XG + 32 * MiB;
constexpr size_t WS_QKVP = 160 * MiB;
constexpr size_t WS_GAB = 288 * MiB;
constexpr size_t WS_POOLED = 416 * MiB;
constexpr size_t WS_END = 448 * MiB;
constexpr int CW_TMO = 0, CW_BAR = 4096;
constexpr int CW_NRM = 2048;

constexpr int RING_OFF = 0, RING_BYTES = 131072;
constexpr int LDS_BYTES = 147456;
constexpr int LDSCTL_OFF = LDS_BYTES - 512, MISC_OFF = LDSCTL_OFF + 320;

#define GAS __attribute__((address_space(1)))
#define LAS __attribute__((address_space(3)))
typedef unsigned short bf16;
typedef unsigned v4u __attribute__((ext_vector_type(4)));
typedef unsigned v2u __attribute__((ext_vector_type(2)));
typedef float f32x4 __attribute__((ext_vector_type(4)));
typedef GAS unsigned gu32;
#define RLX_AGENT __ATOMIC_RELAXED, __HIP_MEMORY_SCOPE_AGENT
#define LDS_WAIT() asm volatile("s_waitcnt lgkmcnt(0)" ::: "memory")
#define VM_WAIT() asm volatile("s_waitcnt vmcnt(0)" ::: "memory")
__device__ __forceinline__ unsigned f2bf(float f) { unsigned u = __builtin_bit_cast(unsigned, f); return (u + 0x7fffu + ((u >> 16) & 1u)) >> 16; }
__device__ __forceinline__ unsigned pk2(float lo, float hi) { return f2bf(lo) | (f2bf(hi) << 16); }
__device__ __forceinline__ float bflo(unsigned w) { return __uint_as_float(w << 16); }
__device__ __forceinline__ float bfhi(unsigned w) { return __uint_as_float(w & 0xffff0000u); }
__device__ __forceinline__ float wave_sum(float v) {
#pragma unroll
    for (int o = 1; o < 64; o <<= 1) v += __shfl_xor(v, o);
    return v;
}
__device__ __forceinline__ float wave_max(float v) {
#pragma unroll
    for (int o = 1; o < 64; o <<= 1) v = fmaxf(v, __shfl_xor(v, o));
    return v;
}

#define XB_TMO      128
#define XB_XCNT(j)  (256  + 64 * (j))
#define XB_XSUB(j)  (1280 + 64 * (j))
#define XB_XGEN(j)  (2304 + 64 * (j))
#define XB_TOP      3328
#define XB_TOPGEN   3392
#define XCD_BAR_WORDS 3456
#define XB_SPIN_CAP (1u << 22)

__device__ __forceinline__ unsigned xb_ld(unsigned* p)              { return __hip_atomic_load(p, __ATOMIC_RELAXED, __HIP_MEMORY_SCOPE_AGENT); }
__device__ __forceinline__ unsigned xb_add(unsigned* p, unsigned v) { return __hip_atomic_fetch_add(p, v, __ATOMIC_RELAXED, __HIP_MEMORY_SCOPE_AGENT); }
__device__ __forceinline__ unsigned xb_xcc_id() { return (unsigned)__builtin_amdgcn_s_getreg((3 << 11) | 20) & 0xFu; }
#define XB_SPIN(cond, bar) do { unsigned _sp = 0; while (cond) { __builtin_amdgcn_s_sleep(1); \
    if ((++_sp & 255u) == 0u) { if (xb_ld(&(bar)[XB_TMO])) break; if (_sp > XB_SPIN_CAP) { atomicAdd(&(bar)[XB_TMO], 1u); break; } } } } while (0)

struct XcdBarrier { unsigned* bar; unsigned x; volatile LAS unsigned* st; };

__device__ __forceinline__ XcdBarrier xcd_barrier_post(unsigned* bar, volatile LAS unsigned* st) {
    XcdBarrier b; b.bar = bar; b.x = xb_xcc_id(); b.st = st;
    if (threadIdx.x == 0) (void)xb_add(&bar[XB_XCNT(b.x)], 1u);
    return b;
}
__device__ __forceinline__ void xcd_barrier_complete(unsigned* bar, unsigned x, unsigned& nloc, unsigned& nx) {
    const unsigned G = gridDim.x * gridDim.y * gridDim.z;
    unsigned sum, cnt, mine, sp = 0u;
    for (;;) {
        sum = 0u; cnt = 0u; mine = 0u;
#pragma unroll
        for (unsigned j = 0; j < 16; ++j) { const unsigned c = xb_ld(&bar[XB_XCNT(j)]); sum += c; cnt += (c > 0u) ? 1u : 0u; mine = (j == x) ? c : mine; }
        if (sum == G) break;
        __builtin_amdgcn_s_sleep(1);
        if ((++sp & 255u) == 0u) { if (xb_ld(&bar[XB_TMO])) break; if (sp > XB_SPIN_CAP) { atomicAdd(&bar[XB_TMO], 1u); break; } }
    }
    nloc = mine > 0u ? mine : 1u; nx = cnt > 0u ? cnt : 1u;
}
__device__ __forceinline__ void xcd_barrier(const XcdBarrier& b) {
    asm volatile("s_waitcnt vmcnt(0)" ::: "memory");
    __syncthreads();
    if (threadIdx.x == 0) {
        unsigned* bar = b.bar;
        __builtin_amdgcn_s_waitcnt(0);
        unsigned nloc = b.st[0], nx = b.st[1];
        if (nloc == 0u) { xcd_barrier_complete(bar, b.x, nloc, nx); b.st[0] = nloc; b.st[1] = nx; }
        const unsigned old = xb_add(&bar[XB_XSUB(b.x)], 1u);
        const unsigned gen = old / nloc;
        if (old + 1u == (gen + 1u) * nloc) {
            __builtin_amdgcn_fence(__ATOMIC_RELEASE, "agent");
            asm volatile("s_waitcnt vmcnt(0)" ::: "memory");
            const unsigned og = xb_add(&bar[XB_TOP], 1u);
            const unsigned tg = og / nx;
            if (og + 1u == (tg + 1u) * nx) xb_add(&bar[XB_TOPGEN], 1u);
            else XB_SPIN(xb_ld(&bar[XB_TOPGEN]) == tg, bar);
            __builtin_amdgcn_fence(__ATOMIC_ACQUIRE, "agent");
            xb_add(&bar[XB_XGEN(b.x)], 1u);
            asm volatile("s_waitcnt vmcnt(0)" ::: "memory");
        } else {
            XB_SPIN(xb_ld(&bar[XB_XGEN(b.x)]) == gen, bar);
            __builtin_amdgcn_fence(__ATOMIC_ACQUIRE, "agent");
            asm volatile("s_waitcnt vmcnt(0)" ::: "memory");
        }
    }
    __syncthreads();
}

struct Frame {
    LAS unsigned char* lds;
    volatile LAS unsigned* MISC;
    gu32* ctl;
    int tid, lane, wave;
    int vcu, G;
};
struct Args { const float* in[18]; float* out; unsigned char* ws; };

__device__ __forceinline__ float modp_sum(const float* modp, int idx) {
    float s = 0.f;
#pragma unroll
    for (int kc = 0; kc < 8; ++kc) s += modp[(size_t)kc * 8 * 6144 + idx];
    return s;
}
template <int MODE>
__device__ __forceinline__ void p0_wg_dot(Frame& F, const float* cin, const float* modp, int soff, const float* W, int N, const float* addv, float* outp, int first, int ntask) {
    LAS float* scr = (LAS float*)(F.lds + RING_OFF + F.wave * 16384);
    const int ncn = N / 64;
    for (int it = first; it < ntask; it += F.G) {
        const int kc = it / ncn, nc = it % ncn, k0 = kc * 128 + F.wave * 16, n = nc * 64 + F.lane;
        float w[16];
#pragma unroll
        for (int kk = 0; kk < 16; ++kk) w[kk] = (MODE == 0) ? __builtin_nontemporal_load(W + (size_t)(k0 + kk) * N + n) : W[(size_t)(k0 + kk) * N + n];
#pragma unroll
        for (int j = 0; j < 2; ++j) { const int idx = F.lane + 64 * j, b = idx >> 4, kk = idx & 15;
            float cf; if (MODE == 0) { const float cv = cin[b * 1024 + k0 + kk]; cf = cv / (1.0f + __expf(-cv)); } else cf = modp_sum(modp, b * 6144 + soff + k0 + kk);
            scr[idx] = cf; }
        LDS_WAIT(); asm volatile("" ::: "memory");
#pragma unroll
        for (int b = 0; b < 8; ++b) { float s = 0.f;
#pragma unroll
            for (int kk = 0; kk < 16; ++kk) s += scr[b * 16 + kk] * w[kk];
            scr[256 + b * 64 + F.lane] = s; }
        __syncthreads();
        { const int b = F.wave; float s = (addv != nullptr && kc == 0) ? addv[n] : 0.f;
#pragma unroll
          for (int w8 = 0; w8 < 8; ++w8) s += ((LAS float*)(F.lds + RING_OFF + w8 * 16384))[256 + b * 64 + F.lane];
          outp[(size_t)(kc * 8 + b) * N + n] = s; }
        __syncthreads();
    }
}
__device__ __forceinline__ void p0a_mod(Frame& F, const Args& A) { p0_wg_dot<0>(F, A.in[1], nullptr, 0, A.in[2], 6144, A.in[3], (float*)(A.ws + WS_MODP), F.vcu, 8 * 96); }
__device__ __forceinline__ void p0_wp_task(Frame& F, const Args& A, int r) {
    LAS float* scr = (LAS float*)(F.lds + RING_OFF + F.wave * 16384);
    const int g = r >> 6, kq = (r >> 4) & 3, nc = r & 15, n = nc * 64 + F.lane, d0 = 16 * F.wave;
    const float* wmix = A.in[7] + (size_t)(g * 128 + 32 * kq) * 128 + d0; const float* scale = A.in[9] + g * 128 + d0; const float* wup = A.in[10] + (size_t)(g * 128 + d0) * D + n; const float* bmix = A.in[8] + g * 128 + d0;
    float wu[16];
#pragma unroll
    for (int d = 0; d < 16; ++d) wu[d] = wup[(size_t)d * D];
    float bp = 0.f;
#pragma unroll
    for (int d = 0; d < 16; ++d) { wu[d] *= scale[d]; bp += bmix[d] * wu[d]; }
#pragma unroll
    for (int kk = 0; kk < 32; ++kk) { float s = 0.f;
#pragma unroll
        for (int d = 0; d < 16; ++d) s += wmix[kk * 128 + d] * wu[d];
        scr[kk * 64 + F.lane] = s; }
    scr[2048 + F.lane] = bp;
    __syncthreads();
    { float s[4]; float bs = 0.f;
#pragma unroll
      for (int e = 0; e < 4; ++e) s[e] = 0.f;
#pragma unroll
      for (int w8 = 0; w8 < 8; ++w8) { const LAS float* o = (const LAS float*)(F.lds + RING_OFF + w8 * 16384);
#pragma unroll
          for (int e = 0; e < 4; ++e) s[e] += o[(4 * F.wave + e) * 64 + F.lane];
          bs += o[2048 + F.lane]; }
      v2u w; w.x = pk2(s[0], s[1]); w.y = pk2(s[2], s[3]);
      *(GAS v2u*)((bf16*)(A.ws + WS_WP) + (size_t)n * PW + g * 128 + 32 * kq + 4 * F.wave) = w;
      if (kq == 0 && F.wave == 0) ((float*)(A.ws + WS_BPRIME))[g * 1024 + n] = bs; }
    __syncthreads();
}

__device__ __forceinline__ void p0_transpose_item(const float* W, int K, int N, bf16* WT, int row_off, LAS float* scr, int item, int lane) {
    const int nblk = N / 32, kb = item / nblk, nb = item % nblk, k0 = 64 * kb, n0 = 32 * nb;
#pragma unroll 8
    for (int i = 0; i < 32; ++i) { const int kk = 2 * i + (lane >> 5); scr[kk * 33 + (lane & 31)] = __builtin_nontemporal_load(W + (size_t)(k0 + kk) * N + n0 + (lane & 31)); }
    LDS_WAIT(); asm volatile("" ::: "memory");
    const int c = lane & 7;
#pragma unroll
    for (int j = 0; j < 4; ++j) { const int n = (lane >> 3) + 8 * j; const LAS float* s = scr + (8 * c) * 33 + n;
        v4u o; o.x = pk2(s[0 * 33], s[1 * 33]); o.y = pk2(s[2 * 33], s[3 * 33]); o.z = pk2(s[4 * 33], s[5 * 33]); o.w = pk2(s[6 * 33], s[7 * 33]);
        *(GAS v4u*)(WT + (size_t)(row_off + n0 + n) * K + k0 + 8 * c) = o; }
    LDS_WAIT(); asm volatile("" ::: "memory");
}
__device__ __forceinline__ void p0_table_rows4(const float* const (&src)[4], unsigned char* const (&dst)[4], float* const (&scale_out)[4], int off, int lane) {
    f32x4 v[4][4]; float am[4];
#pragma unroll
    for (int u = 0; u < 4; ++u)
#pragma unroll
        for (int q = 0; q < 4; ++q) v[u][q] = __builtin_nontemporal_load((const f32x4*)(src[u] + 16 * lane + 4 * q));
#pragma unroll
    for (int u = 0; u < 4; ++u) { float a = 0.f;
#pragma unroll
        for (int q = 0; q < 4; ++q) a = fmaxf(fmaxf(a, fmaxf(fabsf(v[u][q][0]), fabsf(v[u][q][1]))), fmaxf(fabsf(v[u][q][2]), fabsf(v[u][q][3])));
        am[u] = a; }
#pragma unroll
    for (int o = 1; o < 64; o <<= 1) {
#pragma unroll
        for (int u = 0; u < 4; ++u) am[u] = fmaxf(am[u], __shfl_xor(am[u], o)); }
#pragma unroll
    for (int u = 0; u < 4; ++u) { const float sc = (am[u] > 0.f) ? am[u] * (1.0f / 127.0f) : 1.0f, inv = 1.0f / sc;
        v4u o;
#pragma unroll
        for (int q = 0; q < 4; ++q) { const int q0 = (int)rintf(v[u][q][0] * inv) + off, q1 = (int)rintf(v[u][q][1] * inv) + off, q2 = (int)rintf(v[u][q][2] * inv) + off, q3 = (int)rintf(v[u][q][3] * inv) + off;
            o[q] = (unsigned)(q0 & 255) | ((unsigned)(q1 & 255) << 8) | ((unsigned)(q2 & 255) << 16) | ((unsigned)q3 << 24); }
        *(GAS v4u*)(dst[u] + ((size_t)(lane >> 3) << 21) + 16 * (lane & 7)) = o;
        if (lane == 0) *scale_out[u] = sc; }
}
__device__ __forceinline__ void p0_table_trip(const Args& A, int r0, int NGW, int lane) {
    const float* src[4]; unsigned char* dst[4]; float* sco[4];
#pragma unroll
    for (int u = 0; u < 4; ++u) { int r = r0 + u * NGW; if (r >= 2 * PEXP) r = r0; const int tb = r / PEXP, e = r % PEXP;
        src[u] = (tb ? A.in[16] : A.in[15]) + (size_t)e * D; dst[u] = A.ws + (tb ? WS_V : WS_U) + (size_t)e * 128; sco[u] = (float*)(A.ws + WS_U + 16 * MiB) + 2 * e + tb; }
    const int tb0 = r0 / PEXP;
    if ((r0 + 3 * NGW) / PEXP == tb0 && r0 + 3 * NGW < 2 * PEXP) p0_table_rows4(src, dst, sco, 0, lane);
    else { for (int u = 0; u < 4; ++u) { const int r = r0 + u * NGW; if (r < 2 * PEXP) { const float* s1[4] = {src[u], src[u], src[u], src[u]}; unsigned char* d1[4] = {dst[u], dst[u], dst[u], dst[u]}; float* c1[4] = {sco[u], sco[u], sco[u], sco[u]}; p0_table_rows4(s1, d1, c1, 0, lane); } } }
}
template <int STAGE>
__device__ __forceinline__ void p0b_prologue(Frame& F, const Args& A) {
    const int gw = F.vcu * NWAVES + F.wave, NGW = F.G * NWAVES, lane = F.lane;
    const float* modp = (const float*)(A.ws + WS_MODP);
    LAS float* G1 = (LAS float*)(F.lds + 135168);
    if (STAGE == 0) { float* ks = (float*)(A.ws + WS_KSUM); for (int i = F.vcu * NTHREADS + F.tid; i < NB * NBLK * 512; i += F.G * NTHREADS) ks[i] = 0.f; }
    if (STAGE == 0) { for (int r = F.vcu; r < 256; r += F.G) p0_wp_task(F, A, r); }
    else { p0_wg_dot<1>(F, nullptr, modp, 0, A.in[5], INW, nullptr, (float*)(A.ws + WS_BIAS1P), F.vcu, 8 * (INW / 64));
           p0_wg_dot<1>(F, nullptr, modp, 3072, A.in[13], PQW, nullptr, (float*)(A.ws + WS_BIAS2P), F.vcu, 8 * (PQW / 64)); }
    LAS float* scr = (LAS float*)(F.lds + RING_OFF + F.wave * 16384);
    constexpr int I_MODF = 768, I_WIN = (D / 64) * (INW / 32), I_WA = (AW / 64) * (D / 32), I_WOUT = (D / 64) * (D / 32), I_WQ = (D / 64) * (PQW / 32);
    constexpr int I_SUBK = 64;
    constexpr int NITEMS = I_MODF + I_WIN + I_WA + I_WOUT + I_WQ + I_SUBK;
    for (int it = gw; it < NITEMS; it += NGW) {
        int r = it;
        if (r < I_MODF) { if (STAGE != 1) continue; const int idx = r * 64 + lane; ((float*)(A.ws + WS_MODF))[idx] = modp_sum(modp, idx); continue; } r -= I_MODF;
        if (r < I_WIN) { if (STAGE != 0) continue; p0_transpose_item(A.in[5], D, INW, (bf16*)(A.ws + WS_WIN), 0, scr, r, lane); continue; } r -= I_WIN;
        if (r < I_WA) { if (STAGE != 0) continue; p0_transpose_item(A.in[6], AW, D, (bf16*)(A.ws + WS_WA), 0, scr, r, lane); continue; } r -= I_WA;
        if (r < I_WOUT) { if (STAGE != 0) continue; p0_transpose_item(A.in[11], D, D, (bf16*)(A.ws + WS_WOUT), 0, scr, r, lane); continue; } r -= I_WOUT;
        if (r < I_WQ) { if (STAGE != 0) continue; p0_transpose_item(A.in[13], D, PQW, (bf16*)(A.ws + WS_WQ), 0, scr, r, lane); continue; } r -= I_WQ;
        if (r < I_SUBK) { if (STAGE != 0) continue; const float* s = A.in[14] + (size_t)r * 512 + 8 * lane; const f32x4 a = *(const f32x4*)s, b = *(const f32x4*)(s + 4);
            v4u o; o.x = pk2(a[0], a[1]); o.y = pk2(a[2], a[3]); o.z = pk2(b[0], b[1]); o.w = pk2(b[2], b[3]);
            *(GAS v4u*)((bf16*)(A.ws + WS_SUBK) + (size_t)r * 512 + 8 * lane) = o; continue; } r -= I_SUBK;
    }
    auto xg_rows = [&](const int rb) {
        const float* x = A.in[0]; bf16* XG = (bf16*)(A.ws + WS_XG); float* rstd1 = (float*)(A.ws + WS_RSTD1);
            for (int r0 = F.wave; r0 < 128; r0 += 4 * NWAVES) {
                f32x4 v[4][2][2]; float s[4];
#pragma unroll
                for (int u = 0; u < 4; ++u) { const float* xr = x + (size_t)(rb * 128 + r0 + u * NWAVES) * 1024;
#pragma unroll
                    for (int h = 0; h < 2; ++h)
#pragma unroll
                        for (int q = 0; q < 2; ++q) v[u][h][q] = __builtin_nontemporal_load((const f32x4*)(xr + h * 512 + 8 * lane + 4 * q)); }
#pragma unroll
                for (int u = 0; u < 4; ++u) { float t = 0.f;
#pragma unroll
                    for (int h = 0; h < 2; ++h)
#pragma unroll
                        for (int q = 0; q < 2; ++q) t += (v[u][h][q][0] * v[u][h][q][0] + v[u][h][q][1] * v[u][h][q][1]) + (v[u][h][q][2] * v[u][h][q][2] + v[u][h][q][3] * v[u][h][q][3]);
                    s[u] = t; }
#pragma unroll
                for (int o = 1; o < 64; o <<= 1) {
#pragma unroll
                    for (int u = 0; u < 4; ++u) s[u] += __shfl_xor(s[u], o); }
#pragma unroll
                for (int u = 0; u < 4; ++u) { const int row = rb * 128 + r0 + u * NWAVES;
                    if (lane == 0) rstd1[row] = 1.0f / sqrtf(s[u] * (1.0f / D) + RMS_EPS);
#pragma unroll
                    for (int h = 0; h < 2; ++h) { const LAS float* g = G1 + h * 512 + 8 * lane;
                        v4u o; o.x = pk2(v[u][h][0][0] * g[0], v[u][h][0][1] * g[1]); o.y = pk2(v[u][h][0][2] * g[2], v[u][h][0][3] * g[3]); o.z = pk2(v[u][h][1][0] * g[4], v[u][h][1][1] * g[5]); o.w = pk2(v[u][h][1][2] * g[6], v[u][h][1][3] * g[7]);
                        *(GAS v4u*)(XG + (size_t)row * 1024 + h * 512 + 8 * lane) = o; } }
            }
    };
#ifndef TABLES_IN_ROUTER
    if (STAGE == 0) { for (int r0 = gw; r0 < 2 * PEXP; r0 += 4 * NGW) p0_table_trip(A, r0, NGW, lane); }
    else
#else
    if (STAGE == 1)
#endif
    for (int rb = F.vcu; rb < T / 128; rb += F.G) {
        const float* g1 = A.in[4]; const int b = (rb * 128) / SEQ;
        __syncthreads();
        for (int k = F.tid; k < 1024; k += NTHREADS) G1[k] = g1[k] * (1.0f + modp_sum(modp, b * 6144 + 1024 + k));
        __syncthreads();
        xg_rows(rb);
    }

}
namespace attn_body {
using bf16=__hip_bfloat16;
using bf16x8=__attribute__((ext_vector_type(8)))short;
using s16x4=__attribute__((ext_vector_type(4)))short;
using f32x16=__attribute__((ext_vector_type(16)))float;
using u32x4=__attribute__((ext_vector_type(4)))unsigned;
constexpr int BATCH=8,NHEAD=8,SEQ=4096,D=64,DM=NHEAD*D;
constexpr int NW=8,QBLK=32,QB=QBLK*NW,KVBLK=64,NQB=SEQ/QB;
constexpr int ATTN_PITCH=DM, ATTN_UNIT_ROWS=QB;
__device__ __forceinline__ int crow(int r,int hi){return (r&3)+8*(r>>2)+4*hi;}
#define SBAR() __builtin_amdgcn_sched_barrier(0)
__device__ __forceinline__ void cmask(f32x16&p0,f32x16&p1,int jb,int qrel,int hi){
  const float NEG=-INFINITY; int kb=64*jb+4*hi;
  #pragma unroll
  for(int r=0;r<16;++r){int kv=kb+(r&3)+8*(r>>2); if(kv>qrel)p0[r]=NEG; if(kv+32>qrel)p1[r]=NEG;}
}

constexpr int NSLOT=3, SLOTB=8192;
constexpr int LDS_K=0, LDS_V=NSLOT*SLOTB, LDS_WS=2*NSLOT*SLOTB, LDS_OST=LDS_WS+NW*64*4, LDS_KSL=LDS_OST+NW*4096, LDS_BYTES=LDS_KSL+4096;
constexpr float C2=0.125f*1.4426950408889634f;
__device__ __forceinline__ void glds16(const void*sbase,unsigned voff,unsigned lds_dst){unsigned keep;
  asm volatile("s_mov_b32 %0, m0\n\ts_mov_b32 m0, %3\n\ts_nop 4\n\tglobal_load_lds_dwordx4 %1, %2\n\ts_mov_b32 m0, %0":"=&s"(keep):"v"(voff),"s"(sbase),"s"(lds_dst):"memory");}
__device__ __forceinline__ float max3f(float a,float b,float c){float r;asm("v_max3_f32 %0, %1, %2, %3":"=v"(r):"v"(a),"v"(b),"v"(c));return r;}
__device__ __forceinline__ float max2f(float a,float b){float r;asm("v_max_f32_e32 %0, %1, %2":"=v"(r):"v"(a),"v"(b));return r;}
__device__ __forceinline__ float fadd_s(float a,float b){float r;asm("v_add_f32_e32 %0, %1, %2":"=v"(r):"v"(a),"v"(b));return r;}
__device__ __forceinline__ float fsub_s(float a,float b){float r;asm("v_sub_f32_e32 %0, %1, %2":"=v"(r):"v"(a),"v"(b));return r;}
typedef float f32x2_t __attribute__((ext_vector_type(2))); typedef __bf16 bf16x2_t __attribute__((ext_vector_type(2)));
__device__ __forceinline__ unsigned cvtpk_s(float lo,float hi){f32x2_t v={lo,hi};bf16x2_t b=__builtin_convertvector(v,bf16x2_t);return __builtin_bit_cast(unsigned,b);}
#define WAIT_BAR(N) asm volatile("s_waitcnt vmcnt(" #N ") lgkmcnt(0)\n\ts_barrier":::"memory")

__device__ __forceinline__ void qkt(f32x16&p0,f32x16&p1,const char*Kslot,const bf16x8*qr,const f32x16&negm,int r32,int hi){
  const char*kb=Kslot+hi*1024+r32*16;
  #pragma unroll
  for(int d0=0;d0<4;++d0){
    const bf16x8 b0=*reinterpret_cast<const bf16x8*>(kb+d0*2048);
    const bf16x8 b1=*reinterpret_cast<const bf16x8*>(kb+d0*2048+512);
    if(d0==0){p0=__builtin_amdgcn_mfma_f32_32x32x16_bf16(b0,qr[0],negm,0,0,0);p1=__builtin_amdgcn_mfma_f32_32x32x16_bf16(b1,qr[0],negm,0,0,0);}
    else{p0=__builtin_amdgcn_mfma_f32_32x32x16_bf16(b0,qr[d0],p0,0,0,0);p1=__builtin_amdgcn_mfma_f32_32x32x16_bf16(b1,qr[d0],p1,0,0,0);}}
}
typedef __attribute__((address_space(3))) const char* lds_cptr;
typedef short v4i16_t __attribute__((ext_vector_type(4)));
__device__ __forceinline__ void kload8(bf16x8*kf,lds_cptr kp){
  kf[0]=*(const __attribute__((address_space(3))) bf16x8*)(kp);      kf[1]=*(const __attribute__((address_space(3))) bf16x8*)(kp+512);
  kf[2]=*(const __attribute__((address_space(3))) bf16x8*)(kp+2048); kf[3]=*(const __attribute__((address_space(3))) bf16x8*)(kp+2560);
  kf[4]=*(const __attribute__((address_space(3))) bf16x8*)(kp+4096); kf[5]=*(const __attribute__((address_space(3))) bf16x8*)(kp+4608);
  kf[6]=*(const __attribute__((address_space(3))) bf16x8*)(kp+6144); kf[7]=*(const __attribute__((address_space(3))) bf16x8*)(kp+6656);
}
__device__ __forceinline__ void kload2(bf16x8*kf,lds_cptr kp,int j){ kf[2*j]=*(const __attribute__((address_space(3))) bf16x8*)(kp+j*2048); kf[2*j+1]=*(const __attribute__((address_space(3))) bf16x8*)(kp+j*2048+512); }
__device__ __forceinline__ s16x4 vtr(lds_cptr p){ return __builtin_bit_cast(s16x4,__builtin_amdgcn_ds_read_tr16_b64_v4i16((__attribute__((address_space(3))) v4i16_t*)p)); }
__device__ __forceinline__ float rowmax(const f32x16&p0,const f32x16&p1){
  float a=max3f(p0[0],p0[1],p1[0]),b=max3f(p0[2],p0[3],p1[1]);a=max3f(a,p1[2],p1[3]);
  #pragma unroll
  for(int r=4;r<16;r+=4){a=max3f(a,p0[r],p0[r+1]);b=max3f(b,p0[r+2],p0[r+3]);a=max3f(a,p1[r],p1[r+1]);b=max3f(b,p1[r+2],p1[r+3]);}
  const float m=max2f(a,b);
  auto rr=__builtin_amdgcn_permlane32_swap(__float_as_uint(m),__float_as_uint(m),false,false);
  return max2f(__uint_as_float(rr[0]),__uint_as_float(rr[1]));
}
__device__ __forceinline__ void pv(f32x16*o,int vb,bf16x8 pa0,bf16x8 pa1,bf16x8 pa2,bf16x8 pa3){
  #pragma unroll
  for(int d0=0;d0<2;++d0){s16x4 lo[4],hi[4];
    #pragma unroll
    for(int ks=0;ks<4;++ks){
      asm volatile("ds_read_b64_tr_b16 %0,%1 offset:%c2":"=&v"(lo[ks]):"v"(vb),"i"(d0*4096+ks*1024):"memory");
      asm volatile("ds_read_b64_tr_b16 %0,%1 offset:%c2":"=&v"(hi[ks]):"v"(vb),"i"(d0*4096+ks*1024+512):"memory");}
    asm volatile("s_waitcnt lgkmcnt(0)":::"memory");SBAR();
    #define PK(k) (bf16x8){lo[k][0],lo[k][1],lo[k][2],lo[k][3],hi[k][0],hi[k][1],hi[k][2],hi[k][3]}
    o[d0]=__builtin_amdgcn_mfma_f32_32x32x16_bf16(pa0,PK(0),o[d0],0,0,0);
    o[d0]=__builtin_amdgcn_mfma_f32_32x32x16_bf16(pa1,PK(1),o[d0],0,0,0);
    o[d0]=__builtin_amdgcn_mfma_f32_32x32x16_bf16(pa2,PK(2),o[d0],0,0,0);
    o[d0]=__builtin_amdgcn_mfma_f32_32x32x16_bf16(pa3,PK(3),o[d0],0,0,0);
    #undef PK
  }
}

#ifndef ATTN_STORE16
#define ATTN_STORE16(p,v) (*(u32x4*)(p)=(v))
#endif
template<int THRL> __device__ __forceinline__ void attn_unit(int b,int h,int qb,const bf16*Q,const bf16*__restrict__ K,const bf16*__restrict__ V,bf16*O,const float*ksum,const float*nrm,char*shm){
  int tid_=threadIdx.x; asm volatile("":"+v"(tid_)); const int tid=tid_,lane=tid&63,r32=lane&31,hi=lane>>5; const int wid=__builtin_amdgcn_readfirstlane(tid>>6);
  const long rowbase=(long)b*SEQ; const int q0=qb*QB;
  const bf16*Qw=Q+(rowbase+q0+wid*QBLK)*DM+h*D;
  const bf16*Kh=K+rowbase*DM+h*D,*Vh=V+rowbase*DM+h*D;
  const unsigned lds0=(unsigned)(uintptr_t)shm;
  float*wsf=(float*)(shm+LDS_WS)+wid*64;
  const unsigned kvoff=(unsigned)(lane*DM+wid*8)*2u;
  const unsigned vvoff=(unsigned)((16*(wid&3)+(lane>>2))*DM+(wid>>2)*32+(lane&3)*8)*2u;
  const unsigned kdst=lds0+LDS_K+wid*1024, vdst=lds0+LDS_V+wid*1024;
  #define DMA_K(t,slot) glds16(Kh+(long)(NTF-1-(t))*KVBLK*DM,kvoff,(unsigned)__builtin_amdgcn_readfirstlane(kdst+(slot)))
  #define DMA_V(t,slot) glds16(Vh+(long)(NTF-1-(t))*KVBLK*DM,vvoff,(unsigned)__builtin_amdgcn_readfirstlane(vdst+(slot)))
  const int vb0=(int)(lds0+LDS_V)+((lane>>4)&1)*32+(lane&3)*8+(4*hi+((lane&15)>>2))*64;
  const char*Kbase=shm+LDS_K; bf16x8 kf[8];
  const lds_cptr shm3=(lds_cptr)shm; const lds_cptr kp0=shm3+LDS_K+hi*1024+r32*16; const lds_cptr vp0=shm3+LDS_V+((lane>>4)&1)*32+(lane&3)*8+(4*hi+((lane&15)>>2))*64;
  const int NTF=(q0+QB)/KVBLK;
  int NT=NTF;
  { const float*nq=nrm+(long)(b*2+0)*16+2*h,*nk=nrm+(long)(b*2+1)*16+2*h; const float B=__builtin_sqrtf((nq[0]+nq[1])*(nk[0]+nk[1]))*1.02f+0.5f;
    const float slope2_=__uint_as_float(0x3FB8AA3Bu-((unsigned)(h+1)<<23)); const float dh=(160.f+2.f*B)/slope2_;
    const float tminf=((float)(q0-63)-dh)*(1.f/64.f); int tmin=tminf>0.f?(int)tminf:0;
    tmin=__builtin_amdgcn_readfirstlane(tmin); int nt=NTF-tmin; nt+=nt&1; if(nt>NTF)nt=NTF; if(nt<4)nt=4; NT=nt; }
  { float*ksl=(float*)(shm+LDS_KSL); const float k0=ksum[(long)(b*16+(tid>>6))*512+h*64+(tid&63)],k1=ksum[(long)(b*16+8+(tid>>6))*512+h*64+(tid&63)]; ksl[tid]=k0; ksl[512+tid]=k1; }
  DMA_K(0,0);DMA_V(0,0);DMA_K(1,SLOTB);
  bf16x8 qr[4];
  #pragma unroll
  for(int d0=0;d0<4;++d0)qr[d0]=*reinterpret_cast<const bf16x8*>(&Qw[(long)r32*DM+d0*16+hi*8]);
  float mhat=0.f,l_reg=0.f;f32x16 o[2];o[0]=f32x16{};o[1]=f32x16{};const f32x16 zero16=f32x16{};
  const int qrel=wid*QBLK+r32;
  #define CMASK(P0,P1,t) do{int jb_=3-(t); if(jb_>=0)cmask(P0,P1,jb_,qrel,hi);}while(0)
  const unsigned sl2b=0x3FB8AA3Bu-((unsigned)(h+1)<<23);
  const float slope2=__uint_as_float(sl2b), s2x=__uint_as_float(sl2b+(1u<<23)), s8x=__uint_as_float(sl2b+(3u<<23)), s32=__uint_as_float(sl2b+(5u<<23));
  const float s3x=__uint_as_float((unsigned)__builtin_amdgcn_readfirstlane((int)__float_as_uint(slope2*3.0f)));
  #define NBSEL(r) (((r)>>2)==0?nbb0_:((r)>>2)==1?nbb1_:((r)>>2)==2?nbb2_:nbb3_)
  #define NEGV(r) ((((r)&3)==0)?NBSEL(r):(NBSEL(r)+(((r)&3)==1?slope2:((r)&3)==2?s2x:s3x)))
  #define NBB(nb) const float nbb0_=(nb), nbb1_=nbb0_+s8x, nbb2_=nbb1_+s8x, nbb3_=nbb2_+s8x
  #define NBSELC(r) (((r)>>2)==0?nbc0_:((r)>>2)==1?nbc1_:((r)>>2)==2?nbc2_:nbc3_)
  #define SAV(r) (((r)&3)==1?slope2:((r)&3)==2?s2x:s3x)
  #define BIAS(C0,C1,s) do{ NBB(NBV(s)); const float nbc0_=nbb0_+s32,nbc1_=nbb1_+s32,nbc2_=nbb2_+s32,nbc3_=nbb3_+s32; \
      _Pragma("unroll") for(int r=0;r<16;++r){ if((r&3)==0){C0[r]+=NBSEL(r);C1[r]+=NBSELC(r);} else {C0[r]=(C0[r]+NBSEL(r))+SAV(r);C1[r]=(C1[r]+NBSELC(r))+SAV(r);} } }while(0)
  unsigned sel=0u;
  #define NBV(s) ({ const int tl_=NTF-1-(s); const int tc_=tl_<0?0:tl_; const int bj_=tc_>>2; const float off_=(bj_>=qb||((sel>>bj_)&1u))?0.f:-1.0e30f; \
      __builtin_fmaf(slope2,(float)(64*tl_+4*hi-q0-qrel),off_-mhat); })
  #define CRC(r) ((float)(((r)&3)+8*((r)>>2)))
  bool resc=false;
  #define START(P0,P1) do{ const float rm=rowmax(P0,P1); resc=false; \
    { const float dl=(rm>-1.0e20f)?rm:0.f; mhat=fadd_s(mhat,dl); \
      _Pragma("unroll") for(int r=0;r<16;++r){P0[r]=fsub_s(P0[r],dl);P1[r]=fsub_s(P1[r],dl);} } \
    _Pragma("unroll") for(int r=0;r<16;++r)P0[r]=__builtin_amdgcn_exp2f(P0[r]); }while(0)
  #define RESC() do{ if(resc){ asm volatile("s_waitcnt lgkmcnt(0)":::"memory"); \
      _Pragma("unroll") for(int d_=0;d_<2;++d_) _Pragma("unroll") for(int r=0;r<16;++r)o[d_][r]*=wsf[crow(r,hi)]; } }while(0)
  f32x16 pA0,pA1,pB0,pB1;
  int sl_prev=0,sl_cur=0,sl_next=SLOTB;
  #define ROT() do{sl_prev=sl_cur;sl_cur=sl_next;sl_next=(sl_next==(NSLOT-1)*SLOTB)?0:sl_next+SLOTB;}while(0)
  DMA_K(2,2*SLOTB);
  WAIT_BAR(3);
  if(qb>0){
    float qf[32];
    _Pragma("unroll") for(int d0=0;d0<4;++d0) _Pragma("unroll") for(int e=0;e<8;++e) qf[d0*8+e]=__uint_as_float(((unsigned)(unsigned short)qr[d0][e])<<16);
    const float*ksl=(const float*)(shm+LDS_KSL)+8*hi;
    float b1=-3.0e38f,b2=-3.0e38f,b3=-3.0e38f; int i1=-1,i2=-1,i3=-1;
    for(int j=0;j<qb;++j){ float g=0.f;
      _Pragma("unroll") for(int d0=0;d0<4;++d0) _Pragma("unroll") for(int e=0;e<8;++e) g=__builtin_fmaf(qf[d0*8+e],ksl[j*64+16*d0+e],g);
      { auto rr=__builtin_amdgcn_permlane32_swap(__float_as_uint(g),__float_as_uint(g),false,false); g=__uint_as_float(rr[0])+__uint_as_float(rr[1]); }
      const bool c1=g>b1,c2=g>b2,c3=g>b3;
      b3=c2?b2:(c3?g:b3); i3=c2?i2:(c3?j:i3); b2=c1?b1:(c2?g:b2); i2=c1?i1:(c2?j:i2); b1=c1?g:b1; i1=c1?j:i1; }
    sel=(1u<<i1)|(i2>=0?(1u<<i2):0u)|(i3>=0?(1u<<i3):0u); }
  qkt(pA0,pA1,Kbase,qr,zero16,r32,hi);asm volatile("s_nop 15\n\ts_nop 7":"+v"(pA0),"+v"(pA1));
  BIAS(pA0,pA1,0);
  CMASK(pA0,pA1,0);
  START(pA0,pA1);
  _Pragma("unroll") for(int r=0;r<16;++r)pA1[r]=__builtin_amdgcn_exp2f(pA1[r]);
  WAIT_BAR(0);
  DMA_K(3,0);DMA_V(1,SLOTB);
  ROT();
  kload8(kf,kp0+sl_cur);
  WAIT_BAR(2);
  s16x4 vlo[8],vhi[8]; u32x4 pw0,pw1,pw2,pw3;
  #define PKW(P,B) cvtpk_s(P[B],P[B+1])
  #define PAF(k) __builtin_bit_cast(bf16x8,pw##k)
  #define VFR(i) (bf16x8){vlo[i][0],vlo[i][1],vlo[i][2],vlo[i][3],vhi[i][0],vhi[i][1],vhi[i][2],vhi[i][3]}
  #define PIN(x) asm volatile("":"+v"(x))
  #define MX3(a,b,c) __builtin_fmaxf(__builtin_fmaxf((a),(b)),(c))
  #define GAPA(MF,A0,A1,A2,A3,W0,W1,PW) do{ MF; sacc+=A0; sacc+=A1; sacc+=A2; sacc+=A3; PIN(sacc); W0; W1; PIN(PW); SBAR(); }while(0)
  #define EX(v) __builtin_amdgcn_exp2f(v)
  #define GAPB(MF,X,B) do{ MF; X[B]=EX(X[B]); X[B+1]=EX(X[B+1]); X[B+2]=EX(X[B+2]); X[B+3]=EX(X[B+3]); PIN(X); SBAR(); }while(0)
  #define VRD(i) do{ vlo[i]=vtr(vp_+(((i)>>2)*4096+((i)&3)*1024)); vhi[i]=vtr(vp_+(((i)>>2)*4096+((i)&3)*1024+512)); }while(0)
  #define KRD(G,j) do{ if(G){ kload2(kf,kp0+sl_next,j); SBAR(); } }while(0)
  #define STEP(C0,C1,P0,P1,t,GK,GV,GL) do{ SBAR(); \
    const lds_cptr vp_=vp0+sl_prev; \
    VRD(0); SBAR(); float sacc=(P0[0]+P0[1]); \
    GAPA(C0=__builtin_amdgcn_mfma_f32_32x32x16_bf16(kf[0],qr[0],zero16,0,0,0), P0[2],P0[3],P0[4],P0[5],     pw0[0]=PKW(P0,0), pw0[1]=PKW(P0,2), pw0); \
    VRD(4); SBAR(); GAPA(C1=__builtin_amdgcn_mfma_f32_32x32x16_bf16(kf[1],qr[0],zero16,0,0,0), P0[6],P0[7],P0[8],P0[9],     pw0[2]=PKW(P0,4), pw0[3]=PKW(P0,6), pw0); \
    VRD(1); SBAR(); GAPA(C0=__builtin_amdgcn_mfma_f32_32x32x16_bf16(kf[2],qr[1],C0,0,0,0),   P0[10],P0[11],P0[12],P0[13], pw1[0]=PKW(P0,8), pw1[1]=PKW(P0,10), pw1); \
    VRD(5); SBAR(); GAPA(C1=__builtin_amdgcn_mfma_f32_32x32x16_bf16(kf[3],qr[1],C1,0,0,0),   P0[14],P0[15],P1[0],P1[1],   pw1[2]=PKW(P0,12),pw1[3]=PKW(P0,14), pw1); \
    VRD(2); SBAR(); GAPA(C0=__builtin_amdgcn_mfma_f32_32x32x16_bf16(kf[4],qr[2],C0,0,0,0),   P1[2],P1[3],P1[4],P1[5],     pw2[0]=PKW(P1,0), pw2[1]=PKW(P1,2), pw2); \
    VRD(6); SBAR(); GAPA(C1=__builtin_amdgcn_mfma_f32_32x32x16_bf16(kf[5],qr[2],C1,0,0,0),   P1[6],P1[7],P1[8],P1[9],     pw2[2]=PKW(P1,4), pw2[3]=PKW(P1,6), pw2); \
    VRD(3); SBAR(); GAPA(C0=__builtin_amdgcn_mfma_f32_32x32x16_bf16(kf[6],qr[3],C0,0,0,0),   P1[10],P1[11],P1[12],P1[13], pw3[0]=PKW(P1,8), pw3[1]=PKW(P1,10), pw3); \
    VRD(7); SBAR(); GAPA(C1=__builtin_amdgcn_mfma_f32_32x32x16_bf16(kf[7],qr[3],C1,0,0,0),   P1[14],P1[15],0.f,0.f,       pw3[2]=PKW(P1,12),pw3[3]=PKW(P1,14), pw3); \
    l_reg+=sacc; \
    if(GK){DMA_K((t)+3,sl_cur);} if(GV){DMA_V((t)+1,sl_next);} \
    BIAS(C0,C1,t); \
    CMASK(C0,C1,t); \
    { float a=MX3(C0[0],C0[1],C1[0]),b=MX3(C0[2],C0[3],C1[1]); a=MX3(a,C1[2],C1[3]); \
      _Pragma("unroll") for(int r=4;r<16;r+=4){a=MX3(a,C0[r],C0[r+1]);b=MX3(b,C0[r+2],C0[r+3]);a=MX3(a,C1[r],C1[r+1]);b=MX3(b,C1[r+2],C1[r+3]);} \
      float rm=__builtin_fmaxf(a,b); { auto rr=__builtin_amdgcn_permlane32_swap(__float_as_uint(rm),__float_as_uint(rm),false,false); rm=__builtin_fmaxf(__uint_as_float(rr[0]),__uint_as_float(rr[1])); } \
      resc=false; \
      if(__builtin_expect(__any(rm>(float)THRL),0)){ const float dl=__builtin_fmaxf(rm,0.f); mhat+=dl; \
        _Pragma("unroll") for(int r=0;r<16;++r){C0[r]-=dl;C1[r]-=dl;} \
        const float f=__builtin_amdgcn_exp2f(-dl); l_reg*=f; if(hi==0)wsf[r32]=f; resc=true; } } \
    SBAR(); \
    GAPB(o[0]=__builtin_amdgcn_mfma_f32_32x32x16_bf16(PAF(0),VFR(0),o[0],0,0,0), C0,0); \
    GAPB(o[1]=__builtin_amdgcn_mfma_f32_32x32x16_bf16(PAF(0),VFR(4),o[1],0,0,0), C0,4); \
    KRD(GL,0); GAPB(o[0]=__builtin_amdgcn_mfma_f32_32x32x16_bf16(PAF(1),VFR(1),o[0],0,0,0), C0,8); \
    KRD(GL,1); GAPB(o[1]=__builtin_amdgcn_mfma_f32_32x32x16_bf16(PAF(1),VFR(5),o[1],0,0,0), C0,12); \
    KRD(GL,2); GAPB(o[0]=__builtin_amdgcn_mfma_f32_32x32x16_bf16(PAF(2),VFR(2),o[0],0,0,0), C1,0); \
    KRD(GL,3); GAPB(o[1]=__builtin_amdgcn_mfma_f32_32x32x16_bf16(PAF(2),VFR(6),o[1],0,0,0), C1,4); \
    GAPB(o[0]=__builtin_amdgcn_mfma_f32_32x32x16_bf16(PAF(3),VFR(3),o[0],0,0,0), C1,8); \
    GAPB(o[1]=__builtin_amdgcn_mfma_f32_32x32x16_bf16(PAF(3),VFR(7),o[1],0,0,0), C1,12); \
    }while(0)
  int t=1;
  #define ENDW(tt) do{ if((tt)+3<NT){WAIT_BAR(2);} else if((tt)+2<NT){WAIT_BAR(1);} else {WAIT_BAR(0);} }while(0)
  #define PEELED_PAIR() do{ \
    STEP(pB0,pB1,pA0,pA1,t,(t+3<NT),(t+1<NT),(t+1<NT));       ENDW(t);   RESC(); ROT(); \
    STEP(pA0,pA1,pB0,pB1,t+1,(t+4<NT),(t+2<NT),(t+2<NT));     ENDW(t+1); RESC(); ROT(); }while(0)
  for(;t<5&&t+1<NT;t+=2){ PEELED_PAIR(); }
  #undef CMASK
  #define CMASK(P0,P1,t) do{}while(0)
  for(;t+5<NT;t+=2){
    STEP(pB0,pB1,pA0,pA1,t,true,true,true);     WAIT_BAR(2); RESC(); ROT();
    STEP(pA0,pA1,pB0,pB1,t+1,true,true,true);   WAIT_BAR(2); RESC(); ROT();
  }
  #undef CMASK
  #define CMASK(P0,P1,t) do{int jb_=3-(t); if(jb_>=0)cmask(P0,P1,jb_,qrel,hi);}while(0)
  for(;t+1<NT;t+=2){ PEELED_PAIR(); }
  STEP(pB0,pB1,pA0,pA1,NT-1,false,false,false); RESC();
  { float sacc=pB0[0]+pB0[1]; _Pragma("unroll") for(int r=2;r<16;++r)sacc+=pB0[r]; _Pragma("unroll") for(int r=0;r<16;++r)sacc+=pB1[r]; l_reg+=sacc;
    pw0=(u32x4){PKW(pB0,0),PKW(pB0,2),PKW(pB0,4),PKW(pB0,6)};pw1=(u32x4){PKW(pB0,8),PKW(pB0,10),PKW(pB0,12),PKW(pB0,14)};pw2=(u32x4){PKW(pB1,0),PKW(pB1,2),PKW(pB1,4),PKW(pB1,6)};pw3=(u32x4){PKW(pB1,8),PKW(pB1,10),PKW(pB1,12),PKW(pB1,14)};
    SBAR(); pv(o,vb0+sl_cur,PAF(0),PAF(1),PAF(2),PAF(3)); }
  #undef PKW
  #undef PAF
  #undef VFR
  #undef PIN
  #undef MX3
  #undef GAPA
  #undef GAPB
  #undef EX
  #undef VRD
  #undef KRD
  #undef STEP
  #undef ENDW
  #undef PEELED_PAIR
  #undef NBV
  #undef CRC
  #undef NEGV
  #undef NBSEL
  #undef NBB
  #undef NBSELC
  #undef SAV
  #undef BIAS
  {auto rr=__builtin_amdgcn_permlane32_swap(__float_as_uint(l_reg),__float_as_uint(l_reg),false,false);l_reg=__uint_as_float(rr[0])+__uint_as_float(rr[1]);}
  if(hi==0)wsf[32+r32]=l_reg;asm volatile("s_waitcnt lgkmcnt(0)":::"memory");
  float rli[16];
  #pragma unroll
  for(int r=0;r<16;++r)rli[r]=__builtin_amdgcn_rcpf(wsf[32+crow(r,hi)]);
  bf16*Ow=O+(rowbase+q0+wid*QBLK)*DM+h*D;
  { bf16*stg=(bf16*)(shm+LDS_OST)+wid*2048;
    #pragma unroll
    for(int r=0;r<16;++r){const int orow=crow(r,hi);
      #pragma unroll
      for(int d0=0;d0<2;++d0)stg[orow*64+d0*32+r32]=__float2bfloat16(o[d0][r]*rli[r]);}
    asm volatile("s_waitcnt lgkmcnt(0)":::"memory");
    #pragma unroll
    for(int i=0;i<4;++i){const int row=i*8+(lane>>3),ch=lane&7; const u32x4 v=*(const u32x4*)(stg+row*64+ch*8); ATTN_STORE16(Ow+(long)row*DM+ch*8,v);} }
  asm volatile("s_waitcnt lgkmcnt(0)\n\ts_barrier":::"memory");
  #undef DMA_K
  #undef DMA_V
  #undef CMASK
  #undef START
  #undef RESC
  #undef ROT
}
constexpr int ATTN_LDS_BYTES=LDS_BYTES;
struct AttnTensors { const bf16* Q; const bf16* K; const bf16* V; bf16* O; };
struct AttnUnit { int bh; int qb; };
struct AttnPlan { unsigned char unit[32][12]; unsigned char n[32]; };
constexpr int attn_nominal_cost(int h,int qb){ const int pmax[8]={7,12,22,41,64,64,64,64}; const int past=4*qb<pmax[h]?4*qb:pmax[h]; return 4+past+2; }
constexpr AttnPlan make_attn_plan(){
  AttnPlan p{}; int load[32]={}; bool used[128]={};
  for(int it=0;it<128;++it){ int best=-1,bc=-1; for(int e=0;e<128;++e){ if(used[e])continue; const int c=attn_nominal_cost(e>>4,e&15); if(c>bc){bc=c;best=e;} }
    used[best]=true; int cu=0; for(int c=1;c<32;++c) if(load[c]<load[cu]||(load[c]==load[cu]&&p.n[c]<p.n[cu]))cu=c;
    if(p.n[cu]>=12){ for(int c=0;c<32;++c) if(p.n[c]<12){cu=c;break;} }
    p.unit[cu][p.n[cu]++]=(unsigned char)best; load[cu]+=bc; }
  return p; }
__device__ const AttnPlan g_attn_plan=make_attn_plan();
struct StaticOrder {
  int vcu,G;
  __device__ __forceinline__ explicit StaticOrder(int grid,int vcu_):vcu(vcu_),G(grid){}
  __device__ __forceinline__ bool next(int i,AttnUnit&u)const{
    if(G!=256){ const int id=vcu+i*G; if(id>=BATCH*NHEAD*NQB)return false; u.bh=id>>4; u.qb=id&15; return true; }
    const int c=vcu&31; if(i>=(int)g_attn_plan.n[c])return false; const int e=g_attn_plan.unit[c][i]; u.bh=(vcu>>5)*NHEAD+(e>>4); u.qb=e&15; return true; }
};
template<class Sched,int THRL=8> __device__ __forceinline__ void attn_phase(char*lds,const AttnTensors&T,const float*ksum,const float*nrm,const Sched&S){
  AttnUnit u;
  for(int i=0;S.next(i,u);++i){ attn_unit<THRL>(u.bh/NHEAD,u.bh%NHEAD,u.qb,T.Q,T.K,T.V,T.O,ksum,nrm,lds); }
}
#undef SBAR
#undef WAIT_BAR
}

__device__ __forceinline__ void pooled_phase(Frame& F, const Args& A) {
    const bf16* P = (const bf16*)(A.ws + WS_QKVP) + (size_t)3 * T * 512; bf16* PO = (bf16*)(A.ws + WS_POOLED);
    const int gw = F.vcu * NWAVES + F.wave, NGW = F.G * NWAVES, lane = F.lane, w = 2 << (lane >> 4);
    for (int tk = gw; tk < T / 16; tk += NGW) {
        const int row0 = tk * 16, s0 = row0 & (SEQ - 1);
        v4u rv[31];
#pragma unroll
        for (int i = 0; i < 31; ++i) { const int sidx = s0 - 15 + i; rv[i] = (sidx >= 0) ? *(const v4u*)(P + (size_t)(row0 - 15 + i) * 512 + 8 * lane) : (v4u){0u, 0u, 0u, 0u}; }
#pragma unroll
        for (int i = 0; i < 16; ++i) {
            const int sidx = s0 + i; float acc[8];
#pragma unroll
            for (int e = 0; e < 8; ++e) acc[e] = 0.f;
#pragma unroll
            for (int k = 0; k < 16; ++k) { const bool ok = (k < w) && (sidx - k >= 0); const v4u x = rv[15 + i - k]; const float msk = ok ? 1.0f : 0.0f;
                acc[0] += msk * bflo(x.x); acc[1] += msk * bfhi(x.x); acc[2] += msk * bflo(x.y); acc[3] += msk * bfhi(x.y); acc[4] += msk * bflo(x.z); acc[5] += msk * bfhi(x.z); acc[6] += msk * bflo(x.w); acc[7] += msk * bfhi(x.w); }
            const float inv = 1.0f / (float)min(sidx + 1, w); const v4u x = rv[15 + i];
            v4u o; o.x = pk2(acc[0] * inv - bflo(x.x), acc[1] * inv - bfhi(x.x)); o.y = pk2(acc[2] * inv - bflo(x.y), acc[3] * inv - bfhi(x.y));
            o.z = pk2(acc[4] * inv - bflo(x.z), acc[5] * inv - bfhi(x.z)); o.w = pk2(acc[6] * inv - bflo(x.w), acc[7] * inv - bfhi(x.w));
            *(v4u*)(PO + (size_t)(row0 + i) * 512 + 8 * lane) = o;
        }
    }
}

typedef float f32x2 __attribute__((ext_vector_type(2)));
typedef int v4i __attribute__((ext_vector_type(4)));
__device__ __forceinline__ void h2q_rows4(const Args& A, int t0, int lane) {
    const float* modf = (const float*)(A.ws + WS_MODF); const float* ss2 = (const float*)(A.ws + WS_SS2); const float* g2 = A.in[12];
    const int b = t0 / SEQ;
    f32x4 xv[4][4];
#pragma unroll
    for (int u = 0; u < 4; ++u)
#pragma unroll
        for (int q = 0; q < 4; ++q) xv[u][q] = *(const f32x4*)(A.out + (size_t)(t0 + u) * D + 16 * lane + 4 * q);
    f32x4 G[4], S[4];
#pragma unroll
    for (int q = 0; q < 4; ++q) { const int c = 16 * lane + 4 * q; G[q] = *(const f32x4*)(g2 + c) * (*(const f32x4*)(modf + (size_t)b * 6144 + 4096 + c) + 1.0f); S[q] = *(const f32x4*)(modf + (size_t)b * 6144 + 3072 + c); }
#pragma unroll
    for (int u = 0; u < 4; ++u) {
        const f32x4* sp = (const f32x4*)(ss2 + (size_t)(t0 + u) * 16); const f32x4 s4 = (sp[0] + sp[1]) + (sp[2] + sp[3]);
        const float rs = 1.0f / sqrtf(((s4[0] + s4[1]) + (s4[2] + s4[3])) * (1.0f / D) + RMS_EPS);
        float h2[16]; float am = 0.f;
#pragma unroll
        for (int q = 0; q < 4; ++q)
#pragma unroll
            for (int e = 0; e < 4; ++e) { const float h = xv[u][q][e] * rs * G[q][e] + S[q][e]; h2[4 * q + e] = h; am = fmaxf(am, fabsf(h)); }
        am = fmaxf(am, __shfl_xor(am, 1)); am = fmaxf(am, __shfl_xor(am, 2)); am = fmaxf(am, __shfl_xor(am, 4));
        const float hs = (am > 0.f) ? am * (1.0f / 127.0f) : 1.0f, hinv = 1.0f / hs;
        v4u o;
#pragma unroll
        for (int q = 0; q < 4; ++q) { const int q0 = (int)rintf(h2[4 * q] * hinv), q1 = (int)rintf(h2[4 * q + 1] * hinv), q2 = (int)rintf(h2[4 * q + 2] * hinv), q3 = (int)rintf(h2[4 * q + 3] * hinv);
            o[q] = (unsigned)(q0 & 255) | ((unsigned)(q1 & 255) << 8) | ((unsigned)(q2 & 255) << 16) | ((unsigned)q3 << 24); }
        *(v4u*)(A.ws + WS_H2Q + (size_t)(t0 + u) * D + 16 * lane) = o;
        if ((lane & 7) == 0) ((float*)(A.ws + WS_HS))[(size_t)(t0 + u) * 8 + (lane >> 3)] = hs;
    }
}

namespace rt {
typedef float f32x16 __attribute__((ext_vector_type(16)));
typedef short bf16x8 __attribute__((ext_vector_type(8)));
__device__ __forceinline__ void ce(float& hi, float& lo) { const float a = fmaxf(hi, lo), b = fminf(hi, lo); hi = a; lo = b; }
template <int N> __device__ __forceinline__ void sort_desc(float (&v)[N]) {
#pragma unroll
    for (int k = 2; k <= N; k <<= 1)
#pragma unroll
        for (int j = k >> 1; j > 0; j >>= 1)
#pragma unroll
            for (int i = 0; i < N; ++i) { const int l = i ^ j; if (l > i) { if ((i & k) == 0) ce(v[i], v[l]); else ce(v[l], v[i]); } }
}
__device__ __forceinline__ void sort16_desc(float (&v)[16]) {
    ce(v[0], v[13]); ce(v[1], v[12]); ce(v[2], v[15]); ce(v[3], v[14]); ce(v[4], v[8]); ce(v[5], v[6]); ce(v[7], v[11]); ce(v[9], v[10]);
    ce(v[0], v[5]); ce(v[1], v[7]); ce(v[2], v[9]); ce(v[3], v[4]); ce(v[6], v[13]); ce(v[8], v[14]); ce(v[10], v[15]); ce(v[11], v[12]);
    ce(v[0], v[1]); ce(v[2], v[3]); ce(v[4], v[5]); ce(v[6], v[8]); ce(v[7], v[9]); ce(v[10], v[11]); ce(v[12], v[13]); ce(v[14], v[15]);
    ce(v[0], v[2]); ce(v[1], v[3]); ce(v[4], v[10]); ce(v[5], v[11]); ce(v[6], v[7]); ce(v[8], v[9]); ce(v[12], v[14]); ce(v[13], v[15]);
    ce(v[1], v[2]); ce(v[3], v[12]); ce(v[4], v[6]); ce(v[5], v[7]); ce(v[8], v[10]); ce(v[9], v[11]); ce(v[13], v[14]);
    ce(v[1], v[4]); ce(v[2], v[6]); ce(v[5], v[8]); ce(v[7], v[10]); ce(v[9], v[13]); ce(v[11], v[14]);
    ce(v[2], v[4]); ce(v[3], v[6]); ce(v[9], v[12]); ce(v[11], v[13]);
    ce(v[3], v[5]); ce(v[6], v[8]); ce(v[7], v[9]); ce(v[10], v[12]);
    ce(v[3], v[4]); ce(v[5], v[6]); ce(v[7], v[8]); ce(v[9], v[10]); ce(v[11], v[12]);
    ce(v[6], v[7]); ce(v[8], v[9]);
}
template <int N> __device__ __forceinline__ void bitonic_merge_desc(float (&v)[N]) {
#pragma unroll
    for (int j = N >> 1; j > 0; j >>= 1)
#pragma unroll
        for (int i = 0; i < N; ++i) { const int l = i ^ j; if (l > i) ce(v[i], v[l]); }
}
__device__ __forceinline__ void merge_top16(float (&a)[16], const float (&b)[16]) {
#pragma unroll
    for (int i = 0; i < 16; ++i) a[i] = fmaxf(a[i], b[15 - i]);
    bitonic_merge_desc<16>(a);
}
template <bool SORT> __device__ __forceinline__ void pair_merge(float (&a)[16], bool hi) {
    float w[16];
#pragma unroll
    for (int i = 0; i < 16; ++i) w[i] = hi ? a[15 - i] : a[i];
#pragma unroll
    for (int i = 0; i < 16; ++i) { const auto rr = __builtin_amdgcn_permlane32_swap(__float_as_uint(w[i]), __float_as_uint(w[i]), false, false); a[i] = fmaxf(__uint_as_float(rr[0]), __uint_as_float(rr[1])); }
    if (SORT) bitonic_merge_desc<16>(a);
}
__device__ __forceinline__ void fold_tile(const f32x16& acc, int kt, int hi, float (&out)[16]) {
    float g[16];
#pragma unroll
    for (int r = 0; r < 16; ++r) { const unsigned key = (unsigned)(32 * kt + (r & 3) + 8 * (r >> 2)); g[r] = __uint_as_float((__float_as_uint(acc[r]) & ~127u) | key | ((unsigned)hi << 2)); }
    sort16_desc(g);
    if (kt == 0) {
#pragma unroll
        for (int r = 0; r < 16; ++r) out[r] = g[r];
    } else merge_top16(out, g);
}
}
__device__ __forceinline__ void router_phase(Frame& F, const Args& A) {
    using namespace rt;
    const bf16* QP = (const bf16*)(A.ws + WS_GAB); const bf16* SK = (const bf16*)(A.ws + WS_SUBK);
    unsigned short* IDX = (unsigned short*)(A.ws + WS_POOLED); float* GATE = (float*)(A.ws + WS_POOLED + 16 * MiB);
    const int lane = F.lane, n32 = lane & 31, hi = lane >> 5, gw = F.vcu * NWAVES + F.wave, NGW = F.G * NWAVES;
    __syncthreads();
    for (int i = F.tid; i < 2 * 128 * 16; i += NTHREADS) { const int r = i >> 4, ch = i & 15; *(LAS v4u*)(F.lds + r * 272 + ch * 16) = *(const v4u*)(SK + (size_t)r * 128 + ch * 8); }
    __syncthreads();
    LAS unsigned char* scr = F.lds + 73728 + F.wave * 1024;
    const LAS unsigned char* afrag = F.lds + n32 * 272 + hi * 16;
    bf16x8 qa[8], qb[8];
#define RT_QLOAD(task_, p_, q_) do { const int tq_ = (task_) * 4 + (n32 >> 3); const bf16* qr_ = QP + (size_t)tq_ * PQW + (n32 & 7) * 256 + (p_) * 128 + 8 * hi; \
        _Pragma("unroll") for (int i = 0; i < 8; ++i) q_[i] = __builtin_nontemporal_load((const bf16x8*)(qr_ + 16 * i)); } while (0)
#define RT_HALF(p_, q_, out_) do { _Pragma("unroll") for (int kt = 0; kt < 4; ++kt) { f32x16 acc = f32x16{}; \
        _Pragma("unroll") for (int ks = 0; ks < 8; ++ks) { const bf16x8 kf = *(const LAS bf16x8*)(afrag + ((p_) * 128 + 32 * kt) * 272 + 32 * ks); acc = __builtin_amdgcn_mfma_f32_32x32x16_bf16(kf, q_[ks], acc, 0, 0, 0); } \
        fold_tile(acc, kt, hi, out_); } pair_merge<true>(out_, hi != 0); } while (0)
    if (gw < T * PHEADS / 32) RT_QLOAD(gw, 0, qa);
#ifdef TABLES_IN_ROUTER
    int tr0 = gw; const bool late_trip = F.wave >= 4;
#define RT_TABLE_TRIP(cond_) do { if (cond_) { asm volatile("" ::: "memory"); if (tr0 < 2 * PEXP) { p0_table_trip(A, tr0, NGW, lane); tr0 += 4 * NGW; } asm volatile("" ::: "memory"); h2q_rows4(A, task * 4, lane); asm volatile("" ::: "memory"); } } while (0)
#else
#define RT_TABLE_TRIP(cond_) do { } while (0)
#endif
    for (int task = gw; task < T * PHEADS / 32; task += NGW) {
        const int t = task * 4 + (n32 >> 3), h = n32 & 7;
        float la[16], lb[16];
        RT_TABLE_TRIP(!late_trip);
        RT_QLOAD(task, 1, qb);
        RT_HALF(0, qa, la);
        { const int nxt = task + NGW; if (nxt < T * PHEADS / 32) RT_QLOAD(nxt, 0, qa); }
        RT_HALF(1, qb, lb);
        { unsigned w[4];
#pragma unroll
          for (int q = 0; q < 4; ++q) {
              const unsigned i0 = __float_as_uint(hi ? lb[4 * q] : la[4 * q]) & 127u, i1 = __float_as_uint(hi ? lb[4 * q + 1] : la[4 * q + 1]) & 127u, i2 = __float_as_uint(hi ? lb[4 * q + 2] : la[4 * q + 2]) & 127u, i3 = __float_as_uint(hi ? lb[4 * q + 3] : la[4 * q + 3]) & 127u;
              w[q] = i0 | (i1 << 8) | (i2 << 16) | (i3 << 24); }
          *(LAS v4u*)(scr + n32 * 32 + hi * 16) = (v4u){w[0], w[1], w[2], w[3]}; }
        float x[16], y[16];
#pragma unroll
        for (int i = 0; i < 16; ++i) { const float av = __uint_as_float(__float_as_uint(la[i]) & ~127u), bv = __uint_as_float(__float_as_uint(lb[i]) & ~127u); x[i] = hi ? bv : av; y[i] = hi ? av : bv; }
        float c0[16], c1[16];
        {
            const unsigned hb = (unsigned)hi << 8;
#define RT_CAND(i, j) __uint_as_float(((__float_as_uint(x[i] + y[j]) & ~511u) | (unsigned)((i) * 16 + (j))) | hb)
#define RT_DIAG(i) (hi ? -3.0e38f : RT_CAND(i, i))
            c0[0] = RT_DIAG(0);
#pragma unroll
            for (int j = 1; j < 16; ++j) c0[j] = RT_CAND(0, j);
            c1[0] = RT_DIAG(1);
#pragma unroll
            for (int j = 2; j < 8; ++j) c1[j - 1] = RT_CAND(1, j);
            c1[7] = RT_DIAG(2); c1[8] = RT_CAND(2, 3); c1[9] = RT_CAND(2, 4); c1[10] = RT_DIAG(3);
#pragma unroll
            for (int k = 11; k < 16; ++k) c1[k] = -3.0e38f;
#undef RT_CAND
#undef RT_DIAG
        }
        sort16_desc(c0); sort16_desc(c1); merge_top16(c0, c1);
        pair_merge<false>(c0, hi != 0);
        float mx = c0[0];
#pragma unroll
        for (int i = 1; i < 16; ++i) mx = fmaxf(mx, c0[i]);
        float ex[16], sm = 0.f;
#pragma unroll
        for (int i = 0; i < 16; ++i) { ex[i] = __expf(__uint_as_float(__float_as_uint(c0[i]) & ~511u) - mx); sm += ex[i]; }
        const float inv = 1.0f / sm;
        asm volatile("s_waitcnt lgkmcnt(0)" ::: "memory");
        int eo[8]; float go[8];
#pragma unroll
        for (int k = 0; k < 8; ++k) { const float wv = hi ? c0[8 + k] : c0[k]; go[k] = (hi ? ex[8 + k] : ex[k]) * inv;
            const unsigned bits = __float_as_uint(wv), fromhi = (bits >> 8) & 1u, xi = (bits >> 4) & 15u, yj = bits & 15u;
            const unsigned ar = fromhi ? yj : xi, br = fromhi ? xi : yj;
            const unsigned e1 = scr[n32 * 32 + ar], e2 = scr[n32 * 32 + 16 + br];
            eo[k] = (int)(e1 * 128u + e2); }
        unsigned short* ip = IDX + (size_t)t * PSEL + h * PTOP + 8 * hi; float* gp = GATE + (size_t)t * PSEL + h * PTOP + 8 * hi;
        *(v4u*)ip = (v4u){(unsigned)eo[0] | ((unsigned)eo[1] << 16), (unsigned)eo[2] | ((unsigned)eo[3] << 16), (unsigned)eo[4] | ((unsigned)eo[5] << 16), (unsigned)eo[6] | ((unsigned)eo[7] << 16)};
        *(f32x4*)gp = (f32x4){go[0], go[1], go[2], go[3]}; *(f32x4*)(gp + 4) = (f32x4){go[4], go[5], go[6], go[7]};
        asm volatile("s_waitcnt lgkmcnt(0)" ::: "memory");
        RT_TABLE_TRIP(late_trip);
    }
#ifdef TABLES_IN_ROUTER
    while (tr0 < 2 * PEXP) { p0_table_trip(A, tr0, NGW, lane); tr0 += 4 * NGW; }
#endif
#undef RT_TABLE_TRIP
#undef RT_QLOAD
#undef RT_HALF
    __syncthreads();
}

__device__ __forceinline__ float gelu_tanh(float x) { const float u = 0.7978845608028654f * (x + 0.044715f * x * x * x); return x / (1.0f + __expf(-2.0f * u)); }
__device__ __forceinline__ void peer_sliced_phase(Frame& F, const Args& A) {
    const int lane = F.lane, c8 = lane & 7, g8 = lane >> 3, gw = F.vcu * NWAVES + F.wave, NGW = F.G * NWAVES;
    const float* modf = (const float*)(A.ws + WS_MODF);
    const unsigned char* U8 = A.ws + WS_U; const unsigned char* V8 = A.ws + WS_V;
    const f32x2* SUV = (const f32x2*)(A.ws + WS_U + 16 * MiB);
    const unsigned short* IDX = (const unsigned short*)(A.ws + WS_POOLED); const float* GATE = (const float*)(A.ws + WS_POOLED + 16 * MiB);
    const float* gf = A.in[17];
    LAS float* AL = (LAS float*)(F.lds + F.wave * 17664);
    LAS float* SSQ = AL + 2048;
    LAS float* SAV = AL + 3072;
    LAS float* RS2 = AL + 3088;
    LAS float* GS = AL + 3104;
    LAS unsigned short* IDL = (LAS unsigned short*)(AL + 3360);
    for (int tb = gw * 16; tb < T; tb += NGW * 16) {
        for (int i = lane; i < 2048; i += 64) AL[i] = 0.f;
        for (int i = lane; i < 1024; i += 64) SSQ[i] = 0.f;
#pragma unroll
        for (int i = 0; i < 16; ++i) *(LAS unsigned*)(IDL + i * 128 + 2 * lane) = *(const unsigned*)(IDX + (size_t)(tb + i) * PSEL + 2 * lane);
        LDS_WAIT();
        {
            v4i W0[16], W1[16], H0, H1, H; float hs0, hs1, hs;
            const unsigned char* H2Q = A.ws + WS_H2Q; const float* HS = (const float*)(A.ws + WS_HS);
#define PU_X(k, Hx, hx) do { const int k_ = (k) < 128 ? (k) : 127; const int s_ = k_ >> 4, t_ = tb + (k_ & 15); Hx = *(const v4i*)(H2Q + (size_t)t_ * D + 128 * s_ + 16 * c8); hx = HS[(size_t)t_ * 8 + s_]; } while (0)
#define PU_B(k, W) do { const int k_ = (k) < 128 ? (k) : 127; const int s_ = k_ >> 4; const unsigned base_ = ((unsigned)s_ << 21) + 16u * (unsigned)c8; v4u I[2]; I[0] = *(const LAS v4u*)(IDL + (k_ & 15) * 128 + 16 * g8); I[1] = *(const LAS v4u*)(IDL + (k_ & 15) * 128 + 16 * g8 + 8); \
            _Pragma("unroll") for (int j = 0; j < 16; ++j) W[j] = *(const v4i*)(U8 + (base_ + (((I[j >> 3][(j >> 1) & 3] >> (16 * (j & 1))) & 0xffffu) << 7))); \
            } while (0)
#define PU_Q(k, Hx, hx) do { H = Hx; hs = hx; } while (0)
#define PU_C(k, W) do { int part[16]; \
            _Pragma("unroll") for (int j = 0; j < 16; ++j) part[j] = __builtin_amdgcn_sdot4(W[j].x, H.x, __builtin_amdgcn_sdot4(W[j].y, H.y, __builtin_amdgcn_sdot4(W[j].z, H.z, __builtin_amdgcn_sdot4(W[j].w, H.w, 0, false), false), false), false); \
            _Pragma("unroll") for (int step = 4; step >= 1; step >>= 1) { const bool up = (lane & step) != 0; \
                _Pragma("unroll") for (int i = 0; i < 2 * step; ++i) { const int send = up ? part[i] : part[i + 2 * step], keep = up ? part[i + 2 * step] : part[i]; part[i] = keep + __shfl_xor(send, step); } } \
            LAS f32x2* ap_ = (LAS f32x2*)(AL + ((k) & 15) * 128 + 2 * lane); f32x2 a_ = *ap_; a_.x += hs * (float)part[0]; a_.y += hs * (float)part[1]; *ap_ = a_; } while (0)
            PU_X(0, H0, hs0); PU_X(1, H1, hs1); PU_B(0, W0);
#pragma unroll 1
            for (int k = 0; k < 128; k += 2) {
                PU_Q(k, H0, hs0); PU_B(k + 1, W1); PU_X(k + 2, H0, hs0);
                PU_C(k, W0);
                PU_Q(k + 1, H1, hs1); PU_B(k + 2, W0); PU_X(k + 3, H1, hs1);
                PU_C(k + 1, W1);
            }
#undef PU_X
#undef PU_B
#undef PU_Q
#undef PU_C
        }
        LDS_WAIT();
#pragma unroll 4
        for (int i = 0; i < 16; ++i) {
            const int t = tb + i; const unsigned e01 = *(const LAS unsigned*)(IDL + i * 128 + 2 * lane); const int e0 = (int)(e01 & 0xffffu), e1 = (int)(e01 >> 16);
            const f32x2 gt = *(const f32x2*)(GATE + (size_t)t * PSEL + 2 * lane); const f32x2 a = *(LAS f32x2*)(AL + i * 128 + 2 * lane);
            const f32x2 s0 = SUV[e0], s1 = SUV[e1];
            f32x2 av; av.x = gelu_tanh(a.x * s0.x) * gt.x * s0.y; av.y = gelu_tanh(a.y * s1.x) * gt.y * s1.y;
            const float am = wave_max(fmaxf(fabsf(av.x), fabsf(av.y))); const float as = (am > 0.f) ? am * (1.0f / 127.0f) : 1.0f, ainv = 1.0f / as;
            const int q0 = (int)rintf(av.x * ainv), q1 = (int)rintf(av.y * ainv);
            *(LAS unsigned short*)((LAS unsigned char*)AL + i * 512 + 2 * lane) = (unsigned short)((unsigned)(q0 & 255) | ((unsigned)(q1 & 255) << 8));
            if (lane == 0) SAV[i] = as;
        }
        LDS_WAIT();
        {
            v4u W0[16], W1[16]; f32x2 X0, X1, gt2v = (f32x2){0.f, 0.f};
            const int b = tb / SEQ;
#define PV_B(k, W, X) do { const int k_ = (k) < 128 ? (k) : 127; const int s_ = k_ >> 4, t_ = tb + (k_ & 15); const unsigned base_ = ((unsigned)s_ << 21) + 16u * (unsigned)c8; v4u I[2]; I[0] = *(const LAS v4u*)(IDL + (k_ & 15) * 128 + 16 * g8); I[1] = *(const LAS v4u*)(IDL + (k_ & 15) * 128 + 16 * g8 + 8); \
            _Pragma("unroll") for (int j = 0; j < 16; ++j) W[j] = *(const v4u*)(V8 + (base_ + (((I[j >> 3][(j >> 1) & 3] >> (16 * (j & 1))) & 0xffffu) << 7))); \
            X = __builtin_nontemporal_load((const f32x2*)(A.out + (size_t)t_ * D + 128 * s_ + 16 * c8 + 2 * g8)); } while (0)
#define PV_D(W, q4, d, cm) do { const unsigned r0 = W[4 * (q4)].cm, r1 = W[4 * (q4) + 1].cm, r2 = W[4 * (q4) + 2].cm, r3 = W[4 * (q4) + 3].cm; \
                    const unsigned t0 = __builtin_amdgcn_perm(r1, r0, 0x05010400u), t1 = __builtin_amdgcn_perm(r1, r0, 0x07030602u), t2 = __builtin_amdgcn_perm(r3, r2, 0x05010400u), t3 = __builtin_amdgcn_perm(r3, r2, 0x07030602u); \
                    pi[4 * d] = __builtin_amdgcn_sdot4((int)__builtin_amdgcn_perm(t2, t0, 0x05040100u), aq, pi[4 * d], false); pi[4 * d + 1] = __builtin_amdgcn_sdot4((int)__builtin_amdgcn_perm(t2, t0, 0x07060302u), aq, pi[4 * d + 1], false); \
                    pi[4 * d + 2] = __builtin_amdgcn_sdot4((int)__builtin_amdgcn_perm(t3, t1, 0x05040100u), aq, pi[4 * d + 2], false); pi[4 * d + 3] = __builtin_amdgcn_sdot4((int)__builtin_amdgcn_perm(t3, t1, 0x07060302u), aq, pi[4 * d + 3], false); } while (0)
#define PV_Q(W, q4, acm) do { const int aq = (int)a4_.acm; PV_D(W, q4, 0, x); PV_D(W, q4, 1, y); PV_D(W, q4, 2, z); PV_D(W, q4, 3, w); } while (0)
#define PV_C(k, W, X) do { const int s_ = (k) >> 4, i_ = (k) & 15; \
            if (i_ == 0) gt2v = *(const f32x2*)(modf + (size_t)b * 6144 + 5120 + 128 * s_ + 16 * c8 + 2 * g8); \
            int pi[16]; _Pragma("unroll") for (int q = 0; q < 16; ++q) pi[q] = 0; \
            const v4u a4_ = *(const LAS v4u*)((const LAS unsigned char*)AL + i_ * 512 + 16 * g8); \
            PV_Q(W, 0, x); PV_Q(W, 1, y); PV_Q(W, 2, z); PV_Q(W, 3, w); \
            float pc[16]; _Pragma("unroll") for (int q = 0; q < 16; ++q) pc[q] = (float)pi[q];        \
            _Pragma("unroll") for (int step = 4; step >= 1; step >>= 1) { const bool up = (g8 & step) != 0; \
                _Pragma("unroll") for (int i = 0; i < 2 * step; ++i) { const float send = up ? pc[i] : pc[i + 2 * step], keep = up ? pc[i + 2 * step] : pc[i]; pc[i] = keep + __shfl_xor(send, 8 * step); } } \
            const float sav_ = SAV[i_]; f32x2 x2_; x2_.x = X.x + gt2v.x * (sav_ * pc[0]); x2_.y = X.y + gt2v.y * (sav_ * pc[1]); \
            *(f32x2*)(A.out + (size_t)(tb + i_) * D + 128 * s_ + 16 * c8 + 2 * g8) = x2_; \
            SSQ[i_ * 64 + lane] += x2_.x * x2_.x + x2_.y * x2_.y; } while (0)
            PV_B(0, W0, X0);
#pragma unroll 1
            for (int k = 0; k < 128; k += 2) {
                PV_B(k + 1, W1, X1);
                PV_C(k, W0, X0);
                PV_B(k + 2, W0, X0);
                PV_C(k + 1, W1, X1);
            }
#undef PV_B
#undef PV_C
#undef PV_D
#undef PV_Q
        }
        VM_WAIT(); LDS_WAIT();
#pragma unroll 2
        for (int i = 0; i < 16; ++i) {
            float* xr = A.out + (size_t)(tb + i) * D + 16 * lane;
            f32x4 v[4];
#pragma unroll
            for (int q = 0; q < 4; ++q) v[q] = __builtin_nontemporal_load((const f32x4*)(xr + 4 * q));
            const float rs = 1.0f / sqrtf(wave_sum(SSQ[i * 64 + lane]) * (1.0f / D) + RMS_EPS);
#pragma unroll
            for (int q = 0; q < 4; ++q) *(f32x4*)(xr + 4 * q) = v[q] * rs * *(const f32x4*)(gf + 16 * lane + 4 * q);
        }
        LDS_WAIT();
    }
}

#ifndef PHASE_ONLY
#define PHASE_ONLY -1
#endif
#ifndef PHASE_SKIP
#define PHASE_SKIP -2
#endif
#define PH(n) ((PHASE_ONLY < 0 || PHASE_ONLY == (n)) && PHASE_SKIP != (n))
#ifndef PROBE_DOUBLE
#define PROBE_DOUBLE -1
#endif
#define REPS(n) for (int rep_ = 0; rep_ < ((PROBE_DOUBLE == (n)) ? 2 : 1); ++rep_)
__global__ void __launch_bounds__(NTHREADS, 2) fwd_megakernel(Args A) {
    extern __shared__ __attribute__((aligned(16))) unsigned char lds[];
    Frame F;
    F.lds = (LAS unsigned char*)lds;
    F.MISC = (volatile LAS unsigned*)(F.lds + MISC_OFF);
    F.tid = threadIdx.x; F.lane = F.tid & 63; F.wave = __builtin_amdgcn_readfirstlane(F.tid >> 6);
    F.G = gridDim.x; { const int bx = blockIdx.x; F.vcu = (F.G % 8 == 0) ? (bx % 8) * (F.G / 8) + bx / 8 : bx; }
    F.ctl = (gu32*)(A.ws + WS_CTL);
    for (int u = F.tid; u < (LDS_BYTES - LDSCTL_OFF) / 4; u += NTHREADS) ((LAS unsigned*)(F.lds + LDSCTL_OFF))[u] = 0u;
    __syncthreads();
    XcdBarrier bar = xcd_barrier_post((unsigned*)(F.ctl + CW_BAR), F.MISC + 8);
#define GRID_BAR() do { xcd_barrier(bar); int t_ = threadIdx.x; asm volatile("" : "+v"(t_)); F.tid = t_; F.lane = t_ & 63; F.wave = __builtin_amdgcn_readfirstlane(t_ >> 6); } while (0)
    unsigned char* ws = A.ws;

    REPS(0) if (PH(0)) { p0a_mod(F, A); p0b_prologue<0>(F, A); }
    GRID_BAR();
    REPS(1) if (PH(1)) p0b_prologue<1>(F, A);
    GRID_BAR();
    REPS(2) if (PH(2)) {
        pg8::Gemm g{(const bf16*)(ws + WS_XG), nullptr, (const bf16*)(ws + WS_WIN), nullptr, D, D, D};
        pg8::StaticOrder S; S.init(T, INW, F.G, (int)blockIdx.x);
        pg8::EpiIn E{(bf16*)(ws + WS_QKVP), (bf16*)(ws + WS_GAB), (const float*)(ws + WS_RSTD1), (const float*)(ws + WS_BIAS1P), (float*)(ws + WS_KSUM), (unsigned*)(ws + WS_CTL) + CW_NRM};
        pg8::gemm_phase<pg8::EpiIn, pg8::StaticOrder, true, true>(F.lds + RING_OFF, g, S, E);
    }
    GRID_BAR();
    REPS(3) if (PH(3)) {
        const attn_body::AttnTensors AT{(const attn_body::bf16*)(ws + WS_QKVP), (const attn_body::bf16*)(ws + WS_QKVP) + (size_t)T * 512, (const attn_body::bf16*)(ws + WS_QKVP) + (size_t)2 * T * 512, (PROBE_DOUBLE == 3 && rep_ == 0) ? (attn_body::bf16*)(ws + WS_XG) : (attn_body::bf16*)(ws + WS_QKVP)};
        const attn_body::StaticOrder S((int)F.G, F.vcu);
        attn_body::attn_phase<attn_body::StaticOrder>((char*)lds + RING_OFF, AT, (const float*)(ws + WS_KSUM), (const float*)((const unsigned*)(ws + WS_CTL) + CW_NRM), S);
    }
    REPS(4) if (PH(4)) pooled_phase(F, A);
    GRID_BAR();
    REPS(5) if (PH(5)) {
        pg8::Gemm g{(const bf16*)(ws + WS_QKVP), (const bf16*)(ws + WS_POOLED), (const bf16*)(ws + WS_WA), (const bf16*)(ws + WS_WP), AW, AW, AW};
        pg8::DualOrder S; S.init(T, D, F.G, (int)blockIdx.x);
        pg8::EpiUp E{(bf16*)(ws + WS_XG), (const bf16*)(ws + WS_GAB), (const float*)(ws + WS_BPRIME)};
        pg8::gemm_phase<pg8::EpiUp, pg8::DualOrder, true, true>(F.lds + RING_OFF, g, S, E);
    }
    GRID_BAR();
    REPS(6) if (PH(6)) {
        pg8::Gemm g{(const bf16*)(ws + WS_XG), nullptr, (const bf16*)(ws + WS_WOUT), nullptr, D, D, D};
        pg8::StaticOrder S; S.init(T, D, F.G, (int)blockIdx.x);
        pg8::EpiOut E{A.in[0], A.out, (bf16*)(ws + WS_QKVP), (const float*)(ws + WS_MODF), A.in[12], (float*)(ws + WS_SS2)};
        pg8::gemm_phase<pg8::EpiOut, pg8::StaticOrder, true, true>(F.lds + RING_OFF, g, S, E);
    }
    GRID_BAR();
    REPS(7) if (PH(7)) {
        pg8::Gemm g{(const bf16*)(ws + WS_QKVP), nullptr, (const bf16*)(ws + WS_WQ), nullptr, D, D, D};
        pg8::StaticOrder S; S.init(T, PQW, F.G, (int)blockIdx.x);
        pg8::EpiPq E{(bf16*)(ws + WS_GAB), (const float*)(ws + WS_SS2), (const float*)(ws + WS_BIAS2P)};
        pg8::gemm_phase<pg8::EpiPq, pg8::StaticOrder, true, true>(F.lds + RING_OFF, g, S, E);
    }
    GRID_BAR();
    REPS(8) if (PH(8)) router_phase(F, A);
    GRID_BAR();
    if (PH(9)) peer_sliced_phase(F, A);
}

extern "C" void kernel_launch(void* const* d_in, const int* in_sizes, int n_in, void* d_out, int out_size, void* d_ws, size_t ws_size, hipStream_t stream) {
    static int grid = 0;
    if (grid == 0) {
        if (n_in != 18 || in_sizes[0] != T * D || out_size != T * D || ws_size < WS_END) { fprintf(stderr, "kernel_launch: unexpected shapes (n_in %d, in0 %d, out %d, ws %zu); nothing launched\n", n_in, n_in > 0 ? in_sizes[0] : -1, out_size, ws_size); grid = -1; return; }
        int dev = 0, cus = 0, per_cu = 0;
        if (hipGetDevice(&dev) != hipSuccess || hipDeviceGetAttribute(&cus, hipDeviceAttributeMultiprocessorCount, dev) != hipSuccess) { grid = -1; return; }
        if (hipFuncSetAttribute((const void*)fwd_megakernel, hipFuncAttributeMaxDynamicSharedMemorySize, LDS_BYTES) != hipSuccess) { fprintf(stderr, "kernel_launch: hipFuncSetAttribute failed\n"); grid = -1; return; }
        if (hipOccupancyMaxActiveBlocksPerMultiprocessor(&per_cu, (const void*)fwd_megakernel, NTHREADS, LDS_BYTES) != hipSuccess || per_cu < 1) { fprintf(stderr, "kernel_launch: occupancy query reports %d workgroups per CU\n", per_cu); per_cu = 1; }
        (void)hipGetLastError();
        grid = cus;
    }
    if (grid < 0) return;
    if (hipMemsetAsync((char*)d_ws + WS_CTL, 0, CTL_ZERO_BYTES, stream) != hipSuccess) { fprintf(stderr, "kernel_launch: hipMemsetAsync failed\n"); return; }
    Args a{};
    for (int i = 0; i < 18; ++i) a.in[i] = (const float*)d_in[i];
    a.out = (float*)d_out; a.ws = (unsigned char*)d_ws;
    void* kargs[] = {&a};
    hipError_t e = hipLaunchCooperativeKernel((const void*)fwd_megakernel, dim3(grid), dim3(NTHREADS), kargs, LDS_BYTES, stream);
    if (e != hipSuccess) fprintf(stderr, "kernel_launch: cooperative launch failed: %s (grid %d)\n", hipGetErrorString(e), grid);
}
```

```cpp
#define TABLES_IN_ROUTER 1
#include <hip/hip_runtime.h>
#include <hip/hip_bf16.h>
#include <cstdio>
#include <cstdint>
#include <cmath>

constexpr int NB = 8, SEQ = 4096, T = NB * SEQ, D = 1024;
constexpr int AW = 512, PW = 512, INW = 4096;
constexpr int NH = 8, HD = 64, MBLK = 256, NBLK = SEQ / MBLK;
constexpr int PQW = 2048, PEXP = 16384, PTOP = 16, PHEADS = 8, PSEL = PHEADS * PTOP;
constexpr float RMS_EPS = 1e-6f;
constexpr float LOG2E = 1.4426950408889634f;
constexpr float QSCALE = 0.125f * LOG2E;
constexpr int NWAVES = 8, NTHREADS = 512;

namespace pg8 {
#define PG8_LAS __attribute__((address_space(3)))
typedef unsigned short bf16_t;
typedef short bf16x8 __attribute__((ext_vector_type(8)));
typedef float f32x4 __attribute__((ext_vector_type(4)));
typedef unsigned u32x4 __attribute__((ext_vector_type(4)));
constexpr int BM = 256, BK = 64, HALF = 128, HTB = HALF * BK * 2  , STAGE_BYTES = 8 * HTB, NXCD = 8, WGM = 8;

__host__ __device__ __forceinline__ int lds_byte(int r, int c) { const int st = (r >> 4) * 2 + (c >> 5), rr = r & 15, cc = c & 31, ob = rr * 64 + cc * 2; return st * 1024 + (ob ^ (((ob >> 9) & 1) << 5)); }
__host__ __device__ __forceinline__ void stage_rc(int b, int& R, int& C) { const int st = b / 1024, sb = b % 1024, swz = sb ^ (((sb >> 9) & 1) << 5); R = (st >> 1) * 16 + swz / 64; C = (st & 1) * 32 + (swz % 64) / 2; }
__host__ __device__ __forceinline__ int perm32(int rho) { const int n = rho >> 4, i = rho & 15; return 8 * (i >> 2) + 4 * n + (i & 3); }

struct Unit { int pm, pn, part; };
struct Gemm {
    const bf16_t* A0; const bf16_t* A1; const bf16_t* B0; const bf16_t* B1; int lda, ldb, K;
    __device__ __forceinline__ const char* a_ptr(const Unit& u) const { return (const char*)(u.part ? A1 : A0) + (size_t)u.pm * BM * lda * 2; }
    __device__ __forceinline__ const char* b_ptr(const Unit& u) const { return (const char*)(u.part ? B1 : B0) + (size_t)u.pn * BM * ldb * 2; }
};

struct StaticOrder {
    int nM, nN, nwg, G, c;
    __host__ __device__ void init(int M, int N, int G_, int c_) { nM = M / BM; nN = N / BM; nwg = nM * nN; G = G_; c = c_; }
    __host__ __device__ bool tile(long L, Unit& u) const {
        if (L >= nwg) return false;
        int wgid = (int)L; { const int q = nwg / NXCD, r = nwg % NXCD, xcd = wgid % NXCD, off = wgid / NXCD; wgid = (xcd < r ? xcd * (q + 1) : r * (q + 1) + (xcd - r) * q) + off; }
        const int nig = WGM * nN, gid = wgid / nig, fm = gid * WGM, gsz = (nM - fm) < WGM ? (nM - fm) : WGM;
        u.pm = fm + ((wgid % nig) % gsz); u.pn = (wgid % nig) / gsz; u.part = 0; return true;
    }
    __host__ __device__ bool next(int i, Unit& u) const { return tile((long)i * G + c, u); }
    __device__ __forceinline__ void a_ready(const Unit&) const {}
    __device__ __forceinline__ void done(const Unit&) const {}
};
struct DualOrder {
    StaticOrder so;
    __host__ __device__ void init(int M, int N, int G_, int c_) { so.init(M, N, G_, c_); }
    __host__ __device__ bool next(int i, Unit& u) const { if (!so.tile((long)(i >> 1) * so.G + so.c, u)) return false; u.part = i & 1; return true; }
    __device__ __forceinline__ void a_ready(const Unit&) const {}
    __device__ __forceinline__ void done(const Unit&) const {}
};

__device__ __forceinline__ unsigned cvt_pk_bf16(float lo, float hi) { unsigned r; asm volatile("v_cvt_pk_bf16_f32 %0, %1, %2" : "=v"(r) : "v"(lo), "v"(hi)); return r; }
__device__ __forceinline__ float bf_lo(unsigned w) { return __uint_as_float(w << 16); }
__device__ __forceinline__ float bf_hi(unsigned w) { return __uint_as_float(w & 0xffff0000u); }
__device__ __forceinline__ float sigmoidf_(float x) { return __builtin_amdgcn_rcpf(1.0f + __builtin_amdgcn_exp2f(-x * 1.4426950408889634f)); }


struct EpiIn {
    static constexpr bool PERM = true, AFTER_DRAIN = false, KEEP_ACC = false;
    bf16_t* QKVP; bf16_t* GAB; const float* rstd1; const float* bias1p; float* ksum; unsigned* nrm;
    __device__ __forceinline__ void operator()(const f32x4 (&acc)[2][2][4][2], const Unit& u, int wr, int wc, int fr, int fq) const {
        bf16_t* base; int ldc, col0;
        if (u.pn < 8) { base = QKVP + (size_t)(u.pn >> 1) * T * 512; ldc = 512; col0 = (u.pn & 1) * 256; }
        else { base = GAB + (size_t)((u.pn - 8) >> 2) * T * 1024; ldc = 1024; col0 = ((u.pn - 8) & 3) * 256; }
        const float sc = (u.pn < 2) ? QSCALE : 1.0f;
        const int b = u.pm >> 4;
        const int bcol = u.pn * 256 + wc * 32 + 8 * fq;
        f32x4 bv[2][2];
#pragma unroll
        for (int bj = 0; bj < 2; ++bj)
#pragma unroll
            for (int n = 0; n < 2; ++n) { f32x4 s = (f32x4){0.f, 0.f, 0.f, 0.f};
#pragma unroll
                for (int kc = 0; kc < 8; ++kc) s += *(const f32x4*)(bias1p + (size_t)(kc * 8 + b) * INW + bcol + bj * HALF + 4 * n);
                bv[bj][n] = s; }
        const bool isk = (u.pn == 2 || u.pn == 3); const bool isqk = (u.pn < 4); float nmax[2] = {0.f, 0.f};
        f32x4 ks[2][2];
#pragma unroll
        for (int bj = 0; bj < 2; ++bj)
#pragma unroll
            for (int n = 0; n < 2; ++n) ks[bj][n] = (f32x4){0.f, 0.f, 0.f, 0.f};
        const int row0 = u.pm * BM + wr * 64 + fr;
#pragma unroll
        for (int ai = 0; ai < 2; ++ai)
#pragma unroll
            for (int m = 0; m < 4; ++m) { const int row = row0 + ai * HALF + m * 16; const float rs = rstd1[row];
                bf16_t* rowp = base + (size_t)row * ldc + col0 + wc * 32 + 8 * fq;
#pragma unroll
                for (int bj = 0; bj < 2; ++bj) { f32x4 v0 = acc[ai][bj][m][0] * rs + bv[bj][0], v1 = acc[ai][bj][m][1] * rs + bv[bj][1];
                    ks[bj][0] += v0; ks[bj][1] += v1;
                    v0 = v0 * sc; v1 = v1 * sc;
                    if (isqk) { float ss = (v0[0] * v0[0] + v0[1] * v0[1]) + (v0[2] * v0[2] + v0[3] * v0[3]) + (v1[0] * v1[0] + v1[1] * v1[1]) + (v1[2] * v1[2] + v1[3] * v1[3]); ss += __shfl_xor(ss, 16); ss += __shfl_xor(ss, 32); nmax[bj] = fmaxf(nmax[bj], ss); }
                    u32x4 w; w.x = cvt_pk_bf16(v0[0], v0[1]); w.y = cvt_pk_bf16(v0[2], v0[3]); w.z = cvt_pk_bf16(v1[0], v1[1]); w.w = cvt_pk_bf16(v1[2], v1[3]);
                    *(u32x4*)(rowp + bj * HALF) = w; } }
        if (isqk) {
#pragma unroll
            for (int bj = 0; bj < 2; ++bj) { float v = nmax[bj]; v = fmaxf(v, __shfl_xor(v, 1)); v = fmaxf(v, __shfl_xor(v, 2)); v = fmaxf(v, __shfl_xor(v, 4)); v = fmaxf(v, __shfl_xor(v, 8));
                if (fr == 0 && fq == 0) atomicMax(nrm + (size_t)(b * 2 + (u.pn >> 1)) * 16 + (u.pn & 1) * 8 + bj * 4 + wc, __float_as_uint(v)); }
        }
        if (isk) {
#pragma unroll
            for (int bj = 0; bj < 2; ++bj)
#pragma unroll
                for (int n = 0; n < 2; ++n)
#pragma unroll
                    for (int e = 0; e < 4; ++e) { float v = ks[bj][n][e]; v += __shfl_xor(v, 1); v += __shfl_xor(v, 2); v += __shfl_xor(v, 4); v += __shfl_xor(v, 8); ks[bj][n][e] = v; }
            if (fr == 0) { float* kp = ksum + (size_t)u.pm * 512 + (u.pn - 2) * 256 + wc * 32 + 8 * fq;
#pragma unroll
                for (int bj = 0; bj < 2; ++bj)
#pragma unroll
                    for (int n = 0; n < 2; ++n)
#pragma unroll
                        for (int e = 0; e < 4; ++e) atomicAdd(kp + bj * HALF + 4 * n + e, ks[bj][n][e]); }
        }
    }
};

struct EpiUp {
    static constexpr bool PERM = true, AFTER_DRAIN = false, KEEP_ACC = true;
    bf16_t* merged; const bf16_t* GAB; const float* bprime;
    static __device__ __forceinline__ float e_neg(float g) { return __builtin_amdgcn_exp2f(-g * 1.4426950408889634f); }
    static __device__ __forceinline__ float ratio(float ga, float gb) { return (1.0f + e_neg(fmaxf(gb, -60.0f))) * __builtin_amdgcn_rcpf(1.0f + e_neg(ga)); }
    static __device__ __forceinline__ float sigb(float gb) { return __builtin_amdgcn_rcpf(1.0f + e_neg(fmaxf(gb, -60.0f))); }
    __device__ __forceinline__ void operator()(f32x4 (&acc)[2][2][4][2], const Unit& u, int wr, int wc, int fr, int fq) const {
        const int row0 = u.pm * BM + wr * 64 + fr, colb = u.pn * BM + wc * 32 + 8 * fq;
        const bf16_t* ga = GAB; const bf16_t* gb = GAB + (size_t)T * 1024;
        if (u.part == 0) {
#pragma unroll
            for (int ai = 0; ai < 2; ++ai) {
                u32x4 apre[4][2], bpre[4][2];
#pragma unroll
                for (int m = 0; m < 4; ++m) { const size_t off = (size_t)(row0 + ai * HALF + m * 16) * 1024 + colb;
#pragma unroll
                    for (int bj = 0; bj < 2; ++bj) { apre[m][bj] = __builtin_nontemporal_load((const u32x4*)(ga + off + bj * HALF)); bpre[m][bj] = *(const u32x4*)(gb + off + bj * HALF); } }
#pragma unroll
                for (int m = 0; m < 4; ++m)
#pragma unroll
                    for (int bj = 0; bj < 2; ++bj) { const u32x4 aw = apre[m][bj], bw = bpre[m][bj];
                        f32x4& v0 = acc[ai][bj][m][0]; f32x4& v1 = acc[ai][bj][m][1];
                        v0[0] *= ratio(bf_lo(aw.x), bf_lo(bw.x)); v0[1] *= ratio(bf_hi(aw.x), bf_hi(bw.x)); v0[2] *= ratio(bf_lo(aw.y), bf_lo(bw.y)); v0[3] *= ratio(bf_hi(aw.y), bf_hi(bw.y));
                        v1[0] *= ratio(bf_lo(aw.z), bf_lo(bw.z)); v1[1] *= ratio(bf_hi(aw.z), bf_hi(bw.z)); v1[2] *= ratio(bf_lo(aw.w), bf_lo(bw.w)); v1[3] *= ratio(bf_hi(aw.w), bf_hi(bw.w)); }
            }
            return;
        }
        f32x4 bv[2][2];
#pragma unroll
        for (int bj = 0; bj < 2; ++bj)
#pragma unroll
            for (int n = 0; n < 2; ++n) { f32x4 s_ = (f32x4){0.f, 0.f, 0.f, 0.f}; _Pragma("unroll") for (int g_ = 0; g_ < 4; ++g_) s_ += *(const f32x4*)(bprime + g_ * 1024 + colb + bj * HALF + 4 * n); bv[bj][n] = s_; }
#pragma unroll
        for (int ai = 0; ai < 2; ++ai) {
            u32x4 gpre[4][2];
#pragma unroll
            for (int m = 0; m < 4; ++m) { const size_t off = (size_t)(row0 + ai * HALF + m * 16) * 1024 + colb;
#pragma unroll
                for (int bj = 0; bj < 2; ++bj) gpre[m][bj] = __builtin_nontemporal_load((const u32x4*)(gb + off + bj * HALF)); }
#pragma unroll
            for (int m = 0; m < 4; ++m) { const size_t off = (size_t)(row0 + ai * HALF + m * 16) * 1024 + colb;
#pragma unroll
                for (int bj = 0; bj < 2; ++bj) {
                    const u32x4 gw = gpre[m][bj];
                    f32x4 v0 = acc[ai][bj][m][0] + bv[bj][0], v1 = acc[ai][bj][m][1] + bv[bj][1];
                    v0[0] *= sigb(bf_lo(gw.x)); v0[1] *= sigb(bf_hi(gw.x)); v0[2] *= sigb(bf_lo(gw.y)); v0[3] *= sigb(bf_hi(gw.y));
                    v1[0] *= sigb(bf_lo(gw.z)); v1[1] *= sigb(bf_hi(gw.z)); v1[2] *= sigb(bf_lo(gw.w)); v1[3] *= sigb(bf_hi(gw.w));
                    u32x4 w; w.x = cvt_pk_bf16(v0[0], v0[1]); w.y = cvt_pk_bf16(v0[2], v0[3]); w.z = cvt_pk_bf16(v1[0], v1[1]); w.w = cvt_pk_bf16(v1[2], v1[3]);
                    *(u32x4*)(merged + off + bj * HALF) = w; } }
        }
    }
};

struct EpiOut {
    static constexpr bool PERM = true, AFTER_DRAIN = false, KEEP_ACC = false;
    const float* x; float* x1; bf16_t* A2; const float* modf; const float* g2; float* ss2;
    __device__ __forceinline__ void operator()(const f32x4 (&acc)[2][2][4][2], const Unit& u, int wr, int wc, int fr, int fq) const {
        const int row0 = u.pm * BM + wr * 64 + fr, colb = u.pn * BM + wc * 32 + 8 * fq, b = u.pm >> 4;
        f32x4 gt[2][2], gg[2][2];
#pragma unroll
        for (int bj = 0; bj < 2; ++bj)
#pragma unroll
            for (int n = 0; n < 2; ++n) { const int c = colb + bj * HALF + 4 * n; gt[bj][n] = *(const f32x4*)(modf + (size_t)b * 6144 + 2048 + c);
                const f32x4 sc2 = *(const f32x4*)(modf + (size_t)b * 6144 + 4096 + c); gg[bj][n] = *(const f32x4*)(g2 + c) * (sc2 + 1.0f); }
#pragma unroll
        for (int ai = 0; ai < 2; ++ai) {
#pragma unroll
          for (int mh = 0; mh < 2; ++mh) {
            f32x4 xr[2][2][2];
#pragma unroll
            for (int m2 = 0; m2 < 2; ++m2) { const size_t off = (size_t)(row0 + ai * HALF + (2 * mh + m2) * 16) * 1024 + colb;
#pragma unroll
                for (int bj = 0; bj < 2; ++bj) { xr[m2][bj][0] = __builtin_nontemporal_load((const f32x4*)(x + off + bj * HALF)); xr[m2][bj][1] = __builtin_nontemporal_load((const f32x4*)(x + off + bj * HALF + 4)); } }
#pragma unroll
            for (int m2 = 0; m2 < 2; ++m2) { const int m = 2 * mh + m2; const int row = row0 + ai * HALF + m * 16; const size_t off = (size_t)row * 1024 + colb; float ssq = 0.f;
#pragma unroll
                for (int bj = 0; bj < 2; ++bj) {
                    const f32x4 y0 = xr[m2][bj][0] + gt[bj][0] * acc[ai][bj][m][0], y1 = xr[m2][bj][1] + gt[bj][1] * acc[ai][bj][m][1];
                    *(f32x4*)(x1 + off + bj * HALF) = y0; *(f32x4*)(x1 + off + bj * HALF + 4) = y1;
                    ssq += (y0[0] * y0[0] + y0[1] * y0[1]) + (y0[2] * y0[2] + y0[3] * y0[3]) + (y1[0] * y1[0] + y1[1] * y1[1]) + (y1[2] * y1[2] + y1[3] * y1[3]);
                    const f32x4 a0 = y0 * gg[bj][0], a1 = y1 * gg[bj][1];
                    u32x4 w; w.x = cvt_pk_bf16(a0[0], a0[1]); w.y = cvt_pk_bf16(a0[2], a0[3]); w.z = cvt_pk_bf16(a1[0], a1[1]); w.w = cvt_pk_bf16(a1[2], a1[3]);
                    *(u32x4*)(A2 + off + bj * HALF) = w; }
                ssq += __shfl_xor(ssq, 16); ssq += __shfl_xor(ssq, 32);
                if (fq == 0) ss2[(size_t)row * 16 + u.pn * 4 + wc] = ssq; }
          }
        }
    }
};

struct EpiPq {
    static constexpr bool PERM = true, AFTER_DRAIN = false, KEEP_ACC = false;
    bf16_t* QP; const float* ss2; const float* bias2p;
    __device__ __forceinline__ void operator()(const f32x4 (&acc)[2][2][4][2], const Unit& u, int wr, int wc, int fr, int fq) const {
        const int row0 = u.pm * BM + wr * 64 + fr, colb = u.pn * BM + wc * 32 + 8 * fq, b = u.pm >> 4;
        f32x4 bv[2][2];
#pragma unroll
        for (int bj = 0; bj < 2; ++bj)
#pragma unroll
            for (int n = 0; n < 2; ++n) { f32x4 s = (f32x4){0.f, 0.f, 0.f, 0.f};
#pragma unroll
                for (int kc = 0; kc < 8; ++kc) s += *(const f32x4*)(bias2p + (size_t)(kc * 8 + b) * PQW + colb + bj * HALF + 4 * n);
                bv[bj][n] = s; }
#pragma unroll
        for (int ai = 0; ai < 2; ++ai)
#pragma unroll
            for (int m = 0; m < 4; ++m) { const int row = row0 + ai * HALF + m * 16;
                const f32x4* sp = (const f32x4*)(ss2 + (size_t)row * 16); const f32x4 s4 = (sp[0] + sp[1]) + (sp[2] + sp[3]);
                const float rs = __builtin_amdgcn_rsqf(((s4[0] + s4[1]) + (s4[2] + s4[3])) * (1.0f / D) + RMS_EPS);
                bf16_t* rowp = QP + (size_t)row * PQW + colb;
#pragma unroll
                for (int bj = 0; bj < 2; ++bj) { const f32x4 v0 = acc[ai][bj][m][0] * rs + bv[bj][0], v1 = acc[ai][bj][m][1] * rs + bv[bj][1];
                    u32x4 w; w.x = cvt_pk_bf16(v0[0], v0[1]); w.y = cvt_pk_bf16(v0[2], v0[3]); w.z = cvt_pk_bf16(v1[0], v1[1]); w.w = cvt_pk_bf16(v1[2], v1[3]);
                    *(u32x4*)(rowp + bj * HALF) = w; } }
    }
};

template <class Epi, class Sched, bool ALIGN_EPI = false, bool SP2 = false>
__device__ __forceinline__ void gemm_phase(PG8_LAS unsigned char* lds, const Gemm g, const Sched& S, const Epi& E) {
    int tid_ = threadIdx.x; asm volatile("" : "+v"(tid_));
    const int tid = tid_, wid = __builtin_amdgcn_readfirstlane(tid >> 6), lane = tid & 63, wr = wid >> 2, wc = wid & 3, fr = lane & 15, fq = lane >> 4;
    const int K = g.K, nt = K / BK, lda = g.lda, ldb = g.ldb;
    unsigned voffA[2], voffB[2];
#pragma unroll
    for (int i = 0; i < 2; ++i) { int R, C; stage_rc(tid * 16 + i * 8192, R, C); const int Rb = Epi::PERM ? ((R & ~31) + perm32(R & 31)) : R;
        voffA[i] = (unsigned)(R * lda + C) * 2u; voffB[i] = (unsigned)(Rb * ldb + C) * 2u; }
    const size_t kstep = (size_t)(BK * 2);
    const size_t hstepA = (size_t)HALF * lda * 2, hstepB = (size_t)HALF * ldb * 2;
    const unsigned ldsw = (unsigned)wid * 1024u;
    const int aoff = lds_byte(wr * 64 + fr, fq * 8), boff = lds_byte(wc * 32 + fr, fq * 8);
#define PG8_SA(b, h) (((b) * 2 + (h)) * HTB)
#define PG8_SB(b, h) ((4 + (b) * 2 + (h)) * HTB)
#define PG8_STAGE(bufoff, gbase, voff) do { _Pragma("unroll") for (int _i = 0; _i < 2; ++_i) \
        __builtin_amdgcn_global_load_lds((const unsigned*)((const char*)(gbase) + (voff)[_i]), (PG8_LAS unsigned*)(lds + (bufoff) + ldsw + _i * 8192), 16, 0, 0); } while (0)
#define PG8_LDA(dst, b, h) do { _Pragma("unroll") for (int m = 0; m < 4; ++m) _Pragma("unroll") for (int k = 0; k < 2; ++k) dst[m][k] = *(const PG8_LAS bf16x8*)(lds + PG8_SA(b, h) + aoff + m * 2048 + k * 1024); } while (0)
#define PG8_LDB(dst, b, h) do { _Pragma("unroll") for (int n = 0; n < 2; ++n) _Pragma("unroll") for (int k = 0; k < 2; ++k) dst[n][k] = *(const PG8_LAS bf16x8*)(lds + PG8_SB(b, h) + boff + n * 2048 + k * 1024); } while (0)
#define PG8_MMA(ai, bj, At, Bt) do { __builtin_amdgcn_s_setprio(1); _Pragma("unroll") for (int m = 0; m < 4; ++m) _Pragma("unroll") for (int n = 0; n < 2; ++n) _Pragma("unroll") for (int k = 0; k < 2; ++k) \
        acc[ai][bj][m][n] = __builtin_amdgcn_mfma_f32_16x16x32_bf16(Bt[n][k], At[m][k], acc[ai][bj][m][n], 0, 0, 0); __builtin_amdgcn_s_setprio(0); } while (0)
#define PG8_WAIT_V(n) asm volatile("s_waitcnt vmcnt(" #n ")" ::: "memory")
#define PG8_WAIT_L(n) asm volatile("s_waitcnt lgkmcnt(" #n ")" ::: "memory")
#define PG8_BAR __builtin_amdgcn_s_barrier()
#define PG8_SCHED __builtin_amdgcn_sched_barrier(0)
    Unit cur, nxt; int ui = 0;
    if (!S.next(0, cur)) return;
    f32x4 acc[2][2][4][2];
#pragma unroll
    for (int a = 0; a < 2; ++a)
#pragma unroll
        for (int b = 0; b < 2; ++b)
#pragma unroll
            for (int m = 0; m < 4; ++m)
#pragma unroll
                for (int n = 0; n < 2; ++n) acc[a][b][m][n] = (f32x4){0.f, 0.f, 0.f, 0.f};
    bf16x8 At[4][2], B0[2][2], B1[2][2];
    const char* cA = g.a_ptr(cur); const char* cB = g.b_ptr(cur);
    S.a_ready(cur);
    if constexpr (SP2) {
        PG8_STAGE(PG8_SB(0, 0), cB, voffB); PG8_STAGE(PG8_SB(0, 1), cB + hstepB, voffB); PG8_STAGE(PG8_SA(0, 0), cA, voffA); PG8_STAGE(PG8_SA(0, 1), cA + hstepA, voffA);
        if (wr == 1) PG8_BAR;
        PG8_WAIT_V(2); PG8_BAR;
        PG8_STAGE(PG8_SB(1, 0), cB + kstep, voffB); PG8_STAGE(PG8_SA(1, 0), cA + kstep, voffA); PG8_STAGE(PG8_SB(1, 1), cB + hstepB + kstep, voffB);
        PG8_WAIT_V(6); PG8_BAR;
    } else {
        PG8_STAGE(PG8_SB(0, 0), cB, voffB); PG8_STAGE(PG8_SA(0, 0), cA, voffA); PG8_STAGE(PG8_SB(0, 1), cB + hstepB, voffB); PG8_STAGE(PG8_SA(0, 1), cA + hstepA, voffA);
        if (wr == 1) PG8_BAR;
        PG8_WAIT_V(4); PG8_BAR;
        PG8_STAGE(PG8_SB(1, 0), cB + kstep, voffB); PG8_STAGE(PG8_SA(1, 0), cA + kstep, voffA); PG8_STAGE(PG8_SB(1, 1), cB + hstepB + kstep, voffB);
        PG8_WAIT_V(6); PG8_BAR;
    }
    for (;;) {
        const bool has_next = S.next(ui + 1, nxt);
        const char* nA = has_next ? g.a_ptr(nxt) : cA; const char* nB = has_next ? g.b_ptr(nxt) : cB;
        for (int t = 0; t < nt; t += 2) {
            const bool last = (t == nt - 2);
            const char* a1 = cA + (size_t)(t + 1) * kstep;
            const char* a2 = last ? nA : cA + (size_t)(t + 2) * kstep; const char* b2 = last ? nB : cB + (size_t)(t + 2) * kstep;
            const char* a3 = a2 + kstep; const char* b3 = b2 + kstep;
            if (last && has_next) S.a_ready(nxt);
            if constexpr (SP2) {
            PG8_LDB(B0, 0, 0); PG8_LDB(B1, 0, 1); PG8_SCHED; PG8_LDA(At, 0, 0); PG8_STAGE(PG8_SA(1, 1), a1 + hstepA, voffA);
            PG8_WAIT_V(8); PG8_WAIT_L(0); PG8_BAR; PG8_MMA(0, 0, At, B0); PG8_MMA(0, 1, At, B1); PG8_BAR; PG8_SCHED;
            PG8_LDA(At, 0, 1); PG8_STAGE(PG8_SB(0, 0), b2, voffB); PG8_STAGE(PG8_SB(0, 1), b2 + hstepB, voffB); PG8_STAGE(PG8_SA(0, 0), a2, voffA);
            PG8_WAIT_V(8); PG8_WAIT_L(0); PG8_BAR; PG8_MMA(1, 0, At, B0); PG8_MMA(1, 1, At, B1); PG8_BAR; PG8_SCHED;
            PG8_LDB(B0, 1, 0); PG8_LDB(B1, 1, 1); PG8_SCHED; PG8_LDA(At, 1, 0); PG8_STAGE(PG8_SA(0, 1), a2 + hstepA, voffA);
            PG8_WAIT_V(8); PG8_WAIT_L(0); PG8_BAR; PG8_MMA(0, 0, At, B0); PG8_MMA(0, 1, At, B1); PG8_BAR; PG8_SCHED;
            PG8_LDA(At, 1, 1); PG8_STAGE(PG8_SB(1, 0), b3, voffB); PG8_STAGE(PG8_SB(1, 1), b3 + hstepB, voffB); PG8_STAGE(PG8_SA(1, 0), a3, voffA);
            PG8_WAIT_V(8); PG8_WAIT_L(0); PG8_BAR; PG8_MMA(1, 0, At, B0); PG8_MMA(1, 1, At, B1); PG8_BAR; PG8_SCHED;
            } else {
            PG8_LDB(B0, 0, 0); PG8_SCHED; PG8_LDA(At, 0, 0); PG8_STAGE(PG8_SA(1, 1), a1 + hstepA, voffA);
            PG8_WAIT_L(8); PG8_BAR; PG8_WAIT_L(0); PG8_MMA(0, 0, At, B0); PG8_BAR; PG8_SCHED;
            PG8_LDB(B1, 0, 1); PG8_STAGE(PG8_SB(0, 0), b2, voffB);
            PG8_BAR; PG8_WAIT_L(0); PG8_MMA(0, 1, At, B1); PG8_BAR;
            PG8_LDA(At, 0, 1); PG8_STAGE(PG8_SA(0, 0), a2, voffA);
            PG8_BAR; PG8_WAIT_L(0); PG8_MMA(1, 0, At, B0); PG8_BAR; PG8_SCHED;
            PG8_STAGE(PG8_SB(0, 1), b2 + hstepB, voffB);
            PG8_WAIT_V(6); PG8_BAR; PG8_MMA(1, 1, At, B1); PG8_BAR;
            PG8_LDB(B0, 1, 0); PG8_SCHED; PG8_LDA(At, 1, 0); PG8_STAGE(PG8_SA(0, 1), a2 + hstepA, voffA);
            PG8_WAIT_L(8); PG8_BAR; PG8_WAIT_L(0); PG8_MMA(0, 0, At, B0); PG8_BAR; PG8_SCHED;
            PG8_LDB(B1, 1, 1); PG8_STAGE(PG8_SB(1, 0), b3, voffB);
            PG8_BAR; PG8_WAIT_L(0); PG8_MMA(0, 1, At, B1); PG8_BAR;
            PG8_LDA(At, 1, 1); PG8_STAGE(PG8_SA(1, 0), a3, voffA);
            PG8_BAR; PG8_WAIT_L(0); PG8_MMA(1, 0, At, B0); PG8_BAR; PG8_SCHED;
            PG8_STAGE(PG8_SB(1, 1), b3 + hstepB, voffB);
            PG8_WAIT_V(6); PG8_BAR; PG8_MMA(1, 1, At, B1); PG8_BAR;
            }
        }
        if constexpr (ALIGN_EPI) { if (wr == 0) PG8_BAR; }
        if constexpr (!Epi::AFTER_DRAIN) { E(acc, cur, wr, wc, fr, fq); S.done(cur); }
        if (!has_next) break;
        if (!(Epi::KEEP_ACC && cur.part == 0)) {
#pragma unroll
        for (int a = 0; a < 2; ++a)
#pragma unroll
            for (int b = 0; b < 2; ++b)
#pragma unroll
                for (int m = 0; m < 4; ++m)
#pragma unroll
                    for (int n = 0; n < 2; ++n) acc[a][b][m][n] = (f32x4){0.f, 0.f, 0.f, 0.f};
        }
        cur = nxt; cA = nA; cB = nB; ++ui;
        if constexpr (ALIGN_EPI) { if (wr == 1) PG8_BAR; }
    }
    PG8_WAIT_V(0);
    if constexpr (!ALIGN_EPI) { if (wr == 0) PG8_BAR; }
    PG8_BAR;
    if constexpr (Epi::AFTER_DRAIN) { E.fused(acc, cur, wr, wc, fr, fq, lds, wid, lane); S.done(cur); }
#undef PG8_SA
#undef PG8_SB
#undef PG8_STAGE
#undef PG8_LDA
#undef PG8_LDB
#undef PG8_MMA
#undef PG8_WAIT_V
#undef PG8_WAIT_L
#undef PG8_BAR
#undef PG8_SCHED
}
}

constexpr size_t MiB = 1u << 20;
constexpr size_t WS_CTL = 0, CTL_ZERO_BYTES = 32 * 1024;
constexpr size_t WS_KSUM = 256 * 1024;
constexpr size_t WS_MODP = 1 * MiB;
constexpr size_t WS_MODF = WS_MODP + 8 * 8 * 6144 * 4;
constexpr size_t WS_BIAS1P = 3 * MiB;
constexpr size_t WS_BIAS2P = 4 * MiB;
constexpr size_t WS_BPRIME = 4 * MiB + 512 * 1024;
constexpr size_t WS_RSTD1 = 5 * MiB;
constexpr size_t WS_SS2 = 6 * MiB;
constexpr size_t WS_SUBK = 8 * MiB;
constexpr size_t WS_WIN = 16 * MiB, WS_WA = 24 * MiB, WS_WP = 25 * MiB, WS_WOUT = 26 * MiB, WS_WQ = 28 * MiB;
constexpr size_t WS_U = 32 * MiB, WS_V = 64 * MiB;
constexpr size_t WS_XG = 96 * MiB;
constexpr size_t WS_H2Q = WS_XG, WS_HS = WS_XG + 32 * MiB;
constexpr size_t WS_QKVP = 160 * MiB;
constexpr size_t WS_GAB = 288 * MiB;
constexpr size_t WS_POOLED = 416 * MiB;
constexpr size_t WS_END = 448 * MiB;
constexpr int CW_TMO = 0, CW_BAR = 4096;
constexpr int CW_NRM = 2048;

constexpr int RING_OFF = 0, RING_BYTES = 131072;
constexpr int LDS_BYTES = 147456;
constexpr int LDSCTL_OFF = LDS_BYTES - 512, MISC_OFF = LDSCTL_OFF + 320;

#define GAS __attribute__((address_space(1)))
#define LAS __attribute__((address_space(3)))
typedef unsigned short bf16;
typedef unsigned v4u __attribute__((ext_vector_type(4)));
typedef unsigned v2u __attribute__((ext_vector_type(2)));
typedef float f32x4 __attribute__((ext_vector_type(4)));
typedef GAS unsigned gu32;
#define RLX_AGENT __ATOMIC_RELAXED, __HIP_MEMORY_SCOPE_AGENT
#define LDS_WAIT() asm volatile("s_waitcnt lgkmcnt(0)" ::: "memory")
#define VM_WAIT() asm volatile("s_waitcnt vmcnt(0)" ::: "memory")
__device__ __forceinline__ unsigned f2bf(float f) { unsigned u = __builtin_bit_cast(unsigned, f); return (u + 0x7fffu + ((u >> 16) & 1u)) >> 16; }
__device__ __forceinline__ unsigned pk2(float lo, float hi) { return f2bf(lo) | (f2bf(hi) << 16); }
__device__ __forceinline__ float bflo(unsigned w) { return __uint_as_float(w << 16); }
__device__ __forceinline__ float bfhi(unsigned w) { return __uint_as_float(w & 0xffff0000u); }
__device__ __forceinline__ float wave_sum(float v) {
#pragma unroll
    for (int o = 1; o < 64; o <<= 1) v += __shfl_xor(v, o);
    return v;
}
__device__ __forceinline__ float wave_max(float v) {
#pragma unroll
    for (int o = 1; o < 64; o <<= 1) v = fmaxf(v, __shfl_xor(v, o));
    return v;
}

#define XB_TMO      128
#define XB_XCNT(j)  (256  + 64 * (j))
#define XB_XSUB(j)  (1280 + 64 * (j))
#define XB_XGEN(j)  (2304 + 64 * (j))
#define XB_TOP      3328
#define XB_TOPGEN   3392
#define XCD_BAR_WORDS 3456
#define XB_SPIN_CAP (1u << 22)

__device__ __forceinline__ unsigned xb_ld(unsigned* p)              { return __hip_atomic_load(p, __ATOMIC_RELAXED, __HIP_MEMORY_SCOPE_AGENT); }
__device__ __forceinline__ unsigned xb_add(unsigned* p, unsigned v) { return __hip_atomic_fetch_add(p, v, __ATOMIC_RELAXED, __HIP_MEMORY_SCOPE_AGENT); }
__device__ __forceinline__ unsigned xb_xcc_id() { return (unsigned)__builtin_amdgcn_s_getreg((3 << 11) | 20) & 0xFu; }
#define XB_SPIN(cond, bar) do { unsigned _sp = 0; while (cond) { __builtin_amdgcn_s_sleep(1); \
    if ((++_sp & 255u) == 0u) { if (xb_ld(&(bar)[XB_TMO])) break; if (_sp > XB_SPIN_CAP) { atomicAdd(&(bar)[XB_TMO], 1u); break; } } } } while (0)

struct XcdBarrier { unsigned* bar; unsigned x; volatile LAS unsigned* st; };

__device__ __forceinline__ XcdBarrier xcd_barrier_post(unsigned* bar, volatile LAS unsigned* st) {
    XcdBarrier b; b.bar = bar; b.x = xb_xcc_id(); b.st = st;
    if (threadIdx.x == 0) (void)xb_add(&bar[XB_XCNT(b.x)], 1u);
    return b;
}
__device__ __forceinline__ void xcd_barrier_complete(unsigned* bar, unsigned x, unsigned& nloc, unsigned& nx) {
    const unsigned G = gridDim.x * gridDim.y * gridDim.z;
    unsigned sum, cnt, mine, sp = 0u;
    for (;;) {
        sum = 0u; cnt = 0u; mine = 0u;
#pragma unroll
        for (unsigned j = 0; j < 16; ++j) { const unsigned c = xb_ld(&bar[XB_XCNT(j)]); sum += c; cnt += (c > 0u) ? 1u : 0u; mine = (j == x) ? c : mine; }
        if (sum == G) break;
        __builtin_amdgcn_s_sleep(1);
        if ((++sp & 255u) == 0u) { if (xb_ld(&bar[XB_TMO])) break; if (sp > XB_SPIN_CAP) { atomicAdd(&bar[XB_TMO], 1u); break; } }
    }
    nloc = mine > 0u ? mine : 1u; nx = cnt > 0u ? cnt : 1u;
}
__device__ __forceinline__ void xcd_barrier(const XcdBarrier& b) {
    asm volatile("s_waitcnt vmcnt(0)" ::: "memory");
    __syncthreads();
    if (threadIdx.x == 0) {
        unsigned* bar = b.bar;
        __builtin_amdgcn_s_waitcnt(0);
        unsigned nloc = b.st[0], nx = b.st[1];
        if (nloc == 0u) { xcd_barrier_complete(bar, b.x, nloc, nx); b.st[0] = nloc; b.st[1] = nx; }
        const unsigned old = xb_add(&bar[XB_XSUB(b.x)], 1u);
        const unsigned gen = old / nloc;
        if (old + 1u == (gen + 1u) * nloc) {
            __builtin_amdgcn_fence(__ATOMIC_RELEASE, "agent");
            asm volatile("s_waitcnt vmcnt(0)" ::: "memory");
            const unsigned og = xb_add(&bar[XB_TOP], 1u);
            const unsigned tg = og / nx;
            if (og + 1u == (tg + 1u) * nx) xb_add(&bar[XB_TOPGEN], 1u);
            else XB_SPIN(xb_ld(&bar[XB_TOPGEN]) == tg, bar);
            __builtin_amdgcn_fence(__ATOMIC_ACQUIRE, "agent");
            xb_add(&bar[XB_XGEN(b.x)], 1u);
            asm volatile("s_waitcnt vmcnt(0)" ::: "memory");
        } else {
            XB_SPIN(xb_ld(&bar[XB_XGEN(b.x)]) == gen, bar);
            __builtin_amdgcn_fence(__ATOMIC_ACQUIRE, "agent");
            asm volatile("s_waitcnt vmcnt(0)" ::: "memory");
        }
    }
    __syncthreads();
}

struct Frame {
    LAS unsigned char* lds;
    volatile LAS unsigned* MISC;
    gu32* ctl;
    int tid, lane, wave;
    int vcu, G;
};
struct Args { const float* in[18]; float* out; unsigned char* ws; };

__device__ __forceinline__ float modp_sum(const float* modp, int idx) {
    float s = 0.f;
#pragma unroll
    for (int kc = 0; kc < 8; ++kc) s += modp[(size_t)kc * 8 * 6144 + idx];
    return s;
}
template <int MODE>
__device__ __forceinline__ void p0_wg_dot(Frame& F, const float* cin, const float* modp, int soff, const float* W, int N, const float* addv, float* outp, int first, int ntask) {
    LAS float* scr = (LAS float*)(F.lds + RING_OFF + F.wave * 16384);
    const int ncn = N / 64;
    for (int it = first; it < ntask; it += F.G) {
        const int kc = it / ncn, nc = it % ncn, k0 = kc * 128 + F.wave * 16, n = nc * 64 + F.lane;
        float w[16];
#pragma unroll
        for (int kk = 0; kk < 16; ++kk) w[kk] = (MODE == 0) ? __builtin_nontemporal_load(W + (size_t)(k0 + kk) * N + n) : W[(size_t)(k0 + kk) * N + n];
#pragma unroll
        for (int j = 0; j < 2; ++j) { const int idx = F.lane + 64 * j, b = idx >> 4, kk = idx & 15;
            float cf; if (MODE == 0) { const float cv = cin[b * 1024 + k0 + kk]; cf = cv / (1.0f + __expf(-cv)); } else cf = modp_sum(modp, b * 6144 + soff + k0 + kk);
            scr[idx] = cf; }
        LDS_WAIT(); asm volatile("" ::: "memory");
#pragma unroll
        for (int b = 0; b < 8; ++b) { float s = 0.f;
#pragma unroll
            for (int kk = 0; kk < 16; ++kk) s += scr[b * 16 + kk] * w[kk];
            scr[256 + b * 64 + F.lane] = s; }
        __syncthreads();
        { const int b = F.wave; float s = (addv != nullptr && kc == 0) ? addv[n] : 0.f;
#pragma unroll
          for (int w8 = 0; w8 < 8; ++w8) s += ((LAS float*)(F.lds + RING_OFF + w8 * 16384))[256 + b * 64 + F.lane];
          outp[(size_t)(kc * 8 + b) * N + n] = s; }
        __syncthreads();
    }
}
__device__ __forceinline__ void p0a_mod(Frame& F, const Args& A) { p0_wg_dot<0>(F, A.in[1], nullptr, 0, A.in[2], 6144, A.in[3], (float*)(A.ws + WS_MODP), F.vcu, 8 * 96); }
__device__ __forceinline__ void p0_wp_task(Frame& F, const Args& A, int r) {
    LAS float* scr = (LAS float*)(F.lds + RING_OFF + F.wave * 16384);
    const int g = r >> 6, kq = (r >> 4) & 3, nc = r & 15, n = nc * 64 + F.lane, d0 = 16 * F.wave;
    const float* wmix = A.in[7] + (size_t)(g * 128 + 32 * kq) * 128 + d0; const float* scale = A.in[9] + g * 128 + d0; const float* wup = A.in[10] + (size_t)(g * 128 + d0) * D + n; const float* bmix = A.in[8] + g * 128 + d0;
    float wu[16];
#pragma unroll
    for (int d = 0; d < 16; ++d) wu[d] = wup[(size_t)d * D];
    float bp = 0.f;
#pragma unroll
    for (int d = 0; d < 16; ++d) { wu[d] *= scale[d]; bp += bmix[d] * wu[d]; }
#pragma unroll
    for (int kk = 0; kk < 32; ++kk) { float s = 0.f;
#pragma unroll
        for (int d = 0; d < 16; ++d) s += wmix[kk * 128 + d] * wu[d];
        scr[kk * 64 + F.lane] = s; }
    scr[2048 + F.lane] = bp;
    __syncthreads();
    { float s[4]; float bs = 0.f;
#pragma unroll
      for (int e = 0; e < 4; ++e) s[e] = 0.f;
#pragma unroll
      for (int w8 = 0; w8 < 8; ++w8) { const LAS float* o = (const LAS float*)(F.lds + RING_OFF + w8 * 16384);
#pragma unroll
          for (int e = 0; e < 4; ++e) s[e] += o[(4 * F.wave + e) * 64 + F.lane];
          bs += o[2048 + F.lane]; }
      v2u w; w.x = pk2(s[0], s[1]); w.y = pk2(s[2], s[3]);
      *(GAS v2u*)((bf16*)(A.ws + WS_WP) + (size_t)n * PW + g * 128 + 32 * kq + 4 * F.wave) = w;
      if (kq == 0 && F.wave == 0) ((float*)(A.ws + WS_BPRIME))[g * 1024 + n] = bs; }
    __syncthreads();
}

__device__ __forceinline__ void p0_transpose_item(const float* W, int K, int N, bf16* WT, int row_off, LAS float* scr, int item, int lane) {
    const int nblk = N / 32, kb = item / nblk, nb = item % nblk, k0 = 64 * kb, n0 = 32 * nb;
#pragma unroll 8
    for (int i = 0; i < 32; ++i) { const int kk = 2 * i + (lane >> 5); scr[kk * 33 + (lane & 31)] = __builtin_nontemporal_load(W + (size_t)(k0 + kk) * N + n0 + (lane & 31)); }
    LDS_WAIT(); asm volatile("" ::: "memory");
    const int c = lane & 7;
#pragma unroll
    for (int j = 0; j < 4; ++j) { const int n = (lane >> 3) + 8 * j; const LAS float* s = scr + (8 * c) * 33 + n;
        v4u o; o.x = pk2(s[0 * 33], s[1 * 33]); o.y = pk2(s[2 * 33], s[3 * 33]); o.z = pk2(s[4 * 33], s[5 * 33]); o.w = pk2(s[6 * 33], s[7 * 33]);
        *(GAS v4u*)(WT + (size_t)(row_off + n0 + n) * K + k0 + 8 * c) = o; }
    LDS_WAIT(); asm volatile("" ::: "memory");
}
__device__ __forceinline__ void p0_table_rows4(const float* const (&src)[4], unsigned char* const (&dst)[4], float* const (&scale_out)[4], int off, int lane) {
    f32x4 v[4][4]; float am[4];
#pragma unroll
    for (int u = 0; u < 4; ++u)
#pragma unroll
        for (int q = 0; q < 4; ++q) v[u][q] = __builtin_nontemporal_load((const f32x4*)(src[u] + 16 * lane + 4 * q));
#pragma unroll
    for (int u = 0; u < 4; ++u) { float a = 0.f;
#pragma unroll
        for (int q = 0; q < 4; ++q) a = fmaxf(fmaxf(a, fmaxf(fabsf(v[u][q][0]), fabsf(v[u][q][1]))), fmaxf(fabsf(v[u][q][2]), fabsf(v[u][q][3])));
        am[u] = a; }
#pragma unroll
    for (int o = 1; o < 64; o <<= 1) {
#pragma unroll
        for (int u = 0; u < 4; ++u) am[u] = fmaxf(am[u], __shfl_xor(am[u], o)); }
#pragma unroll
    for (int u = 0; u < 4; ++u) { const float sc = (am[u] > 0.f) ? am[u] * (1.0f / 127.0f) : 1.0f, inv = 1.0f / sc;
        v4u o;
#pragma unroll
        for (int q = 0; q < 4; ++q) { const int q0 = (int)rintf(v[u][q][0] * inv) + off, q1 = (int)rintf(v[u][q][1] * inv) + off, q2 = (int)rintf(v[u][q][2] * inv) + off, q3 = (int)rintf(v[u][q][3] * inv) + off;
            o[q] = (unsigned)(q0 & 255) | ((unsigned)(q1 & 255) << 8) | ((unsigned)(q2 & 255) << 16) | ((unsigned)q3 << 24); }
        *(GAS v4u*)(dst[u] + ((size_t)(lane >> 3) << 21) + 16 * (lane & 7)) = o;
        if (lane == 0) *scale_out[u] = sc; }
}
__device__ __forceinline__ void p0_table_trip(const Args& A, int r0, int NGW, int lane) {
    const float* src[4]; unsigned char* dst[4]; float* sco[4];
#pragma unroll
    for (int u = 0; u < 4; ++u) { int r = r0 + u * NGW; if (r >= 2 * PEXP) r = r0; const int tb = r / PEXP, e = r % PEXP;
        src[u] = (tb ? A.in[16] : A.in[15]) + (size_t)e * D; dst[u] = A.ws + (tb ? WS_V : WS_U) + (size_t)e * 128; sco[u] = (float*)(A.ws + WS_U + 16 * MiB) + 2 * e + tb; }
    const int tb0 = r0 / PEXP;
    if ((r0 + 3 * NGW) / PEXP == tb0 && r0 + 3 * NGW < 2 * PEXP) p0_table_rows4(src, dst, sco, 0, lane);
    else { for (int u = 0; u < 4; ++u) { const int r = r0 + u * NGW; if (r < 2 * PEXP) { const float* s1[4] = {src[u], src[u], src[u], src[u]}; unsigned char* d1[4] = {dst[u], dst[u], dst[u], dst[u]}; float* c1[4] = {sco[u], sco[u], sco[u], sco[u]}; p0_table_rows4(s1, d1, c1, 0, lane); } } }
}
template <int STAGE>
__device__ __forceinline__ void p0b_prologue(Frame& F, const Args& A) {
    const int gw = F.vcu * NWAVES + F.wave, NGW = F.G * NWAVES, lane = F.lane;
    const float* modp = (const float*)(A.ws + WS_MODP);
    LAS float* G1 = (LAS float*)(F.lds + 135168);
    if (STAGE == 0) { float* ks = (float*)(A.ws + WS_KSUM); for (int i = F.vcu * NTHREADS + F.tid; i < NB * NBLK * 512; i += F.G * NTHREADS) ks[i] = 0.f; }
    if (STAGE == 0) { for (int r = F.vcu; r < 256; r += F.G) p0_wp_task(F, A, r); }
    else { p0_wg_dot<1>(F, nullptr, modp, 0, A.in[5], INW, nullptr, (float*)(A.ws + WS_BIAS1P), F.vcu, 8 * (INW / 64));
           p0_wg_dot<1>(F, nullptr, modp, 3072, A.in[13], PQW, nullptr, (float*)(A.ws + WS_BIAS2P), F.vcu, 8 * (PQW / 64)); }
    LAS float* scr = (LAS float*)(F.lds + RING_OFF + F.wave * 16384);
    constexpr int I_MODF = 768, I_WIN = (D / 64) * (INW / 32), I_WA = (AW / 64) * (D / 32), I_WOUT = (D / 64) * (D / 32), I_WQ = (D / 64) * (PQW / 32);
    constexpr int I_SUBK = 64;
    constexpr int NITEMS = I_MODF + I_WIN + I_WA + I_WOUT + I_WQ + I_SUBK;
    for (int it = gw; it < NITEMS; it += NGW) {
        int r = it;
        if (r < I_MODF) { if (STAGE != 1) continue; const int idx = r * 64 + lane; ((float*)(A.ws + WS_MODF))[idx] = modp_sum(modp, idx); continue; } r -= I_MODF;
        if (r < I_WIN) { if (STAGE != 0) continue; p0_transpose_item(A.in[5], D, INW, (bf16*)(A.ws + WS_WIN), 0, scr, r, lane); continue; } r -= I_WIN;
        if (r < I_WA) { if (STAGE != 0) continue; p0_transpose_item(A.in[6], AW, D, (bf16*)(A.ws + WS_WA), 0, scr, r, lane); continue; } r -= I_WA;
        if (r < I_WOUT) { if (STAGE != 0) continue; p0_transpose_item(A.in[11], D, D, (bf16*)(A.ws + WS_WOUT), 0, scr, r, lane); continue; } r -= I_WOUT;
        if (r < I_WQ) { if (STAGE != 0) continue; p0_transpose_item(A.in[13], D, PQW, (bf16*)(A.ws + WS_WQ), 0, scr, r, lane); continue; } r -= I_WQ;
        if (r < I_SUBK) { if (STAGE != 0) continue; const float* s = A.in[14] + (size_t)r * 512 + 8 * lane; const f32x4 a = *(const f32x4*)s, b = *(const f32x4*)(s + 4);
            v4u o; o.x = pk2(a[0], a[1]); o.y = pk2(a[2], a[3]); o.z = pk2(b[0], b[1]); o.w = pk2(b[2], b[3]);
            *(GAS v4u*)((bf16*)(A.ws + WS_SUBK) + (size_t)r * 512 + 8 * lane) = o; continue; } r -= I_SUBK;
    }
    auto xg_rows = [&](const int rb) {
        const float* x = A.in[0]; bf16* XG = (bf16*)(A.ws + WS_XG); float* rstd1 = (float*)(A.ws + WS_RSTD1);
            for (int r0 = F.wave; r0 < 128; r0 += 4 * NWAVES) {
                f32x4 v[4][2][2]; float s[4];
#pragma unroll
                for (int u = 0; u < 4; ++u) { const float* xr = x + (size_t)(rb * 128 + r0 + u * NWAVES) * 1024;
#pragma unroll
                    for (int h = 0; h < 2; ++h)
#pragma unroll
                        for (int q = 0; q < 2; ++q) v[u][h][q] = __builtin_nontemporal_load((const f32x4*)(xr + h * 512 + 8 * lane + 4 * q)); }
#pragma unroll
                for (int u = 0; u < 4; ++u) { float t = 0.f;
#pragma unroll
                    for (int h = 0; h < 2; ++h)
#pragma unroll
                        for (int q = 0; q < 2; ++q) t += (v[u][h][q][0] * v[u][h][q][0] + v[u][h][q][1] * v[u][h][q][1]) + (v[u][h][q][2] * v[u][h][q][2] + v[u][h][q][3] * v[u][h][q][3]);
                    s[u] = t; }
#pragma unroll
                for (int o = 1; o < 64; o <<= 1) {
#pragma unroll
                    for (int u = 0; u < 4; ++u) s[u] += __shfl_xor(s[u], o); }
#pragma unroll
                for (int u = 0; u < 4; ++u) { const int row = rb * 128 + r0 + u * NWAVES;
                    if (lane == 0) rstd1[row] = 1.0f / sqrtf(s[u] * (1.0f / D) + RMS_EPS);
#pragma unroll
                    for (int h = 0; h < 2; ++h) { const LAS float* g = G1 + h * 512 + 8 * lane;
                        v4u o; o.x = pk2(v[u][h][0][0] * g[0], v[u][h][0][1] * g[1]); o.y = pk2(v[u][h][0][2] * g[2], v[u][h][0][3] * g[3]); o.z = pk2(v[u][h][1][0] * g[4], v[u][h][1][1] * g[5]); o.w = pk2(v[u][h][1][2] * g[6], v[u][h][1][3] * g[7]);
                        *(GAS v4u*)(XG + (size_t)row * 1024 + h * 512 + 8 * lane) = o; } }
            }
    };
#ifndef TABLES_IN_ROUTER
    if (STAGE == 0) { for (int r0 = gw; r0 < 2 * PEXP; r0 += 4 * NGW) p0_table_trip(A, r0, NGW, lane); }
    else
#else
    if (STAGE == 1)
#endif
    for (int rb = F.vcu; rb < T / 128; rb += F.G) {
        const float* g1 = A.in[4]; const int b = (rb * 128) / SEQ;
        __syncthreads();
        for (int k = F.tid; k < 1024; k += NTHREADS) G1[k] = g1[k] * (1.0f + modp_sum(modp, b * 6144 + 1024 + k));
        __syncthreads();
        xg_rows(rb);
    }

}
namespace attn_body {
using bf16=__hip_bfloat16;
using bf16x8=__attribute__((ext_vector_type(8)))short;
using s16x4=__attribute__((ext_vector_type(4)))short;
using f32x16=__attribute__((ext_vector_type(16)))float;
using u32x4=__attribute__((ext_vector_type(4)))unsigned;
constexpr int BATCH=8,NHEAD=8,SEQ=4096,D=64,DM=NHEAD*D;
constexpr int NW=8,QBLK=32,QB=QBLK*NW,KVBLK=64,NQB=SEQ/QB;
constexpr int ATTN_PITCH=DM, ATTN_UNIT_ROWS=QB;
__device__ __forceinline__ int crow(int r,int hi){return (r&3)+8*(r>>2)+4*hi;}
#define SBAR() __builtin_amdgcn_sched_barrier(0)
__device__ __forceinline__ void cmask(f32x16&p0,f32x16&p1,int jb,int qrel,int hi){
  const float NEG=-INFINITY; int kb=64*jb+4*hi;
  #pragma unroll
  for(int r=0;r<16;++r){int kv=kb+(r&3)+8*(r>>2); if(kv>qrel)p0[r]=NEG; if(kv+32>qrel)p1[r]=NEG;}
}

constexpr int NSLOT=3, SLOTB=8192;
constexpr int LDS_K=0, LDS_V=NSLOT*SLOTB, LDS_WS=2*NSLOT*SLOTB, LDS_OST=LDS_WS+NW*64*4, LDS_KSL=LDS_OST+NW*4096, LDS_BYTES=LDS_KSL+4096;
constexpr float C2=0.125f*1.4426950408889634f;
__device__ __forceinline__ void glds16(const void*sbase,unsigned voff,unsigned lds_dst){unsigned keep;
  asm volatile("s_mov_b32 %0, m0\n\ts_mov_b32 m0, %3\n\ts_nop 4\n\tglobal_load_lds_dwordx4 %1, %2\n\ts_mov_b32 m0, %0":"=&s"(keep):"v"(voff),"s"(sbase),"s"(lds_dst):"memory");}
__device__ __forceinline__ float max3f(float a,float b,float c){float r;asm("v_max3_f32 %0, %1, %2, %3":"=v"(r):"v"(a),"v"(b),"v"(c));return r;}
__device__ __forceinline__ float max2f(float a,float b){float r;asm("v_max_f32_e32 %0, %1, %2":"=v"(r):"v"(a),"v"(b));return r;}
__device__ __forceinline__ float fadd_s(float a,float b){float r;asm("v_add_f32_e32 %0, %1, %2":"=v"(r):"v"(a),"v"(b));return r;}
__device__ __forceinline__ float fsub_s(float a,float b){float r;asm("v_sub_f32_e32 %0, %1, %2":"=v"(r):"v"(a),"v"(b));return r;}
typedef float f32x2_t __attribute__((ext_vector_type(2))); typedef __bf16 bf16x2_t __attribute__((ext_vector_type(2)));
__device__ __forceinline__ unsigned cvtpk_s(float lo,float hi){f32x2_t v={lo,hi};bf16x2_t b=__builtin_convertvector(v,bf16x2_t);return __builtin_bit_cast(unsigned,b);}
#define WAIT_BAR(N) asm volatile("s_waitcnt vmcnt(" #N ") lgkmcnt(0)\n\ts_barrier":::"memory")

__device__ __forceinline__ void qkt(f32x16&p0,f32x16&p1,const char*Kslot,const bf16x8*qr,const f32x16&negm,int r32,int hi){
  const char*kb=Kslot+hi*1024+r32*16;
  #pragma unroll
  for(int d0=0;d0<4;++d0){
    const bf16x8 b0=*reinterpret_cast<const bf16x8*>(kb+d0*2048);
    const bf16x8 b1=*reinterpret_cast<const bf16x8*>(kb+d0*2048+512);
    if(d0==0){p0=__builtin_amdgcn_mfma_f32_32x32x16_bf16(b0,qr[0],negm,0,0,0);p1=__builtin_amdgcn_mfma_f32_32x32x16_bf16(b1,qr[0],negm,0,0,0);}
    else{p0=__builtin_amdgcn_mfma_f32_32x32x16_bf16(b0,qr[d0],p0,0,0,0);p1=__builtin_amdgcn_mfma_f32_32x32x16_bf16(b1,qr[d0],p1,0,0,0);}}
}
typedef __attribute__((address_space(3))) const char* lds_cptr;
typedef short v4i16_t __attribute__((ext_vector_type(4)));
__device__ __forceinline__ void kload8(bf16x8*kf,lds_cptr kp){
  kf[0]=*(const __attribute__((address_space(3))) bf16x8*)(kp);      kf[1]=*(const __attribute__((address_space(3))) bf16x8*)(kp+512);
  kf[2]=*(const __attribute__((address_space(3))) bf16x8*)(kp+2048); kf[3]=*(const __attribute__((address_space(3))) bf16x8*)(kp+2560);
  kf[4]=*(const __attribute__((address_space(3))) bf16x8*)(kp+4096); kf[5]=*(const __attribute__((address_space(3))) bf16x8*)(kp+4608);
  kf[6]=*(const __attribute__((address_space(3))) bf16x8*)(kp+6144); kf[7]=*(const __attribute__((address_space(3))) bf16x8*)(kp+6656);
}
__device__ __forceinline__ void kload2(bf16x8*kf,lds_cptr kp,int j){ kf[2*j]=*(const __attribute__((address_space(3))) bf16x8*)(kp+j*2048); kf[2*j+1]=*(const __attribute__((address_space(3))) bf16x8*)(kp+j*2048+512); }
__device__ __forceinline__ s16x4 vtr(lds_cptr p){ return __builtin_bit_cast(s16x4,__builtin_amdgcn_ds_read_tr16_b64_v4i16((__attribute__((address_space(3))) v4i16_t*)p)); }
__device__ __forceinline__ float rowmax(const f32x16&p0,const f32x16&p1){
  float a=max3f(p0[0],p0[1],p1[0]),b=max3f(p0[2],p0[3],p1[1]);a=max3f(a,p1[2],p1[3]);
  #pragma unroll
  for(int r=4;r<16;r+=4){a=max3f(a,p0[r],p0[r+1]);b=max3f(b,p0[r+2],p0[r+3]);a=max3f(a,p1[r],p1[r+1]);b=max3f(b,p1[r+2],p1[r+3]);}
  const float m=max2f(a,b);
  auto rr=__builtin_amdgcn_permlane32_swap(__float_as_uint(m),__float_as_uint(m),false,false);
  return max2f(__uint_as_float(rr[0]),__uint_as_float(rr[1]));
}
__device__ __forceinline__ void pv(f32x16*o,int vb,bf16x8 pa0,bf16x8 pa1,bf16x8 pa2,bf16x8 pa3){
  #pragma unroll
  for(int d0=0;d0<2;++d0){s16x4 lo[4],hi[4];
    #pragma unroll
    for(int ks=0;ks<4;++ks){
      asm volatile("ds_read_b64_tr_b16 %0,%1 offset:%c2":"=&v"(lo[ks]):"v"(vb),"i"(d0*4096+ks*1024):"memory");
      asm volatile("ds_read_b64_tr_b16 %0,%1 offset:%c2":"=&v"(hi[ks]):"v"(vb),"i"(d0*4096+ks*1024+512):"memory");}
    asm volatile("s_waitcnt lgkmcnt(0)":::"memory");SBAR();
    #define PK(k) (bf16x8){lo[k][0],lo[k][1],lo[k][2],lo[k][3],hi[k][0],hi[k][1],hi[k][2],hi[k][3]}
    o[d0]=__builtin_amdgcn_mfma_f32_32x32x16_bf16(pa0,PK(0),o[d0],0,0,0);
    o[d0]=__builtin_amdgcn_mfma_f32_32x32x16_bf16(pa1,PK(1),o[d0],0,0,0);
    o[d0]=__builtin_amdgcn_mfma_f32_32x32x16_bf16(pa2,PK(2),o[d0],0,0,0);
    o[d0]=__builtin_amdgcn_mfma_f32_32x32x16_bf16(pa3,PK(3),o[d0],0,0,0);
    #undef PK
  }
}

#ifndef ATTN_STORE16
#define ATTN_STORE16(p,v) (*(u32x4*)(p)=(v))
#endif
template<int THRL> __device__ __forceinline__ void attn_unit(int b,int h,int qb,const bf16*Q,const bf16*__restrict__ K,const bf16*__restrict__ V,bf16*O,const float*ksum,const float*nrm,char*shm){
  int tid_=threadIdx.x; asm volatile("":"+v"(tid_)); const int tid=tid_,lane=tid&63,r32=lane&31,hi=lane>>5; const int wid=__builtin_amdgcn_readfirstlane(tid>>6);
  const long rowbase=(long)b*SEQ; const int q0=qb*QB;
  const bf16*Qw=Q+(rowbase+q0+wid*QBLK)*DM+h*D;
  const bf16*Kh=K+rowbase*DM+h*D,*Vh=V+rowbase*DM+h*D;
  const unsigned lds0=(unsigned)(uintptr_t)shm;
  float*wsf=(float*)(shm+LDS_WS)+wid*64;
  const unsigned kvoff=(unsigned)(lane*DM+wid*8)*2u;
  const unsigned vvoff=(unsigned)((16*(wid&3)+(lane>>2))*DM+(wid>>2)*32+(lane&3)*8)*2u;
  const unsigned kdst=lds0+LDS_K+wid*1024, vdst=lds0+LDS_V+wid*1024;
  #define DMA_K(t,slot) glds16(Kh+(long)(NTF-1-(t))*KVBLK*DM,kvoff,(unsigned)__builtin_amdgcn_readfirstlane(kdst+(slot)))
  #define DMA_V(t,slot) glds16(Vh+(long)(NTF-1-(t))*KVBLK*DM,vvoff,(unsigned)__builtin_amdgcn_readfirstlane(vdst+(slot)))
  const int vb0=(int)(lds0+LDS_V)+((lane>>4)&1)*32+(lane&3)*8+(4*hi+((lane&15)>>2))*64;
  const char*Kbase=shm+LDS_K; bf16x8 kf[8];
  const lds_cptr shm3=(lds_cptr)shm; const lds_cptr kp0=shm3+LDS_K+hi*1024+r32*16; const lds_cptr vp0=shm3+LDS_V+((lane>>4)&1)*32+(lane&3)*8+(4*hi+((lane&15)>>2))*64;
  const int NTF=(q0+QB)/KVBLK;
  int NT=NTF;
  { const float*nq=nrm+(long)(b*2+0)*16+2*h,*nk=nrm+(long)(b*2+1)*16+2*h; const float B=__builtin_sqrtf((nq[0]+nq[1])*(nk[0]+nk[1]))*1.02f+0.5f;
    const float slope2_=__uint_as_float(0x3FB8AA3Bu-((unsigned)(h+1)<<23)); const float dh=(160.f+2.f*B)/slope2_;
    const float tminf=((float)(q0-63)-dh)*(1.f/64.f); int tmin=tminf>0.f?(int)tminf:0;
    tmin=__builtin_amdgcn_readfirstlane(tmin); int nt=NTF-tmin; nt+=nt&1; if(nt>NTF)nt=NTF; if(nt<4)nt=4; NT=nt; }
  { float*ksl=(float*)(shm+LDS_KSL); const float k0=ksum[(long)(b*16+(tid>>6))*512+h*64+(tid&63)],k1=ksum[(long)(b*16+8+(tid>>6))*512+h*64+(tid&63)]; ksl[tid]=k0; ksl[512+tid]=k1; }
  DMA_K(0,0);DMA_V(0,0);DMA_K(1,SLOTB);
  bf16x8 qr[4];
  #pragma unroll
  for(int d0=0;d0<4;++d0)qr[d0]=*reinterpret_cast<const bf16x8*>(&Qw[(long)r32*DM+d0*16+hi*8]);
  float mhat=0.f,l_reg=0.f;f32x16 o[2];o[0]=f32x16{};o[1]=f32x16{};const f32x16 zero16=f32x16{};
  const int qrel=wid*QBLK+r32;
  #define CMASK(P0,P1,t) do{int jb_=3-(t); if(jb_>=0)cmask(P0,P1,jb_,qrel,hi);}while(0)
  const unsigned sl2b=0x3FB8AA3Bu-((unsigned)(h+1)<<23);
  const float slope2=__uint_as_float(sl2b), s2x=__uint_as_float(sl2b+(1u<<23)), s8x=__uint_as_float(sl2b+(3u<<23)), s32=__uint_as_float(sl2b+(5u<<23));
  const float s3x=__uint_as_float((unsigned)__builtin_amdgcn_readfirstlane((int)__float_as_uint(slope2*3.0f)));
  #define NBSEL(r) (((r)>>2)==0?nbb0_:((r)>>2)==1?nbb1_:((r)>>2)==2?nbb2_:nbb3_)
  #define NEGV(r) ((((r)&3)==0)?NBSEL(r):(NBSEL(r)+(((r)&3)==1?slope2:((r)&3)==2?s2x:s3x)))
  #define NBB(nb) const float nbb0_=(nb), nbb1_=nbb0_+s8x, nbb2_=nbb1_+s8x, nbb3_=nbb2_+s8x
  #define NBSELC(r) (((r)>>2)==0?nbc0_:((r)>>2)==1?nbc1_:((r)>>2)==2?nbc2_:nbc3_)
  #define SAV(r) (((r)&3)==1?slope2:((r)&3)==2?s2x:s3x)
  #define BIAS(C0,C1,s) do{ NBB(NBV(s)); const float nbc0_=nbb0_+s32,nbc1_=nbb1_+s32,nbc2_=nbb2_+s32,nbc3_=nbb3_+s32; \
      _Pragma("unroll") for(int r=0;r<16;++r){ if((r&3)==0){C0[r]+=NBSEL(r);C1[r]+=NBSELC(r);} else {C0[r]=(C0[r]+NBSEL(r))+SAV(r);C1[r]=(C1[r]+NBSELC(r))+SAV(r);} } }while(0)
  unsigned sel=0u;
  #define NBV(s) ({ const int tl_=NTF-1-(s); const int tc_=tl_<0?0:tl_; const int bj_=tc_>>2; const float off_=(bj_>=qb||((sel>>bj_)&1u))?0.f:-1.0e30f; \
      __builtin_fmaf(slope2,(float)(64*tl_+4*hi-q0-qrel),off_-mhat); })
  #define CRC(r) ((float)(((r)&3)+8*((r)>>2)))
  bool resc=false;
  #define START(P0,P1) do{ const float rm=rowmax(P0,P1); resc=false; \
    { const float dl=(rm>-1.0e20f)?rm:0.f; mhat=fadd_s(mhat,dl); \
      _Pragma("unroll") for(int r=0;r<16;++r){P0[r]=fsub_s(P0[r],dl);P1[r]=fsub_s(P1[r],dl);} } \
    _Pragma("unroll") for(int r=0;r<16;++r)P0[r]=__builtin_amdgcn_exp2f(P0[r]); }while(0)
  #define RESC() do{ if(resc){ asm volatile("s_waitcnt lgkmcnt(0)":::"memory"); \
      _Pragma("unroll") for(int d_=0;d_<2;++d_) _Pragma("unroll") for(int r=0;r<16;++r)o[d_][r]*=wsf[crow(r,hi)]; } }while(0)
  f32x16 pA0,pA1,pB0,pB1;
  int sl_prev=0,sl_cur=0,sl_next=SLOTB;
  #define ROT() do{sl_prev=sl_cur;sl_cur=sl_next;sl_next=(sl_next==(NSLOT-1)*SLOTB)?0:sl_next+SLOTB;}while(0)
  DMA_K(2,2*SLOTB);
  WAIT_BAR(3);
  if(qb>0){
    float qf[32];
    _Pragma("unroll") for(int d0=0;d0<4;++d0) _Pragma("unroll") for(int e=0;e<8;++e) qf[d0*8+e]=__uint_as_float(((unsigned)(unsigned short)qr[d0][e])<<16);
    const float*ksl=(const float*)(shm+LDS_KSL)+8*hi;
    float b1=-3.0e38f,b2=-3.0e38f,b3=-3.0e38f; int i1=-1,i2=-1,i3=-1;
    for(int j=0;j<qb;++j){ float g=0.f;
      _Pragma("unroll") for(int d0=0;d0<4;++d0) _Pragma("unroll") for(int e=0;e<8;++e) g=__builtin_fmaf(qf[d0*8+e],ksl[j*64+16*d0+e],g);
      { auto rr=__builtin_amdgcn_permlane32_swap(__float_as_uint(g),__float_as_uint(g),false,false); g=__uint_as_float(rr[0])+__uint_as_float(rr[1]); }
      const bool c1=g>b1,c2=g>b2,c3=g>b3;
      b3=c2?b2:(c3?g:b3); i3=c2?i2:(c3?j:i3); b2=c1?b1:(c2?g:b2); i2=c1?i1:(c2?j:i2); b1=c1?g:b1; i1=c1?j:i1; }
    sel=(1u<<i1)|(i2>=0?(1u<<i2):0u)|(i3>=0?(1u<<i3):0u); }
  qkt(pA0,pA1,Kbase,qr,zero16,r32,hi);asm volatile("s_nop 15\n\ts_nop 7":"+v"(pA0),"+v"(pA1));
  BIAS(pA0,pA1,0);
  CMASK(pA0,pA1,0);
  START(pA0,pA1);
  _Pragma("unroll") for(int r=0;r<16;++r)pA1[r]=__builtin_amdgcn_exp2f(pA1[r]);
  WAIT_BAR(0);
  DMA_K(3,0);DMA_V(1,SLOTB);
  ROT();
  kload8(kf,kp0+sl_cur);
  WAIT_BAR(2);
  s16x4 vlo[8],vhi[8]; u32x4 pw0,pw1,pw2,pw3;
  #define PKW(P,B) cvtpk_s(P[B],P[B+1])
  #define PAF(k) __builtin_bit_cast(bf16x8,pw##k)
  #define VFR(i) (bf16x8){vlo[i][0],vlo[i][1],vlo[i][2],vlo[i][3],vhi[i][0],vhi[i][1],vhi[i][2],vhi[i][3]}
  #define PIN(x) asm volatile("":"+v"(x))
  #define MX3(a,b,c) __builtin_fmaxf(__builtin_fmaxf((a),(b)),(c))
  #define GAPA(MF,A0,A1,A2,A3,W0,W1,PW) do{ MF; sacc+=A0; sacc+=A1; sacc+=A2; sacc+=A3; PIN(sacc); W0; W1; PIN(PW); SBAR(); }while(0)
  #define EX(v) __builtin_amdgcn_exp2f(v)
  #define GAPB(MF,X,B) do{ MF; X[B]=EX(X[B]); X[B+1]=EX(X[B+1]); X[B+2]=EX(X[B+2]); X[B+3]=EX(X[B+3]); PIN(X); SBAR(); }while(0)
  #define VRD(i) do{ vlo[i]=vtr(vp_+(((i)>>2)*4096+((i)&3)*1024)); vhi[i]=vtr(vp_+(((i)>>2)*4096+((i)&3)*1024+512)); }while(0)
  #define KRD(G,j) do{ if(G){ kload2(kf,kp0+sl_next,j); SBAR(); } }while(0)
  #define STEP(C0,C1,P0,P1,t,GK,GV,GL) do{ SBAR(); \
    const lds_cptr vp_=vp0+sl_prev; \
    VRD(0); SBAR(); float sacc=(P0[0]+P0[1]); \
    GAPA(C0=__builtin_amdgcn_mfma_f32_32x32x16_bf16(kf[0],qr[0],zero16,0,0,0), P0[2],P0[3],P0[4],P0[5],     pw0[0]=PKW(P0,0), pw0[1]=PKW(P0,2), pw0); \
    VRD(4); SBAR(); GAPA(C1=__builtin_amdgcn_mfma_f32_32x32x16_bf16(kf[1],qr[0],zero16,0,0,0), P0[6],P0[7],P0[8],P0[9],     pw0[2]=PKW(P0,4), pw0[3]=PKW(P0,6), pw0); \
    VRD(1); SBAR(); GAPA(C0=__builtin_amdgcn_mfma_f32_32x32x16_bf16(kf[2],qr[1],C0,0,0,0),   P0[10],P0[11],P0[12],P0[13], pw1[0]=PKW(P0,8), pw1[1]=PKW(P0,10), pw1); \
    VRD(5); SBAR(); GAPA(C1=__builtin_amdgcn_mfma_f32_32x32x16_bf16(kf[3],qr[1],C1,0,0,0),   P0[14],P0[15],P1[0],P1[1],   pw1[2]=PKW(P0,12),pw1[3]=PKW(P0,14), pw1); \
    VRD(2); SBAR(); GAPA(C0=__builtin_amdgcn_mfma_f32_32x32x16_bf16(kf[4],qr[2],C0,0,0,0),   P1[2],P1[3],P1[4],P1[5],     pw2[0]=PKW(P1,0), pw2[1]=PKW(P1,2), pw2); \
    VRD(6); SBAR(); GAPA(C1=__builtin_amdgcn_mfma_f32_32x32x16_bf16(kf[5],qr[2],C1,0,0,0),   P1[6],P1[7],P1[8],P1[9],     pw2[2]=PKW(P1,4), pw2[3]=PKW(P1,6), pw2); \
    VRD(3); SBAR(); GAPA(C0=__builtin_amdgcn_mfma_f32_32x32x16_bf16(kf[6],qr[3],C0,0,0,0),   P1[10],P1[11],P1[12],P1[13], pw3[0]=PKW(P1,8), pw3[1]=PKW(P1,10), pw3); \
    VRD(7); SBAR(); GAPA(C1=__builtin_amdgcn_mfma_f32_32x32x16_bf16(kf[7],qr[3],C1,0,0,0),   P1[14],P1[15],0.f,0.f,       pw3[2]=PKW(P1,12),pw3[3]=PKW(P1,14), pw3); \
    l_reg+=sacc; \
    if(GK){DMA_K((t)+3,sl_cur);} if(GV){DMA_V((t)+1,sl_next);} \
    BIAS(C0,C1,t); \
    CMASK(C0,C1,t); \
    { float a=MX3(C0[0],C0[1],C1[0]),b=MX3(C0[2],C0[3],C1[1]); a=MX3(a,C1[2],C1[3]); \
      _Pragma("unroll") for(int r=4;r<16;r+=4){a=MX3(a,C0[r],C0[r+1]);b=MX3(b,C0[r+2],C0[r+3]);a=MX3(a,C1[r],C1[r+1]);b=MX3(b,C1[r+2],C1[r+3]);} \
      float rm=__builtin_fmaxf(a,b); { auto rr=__builtin_amdgcn_permlane32_swap(__float_as_uint(rm),__float_as_uint(rm),false,false); rm=__builtin_fmaxf(__uint_as_float(rr[0]),__uint_as_float(rr[1])); } \
      resc=false; \
      if(__builtin_expect(__any(rm>(float)THRL),0)){ const float dl=__builtin_fmaxf(rm,0.f); mhat+=dl; \
        _Pragma("unroll") for(int r=0;r<16;++r){C0[r]-=dl;C1[r]-=dl;} \
        const float f=__builtin_amdgcn_exp2f(-dl); l_reg*=f; if(hi==0)wsf[r32]=f; resc=true; } } \
    SBAR(); \
    GAPB(o[0]=__builtin_amdgcn_mfma_f32_32x32x16_bf16(PAF(0),VFR(0),o[0],0,0,0), C0,0); \
    GAPB(o[1]=__builtin_amdgcn_mfma_f32_32x32x16_bf16(PAF(0),VFR(4),o[1],0,0,0), C0,4); \
    KRD(GL,0); GAPB(o[0]=__builtin_amdgcn_mfma_f32_32x32x16_bf16(PAF(1),VFR(1),o[0],0,0,0), C0,8); \
    KRD(GL,1); GAPB(o[1]=__builtin_amdgcn_mfma_f32_32x32x16_bf16(PAF(1),VFR(5),o[1],0,0,0), C0,12); \
    KRD(GL,2); GAPB(o[0]=__builtin_amdgcn_mfma_f32_32x32x16_bf16(PAF(2),VFR(2),o[0],0,0,0), C1,0); \
    KRD(GL,3); GAPB(o[1]=__builtin_amdgcn_mfma_f32_32x32x16_bf16(PAF(2),VFR(6),o[1],0,0,0), C1,4); \
    GAPB(o[0]=__builtin_amdgcn_mfma_f32_32x32x16_bf16(PAF(3),VFR(3),o[0],0,0,0), C1,8); \
    GAPB(o[1]=__builtin_amdgcn_mfma_f32_32x32x16_bf16(PAF(3),VFR(7),o[1],0,0,0), C1,12); \
    }while(0)
  int t=1;
  #define ENDW(tt) do{ if((tt)+3<NT){WAIT_BAR(2);} else if((tt)+2<NT){WAIT_BAR(1);} else {WAIT_BAR(0);} }while(0)
  #define PEELED_PAIR() do{ \
    STEP(pB0,pB1,pA0,pA1,t,(t+3<NT),(t+1<NT),(t+1<NT));       ENDW(t);   RESC(); ROT(); \
    STEP(pA0,pA1,pB0,pB1,t+1,(t+4<NT),(t+2<NT),(t+2<NT));     ENDW(t+1); RESC(); ROT(); }while(0)
  for(;t<5&&t+1<NT;t+=2){ PEELED_PAIR(); }
  #undef CMASK
  #define CMASK(P0,P1,t) do{}while(0)
  for(;t+5<NT;t+=2){
    STEP(pB0,pB1,pA0,pA1,t,true,true,true);     WAIT_BAR(2); RESC(); ROT();
    STEP(pA0,pA1,pB0,pB1,t+1,true,true,true);   WAIT_BAR(2); RESC(); ROT();
  }
  #undef CMASK
  #define CMASK(P0,P1,t) do{int jb_=3-(t); if(jb_>=0)cmask(P0,P1,jb_,qrel,hi);}while(0)
  for(;t+1<NT;t+=2){ PEELED_PAIR(); }
  STEP(pB0,pB1,pA0,pA1,NT-1,false,false,false); RESC();
  { float sacc=pB0[0]+pB0[1]; _Pragma("unroll") for(int r=2;r<16;++r)sacc+=pB0[r]; _Pragma("unroll") for(int r=0;r<16;++r)sacc+=pB1[r]; l_reg+=sacc;
    pw0=(u32x4){PKW(pB0,0),PKW(pB0,2),PKW(pB0,4),PKW(pB0,6)};pw1=(u32x4){PKW(pB0,8),PKW(pB0,10),PKW(pB0,12),PKW(pB0,14)};pw2=(u32x4){PKW(pB1,0),PKW(pB1,2),PKW(pB1,4),PKW(pB1,6)};pw3=(u32x4){PKW(pB1,8),PKW(pB1,10),PKW(pB1,12),PKW(pB1,14)};
    SBAR(); pv(o,vb0+sl_cur,PAF(0),PAF(1),PAF(2),PAF(3)); }
  #undef PKW
  #undef PAF
  #undef VFR
  #undef PIN
  #undef MX3
  #undef GAPA
  #undef GAPB
  #undef EX
  #undef VRD
  #undef KRD
  #undef STEP
  #undef ENDW
  #undef PEELED_PAIR
  #undef NBV
  #undef CRC
  #undef NEGV
  #undef NBSEL
  #undef NBB
  #undef NBSELC
  #undef SAV
  #undef BIAS
  {auto rr=__builtin_amdgcn_permlane32_swap(__float_as_uint(l_reg),__float_as_uint(l_reg),false,false);l_reg=__uint_as_float(rr[0])+__uint_as_float(rr[1]);}
  if(hi==0)wsf[32+r32]=l_reg;asm volatile("s_waitcnt lgkmcnt(0)":::"memory");
  float rli[16];
  #pragma unroll
  for(int r=0;r<16;++r)rli[r]=__builtin_amdgcn_rcpf(wsf[32+crow(r,hi)]);
  bf16*Ow=O+(rowbase+q0+wid*QBLK)*DM+h*D;
  { bf16*stg=(bf16*)(shm+LDS_OST)+wid*2048;
    #pragma unroll
    for(int r=0;r<16;++r){const int orow=crow(r,hi);
      #pragma unroll
      for(int d0=0;d0<2;++d0)stg[orow*64+d0*32+r32]=__float2bfloat16(o[d0][r]*rli[r]);}
    asm volatile("s_waitcnt lgkmcnt(0)":::"memory");
    #pragma unroll
    for(int i=0;i<4;++i){const int row=i*8+(lane>>3),ch=lane&7; const u32x4 v=*(const u32x4*)(stg+row*64+ch*8); ATTN_STORE16(Ow+(long)row*DM+ch*8,v);} }
  asm volatile("s_waitcnt lgkmcnt(0)\n\ts_barrier":::"memory");
  #undef DMA_K
  #undef DMA_V
  #undef CMASK
  #undef START
  #undef RESC
  #undef ROT
}
constexpr int ATTN_LDS_BYTES=LDS_BYTES;
struct AttnTensors { const bf16* Q; const bf16* K; const bf16* V; bf16* O; };
struct AttnUnit { int bh; int qb; };
struct AttnPlan { unsigned char unit[32][12]; unsigned char n[32]; };
constexpr int attn_nominal_cost(int h,int qb){ const int pmax[8]={7,12,22,41,64,64,64,64}; const int past=4*qb<pmax[h]?4*qb:pmax[h]; return 4+past+2; }
constexpr AttnPlan make_attn_plan(){
  AttnPlan p{}; int load[32]={}; bool used[128]={};
  for(int it=0;it<128;++it){ int best=-1,bc=-1; for(int e=0;e<128;++e){ if(used[e])continue; const int c=attn_nominal_cost(e>>4,e&15); if(c>bc){bc=c;best=e;} }
    used[best]=true; int cu=0; for(int c=1;c<32;++c) if(load[c]<load[cu]||(load[c]==load[cu]&&p.n[c]<p.n[cu]))cu=c;
    if(p.n[cu]>=12){ for(int c=0;c<32;++c) if(p.n[c]<12){cu=c;break;} }
    p.unit[cu][p.n[cu]++]=(unsigned char)best; load[cu]+=bc; }
  return p; }
__device__ const AttnPlan g_attn_plan=make_attn_plan();
struct StaticOrder {
  int vcu,G;
  __device__ __forceinline__ explicit StaticOrder(int grid,int vcu_):vcu(vcu_),G(grid){}
  __device__ __forceinline__ bool next(int i,AttnUnit&u)const{
    if(G!=256){ const int id=vcu+i*G; if(id>=BATCH*NHEAD*NQB)return false; u.bh=id>>4; u.qb=id&15; return true; }
    const int c=vcu&31; if(i>=(int)g_attn_plan.n[c])return false; const int e=g_attn_plan.unit[c][i]; u.bh=(vcu>>5)*NHEAD+(e>>4); u.qb=e&15; return true; }
};
template<class Sched,int THRL=8> __device__ __forceinline__ void attn_phase(char*lds,const AttnTensors&T,const float*ksum,const float*nrm,const Sched&S){
  AttnUnit u;
  for(int i=0;S.next(i,u);++i){ attn_unit<THRL>(u.bh/NHEAD,u.bh%NHEAD,u.qb,T.Q,T.K,T.V,T.O,ksum,nrm,lds); }
}
#undef SBAR
#undef WAIT_BAR
}

__device__ __forceinline__ void pooled_phase(Frame& F, const Args& A) {
    const bf16* P = (const bf16*)(A.ws + WS_QKVP) + (size_t)3 * T * 512; bf16* PO = (bf16*)(A.ws + WS_POOLED);
    const int gw = F.vcu * NWAVES + F.wave, NGW = F.G * NWAVES, lane = F.lane, w = 2 << (lane >> 4);
    for (int tk = gw; tk < T / 16; tk += NGW) {
        const int row0 = tk * 16, s0 = row0 & (SEQ - 1);
        v4u rv[31];
#pragma unroll
        for (int i = 0; i < 31; ++i) { const int sidx = s0 - 15 + i; rv[i] = (sidx >= 0) ? *(const v4u*)(P + (size_t)(row0 - 15 + i) * 512 + 8 * lane) : (v4u){0u, 0u, 0u, 0u}; }
#pragma unroll
        for (int i = 0; i < 16; ++i) {
            const int sidx = s0 + i; float acc[8];
#pragma unroll
            for (int e = 0; e < 8; ++e) acc[e] = 0.f;
#pragma unroll
            for (int k = 0; k < 16; ++k) { const bool ok = (k < w) && (sidx - k >= 0); const v4u x = rv[15 + i - k]; const float msk = ok ? 1.0f : 0.0f;
                acc[0] += msk * bflo(x.x); acc[1] += msk * bfhi(x.x); acc[2] += msk * bflo(x.y); acc[3] += msk * bfhi(x.y); acc[4] += msk * bflo(x.z); acc[5] += msk * bfhi(x.z); acc[6] += msk * bflo(x.w); acc[7] += msk * bfhi(x.w); }
            const float inv = 1.0f / (float)min(sidx + 1, w); const v4u x = rv[15 + i];
            v4u o; o.x = pk2(acc[0] * inv - bflo(x.x), acc[1] * inv - bfhi(x.x)); o.y = pk2(acc[2] * inv - bflo(x.y), acc[3] * inv - bfhi(x.y));
            o.z = pk2(acc[4] * inv - bflo(x.z), acc[5] * inv - bfhi(x.z)); o.w = pk2(acc[6] * inv - bflo(x.w), acc[7] * inv - bfhi(x.w));
            *(v4u*)(PO + (size_t)(row0 + i) * 512 + 8 * lane) = o;
        }
    }
}

typedef float f32x2 __attribute__((ext_vector_type(2)));
typedef int v4i __attribute__((ext_vector_type(4)));
__device__ __forceinline__ void h2q_rows4(const Args& A, int t0, int lane) {
    const float* modf = (const float*)(A.ws + WS_MODF); const float* ss2 = (const float*)(A.ws + WS_SS2); const float* g2 = A.in[12];
    const int b = t0 / SEQ;
    f32x4 xv[4][4];
#pragma unroll
    for (int u = 0; u < 4; ++u)
#pragma unroll
        for (int q = 0; q < 4; ++q) xv[u][q] = *(const f32x4*)(A.out + (size_t)(t0 + u) * D + 16 * lane + 4 * q);
    f32x4 G[4], S[4];
#pragma unroll
    for (int q = 0; q < 4; ++q) { const int c = 16 * lane + 4 * q; G[q] = *(const f32x4*)(g2 + c) * (*(const f32x4*)(modf + (size_t)b * 6144 + 4096 + c) + 1.0f); S[q] = *(const f32x4*)(modf + (size_t)b * 6144 + 3072 + c); }
#pragma unroll
    for (int u = 0; u < 4; ++u) {
        const f32x4* sp = (const f32x4*)(ss2 + (size_t)(t0 + u) * 16); const f32x4 s4 = (sp[0] + sp[1]) + (sp[2] + sp[3]);
        const float rs = 1.0f / sqrtf(((s4[0] + s4[1]) + (s4[2] + s4[3])) * (1.0f / D) + RMS_EPS);
        float h2[16]; float am = 0.f;
#pragma unroll
        for (int q = 0; q < 4; ++q)
#pragma unroll
            for (int e = 0; e < 4; ++e) { const float h = xv[u][q][e] * rs * G[q][e] + S[q][e]; h2[4 * q + e] = h; am = fmaxf(am, fabsf(h)); }
        am = fmaxf(am, __shfl_xor(am, 1)); am = fmaxf(am, __shfl_xor(am, 2)); am = fmaxf(am, __shfl_xor(am, 4));
        const float hs = (am > 0.f) ? am * (1.0f / 127.0f) : 1.0f, hinv = 1.0f / hs;
        v4u o;
#pragma unroll
        for (int q = 0; q < 4; ++q) { const int q0 = (int)rintf(h2[4 * q] * hinv), q1 = (int)rintf(h2[4 * q + 1] * hinv), q2 = (int)rintf(h2[4 * q + 2] * hinv), q3 = (int)rintf(h2[4 * q + 3] * hinv);
            o[q] = (unsigned)(q0 & 255) | ((unsigned)(q1 & 255) << 8) | ((unsigned)(q2 & 255) << 16) | ((unsigned)q3 << 24); }
        *(v4u*)(A.ws + WS_H2Q + (size_t)(t0 + u) * D + 16 * lane) = o;
        if ((lane & 7) == 0) ((float*)(A.ws + WS_HS))[(size_t)(t0 + u) * 8 + (lane >> 3)] = hs;
    }
}

namespace rt {
typedef float f32x16 __attribute__((ext_vector_type(16)));
typedef short bf16x8 __attribute__((ext_vector_type(8)));
__device__ __forceinline__ void ce(float& hi, float& lo) { const float a = fmaxf(hi, lo), b = fminf(hi, lo); hi = a; lo = b; }
template <int N> __device__ __forceinline__ void sort_desc(float (&v)[N]) {
#pragma unroll
    for (int k = 2; k <= N; k <<= 1)
#pragma unroll
        for (int j = k >> 1; j > 0; j >>= 1)
#pragma unroll
            for (int i = 0; i < N; ++i) { const int l = i ^ j; if (l > i) { if ((i & k) == 0) ce(v[i], v[l]); else ce(v[l], v[i]); } }
}
__device__ __forceinline__ void sort16_desc(float (&v)[16]) {
    ce(v[0], v[13]); ce(v[1], v[12]); ce(v[2], v[15]); ce(v[3], v[14]); ce(v[4], v[8]); ce(v[5], v[6]); ce(v[7], v[11]); ce(v[9], v[10]);
    ce(v[0], v[5]); ce(v[1], v[7]); ce(v[2], v[9]); ce(v[3], v[4]); ce(v[6], v[13]); ce(v[8], v[14]); ce(v[10], v[15]); ce(v[11], v[12]);
    ce(v[0], v[1]); ce(v[2], v[3]); ce(v[4], v[5]); ce(v[6], v[8]); ce(v[7], v[9]); ce(v[10], v[11]); ce(v[12], v[13]); ce(v[14], v[15]);
    ce(v[0], v[2]); ce(v[1], v[3]); ce(v[4], v[10]); ce(v[5], v[11]); ce(v[6], v[7]); ce(v[8], v[9]); ce(v[12], v[14]); ce(v[13], v[15]);
    ce(v[1], v[2]); ce(v[3], v[12]); ce(v[4], v[6]); ce(v[5], v[7]); ce(v[8], v[10]); ce(v[9], v[11]); ce(v[13], v[14]);
    ce(v[1], v[4]); ce(v[2], v[6]); ce(v[5], v[8]); ce(v[7], v[10]); ce(v[9], v[13]); ce(v[11], v[14]);
    ce(v[2], v[4]); ce(v[3], v[6]); ce(v[9], v[12]); ce(v[11], v[13]);
    ce(v[3], v[5]); ce(v[6], v[8]); ce(v[7], v[9]); ce(v[10], v[12]);
    ce(v[3], v[4]); ce(v[5], v[6]); ce(v[7], v[8]); ce(v[9], v[10]); ce(v[11], v[12]);
    ce(v[6], v[7]); ce(v[8], v[9]);
}
template <int N> __device__ __forceinline__ void bitonic_merge_desc(float (&v)[N]) {
#pragma unroll
    for (int j = N >> 1; j > 0; j >>= 1)
#pragma unroll
        for (int i = 0; i < N; ++i) { const int l = i ^ j; if (l > i) ce(v[i], v[l]); }
}
__device__ __forceinline__ void merge_top16(float (&a)[16], const float (&b)[16]) {
#pragma unroll
    for (int i = 0; i < 16; ++i) a[i] = fmaxf(a[i], b[15 - i]);
    bitonic_merge_desc<16>(a);
}
template <bool SORT> __device__ __forceinline__ void pair_merge(float (&a)[16], bool hi) {
    float w[16];
#pragma unroll
    for (int i = 0; i < 16; ++i) w[i] = hi ? a[15 - i] : a[i];
#pragma unroll
    for (int i = 0; i < 16; ++i) { const auto rr = __builtin_amdgcn_permlane32_swap(__float_as_uint(w[i]), __float_as_uint(w[i]), false, false); a[i] = fmaxf(__uint_as_float(rr[0]), __uint_as_float(rr[1])); }
    if (SORT) bitonic_merge_desc<16>(a);
}
__device__ __forceinline__ void fold_tile(const f32x16& acc, int kt, int hi, float (&out)[16]) {
    float g[16];
#pragma unroll
    for (int r = 0; r < 16; ++r) { const unsigned key = (unsigned)(32 * kt + (r & 3) + 8 * (r >> 2)); g[r] = __uint_as_float((__float_as_uint(acc[r]) & ~127u) | key | ((unsigned)hi << 2)); }
    sort16_desc(g);
    if (kt == 0) {
#pragma unroll
        for (int r = 0; r < 16; ++r) out[r] = g[r];
    } else merge_top16(out, g);
}
}
__device__ __forceinline__ void router_phase(Frame& F, const Args& A) {
    using namespace rt;
    const bf16* QP = (const bf16*)(A.ws + WS_GAB); const bf16* SK = (const bf16*)(A.ws + WS_SUBK);
    unsigned short* IDX = (unsigned short*)(A.ws + WS_POOLED); float* GATE = (float*)(A.ws + WS_POOLED + 16 * MiB);
    const int lane = F.lane, n32 = lane & 31, hi = lane >> 5, gw = F.vcu * NWAVES + F.wave, NGW = F.G * NWAVES;
    __syncthreads();
    for (int i = F.tid; i < 2 * 128 * 16; i += NTHREADS) { const int r = i >> 4, ch = i & 15; *(LAS v4u*)(F.lds + r * 272 + ch * 16) = *(const v4u*)(SK + (size_t)r * 128 + ch * 8); }
    __syncthreads();
    LAS unsigned char* scr = F.lds + 73728 + F.wave * 1024;
    const LAS unsigned char* afrag = F.lds + n32 * 272 + hi * 16;
    bf16x8 qa[8], qb[8];
#define RT_QLOAD(task_, p_, q_) do { const int tq_ = (task_) * 4 + (n32 >> 3); const bf16* qr_ = QP + (size_t)tq_ * PQW + (n32 & 7) * 256 + (p_) * 128 + 8 * hi; \
        _Pragma("unroll") for (int i = 0; i < 8; ++i) q_[i] = __builtin_nontemporal_load((const bf16x8*)(qr_ + 16 * i)); } while (0)
#define RT_HALF(p_, q_, out_) do { _Pragma("unroll") for (int kt = 0; kt < 4; ++kt) { f32x16 acc = f32x16{}; \
        _Pragma("unroll") for (int ks = 0; ks < 8; ++ks) { const bf16x8 kf = *(const LAS bf16x8*)(afrag + ((p_) * 128 + 32 * kt) * 272 + 32 * ks); acc = __builtin_amdgcn_mfma_f32_32x32x16_bf16(kf, q_[ks], acc, 0, 0, 0); } \
        fold_tile(acc, kt, hi, out_); } pair_merge<true>(out_, hi != 0); } while (0)
    if (gw < T * PHEADS / 32) RT_QLOAD(gw, 0, qa);
#ifdef TABLES_IN_ROUTER
    int tr0 = gw; const bool late_trip = F.wave >= 4;
#define RT_TABLE_TRIP(cond_) do { if (cond_) { asm volatile("" ::: "memory"); if (tr0 < 2 * PEXP) { p0_table_trip(A, tr0, NGW, lane); tr0 += 4 * NGW; } asm volatile("" ::: "memory"); h2q_rows4(A, task * 4, lane); asm volatile("" ::: "memory"); } } while (0)
#else
#define RT_TABLE_TRIP(cond_) do { } while (0)
#endif
    for (int task = gw; task < T * PHEADS / 32; task += NGW) {
        const int t = task * 4 + (n32 >> 3), h = n32 & 7;
        float la[16], lb[16];
        RT_TABLE_TRIP(!late_trip);
        RT_QLOAD(task, 1, qb);
        RT_HALF(0, qa, la);
        { const int nxt = task + NGW; if (nxt < T * PHEADS / 32) RT_QLOAD(nxt, 0, qa); }
        RT_HALF(1, qb, lb);
        { unsigned w[4];
#pragma unroll
          for (int q = 0; q < 4; ++q) {
              const unsigned i0 = __float_as_uint(hi ? lb[4 * q] : la[4 * q]) & 127u, i1 = __float_as_uint(hi ? lb[4 * q + 1] : la[4 * q + 1]) & 127u, i2 = __float_as_uint(hi ? lb[4 * q + 2] : la[4 * q + 2]) & 127u, i3 = __float_as_uint(hi ? lb[4 * q + 3] : la[4 * q + 3]) & 127u;
              w[q] = i0 | (i1 << 8) | (i2 << 16) | (i3 << 24); }
          *(LAS v4u*)(scr + n32 * 32 + hi * 16) = (v4u){w[0], w[1], w[2], w[3]}; }
        float x[16], y[16];
#pragma unroll
        for (int i = 0; i < 16; ++i) { const float av = __uint_as_float(__float_as_uint(la[i]) & ~127u), bv = __uint_as_float(__float_as_uint(lb[i]) & ~127u); x[i] = hi ? bv : av; y[i] = hi ? av : bv; }
        float c0[16], c1[16];
        {
            const unsigned hb = (unsigned)hi << 8;
#define RT_CAND(i, j) __uint_as_float(((__float_as_uint(x[i] + y[j]) & ~511u) | (unsigned)((i) * 16 + (j))) | hb)
#define RT_DIAG(i) (hi ? -3.0e38f : RT_CAND(i, i))
            c0[0] = RT_DIAG(0);
#pragma unroll
            for (int j = 1; j < 16; ++j) c0[j] = RT_CAND(0, j);
            c1[0] = RT_DIAG(1);
#pragma unroll
            for (int j = 2; j < 8; ++j) c1[j - 1] = RT_CAND(1, j);
            c1[7] = RT_DIAG(2); c1[8] = RT_CAND(2, 3); c1[9] = RT_CAND(2, 4); c1[10] = RT_DIAG(3);
#pragma unroll
            for (int k = 11; k < 16; ++k) c1[k] = -3.0e38f;
#undef RT_CAND
#undef RT_DIAG
        }
        sort16_desc(c0); sort16_desc(c1); merge_top16(c0, c1);
        pair_merge<false>(c0, hi != 0);
        float mx = c0[0];
#pragma unroll
        for (int i = 1; i < 16; ++i) mx = fmaxf(mx, c0[i]);
        float ex[16], sm = 0.f;
#pragma unroll
        for (int i = 0; i < 16; ++i) { ex[i] = __expf(__uint_as_float(__float_as_uint(c0[i]) & ~511u) - mx); sm += ex[i]; }
        const float inv = 1.0f / sm;
        asm volatile("s_waitcnt lgkmcnt(0)" ::: "memory");
        int eo[8]; float go[8];
#pragma unroll
        for (int k = 0; k < 8; ++k) { const float wv = hi ? c0[8 + k] : c0[k]; go[k] = (hi ? ex[8 + k] : ex[k]) * inv;
            const unsigned bits = __float_as_uint(wv), fromhi = (bits >> 8) & 1u, xi = (bits >> 4) & 15u, yj = bits & 15u;
            const unsigned ar = fromhi ? yj : xi, br = fromhi ? xi : yj;
            const unsigned e1 = scr[n32 * 32 + ar], e2 = scr[n32 * 32 + 16 + br];
            eo[k] = (int)(e1 * 128u + e2); }
        unsigned short* ip = IDX + (size_t)t * PSEL + h * PTOP + 8 * hi; float* gp = GATE + (size_t)t * PSEL + h * PTOP + 8 * hi;
        *(v4u*)ip = (v4u){(unsigned)eo[0] | ((unsigned)eo[1] << 16), (unsigned)eo[2] | ((unsigned)eo[3] << 16), (unsigned)eo[4] | ((unsigned)eo[5] << 16), (unsigned)eo[6] | ((unsigned)eo[7] << 16)};
        *(f32x4*)gp = (f32x4){go[0], go[1], go[2], go[3]}; *(f32x4*)(gp + 4) = (f32x4){go[4], go[5], go[6], go[7]};
        asm volatile("s_waitcnt lgkmcnt(0)" ::: "memory");
        RT_TABLE_TRIP(late_trip);
    }
#ifdef TABLES_IN_ROUTER
    while (tr0 < 2 * PEXP) { p0_table_trip(A, tr0, NGW, lane); tr0 += 4 * NGW; }
#endif
#undef RT_TABLE_TRIP
#undef RT_QLOAD
#undef RT_HALF
    __syncthreads();
}

__device__ __forceinline__ float gelu_tanh(float x) { const float u = 0.7978845608028654f * (x + 0.044715f * x * x * x); return x / (1.0f + __expf(-2.0f * u)); }
__device__ __forceinline__ void peer_sliced_phase(Frame& F, const Args& A) {
    const int lane = F.lane, c8 = lane & 7, g8 = lane >> 3, gw = F.vcu * NWAVES + F.wave, NGW = F.G * NWAVES;
    const float* modf = (const float*)(A.ws + WS_MODF);
    const unsigned char* U8 = A.ws + WS_U; const unsigned char* V8 = A.ws + WS_V;
    const f32x2* SUV = (const f32x2*)(A.ws + WS_U + 16 * MiB);
    const unsigned short* IDX = (const unsigned short*)(A.ws + WS_POOLED); const float* GATE = (const float*)(A.ws + WS_POOLED + 16 * MiB);
    const float* gf = A.in[17];
    LAS float* AL = (LAS float*)(F.lds + F.wave * 17664);
    LAS float* SSQ = AL + 2048;
    LAS float* SAV = AL + 3072;
    LAS float* RS2 = AL + 3088;
    LAS float* GS = AL + 3104;
    LAS unsigned short* IDL = (LAS unsigned short*)(AL + 3360);
    for (int tb = gw * 16; tb < T; tb += NGW * 16) {
        for (int i = lane; i < 2048; i += 64) AL[i] = 0.f;
        for (int i = lane; i < 1024; i += 64) SSQ[i] = 0.f;
#pragma unroll
        for (int i = 0; i < 16; ++i) *(LAS unsigned*)(IDL + i * 128 + 2 * lane) = *(const unsigned*)(IDX + (size_t)(tb + i) * PSEL + 2 * lane);
        LDS_WAIT();
        {
            v4i W0[16], W1[16], H0, H1, H; float hs0, hs1, hs;
            const unsigned char* H2Q = A.ws + WS_H2Q; const float* HS = (const float*)(A.ws + WS_HS);
#define PU_X(k, Hx, hx) do { const int k_ = (k) < 128 ? (k) : 127; const int s_ = k_ >> 4, t_ = tb + (k_ & 15); Hx = *(const v4i*)(H2Q + (size_t)t_ * D + 128 * s_ + 16 * c8); hx = HS[(size_t)t_ * 8 + s_]; } while (0)
#define PU_B(k, W) do { const int k_ = (k) < 128 ? (k) : 127; const int s_ = k_ >> 4; const unsigned base_ = ((unsigned)s_ << 21) + 16u * (unsigned)c8; v4u I[2]; I[0] = *(const LAS v4u*)(IDL + (k_ & 15) * 128 + 16 * g8); I[1] = *(const LAS v4u*)(IDL + (k_ & 15) * 128 + 16 * g8 + 8); \
            _Pragma("unroll") for (int j = 0; j < 16; ++j) W[j] = *(const v4i*)(U8 + (base_ + (((I[j >> 3][(j >> 1) & 3] >> (16 * (j & 1))) & 0xffffu) << 7))); \
            } while (0)
#define PU_Q(k, Hx, hx) do { H = Hx; hs = hx; } while (0)
#define PU_C(k, W) do { int part[16]; \
            _Pragma("unroll") for (int j = 0; j < 16; ++j) part[j] = __builtin_amdgcn_sdot4(W[j].x, H.x, __builtin_amdgcn_sdot4(W[j].y, H.y, __builtin_amdgcn_sdot4(W[j].z, H.z, __builtin_amdgcn_sdot4(W[j].w, H.w, 0, false), false), false), false); \
            _Pragma("unroll") for (int step = 4; step >= 1; step >>= 1) { const bool up = (lane & step) != 0; \
                _Pragma("unroll") for (int i = 0; i < 2 * step; ++i) { const int send = up ? part[i] : part[i + 2 * step], keep = up ? part[i + 2 * step] : part[i]; part[i] = keep + __shfl_xor(send, step); } } \
            LAS f32x2* ap_ = (LAS f32x2*)(AL + ((k) & 15) * 128 + 2 * lane); f32x2 a_ = *ap_; a_.x += hs * (float)part[0]; a_.y += hs * (float)part[1]; *ap_ = a_; } while (0)
            PU_X(0, H0, hs0); PU_X(1, H1, hs1); PU_B(0, W0);
#pragma unroll 1
            for (int k = 0; k < 128; k += 2) {
                PU_Q(k, H0, hs0); PU_B(k + 1, W1); PU_X(k + 2, H0, hs0);
                PU_C(k, W0);
                PU_Q(k + 1, H1, hs1); PU_B(k + 2, W0); PU_X(k + 3, H1, hs1);
                PU_C(k + 1, W1);
            }
#undef PU_X
#undef PU_B
#undef PU_Q
#undef PU_C
        }
        LDS_WAIT();
#pragma unroll 4
        for (int i = 0; i < 16; ++i) {
            const int t = tb + i; const unsigned e01 = *(const LAS unsigned*)(IDL + i * 128 + 2 * lane); const int e0 = (int)(e01 & 0xffffu), e1 = (int)(e01 >> 16);
            const f32x2 gt = *(const f32x2*)(GATE + (size_t)t * PSEL + 2 * lane); const f32x2 a = *(LAS f32x2*)(AL + i * 128 + 2 * lane);
            const f32x2 s0 = SUV[e0], s1 = SUV[e1];
            f32x2 av; av.x = gelu_tanh(a.x * s0.x) * gt.x * s0.y; av.y = gelu_tanh(a.y * s1.x) * gt.y * s1.y;
            const float am = wave_max(fmaxf(fabsf(av.x), fabsf(av.y))); const float as = (am > 0.f) ? am * (1.0f / 127.0f) : 1.0f, ainv = 1.0f / as;
            const int q0 = (int)rintf(av.x * ainv), q1 = (int)rintf(av.y * ainv);
            *(LAS unsigned short*)((LAS unsigned char*)AL + i * 512 + 2 * lane) = (unsigned short)((unsigned)(q0 & 255) | ((unsigned)(q1 & 255) << 8));
            if (lane == 0) SAV[i] = as;
        }
        LDS_WAIT();
        {
            v4u W0[16], W1[16]; f32x2 X0, X1, gt2v = (f32x2){0.f, 0.f};
            const int b = tb / SEQ;
#define PV_B(k, W, X) do { const int k_ = (k) < 128 ? (k) : 127; const int s_ = k_ >> 4, t_ = tb + (k_ & 15); const unsigned base_ = ((unsigned)s_ << 21) + 16u * (unsigned)c8; v4u I[2]; I[0] = *(const LAS v4u*)(IDL + (k_ & 15) * 128 + 16 * g8); I[1] = *(const LAS v4u*)(IDL + (k_ & 15) * 128 + 16 * g8 + 8); \
            _Pragma("unroll") for (int j = 0; j < 16; ++j) W[j] = *(const v4u*)(V8 + (base_ + (((I[j >> 3][(j >> 1) & 3] >> (16 * (j & 1))) & 0xffffu) << 7))); \
            X = __builtin_nontemporal_load((const f32x2*)(A.out + (size_t)t_ * D + 128 * s_ + 16 * c8 + 2 * g8)); } while (0)
#define PV_D(W, q4, d, cm) do { const unsigned r0 = W[4 * (q4)].cm, r1 = W[4 * (q4) + 1].cm, r2 = W[4 * (q4) + 2].cm, r3 = W[4 * (q4) + 3].cm; \
                    const unsigned t0 = __builtin_amdgcn_perm(r1, r0, 0x05010400u), t1 = __builtin_amdgcn_perm(r1, r0, 0x07030602u), t2 = __builtin_amdgcn_perm(r3, r2, 0x05010400u), t3 = __builtin_amdgcn_perm(r3, r2, 0x07030602u); \
                    pi[4 * d] = __builtin_amdgcn_sdot4((int)__builtin_amdgcn_perm(t2, t0, 0x05040100u), aq, pi[4 * d], false); pi[4 * d + 1] = __builtin_amdgcn_sdot4((int)__builtin_amdgcn_perm(t2, t0, 0x07060302u), aq, pi[4 * d + 1], false); \
                    pi[4 * d + 2] = __builtin_amdgcn_sdot4((int)__builtin_amdgcn_perm(t3, t1, 0x05040100u), aq, pi[4 * d + 2], false); pi[4 * d + 3] = __builtin_amdgcn_sdot4((int)__builtin_amdgcn_perm(t3, t1, 0x07060302u), aq, pi[4 * d + 3], false); } while (0)
#define PV_Q(W, q4, acm) do { const int aq = (int)a4_.acm; PV_D(W, q4, 0, x); PV_D(W, q4, 1, y); PV_D(W, q4, 2, z); PV_D(W, q4, 3, w); } while (0)
#define PV_C(k, W, X) do { const int s_ = (k) >> 4, i_ = (k) & 15; \
            if (i_ == 0) gt2v = *(const f32x2*)(modf + (size_t)b * 6144 + 5120 + 128 * s_ + 16 * c8 + 2 * g8); \
            int pi[16]; _Pragma("unroll") for (int q = 0; q < 16; ++q) pi[q] = 0; \
            const v4u a4_ = *(const LAS v4u*)((const LAS unsigned char*)AL + i_ * 512 + 16 * g8); \
            PV_Q(W, 0, x); PV_Q(W, 1, y); PV_Q(W, 2, z); PV_Q(W, 3, w); \
            float pc[16]; _Pragma("unroll") for (int q = 0; q < 16; ++q) pc[q] = (float)pi[q];        \
            _Pragma("unroll") for (int step = 4; step >= 1; step >>= 1) { const bool up = (g8 & step) != 0; \
                _Pragma("unroll") for (int i = 0; i < 2 * step; ++i) { const float send = up ? pc[i] : pc[i + 2 * step], keep = up ? pc[i + 2 * step] : pc[i]; pc[i] = keep + __shfl_xor(send, 8 * step); } } \
            const float sav_ = SAV[i_]; f32x2 x2_; x2_.x = X.x + gt2v.x * (sav_ * pc[0]); x2_.y = X.y + gt2v.y * (sav_ * pc[1]); \
            *(f32x2*)(A.out + (size_t)(tb + i_) * D + 128 * s_ + 16 * c8 + 2 * g8) = x2_; \
            SSQ[i_ * 64 + lane] += x2_.x * x2_.x + x2_.y * x2_.y; } while (0)
            PV_B(0, W0, X0);
#pragma unroll 1
            for (int k = 0; k < 128; k += 2) {
                PV_B(k + 1, W1, X1);
                PV_C(k, W0, X0);
                PV_B(k + 2, W0, X0);
                PV_C(k + 1, W1, X1);
            }
#undef PV_B
#undef PV_C
#undef PV_D
#undef PV_Q
        }
        VM_WAIT(); LDS_WAIT();
#pragma unroll 2
        for (int i = 0; i < 16; ++i) {
            float* xr = A.out + (size_t)(tb + i) * D + 16 * lane;
            f32x4 v[4];
#pragma unroll
            for (int q = 0; q < 4; ++q) v[q] = __builtin_nontemporal_load((const f32x4*)(xr + 4 * q));
            const float rs = 1.0f / sqrtf(wave_sum(SSQ[i * 64 + lane]) * (1.0f / D) + RMS_EPS);
#pragma unroll
            for (int q = 0; q < 4; ++q) *(f32x4*)(xr + 4 * q) = v[q] * rs * *(const f32x4*)(gf + 16 * lane + 4 * q);
        }
        LDS_WAIT();
    }
}

#ifndef PHASE_ONLY
#define PHASE_ONLY -1
#endif
#ifndef PHASE_SKIP
#define PHASE_SKIP -2
#endif
#define PH(n) ((PHASE_ONLY < 0 || PHASE_ONLY == (n)) && PHASE_SKIP != (n))
#ifndef PROBE_DOUBLE
#define PROBE_DOUBLE -1
#endif
#define REPS(n) for (int rep_ = 0; rep_ < ((PROBE_DOUBLE == (n)) ? 2 : 1); ++rep_)
__global__ void __launch_bounds__(NTHREADS, 2) fwd_megakernel(Args A) {
    extern __shared__ __attribute__((aligned(16))) unsigned char lds[];
    Frame F;
    F.lds = (LAS unsigned char*)lds;
    F.MISC = (volatile LAS unsigned*)(F.lds + MISC_OFF);
    F.tid = threadIdx.x; F.lane = F.tid & 63; F.wave = __builtin_amdgcn_readfirstlane(F.tid >> 6);
    F.G = gridDim.x; { const int bx = blockIdx.x; F.vcu = (F.G % 8 == 0) ? (bx % 8) * (F.G / 8) + bx / 8 : bx; }
    F.ctl = (gu32*)(A.ws + WS_CTL);
    for (int u = F.tid; u < (LDS_BYTES - LDSCTL_OFF) / 4; u += NTHREADS) ((LAS unsigned*)(F.lds + LDSCTL_OFF))[u] = 0u;
    __syncthreads();
    XcdBarrier bar = xcd_barrier_post((unsigned*)(F.ctl + CW_BAR), F.MISC + 8);
#define GRID_BAR() do { xcd_barrier(bar); int t_ = threadIdx.x; asm volatile("" : "+v"(t_)); F.tid = t_; F.lane = t_ & 63; F.wave = __builtin_amdgcn_readfirstlane(t_ >> 6); } while (0)
    unsigned char* ws = A.ws;

    REPS(0) if (PH(0)) { p0a_mod(F, A); p0b_prologue<0>(F, A); }
    GRID_BAR();
    REPS(1) if (PH(1)) p0b_prologue<1>(F, A);
    GRID_BAR();
    REPS(2) if (PH(2)) {
        pg8::Gemm g{(const bf16*)(ws + WS_XG), nullptr, (const bf16*)(ws + WS_WIN), nullptr, D, D, D};
        pg8::StaticOrder S; S.init(T, INW, F.G, (int)blockIdx.x);
        pg8::EpiIn E{(bf16*)(ws + WS_QKVP), (bf16*)(ws + WS_GAB), (const float*)(ws + WS_RSTD1), (const float*)(ws + WS_BIAS1P), (float*)(ws + WS_KSUM), (unsigned*)(ws + WS_CTL) + CW_NRM};
        pg8::gemm_phase<pg8::EpiIn, pg8::StaticOrder, true, true>(F.lds + RING_OFF, g, S, E);
    }
    GRID_BAR();
    REPS(3) if (PH(3)) {
        const attn_body::AttnTensors AT{(const attn_body::bf16*)(ws + WS_QKVP), (const attn_body::bf16*)(ws + WS_QKVP) + (size_t)T * 512, (const attn_body::bf16*)(ws + WS_QKVP) + (size_t)2 * T * 512, (PROBE_DOUBLE == 3 && rep_ == 0) ? (attn_body::bf16*)(ws + WS_XG) : (attn_body::bf16*)(ws + WS_QKVP)};
        const attn_body::StaticOrder S((int)F.G, F.vcu);
        attn_body::attn_phase<attn_body::StaticOrder>((char*)lds + RING_OFF, AT, (const float*)(ws + WS_KSUM), (const float*)((const unsigned*)(ws + WS_CTL) + CW_NRM), S);
    }
    REPS(4) if (PH(4)) pooled_phase(F, A);
    GRID_BAR();
    REPS(5) if (PH(5)) {
        pg8::Gemm g{(const bf16*)(ws + WS_QKVP), (const bf16*)(ws + WS_POOLED), (const bf16*)(ws + WS_WA), (const bf16*)(ws + WS_WP), AW, AW, AW};
        pg8::DualOrder S; S.init(T, D, F.G, (int)blockIdx.x);
        pg8::EpiUp E{(bf16*)(ws + WS_XG), (const bf16*)(ws + WS_GAB), (const float*)(ws + WS_BPRIME)};
        pg8::gemm_phase<pg8::EpiUp, pg8::DualOrder, true, true>(F.lds + RING_OFF, g, S, E);
    }
    GRID_BAR();
    REPS(6) if (PH(6)) {
        pg8::Gemm g{(const bf16*)(ws + WS_XG), nullptr, (const bf16*)(ws + WS_WOUT), nullptr, D, D, D};
        pg8::StaticOrder S; S.init(T, D, F.G, (int)blockIdx.x);
        pg8::EpiOut E{A.in[0], A.out, (bf16*)(ws + WS_QKVP), (const float*)(ws + WS_MODF), A.in[12], (float*)(ws + WS_SS2)};
        pg8::gemm_phase<pg8::EpiOut, pg8::StaticOrder, true, true>(F.lds + RING_OFF, g, S, E);
    }
    GRID_BAR();
    REPS(7) if (PH(7)) {
        pg8::Gemm g{(const bf16*)(ws + WS_QKVP), nullptr, (const bf16*)(ws + WS_WQ), nullptr, D, D, D};
        pg8::StaticOrder S; S.init(T, PQW, F.G, (int)blockIdx.x);
        pg8::EpiPq E{(bf16*)(ws + WS_GAB), (const float*)(ws + WS_SS2), (const float*)(ws + WS_BIAS2P)};
        pg8::gemm_phase<pg8::EpiPq, pg8::StaticOrder, true, true>(F.lds + RING_OFF, g, S, E);
    }
    GRID_BAR();
    REPS(8) if (PH(8)) router_phase(F, A);
    GRID_BAR();
    if (PH(9)) peer_sliced_phase(F, A);
}

extern "C" void kernel_launch(void* const* d_in, const int* in_sizes, int n_in, void* d_out, int out_size, void* d_ws, size_t ws_size, hipStream_t stream) {
    static int grid = 0;
    if (grid == 0) {
        if (n_in != 18 || in_sizes[0] != T * D || out_size != T * D || ws_size < WS_END) { fprintf(stderr, "kernel_launch: unexpected shapes (n_in %d, in0 %d, out %d, ws %zu); nothing launched\n", n_in, n_in > 0 ? in_sizes[0] : -1, out_size, ws_size); grid = -1; return; }
        int dev = 0, cus = 0, per_cu = 0;
        if (hipGetDevice(&dev) != hipSuccess || hipDeviceGetAttribute(&cus, hipDeviceAttributeMultiprocessorCount, dev) != hipSuccess) { grid = -1; return; }
        if (hipFuncSetAttribute((const void*)fwd_megakernel, hipFuncAttributeMaxDynamicSharedMemorySize, LDS_BYTES) != hipSuccess) { fprintf(stderr, "kernel_launch: hipFuncSetAttribute failed\n"); grid = -1; return; }
        if (hipOccupancyMaxActiveBlocksPerMultiprocessor(&per_cu, (const void*)fwd_megakernel, NTHREADS, LDS_BYTES) != hipSuccess || per_cu < 1) { fprintf(stderr, "kernel_launch: occupancy query reports %d workgroups per CU\n", per_cu); per_cu = 1; }
        (void)hipGetLastError();
        grid = cus;
    }
    if (grid < 0) return;
    if (hipMemsetAsync((char*)d_ws + WS_CTL, 0, CTL_ZERO_BYTES, stream) != hipSuccess) { fprintf(stderr, "kernel_launch: hipMemsetAsync failed\n"); return; }
    Args a{};
    for (int i = 0; i < 18; ++i) a.in[i] = (const float*)d_in[i];
    a.out = (float*)d_out; a.ws = (unsigned char*)d_ws;
    void* kargs[] = {&a};
    hipError_t e = hipLaunchCooperativeKernel((const void*)fwd_megakernel, dim3(grid), dim3(NTHREADS), kargs, LDS_BYTES, stream);
    if (e != hipSuccess) fprintf(stderr, "kernel_launch: cooperative launch failed: %s (grid %d)\n", hipGetErrorString(e), grid);
}
```

```cpp
#define TABLES_IN_ROUTER 1
#include <hip/hip_runtime.h>
#include <hip/hip_bf16.h>
#include <cstdio>
#include <cstdint>
#include <cmath>

constexpr int NB = 8, SEQ = 4096, T = NB * SEQ, D = 1024;
constexpr int AW = 512, PW = 512, INW = 4096;
constexpr int NH = 8, HD = 64, MBLK = 256, NBLK = SEQ / MBLK;
constexpr int PQW = 2048, PEXP = 16384, PTOP = 16, PHEADS = 8, PSEL = PHEADS * PTOP;
constexpr float RMS_EPS = 1e-6f;
constexpr float LOG2E = 1.4426950408889634f;
constexpr float QSCALE = 0.125f * LOG2E;
constexpr int NWAVES = 8, NTHREADS = 512;

namespace pg8 {
#define PG8_LAS __attribute__((address_space(3)))
typedef unsigned short bf16_t;
typedef short bf16x8 __attribute__((ext_vector_type(8)));
typedef float f32x4 __attribute__((ext_vector_type(4)));
typedef unsigned u32x4 __attribute__((ext_vector_type(4)));
constexpr int BM = 256, BK = 64, HALF = 128, HTB = HALF * BK * 2  , STAGE_BYTES = 8 * HTB, NXCD = 8, WGM = 8;

__host__ __device__ __forceinline__ int lds_byte(int r, int c) { const int st = (r >> 4) * 2 + (c >> 5), rr = r & 15, cc = c & 31, ob = rr * 64 + cc * 2; return st * 1024 + (ob ^ (((ob >> 9) & 1) << 5)); }
__host__ __device__ __forceinline__ void stage_rc(int b, int& R, int& C) { const int st = b / 1024, sb = b % 1024, swz = sb ^ (((sb >> 9) & 1) << 5); R = (st >> 1) * 16 + swz / 64; C = (st & 1) * 32 + (swz % 64) / 2; }
__host__ __device__ __forceinline__ int perm32(int rho) { const int n = rho >> 4, i = rho & 15; return 8 * (i >> 2) + 4 * n + (i & 3); }

struct Unit { int pm, pn, part; };
struct Gemm {
    const bf16_t* A0; const bf16_t* A1; const bf16_t* B0; const bf16_t* B1; int lda, ldb, K;
    __device__ __forceinline__ const char* a_ptr(const Unit& u) const { return (const char*)(u.part ? A1 : A0) + (size_t)u.pm * BM * lda * 2; }
    __device__ __forceinline__ const char* b_ptr(const Unit& u) const { return (const char*)(u.part ? B1 : B0) + (size_t)u.pn * BM * ldb * 2; }
};

struct StaticOrder {
    int nM, nN, nwg, G, c;
    __host__ __device__ void init(int M, int N, int G_, int c_) { nM = M / BM; nN = N / BM; nwg = nM * nN; G = G_; c = c_; }
    __host__ __device__ bool tile(long L, Unit& u) const {
        if (L >= nwg) return false;
        int wgid = (int)L; { const int q = nwg / NXCD, r = nwg % NXCD, xcd = wgid % NXCD, off = wgid / NXCD; wgid = (xcd < r ? xcd * (q + 1) : r * (q + 1) + (xcd - r) * q) + off; }
        const int nig = WGM * nN, gid = wgid / nig, fm = gid * WGM, gsz = (nM - fm) < WGM ? (nM - fm) : WGM;
        u.pm = fm + ((wgid % nig) % gsz); u.pn = (wgid % nig) / gsz; u.part = 0; return true;
    }
    __host__ __device__ bool next(int i, Unit& u) const { return tile((long)i * G + c, u); }
    __device__ __forceinline__ void a_ready(const Unit&) const {}
    __device__ __forceinline__ void done(const Unit&) const {}
};
struct DualOrder {
    StaticOrder so;
    __host__ __device__ void init(int M, int N, int G_, int c_) { so.init(M, N, G_, c_); }
    __host__ __device__ bool next(int i, Unit& u) const { if (!so.tile((long)(i >> 1) * so.G + so.c, u)) return false; u.part = i & 1; return true; }
    __device__ __forceinline__ void a_ready(const Unit&) const {}
    __device__ __forceinline__ void done(const Unit&) const {}
};

__device__ __forceinline__ unsigned cvt_pk_bf16(float lo, float hi) { unsigned r; asm volatile("v_cvt_pk_bf16_f32 %0, %1, %2" : "=v"(r) : "v"(lo), "v"(hi)); return r; }
__device__ __forceinline__ float bf_lo(unsigned w) { return __uint_as_float(w << 16); }
__device__ __forceinline__ float bf_hi(unsigned w) { return __uint_as_float(w & 0xffff0000u); }
__device__ __forceinline__ float sigmoidf_(float x) { return __builtin_amdgcn_rcpf(1.0f + __builtin_amdgcn_exp2f(-x * 1.4426950408889634f)); }


struct EpiIn {
    static constexpr bool PERM = true, AFTER_DRAIN = false, KEEP_ACC = false, WANT_INDEX = false;
    bf16_t* QKVP; bf16_t* GAB; const float* rstd1; const float* bias1p; float* ksum; unsigned* nrm;
    __device__ __forceinline__ void operator()(const f32x4 (&acc)[2][2][4][2], const Unit& u, int wr, int wc, int fr, int fq) const {
        bf16_t* base; int ldc, col0;
        if (u.pn < 8) { base = QKVP + (size_t)(u.pn >> 1) * T * 512; ldc = 512; col0 = (u.pn & 1) * 256; }
        else { base = GAB + (size_t)((u.pn - 8) >> 2) * T * 1024; ldc = 1024; col0 = ((u.pn - 8) & 3) * 256; }
        const float sc = (u.pn < 2) ? QSCALE : 1.0f;
        const int b = u.pm >> 4;
        const int bcol = u.pn * 256 + wc * 32 + 8 * fq;
        f32x4 bv[2][2];
#pragma unroll
        for (int bj = 0; bj < 2; ++bj)
#pragma unroll
            for (int n = 0; n < 2; ++n) { f32x4 s = (f32x4){0.f, 0.f, 0.f, 0.f};
#pragma unroll
                for (int kc = 0; kc < 8; ++kc) s += *(const f32x4*)(bias1p + (size_t)(kc * 8 + b) * INW + bcol + bj * HALF + 4 * n);
                bv[bj][n] = s; }
        const bool isk = (u.pn == 2 || u.pn == 3); const bool isqk = (u.pn < 4); float nmax[2] = {0.f, 0.f};
        f32x4 ks[2][2];
#pragma unroll
        for (int bj = 0; bj < 2; ++bj)
#pragma unroll
            for (int n = 0; n < 2; ++n) ks[bj][n] = (f32x4){0.f, 0.f, 0.f, 0.f};
        const int row0 = u.pm * BM + wr * 64 + fr;
#pragma unroll
        for (int ai = 0; ai < 2; ++ai)
#pragma unroll
            for (int m = 0; m < 4; ++m) { const int row = row0 + ai * HALF + m * 16; const float rs = rstd1[row];
                bf16_t* rowp = base + (size_t)row * ldc + col0 + wc * 32 + 8 * fq;
#pragma unroll
                for (int bj = 0; bj < 2; ++bj) { f32x4 v0 = acc[ai][bj][m][0] * rs + bv[bj][0], v1 = acc[ai][bj][m][1] * rs + bv[bj][1];
                    ks[bj][0] += v0; ks[bj][1] += v1;
                    v0 = v0 * sc; v1 = v1 * sc;
                    if (isqk) { float ss = (v0[0] * v0[0] + v0[1] * v0[1]) + (v0[2] * v0[2] + v0[3] * v0[3]) + (v1[0] * v1[0] + v1[1] * v1[1]) + (v1[2] * v1[2] + v1[3] * v1[3]); ss += __shfl_xor(ss, 16); ss += __shfl_xor(ss, 32); nmax[bj] = fmaxf(nmax[bj], ss); }
                    u32x4 w; w.x = cvt_pk_bf16(v0[0], v0[1]); w.y = cvt_pk_bf16(v0[2], v0[3]); w.z = cvt_pk_bf16(v1[0], v1[1]); w.w = cvt_pk_bf16(v1[2], v1[3]);
                    *(u32x4*)(rowp + bj * HALF) = w; } }
        if (isqk) {
#pragma unroll
            for (int bj = 0; bj < 2; ++bj) { float v = nmax[bj]; v = fmaxf(v, __shfl_xor(v, 1)); v = fmaxf(v, __shfl_xor(v, 2)); v = fmaxf(v, __shfl_xor(v, 4)); v = fmaxf(v, __shfl_xor(v, 8));
                if (fr == 0 && fq == 0) atomicMax(nrm + (size_t)(b * 2 + (u.pn >> 1)) * 16 + (u.pn & 1) * 8 + bj * 4 + wc, __float_as_uint(v)); }
        }
        if (isk) {
#pragma unroll
            for (int bj = 0; bj < 2; ++bj)
#pragma unroll
                for (int n = 0; n < 2; ++n)
#pragma unroll
                    for (int e = 0; e < 4; ++e) { float v = ks[bj][n][e]; v += __shfl_xor(v, 1); v += __shfl_xor(v, 2); v += __shfl_xor(v, 4); v += __shfl_xor(v, 8); ks[bj][n][e] = v; }
            if (fr == 0) { float* kp = ksum + (size_t)u.pm * 512 + (u.pn - 2) * 256 + wc * 32 + 8 * fq;
#pragma unroll
                for (int bj = 0; bj < 2; ++bj)
#pragma unroll
                    for (int n = 0; n < 2; ++n)
#pragma unroll
                        for (int e = 0; e < 4; ++e) atomicAdd(kp + bj * HALF + 4 * n + e, ks[bj][n][e]); }
        }
    }
};

struct EpiUp {
    static constexpr bool PERM = true, AFTER_DRAIN = false, KEEP_ACC = true, WANT_INDEX = false;
    bf16_t* merged; const bf16_t* GAB; const float* bprime;
    static __device__ __forceinline__ float e_neg(float g) { return __builtin_amdgcn_exp2f(-g * 1.4426950408889634f); }
    static __device__ __forceinline__ float ratio(float ga, float gb) { return (1.0f + e_neg(fmaxf(gb, -60.0f))) * __builtin_amdgcn_rcpf(1.0f + e_neg(ga)); }
    static __device__ __forceinline__ float sigb(float gb) { return __builtin_amdgcn_rcpf(1.0f + e_neg(fmaxf(gb, -60.0f))); }
    __device__ __forceinline__ void operator()(f32x4 (&acc)[2][2][4][2], const Unit& u, int wr, int wc, int fr, int fq) const {
        const int row0 = u.pm * BM + wr * 64 + fr, colb = u.pn * BM + wc * 32 + 8 * fq;
        const bf16_t* ga = GAB; const bf16_t* gb = GAB + (size_t)T * 1024;
        if (u.part == 0) {
#pragma unroll
            for (int ai = 0; ai < 2; ++ai) {
                u32x4 apre[4][2], bpre[4][2];
#pragma unroll
                for (int m = 0; m < 4; ++m) { const size_t off = (size_t)(row0 + ai * HALF + m * 16) * 1024 + colb;
#pragma unroll
                    for (int bj = 0; bj < 2; ++bj) { apre[m][bj] = __builtin_nontemporal_load((const u32x4*)(ga + off + bj * HALF)); bpre[m][bj] = *(const u32x4*)(gb + off + bj * HALF); } }
#pragma unroll
                for (int m = 0; m < 4; ++m)
#pragma unroll
                    for (int bj = 0; bj < 2; ++bj) { const u32x4 aw = apre[m][bj], bw = bpre[m][bj];
                        f32x4& v0 = acc[ai][bj][m][0]; f32x4& v1 = acc[ai][bj][m][1];
                        v0[0] *= ratio(bf_lo(aw.x), bf_lo(bw.x)); v0[1] *= ratio(bf_hi(aw.x), bf_hi(bw.x)); v0[2] *= ratio(bf_lo(aw.y), bf_lo(bw.y)); v0[3] *= ratio(bf_hi(aw.y), bf_hi(bw.y));
                        v1[0] *= ratio(bf_lo(aw.z), bf_lo(bw.z)); v1[1] *= ratio(bf_hi(aw.z), bf_hi(bw.z)); v1[2] *= ratio(bf_lo(aw.w), bf_lo(bw.w)); v1[3] *= ratio(bf_hi(aw.w), bf_hi(bw.w)); }
            }
            return;
        }
        f32x4 bv[2][2];
#pragma unroll
        for (int bj = 0; bj < 2; ++bj)
#pragma unroll
            for (int n = 0; n < 2; ++n) { f32x4 s_ = (f32x4){0.f, 0.f, 0.f, 0.f}; _Pragma("unroll") for (int g_ = 0; g_ < 4; ++g_) s_ += *(const f32x4*)(bprime + g_ * 1024 + colb + bj * HALF + 4 * n); bv[bj][n] = s_; }
#pragma unroll
        for (int ai = 0; ai < 2; ++ai) {
            u32x4 gpre[4][2];
#pragma unroll
            for (int m = 0; m < 4; ++m) { const size_t off = (size_t)(row0 + ai * HALF + m * 16) * 1024 + colb;
#pragma unroll
                for (int bj = 0; bj < 2; ++bj) gpre[m][bj] = __builtin_nontemporal_load((const u32x4*)(gb + off + bj * HALF)); }
#pragma unroll
            for (int m = 0; m < 4; ++m) { const size_t off = (size_t)(row0 + ai * HALF + m * 16) * 1024 + colb;
#pragma unroll
                for (int bj = 0; bj < 2; ++bj) {
                    const u32x4 gw = gpre[m][bj];
                    f32x4 v0 = acc[ai][bj][m][0] + bv[bj][0], v1 = acc[ai][bj][m][1] + bv[bj][1];
                    v0[0] *= sigb(bf_lo(gw.x)); v0[1] *= sigb(bf_hi(gw.x)); v0[2] *= sigb(bf_lo(gw.y)); v0[3] *= sigb(bf_hi(gw.y));
                    v1[0] *= sigb(bf_lo(gw.z)); v1[1] *= sigb(bf_hi(gw.z)); v1[2] *= sigb(bf_lo(gw.w)); v1[3] *= sigb(bf_hi(gw.w));
                    u32x4 w; w.x = cvt_pk_bf16(v0[0], v0[1]); w.y = cvt_pk_bf16(v0[2], v0[3]); w.z = cvt_pk_bf16(v1[0], v1[1]); w.w = cvt_pk_bf16(v1[2], v1[3]);
                    *(u32x4*)(merged + off + bj * HALF) = w; } }
        }
    }
};

struct EpiOut {
    static constexpr bool PERM = true, AFTER_DRAIN = false, KEEP_ACC = false, WANT_INDEX = false;
    const float* x; float* x1; bf16_t* A2; const float* modf; const float* g2; float* ss2;
    __device__ __forceinline__ void operator()(const f32x4 (&acc)[2][2][4][2], const Unit& u, int wr, int wc, int fr, int fq) const {
        const int row0 = u.pm * BM + wr * 64 + fr, colb = u.pn * BM + wc * 32 + 8 * fq, b = u.pm >> 4;
        f32x4 gt[2][2], gg[2][2];
#pragma unroll
        for (int bj = 0; bj < 2; ++bj)
#pragma unroll
            for (int n = 0; n < 2; ++n) { const int c = colb + bj * HALF + 4 * n; gt[bj][n] = *(const f32x4*)(modf + (size_t)b * 6144 + 2048 + c);
                const f32x4 sc2 = *(const f32x4*)(modf + (size_t)b * 6144 + 4096 + c); gg[bj][n] = *(const f32x4*)(g2 + c) * (sc2 + 1.0f); }
#pragma unroll
        for (int ai = 0; ai < 2; ++ai) {
#pragma unroll
          for (int mh = 0; mh < 2; ++mh) {
            f32x4 xr[2][2][2];
#pragma unroll
            for (int m2 = 0; m2 < 2; ++m2) { const size_t off = (size_t)(row0 + ai * HALF + (2 * mh + m2) * 16) * 1024 + colb;
#pragma unroll
                for (int bj = 0; bj < 2; ++bj) { xr[m2][bj][0] = __builtin_nontemporal_load((const f32x4*)(x + off + bj * HALF)); xr[m2][bj][1] = __builtin_nontemporal_load((const f32x4*)(x + off + bj * HALF + 4)); } }
#pragma unroll
            for (int m2 = 0; m2 < 2; ++m2) { const int m = 2 * mh + m2; const int row = row0 + ai * HALF + m * 16; const size_t off = (size_t)row * 1024 + colb; float ssq = 0.f;
#pragma unroll
                for (int bj = 0; bj < 2; ++bj) {
                    const f32x4 y0 = xr[m2][bj][0] + gt[bj][0] * acc[ai][bj][m][0], y1 = xr[m2][bj][1] + gt[bj][1] * acc[ai][bj][m][1];
                    *(f32x4*)(x1 + off + bj * HALF) = y0; *(f32x4*)(x1 + off + bj * HALF + 4) = y1;
                    ssq += (y0[0] * y0[0] + y0[1] * y0[1]) + (y0[2] * y0[2] + y0[3] * y0[3]) + (y1[0] * y1[0] + y1[1] * y1[1]) + (y1[2] * y1[2] + y1[3] * y1[3]);
                    const f32x4 a0 = y0 * gg[bj][0], a1 = y1 * gg[bj][1];
                    u32x4 w; w.x = cvt_pk_bf16(a0[0], a0[1]); w.y = cvt_pk_bf16(a0[2], a0[3]); w.z = cvt_pk_bf16(a1[0], a1[1]); w.w = cvt_pk_bf16(a1[2], a1[3]);
                    *(u32x4*)(A2 + off + bj * HALF) = w; }
                ssq += __shfl_xor(ssq, 16); ssq += __shfl_xor(ssq, 32);
                if (fq == 0) ss2[(size_t)row * 16 + u.pn * 4 + wc] = ssq; }
          }
        }
    }
};

struct EpiPq {
    static constexpr bool PERM = true, AFTER_DRAIN = false, KEEP_ACC = false, WANT_INDEX = true;
    bf16_t* QP; const float* ss2; const float* bias2p; const PG8_LAS float* btab; const PG8_LAS float* rtab;
    __device__ __forceinline__ void operator()(const f32x4 (&acc)[2][2][4][2], const Unit& u, int wr, int wc, int fr, int fq) const {
        const int row0 = u.pm * BM + wr * 64 + fr, colb = u.pn * BM + wc * 32 + 8 * fq, b = u.pm >> 4;
        f32x4 bv[2][2];
#pragma unroll
        for (int bj = 0; bj < 2; ++bj)
#pragma unroll
            for (int n = 0; n < 2; ++n) { f32x4 s = (f32x4){0.f, 0.f, 0.f, 0.f};
                s = *(const PG8_LAS f32x4*)(btab + u.part * 256 + wc * 32 + 8 * fq + bj * HALF + 4 * n);
                bv[bj][n] = s; }
#pragma unroll
        for (int ai = 0; ai < 2; ++ai)
#pragma unroll
            for (int m = 0; m < 4; ++m) { const int row = row0 + ai * HALF + m * 16;
                const float rs = rtab[u.part * 256 + wr * 64 + ai * HALF + m * 16 + fr];
                bf16_t* rowp = QP + (size_t)row * PQW + colb;
#pragma unroll
                for (int bj = 0; bj < 2; ++bj) { const f32x4 v0 = acc[ai][bj][m][0] * rs + bv[bj][0], v1 = acc[ai][bj][m][1] * rs + bv[bj][1];
                    u32x4 w; w.x = cvt_pk_bf16(v0[0], v0[1]); w.y = cvt_pk_bf16(v0[2], v0[3]); w.z = cvt_pk_bf16(v1[0], v1[1]); w.w = cvt_pk_bf16(v1[2], v1[3]);
                    *(u32x4*)(rowp + bj * HALF) = w; } }
    }
};

template <class Epi, class Sched, bool ALIGN_EPI = false, bool SP2 = false>
__device__ __forceinline__ void gemm_phase(PG8_LAS unsigned char* lds, const Gemm g, const Sched& S, const Epi& E) {
    int tid_ = threadIdx.x; asm volatile("" : "+v"(tid_));
    const int tid = tid_, wid = __builtin_amdgcn_readfirstlane(tid >> 6), lane = tid & 63, wr = wid >> 2, wc = wid & 3, fr = lane & 15, fq = lane >> 4;
    const int K = g.K, nt = K / BK, lda = g.lda, ldb = g.ldb;
    unsigned voffA[2], voffB[2];
#pragma unroll
    for (int i = 0; i < 2; ++i) { int R, C; stage_rc(tid * 16 + i * 8192, R, C); const int Rb = Epi::PERM ? ((R & ~31) + perm32(R & 31)) : R;
        voffA[i] = (unsigned)(R * lda + C) * 2u; voffB[i] = (unsigned)(Rb * ldb + C) * 2u; }
    const size_t kstep = (size_t)(BK * 2);
    const size_t hstepA = (size_t)HALF * lda * 2, hstepB = (size_t)HALF * ldb * 2;
    const unsigned ldsw = (unsigned)wid * 1024u;
    const int aoff = lds_byte(wr * 64 + fr, fq * 8), boff = lds_byte(wc * 32 + fr, fq * 8);
#define PG8_SA(b, h) (((b) * 2 + (h)) * HTB)
#define PG8_SB(b, h) ((4 + (b) * 2 + (h)) * HTB)
#define PG8_STAGE(bufoff, gbase, voff) do { _Pragma("unroll") for (int _i = 0; _i < 2; ++_i) \
        __builtin_amdgcn_global_load_lds((const unsigned*)((const char*)(gbase) + (voff)[_i]), (PG8_LAS unsigned*)(lds + (bufoff) + ldsw + _i * 8192), 16, 0, 0); } while (0)
#define PG8_LDA(dst, b, h) do { _Pragma("unroll") for (int m = 0; m < 4; ++m) _Pragma("unroll") for (int k = 0; k < 2; ++k) dst[m][k] = *(const PG8_LAS bf16x8*)(lds + PG8_SA(b, h) + aoff + m * 2048 + k * 1024); } while (0)
#define PG8_LDB(dst, b, h) do { _Pragma("unroll") for (int n = 0; n < 2; ++n) _Pragma("unroll") for (int k = 0; k < 2; ++k) dst[n][k] = *(const PG8_LAS bf16x8*)(lds + PG8_SB(b, h) + boff + n * 2048 + k * 1024); } while (0)
#define PG8_MMA(ai, bj, At, Bt) do { __builtin_amdgcn_s_setprio(1); _Pragma("unroll") for (int m = 0; m < 4; ++m) _Pragma("unroll") for (int n = 0; n < 2; ++n) _Pragma("unroll") for (int k = 0; k < 2; ++k) \
        acc[ai][bj][m][n] = __builtin_amdgcn_mfma_f32_16x16x32_bf16(Bt[n][k], At[m][k], acc[ai][bj][m][n], 0, 0, 0); __builtin_amdgcn_s_setprio(0); } while (0)
#define PG8_WAIT_V(n) asm volatile("s_waitcnt vmcnt(" #n ")" ::: "memory")
#define PG8_WAIT_L(n) asm volatile("s_waitcnt lgkmcnt(" #n ")" ::: "memory")
#define PG8_BAR __builtin_amdgcn_s_barrier()
#define PG8_SCHED __builtin_amdgcn_sched_barrier(0)
    Unit cur, nxt; int ui = 0;
    if (!S.next(0, cur)) return;
    f32x4 acc[2][2][4][2];
#pragma unroll
    for (int a = 0; a < 2; ++a)
#pragma unroll
        for (int b = 0; b < 2; ++b)
#pragma unroll
            for (int m = 0; m < 4; ++m)
#pragma unroll
                for (int n = 0; n < 2; ++n) acc[a][b][m][n] = (f32x4){0.f, 0.f, 0.f, 0.f};
    bf16x8 At[4][2], B0[2][2], B1[2][2];
    const char* cA = g.a_ptr(cur); const char* cB = g.b_ptr(cur);
    S.a_ready(cur);
    if constexpr (SP2) {
        PG8_STAGE(PG8_SB(0, 0), cB, voffB); PG8_STAGE(PG8_SB(0, 1), cB + hstepB, voffB); PG8_STAGE(PG8_SA(0, 0), cA, voffA); PG8_STAGE(PG8_SA(0, 1), cA + hstepA, voffA);
        if (wr == 1) PG8_BAR;
        PG8_WAIT_V(2); PG8_BAR;
        PG8_STAGE(PG8_SB(1, 0), cB + kstep, voffB); PG8_STAGE(PG8_SA(1, 0), cA + kstep, voffA); PG8_STAGE(PG8_SB(1, 1), cB + hstepB + kstep, voffB);
        PG8_WAIT_V(6); PG8_BAR;
    } else {
        PG8_STAGE(PG8_SB(0, 0), cB, voffB); PG8_STAGE(PG8_SA(0, 0), cA, voffA); PG8_STAGE(PG8_SB(0, 1), cB + hstepB, voffB); PG8_STAGE(PG8_SA(0, 1), cA + hstepA, voffA);
        if (wr == 1) PG8_BAR;
        PG8_WAIT_V(4); PG8_BAR;
        PG8_STAGE(PG8_SB(1, 0), cB + kstep, voffB); PG8_STAGE(PG8_SA(1, 0), cA + kstep, voffA); PG8_STAGE(PG8_SB(1, 1), cB + hstepB + kstep, voffB);
        PG8_WAIT_V(6); PG8_BAR;
    }
    for (;;) {
        const bool has_next = S.next(ui + 1, nxt);
        const char* nA = has_next ? g.a_ptr(nxt) : cA; const char* nB = has_next ? g.b_ptr(nxt) : cB;
        for (int t = 0; t < nt; t += 2) {
            const bool last = (t == nt - 2);
            const char* a1 = cA + (size_t)(t + 1) * kstep;
            const char* a2 = last ? nA : cA + (size_t)(t + 2) * kstep; const char* b2 = last ? nB : cB + (size_t)(t + 2) * kstep;
            const char* a3 = a2 + kstep; const char* b3 = b2 + kstep;
            if (last && has_next) S.a_ready(nxt);
            if constexpr (SP2) {
            PG8_LDB(B0, 0, 0); PG8_LDB(B1, 0, 1); PG8_SCHED; PG8_LDA(At, 0, 0); PG8_STAGE(PG8_SA(1, 1), a1 + hstepA, voffA);
            PG8_WAIT_V(8); PG8_WAIT_L(0); PG8_BAR; PG8_MMA(0, 0, At, B0); PG8_MMA(0, 1, At, B1); PG8_BAR; PG8_SCHED;
            PG8_LDA(At, 0, 1); PG8_STAGE(PG8_SB(0, 0), b2, voffB); PG8_STAGE(PG8_SB(0, 1), b2 + hstepB, voffB); PG8_STAGE(PG8_SA(0, 0), a2, voffA);
            PG8_WAIT_V(8); PG8_WAIT_L(0); PG8_BAR; PG8_MMA(1, 0, At, B0); PG8_MMA(1, 1, At, B1); PG8_BAR; PG8_SCHED;
            PG8_LDB(B0, 1, 0); PG8_LDB(B1, 1, 1); PG8_SCHED; PG8_LDA(At, 1, 0); PG8_STAGE(PG8_SA(0, 1), a2 + hstepA, voffA);
            PG8_WAIT_V(8); PG8_WAIT_L(0); PG8_BAR; PG8_MMA(0, 0, At, B0); PG8_MMA(0, 1, At, B1); PG8_BAR; PG8_SCHED;
            PG8_LDA(At, 1, 1); PG8_STAGE(PG8_SB(1, 0), b3, voffB); PG8_STAGE(PG8_SB(1, 1), b3 + hstepB, voffB); PG8_STAGE(PG8_SA(1, 0), a3, voffA);
            PG8_WAIT_V(8); PG8_WAIT_L(0); PG8_BAR; PG8_MMA(1, 0, At, B0); PG8_MMA(1, 1, At, B1); PG8_BAR; PG8_SCHED;
            } else {
            PG8_LDB(B0, 0, 0); PG8_SCHED; PG8_LDA(At, 0, 0); PG8_STAGE(PG8_SA(1, 1), a1 + hstepA, voffA);
            PG8_WAIT_L(8); PG8_BAR; PG8_WAIT_L(0); PG8_MMA(0, 0, At, B0); PG8_BAR; PG8_SCHED;
            PG8_LDB(B1, 0, 1); PG8_STAGE(PG8_SB(0, 0), b2, voffB);
            PG8_BAR; PG8_WAIT_L(0); PG8_MMA(0, 1, At, B1); PG8_BAR;
            PG8_LDA(At, 0, 1); PG8_STAGE(PG8_SA(0, 0), a2, voffA);
            PG8_BAR; PG8_WAIT_L(0); PG8_MMA(1, 0, At, B0); PG8_BAR; PG8_SCHED;
            PG8_STAGE(PG8_SB(0, 1), b2 + hstepB, voffB);
            PG8_WAIT_V(6); PG8_BAR; PG8_MMA(1, 1, At, B1); PG8_BAR;
            PG8_LDB(B0, 1, 0); PG8_SCHED; PG8_LDA(At, 1, 0); PG8_STAGE(PG8_SA(0, 1), a2 + hstepA, voffA);
            PG8_WAIT_L(8); PG8_BAR; PG8_WAIT_L(0); PG8_MMA(0, 0, At, B0); PG8_BAR; PG8_SCHED;
            PG8_LDB(B1, 1, 1); PG8_STAGE(PG8_SB(1, 0), b3, voffB);
            PG8_BAR; PG8_WAIT_L(0); PG8_MMA(0, 1, At, B1); PG8_BAR;
            PG8_LDA(At, 1, 1); PG8_STAGE(PG8_SA(1, 0), a3, voffA);
            PG8_BAR; PG8_WAIT_L(0); PG8_MMA(1, 0, At, B0); PG8_BAR; PG8_SCHED;
            PG8_STAGE(PG8_SB(1, 1), b3 + hstepB, voffB);
            PG8_WAIT_V(6); PG8_BAR; PG8_MMA(1, 1, At, B1); PG8_BAR;
            }
        }
        if constexpr (ALIGN_EPI) { if (wr == 0) PG8_BAR; }
        if constexpr (Epi::WANT_INDEX) cur.part = ui;
        if constexpr (!Epi::AFTER_DRAIN) { E(acc, cur, wr, wc, fr, fq); S.done(cur); }
        if (!has_next) break;
        if (!(Epi::KEEP_ACC && cur.part == 0)) {
#pragma unroll
        for (int a = 0; a < 2; ++a)
#pragma unroll
            for (int b = 0; b < 2; ++b)
#pragma unroll
                for (int m = 0; m < 4; ++m)
#pragma unroll
                    for (int n = 0; n < 2; ++n) acc[a][b][m][n] = (f32x4){0.f, 0.f, 0.f, 0.f};
        }
        cur = nxt; cA = nA; cB = nB; ++ui;
        if constexpr (ALIGN_EPI) { if (wr == 1) PG8_BAR; }
    }
    PG8_WAIT_V(0);
    if constexpr (!ALIGN_EPI) { if (wr == 0) PG8_BAR; }
    PG8_BAR;
    if constexpr (Epi::AFTER_DRAIN) { E.fused(acc, cur, wr, wc, fr, fq, lds, wid, lane); S.done(cur); }
#undef PG8_SA
#undef PG8_SB
#undef PG8_STAGE
#undef PG8_LDA
#undef PG8_LDB
#undef PG8_MMA
#undef PG8_WAIT_V
#undef PG8_WAIT_L
#undef PG8_BAR
#undef PG8_SCHED
}
}

constexpr size_t MiB = 1u << 20;
constexpr size_t WS_CTL = 0, CTL_ZERO_BYTES = 32 * 1024;
constexpr size_t WS_KSUM = 256 * 1024;
constexpr size_t WS_MODP = 1 * MiB;
constexpr size_t WS_MODF = WS_MODP + 8 * 8 * 6144 * 4;
constexpr size_t WS_BIAS1P = 3 * MiB;
constexpr size_t WS_BIAS2P = 4 * MiB;
constexpr size_t WS_BPRIME = 4 * MiB + 512 * 1024;
constexpr size_t WS_RSTD1 = 5 * MiB;
constexpr size_t WS_SS2 = 6 * MiB;
constexpr size_t WS_SUBK = 8 * MiB;
constexpr size_t WS_WIN = 16 * MiB, WS_WA = 24 * MiB, WS_WP = 25 * MiB, WS_WOUT = 26 * MiB, WS_WQ = 28 * MiB;
constexpr size_t WS_U = 32 * MiB, WS_V = 64 * MiB;
constexpr size_t WS_XG = 96 * MiB;
constexpr size_t WS_H2Q = WS_XG, WS_HS = WS_XG + 32 * MiB;
constexpr size_t WS_QKVP = 160 * MiB;
constexpr size_t WS_GAB = 288 * MiB;
constexpr size_t WS_POOLED = 416 * MiB;
constexpr size_t WS_END = 448 * MiB;
constexpr int CW_TMO = 0, CW_BAR = 4096;
constexpr int CW_NRM = 2048;

constexpr int RING_OFF = 0, RING_BYTES = 131072;
constexpr int LDS_BYTES = 147456;
constexpr int BTAB_OFF = 131072, RTAB_OFF = 139264;
constexpr int LDSCTL_OFF = LDS_BYTES - 512, MISC_OFF = LDSCTL_OFF + 320;

#define GAS __attribute__((address_space(1)))
#define LAS __attribute__((address_space(3)))
typedef unsigned short bf16;
typedef unsigned v4u __attribute__((ext_vector_type(4)));
typedef unsigned v2u __attribute__((ext_vector_type(2)));
typedef float f32x4 __attribute__((ext_vector_type(4)));
typedef GAS unsigned gu32;
#define RLX_AGENT __ATOMIC_RELAXED, __HIP_MEMORY_SCOPE_AGENT
#define LDS_WAIT() asm volatile("s_waitcnt lgkmcnt(0)" ::: "memory")
#define VM_WAIT() asm volatile("s_waitcnt vmcnt(0)" ::: "memory")
__device__ __forceinline__ unsigned f2bf(float f) { unsigned u = __builtin_bit_cast(unsigned, f); return (u + 0x7fffu + ((u >> 16) & 1u)) >> 16; }
__device__ __forceinline__ unsigned pk2(float lo, float hi) { return f2bf(lo) | (f2bf(hi) << 16); }
__device__ __forceinline__ float bflo(unsigned w) { return __uint_as_float(w << 16); }
__device__ __forceinline__ float bfhi(unsigned w) { return __uint_as_float(w & 0xffff0000u); }
__device__ __forceinline__ float wave_sum(float v) {
#pragma unroll
    for (int o = 1; o < 64; o <<= 1) v += __shfl_xor(v, o);
    return v;
}
__device__ __forceinline__ float wave_max(float v) {
#pragma unroll
    for (int o = 1; o < 64; o <<= 1) v = fmaxf(v, __shfl_xor(v, o));
    return v;
}

#define XB_TMO      128
#define XB_XCNT(j)  (256  + 64 * (j))
#define XB_XSUB(j)  (1280 + 64 * (j))
#define XB_XGEN(j)  (2304 + 64 * (j))
#define XB_TOP      3328
#define XB_TOPGEN   3392
#define XCD_BAR_WORDS 3456
#define XB_SPIN_CAP (1u << 22)

__device__ __forceinline__ unsigned xb_ld(unsigned* p)              { return __hip_atomic_load(p, __ATOMIC_RELAXED, __HIP_MEMORY_SCOPE_AGENT); }
__device__ __forceinline__ unsigned xb_add(unsigned* p, unsigned v) { return __hip_atomic_fetch_add(p, v, __ATOMIC_RELAXED, __HIP_MEMORY_SCOPE_AGENT); }
__device__ __forceinline__ unsigned xb_xcc_id() { return (unsigned)__builtin_amdgcn_s_getreg((3 << 11) | 20) & 0xFu; }
#define XB_SPIN(cond, bar) do { unsigned _sp = 0; while (cond) { __builtin_amdgcn_s_sleep(1); \
    if ((++_sp & 255u) == 0u) { if (xb_ld(&(bar)[XB_TMO])) break; if (_sp > XB_SPIN_CAP) { atomicAdd(&(bar)[XB_TMO], 1u); break; } } } } while (0)

struct XcdBarrier { unsigned* bar; unsigned x; volatile LAS unsigned* st; };

__device__ __forceinline__ XcdBarrier xcd_barrier_post(unsigned* bar, volatile LAS unsigned* st) {
    XcdBarrier b; b.bar = bar; b.x = xb_xcc_id(); b.st = st;
    if (threadIdx.x == 0) (void)xb_add(&bar[XB_XCNT(b.x)], 1u);
    return b;
}
__device__ __forceinline__ void xcd_barrier_complete(unsigned* bar, unsigned x, unsigned& nloc, unsigned& nx) {
    const unsigned G = gridDim.x * gridDim.y * gridDim.z;
    unsigned sum, cnt, mine, sp = 0u;
    for (;;) {
        sum = 0u; cnt = 0u; mine = 0u;
#pragma unroll
        for (unsigned j = 0; j < 16; ++j) { const unsigned c = xb_ld(&bar[XB_XCNT(j)]); sum += c; cnt += (c > 0u) ? 1u : 0u; mine = (j == x) ? c : mine; }
        if (sum == G) break;
        __builtin_amdgcn_s_sleep(1);
        if ((++sp & 255u) == 0u) { if (xb_ld(&bar[XB_TMO])) break; if (sp > XB_SPIN_CAP) { atomicAdd(&bar[XB_TMO], 1u); break; } }
    }
    nloc = mine > 0u ? mine : 1u; nx = cnt > 0u ? cnt : 1u;
}
__device__ __forceinline__ void xcd_barrier(const XcdBarrier& b) {
    asm volatile("s_waitcnt vmcnt(0)" ::: "memory");
    __syncthreads();
    if (threadIdx.x == 0) {
        unsigned* bar = b.bar;
        __builtin_amdgcn_s_waitcnt(0);
        unsigned nloc = b.st[0], nx = b.st[1];
        if (nloc == 0u) { xcd_barrier_complete(bar, b.x, nloc, nx); b.st[0] = nloc; b.st[1] = nx; }
        const unsigned old = xb_add(&bar[XB_XSUB(b.x)], 1u);
        const unsigned gen = old / nloc;
        if (old + 1u == (gen + 1u) * nloc) {
            __builtin_amdgcn_fence(__ATOMIC_RELEASE, "agent");
            asm volatile("s_waitcnt vmcnt(0)" ::: "memory");
            const unsigned og = xb_add(&bar[XB_TOP], 1u);
            const unsigned tg = og / nx;
            if (og + 1u == (tg + 1u) * nx) xb_add(&bar[XB_TOPGEN], 1u);
            else XB_SPIN(xb_ld(&bar[XB_TOPGEN]) == tg, bar);
            __builtin_amdgcn_fence(__ATOMIC_ACQUIRE, "agent");
            xb_add(&bar[XB_XGEN(b.x)], 1u);
            asm volatile("s_waitcnt vmcnt(0)" ::: "memory");
        } else {
            XB_SPIN(xb_ld(&bar[XB_XGEN(b.x)]) == gen, bar);
            __builtin_amdgcn_fence(__ATOMIC_ACQUIRE, "agent");
            asm volatile("s_waitcnt vmcnt(0)" ::: "memory");
        }
    }
    __syncthreads();
}

struct Frame {
    LAS unsigned char* lds;
    volatile LAS unsigned* MISC;
    gu32* ctl;
    int tid, lane, wave;
    int vcu, G;
};
struct Args { const float* in[18]; float* out; unsigned char* ws; };

__device__ __forceinline__ float modp_sum(const float* modp, int idx) {
    float s = 0.f;
#pragma unroll
    for (int kc = 0; kc < 8; ++kc) s += modp[(size_t)kc * 8 * 6144 + idx];
    return s;
}
template <int MODE>
__device__ __forceinline__ void p0_wg_dot(Frame& F, const float* cin, const float* modp, int soff, const float* W, int N, const float* addv, float* outp, int first, int ntask) {
    LAS float* scr = (LAS float*)(F.lds + RING_OFF + F.wave * 16384);
    const int ncn = N / 64;
    for (int it = first; it < ntask; it += F.G) {
        const int kc = it / ncn, nc = it % ncn, k0 = kc * 128 + F.wave * 16, n = nc * 64 + F.lane;
        float w[16];
#pragma unroll
        for (int kk = 0; kk < 16; ++kk) w[kk] = (MODE == 0) ? __builtin_nontemporal_load(W + (size_t)(k0 + kk) * N + n) : W[(size_t)(k0 + kk) * N + n];
#pragma unroll
        for (int j = 0; j < 2; ++j) { const int idx = F.lane + 64 * j, b = idx >> 4, kk = idx & 15;
            float cf; if (MODE == 0) { const float cv = cin[b * 1024 + k0 + kk]; cf = cv / (1.0f + __expf(-cv)); } else cf = modp_sum(modp, b * 6144 + soff + k0 + kk);
            scr[idx] = cf; }
        LDS_WAIT(); asm volatile("" ::: "memory");
#pragma unroll
        for (int b = 0; b < 8; ++b) { float s = 0.f;
#pragma unroll
            for (int kk = 0; kk < 16; ++kk) s += scr[b * 16 + kk] * w[kk];
            scr[256 + b * 64 + F.lane] = s; }
        __syncthreads();
        { const int b = F.wave; float s = (addv != nullptr && kc == 0) ? addv[n] : 0.f;
#pragma unroll
          for (int w8 = 0; w8 < 8; ++w8) s += ((LAS float*)(F.lds + RING_OFF + w8 * 16384))[256 + b * 64 + F.lane];
          outp[(size_t)(kc * 8 + b) * N + n] = s; }
        __syncthreads();
    }
}
__device__ __forceinline__ void p0a_mod(Frame& F, const Args& A) { p0_wg_dot<0>(F, A.in[1], nullptr, 0, A.in[2], 6144, A.in[3], (float*)(A.ws + WS_MODP), F.vcu, 8 * 96); }
__device__ __forceinline__ void p0_wp_task(Frame& F, const Args& A, int r) {
    LAS float* scr = (LAS float*)(F.lds + RING_OFF + F.wave * 16384);
    const int g = r >> 6, kq = (r >> 4) & 3, nc = r & 15, n = nc * 64 + F.lane, d0 = 16 * F.wave;
    const float* wmix = A.in[7] + (size_t)(g * 128 + 32 * kq) * 128 + d0; const float* scale = A.in[9] + g * 128 + d0; const float* wup = A.in[10] + (size_t)(g * 128 + d0) * D + n; const float* bmix = A.in[8] + g * 128 + d0;
    float wu[16];
#pragma unroll
    for (int d = 0; d < 16; ++d) wu[d] = wup[(size_t)d * D];
    float bp = 0.f;
#pragma unroll
    for (int d = 0; d < 16; ++d) { wu[d] *= scale[d]; bp += bmix[d] * wu[d]; }
#pragma unroll
    for (int kk = 0; kk < 32; ++kk) { float s = 0.f;
#pragma unroll
        for (int d = 0; d < 16; ++d) s += wmix[kk * 128 + d] * wu[d];
        scr[kk * 64 + F.lane] = s; }
    scr[2048 + F.lane] = bp;
    __syncthreads();
    { float s[4]; float bs = 0.f;
#pragma unroll
      for (int e = 0; e < 4; ++e) s[e] = 0.f;
#pragma unroll
      for (int w8 = 0; w8 < 8; ++w8) { const LAS float* o = (const LAS float*)(F.lds + RING_OFF + w8 * 16384);
#pragma unroll
          for (int e = 0; e < 4; ++e) s[e] += o[(4 * F.wave + e) * 64 + F.lane];
          bs += o[2048 + F.lane]; }
      v2u w; w.x = pk2(s[0], s[1]); w.y = pk2(s[2], s[3]);
      *(GAS v2u*)((bf16*)(A.ws + WS_WP) + (size_t)n * PW + g * 128 + 32 * kq + 4 * F.wave) = w;
      if (kq == 0 && F.wave == 0) ((float*)(A.ws + WS_BPRIME))[g * 1024 + n] = bs; }
    __syncthreads();
}

__device__ __forceinline__ void p0_transpose_item(const float* W, int K, int N, bf16* WT, int row_off, LAS float* scr, int item, int lane) {
    const int nblk = N / 32, kb = item / nblk, nb = item % nblk, k0 = 64 * kb, n0 = 32 * nb;
#pragma unroll 8
    for (int i = 0; i < 32; ++i) { const int kk = 2 * i + (lane >> 5); scr[kk * 33 + (lane & 31)] = __builtin_nontemporal_load(W + (size_t)(k0 + kk) * N + n0 + (lane & 31)); }
    LDS_WAIT(); asm volatile("" ::: "memory");
    const int c = lane & 7;
#pragma unroll
    for (int j = 0; j < 4; ++j) { const int n = (lane >> 3) + 8 * j; const LAS float* s = scr + (8 * c) * 33 + n;
        v4u o; o.x = pk2(s[0 * 33], s[1 * 33]); o.y = pk2(s[2 * 33], s[3 * 33]); o.z = pk2(s[4 * 33], s[5 * 33]); o.w = pk2(s[6 * 33], s[7 * 33]);
        *(GAS v4u*)(WT + (size_t)(row_off + n0 + n) * K + k0 + 8 * c) = o; }
    LDS_WAIT(); asm volatile("" ::: "memory");
}
__device__ __forceinline__ void p0_table_rows4(const float* const (&src)[4], unsigned char* const (&dst)[4], float* const (&scale_out)[4], int off, int lane) {
    f32x4 v[4][4]; float am[4];
#pragma unroll
    for (int u = 0; u < 4; ++u)
#pragma unroll
        for (int q = 0; q < 4; ++q) v[u][q] = __builtin_nontemporal_load((const f32x4*)(src[u] + 16 * lane + 4 * q));
#pragma unroll
    for (int u = 0; u < 4; ++u) { float a = 0.f;
#pragma unroll
        for (int q = 0; q < 4; ++q) a = fmaxf(fmaxf(a, fmaxf(fabsf(v[u][q][0]), fabsf(v[u][q][1]))), fmaxf(fabsf(v[u][q][2]), fabsf(v[u][q][3])));
        am[u] = a; }
#pragma unroll
    for (int o = 1; o < 64; o <<= 1) {
#pragma unroll
        for (int u = 0; u < 4; ++u) am[u] = fmaxf(am[u], __shfl_xor(am[u], o)); }
#pragma unroll
    for (int u = 0; u < 4; ++u) { const float sc = (am[u] > 0.f) ? am[u] * (1.0f / 127.0f) : 1.0f, inv = 1.0f / sc;
        v4u o;
#pragma unroll
        for (int q = 0; q < 4; ++q) { const int q0 = (int)rintf(v[u][q][0] * inv) + off, q1 = (int)rintf(v[u][q][1] * inv) + off, q2 = (int)rintf(v[u][q][2] * inv) + off, q3 = (int)rintf(v[u][q][3] * inv) + off;
            o[q] = (unsigned)(q0 & 255) | ((unsigned)(q1 & 255) << 8) | ((unsigned)(q2 & 255) << 16) | ((unsigned)q3 << 24); }
        *(GAS v4u*)(dst[u] + ((size_t)(lane >> 3) << 21) + 16 * (lane & 7)) = o;
        if (lane == 0) *scale_out[u] = sc; }
}
__device__ __forceinline__ void p0_table_trip(const Args& A, int r0, int NGW, int lane) {
    const float* src[4]; unsigned char* dst[4]; float* sco[4];
#pragma unroll
    for (int u = 0; u < 4; ++u) { int r = r0 + u * NGW; if (r >= 2 * PEXP) r = r0; const int tb = r / PEXP, e = r % PEXP;
        src[u] = (tb ? A.in[16] : A.in[15]) + (size_t)e * D; dst[u] = A.ws + (tb ? WS_V : WS_U) + (size_t)e * 128; sco[u] = (float*)(A.ws + WS_U + 16 * MiB) + 2 * e + tb; }
    const int tb0 = r0 / PEXP;
    if ((r0 + 3 * NGW) / PEXP == tb0 && r0 + 3 * NGW < 2 * PEXP) p0_table_rows4(src, dst, sco, 0, lane);
    else { for (int u = 0; u < 4; ++u) { const int r = r0 + u * NGW; if (r < 2 * PEXP) { const float* s1[4] = {src[u], src[u], src[u], src[u]}; unsigned char* d1[4] = {dst[u], dst[u], dst[u], dst[u]}; float* c1[4] = {sco[u], sco[u], sco[u], sco[u]}; p0_table_rows4(s1, d1, c1, 0, lane); } } }
}
template <int STAGE>
__device__ __forceinline__ void p0b_prologue(Frame& F, const Args& A) {
    const int gw = F.vcu * NWAVES + F.wave, NGW = F.G * NWAVES, lane = F.lane;
    const float* modp = (const float*)(A.ws + WS_MODP);
    LAS float* G1 = (LAS float*)(F.lds + 135168);
    if (STAGE == 0) { float* ks = (float*)(A.ws + WS_KSUM); for (int i = F.vcu * NTHREADS + F.tid; i < NB * NBLK * 512; i += F.G * NTHREADS) ks[i] = 0.f; }
    if (STAGE == 0) { for (int r = F.vcu; r < 256; r += F.G) p0_wp_task(F, A, r); }
    else { p0_wg_dot<1>(F, nullptr, modp, 0, A.in[5], INW, nullptr, (float*)(A.ws + WS_BIAS1P), F.vcu, 8 * (INW / 64));
           p0_wg_dot<1>(F, nullptr, modp, 3072, A.in[13], PQW, nullptr, (float*)(A.ws + WS_BIAS2P), F.vcu, 8 * (PQW / 64)); }
    LAS float* scr = (LAS float*)(F.lds + RING_OFF + F.wave * 16384);
    constexpr int I_MODF = 768, I_WIN = (D / 64) * (INW / 32), I_WA = (AW / 64) * (D / 32), I_WOUT = (D / 64) * (D / 32), I_WQ = (D / 64) * (PQW / 32);
    constexpr int I_SUBK = 64;
    constexpr int NITEMS = I_MODF + I_WIN + I_WA + I_WOUT + I_WQ + I_SUBK;
    for (int it = gw; it < NITEMS; it += NGW) {
        int r = it;
        if (r < I_MODF) { if (STAGE != 1) continue; const int idx = r * 64 + lane; ((float*)(A.ws + WS_MODF))[idx] = modp_sum(modp, idx); continue; } r -= I_MODF;
        if (r < I_WIN) { if (STAGE != 0) continue; p0_transpose_item(A.in[5], D, INW, (bf16*)(A.ws + WS_WIN), 0, scr, r, lane); continue; } r -= I_WIN;
        if (r < I_WA) { if (STAGE != 0) continue; p0_transpose_item(A.in[6], AW, D, (bf16*)(A.ws + WS_WA), 0, scr, r, lane); continue; } r -= I_WA;
        if (r < I_WOUT) { if (STAGE != 0) continue; p0_transpose_item(A.in[11], D, D, (bf16*)(A.ws + WS_WOUT), 0, scr, r, lane); continue; } r -= I_WOUT;
        if (r < I_WQ) { if (STAGE != 0) continue; p0_transpose_item(A.in[13], D, PQW, (bf16*)(A.ws + WS_WQ), 0, scr, r, lane); continue; } r -= I_WQ;
        if (r < I_SUBK) { if (STAGE != 0) continue; const float* s = A.in[14] + (size_t)r * 512 + 8 * lane; const f32x4 a = *(const f32x4*)s, b = *(const f32x4*)(s + 4);
            v4u o; o.x = pk2(a[0], a[1]); o.y = pk2(a[2], a[3]); o.z = pk2(b[0], b[1]); o.w = pk2(b[2], b[3]);
            *(GAS v4u*)((bf16*)(A.ws + WS_SUBK) + (size_t)r * 512 + 8 * lane) = o; continue; } r -= I_SUBK;
    }
    auto xg_rows = [&](const int rb) {
        const float* x = A.in[0]; bf16* XG = (bf16*)(A.ws + WS_XG); float* rstd1 = (float*)(A.ws + WS_RSTD1);
            for (int r0 = F.wave; r0 < 128; r0 += 4 * NWAVES) {
                f32x4 v[4][2][2]; float s[4];
#pragma unroll
                for (int u = 0; u < 4; ++u) { const float* xr = x + (size_t)(rb * 128 + r0 + u * NWAVES) * 1024;
#pragma unroll
                    for (int h = 0; h < 2; ++h)
#pragma unroll
                        for (int q = 0; q < 2; ++q) v[u][h][q] = __builtin_nontemporal_load((const f32x4*)(xr + h * 512 + 8 * lane + 4 * q)); }
#pragma unroll
                for (int u = 0; u < 4; ++u) { float t = 0.f;
#pragma unroll
                    for (int h = 0; h < 2; ++h)
#pragma unroll
                        for (int q = 0; q < 2; ++q) t += (v[u][h][q][0] * v[u][h][q][0] + v[u][h][q][1] * v[u][h][q][1]) + (v[u][h][q][2] * v[u][h][q][2] + v[u][h][q][3] * v[u][h][q][3]);
                    s[u] = t; }
#pragma unroll
                for (int o = 1; o < 64; o <<= 1) {
#pragma unroll
                    for (int u = 0; u < 4; ++u) s[u] += __shfl_xor(s[u], o); }
#pragma unroll
                for (int u = 0; u < 4; ++u) { const int row = rb * 128 + r0 + u * NWAVES;
                    if (lane == 0) rstd1[row] = 1.0f / sqrtf(s[u] * (1.0f / D) + RMS_EPS);
#pragma unroll
                    for (int h = 0; h < 2; ++h) { const LAS float* g = G1 + h * 512 + 8 * lane;
                        v4u o; o.x = pk2(v[u][h][0][0] * g[0], v[u][h][0][1] * g[1]); o.y = pk2(v[u][h][0][2] * g[2], v[u][h][0][3] * g[3]); o.z = pk2(v[u][h][1][0] * g[4], v[u][h][1][1] * g[5]); o.w = pk2(v[u][h][1][2] * g[6], v[u][h][1][3] * g[7]);
                        *(GAS v4u*)(XG + (size_t)row * 1024 + h * 512 + 8 * lane) = o; } }
            }
    };
#ifndef TABLES_IN_ROUTER
    if (STAGE == 0) { for (int r0 = gw; r0 < 2 * PEXP; r0 += 4 * NGW) p0_table_trip(A, r0, NGW, lane); }
    else
#else
    if (STAGE == 1)
#endif
    for (int rb = F.vcu; rb < T / 128; rb += F.G) {
        const float* g1 = A.in[4]; const int b = (rb * 128) / SEQ;
        __syncthreads();
        for (int k = F.tid; k < 1024; k += NTHREADS) G1[k] = g1[k] * (1.0f + modp_sum(modp, b * 6144 + 1024 + k));
        __syncthreads();
        xg_rows(rb);
    }

}
namespace attn_body {
using bf16=__hip_bfloat16;
using bf16x8=__attribute__((ext_vector_type(8)))short;
using s16x4=__attribute__((ext_vector_type(4)))short;
using f32x16=__attribute__((ext_vector_type(16)))float;
using u32x4=__attribute__((ext_vector_type(4)))unsigned;
constexpr int BATCH=8,NHEAD=8,SEQ=4096,D=64,DM=NHEAD*D;
constexpr int NW=8,QBLK=32,QB=QBLK*NW,KVBLK=64,NQB=SEQ/QB;
constexpr int ATTN_PITCH=DM, ATTN_UNIT_ROWS=QB;
__device__ __forceinline__ int crow(int r,int hi){return (r&3)+8*(r>>2)+4*hi;}
#define SBAR() __builtin_amdgcn_sched_barrier(0)
__device__ __forceinline__ void cmask(f32x16&p0,f32x16&p1,int jb,int qrel,int hi){
  const float NEG=-INFINITY; int kb=64*jb+4*hi;
  #pragma unroll
  for(int r=0;r<16;++r){int kv=kb+(r&3)+8*(r>>2); if(kv>qrel)p0[r]=NEG; if(kv+32>qrel)p1[r]=NEG;}
}

constexpr int NSLOT=3, SLOTB=8192;
constexpr int LDS_K=0, LDS_V=NSLOT*SLOTB, LDS_WS=2*NSLOT*SLOTB, LDS_OST=LDS_WS+NW*64*4, LDS_KSL=LDS_OST+NW*4096, LDS_BYTES=LDS_KSL+4096;
constexpr float C2=0.125f*1.4426950408889634f;
__device__ __forceinline__ void glds16(const void*sbase,unsigned voff,unsigned lds_dst){unsigned keep;
  asm volatile("s_mov_b32 %0, m0\n\ts_mov_b32 m0, %3\n\ts_nop 4\n\tglobal_load_lds_dwordx4 %1, %2\n\ts_mov_b32 m0, %0":"=&s"(keep):"v"(voff),"s"(sbase),"s"(lds_dst):"memory");}
__device__ __forceinline__ float max3f(float a,float b,float c){float r;asm("v_max3_f32 %0, %1, %2, %3":"=v"(r):"v"(a),"v"(b),"v"(c));return r;}
__device__ __forceinline__ float max2f(float a,float b){float r;asm("v_max_f32_e32 %0, %1, %2":"=v"(r):"v"(a),"v"(b));return r;}
__device__ __forceinline__ float fadd_s(float a,float b){float r;asm("v_add_f32_e32 %0, %1, %2":"=v"(r):"v"(a),"v"(b));return r;}
__device__ __forceinline__ float fsub_s(float a,float b){float r;asm("v_sub_f32_e32 %0, %1, %2":"=v"(r):"v"(a),"v"(b));return r;}
typedef float f32x2_t __attribute__((ext_vector_type(2))); typedef __bf16 bf16x2_t __attribute__((ext_vector_type(2)));
__device__ __forceinline__ unsigned cvtpk_s(float lo,float hi){f32x2_t v={lo,hi};bf16x2_t b=__builtin_convertvector(v,bf16x2_t);return __builtin_bit_cast(unsigned,b);}
#define WAIT_BAR(N) asm volatile("s_waitcnt vmcnt(" #N ") lgkmcnt(0)\n\ts_barrier":::"memory")

__device__ __forceinline__ void qkt(f32x16&p0,f32x16&p1,const char*Kslot,const bf16x8*qr,const f32x16&negm,int r32,int hi){
  const char*kb=Kslot+hi*1024+r32*16;
  #pragma unroll
  for(int d0=0;d0<4;++d0){
    const bf16x8 b0=*reinterpret_cast<const bf16x8*>(kb+d0*2048);
    const bf16x8 b1=*reinterpret_cast<const bf16x8*>(kb+d0*2048+512);
    if(d0==0){p0=__builtin_amdgcn_mfma_f32_32x32x16_bf16(b0,qr[0],negm,0,0,0);p1=__builtin_amdgcn_mfma_f32_32x32x16_bf16(b1,qr[0],negm,0,0,0);}
    else{p0=__builtin_amdgcn_mfma_f32_32x32x16_bf16(b0,qr[d0],p0,0,0,0);p1=__builtin_amdgcn_mfma_f32_32x32x16_bf16(b1,qr[d0],p1,0,0,0);}}
}
typedef __attribute__((address_space(3))) const char* lds_cptr;
typedef short v4i16_t __attribute__((ext_vector_type(4)));
__device__ __forceinline__ void kload8(bf16x8*kf,lds_cptr kp){
  kf[0]=*(const __attribute__((address_space(3))) bf16x8*)(kp);      kf[1]=*(const __attribute__((address_space(3))) bf16x8*)(kp+512);
  kf[2]=*(const __attribute__((address_space(3))) bf16x8*)(kp+2048); kf[3]=*(const __attribute__((address_space(3))) bf16x8*)(kp+2560);
  kf[4]=*(const __attribute__((address_space(3))) bf16x8*)(kp+4096); kf[5]=*(const __attribute__((address_space(3))) bf16x8*)(kp+4608);
  kf[6]=*(const __attribute__((address_space(3))) bf16x8*)(kp+6144); kf[7]=*(const __attribute__((address_space(3))) bf16x8*)(kp+6656);
}
__device__ __forceinline__ void kload2(bf16x8*kf,lds_cptr kp,int j){ kf[2*j]=*(const __attribute__((address_space(3))) bf16x8*)(kp+j*2048); kf[2*j+1]=*(const __attribute__((address_space(3))) bf16x8*)(kp+j*2048+512); }
__device__ __forceinline__ s16x4 vtr(lds_cptr p){ return __builtin_bit_cast(s16x4,__builtin_amdgcn_ds_read_tr16_b64_v4i16((__attribute__((address_space(3))) v4i16_t*)p)); }
__device__ __forceinline__ float rowmax(const f32x16&p0,const f32x16&p1){
  float a=max3f(p0[0],p0[1],p1[0]),b=max3f(p0[2],p0[3],p1[1]);a=max3f(a,p1[2],p1[3]);
  #pragma unroll
  for(int r=4;r<16;r+=4){a=max3f(a,p0[r],p0[r+1]);b=max3f(b,p0[r+2],p0[r+3]);a=max3f(a,p1[r],p1[r+1]);b=max3f(b,p1[r+2],p1[r+3]);}
  const float m=max2f(a,b);
  auto rr=__builtin_amdgcn_permlane32_swap(__float_as_uint(m),__float_as_uint(m),false,false);
  return max2f(__uint_as_float(rr[0]),__uint_as_float(rr[1]));
}
__device__ __forceinline__ void pv(f32x16*o,int vb,bf16x8 pa0,bf16x8 pa1,bf16x8 pa2,bf16x8 pa3){
  #pragma unroll
  for(int d0=0;d0<2;++d0){s16x4 lo[4],hi[4];
    #pragma unroll
    for(int ks=0;ks<4;++ks){
      asm volatile("ds_read_b64_tr_b16 %0,%1 offset:%c2":"=&v"(lo[ks]):"v"(vb),"i"(d0*4096+ks*1024):"memory");
      asm volatile("ds_read_b64_tr_b16 %0,%1 offset:%c2":"=&v"(hi[ks]):"v"(vb),"i"(d0*4096+ks*1024+512):"memory");}
    asm volatile("s_waitcnt lgkmcnt(0)":::"memory");SBAR();
    #define PK(k) (bf16x8){lo[k][0],lo[k][1],lo[k][2],lo[k][3],hi[k][0],hi[k][1],hi[k][2],hi[k][3]}
    o[d0]=__builtin_amdgcn_mfma_f32_32x32x16_bf16(pa0,PK(0),o[d0],0,0,0);
    o[d0]=__builtin_amdgcn_mfma_f32_32x32x16_bf16(pa1,PK(1),o[d0],0,0,0);
    o[d0]=__builtin_amdgcn_mfma_f32_32x32x16_bf16(pa2,PK(2),o[d0],0,0,0);
    o[d0]=__builtin_amdgcn_mfma_f32_32x32x16_bf16(pa3,PK(3),o[d0],0,0,0);
    #undef PK
  }
}

#ifndef ATTN_STORE16
#define ATTN_STORE16(p,v) (*(u32x4*)(p)=(v))
#endif
template<int THRL> __device__ __forceinline__ void attn_unit(int b,int h,int qb,const bf16*Q,const bf16*__restrict__ K,const bf16*__restrict__ V,bf16*O,const float*ksum,const float*nrm,char*shm){
  int tid_=threadIdx.x; asm volatile("":"+v"(tid_)); const int tid=tid_,lane=tid&63,r32=lane&31,hi=lane>>5; const int wid=__builtin_amdgcn_readfirstlane(tid>>6);
  const long rowbase=(long)b*SEQ; const int q0=qb*QB;
  const bf16*Qw=Q+(rowbase+q0+wid*QBLK)*DM+h*D;
  const bf16*Kh=K+rowbase*DM+h*D,*Vh=V+rowbase*DM+h*D;
  const unsigned lds0=(unsigned)(uintptr_t)shm;
  float*wsf=(float*)(shm+LDS_WS)+wid*64;
  const unsigned kvoff=(unsigned)(lane*DM+wid*8)*2u;
  const unsigned vvoff=(unsigned)((16*(wid&3)+(lane>>2))*DM+(wid>>2)*32+(lane&3)*8)*2u;
  const unsigned kdst=lds0+LDS_K+wid*1024, vdst=lds0+LDS_V+wid*1024;
  #define DMA_K(t,slot) glds16(Kh+(long)(NTF-1-(t))*KVBLK*DM,kvoff,(unsigned)__builtin_amdgcn_readfirstlane(kdst+(slot)))
  #define DMA_V(t,slot) glds16(Vh+(long)(NTF-1-(t))*KVBLK*DM,vvoff,(unsigned)__builtin_amdgcn_readfirstlane(vdst+(slot)))
  const int vb0=(int)(lds0+LDS_V)+((lane>>4)&1)*32+(lane&3)*8+(4*hi+((lane&15)>>2))*64;
  const char*Kbase=shm+LDS_K; bf16x8 kf[8];
  const lds_cptr shm3=(lds_cptr)shm; const lds_cptr kp0=shm3+LDS_K+hi*1024+r32*16; const lds_cptr vp0=shm3+LDS_V+((lane>>4)&1)*32+(lane&3)*8+(4*hi+((lane&15)>>2))*64;
  const int NTF=(q0+QB)/KVBLK;
  int NT=NTF;
  { const float*nq=nrm+(long)(b*2+0)*16+2*h,*nk=nrm+(long)(b*2+1)*16+2*h; const float B=__builtin_sqrtf((nq[0]+nq[1])*(nk[0]+nk[1]))*1.02f+0.5f;
    const float slope2_=__uint_as_float(0x3FB8AA3Bu-((unsigned)(h+1)<<23)); const float dh=(160.f+2.f*B)/slope2_;
    const float tminf=((float)(q0-63)-dh)*(1.f/64.f); int tmin=tminf>0.f?(int)tminf:0;
    tmin=__builtin_amdgcn_readfirstlane(tmin); int nt=NTF-tmin; nt+=nt&1; if(nt>NTF)nt=NTF; if(nt<4)nt=4; NT=nt; }
  { float*ksl=(float*)(shm+LDS_KSL); const float k0=ksum[(long)(b*16+(tid>>6))*512+h*64+(tid&63)],k1=ksum[(long)(b*16+8+(tid>>6))*512+h*64+(tid&63)]; ksl[tid]=k0; ksl[512+tid]=k1; }
  DMA_K(0,0);DMA_V(0,0);DMA_K(1,SLOTB);
  bf16x8 qr[4];
  #pragma unroll
  for(int d0=0;d0<4;++d0)qr[d0]=*reinterpret_cast<const bf16x8*>(&Qw[(long)r32*DM+d0*16+hi*8]);
  float mhat=0.f,l_reg=0.f;f32x16 o[2];o[0]=f32x16{};o[1]=f32x16{};const f32x16 zero16=f32x16{};
  const int qrel=wid*QBLK+r32;
  #define CMASK(P0,P1,t) do{int jb_=3-(t); if(jb_>=0)cmask(P0,P1,jb_,qrel,hi);}while(0)
  const unsigned sl2b=0x3FB8AA3Bu-((unsigned)(h+1)<<23);
  const float slope2=__uint_as_float(sl2b), s2x=__uint_as_float(sl2b+(1u<<23)), s8x=__uint_as_float(sl2b+(3u<<23)), s32=__uint_as_float(sl2b+(5u<<23));
  const float s3x=__uint_as_float((unsigned)__builtin_amdgcn_readfirstlane((int)__float_as_uint(slope2*3.0f)));
  #define NBSEL(r) (((r)>>2)==0?nbb0_:((r)>>2)==1?nbb1_:((r)>>2)==2?nbb2_:nbb3_)
  #define NEGV(r) ((((r)&3)==0)?NBSEL(r):(NBSEL(r)+(((r)&3)==1?slope2:((r)&3)==2?s2x:s3x)))
  #define NBB(nb) const float nbb0_=(nb), nbb1_=nbb0_+s8x, nbb2_=nbb1_+s8x, nbb3_=nbb2_+s8x
  #define NBSELC(r) (((r)>>2)==0?nbc0_:((r)>>2)==1?nbc1_:((r)>>2)==2?nbc2_:nbc3_)
  #define SAV(r) (((r)&3)==1?slope2:((r)&3)==2?s2x:s3x)
  #define BIAS(C0,C1,s) do{ NBB(NBV(s)); const float nbc0_=nbb0_+s32,nbc1_=nbb1_+s32,nbc2_=nbb2_+s32,nbc3_=nbb3_+s32; \
      _Pragma("unroll") for(int r=0;r<16;++r){ if((r&3)==0){C0[r]+=NBSEL(r);C1[r]+=NBSELC(r);} else {C0[r]=(C0[r]+NBSEL(r))+SAV(r);C1[r]=(C1[r]+NBSELC(r))+SAV(r);} } }while(0)
  unsigned sel=0u;
  #define NBV(s) ({ const int tl_=NTF-1-(s); const int tc_=tl_<0?0:tl_; const int bj_=tc_>>2; const float off_=(bj_>=qb||((sel>>bj_)&1u))?0.f:-1.0e30f; \
      __builtin_fmaf(slope2,(float)(64*tl_+4*hi-q0-qrel),off_-mhat); })
  #define CRC(r) ((float)(((r)&3)+8*((r)>>2)))
  bool resc=false;
  #define START(P0,P1) do{ const float rm=rowmax(P0,P1); resc=false; \
    { const float dl=(rm>-1.0e20f)?rm:0.f; mhat=fadd_s(mhat,dl); \
      _Pragma("unroll") for(int r=0;r<16;++r){P0[r]=fsub_s(P0[r],dl);P1[r]=fsub_s(P1[r],dl);} } \
    _Pragma("unroll") for(int r=0;r<16;++r)P0[r]=__builtin_amdgcn_exp2f(P0[r]); }while(0)
  #define RESC() do{ if(resc){ asm volatile("s_waitcnt lgkmcnt(0)":::"memory"); \
      _Pragma("unroll") for(int d_=0;d_<2;++d_) _Pragma("unroll") for(int r=0;r<16;++r)o[d_][r]*=wsf[crow(r,hi)]; } }while(0)
  f32x16 pA0,pA1,pB0,pB1;
  int sl_prev=0,sl_cur=0,sl_next=SLOTB;
  #define ROT() do{sl_prev=sl_cur;sl_cur=sl_next;sl_next=(sl_next==(NSLOT-1)*SLOTB)?0:sl_next+SLOTB;}while(0)
  DMA_K(2,2*SLOTB);
  WAIT_BAR(3);
  if(qb>0){
    float qf[32];
    _Pragma("unroll") for(int d0=0;d0<4;++d0) _Pragma("unroll") for(int e=0;e<8;++e) qf[d0*8+e]=__uint_as_float(((unsigned)(unsigned short)qr[d0][e])<<16);
    const float*ksl=(const float*)(shm+LDS_KSL)+8*hi;
    float b1=-3.0e38f,b2=-3.0e38f,b3=-3.0e38f; int i1=-1,i2=-1,i3=-1;
    for(int j=0;j<qb;++j){ float g=0.f;
      _Pragma("unroll") for(int d0=0;d0<4;++d0) _Pragma("unroll") for(int e=0;e<8;++e) g=__builtin_fmaf(qf[d0*8+e],ksl[j*64+16*d0+e],g);
      { auto rr=__builtin_amdgcn_permlane32_swap(__float_as_uint(g),__float_as_uint(g),false,false); g=__uint_as_float(rr[0])+__uint_as_float(rr[1]); }
      const bool c1=g>b1,c2=g>b2,c3=g>b3;
      b3=c2?b2:(c3?g:b3); i3=c2?i2:(c3?j:i3); b2=c1?b1:(c2?g:b2); i2=c1?i1:(c2?j:i2); b1=c1?g:b1; i1=c1?j:i1; }
    sel=(1u<<i1)|(i2>=0?(1u<<i2):0u)|(i3>=0?(1u<<i3):0u); }
  qkt(pA0,pA1,Kbase,qr,zero16,r32,hi);asm volatile("s_nop 15\n\ts_nop 7":"+v"(pA0),"+v"(pA1));
  BIAS(pA0,pA1,0);
  CMASK(pA0,pA1,0);
  START(pA0,pA1);
  _Pragma("unroll") for(int r=0;r<16;++r)pA1[r]=__builtin_amdgcn_exp2f(pA1[r]);
  WAIT_BAR(0);
  DMA_K(3,0);DMA_V(1,SLOTB);
  ROT();
  kload8(kf,kp0+sl_cur);
  WAIT_BAR(2);
  s16x4 vlo[8],vhi[8]; u32x4 pw0,pw1,pw2,pw3;
  #define PKW(P,B) cvtpk_s(P[B],P[B+1])
  #define PAF(k) __builtin_bit_cast(bf16x8,pw##k)
  #define VFR(i) (bf16x8){vlo[i][0],vlo[i][1],vlo[i][2],vlo[i][3],vhi[i][0],vhi[i][1],vhi[i][2],vhi[i][3]}
  #define PIN(x) asm volatile("":"+v"(x))
  #define MX3(a,b,c) __builtin_fmaxf(__builtin_fmaxf((a),(b)),(c))
  #define GAPA(MF,A0,A1,A2,A3,W0,W1,PW) do{ MF; sacc+=A0; sacc+=A1; sacc+=A2; sacc+=A3; PIN(sacc); W0; W1; PIN(PW); SBAR(); }while(0)
  #define EX(v) __builtin_amdgcn_exp2f(v)
  #define GAPB(MF,X,B) do{ MF; X[B]=EX(X[B]); X[B+1]=EX(X[B+1]); X[B+2]=EX(X[B+2]); X[B+3]=EX(X[B+3]); PIN(X); SBAR(); }while(0)
  #define VRD(i) do{ vlo[i]=vtr(vp_+(((i)>>2)*4096+((i)&3)*1024)); vhi[i]=vtr(vp_+(((i)>>2)*4096+((i)&3)*1024+512)); }while(0)
  #define KRD(G,j) do{ if(G){ kload2(kf,kp0+sl_next,j); SBAR(); } }while(0)
  #define STEP(C0,C1,P0,P1,t,GK,GV,GL) do{ SBAR(); \
    const lds_cptr vp_=vp0+sl_prev; \
    VRD(0); SBAR(); float sacc=(P0[0]+P0[1]); \
    GAPA(C0=__builtin_amdgcn_mfma_f32_32x32x16_bf16(kf[0],qr[0],zero16,0,0,0), P0[2],P0[3],P0[4],P0[5],     pw0[0]=PKW(P0,0), pw0[1]=PKW(P0,2), pw0); \
    VRD(4); SBAR(); GAPA(C1=__builtin_amdgcn_mfma_f32_32x32x16_bf16(kf[1],qr[0],zero16,0,0,0), P0[6],P0[7],P0[8],P0[9],     pw0[2]=PKW(P0,4), pw0[3]=PKW(P0,6), pw0); \
    VRD(1); SBAR(); GAPA(C0=__builtin_amdgcn_mfma_f32_32x32x16_bf16(kf[2],qr[1],C0,0,0,0),   P0[10],P0[11],P0[12],P0[13], pw1[0]=PKW(P0,8), pw1[1]=PKW(P0,10), pw1); \
    VRD(5); SBAR(); GAPA(C1=__builtin_amdgcn_mfma_f32_32x32x16_bf16(kf[3],qr[1],C1,0,0,0),   P0[14],P0[15],P1[0],P1[1],   pw1[2]=PKW(P0,12),pw1[3]=PKW(P0,14), pw1); \
    VRD(2); SBAR(); GAPA(C0=__builtin_amdgcn_mfma_f32_32x32x16_bf16(kf[4],qr[2],C0,0,0,0),   P1[2],P1[3],P1[4],P1[5],     pw2[0]=PKW(P1,0), pw2[1]=PKW(P1,2), pw2); \
    VRD(6); SBAR(); GAPA(C1=__builtin_amdgcn_mfma_f32_32x32x16_bf16(kf[5],qr[2],C1,0,0,0),   P1[6],P1[7],P1[8],P1[9],     pw2[2]=PKW(P1,4), pw2[3]=PKW(P1,6), pw2); \
    VRD(3); SBAR(); GAPA(C0=__builtin_amdgcn_mfma_f32_32x32x16_bf16(kf[6],qr[3],C0,0,0,0),   P1[10],P1[11],P1[12],P1[13], pw3[0]=PKW(P1,8), pw3[1]=PKW(P1,10), pw3); \
    VRD(7); SBAR(); GAPA(C1=__builtin_amdgcn_mfma_f32_32x32x16_bf16(kf[7],qr[3],C1,0,0,0),   P1[14],P1[15],0.f,0.f,       pw3[2]=PKW(P1,12),pw3[3]=PKW(P1,14), pw3); \
    l_reg+=sacc; \
    if(GK){DMA_K((t)+3,sl_cur);} if(GV){DMA_V((t)+1,sl_next);} \
    BIAS(C0,C1,t); \
    CMASK(C0,C1,t); \
    { float a=MX3(C0[0],C0[1],C1[0]),b=MX3(C0[2],C0[3],C1[1]); a=MX3(a,C1[2],C1[3]); \
      _Pragma("unroll") for(int r=4;r<16;r+=4){a=MX3(a,C0[r],C0[r+1]);b=MX3(b,C0[r+2],C0[r+3]);a=MX3(a,C1[r],C1[r+1]);b=MX3(b,C1[r+2],C1[r+3]);} \
      float rm=__builtin_fmaxf(a,b); { auto rr=__builtin_amdgcn_permlane32_swap(__float_as_uint(rm),__float_as_uint(rm),false,false); rm=__builtin_fmaxf(__uint_as_float(rr[0]),__uint_as_float(rr[1])); } \
      resc=false; \
      if(__builtin_expect(__any(rm>(float)THRL),0)){ const float dl=__builtin_fmaxf(rm,0.f); mhat+=dl; \
        _Pragma("unroll") for(int r=0;r<16;++r){C0[r]-=dl;C1[r]-=dl;} \
        const float f=__builtin_amdgcn_exp2f(-dl); l_reg*=f; if(hi==0)wsf[r32]=f; resc=true; } } \
    SBAR(); \
    GAPB(o[0]=__builtin_amdgcn_mfma_f32_32x32x16_bf16(PAF(0),VFR(0),o[0],0,0,0), C0,0); \
    GAPB(o[1]=__builtin_amdgcn_mfma_f32_32x32x16_bf16(PAF(0),VFR(4),o[1],0,0,0), C0,4); \
    KRD(GL,0); GAPB(o[0]=__builtin_amdgcn_mfma_f32_32x32x16_bf16(PAF(1),VFR(1),o[0],0,0,0), C0,8); \
    KRD(GL,1); GAPB(o[1]=__builtin_amdgcn_mfma_f32_32x32x16_bf16(PAF(1),VFR(5),o[1],0,0,0), C0,12); \
    KRD(GL,2); GAPB(o[0]=__builtin_amdgcn_mfma_f32_32x32x16_bf16(PAF(2),VFR(2),o[0],0,0,0), C1,0); \
    KRD(GL,3); GAPB(o[1]=__builtin_amdgcn_mfma_f32_32x32x16_bf16(PAF(2),VFR(6),o[1],0,0,0), C1,4); \
    GAPB(o[0]=__builtin_amdgcn_mfma_f32_32x32x16_bf16(PAF(3),VFR(3),o[0],0,0,0), C1,8); \
    GAPB(o[1]=__builtin_amdgcn_mfma_f32_32x32x16_bf16(PAF(3),VFR(7),o[1],0,0,0), C1,12); \
    }while(0)
  int t=1;
  #define ENDW(tt) do{ if((tt)+3<NT){WAIT_BAR(2);} else if((tt)+2<NT){WAIT_BAR(1);} else {WAIT_BAR(0);} }while(0)
  #define PEELED_PAIR() do{ \
    STEP(pB0,pB1,pA0,pA1,t,(t+3<NT),(t+1<NT),(t+1<NT));       ENDW(t);   RESC(); ROT(); \
    STEP(pA0,pA1,pB0,pB1,t+1,(t+4<NT),(t+2<NT),(t+2<NT));     ENDW(t+1); RESC(); ROT(); }while(0)
  for(;t<5&&t+1<NT;t+=2){ PEELED_PAIR(); }
  #undef CMASK
  #define CMASK(P0,P1,t) do{}while(0)
  for(;t+5<NT;t+=2){
    STEP(pB0,pB1,pA0,pA1,t,true,true,true);     WAIT_BAR(2); RESC(); ROT();
    STEP(pA0,pA1,pB0,pB1,t+1,true,true,true);   WAIT_BAR(2); RESC(); ROT();
  }
  #undef CMASK
  #define CMASK(P0,P1,t) do{int jb_=3-(t); if(jb_>=0)cmask(P0,P1,jb_,qrel,hi);}while(0)
  for(;t+1<NT;t+=2){ PEELED_PAIR(); }
  STEP(pB0,pB1,pA0,pA1,NT-1,false,false,false); RESC();
  { float sacc=pB0[0]+pB0[1]; _Pragma("unroll") for(int r=2;r<16;++r)sacc+=pB0[r]; _Pragma("unroll") for(int r=0;r<16;++r)sacc+=pB1[r]; l_reg+=sacc;
    pw0=(u32x4){PKW(pB0,0),PKW(pB0,2),PKW(pB0,4),PKW(pB0,6)};pw1=(u32x4){PKW(pB0,8),PKW(pB0,10),PKW(pB0,12),PKW(pB0,14)};pw2=(u32x4){PKW(pB1,0),PKW(pB1,2),PKW(pB1,4),PKW(pB1,6)};pw3=(u32x4){PKW(pB1,8),PKW(pB1,10),PKW(pB1,12),PKW(pB1,14)};
    SBAR(); pv(o,vb0+sl_cur,PAF(0),PAF(1),PAF(2),PAF(3)); }
  #undef PKW
  #undef PAF
  #undef VFR
  #undef PIN
  #undef MX3
  #undef GAPA
  #undef GAPB
  #undef EX
  #undef VRD
  #undef KRD
  #undef STEP
  #undef ENDW
  #undef PEELED_PAIR
  #undef NBV
  #undef CRC
  #undef NEGV
  #undef NBSEL
  #undef NBB
  #undef NBSELC
  #undef SAV
  #undef BIAS
  {auto rr=__builtin_amdgcn_permlane32_swap(__float_as_uint(l_reg),__float_as_uint(l_reg),false,false);l_reg=__uint_as_float(rr[0])+__uint_as_float(rr[1]);}
  if(hi==0)wsf[32+r32]=l_reg;asm volatile("s_waitcnt lgkmcnt(0)":::"memory");
  float rli[16];
  #pragma unroll
  for(int r=0;r<16;++r)rli[r]=__builtin_amdgcn_rcpf(wsf[32+crow(r,hi)]);
  bf16*Ow=O+(rowbase+q0+wid*QBLK)*DM+h*D;
  { bf16*stg=(bf16*)(shm+LDS_OST)+wid*2048;
    #pragma unroll
    for(int r=0;r<16;++r){const int orow=crow(r,hi);
      #pragma unroll
      for(int d0=0;d0<2;++d0)stg[orow*64+d0*32+r32]=__float2bfloat16(o[d0][r]*rli[r]);}
    asm volatile("s_waitcnt lgkmcnt(0)":::"memory");
    #pragma unroll
    for(int i=0;i<4;++i){const int row=i*8+(lane>>3),ch=lane&7; const u32x4 v=*(const u32x4*)(stg+row*64+ch*8); ATTN_STORE16(Ow+(long)row*DM+ch*8,v);} }
  asm volatile("s_waitcnt lgkmcnt(0)\n\ts_barrier":::"memory");
  #undef DMA_K
  #undef DMA_V
  #undef CMASK
  #undef START
  #undef RESC
  #undef ROT
}
constexpr int ATTN_LDS_BYTES=LDS_BYTES;
struct AttnTensors { const bf16* Q; const bf16* K; const bf16* V; bf16* O; };
struct AttnUnit { int bh; int qb; };
struct AttnPlan { unsigned char unit[32][12]; unsigned char n[32]; };
constexpr int attn_nominal_cost(int h,int qb){ const int pmax[8]={7,12,22,41,64,64,64,64}; const int past=4*qb<pmax[h]?4*qb:pmax[h]; return 4+past+2; }
constexpr AttnPlan make_attn_plan(){
  AttnPlan p{}; int load[32]={}; bool used[128]={};
  for(int it=0;it<128;++it){ int best=-1,bc=-1; for(int e=0;e<128;++e){ if(used[e])continue; const int c=attn_nominal_cost(e>>4,e&15); if(c>bc){bc=c;best=e;} }
    used[best]=true; int cu=0; for(int c=1;c<32;++c) if(load[c]<load[cu]||(load[c]==load[cu]&&p.n[c]<p.n[cu]))cu=c;
    if(p.n[cu]>=12){ for(int c=0;c<32;++c) if(p.n[c]<12){cu=c;break;} }
    p.unit[cu][p.n[cu]++]=(unsigned char)best; load[cu]+=bc; }
  return p; }
__device__ const AttnPlan g_attn_plan=make_attn_plan();
struct StaticOrder {
  int vcu,G;
  __device__ __forceinline__ explicit StaticOrder(int grid,int vcu_):vcu(vcu_),G(grid){}
  __device__ __forceinline__ bool next(int i,AttnUnit&u)const{
    if(G!=256){ const int id=vcu+i*G; if(id>=BATCH*NHEAD*NQB)return false; u.bh=id>>4; u.qb=id&15; return true; }
    const int c=vcu&31; if(i>=(int)g_attn_plan.n[c])return false; const int e=g_attn_plan.unit[c][i]; u.bh=(vcu>>5)*NHEAD+(e>>4); u.qb=e&15; return true; }
};
template<class Sched,int THRL=8> __device__ __forceinline__ void attn_phase(char*lds,const AttnTensors&T,const float*ksum,const float*nrm,const Sched&S){
  AttnUnit u;
  for(int i=0;S.next(i,u);++i){ attn_unit<THRL>(u.bh/NHEAD,u.bh%NHEAD,u.qb,T.Q,T.K,T.V,T.O,ksum,nrm,lds); }
}
#undef SBAR
#undef WAIT_BAR
}

__device__ __forceinline__ void pooled_phase(Frame& F, const Args& A) {
    const bf16* P = (const bf16*)(A.ws + WS_QKVP) + (size_t)3 * T * 512; bf16* PO = (bf16*)(A.ws + WS_POOLED);
    const int gw = F.vcu * NWAVES + F.wave, NGW = F.G * NWAVES, lane = F.lane, w = 2 << (lane >> 4);
    for (int tk = gw; tk < T / 16; tk += NGW) {
        const int row0 = tk * 16, s0 = row0 & (SEQ - 1);
        v4u rv[31];
#pragma unroll
        for (int i = 0; i < 31; ++i) { const int sidx = s0 - 15 + i; rv[i] = (sidx >= 0) ? *(const v4u*)(P + (size_t)(row0 - 15 + i) * 512 + 8 * lane) : (v4u){0u, 0u, 0u, 0u}; }
#pragma unroll
        for (int i = 0; i < 16; ++i) {
            const int sidx = s0 + i; float acc[8];
#pragma unroll
            for (int e = 0; e < 8; ++e) acc[e] = 0.f;
#pragma unroll
            for (int k = 0; k < 16; ++k) { const bool ok = (k < w) && (sidx - k >= 0); const v4u x = rv[15 + i - k]; const float msk = ok ? 1.0f : 0.0f;
                acc[0] += msk * bflo(x.x); acc[1] += msk * bfhi(x.x); acc[2] += msk * bflo(x.y); acc[3] += msk * bfhi(x.y); acc[4] += msk * bflo(x.z); acc[5] += msk * bfhi(x.z); acc[6] += msk * bflo(x.w); acc[7] += msk * bfhi(x.w); }
            const float inv = 1.0f / (float)min(sidx + 1, w); const v4u x = rv[15 + i];
            v4u o; o.x = pk2(acc[0] * inv - bflo(x.x), acc[1] * inv - bfhi(x.x)); o.y = pk2(acc[2] * inv - bflo(x.y), acc[3] * inv - bfhi(x.y));
            o.z = pk2(acc[4] * inv - bflo(x.z), acc[5] * inv - bfhi(x.z)); o.w = pk2(acc[6] * inv - bflo(x.w), acc[7] * inv - bfhi(x.w));
            *(v4u*)(PO + (size_t)(row0 + i) * 512 + 8 * lane) = o;
        }
    }
}

typedef float f32x2 __attribute__((ext_vector_type(2)));
typedef int v4i __attribute__((ext_vector_type(4)));
__device__ __forceinline__ void h2q_rows4(const Args& A, int t0, int lane) {
    const float* modf = (const float*)(A.ws + WS_MODF); const float* ss2 = (const float*)(A.ws + WS_SS2); const float* g2 = A.in[12];
    const int b = t0 / SEQ;
    f32x4 xv[4][4];
#pragma unroll
    for (int u = 0; u < 4; ++u)
#pragma unroll
        for (int q = 0; q < 4; ++q) xv[u][q] = *(const f32x4*)(A.out + (size_t)(t0 + u) * D + 16 * lane + 4 * q);
    f32x4 G[4], S[4];
#pragma unroll
    for (int q = 0; q < 4; ++q) { const int c = 16 * lane + 4 * q; G[q] = *(const f32x4*)(g2 + c) * (*(const f32x4*)(modf + (size_t)b * 6144 + 4096 + c) + 1.0f); S[q] = *(const f32x4*)(modf + (size_t)b * 6144 + 3072 + c); }
#pragma unroll
    for (int u = 0; u < 4; ++u) {
        const f32x4* sp = (const f32x4*)(ss2 + (size_t)(t0 + u) * 16); const f32x4 s4 = (sp[0] + sp[1]) + (sp[2] + sp[3]);
        const float rs = 1.0f / sqrtf(((s4[0] + s4[1]) + (s4[2] + s4[3])) * (1.0f / D) + RMS_EPS);
        float h2[16]; float am = 0.f;
#pragma unroll
        for (int q = 0; q < 4; ++q)
#pragma unroll
            for (int e = 0; e < 4; ++e) { const float h = xv[u][q][e] * rs * G[q][e] + S[q][e]; h2[4 * q + e] = h; am = fmaxf(am, fabsf(h)); }
        am = fmaxf(am, __shfl_xor(am, 1)); am = fmaxf(am, __shfl_xor(am, 2)); am = fmaxf(am, __shfl_xor(am, 4));
        const float hs = (am > 0.f) ? am * (1.0f / 127.0f) : 1.0f, hinv = 1.0f / hs;
        v4u o;
#pragma unroll
        for (int q = 0; q < 4; ++q) { const int q0 = (int)rintf(h2[4 * q] * hinv), q1 = (int)rintf(h2[4 * q + 1] * hinv), q2 = (int)rintf(h2[4 * q + 2] * hinv), q3 = (int)rintf(h2[4 * q + 3] * hinv);
            o[q] = (unsigned)(q0 & 255) | ((unsigned)(q1 & 255) << 8) | ((unsigned)(q2 & 255) << 16) | ((unsigned)q3 << 24); }
        *(v4u*)(A.ws + WS_H2Q + (size_t)(t0 + u) * D + 16 * lane) = o;
        if ((lane & 7) == 0) ((float*)(A.ws + WS_HS))[(size_t)(t0 + u) * 8 + (lane >> 3)] = hs;
    }
}

namespace rt {
typedef float f32x16 __attribute__((ext_vector_type(16)));
typedef short bf16x8 __attribute__((ext_vector_type(8)));
__device__ __forceinline__ void ce(float& hi, float& lo) { const float a = fmaxf(hi, lo), b = fminf(hi, lo); hi = a; lo = b; }
template <int N> __device__ __forceinline__ void sort_desc(float (&v)[N]) {
#pragma unroll
    for (int k = 2; k <= N; k <<= 1)
#pragma unroll
        for (int j = k >> 1; j > 0; j >>= 1)
#pragma unroll
            for (int i = 0; i < N; ++i) { const int l = i ^ j; if (l > i) { if ((i & k) == 0) ce(v[i], v[l]); else ce(v[l], v[i]); } }
}
__device__ __forceinline__ void sort16_desc(float (&v)[16]) {
    ce(v[0], v[13]); ce(v[1], v[12]); ce(v[2], v[15]); ce(v[3], v[14]); ce(v[4], v[8]); ce(v[5], v[6]); ce(v[7], v[11]); ce(v[9], v[10]);
    ce(v[0], v[5]); ce(v[1], v[7]); ce(v[2], v[9]); ce(v[3], v[4]); ce(v[6], v[13]); ce(v[8], v[14]); ce(v[10], v[15]); ce(v[11], v[12]);
    ce(v[0], v[1]); ce(v[2], v[3]); ce(v[4], v[5]); ce(v[6], v[8]); ce(v[7], v[9]); ce(v[10], v[11]); ce(v[12], v[13]); ce(v[14], v[15]);
    ce(v[0], v[2]); ce(v[1], v[3]); ce(v[4], v[10]); ce(v[5], v[11]); ce(v[6], v[7]); ce(v[8], v[9]); ce(v[12], v[14]); ce(v[13], v[15]);
    ce(v[1], v[2]); ce(v[3], v[12]); ce(v[4], v[6]); ce(v[5], v[7]); ce(v[8], v[10]); ce(v[9], v[11]); ce(v[13], v[14]);
    ce(v[1], v[4]); ce(v[2], v[6]); ce(v[5], v[8]); ce(v[7], v[10]); ce(v[9], v[13]); ce(v[11], v[14]);
    ce(v[2], v[4]); ce(v[3], v[6]); ce(v[9], v[12]); ce(v[11], v[13]);
    ce(v[3], v[5]); ce(v[6], v[8]); ce(v[7], v[9]); ce(v[10], v[12]);
    ce(v[3], v[4]); ce(v[5], v[6]); ce(v[7], v[8]); ce(v[9], v[10]); ce(v[11], v[12]);
    ce(v[6], v[7]); ce(v[8], v[9]);
}
template <int N> __device__ __forceinline__ void bitonic_merge_desc(float (&v)[N]) {
#pragma unroll
    for (int j = N >> 1; j > 0; j >>= 1)
#pragma unroll
        for (int i = 0; i < N; ++i) { const int l = i ^ j; if (l > i) ce(v[i], v[l]); }
}
__device__ __forceinline__ void merge_top16(float (&a)[16], const float (&b)[16]) {
#pragma unroll
    for (int i = 0; i < 16; ++i) a[i] = fmaxf(a[i], b[15 - i]);
    bitonic_merge_desc<16>(a);
}
template <bool SORT> __device__ __forceinline__ void pair_merge(float (&a)[16], bool hi) {
    float w[16];
#pragma unroll
    for (int i = 0; i < 16; ++i) w[i] = hi ? a[15 - i] : a[i];
#pragma unroll
    for (int i = 0; i < 16; ++i) { const auto rr = __builtin_amdgcn_permlane32_swap(__float_as_uint(w[i]), __float_as_uint(w[i]), false, false); a[i] = fmaxf(__uint_as_float(rr[0]), __uint_as_float(rr[1])); }
    if (SORT) bitonic_merge_desc<16>(a);
}
__device__ __forceinline__ void fold_tile(const f32x16& acc, int kt, int hi, float (&out)[16]) {
    float g[16];
#pragma unroll
    for (int r = 0; r < 16; ++r) { const unsigned key = (unsigned)(32 * kt + (r & 3) + 8 * (r >> 2)); g[r] = __uint_as_float((__float_as_uint(acc[r]) & ~127u) | key | ((unsigned)hi << 2)); }
    sort16_desc(g);
    if (kt == 0) {
#pragma unroll
        for (int r = 0; r < 16; ++r) out[r] = g[r];
    } else merge_top16(out, g);
}
}
__device__ __forceinline__ void router_phase(Frame& F, const Args& A) {
    using namespace rt;
    const bf16* QP = (const bf16*)(A.ws + WS_GAB); const bf16* SK = (const bf16*)(A.ws + WS_SUBK);
    unsigned short* IDX = (unsigned short*)(A.ws + WS_POOLED); float* GATE = (float*)(A.ws + WS_POOLED + 16 * MiB);
    const int lane = F.lane, n32 = lane & 31, hi = lane >> 5, gw = F.vcu * NWAVES + F.wave, NGW = F.G * NWAVES;
    __syncthreads();
    for (int i = F.tid; i < 2 * 128 * 16; i += NTHREADS) { const int r = i >> 4, ch = i & 15; *(LAS v4u*)(F.lds + r * 272 + ch * 16) = *(const v4u*)(SK + (size_t)r * 128 + ch * 8); }
    __syncthreads();
    LAS unsigned char* scr = F.lds + 73728 + F.wave * 1024;
    const LAS unsigned char* afrag = F.lds + n32 * 272 + hi * 16;
    bf16x8 qa[8], qb[8];
#define RT_QLOAD(task_, p_, q_) do { const int tq_ = (task_) * 4 + (n32 >> 3); const bf16* qr_ = QP + (size_t)tq_ * PQW + (n32 & 7) * 256 + (p_) * 128 + 8 * hi; \
        _Pragma("unroll") for (int i = 0; i < 8; ++i) q_[i] = __builtin_nontemporal_load((const bf16x8*)(qr_ + 16 * i)); } while (0)
#define RT_HALF(p_, q_, out_) do { _Pragma("unroll") for (int kt = 0; kt < 4; ++kt) { f32x16 acc = f32x16{}; \
        _Pragma("unroll") for (int ks = 0; ks < 8; ++ks) { const bf16x8 kf = *(const LAS bf16x8*)(afrag + ((p_) * 128 + 32 * kt) * 272 + 32 * ks); acc = __builtin_amdgcn_mfma_f32_32x32x16_bf16(kf, q_[ks], acc, 0, 0, 0); } \
        fold_tile(acc, kt, hi, out_); } pair_merge<true>(out_, hi != 0); } while (0)
    if (gw < T * PHEADS / 32) RT_QLOAD(gw, 0, qa);
#ifdef TABLES_IN_ROUTER
    int tr0 = gw; const bool late_trip = F.wave >= 4;
#define RT_TABLE_TRIP(cond_) do { if (cond_) { asm volatile("" ::: "memory"); if (tr0 < 2 * PEXP) { p0_table_trip(A, tr0, NGW, lane); tr0 += 4 * NGW; } asm volatile("" ::: "memory"); h2q_rows4(A, task * 4, lane); asm volatile("" ::: "memory"); } } while (0)
#else
#define RT_TABLE_TRIP(cond_) do { } while (0)
#endif
    for (int task = gw; task < T * PHEADS / 32; task += NGW) {
        const int t = task * 4 + (n32 >> 3), h = n32 & 7;
        float la[16], lb[16];
        RT_TABLE_TRIP(!late_trip);
        RT_QLOAD(task, 1, qb);
        RT_HALF(0, qa, la);
        { const int nxt = task + NGW; if (nxt < T * PHEADS / 32) RT_QLOAD(nxt, 0, qa); }
        RT_HALF(1, qb, lb);
        { unsigned w[4];
#pragma unroll
          for (int q = 0; q < 4; ++q) {
              const unsigned i0 = __float_as_uint(hi ? lb[4 * q] : la[4 * q]) & 127u, i1 = __float_as_uint(hi ? lb[4 * q + 1] : la[4 * q + 1]) & 127u, i2 = __float_as_uint(hi ? lb[4 * q + 2] : la[4 * q + 2]) & 127u, i3 = __float_as_uint(hi ? lb[4 * q + 3] : la[4 * q + 3]) & 127u;
              w[q] = i0 | (i1 << 8) | (i2 << 16) | (i3 << 24); }
          *(LAS v4u*)(scr + n32 * 32 + hi * 16) = (v4u){w[0], w[1], w[2], w[3]}; }
        float x[16], y[16];
#pragma unroll
        for (int i = 0; i < 16; ++i) { const float av = __uint_as_float(__float_as_uint(la[i]) & ~127u), bv = __uint_as_float(__float_as_uint(lb[i]) & ~127u); x[i] = hi ? bv : av; y[i] = hi ? av : bv; }
        float c0[16], c1[16];
        {
            const unsigned hb = (unsigned)hi << 8;
#define RT_CAND(i, j) __uint_as_float(((__float_as_uint(x[i] + y[j]) & ~511u) | (unsigned)((i) * 16 + (j))) | hb)
#define RT_DIAG(i) (hi ? -3.0e38f : RT_CAND(i, i))
            c0[0] = RT_DIAG(0);
#pragma unroll
            for (int j = 1; j < 16; ++j) c0[j] = RT_CAND(0, j);
            c1[0] = RT_DIAG(1);
#pragma unroll
            for (int j = 2; j < 8; ++j) c1[j - 1] = RT_CAND(1, j);
            c1[7] = RT_DIAG(2); c1[8] = RT_CAND(2, 3); c1[9] = RT_CAND(2, 4); c1[10] = RT_DIAG(3);
#pragma unroll
            for (int k = 11; k < 16; ++k) c1[k] = -3.0e38f;
#undef RT_CAND
#undef RT_DIAG
        }
        sort16_desc(c0); sort16_desc(c1); merge_top16(c0, c1);
        pair_merge<false>(c0, hi != 0);
        float mx = c0[0];
#pragma unroll
        for (int i = 1; i < 16; ++i) mx = fmaxf(mx, c0[i]);
        float ex[16], sm = 0.f;
#pragma unroll
        for (int i = 0; i < 16; ++i) { ex[i] = __expf(__uint_as_float(__float_as_uint(c0[i]) & ~511u) - mx); sm += ex[i]; }
        const float inv = 1.0f / sm;
        asm volatile("s_waitcnt lgkmcnt(0)" ::: "memory");
        int eo[8]; float go[8];
#pragma unroll
        for (int k = 0; k < 8; ++k) { const float wv = hi ? c0[8 + k] : c0[k]; go[k] = (hi ? ex[8 + k] : ex[k]) * inv;
            const unsigned bits = __float_as_uint(wv), fromhi = (bits >> 8) & 1u, xi = (bits >> 4) & 15u, yj = bits & 15u;
            const unsigned ar = fromhi ? yj : xi, br = fromhi ? xi : yj;
            const unsigned e1 = scr[n32 * 32 + ar], e2 = scr[n32 * 32 + 16 + br];
            eo[k] = (int)(e1 * 128u + e2); }
        unsigned short* ip = IDX + (size_t)t * PSEL + h * PTOP + 8 * hi; float* gp = GATE + (size_t)t * PSEL + h * PTOP + 8 * hi;
        *(v4u*)ip = (v4u){(unsigned)eo[0] | ((unsigned)eo[1] << 16), (unsigned)eo[2] | ((unsigned)eo[3] << 16), (unsigned)eo[4] | ((unsigned)eo[5] << 16), (unsigned)eo[6] | ((unsigned)eo[7] << 16)};
        *(f32x4*)gp = (f32x4){go[0], go[1], go[2], go[3]}; *(f32x4*)(gp + 4) = (f32x4){go[4], go[5], go[6], go[7]};
        asm volatile("s_waitcnt lgkmcnt(0)" ::: "memory");
        RT_TABLE_TRIP(late_trip);
    }
#ifdef TABLES_IN_ROUTER
    while (tr0 < 2 * PEXP) { p0_table_trip(A, tr0, NGW, lane); tr0 += 4 * NGW; }
#endif
#undef RT_TABLE_TRIP
#undef RT_QLOAD
#undef RT_HALF
    __syncthreads();
}

__device__ __forceinline__ float gelu_tanh(float x) { const float u = 0.7978845608028654f * (x + 0.044715f * x * x * x); return x / (1.0f + __expf(-2.0f * u)); }
__device__ __forceinline__ void peer_sliced_phase(Frame& F, const Args& A) {
    const int lane = F.lane, c8 = lane & 7, g8 = lane >> 3, gw = F.vcu * NWAVES + F.wave, NGW = F.G * NWAVES;
    const float* modf = (const float*)(A.ws + WS_MODF);
    const unsigned char* U8 = A.ws + WS_U; const unsigned char* V8 = A.ws + WS_V;
    const f32x2* SUV = (const f32x2*)(A.ws + WS_U + 16 * MiB);
    const unsigned short* IDX = (const unsigned short*)(A.ws + WS_POOLED); const float* GATE = (const float*)(A.ws + WS_POOLED + 16 * MiB);
    const float* gf = A.in[17];
    LAS float* AL = (LAS float*)(F.lds + F.wave * 17664);
    LAS float* SSQ = AL + 2048;
    LAS float* SAV = AL + 3072;
    LAS float* RS2 = AL + 3088;
    LAS float* GS = AL + 3104;
    LAS unsigned short* IDL = (LAS unsigned short*)(AL + 3360);
    for (int tb = gw * 16; tb < T; tb += NGW * 16) {
        for (int i = lane; i < 2048; i += 64) AL[i] = 0.f;
        for (int i = lane; i < 1024; i += 64) SSQ[i] = 0.f;
#pragma unroll
        for (int i = 0; i < 16; ++i) *(LAS unsigned*)(IDL + i * 128 + 2 * lane) = *(const unsigned*)(IDX + (size_t)(tb + i) * PSEL + 2 * lane);
        LDS_WAIT();
        {
            v4i W0[16], W1[16], H0, H1, H; float hs0, hs1, hs;
            const unsigned char* H2Q = A.ws + WS_H2Q; const float* HS = (const float*)(A.ws + WS_HS);
#define PU_X(k, Hx, hx) do { const int k_ = (k) < 128 ? (k) : 127; const int s_ = k_ >> 4, t_ = tb + (k_ & 15); Hx = *(const v4i*)(H2Q + (size_t)t_ * D + 128 * s_ + 16 * c8); hx = HS[(size_t)t_ * 8 + s_]; } while (0)
#define PU_B(k, W) do { const int k_ = (k) < 128 ? (k) : 127; const int s_ = k_ >> 4; const unsigned base_ = ((unsigned)s_ << 21) + 16u * (unsigned)c8; v4u I[2]; I[0] = *(const LAS v4u*)(IDL + (k_ & 15) * 128 + 16 * g8); I[1] = *(const LAS v4u*)(IDL + (k_ & 15) * 128 + 16 * g8 + 8); \
            _Pragma("unroll") for (int j = 0; j < 16; ++j) W[j] = *(const v4i*)(U8 + (base_ + (((I[j >> 3][(j >> 1) & 3] >> (16 * (j & 1))) & 0xffffu) << 7))); \
            } while (0)
#define PU_Q(k, Hx, hx) do { H = Hx; hs = hx; } while (0)
#define PU_C(k, W) do { int part[16]; \
            _Pragma("unroll") for (int j = 0; j < 16; ++j) part[j] = __builtin_amdgcn_sdot4(W[j].x, H.x, __builtin_amdgcn_sdot4(W[j].y, H.y, __builtin_amdgcn_sdot4(W[j].z, H.z, __builtin_amdgcn_sdot4(W[j].w, H.w, 0, false), false), false), false); \
            _Pragma("unroll") for (int step = 4; step >= 1; step >>= 1) { const bool up = (lane & step) != 0; \
                _Pragma("unroll") for (int i = 0; i < 2 * step; ++i) { const int send = up ? part[i] : part[i + 2 * step], keep = up ? part[i + 2 * step] : part[i]; part[i] = keep + __shfl_xor(send, step); } } \
            LAS f32x2* ap_ = (LAS f32x2*)(AL + ((k) & 15) * 128 + 2 * lane); f32x2 a_ = *ap_; a_.x += hs * (float)part[0]; a_.y += hs * (float)part[1]; *ap_ = a_; } while (0)
            PU_X(0, H0, hs0); PU_X(1, H1, hs1); PU_B(0, W0);
#pragma unroll 1
            for (int k = 0; k < 128; k += 2) {
                PU_Q(k, H0, hs0); PU_B(k + 1, W1); PU_X(k + 2, H0, hs0);
                PU_C(k, W0);
                PU_Q(k + 1, H1, hs1); PU_B(k + 2, W0); PU_X(k + 3, H1, hs1);
                PU_C(k + 1, W1);
            }
#undef PU_X
#undef PU_B
#undef PU_Q
#undef PU_C
        }
        LDS_WAIT();
#pragma unroll 4
        for (int i = 0; i < 16; ++i) {
            const int t = tb + i; const unsigned e01 = *(const LAS unsigned*)(IDL + i * 128 + 2 * lane); const int e0 = (int)(e01 & 0xffffu), e1 = (int)(e01 >> 16);
            const f32x2 gt = *(const f32x2*)(GATE + (size_t)t * PSEL + 2 * lane); const f32x2 a = *(LAS f32x2*)(AL + i * 128 + 2 * lane);
            const f32x2 s0 = SUV[e0], s1 = SUV[e1];
            f32x2 av; av.x = gelu_tanh(a.x * s0.x) * gt.x * s0.y; av.y = gelu_tanh(a.y * s1.x) * gt.y * s1.y;
            const float am = wave_max(fmaxf(fabsf(av.x), fabsf(av.y))); const float as = (am > 0.f) ? am * (1.0f / 127.0f) : 1.0f, ainv = 1.0f / as;
            const int q0 = (int)rintf(av.x * ainv), q1 = (int)rintf(av.y * ainv);
            *(LAS unsigned short*)((LAS unsigned char*)AL + i * 512 + 2 * lane) = (unsigned short)((unsigned)(q0 & 255) | ((unsigned)(q1 & 255) << 8));
            if (lane == 0) SAV[i] = as;
        }
        LDS_WAIT();
        {
            v4u W0[16], W1[16]; f32x2 X0, X1, gt2v = (f32x2){0.f, 0.f};
            const int b = tb / SEQ;
#define PV_B(k, W, X) do { const int k_ = (k) < 128 ? (k) : 127; const int s_ = k_ >> 4, t_ = tb + (k_ & 15); const unsigned base_ = ((unsigned)s_ << 21) + 16u * (unsigned)c8; v4u I[2]; I[0] = *(const LAS v4u*)(IDL + (k_ & 15) * 128 + 16 * g8); I[1] = *(const LAS v4u*)(IDL + (k_ & 15) * 128 + 16 * g8 + 8); \
            _Pragma("unroll") for (int j = 0; j < 16; ++j) W[j] = *(const v4u*)(V8 + (base_ + (((I[j >> 3][(j >> 1) & 3] >> (16 * (j & 1))) & 0xffffu) << 7))); \
            X = __builtin_nontemporal_load((const f32x2*)(A.out + (size_t)t_ * D + 128 * s_ + 16 * c8 + 2 * g8)); } while (0)
#define PV_D(W, q4, d, cm) do { const unsigned r0 = W[4 * (q4)].cm, r1 = W[4 * (q4) + 1].cm, r2 = W[4 * (q4) + 2].cm, r3 = W[4 * (q4) + 3].cm; \
                    const unsigned t0 = __builtin_amdgcn_perm(r1, r0, 0x05010400u), t1 = __builtin_amdgcn_perm(r1, r0, 0x07030602u), t2 = __builtin_amdgcn_perm(r3, r2, 0x05010400u), t3 = __builtin_amdgcn_perm(r3, r2, 0x07030602u); \
                    pi[4 * d] = __builtin_amdgcn_sdot4((int)__builtin_amdgcn_perm(t2, t0, 0x05040100u), aq, pi[4 * d], false); pi[4 * d + 1] = __builtin_amdgcn_sdot4((int)__builtin_amdgcn_perm(t2, t0, 0x07060302u), aq, pi[4 * d + 1], false); \
                    pi[4 * d + 2] = __builtin_amdgcn_sdot4((int)__builtin_amdgcn_perm(t3, t1, 0x05040100u), aq, pi[4 * d + 2], false); pi[4 * d + 3] = __builtin_amdgcn_sdot4((int)__builtin_amdgcn_perm(t3, t1, 0x07060302u), aq, pi[4 * d + 3], false); } while (0)
#define PV_Q(W, q4, acm) do { const int aq = (int)a4_.acm; PV_D(W, q4, 0, x); PV_D(W, q4, 1, y); PV_D(W, q4, 2, z); PV_D(W, q4, 3, w); } while (0)
#define PV_C(k, W, X) do { const int s_ = (k) >> 4, i_ = (k) & 15; \
            if (i_ == 0) gt2v = *(const f32x2*)(modf + (size_t)b * 6144 + 5120 + 128 * s_ + 16 * c8 + 2 * g8); \
            int pi[16]; _Pragma("unroll") for (int q = 0; q < 16; ++q) pi[q] = 0; \
            const v4u a4_ = *(const LAS v4u*)((const LAS unsigned char*)AL + i_ * 512 + 16 * g8); \
            PV_Q(W, 0, x); PV_Q(W, 1, y); PV_Q(W, 2, z); PV_Q(W, 3, w); \
            float pc[16]; _Pragma("unroll") for (int q = 0; q < 16; ++q) pc[q] = (float)pi[q];        \
            _Pragma("unroll") for (int step = 4; step >= 1; step >>= 1) { const bool up = (g8 & step) != 0; \
                _Pragma("unroll") for (int i = 0; i < 2 * step; ++i) { const float send = up ? pc[i] : pc[i + 2 * step], keep = up ? pc[i + 2 * step] : pc[i]; pc[i] = keep + __shfl_xor(send, 8 * step); } } \
            const float sav_ = SAV[i_]; f32x2 x2_; x2_.x = X.x + gt2v.x * (sav_ * pc[0]); x2_.y = X.y + gt2v.y * (sav_ * pc[1]); \
            *(f32x2*)(A.out + (size_t)(tb + i_) * D + 128 * s_ + 16 * c8 + 2 * g8) = x2_; \
            SSQ[i_ * 64 + lane] += x2_.x * x2_.x + x2_.y * x2_.y; } while (0)
            PV_B(0, W0, X0);
#pragma unroll 1
            for (int k = 0; k < 128; k += 2) {
                PV_B(k + 1, W1, X1);
                PV_C(k, W0, X0);
                PV_B(k + 2, W0, X0);
                PV_C(k + 1, W1, X1);
            }
#undef PV_B
#undef PV_C
#undef PV_D
#undef PV_Q
        }
        VM_WAIT(); LDS_WAIT();
#pragma unroll 2
        for (int i = 0; i < 16; ++i) {
            float* xr = A.out + (size_t)(tb + i) * D + 16 * lane;
            f32x4 v[4];
#pragma unroll
            for (int q = 0; q < 4; ++q) v[q] = __builtin_nontemporal_load((const f32x4*)(xr + 4 * q));
            const float rs = 1.0f / sqrtf(wave_sum(SSQ[i * 64 + lane]) * (1.0f / D) + RMS_EPS);
#pragma unroll
            for (int q = 0; q < 4; ++q) *(f32x4*)(xr + 4 * q) = v[q] * rs * *(const f32x4*)(gf + 16 * lane + 4 * q);
        }
        LDS_WAIT();
    }
}

template <int NU, bool RS>
__device__ __forceinline__ void stage_unit_tables(Frame& F, const pg8::StaticOrder& S, const float* biasp, int N, LAS float* btab, const float* ss2, LAS float* rtab) {
    pg8::Unit u;
    { const int j = F.tid >> 6, t = F.tid & 63;
      if (j < NU && S.next(j, u)) { const int b = u.pm >> 4, col = u.pn * 256 + 4 * t; f32x4 s = (f32x4){0.f, 0.f, 0.f, 0.f};
#pragma unroll
          for (int kc = 0; kc < 8; ++kc) s += *(const f32x4*)(biasp + (size_t)(kc * 8 + b) * N + col);
          *(LAS f32x4*)(btab + j * 256 + 4 * t) = s; } }
    if (RS) {
#pragma unroll
        for (int jj = 0; jj < (NU * 256 + NTHREADS - 1) / NTHREADS; ++jj) { const int idx = jj * NTHREADS + F.tid, j = idx >> 8, r = idx & 255;
            if (j < NU && S.next(j, u)) { const f32x4* sp = (const f32x4*)(ss2 + (size_t)(u.pm * 256 + r) * 16); const f32x4 s4 = (sp[0] + sp[1]) + (sp[2] + sp[3]);
                rtab[j * 256 + r] = __builtin_amdgcn_rsqf(((s4[0] + s4[1]) + (s4[2] + s4[3])) * (1.0f / D) + RMS_EPS); } }
    }
    __syncthreads();
}

#ifndef PHASE_ONLY
#define PHASE_ONLY -1
#endif
#ifndef PHASE_SKIP
#define PHASE_SKIP -2
#endif
#define PH(n) ((PHASE_ONLY < 0 || PHASE_ONLY == (n)) && PHASE_SKIP != (n))
#ifndef PROBE_DOUBLE
#define PROBE_DOUBLE -1
#endif
#define REPS(n) for (int rep_ = 0; rep_ < ((PROBE_DOUBLE == (n)) ? 2 : 1); ++rep_)
__global__ void __launch_bounds__(NTHREADS, 2) fwd_megakernel(Args A) {
    extern __shared__ __attribute__((aligned(16))) unsigned char lds[];
    Frame F;
    F.lds = (LAS unsigned char*)lds;
    F.MISC = (volatile LAS unsigned*)(F.lds + MISC_OFF);
    F.tid = threadIdx.x; F.lane = F.tid & 63; F.wave = __builtin_amdgcn_readfirstlane(F.tid >> 6);
    F.G = gridDim.x; { const int bx = blockIdx.x; F.vcu = (F.G % 8 == 0) ? (bx % 8) * (F.G / 8) + bx / 8 : bx; }
    F.ctl = (gu32*)(A.ws + WS_CTL);
    for (int u = F.tid; u < (LDS_BYTES - LDSCTL_OFF) / 4; u += NTHREADS) ((LAS unsigned*)(F.lds + LDSCTL_OFF))[u] = 0u;
    __syncthreads();
    XcdBarrier bar = xcd_barrier_post((unsigned*)(F.ctl + CW_BAR), F.MISC + 8);
#define GRID_BAR() do { xcd_barrier(bar); int t_ = threadIdx.x; asm volatile("" : "+v"(t_)); F.tid = t_; F.lane = t_ & 63; F.wave = __builtin_amdgcn_readfirstlane(t_ >> 6); } while (0)
    unsigned char* ws = A.ws;

    REPS(0) if (PH(0)) { p0a_mod(F, A); p0b_prologue<0>(F, A); }
    GRID_BAR();
    REPS(1) if (PH(1)) p0b_prologue<1>(F, A);
    GRID_BAR();
    REPS(2) if (PH(2)) {
        pg8::Gemm g{(const bf16*)(ws + WS_XG), nullptr, (const bf16*)(ws + WS_WIN), nullptr, D, D, D};
        pg8::StaticOrder S; S.init(T, INW, F.G, (int)blockIdx.x);
        pg8::EpiIn E{(bf16*)(ws + WS_QKVP), (bf16*)(ws + WS_GAB), (const float*)(ws + WS_RSTD1), (const float*)(ws + WS_BIAS1P), (float*)(ws + WS_KSUM), (unsigned*)(ws + WS_CTL) + CW_NRM};
        pg8::gemm_phase<pg8::EpiIn, pg8::StaticOrder, true, true>(F.lds + RING_OFF, g, S, E);
    }
    GRID_BAR();
    REPS(3) if (PH(3)) {
        const attn_body::AttnTensors AT{(const attn_body::bf16*)(ws + WS_QKVP), (const attn_body::bf16*)(ws + WS_QKVP) + (size_t)T * 512, (const attn_body::bf16*)(ws + WS_QKVP) + (size_t)2 * T * 512, (PROBE_DOUBLE == 3 && rep_ == 0) ? (attn_body::bf16*)(ws + WS_XG) : (attn_body::bf16*)(ws + WS_QKVP)};
        const attn_body::StaticOrder S((int)F.G, F.vcu);
        attn_body::attn_phase<attn_body::StaticOrder>((char*)lds + RING_OFF, AT, (const float*)(ws + WS_KSUM), (const float*)((const unsigned*)(ws + WS_CTL) + CW_NRM), S);
    }
    REPS(4) if (PH(4)) pooled_phase(F, A);
    GRID_BAR();
    REPS(5) if (PH(5)) {
        pg8::Gemm g{(const bf16*)(ws + WS_QKVP), (const bf16*)(ws + WS_POOLED), (const bf16*)(ws + WS_WA), (const bf16*)(ws + WS_WP), AW, AW, AW};
        pg8::DualOrder S; S.init(T, D, F.G, (int)blockIdx.x);
        pg8::EpiUp E{(bf16*)(ws + WS_XG), (const bf16*)(ws + WS_GAB), (const float*)(ws + WS_BPRIME)};
        pg8::gemm_phase<pg8::EpiUp, pg8::DualOrder, true, true>(F.lds + RING_OFF, g, S, E);
    }
    GRID_BAR();
    REPS(6) if (PH(6)) {
        pg8::Gemm g{(const bf16*)(ws + WS_XG), nullptr, (const bf16*)(ws + WS_WOUT), nullptr, D, D, D};
        pg8::StaticOrder S; S.init(T, D, F.G, (int)blockIdx.x);
        pg8::EpiOut E{A.in[0], A.out, (bf16*)(ws + WS_QKVP), (const float*)(ws + WS_MODF), A.in[12], (float*)(ws + WS_SS2)};
        pg8::gemm_phase<pg8::EpiOut, pg8::StaticOrder, true, true>(F.lds + RING_OFF, g, S, E);
    }
    GRID_BAR();
    REPS(7) if (PH(7)) {
        pg8::Gemm g{(const bf16*)(ws + WS_QKVP), nullptr, (const bf16*)(ws + WS_WQ), nullptr, D, D, D};
        pg8::StaticOrder S; S.init(T, PQW, F.G, (int)blockIdx.x);
        LAS float* btab = (LAS float*)(F.lds + BTAB_OFF); LAS float* rtab = (LAS float*)(F.lds + RTAB_OFF);
        stage_unit_tables<4, true>(F, S, (const float*)(ws + WS_BIAS2P), PQW, btab, (const float*)(ws + WS_SS2), rtab);
        pg8::EpiPq E{(bf16*)(ws + WS_GAB), (const float*)(ws + WS_SS2), (const float*)(ws + WS_BIAS2P), btab, rtab};
        pg8::gemm_phase<pg8::EpiPq, pg8::StaticOrder, true, true>(F.lds + RING_OFF, g, S, E);
    }
    GRID_BAR();
    REPS(8) if (PH(8)) router_phase(F, A);
    GRID_BAR();
    if (PH(9)) peer_sliced_phase(F, A);
}

extern "C" void kernel_launch(void* const* d_in, const int* in_sizes, int n_in, void* d_out, int out_size, void* d_ws, size_t ws_size, hipStream_t stream) {
    static int grid = 0;
    if (grid == 0) {
        if (n_in != 18 || in_sizes[0] != T * D || out_size != T * D || ws_size < WS_END) { fprintf(stderr, "kernel_launch: unexpected shapes (n_in %d, in0 %d, out %d, ws %zu); nothing launched\n", n_in, n_in > 0 ? in_sizes[0] : -1, out_size, ws_size); grid = -1; return; }
        int dev = 0, cus = 0, per_cu = 0;
        if (hipGetDevice(&dev) != hipSuccess || hipDeviceGetAttribute(&cus, hipDeviceAttributeMultiprocessorCount, dev) != hipSuccess) { grid = -1; return; }
        if (hipFuncSetAttribute((const void*)fwd_megakernel, hipFuncAttributeMaxDynamicSharedMemorySize, LDS_BYTES) != hipSuccess) { fprintf(stderr, "kernel_launch: hipFuncSetAttribute failed\n"); grid = -1; return; }
        if (hipOccupancyMaxActiveBlocksPerMultiprocessor(&per_cu, (const void*)fwd_megakernel, NTHREADS, LDS_BYTES) != hipSuccess || per_cu < 1) { fprintf(stderr, "kernel_launch: occupancy query reports %d workgroups per CU\n", per_cu); per_cu = 1; }
        (void)hipGetLastError();
        grid = cus;
        if ((long)grid * 8 < (long)(T / 256) * (INW / 256) || (long)grid * 4 < (long)(T / 256) * (PQW / 256)) { fprintf(stderr, "kernel_launch: %d workgroups are too few for the per-unit epilogue tables (need >= 256); nothing launched\n", grid); grid = -1; return; }
    }
    if (grid < 0) return;
    if (hipMemsetAsync((char*)d_ws + WS_CTL, 0, CTL_ZERO_BYTES, stream) != hipSuccess) { fprintf(stderr, "kernel_launch: hipMemsetAsync failed\n"); return; }
    Args a{};
    for (int i = 0; i < 18; ++i) a.in[i] = (const float*)d_in[i];
    a.out = (float*)d_out; a.ws = (unsigned char*)d_ws;
    void* kargs[] = {&a};
    hipError_t e = hipLaunchCooperativeKernel((const void*)fwd_megakernel, dim3(grid), dim3(NTHREADS), kargs, LDS_BYTES, stream);
    if (e != hipSuccess) fprintf(stderr, "kernel_launch: cooperative launch failed: %s (grid %d)\n", hipGetErrorString(e), grid);
}
```

```cpp
#define TABLES_IN_ROUTER 1
#include <hip/hip_runtime.h>
#include <hip/hip_bf16.h>
#include <cstdio>
#include <cstdint>
#include <cmath>

constexpr int NB = 8, SEQ = 4096, T = NB * SEQ, D = 1024;
constexpr int AW = 512, PW = 512, INW = 4096;
constexpr int NH = 8, HD = 64, MBLK = 256, NBLK = SEQ / MBLK;
constexpr int PQW = 2048, PEXP = 16384, PTOP = 16, PHEADS = 8, PSEL = PHEADS * PTOP;
constexpr float RMS_EPS = 1e-6f;
constexpr float LOG2E = 1.4426950408889634f;
constexpr float QSCALE = 0.125f * LOG2E;
constexpr int NWAVES = 8, NTHREADS = 512;

namespace pg8 {
#define PG8_LAS __attribute__((address_space(3)))
typedef unsigned short bf16_t;
typedef short bf16x8 __attribute__((ext_vector_type(8)));
typedef float f32x4 __attribute__((ext_vector_type(4)));
typedef unsigned u32x4 __attribute__((ext_vector_type(4)));
constexpr int BM = 256, BK = 64, HALF = 128, HTB = HALF * BK * 2  , STAGE_BYTES = 8 * HTB, NXCD = 8, WGM = 8;

__host__ __device__ __forceinline__ int lds_byte(int r, int c) { const int st = (r >> 4) * 2 + (c >> 5), rr = r & 15, cc = c & 31, ob = rr * 64 + cc * 2; return st * 1024 + (ob ^ (((ob >> 9) & 1) << 5)); }
__host__ __device__ __forceinline__ void stage_rc(int b, int& R, int& C) { const int st = b / 1024, sb = b % 1024, swz = sb ^ (((sb >> 9) & 1) << 5); R = (st >> 1) * 16 + swz / 64; C = (st & 1) * 32 + (swz % 64) / 2; }
__host__ __device__ __forceinline__ int perm32(int rho) { const int n = rho >> 4, i = rho & 15; return 8 * (i >> 2) + 4 * n + (i & 3); }

struct Unit { int pm, pn, part; };
struct Gemm {
    const bf16_t* A0; const bf16_t* A1; const bf16_t* B0; const bf16_t* B1; int lda, ldb, K;
    __device__ __forceinline__ const char* a_ptr(const Unit& u) const { return (const char*)(u.part ? A1 : A0) + (size_t)u.pm * BM * lda * 2; }
    __device__ __forceinline__ const char* b_ptr(const Unit& u) const { return (const char*)(u.part ? B1 : B0) + (size_t)u.pn * BM * ldb * 2; }
};

struct StaticOrder {
    int nM, nN, nwg, G, c;
    __host__ __device__ void init(int M, int N, int G_, int c_) { nM = M / BM; nN = N / BM; nwg = nM * nN; G = G_; c = c_; }
    __host__ __device__ bool tile(long L, Unit& u) const {
        if (L >= nwg) return false;
        int wgid = (int)L; { const int q = nwg / NXCD, r = nwg % NXCD, xcd = wgid % NXCD, off = wgid / NXCD; wgid = (xcd < r ? xcd * (q + 1) : r * (q + 1) + (xcd - r) * q) + off; }
        const int nig = WGM * nN, gid = wgid / nig, fm = gid * WGM, gsz = (nM - fm) < WGM ? (nM - fm) : WGM;
        u.pm = fm + ((wgid % nig) % gsz); u.pn = (wgid % nig) / gsz; u.part = 0; return true;
    }
    __host__ __device__ bool next(int i, Unit& u) const { return tile((long)i * G + c, u); }
    __device__ __forceinline__ void a_ready(const Unit&) const {}
    __device__ __forceinline__ void done(const Unit&) const {}
};
struct DualOrder {
    StaticOrder so;
    __host__ __device__ void init(int M, int N, int G_, int c_) { so.init(M, N, G_, c_); }
    __host__ __device__ bool next(int i, Unit& u) const { if (!so.tile((long)(i >> 1) * so.G + so.c, u)) return false; u.part = i & 1; return true; }
    __device__ __forceinline__ void a_ready(const Unit&) const {}
    __device__ __forceinline__ void done(const Unit&) const {}
};

__device__ __forceinline__ unsigned cvt_pk_bf16(float lo, float hi) { unsigned r; asm volatile("v_cvt_pk_bf16_f32 %0, %1, %2" : "=v"(r) : "v"(lo), "v"(hi)); return r; }
__device__ __forceinline__ float bf_lo(unsigned w) { return __uint_as_float(w << 16); }
__device__ __forceinline__ float bf_hi(unsigned w) { return __uint_as_float(w & 0xffff0000u); }
__device__ __forceinline__ float sigmoidf_(float x) { return __builtin_amdgcn_rcpf(1.0f + __builtin_amdgcn_exp2f(-x * 1.4426950408889634f)); }


struct EpiIn {
    static constexpr bool PERM = true, AFTER_DRAIN = false, KEEP_ACC = false, WANT_INDEX = true;
    bf16_t* QKVP; bf16_t* GAB; const float* rstd1; const float* bias1p; float* ksum; unsigned* nrm; const PG8_LAS float* btab;
    __device__ __forceinline__ void operator()(const f32x4 (&acc)[2][2][4][2], const Unit& u, int wr, int wc, int fr, int fq) const {
        bf16_t* base; int ldc, col0;
        if (u.pn < 8) { base = QKVP + (size_t)(u.pn >> 1) * T * 512; ldc = 512; col0 = (u.pn & 1) * 256; }
        else { base = GAB + (size_t)((u.pn - 8) >> 2) * T * 1024; ldc = 1024; col0 = ((u.pn - 8) & 3) * 256; }
        const float sc = (u.pn < 2) ? QSCALE : 1.0f;
        const int b = u.pm >> 4;
        const int bcol = u.pn * 256 + wc * 32 + 8 * fq;
        f32x4 bv[2][2];
#pragma unroll
        for (int bj = 0; bj < 2; ++bj)
#pragma unroll
            for (int n = 0; n < 2; ++n) { f32x4 s = (f32x4){0.f, 0.f, 0.f, 0.f};
                s = *(const PG8_LAS f32x4*)(btab + u.part * 256 + wc * 32 + 8 * fq + bj * HALF + 4 * n);
                bv[bj][n] = s; }
        const bool isk = (u.pn == 2 || u.pn == 3); const bool isqk = (u.pn < 4); float nmax[2] = {0.f, 0.f};
        f32x4 ks[2][2];
#pragma unroll
        for (int bj = 0; bj < 2; ++bj)
#pragma unroll
            for (int n = 0; n < 2; ++n) ks[bj][n] = (f32x4){0.f, 0.f, 0.f, 0.f};
        const int row0 = u.pm * BM + wr * 64 + fr;
#pragma unroll
        for (int ai = 0; ai < 2; ++ai)
#pragma unroll
            for (int m = 0; m < 4; ++m) { const int row = row0 + ai * HALF + m * 16; const float rs = rstd1[row];
                bf16_t* rowp = base + (size_t)row * ldc + col0 + wc * 32 + 8 * fq;
#pragma unroll
                for (int bj = 0; bj < 2; ++bj) { f32x4 v0 = acc[ai][bj][m][0] * rs + bv[bj][0], v1 = acc[ai][bj][m][1] * rs + bv[bj][1];
                    ks[bj][0] += v0; ks[bj][1] += v1;
                    v0 = v0 * sc; v1 = v1 * sc;
                    if (isqk) { float ss = (v0[0] * v0[0] + v0[1] * v0[1]) + (v0[2] * v0[2] + v0[3] * v0[3]) + (v1[0] * v1[0] + v1[1] * v1[1]) + (v1[2] * v1[2] + v1[3] * v1[3]); ss += __shfl_xor(ss, 16); ss += __shfl_xor(ss, 32); nmax[bj] = fmaxf(nmax[bj], ss); }
                    u32x4 w; w.x = cvt_pk_bf16(v0[0], v0[1]); w.y = cvt_pk_bf16(v0[2], v0[3]); w.z = cvt_pk_bf16(v1[0], v1[1]); w.w = cvt_pk_bf16(v1[2], v1[3]);
                    *(u32x4*)(rowp + bj * HALF) = w; } }
        if (isqk) {
#pragma unroll
            for (int bj = 0; bj < 2; ++bj) { float v = nmax[bj]; v = fmaxf(v, __shfl_xor(v, 1)); v = fmaxf(v, __shfl_xor(v, 2)); v = fmaxf(v, __shfl_xor(v, 4)); v = fmaxf(v, __shfl_xor(v, 8));
                if (fr == 0 && fq == 0) atomicMax(nrm + (size_t)(b * 2 + (u.pn >> 1)) * 16 + (u.pn & 1) * 8 + bj * 4 + wc, __float_as_uint(v)); }
        }
        if (isk) {
#pragma unroll
            for (int bj = 0; bj < 2; ++bj)
#pragma unroll
                for (int n = 0; n < 2; ++n)
#pragma unroll
                    for (int e = 0; e < 4; ++e) { float v = ks[bj][n][e]; v += __shfl_xor(v, 1); v += __shfl_xor(v, 2); v += __shfl_xor(v, 4); v += __shfl_xor(v, 8); ks[bj][n][e] = v; }
            if (fr == 0) { float* kp = ksum + (size_t)u.pm * 512 + (u.pn - 2) * 256 + wc * 32 + 8 * fq;
#pragma unroll
                for (int bj = 0; bj < 2; ++bj)
#pragma unroll
                    for (int n = 0; n < 2; ++n)
#pragma unroll
                        for (int e = 0; e < 4; ++e) atomicAdd(kp + bj * HALF + 4 * n + e, ks[bj][n][e]); }
        }
    }
};

struct EpiUp {
    static constexpr bool PERM = true, AFTER_DRAIN = false, KEEP_ACC = true, WANT_INDEX = false;
    bf16_t* merged; const bf16_t* GAB; const float* bprime;
    static __device__ __forceinline__ float e_neg(float g) { return __builtin_amdgcn_exp2f(-g * 1.4426950408889634f); }
    static __device__ __forceinline__ float ratio(float ga, float gb) { return (1.0f + e_neg(fmaxf(gb, -60.0f))) * __builtin_amdgcn_rcpf(1.0f + e_neg(ga)); }
    static __device__ __forceinline__ float sigb(float gb) { return __builtin_amdgcn_rcpf(1.0f + e_neg(fmaxf(gb, -60.0f))); }
    __device__ __forceinline__ void operator()(f32x4 (&acc)[2][2][4][2], const Unit& u, int wr, int wc, int fr, int fq) const {
        const int row0 = u.pm * BM + wr * 64 + fr, colb = u.pn * BM + wc * 32 + 8 * fq;
        const bf16_t* ga = GAB; const bf16_t* gb = GAB + (size_t)T * 1024;
        if (u.part == 0) {
#pragma unroll
            for (int ai = 0; ai < 2; ++ai) {
                u32x4 apre[4][2], bpre[4][2];
#pragma unroll
                for (int m = 0; m < 4; ++m) { const size_t off = (size_t)(row0 + ai * HALF + m * 16) * 1024 + colb;
#pragma unroll
                    for (int bj = 0; bj < 2; ++bj) { apre[m][bj] = __builtin_nontemporal_load((const u32x4*)(ga + off + bj * HALF)); bpre[m][bj] = *(const u32x4*)(gb + off + bj * HALF); } }
#pragma unroll
                for (int m = 0; m < 4; ++m)
#pragma unroll
                    for (int bj = 0; bj < 2; ++bj) { const u32x4 aw = apre[m][bj], bw = bpre[m][bj];
                        f32x4& v0 = acc[ai][bj][m][0]; f32x4& v1 = acc[ai][bj][m][1];
                        v0[0] *= ratio(bf_lo(aw.x), bf_lo(bw.x)); v0[1] *= ratio(bf_hi(aw.x), bf_hi(bw.x)); v0[2] *= ratio(bf_lo(aw.y), bf_lo(bw.y)); v0[3] *= ratio(bf_hi(aw.y), bf_hi(bw.y));
                        v1[0] *= ratio(bf_lo(aw.z), bf_lo(bw.z)); v1[1] *= ratio(bf_hi(aw.z), bf_hi(bw.z)); v1[2] *= ratio(bf_lo(aw.w), bf_lo(bw.w)); v1[3] *= ratio(bf_hi(aw.w), bf_hi(bw.w)); }
            }
            return;
        }
        f32x4 bv[2][2];
#pragma unroll
        for (int bj = 0; bj < 2; ++bj)
#pragma unroll
            for (int n = 0; n < 2; ++n) { f32x4 s_ = (f32x4){0.f, 0.f, 0.f, 0.f}; _Pragma("unroll") for (int g_ = 0; g_ < 4; ++g_) s_ += *(const f32x4*)(bprime + g_ * 1024 + colb + bj * HALF + 4 * n); bv[bj][n] = s_; }
#pragma unroll
        for (int ai = 0; ai < 2; ++ai) {
            u32x4 gpre[4][2];
#pragma unroll
            for (int m = 0; m < 4; ++m) { const size_t off = (size_t)(row0 + ai * HALF + m * 16) * 1024 + colb;
#pragma unroll
                for (int bj = 0; bj < 2; ++bj) gpre[m][bj] = __builtin_nontemporal_load((const u32x4*)(gb + off + bj * HALF)); }
#pragma unroll
            for (int m = 0; m < 4; ++m) { const size_t off = (size_t)(row0 + ai * HALF + m * 16) * 1024 + colb;
#pragma unroll
                for (int bj = 0; bj < 2; ++bj) {
                    const u32x4 gw = gpre[m][bj];
                    f32x4 v0 = acc[ai][bj][m][0] + bv[bj][0], v1 = acc[ai][bj][m][1] + bv[bj][1];
                    v0[0] *= sigb(bf_lo(gw.x)); v0[1] *= sigb(bf_hi(gw.x)); v0[2] *= sigb(bf_lo(gw.y)); v0[3] *= sigb(bf_hi(gw.y));
                    v1[0] *= sigb(bf_lo(gw.z)); v1[1] *= sigb(bf_hi(gw.z)); v1[2] *= sigb(bf_lo(gw.w)); v1[3] *= sigb(bf_hi(gw.w));
                    u32x4 w; w.x = cvt_pk_bf16(v0[0], v0[1]); w.y = cvt_pk_bf16(v0[2], v0[3]); w.z = cvt_pk_bf16(v1[0], v1[1]); w.w = cvt_pk_bf16(v1[2], v1[3]);
                    *(u32x4*)(merged + off + bj * HALF) = w; } }
        }
    }
};

struct EpiOut {
    static constexpr bool PERM = true, AFTER_DRAIN = false, KEEP_ACC = false, WANT_INDEX = false;
    const float* x; float* x1; bf16_t* A2; const float* modf; const float* g2; float* ss2;
    __device__ __forceinline__ void operator()(const f32x4 (&acc)[2][2][4][2], const Unit& u, int wr, int wc, int fr, int fq) const {
        const int row0 = u.pm * BM + wr * 64 + fr, colb = u.pn * BM + wc * 32 + 8 * fq, b = u.pm >> 4;
        f32x4 gt[2][2], gg[2][2];
#pragma unroll
        for (int bj = 0; bj < 2; ++bj)
#pragma unroll
            for (int n = 0; n < 2; ++n) { const int c = colb + bj * HALF + 4 * n; gt[bj][n] = *(const f32x4*)(modf + (size_t)b * 6144 + 2048 + c);
                const f32x4 sc2 = *(const f32x4*)(modf + (size_t)b * 6144 + 4096 + c); gg[bj][n] = *(const f32x4*)(g2 + c) * (sc2 + 1.0f); }
#pragma unroll
        for (int ai = 0; ai < 2; ++ai) {
#pragma unroll
          for (int mh = 0; mh < 2; ++mh) {
            f32x4 xr[2][2][2];
#pragma unroll
            for (int m2 = 0; m2 < 2; ++m2) { const size_t off = (size_t)(row0 + ai * HALF + (2 * mh + m2) * 16) * 1024 + colb;
#pragma unroll
                for (int bj = 0; bj < 2; ++bj) { xr[m2][bj][0] = __builtin_nontemporal_load((const f32x4*)(x + off + bj * HALF)); xr[m2][bj][1] = __builtin_nontemporal_load((const f32x4*)(x + off + bj * HALF + 4)); } }
#pragma unroll
            for (int m2 = 0; m2 < 2; ++m2) { const int m = 2 * mh + m2; const int row = row0 + ai * HALF + m * 16; const size_t off = (size_t)row * 1024 + colb; float ssq = 0.f;
#pragma unroll
                for (int bj = 0; bj < 2; ++bj) {
                    const f32x4 y0 = xr[m2][bj][0] + gt[bj][0] * acc[ai][bj][m][0], y1 = xr[m2][bj][1] + gt[bj][1] * acc[ai][bj][m][1];
                    *(f32x4*)(x1 + off + bj * HALF) = y0; *(f32x4*)(x1 + off + bj * HALF + 4) = y1;
                    ssq += (y0[0] * y0[0] + y0[1] * y0[1]) + (y0[2] * y0[2] + y0[3] * y0[3]) + (y1[0] * y1[0] + y1[1] * y1[1]) + (y1[2] * y1[2] + y1[3] * y1[3]);
                    const f32x4 a0 = y0 * gg[bj][0], a1 = y1 * gg[bj][1];
                    u32x4 w; w.x = cvt_pk_bf16(a0[0], a0[1]); w.y = cvt_pk_bf16(a0[2], a0[3]); w.z = cvt_pk_bf16(a1[0], a1[1]); w.w = cvt_pk_bf16(a1[2], a1[3]);
                    *(u32x4*)(A2 + off + bj * HALF) = w; }
                ssq += __shfl_xor(ssq, 16); ssq += __shfl_xor(ssq, 32);
                if (fq == 0) ss2[(size_t)row * 16 + u.pn * 4 + wc] = ssq; }
          }
        }
    }
};

struct EpiPq {
    static constexpr bool PERM = true, AFTER_DRAIN = false, KEEP_ACC = false, WANT_INDEX = true;
    bf16_t* QP; const float* ss2; const float* bias2p; const PG8_LAS float* btab; const PG8_LAS float* rtab;
    __device__ __forceinline__ void operator()(const f32x4 (&acc)[2][2][4][2], const Unit& u, int wr, int wc, int fr, int fq) const {
        const int row0 = u.pm * BM + wr * 64 + fr, colb = u.pn * BM + wc * 32 + 8 * fq, b = u.pm >> 4;
        f32x4 bv[2][2];
#pragma unroll
        for (int bj = 0; bj < 2; ++bj)
#pragma unroll
            for (int n = 0; n < 2; ++n) { f32x4 s = (f32x4){0.f, 0.f, 0.f, 0.f};
                s = *(const PG8_LAS f32x4*)(btab + u.part * 256 + wc * 32 + 8 * fq + bj * HALF + 4 * n);
                bv[bj][n] = s; }
#pragma unroll
        for (int ai = 0; ai < 2; ++ai)
#pragma unroll
            for (int m = 0; m < 4; ++m) { const int row = row0 + ai * HALF + m * 16;
                const float rs = rtab[u.part * 256 + wr * 64 + ai * HALF + m * 16 + fr];
                bf16_t* rowp = QP + (size_t)row * PQW + colb;
#pragma unroll
                for (int bj = 0; bj < 2; ++bj) { const f32x4 v0 = acc[ai][bj][m][0] * rs + bv[bj][0], v1 = acc[ai][bj][m][1] * rs + bv[bj][1];
                    u32x4 w; w.x = cvt_pk_bf16(v0[0], v0[1]); w.y = cvt_pk_bf16(v0[2], v0[3]); w.z = cvt_pk_bf16(v1[0], v1[1]); w.w = cvt_pk_bf16(v1[2], v1[3]);
                    *(u32x4*)(rowp + bj * HALF) = w; } }
    }
};

template <class Epi, class Sched, bool ALIGN_EPI = false, bool SP2 = false>
__device__ __forceinline__ void gemm_phase(PG8_LAS unsigned char* lds, const Gemm g, const Sched& S, const Epi& E) {
    int tid_ = threadIdx.x; asm volatile("" : "+v"(tid_));
    const int tid = tid_, wid = __builtin_amdgcn_readfirstlane(tid >> 6), lane = tid & 63, wr = wid >> 2, wc = wid & 3, fr = lane & 15, fq = lane >> 4;
    const int K = g.K, nt = K / BK, lda = g.lda, ldb = g.ldb;
    unsigned voffA[2], voffB[2];
#pragma unroll
    for (int i = 0; i < 2; ++i) { int R, C; stage_rc(tid * 16 + i * 8192, R, C); const int Rb = Epi::PERM ? ((R & ~31) + perm32(R & 31)) : R;
        voffA[i] = (unsigned)(R * lda + C) * 2u; voffB[i] = (unsigned)(Rb * ldb + C) * 2u; }
    const size_t kstep = (size_t)(BK * 2);
    const size_t hstepA = (size_t)HALF * lda * 2, hstepB = (size_t)HALF * ldb * 2;
    const unsigned ldsw = (unsigned)wid * 1024u;
    const int aoff = lds_byte(wr * 64 + fr, fq * 8), boff = lds_byte(wc * 32 + fr, fq * 8);
#define PG8_SA(b, h) (((b) * 2 + (h)) * HTB)
#define PG8_SB(b, h) ((4 + (b) * 2 + (h)) * HTB)
#define PG8_STAGE(bufoff, gbase, voff) do { _Pragma("unroll") for (int _i = 0; _i < 2; ++_i) \
        __builtin_amdgcn_global_load_lds((const unsigned*)((const char*)(gbase) + (voff)[_i]), (PG8_LAS unsigned*)(lds + (bufoff) + ldsw + _i * 8192), 16, 0, 0); } while (0)
#define PG8_LDA(dst, b, h) do { _Pragma("unroll") for (int m = 0; m < 4; ++m) _Pragma("unroll") for (int k = 0; k < 2; ++k) dst[m][k] = *(const PG8_LAS bf16x8*)(lds + PG8_SA(b, h) + aoff + m * 2048 + k * 1024); } while (0)
#define PG8_LDB(dst, b, h) do { _Pragma("unroll") for (int n = 0; n < 2; ++n) _Pragma("unroll") for (int k = 0; k < 2; ++k) dst[n][k] = *(const PG8_LAS bf16x8*)(lds + PG8_SB(b, h) + boff + n * 2048 + k * 1024); } while (0)
#define PG8_MMA(ai, bj, At, Bt) do { __builtin_amdgcn_s_setprio(1); _Pragma("unroll") for (int m = 0; m < 4; ++m) _Pragma("unroll") for (int n = 0; n < 2; ++n) _Pragma("unroll") for (int k = 0; k < 2; ++k) \
        acc[ai][bj][m][n] = __builtin_amdgcn_mfma_f32_16x16x32_bf16(Bt[n][k], At[m][k], acc[ai][bj][m][n], 0, 0, 0); __builtin_amdgcn_s_setprio(0); } while (0)
#define PG8_WAIT_V(n) asm volatile("s_waitcnt vmcnt(" #n ")" ::: "memory")
#define PG8_WAIT_L(n) asm volatile("s_waitcnt lgkmcnt(" #n ")" ::: "memory")
#define PG8_BAR __builtin_amdgcn_s_barrier()
#define PG8_SCHED __builtin_amdgcn_sched_barrier(0)
    Unit cur, nxt; int ui = 0;
    if (!S.next(0, cur)) return;
    f32x4 acc[2][2][4][2];
#pragma unroll
    for (int a = 0; a < 2; ++a)
#pragma unroll
        for (int b = 0; b < 2; ++b)
#pragma unroll
            for (int m = 0; m < 4; ++m)
#pragma unroll
                for (int n = 0; n < 2; ++n) acc[a][b][m][n] = (f32x4){0.f, 0.f, 0.f, 0.f};
    bf16x8 At[4][2], B0[2][2], B1[2][2];
    const char* cA = g.a_ptr(cur); const char* cB = g.b_ptr(cur);
    S.a_ready(cur);
    if constexpr (SP2) {
        PG8_STAGE(PG8_SB(0, 0), cB, voffB); PG8_STAGE(PG8_SB(0, 1), cB + hstepB, voffB); PG8_STAGE(PG8_SA(0, 0), cA, voffA); PG8_STAGE(PG8_SA(0, 1), cA + hstepA, voffA);
        if (wr == 1) PG8_BAR;
        PG8_WAIT_V(2); PG8_BAR;
        PG8_STAGE(PG8_SB(1, 0), cB + kstep, voffB); PG8_STAGE(PG8_SA(1, 0), cA + kstep, voffA); PG8_STAGE(PG8_SB(1, 1), cB + hstepB + kstep, voffB);
        PG8_WAIT_V(6); PG8_BAR;
    } else {
        PG8_STAGE(PG8_SB(0, 0), cB, voffB); PG8_STAGE(PG8_SA(0, 0), cA, voffA); PG8_STAGE(PG8_SB(0, 1), cB + hstepB, voffB); PG8_STAGE(PG8_SA(0, 1), cA + hstepA, voffA);
        if (wr == 1) PG8_BAR;
        PG8_WAIT_V(4); PG8_BAR;
        PG8_STAGE(PG8_SB(1, 0), cB + kstep, voffB); PG8_STAGE(PG8_SA(1, 0), cA + kstep, voffA); PG8_STAGE(PG8_SB(1, 1), cB + hstepB + kstep, voffB);
        PG8_WAIT_V(6); PG8_BAR;
    }
    for (;;) {
        const bool has_next = S.next(ui + 1, nxt);
        const char* nA = has_next ? g.a_ptr(nxt) : cA; const char* nB = has_next ? g.b_ptr(nxt) : cB;
        for (int t = 0; t < nt; t += 2) {
            const bool last = (t == nt - 2);
            const char* a1 = cA + (size_t)(t + 1) * kstep;
            const char* a2 = last ? nA : cA + (size_t)(t + 2) * kstep; const char* b2 = last ? nB : cB + (size_t)(t + 2) * kstep;
            const char* a3 = a2 + kstep; const char* b3 = b2 + kstep;
            if (last && has_next) S.a_ready(nxt);
            if constexpr (SP2) {
            PG8_LDB(B0, 0, 0); PG8_LDB(B1, 0, 1); PG8_SCHED; PG8_LDA(At, 0, 0); PG8_STAGE(PG8_SA(1, 1), a1 + hstepA, voffA);
            PG8_WAIT_V(8); PG8_WAIT_L(0); PG8_BAR; PG8_MMA(0, 0, At, B0); PG8_MMA(0, 1, At, B1); PG8_BAR; PG8_SCHED;
            PG8_LDA(At, 0, 1); PG8_STAGE(PG8_SB(0, 0), b2, voffB); PG8_STAGE(PG8_SB(0, 1), b2 + hstepB, voffB); PG8_STAGE(PG8_SA(0, 0), a2, voffA);
            PG8_WAIT_V(8); PG8_WAIT_L(0); PG8_BAR; PG8_MMA(1, 0, At, B0); PG8_MMA(1, 1, At, B1); PG8_BAR; PG8_SCHED;
            PG8_LDB(B0, 1, 0); PG8_LDB(B1, 1, 1); PG8_SCHED; PG8_LDA(At, 1, 0); PG8_STAGE(PG8_SA(0, 1), a2 + hstepA, voffA);
            PG8_WAIT_V(8); PG8_WAIT_L(0); PG8_BAR; PG8_MMA(0, 0, At, B0); PG8_MMA(0, 1, At, B1); PG8_BAR; PG8_SCHED;
            PG8_LDA(At, 1, 1); PG8_STAGE(PG8_SB(1, 0), b3, voffB); PG8_STAGE(PG8_SB(1, 1), b3 + hstepB, voffB); PG8_STAGE(PG8_SA(1, 0), a3, voffA);
            PG8_WAIT_V(8); PG8_WAIT_L(0); PG8_BAR; PG8_MMA(1, 0, At, B0); PG8_MMA(1, 1, At, B1); PG8_BAR; PG8_SCHED;
            } else {
            PG8_LDB(B0, 0, 0); PG8_SCHED; PG8_LDA(At, 0, 0); PG8_STAGE(PG8_SA(1, 1), a1 + hstepA, voffA);
            PG8_WAIT_L(8); PG8_BAR; PG8_WAIT_L(0); PG8_MMA(0, 0, At, B0); PG8_BAR; PG8_SCHED;
            PG8_LDB(B1, 0, 1); PG8_STAGE(PG8_SB(0, 0), b2, voffB);
            PG8_BAR; PG8_WAIT_L(0); PG8_MMA(0, 1, At, B1); PG8_BAR;
            PG8_LDA(At, 0, 1); PG8_STAGE(PG8_SA(0, 0), a2, voffA);
            PG8_BAR; PG8_WAIT_L(0); PG8_MMA(1, 0, At, B0); PG8_BAR; PG8_SCHED;
            PG8_STAGE(PG8_SB(0, 1), b2 + hstepB, voffB);
            PG8_WAIT_V(6); PG8_BAR; PG8_MMA(1, 1, At, B1); PG8_BAR;
            PG8_LDB(B0, 1, 0); PG8_SCHED; PG8_LDA(At, 1, 0); PG8_STAGE(PG8_SA(0, 1), a2 + hstepA, voffA);
            PG8_WAIT_L(8); PG8_BAR; PG8_WAIT_L(0); PG8_MMA(0, 0, At, B0); PG8_BAR; PG8_SCHED;
            PG8_LDB(B1, 1, 1); PG8_STAGE(PG8_SB(1, 0), b3, voffB);
            PG8_BAR; PG8_WAIT_L(0); PG8_MMA(0, 1, At, B1); PG8_BAR;
            PG8_LDA(At, 1, 1); PG8_STAGE(PG8_SA(1, 0), a3, voffA);
            PG8_BAR; PG8_WAIT_L(0); PG8_MMA(1, 0, At, B0); PG8_BAR; PG8_SCHED;
            PG8_STAGE(PG8_SB(1, 1), b3 + hstepB, voffB);
            PG8_WAIT_V(6); PG8_BAR; PG8_MMA(1, 1, At, B1); PG8_BAR;
            }
        }
        if constexpr (ALIGN_EPI) { if (wr == 0) PG8_BAR; }
        if constexpr (Epi::WANT_INDEX) cur.part = ui;
        if constexpr (!Epi::AFTER_DRAIN) { E(acc, cur, wr, wc, fr, fq); S.done(cur); }
        if (!has_next) break;
        if (!(Epi::KEEP_ACC && cur.part == 0)) {
#pragma unroll
        for (int a = 0; a < 2; ++a)
#pragma unroll
            for (int b = 0; b < 2; ++b)
#pragma unroll
                for (int m = 0; m < 4; ++m)
#pragma unroll
                    for (int n = 0; n < 2; ++n) acc[a][b][m][n] = (f32x4){0.f, 0.f, 0.f, 0.f};
        }
        cur = nxt; cA = nA; cB = nB; ++ui;
        if constexpr (ALIGN_EPI) { if (wr == 1) PG8_BAR; }
    }
    PG8_WAIT_V(0);
    if constexpr (!ALIGN_EPI) { if (wr == 0) PG8_BAR; }
    PG8_BAR;
    if constexpr (Epi::AFTER_DRAIN) { E.fused(acc, cur, wr, wc, fr, fq, lds, wid, lane); S.done(cur); }
#undef PG8_SA
#undef PG8_SB
#undef PG8_STAGE
#undef PG8_LDA
#undef PG8_LDB
#undef PG8_MMA
#undef PG8_WAIT_V
#undef PG8_WAIT_L
#undef PG8_BAR
#undef PG8_SCHED
}
}

constexpr size_t MiB = 1u << 20;
constexpr size_t WS_CTL = 0, CTL_ZERO_BYTES = 32 * 1024;
constexpr size_t WS_KSUM = 256 * 1024;
constexpr size_t WS_MODP = 1 * MiB;
constexpr size_t WS_MODF = WS_MODP + 8 * 8 * 6144 * 4;
constexpr size_t WS_BIAS1P = 3 * MiB;
constexpr size_t WS_BIAS2P = 4 * MiB;
constexpr size_t WS_BPRIME = 4 * MiB + 512 * 1024;
constexpr size_t WS_RSTD1 = 5 * MiB;
constexpr size_t WS_SS2 = 6 * MiB;
constexpr size_t WS_SUBK = 8 * MiB;
constexpr size_t WS_WIN = 16 * MiB, WS_WA = 24 * MiB, WS_WP = 25 * MiB, WS_WOUT = 26 * MiB, WS_WQ = 28 * MiB;
constexpr size_t WS_U = 32 * MiB, WS_V = 64 * MiB;
constexpr size_t WS_XG = 96 * MiB;
constexpr size_t WS_H2Q = WS_XG, WS_HS = WS_XG + 32 * MiB;
constexpr size_t WS_QKVP = 160 * MiB;
constexpr size_t WS_GAB = 288 * MiB;
constexpr size_t WS_POOLED = 416 * MiB;
constexpr size_t WS_END = 448 * MiB;
constexpr int CW_TMO = 0, CW_BAR = 4096;
constexpr int CW_NRM = 2048;

constexpr int RING_OFF = 0, RING_BYTES = 131072;
constexpr int LDS_BYTES = 147456;
constexpr int BTAB_OFF = 131072, RTAB_OFF = 139264;
constexpr int LDSCTL_OFF = LDS_BYTES - 512, MISC_OFF = LDSCTL_OFF + 320;

#define GAS __attribute__((address_space(1)))
#define LAS __attribute__((address_space(3)))
typedef unsigned short bf16;
typedef unsigned v4u __attribute__((ext_vector_type(4)));
typedef unsigned v2u __attribute__((ext_vector_type(2)));
typedef float f32x4 __attribute__((ext_vector_type(4)));
typedef GAS unsigned gu32;
#define RLX_AGENT __ATOMIC_RELAXED, __HIP_MEMORY_SCOPE_AGENT
#define LDS_WAIT() asm volatile("s_waitcnt lgkmcnt(0)" ::: "memory")
#define VM_WAIT() asm volatile("s_waitcnt vmcnt(0)" ::: "memory")
__device__ __forceinline__ unsigned f2bf(float f) { unsigned u = __builtin_bit_cast(unsigned, f); return (u + 0x7fffu + ((u >> 16) & 1u)) >> 16; }
__device__ __forceinline__ unsigned pk2(float lo, float hi) { return f2bf(lo) | (f2bf(hi) << 16); }
__device__ __forceinline__ float bflo(unsigned w) { return __uint_as_float(w << 16); }
__device__ __forceinline__ float bfhi(unsigned w) { return __uint_as_float(w & 0xffff0000u); }
__device__ __forceinline__ float wave_sum(float v) {
#pragma unroll
    for (int o = 1; o < 64; o <<= 1) v += __shfl_xor(v, o);
    return v;
}
__device__ __forceinline__ float wave_max(float v) {
#pragma unroll
    for (int o = 1; o < 64; o <<= 1) v = fmaxf(v, __shfl_xor(v, o));
    return v;
}

#define XB_TMO      128
#define XB_XCNT(j)  (256  + 64 * (j))
#define XB_XSUB(j)  (1280 + 64 * (j))
#define XB_XGEN(j)  (2304 + 64 * (j))
#define XB_TOP      3328
#define XB_TOPGEN   3392
#define XCD_BAR_WORDS 3456
#define XB_SPIN_CAP (1u << 22)

__device__ __forceinline__ unsigned xb_ld(unsigned* p)              { return __hip_atomic_load(p, __ATOMIC_RELAXED, __HIP_MEMORY_SCOPE_AGENT); }
__device__ __forceinline__ unsigned xb_add(unsigned* p, unsigned v) { return __hip_atomic_fetch_add(p, v, __ATOMIC_RELAXED, __HIP_MEMORY_SCOPE_AGENT); }
__device__ __forceinline__ unsigned xb_xcc_id() { return (unsigned)__builtin_amdgcn_s_getreg((3 << 11) | 20) & 0xFu; }
#define XB_SPIN(cond, bar) do { unsigned _sp = 0; while (cond) { __builtin_amdgcn_s_sleep(1); \
    if ((++_sp & 255u) == 0u) { if (xb_ld(&(bar)[XB_TMO])) break; if (_sp > XB_SPIN_CAP) { atomicAdd(&(bar)[XB_TMO], 1u); break; } } } } while (0)

struct XcdBarrier { unsigned* bar; unsigned x; volatile LAS unsigned* st; };

__device__ __forceinline__ XcdBarrier xcd_barrier_post(unsigned* bar, volatile LAS unsigned* st) {
    XcdBarrier b; b.bar = bar; b.x = xb_xcc_id(); b.st = st;
    if (threadIdx.x == 0) (void)xb_add(&bar[XB_XCNT(b.x)], 1u);
    return b;
}
__device__ __forceinline__ void xcd_barrier_complete(unsigned* bar, unsigned x, unsigned& nloc, unsigned& nx) {
    const unsigned G = gridDim.x * gridDim.y * gridDim.z;
    unsigned sum, cnt, mine, sp = 0u;
    for (;;) {
        sum = 0u; cnt = 0u; mine = 0u;
#pragma unroll
        for (unsigned j = 0; j < 16; ++j) { const unsigned c = xb_ld(&bar[XB_XCNT(j)]); sum += c; cnt += (c > 0u) ? 1u : 0u; mine = (j == x) ? c : mine; }
        if (sum == G) break;
        __builtin_amdgcn_s_sleep(1);
        if ((++sp & 255u) == 0u) { if (xb_ld(&bar[XB_TMO])) break; if (sp > XB_SPIN_CAP) { atomicAdd(&bar[XB_TMO], 1u); break; } }
    }
    nloc = mine > 0u ? mine : 1u; nx = cnt > 0u ? cnt : 1u;
}
__device__ __forceinline__ void xcd_barrier(const XcdBarrier& b) {
    asm volatile("s_waitcnt vmcnt(0)" ::: "memory");
    __syncthreads();
    if (threadIdx.x == 0) {
        unsigned* bar = b.bar;
        __builtin_amdgcn_s_waitcnt(0);
        unsigned nloc = b.st[0], nx = b.st[1];
        if (nloc == 0u) { xcd_barrier_complete(bar, b.x, nloc, nx); b.st[0] = nloc; b.st[1] = nx; }
        const unsigned old = xb_add(&bar[XB_XSUB(b.x)], 1u);
        const unsigned gen = old / nloc;
        if (old + 1u == (gen + 1u) * nloc) {
            __builtin_amdgcn_fence(__ATOMIC_RELEASE, "agent");
            asm volatile("s_waitcnt vmcnt(0)" ::: "memory");
            const unsigned og = xb_add(&bar[XB_TOP], 1u);
            const unsigned tg = og / nx;
            if (og + 1u == (tg + 1u) * nx) xb_add(&bar[XB_TOPGEN], 1u);
            else XB_SPIN(xb_ld(&bar[XB_TOPGEN]) == tg, bar);
            __builtin_amdgcn_fence(__ATOMIC_ACQUIRE, "agent");
            xb_add(&bar[XB_XGEN(b.x)], 1u);
            asm volatile("s_waitcnt vmcnt(0)" ::: "memory");
        } else {
            XB_SPIN(xb_ld(&bar[XB_XGEN(b.x)]) == gen, bar);
            __builtin_amdgcn_fence(__ATOMIC_ACQUIRE, "agent");
            asm volatile("s_waitcnt vmcnt(0)" ::: "memory");
        }
    }
    __syncthreads();
}

struct Frame {
    LAS unsigned char* lds;
    volatile LAS unsigned* MISC;
    gu32* ctl;
    int tid, lane, wave;
    int vcu, G;
};
struct Args { const float* in[18]; float* out; unsigned char* ws; };

__device__ __forceinline__ float modp_sum(const float* modp, int idx) {
    float s = 0.f;
#pragma unroll
    for (int kc = 0; kc < 8; ++kc) s += modp[(size_t)kc * 8 * 6144 + idx];
    return s;
}
template <int MODE>
__device__ __forceinline__ void p0_wg_dot(Frame& F, const float* cin, const float* modp, int soff, const float* W, int N, const float* addv, float* outp, int first, int ntask) {
    LAS float* scr = (LAS float*)(F.lds + RING_OFF + F.wave * 16384);
    const int ncn = N / 64;
    for (int it = first; it < ntask; it += F.G) {
        const int kc = it / ncn, nc = it % ncn, k0 = kc * 128 + F.wave * 16, n = nc * 64 + F.lane;
        float w[16];
#pragma unroll
        for (int kk = 0; kk < 16; ++kk) w[kk] = (MODE == 0) ? __builtin_nontemporal_load(W + (size_t)(k0 + kk) * N + n) : W[(size_t)(k0 + kk) * N + n];
#pragma unroll
        for (int j = 0; j < 2; ++j) { const int idx = F.lane + 64 * j, b = idx >> 4, kk = idx & 15;
            float cf; if (MODE == 0) { const float cv = cin[b * 1024 + k0 + kk]; cf = cv / (1.0f + __expf(-cv)); } else cf = modp_sum(modp, b * 6144 + soff + k0 + kk);
            scr[idx] = cf; }
        LDS_WAIT(); asm volatile("" ::: "memory");
#pragma unroll
        for (int b = 0; b < 8; ++b) { float s = 0.f;
#pragma unroll
            for (int kk = 0; kk < 16; ++kk) s += scr[b * 16 + kk] * w[kk];
            scr[256 + b * 64 + F.lane] = s; }
        __syncthreads();
        { const int b = F.wave; float s = (addv != nullptr && kc == 0) ? addv[n] : 0.f;
#pragma unroll
          for (int w8 = 0; w8 < 8; ++w8) s += ((LAS float*)(F.lds + RING_OFF + w8 * 16384))[256 + b * 64 + F.lane];
          outp[(size_t)(kc * 8 + b) * N + n] = s; }
        __syncthreads();
    }
}
__device__ __forceinline__ void p0a_mod(Frame& F, const Args& A) { p0_wg_dot<0>(F, A.in[1], nullptr, 0, A.in[2], 6144, A.in[3], (float*)(A.ws + WS_MODP), F.vcu, 8 * 96); }
__device__ __forceinline__ void p0_wp_task(Frame& F, const Args& A, int r) {
    LAS float* scr = (LAS float*)(F.lds + RING_OFF + F.wave * 16384);
    const int g = r >> 6, kq = (r >> 4) & 3, nc = r & 15, n = nc * 64 + F.lane, d0 = 16 * F.wave;
    const float* wmix = A.in[7] + (size_t)(g * 128 + 32 * kq) * 128 + d0; const float* scale = A.in[9] + g * 128 + d0; const float* wup = A.in[10] + (size_t)(g * 128 + d0) * D + n; const float* bmix = A.in[8] + g * 128 + d0;
    float wu[16];
#pragma unroll
    for (int d = 0; d < 16; ++d) wu[d] = wup[(size_t)d * D];
    float bp = 0.f;
#pragma unroll
    for (int d = 0; d < 16; ++d) { wu[d] *= scale[d]; bp += bmix[d] * wu[d]; }
#pragma unroll
    for (int kk = 0; kk < 32; ++kk) { float s = 0.f;
#pragma unroll
        for (int d = 0; d < 16; ++d) s += wmix[kk * 128 + d] * wu[d];
        scr[kk * 64 + F.lane] = s; }
    scr[2048 + F.lane] = bp;
    __syncthreads();
    { float s[4]; float bs = 0.f;
#pragma unroll
      for (int e = 0; e < 4; ++e) s[e] = 0.f;
#pragma unroll
      for (int w8 = 0; w8 < 8; ++w8) { const LAS float* o = (const LAS float*)(F.lds + RING_OFF + w8 * 16384);
#pragma unroll
          for (int e = 0; e < 4; ++e) s[e] += o[(4 * F.wave + e) * 64 + F.lane];
          bs += o[2048 + F.lane]; }
      v2u w; w.x = pk2(s[0], s[1]); w.y = pk2(s[2], s[3]);
      *(GAS v2u*)((bf16*)(A.ws + WS_WP) + (size_t)n * PW + g * 128 + 32 * kq + 4 * F.wave) = w;
      if (kq == 0 && F.wave == 0) ((float*)(A.ws + WS_BPRIME))[g * 1024 + n] = bs; }
    __syncthreads();
}

__device__ __forceinline__ void p0_transpose_item(const float* W, int K, int N, bf16* WT, int row_off, LAS float* scr, int item, int lane) {
    const int nblk = N / 32, kb = item / nblk, nb = item % nblk, k0 = 64 * kb, n0 = 32 * nb;
#pragma unroll 8
    for (int i = 0; i < 32; ++i) { const int kk = 2 * i + (lane >> 5); scr[kk * 33 + (lane & 31)] = __builtin_nontemporal_load(W + (size_t)(k0 + kk) * N + n0 + (lane & 31)); }
    LDS_WAIT(); asm volatile("" ::: "memory");
    const int c = lane & 7;
#pragma unroll
    for (int j = 0; j < 4; ++j) { const int n = (lane >> 3) + 8 * j; const LAS float* s = scr + (8 * c) * 33 + n;
        v4u o; o.x = pk2(s[0 * 33], s[1 * 33]); o.y = pk2(s[2 * 33], s[3 * 33]); o.z = pk2(s[4 * 33], s[5 * 33]); o.w = pk2(s[6 * 33], s[7 * 33]);
        *(GAS v4u*)(WT + (size_t)(row_off + n0 + n) * K + k0 + 8 * c) = o; }
    LDS_WAIT(); asm volatile("" ::: "memory");
}
__device__ __forceinline__ void p0_table_rows4(const float* const (&src)[4], unsigned char* const (&dst)[4], float* const (&scale_out)[4], int off, int lane) {
    f32x4 v[4][4]; float am[4];
#pragma unroll
    for (int u = 0; u < 4; ++u)
#pragma unroll
        for (int q = 0; q < 4; ++q) v[u][q] = __builtin_nontemporal_load((const f32x4*)(src[u] + 16 * lane + 4 * q));
#pragma unroll
    for (int u = 0; u < 4; ++u) { float a = 0.f;
#pragma unroll
        for (int q = 0; q < 4; ++q) a = fmaxf(fmaxf(a, fmaxf(fabsf(v[u][q][0]), fabsf(v[u][q][1]))), fmaxf(fabsf(v[u][q][2]), fabsf(v[u][q][3])));
        am[u] = a; }
#pragma unroll
    for (int o = 1; o < 64; o <<= 1) {
#pragma unroll
        for (int u = 0; u < 4; ++u) am[u] = fmaxf(am[u], __shfl_xor(am[u], o)); }
#pragma unroll
    for (int u = 0; u < 4; ++u) { const float sc = (am[u] > 0.f) ? am[u] * (1.0f / 127.0f) : 1.0f, inv = 1.0f / sc;
        v4u o;
#pragma unroll
        for (int q = 0; q < 4; ++q) { const int q0 = (int)rintf(v[u][q][0] * inv) + off, q1 = (int)rintf(v[u][q][1] * inv) + off, q2 = (int)rintf(v[u][q][2] * inv) + off, q3 = (int)rintf(v[u][q][3] * inv) + off;
            o[q] = (unsigned)(q0 & 255) | ((unsigned)(q1 & 255) << 8) | ((unsigned)(q2 & 255) << 16) | ((unsigned)q3 << 24); }
        *(GAS v4u*)(dst[u] + ((size_t)(lane >> 3) << 21) + 16 * (lane & 7)) = o;
        if (lane == 0) *scale_out[u] = sc; }
}
__device__ __forceinline__ void p0_table_trip(const Args& A, int r0, int NGW, int lane) {
    const float* src[4]; unsigned char* dst[4]; float* sco[4];
#pragma unroll
    for (int u = 0; u < 4; ++u) { int r = r0 + u * NGW; if (r >= 2 * PEXP) r = r0; const int tb = r / PEXP, e = r % PEXP;
        src[u] = (tb ? A.in[16] : A.in[15]) + (size_t)e * D; dst[u] = A.ws + (tb ? WS_V : WS_U) + (size_t)e * 128; sco[u] = (float*)(A.ws + WS_U + 16 * MiB) + 2 * e + tb; }
    const int tb0 = r0 / PEXP;
    if ((r0 + 3 * NGW) / PEXP == tb0 && r0 + 3 * NGW < 2 * PEXP) p0_table_rows4(src, dst, sco, 0, lane);
    else { for (int u = 0; u < 4; ++u) { const int r = r0 + u * NGW; if (r < 2 * PEXP) { const float* s1[4] = {src[u], src[u], src[u], src[u]}; unsigned char* d1[4] = {dst[u], dst[u], dst[u], dst[u]}; float* c1[4] = {sco[u], sco[u], sco[u], sco[u]}; p0_table_rows4(s1, d1, c1, 0, lane); } } }
}
template <int STAGE>
__device__ __forceinline__ void p0b_prologue(Frame& F, const Args& A) {
    const int gw = F.vcu * NWAVES + F.wave, NGW = F.G * NWAVES, lane = F.lane;
    const float* modp = (const float*)(A.ws + WS_MODP);
    LAS float* G1 = (LAS float*)(F.lds + 135168);
    if (STAGE == 0) { float* ks = (float*)(A.ws + WS_KSUM); for (int i = F.vcu * NTHREADS + F.tid; i < NB * NBLK * 512; i += F.G * NTHREADS) ks[i] = 0.f; }
    if (STAGE == 0) { for (int r = F.vcu; r < 256; r += F.G) p0_wp_task(F, A, r); }
    else { p0_wg_dot<1>(F, nullptr, modp, 0, A.in[5], INW, nullptr, (float*)(A.ws + WS_BIAS1P), F.vcu, 8 * (INW / 64));
           p0_wg_dot<1>(F, nullptr, modp, 3072, A.in[13], PQW, nullptr, (float*)(A.ws + WS_BIAS2P), F.vcu, 8 * (PQW / 64)); }
    LAS float* scr = (LAS float*)(F.lds + RING_OFF + F.wave * 16384);
    constexpr int I_MODF = 768, I_WIN = (D / 64) * (INW / 32), I_WA = (AW / 64) * (D / 32), I_WOUT = (D / 64) * (D / 32), I_WQ = (D / 64) * (PQW / 32);
    constexpr int I_SUBK = 64;
    constexpr int NITEMS = I_MODF + I_WIN + I_WA + I_WOUT + I_WQ + I_SUBK;
    for (int it = gw; it < NITEMS; it += NGW) {
        int r = it;
        if (r < I_MODF) { if (STAGE != 1) continue; const int idx = r * 64 + lane; ((float*)(A.ws + WS_MODF))[idx] = modp_sum(modp, idx); continue; } r -= I_MODF;
        if (r < I_WIN) { if (STAGE != 0) continue; p0_transpose_item(A.in[5], D, INW, (bf16*)(A.ws + WS_WIN), 0, scr, r, lane); continue; } r -= I_WIN;
        if (r < I_WA) { if (STAGE != 0) continue; p0_transpose_item(A.in[6], AW, D, (bf16*)(A.ws + WS_WA), 0, scr, r, lane); continue; } r -= I_WA;
        if (r < I_WOUT) { if (STAGE != 0) continue; p0_transpose_item(A.in[11], D, D, (bf16*)(A.ws + WS_WOUT), 0, scr, r, lane); continue; } r -= I_WOUT;
        if (r < I_WQ) { if (STAGE != 0) continue; p0_transpose_item(A.in[13], D, PQW, (bf16*)(A.ws + WS_WQ), 0, scr, r, lane); continue; } r -= I_WQ;
        if (r < I_SUBK) { if (STAGE != 0) continue; const float* s = A.in[14] + (size_t)r * 512 + 8 * lane; const f32x4 a = *(const f32x4*)s, b = *(const f32x4*)(s + 4);
            v4u o; o.x = pk2(a[0], a[1]); o.y = pk2(a[2], a[3]); o.z = pk2(b[0], b[1]); o.w = pk2(b[2], b[3]);
            *(GAS v4u*)((bf16*)(A.ws + WS_SUBK) + (size_t)r * 512 + 8 * lane) = o; continue; } r -= I_SUBK;
    }
    auto xg_rows = [&](const int rb) {
        const float* x = A.in[0]; bf16* XG = (bf16*)(A.ws + WS_XG); float* rstd1 = (float*)(A.ws + WS_RSTD1);
            for (int r0 = F.wave; r0 < 128; r0 += 4 * NWAVES) {
                f32x4 v[4][2][2]; float s[4];
#pragma unroll
                for (int u = 0; u < 4; ++u) { const float* xr = x + (size_t)(rb * 128 + r0 + u * NWAVES) * 1024;
#pragma unroll
                    for (int h = 0; h < 2; ++h)
#pragma unroll
                        for (int q = 0; q < 2; ++q) v[u][h][q] = __builtin_nontemporal_load((const f32x4*)(xr + h * 512 + 8 * lane + 4 * q)); }
#pragma unroll
                for (int u = 0; u < 4; ++u) { float t = 0.f;
#pragma unroll
                    for (int h = 0; h < 2; ++h)
#pragma unroll
                        for (int q = 0; q < 2; ++q) t += (v[u][h][q][0] * v[u][h][q][0] + v[u][h][q][1] * v[u][h][q][1]) + (v[u][h][q][2] * v[u][h][q][2] + v[u][h][q][3] * v[u][h][q][3]);
                    s[u] = t; }
#pragma unroll
                for (int o = 1; o < 64; o <<= 1) {
#pragma unroll
                    for (int u = 0; u < 4; ++u) s[u] += __shfl_xor(s[u], o); }
#pragma unroll
                for (int u = 0; u < 4; ++u) { const int row = rb * 128 + r0 + u * NWAVES;
                    if (lane == 0) rstd1[row] = 1.0f / sqrtf(s[u] * (1.0f / D) + RMS_EPS);
#pragma unroll
                    for (int h = 0; h < 2; ++h) { const LAS float* g = G1 + h * 512 + 8 * lane;
                        v4u o; o.x = pk2(v[u][h][0][0] * g[0], v[u][h][0][1] * g[1]); o.y = pk2(v[u][h][0][2] * g[2], v[u][h][0][3] * g[3]); o.z = pk2(v[u][h][1][0] * g[4], v[u][h][1][1] * g[5]); o.w = pk2(v[u][h][1][2] * g[6], v[u][h][1][3] * g[7]);
                        *(GAS v4u*)(XG + (size_t)row * 1024 + h * 512 + 8 * lane) = o; } }
            }
    };
#ifndef TABLES_IN_ROUTER
    if (STAGE == 0) { for (int r0 = gw; r0 < 2 * PEXP; r0 += 4 * NGW) p0_table_trip(A, r0, NGW, lane); }
    else
#else
    if (STAGE == 1)
#endif
    for (int rb = F.vcu; rb < T / 128; rb += F.G) {
        const float* g1 = A.in[4]; const int b = (rb * 128) / SEQ;
        __syncthreads();
        for (int k = F.tid; k < 1024; k += NTHREADS) G1[k] = g1[k] * (1.0f + modp_sum(modp, b * 6144 + 1024 + k));
        __syncthreads();
        xg_rows(rb);
    }

}
namespace attn_body {
using bf16=__hip_bfloat16;
using bf16x8=__attribute__((ext_vector_type(8)))short;
using s16x4=__attribute__((ext_vector_type(4)))short;
using f32x16=__attribute__((ext_vector_type(16)))float;
using u32x4=__attribute__((ext_vector_type(4)))unsigned;
constexpr int BATCH=8,NHEAD=8,SEQ=4096,D=64,DM=NHEAD*D;
constexpr int NW=8,QBLK=32,QB=QBLK*NW,KVBLK=64,NQB=SEQ/QB;
constexpr int ATTN_PITCH=DM, ATTN_UNIT_ROWS=QB;
__device__ __forceinline__ int crow(int r,int hi){return (r&3)+8*(r>>2)+4*hi;}
#define SBAR() __builtin_amdgcn_sched_barrier(0)
__device__ __forceinline__ void cmask(f32x16&p0,f32x16&p1,int jb,int qrel,int hi){
  const float NEG=-INFINITY; int kb=64*jb+4*hi;
  #pragma unroll
  for(int r=0;r<16;++r){int kv=kb+(r&3)+8*(r>>2); if(kv>qrel)p0[r]=NEG; if(kv+32>qrel)p1[r]=NEG;}
}

constexpr int NSLOT=3, SLOTB=8192;
constexpr int LDS_K=0, LDS_V=NSLOT*SLOTB, LDS_WS=2*NSLOT*SLOTB, LDS_OST=LDS_WS+NW*64*4, LDS_KSL=LDS_OST+NW*4096, LDS_BYTES=LDS_KSL+4096;
constexpr float C2=0.125f*1.4426950408889634f;
__device__ __forceinline__ void glds16(const void*sbase,unsigned voff,unsigned lds_dst){unsigned keep;
  asm volatile("s_mov_b32 %0, m0\n\ts_mov_b32 m0, %3\n\ts_nop 4\n\tglobal_load_lds_dwordx4 %1, %2\n\ts_mov_b32 m0, %0":"=&s"(keep):"v"(voff),"s"(sbase),"s"(lds_dst):"memory");}
__device__ __forceinline__ float max3f(float a,float b,float c){float r;asm("v_max3_f32 %0, %1, %2, %3":"=v"(r):"v"(a),"v"(b),"v"(c));return r;}
__device__ __forceinline__ float max2f(float a,float b){float r;asm("v_max_f32_e32 %0, %1, %2":"=v"(r):"v"(a),"v"(b));return r;}
__device__ __forceinline__ float fadd_s(float a,float b){float r;asm("v_add_f32_e32 %0, %1, %2":"=v"(r):"v"(a),"v"(b));return r;}
__device__ __forceinline__ float fsub_s(float a,float b){float r;asm("v_sub_f32_e32 %0, %1, %2":"=v"(r):"v"(a),"v"(b));return r;}
typedef float f32x2_t __attribute__((ext_vector_type(2))); typedef __bf16 bf16x2_t __attribute__((ext_vector_type(2)));
__device__ __forceinline__ unsigned cvtpk_s(float lo,float hi){f32x2_t v={lo,hi};bf16x2_t b=__builtin_convertvector(v,bf16x2_t);return __builtin_bit_cast(unsigned,b);}
#define WAIT_BAR(N) asm volatile("s_waitcnt vmcnt(" #N ") lgkmcnt(0)\n\ts_barrier":::"memory")

__device__ __forceinline__ void qkt(f32x16&p0,f32x16&p1,const char*Kslot,const bf16x8*qr,const f32x16&negm,int r32,int hi){
  const char*kb=Kslot+hi*1024+r32*16;
  #pragma unroll
  for(int d0=0;d0<4;++d0){
    const bf16x8 b0=*reinterpret_cast<const bf16x8*>(kb+d0*2048);
    const bf16x8 b1=*reinterpret_cast<const bf16x8*>(kb+d0*2048+512);
    if(d0==0){p0=__builtin_amdgcn_mfma_f32_32x32x16_bf16(b0,qr[0],negm,0,0,0);p1=__builtin_amdgcn_mfma_f32_32x32x16_bf16(b1,qr[0],negm,0,0,0);}
    else{p0=__builtin_amdgcn_mfma_f32_32x32x16_bf16(b0,qr[d0],p0,0,0,0);p1=__builtin_amdgcn_mfma_f32_32x32x16_bf16(b1,qr[d0],p1,0,0,0);}}
}
typedef __attribute__((address_space(3))) const char* lds_cptr;
typedef short v4i16_t __attribute__((ext_vector_type(4)));
__device__ __forceinline__ void kload8(bf16x8*kf,lds_cptr kp){
  kf[0]=*(const __attribute__((address_space(3))) bf16x8*)(kp);      kf[1]=*(const __attribute__((address_space(3))) bf16x8*)(kp+512);
  kf[2]=*(const __attribute__((address_space(3))) bf16x8*)(kp+2048); kf[3]=*(const __attribute__((address_space(3))) bf16x8*)(kp+2560);
  kf[4]=*(const __attribute__((address_space(3))) bf16x8*)(kp+4096); kf[5]=*(const __attribute__((address_space(3))) bf16x8*)(kp+4608);
  kf[6]=*(const __attribute__((address_space(3))) bf16x8*)(kp+6144); kf[7]=*(const __attribute__((address_space(3))) bf16x8*)(kp+6656);
}
__device__ __forceinline__ void kload2(bf16x8*kf,lds_cptr kp,int j){ kf[2*j]=*(const __attribute__((address_space(3))) bf16x8*)(kp+j*2048); kf[2*j+1]=*(const __attribute__((address_space(3))) bf16x8*)(kp+j*2048+512); }
__device__ __forceinline__ s16x4 vtr(lds_cptr p){ return __builtin_bit_cast(s16x4,__builtin_amdgcn_ds_read_tr16_b64_v4i16((__attribute__((address_space(3))) v4i16_t*)p)); }
__device__ __forceinline__ float rowmax(const f32x16&p0,const f32x16&p1){
  float a=max3f(p0[0],p0[1],p1[0]),b=max3f(p0[2],p0[3],p1[1]);a=max3f(a,p1[2],p1[3]);
  #pragma unroll
  for(int r=4;r<16;r+=4){a=max3f(a,p0[r],p0[r+1]);b=max3f(b,p0[r+2],p0[r+3]);a=max3f(a,p1[r],p1[r+1]);b=max3f(b,p1[r+2],p1[r+3]);}
  const float m=max2f(a,b);
  auto rr=__builtin_amdgcn_permlane32_swap(__float_as_uint(m),__float_as_uint(m),false,false);
  return max2f(__uint_as_float(rr[0]),__uint_as_float(rr[1]));
}
__device__ __forceinline__ void pv(f32x16*o,int vb,bf16x8 pa0,bf16x8 pa1,bf16x8 pa2,bf16x8 pa3){
  #pragma unroll
  for(int d0=0;d0<2;++d0){s16x4 lo[4],hi[4];
    #pragma unroll
    for(int ks=0;ks<4;++ks){
      asm volatile("ds_read_b64_tr_b16 %0,%1 offset:%c2":"=&v"(lo[ks]):"v"(vb),"i"(d0*4096+ks*1024):"memory");
      asm volatile("ds_read_b64_tr_b16 %0,%1 offset:%c2":"=&v"(hi[ks]):"v"(vb),"i"(d0*4096+ks*1024+512):"memory");}
    asm volatile("s_waitcnt lgkmcnt(0)":::"memory");SBAR();
    #define PK(k) (bf16x8){lo[k][0],lo[k][1],lo[k][2],lo[k][3],hi[k][0],hi[k][1],hi[k][2],hi[k][3]}
    o[d0]=__builtin_amdgcn_mfma_f32_32x32x16_bf16(pa0,PK(0),o[d0],0,0,0);
    o[d0]=__builtin_amdgcn_mfma_f32_32x32x16_bf16(pa1,PK(1),o[d0],0,0,0);
    o[d0]=__builtin_amdgcn_mfma_f32_32x32x16_bf16(pa2,PK(2),o[d0],0,0,0);
    o[d0]=__builtin_amdgcn_mfma_f32_32x32x16_bf16(pa3,PK(3),o[d0],0,0,0);
    #undef PK
  }
}

#ifndef ATTN_STORE16
#define ATTN_STORE16(p,v) (*(u32x4*)(p)=(v))
#endif
template<int THRL> __device__ __forceinline__ void attn_unit(int b,int h,int qb,const bf16*Q,const bf16*__restrict__ K,const bf16*__restrict__ V,bf16*O,const float*ksum,const float*nrm,char*shm){
  int tid_=threadIdx.x; asm volatile("":"+v"(tid_)); const int tid=tid_,lane=tid&63,r32=lane&31,hi=lane>>5; const int wid=__builtin_amdgcn_readfirstlane(tid>>6);
  const long rowbase=(long)b*SEQ; const int q0=qb*QB;
  const bf16*Qw=Q+(rowbase+q0+wid*QBLK)*DM+h*D;
  const bf16*Kh=K+rowbase*DM+h*D,*Vh=V+rowbase*DM+h*D;
  const unsigned lds0=(unsigned)(uintptr_t)shm;
  float*wsf=(float*)(shm+LDS_WS)+wid*64;
  const unsigned kvoff=(unsigned)(lane*DM+wid*8)*2u;
  const unsigned vvoff=(unsigned)((16*(wid&3)+(lane>>2))*DM+(wid>>2)*32+(lane&3)*8)*2u;
  const unsigned kdst=lds0+LDS_K+wid*1024, vdst=lds0+LDS_V+wid*1024;
  #define DMA_K(t,slot) glds16(Kh+(long)(NTF-1-(t))*KVBLK*DM,kvoff,(unsigned)__builtin_amdgcn_readfirstlane(kdst+(slot)))
  #define DMA_V(t,slot) glds16(Vh+(long)(NTF-1-(t))*KVBLK*DM,vvoff,(unsigned)__builtin_amdgcn_readfirstlane(vdst+(slot)))
  const int vb0=(int)(lds0+LDS_V)+((lane>>4)&1)*32+(lane&3)*8+(4*hi+((lane&15)>>2))*64;
  const char*Kbase=shm+LDS_K; bf16x8 kf[8];
  const lds_cptr shm3=(lds_cptr)shm; const lds_cptr kp0=shm3+LDS_K+hi*1024+r32*16; const lds_cptr vp0=shm3+LDS_V+((lane>>4)&1)*32+(lane&3)*8+(4*hi+((lane&15)>>2))*64;
  const int NTF=(q0+QB)/KVBLK;
  int NT=NTF;
  { const float*nq=nrm+(long)(b*2+0)*16+2*h,*nk=nrm+(long)(b*2+1)*16+2*h; const float B=__builtin_sqrtf((nq[0]+nq[1])*(nk[0]+nk[1]))*1.02f+0.5f;
    const float slope2_=__uint_as_float(0x3FB8AA3Bu-((unsigned)(h+1)<<23)); const float dh=(160.f+2.f*B)/slope2_;
    const float tminf=((float)(q0-63)-dh)*(1.f/64.f); int tmin=tminf>0.f?(int)tminf:0;
    tmin=__builtin_amdgcn_readfirstlane(tmin); int nt=NTF-tmin; nt+=nt&1; if(nt>NTF)nt=NTF; if(nt<4)nt=4; NT=nt; }
  { float*ksl=(float*)(shm+LDS_KSL); const float k0=ksum[(long)(b*16+(tid>>6))*512+h*64+(tid&63)],k1=ksum[(long)(b*16+8+(tid>>6))*512+h*64+(tid&63)]; ksl[tid]=k0; ksl[512+tid]=k1; }
  DMA_K(0,0);DMA_V(0,0);DMA_K(1,SLOTB);
  bf16x8 qr[4];
  #pragma unroll
  for(int d0=0;d0<4;++d0)qr[d0]=*reinterpret_cast<const bf16x8*>(&Qw[(long)r32*DM+d0*16+hi*8]);
  float mhat=0.f,l_reg=0.f;f32x16 o[2];o[0]=f32x16{};o[1]=f32x16{};const f32x16 zero16=f32x16{};
  const int qrel=wid*QBLK+r32;
  #define CMASK(P0,P1,t) do{int jb_=3-(t); if(jb_>=0)cmask(P0,P1,jb_,qrel,hi);}while(0)
  const unsigned sl2b=0x3FB8AA3Bu-((unsigned)(h+1)<<23);
  const float slope2=__uint_as_float(sl2b), s2x=__uint_as_float(sl2b+(1u<<23)), s8x=__uint_as_float(sl2b+(3u<<23)), s32=__uint_as_float(sl2b+(5u<<23));
  const float s3x=__uint_as_float((unsigned)__builtin_amdgcn_readfirstlane((int)__float_as_uint(slope2*3.0f)));
  #define NBSEL(r) (((r)>>2)==0?nbb0_:((r)>>2)==1?nbb1_:((r)>>2)==2?nbb2_:nbb3_)
  #define NEGV(r) ((((r)&3)==0)?NBSEL(r):(NBSEL(r)+(((r)&3)==1?slope2:((r)&3)==2?s2x:s3x)))
  #define NBB(nb) const float nbb0_=(nb), nbb1_=nbb0_+s8x, nbb2_=nbb1_+s8x, nbb3_=nbb2_+s8x
  #define NBSELC(r) (((r)>>2)==0?nbc0_:((r)>>2)==1?nbc1_:((r)>>2)==2?nbc2_:nbc3_)
  #define SAV(r) (((r)&3)==1?slope2:((r)&3)==2?s2x:s3x)
  #define BIAS(C0,C1,s) do{ NBB(NBV(s)); const float nbc0_=nbb0_+s32,nbc1_=nbb1_+s32,nbc2_=nbb2_+s32,nbc3_=nbb3_+s32; \
      _Pragma("unroll") for(int r=0;r<16;++r){ if((r&3)==0){C0[r]+=NBSEL(r);C1[r]+=NBSELC(r);} else {C0[r]=(C0[r]+NBSEL(r))+SAV(r);C1[r]=(C1[r]+NBSELC(r))+SAV(r);} } }while(0)
  unsigned sel=0u;
  #define NBV(s) ({ const int tl_=NTF-1-(s); const int tc_=tl_<0?0:tl_; const int bj_=tc_>>2; const float off_=(bj_>=qb||((sel>>bj_)&1u))?0.f:-1.0e30f; \
      __builtin_fmaf(slope2,(float)(64*tl_+4*hi-q0-qrel),off_-mhat); })
  #define CRC(r) ((float)(((r)&3)+8*((r)>>2)))
  bool resc=false;
  #define START(P0,P1) do{ const float rm=rowmax(P0,P1); resc=false; \
    { const float dl=(rm>-1.0e20f)?rm:0.f; mhat=fadd_s(mhat,dl); \
      _Pragma("unroll") for(int r=0;r<16;++r){P0[r]=fsub_s(P0[r],dl);P1[r]=fsub_s(P1[r],dl);} } \
    _Pragma("unroll") for(int r=0;r<16;++r)P0[r]=__builtin_amdgcn_exp2f(P0[r]); }while(0)
  #define RESC() do{ if(resc){ asm volatile("s_waitcnt lgkmcnt(0)":::"memory"); \
      _Pragma("unroll") for(int d_=0;d_<2;++d_) _Pragma("unroll") for(int r=0;r<16;++r)o[d_][r]*=wsf[crow(r,hi)]; } }while(0)
  f32x16 pA0,pA1,pB0,pB1;
  int sl_prev=0,sl_cur=0,sl_next=SLOTB;
  #define ROT() do{sl_prev=sl_cur;sl_cur=sl_next;sl_next=(sl_next==(NSLOT-1)*SLOTB)?0:sl_next+SLOTB;}while(0)
  DMA_K(2,2*SLOTB);
  WAIT_BAR(3);
  if(qb>0){
    float qf[32];
    _Pragma("unroll") for(int d0=0;d0<4;++d0) _Pragma("unroll") for(int e=0;e<8;++e) qf[d0*8+e]=__uint_as_float(((unsigned)(unsigned short)qr[d0][e])<<16);
    const float*ksl=(const float*)(shm+LDS_KSL)+8*hi;
    float b1=-3.0e38f,b2=-3.0e38f,b3=-3.0e38f; int i1=-1,i2=-1,i3=-1;
    for(int j=0;j<qb;++j){ float g=0.f;
      _Pragma("unroll") for(int d0=0;d0<4;++d0) _Pragma("unroll") for(int e=0;e<8;++e) g=__builtin_fmaf(qf[d0*8+e],ksl[j*64+16*d0+e],g);
      { auto rr=__builtin_amdgcn_permlane32_swap(__float_as_uint(g),__float_as_uint(g),false,false); g=__uint_as_float(rr[0])+__uint_as_float(rr[1]); }
      const bool c1=g>b1,c2=g>b2,c3=g>b3;
      b3=c2?b2:(c3?g:b3); i3=c2?i2:(c3?j:i3); b2=c1?b1:(c2?g:b2); i2=c1?i1:(c2?j:i2); b1=c1?g:b1; i1=c1?j:i1; }
    sel=(1u<<i1)|(i2>=0?(1u<<i2):0u)|(i3>=0?(1u<<i3):0u); }
  qkt(pA0,pA1,Kbase,qr,zero16,r32,hi);asm volatile("s_nop 15\n\ts_nop 7":"+v"(pA0),"+v"(pA1));
  BIAS(pA0,pA1,0);
  CMASK(pA0,pA1,0);
  START(pA0,pA1);
  _Pragma("unroll") for(int r=0;r<16;++r)pA1[r]=__builtin_amdgcn_exp2f(pA1[r]);
  WAIT_BAR(0);
  DMA_K(3,0);DMA_V(1,SLOTB);
  ROT();
  kload8(kf,kp0+sl_cur);
  WAIT_BAR(2);
  s16x4 vlo[8],vhi[8]; u32x4 pw0,pw1,pw2,pw3;
  #define PKW(P,B) cvtpk_s(P[B],P[B+1])
  #define PAF(k) __builtin_bit_cast(bf16x8,pw##k)
  #define VFR(i) (bf16x8){vlo[i][0],vlo[i][1],vlo[i][2],vlo[i][3],vhi[i][0],vhi[i][1],vhi[i][2],vhi[i][3]}
  #define PIN(x) asm volatile("":"+v"(x))
  #define MX3(a,b,c) __builtin_fmaxf(__builtin_fmaxf((a),(b)),(c))
  #define GAPA(MF,A0,A1,A2,A3,W0,W1,PW) do{ MF; sacc+=A0; sacc+=A1; sacc+=A2; sacc+=A3; PIN(sacc); W0; W1; PIN(PW); SBAR(); }while(0)
  #define EX(v) __builtin_amdgcn_exp2f(v)
  #define GAPB(MF,X,B) do{ MF; X[B]=EX(X[B]); X[B+1]=EX(X[B+1]); X[B+2]=EX(X[B+2]); X[B+3]=EX(X[B+3]); PIN(X); SBAR(); }while(0)
  #define VRD(i) do{ vlo[i]=vtr(vp_+(((i)>>2)*4096+((i)&3)*1024)); vhi[i]=vtr(vp_+(((i)>>2)*4096+((i)&3)*1024+512)); }while(0)
  #define KRD(G,j) do{ if(G){ kload2(kf,kp0+sl_next,j); SBAR(); } }while(0)
  #define STEP(C0,C1,P0,P1,t,GK,GV,GL) do{ SBAR(); \
    const lds_cptr vp_=vp0+sl_prev; \
    VRD(0); SBAR(); float sacc=(P0[0]+P0[1]); \
    GAPA(C0=__builtin_amdgcn_mfma_f32_32x32x16_bf16(kf[0],qr[0],zero16,0,0,0), P0[2],P0[3],P0[4],P0[5],     pw0[0]=PKW(P0,0), pw0[1]=PKW(P0,2), pw0); \
    VRD(4); SBAR(); GAPA(C1=__builtin_amdgcn_mfma_f32_32x32x16_bf16(kf[1],qr[0],zero16,0,0,0), P0[6],P0[7],P0[8],P0[9],     pw0[2]=PKW(P0,4), pw0[3]=PKW(P0,6), pw0); \
    VRD(1); SBAR(); GAPA(C0=__builtin_amdgcn_mfma_f32_32x32x16_bf16(kf[2],qr[1],C0,0,0,0),   P0[10],P0[11],P0[12],P0[13], pw1[0]=PKW(P0,8), pw1[1]=PKW(P0,10), pw1); \
    VRD(5); SBAR(); GAPA(C1=__builtin_amdgcn_mfma_f32_32x32x16_bf16(kf[3],qr[1],C1,0,0,0),   P0[14],P0[15],P1[0],P1[1],   pw1[2]=PKW(P0,12),pw1[3]=PKW(P0,14), pw1); \
    VRD(2); SBAR(); GAPA(C0=__builtin_amdgcn_mfma_f32_32x32x16_bf16(kf[4],qr[2],C0,0,0,0),   P1[2],P1[3],P1[4],P1[5],     pw2[0]=PKW(P1,0), pw2[1]=PKW(P1,2), pw2); \
    VRD(6); SBAR(); GAPA(C1=__builtin_amdgcn_mfma_f32_32x32x16_bf16(kf[5],qr[2],C1,0,0,0),   P1[6],P1[7],P1[8],P1[9],     pw2[2]=PKW(P1,4), pw2[3]=PKW(P1,6), pw2); \
    VRD(3); SBAR(); GAPA(C0=__builtin_amdgcn_mfma_f32_32x32x16_bf16(kf[6],qr[3],C0,0,0,0),   P1[10],P1[11],P1[12],P1[13], pw3[0]=PKW(P1,8), pw3[1]=PKW(P1,10), pw3); \
    VRD(7); SBAR(); GAPA(C1=__builtin_amdgcn_mfma_f32_32x32x16_bf16(kf[7],qr[3],C1,0,0,0),   P1[14],P1[15],0.f,0.f,       pw3[2]=PKW(P1,12),pw3[3]=PKW(P1,14), pw3); \
    l_reg+=sacc; \
    if(GK){DMA_K((t)+3,sl_cur);} if(GV){DMA_V((t)+1,sl_next);} \
    BIAS(C0,C1,t); \
    CMASK(C0,C1,t); \
    { float a=MX3(C0[0],C0[1],C1[0]),b=MX3(C0[2],C0[3],C1[1]); a=MX3(a,C1[2],C1[3]); \
      _Pragma("unroll") for(int r=4;r<16;r+=4){a=MX3(a,C0[r],C0[r+1]);b=MX3(b,C0[r+2],C0[r+3]);a=MX3(a,C1[r],C1[r+1]);b=MX3(b,C1[r+2],C1[r+3]);} \
      float rm=__builtin_fmaxf(a,b); { auto rr=__builtin_amdgcn_permlane32_swap(__float_as_uint(rm),__float_as_uint(rm),false,false); rm=__builtin_fmaxf(__uint_as_float(rr[0]),__uint_as_float(rr[1])); } \
      resc=false; \
      if(__builtin_expect(__any(rm>(float)THRL),0)){ const float dl=__builtin_fmaxf(rm,0.f); mhat+=dl; \
        _Pragma("unroll") for(int r=0;r<16;++r){C0[r]-=dl;C1[r]-=dl;} \
        const float f=__builtin_amdgcn_exp2f(-dl); l_reg*=f; if(hi==0)wsf[r32]=f; resc=true; } } \
    SBAR(); \
    GAPB(o[0]=__builtin_amdgcn_mfma_f32_32x32x16_bf16(PAF(0),VFR(0),o[0],0,0,0), C0,0); \
    GAPB(o[1]=__builtin_amdgcn_mfma_f32_32x32x16_bf16(PAF(0),VFR(4),o[1],0,0,0), C0,4); \
    KRD(GL,0); GAPB(o[0]=__builtin_amdgcn_mfma_f32_32x32x16_bf16(PAF(1),VFR(1),o[0],0,0,0), C0,8); \
    KRD(GL,1); GAPB(o[1]=__builtin_amdgcn_mfma_f32_32x32x16_bf16(PAF(1),VFR(5),o[1],0,0,0), C0,12); \
    KRD(GL,2); GAPB(o[0]=__builtin_amdgcn_mfma_f32_32x32x16_bf16(PAF(2),VFR(2),o[0],0,0,0), C1,0); \
    KRD(GL,3); GAPB(o[1]=__builtin_amdgcn_mfma_f32_32x32x16_bf16(PAF(2),VFR(6),o[1],0,0,0), C1,4); \
    GAPB(o[0]=__builtin_amdgcn_mfma_f32_32x32x16_bf16(PAF(3),VFR(3),o[0],0,0,0), C1,8); \
    GAPB(o[1]=__builtin_amdgcn_mfma_f32_32x32x16_bf16(PAF(3),VFR(7),o[1],0,0,0), C1,12); \
    }while(0)
  int t=1;
  #define ENDW(tt) do{ if((tt)+3<NT){WAIT_BAR(2);} else if((tt)+2<NT){WAIT_BAR(1);} else {WAIT_BAR(0);} }while(0)
  #define PEELED_PAIR() do{ \
    STEP(pB0,pB1,pA0,pA1,t,(t+3<NT),(t+1<NT),(t+1<NT));       ENDW(t);   RESC(); ROT(); \
    STEP(pA0,pA1,pB0,pB1,t+1,(t+4<NT),(t+2<NT),(t+2<NT));     ENDW(t+1); RESC(); ROT(); }while(0)
  for(;t<5&&t+1<NT;t+=2){ PEELED_PAIR(); }
  #undef CMASK
  #define CMASK(P0,P1,t) do{}while(0)
  for(;t+5<NT;t+=2){
    STEP(pB0,pB1,pA0,pA1,t,true,true,true);     WAIT_BAR(2); RESC(); ROT();
    STEP(pA0,pA1,pB0,pB1,t+1,true,true,true);   WAIT_BAR(2); RESC(); ROT();
  }
  #undef CMASK
  #define CMASK(P0,P1,t) do{int jb_=3-(t); if(jb_>=0)cmask(P0,P1,jb_,qrel,hi);}while(0)
  for(;t+1<NT;t+=2){ PEELED_PAIR(); }
  STEP(pB0,pB1,pA0,pA1,NT-1,false,false,false); RESC();
  { float sacc=pB0[0]+pB0[1]; _Pragma("unroll") for(int r=2;r<16;++r)sacc+=pB0[r]; _Pragma("unroll") for(int r=0;r<16;++r)sacc+=pB1[r]; l_reg+=sacc;
    pw0=(u32x4){PKW(pB0,0),PKW(pB0,2),PKW(pB0,4),PKW(pB0,6)};pw1=(u32x4){PKW(pB0,8),PKW(pB0,10),PKW(pB0,12),PKW(pB0,14)};pw2=(u32x4){PKW(pB1,0),PKW(pB1,2),PKW(pB1,4),PKW(pB1,6)};pw3=(u32x4){PKW(pB1,8),PKW(pB1,10),PKW(pB1,12),PKW(pB1,14)};
    SBAR(); pv(o,vb0+sl_cur,PAF(0),PAF(1),PAF(2),PAF(3)); }
  #undef PKW
  #undef PAF
  #undef VFR
  #undef PIN
  #undef MX3
  #undef GAPA
  #undef GAPB
  #undef EX
  #undef VRD
  #undef KRD
  #undef STEP
  #undef ENDW
  #undef PEELED_PAIR
  #undef NBV
  #undef CRC
  #undef NEGV
  #undef NBSEL
  #undef NBB
  #undef NBSELC
  #undef SAV
  #undef BIAS
  {auto rr=__builtin_amdgcn_permlane32_swap(__float_as_uint(l_reg),__float_as_uint(l_reg),false,false);l_reg=__uint_as_float(rr[0])+__uint_as_float(rr[1]);}
  if(hi==0)wsf[32+r32]=l_reg;asm volatile("s_waitcnt lgkmcnt(0)":::"memory");
  float rli[16];
  #pragma unroll
  for(int r=0;r<16;++r)rli[r]=__builtin_amdgcn_rcpf(wsf[32+crow(r,hi)]);
  bf16*Ow=O+(rowbase+q0+wid*QBLK)*DM+h*D;
  { bf16*stg=(bf16*)(shm+LDS_OST)+wid*2048;
    #pragma unroll
    for(int r=0;r<16;++r){const int orow=crow(r,hi);
      #pragma unroll
      for(int d0=0;d0<2;++d0)stg[orow*64+d0*32+r32]=__float2bfloat16(o[d0][r]*rli[r]);}
    asm volatile("s_waitcnt lgkmcnt(0)":::"memory");
    #pragma unroll
    for(int i=0;i<4;++i){const int row=i*8+(lane>>3),ch=lane&7; const u32x4 v=*(const u32x4*)(stg+row*64+ch*8); ATTN_STORE16(Ow+(long)row*DM+ch*8,v);} }
  asm volatile("s_waitcnt lgkmcnt(0)\n\ts_barrier":::"memory");
  #undef DMA_K
  #undef DMA_V
  #undef CMASK
  #undef START
  #undef RESC
  #undef ROT
}
constexpr int ATTN_LDS_BYTES=LDS_BYTES;
struct AttnTensors { const bf16* Q; const bf16* K; const bf16* V; bf16* O; };
struct AttnUnit { int bh; int qb; };
struct AttnPlan { unsigned char unit[32][12]; unsigned char n[32]; };
constexpr int attn_nominal_cost(int h,int qb){ const int pmax[8]={7,12,22,41,64,64,64,64}; const int past=4*qb<pmax[h]?4*qb:pmax[h]; return 4+past+2; }
constexpr AttnPlan make_attn_plan(){
  AttnPlan p{}; int load[32]={}; bool used[128]={};
  for(int it=0;it<128;++it){ int best=-1,bc=-1; for(int e=0;e<128;++e){ if(used[e])continue; const int c=attn_nominal_cost(e>>4,e&15); if(c>bc){bc=c;best=e;} }
    used[best]=true; int cu=0; for(int c=1;c<32;++c) if(load[c]<load[cu]||(load[c]==load[cu]&&p.n[c]<p.n[cu]))cu=c;
    if(p.n[cu]>=12){ for(int c=0;c<32;++c) if(p.n[c]<12){cu=c;break;} }
    p.unit[cu][p.n[cu]++]=(unsigned char)best; load[cu]+=bc; }
  return p; }
__device__ const AttnPlan g_attn_plan=make_attn_plan();
struct StaticOrder {
  int vcu,G;
  __device__ __forceinline__ explicit StaticOrder(int grid,int vcu_):vcu(vcu_),G(grid){}
  __device__ __forceinline__ bool next(int i,AttnUnit&u)const{
    if(G!=256){ const int id=vcu+i*G; if(id>=BATCH*NHEAD*NQB)return false; u.bh=id>>4; u.qb=id&15; return true; }
    const int c=vcu&31; if(i>=(int)g_attn_plan.n[c])return false; const int e=g_attn_plan.unit[c][i]; u.bh=(vcu>>5)*NHEAD+(e>>4); u.qb=e&15; return true; }
};
template<class Sched,int THRL=8> __device__ __forceinline__ void attn_phase(char*lds,const AttnTensors&T,const float*ksum,const float*nrm,const Sched&S){
  AttnUnit u;
  for(int i=0;S.next(i,u);++i){ attn_unit<THRL>(u.bh/NHEAD,u.bh%NHEAD,u.qb,T.Q,T.K,T.V,T.O,ksum,nrm,lds); }
}
#undef SBAR
#undef WAIT_BAR
}

__device__ __forceinline__ void pooled_phase(Frame& F, const Args& A) {
    const bf16* P = (const bf16*)(A.ws + WS_QKVP) + (size_t)3 * T * 512; bf16* PO = (bf16*)(A.ws + WS_POOLED);
    const int gw = F.vcu * NWAVES + F.wave, NGW = F.G * NWAVES, lane = F.lane, w = 2 << (lane >> 4);
    for (int tk = gw; tk < T / 16; tk += NGW) {
        const int row0 = tk * 16, s0 = row0 & (SEQ - 1);
        v4u rv[31];
#pragma unroll
        for (int i = 0; i < 31; ++i) { const int sidx = s0 - 15 + i; rv[i] = (sidx >= 0) ? *(const v4u*)(P + (size_t)(row0 - 15 + i) * 512 + 8 * lane) : (v4u){0u, 0u, 0u, 0u}; }
#pragma unroll
        for (int i = 0; i < 16; ++i) {
            const int sidx = s0 + i; float acc[8];
#pragma unroll
            for (int e = 0; e < 8; ++e) acc[e] = 0.f;
#pragma unroll
            for (int k = 0; k < 16; ++k) { const bool ok = (k < w) && (sidx - k >= 0); const v4u x = rv[15 + i - k]; const float msk = ok ? 1.0f : 0.0f;
                acc[0] += msk * bflo(x.x); acc[1] += msk * bfhi(x.x); acc[2] += msk * bflo(x.y); acc[3] += msk * bfhi(x.y); acc[4] += msk * bflo(x.z); acc[5] += msk * bfhi(x.z); acc[6] += msk * bflo(x.w); acc[7] += msk * bfhi(x.w); }
            const float inv = 1.0f / (float)min(sidx + 1, w); const v4u x = rv[15 + i];
            v4u o; o.x = pk2(acc[0] * inv - bflo(x.x), acc[1] * inv - bfhi(x.x)); o.y = pk2(acc[2] * inv - bflo(x.y), acc[3] * inv - bfhi(x.y));
            o.z = pk2(acc[4] * inv - bflo(x.z), acc[5] * inv - bfhi(x.z)); o.w = pk2(acc[6] * inv - bflo(x.w), acc[7] * inv - bfhi(x.w));
            *(v4u*)(PO + (size_t)(row0 + i) * 512 + 8 * lane) = o;
        }
    }
}

typedef float f32x2 __attribute__((ext_vector_type(2)));
typedef int v4i __attribute__((ext_vector_type(4)));
__device__ __forceinline__ void h2q_rows4(const Args& A, int t0, int lane) {
    const float* modf = (const float*)(A.ws + WS_MODF); const float* ss2 = (const float*)(A.ws + WS_SS2); const float* g2 = A.in[12];
    const int b = t0 / SEQ;
    f32x4 xv[4][4];
#pragma unroll
    for (int u = 0; u < 4; ++u)
#pragma unroll
        for (int q = 0; q < 4; ++q) xv[u][q] = *(const f32x4*)(A.out + (size_t)(t0 + u) * D + 16 * lane + 4 * q);
    f32x4 G[4], S[4];
#pragma unroll
    for (int q = 0; q < 4; ++q) { const int c = 16 * lane + 4 * q; G[q] = *(const f32x4*)(g2 + c) * (*(const f32x4*)(modf + (size_t)b * 6144 + 4096 + c) + 1.0f); S[q] = *(const f32x4*)(modf + (size_t)b * 6144 + 3072 + c); }
#pragma unroll
    for (int u = 0; u < 4; ++u) {
        const f32x4* sp = (const f32x4*)(ss2 + (size_t)(t0 + u) * 16); const f32x4 s4 = (sp[0] + sp[1]) + (sp[2] + sp[3]);
        const float rs = 1.0f / sqrtf(((s4[0] + s4[1]) + (s4[2] + s4[3])) * (1.0f / D) + RMS_EPS);
        float h2[16]; float am = 0.f;
#pragma unroll
        for (int q = 0; q < 4; ++q)
#pragma unroll
            for (int e = 0; e < 4; ++e) { const float h = xv[u][q][e] * rs * G[q][e] + S[q][e]; h2[4 * q + e] = h; am = fmaxf(am, fabsf(h)); }
        am = fmaxf(am, __shfl_xor(am, 1)); am = fmaxf(am, __shfl_xor(am, 2)); am = fmaxf(am, __shfl_xor(am, 4));
        const float hs = (am > 0.f) ? am * (1.0f / 127.0f) : 1.0f, hinv = 1.0f / hs;
        v4u o;
#pragma unroll
        for (int q = 0; q < 4; ++q) { const int q0 = (int)rintf(h2[4 * q] * hinv), q1 = (int)rintf(h2[4 * q + 1] * hinv), q2 = (int)rintf(h2[4 * q + 2] * hinv), q3 = (int)rintf(h2[4 * q + 3] * hinv);
            o[q] = (unsigned)(q0 & 255) | ((unsigned)(q1 & 255) << 8) | ((unsigned)(q2 & 255) << 16) | ((unsigned)q3 << 24); }
        *(v4u*)(A.ws + WS_H2Q + (size_t)(t0 + u) * D + 16 * lane) = o;
        if ((lane & 7) == 0) ((float*)(A.ws + WS_HS))[(size_t)(t0 + u) * 8 + (lane >> 3)] = hs;
    }
}

namespace rt {
typedef float f32x16 __attribute__((ext_vector_type(16)));
typedef short bf16x8 __attribute__((ext_vector_type(8)));
__device__ __forceinline__ void ce(float& hi, float& lo) { const float a = fmaxf(hi, lo), b = fminf(hi, lo); hi = a; lo = b; }
template <int N> __device__ __forceinline__ void sort_desc(float (&v)[N]) {
#pragma unroll
    for (int k = 2; k <= N; k <<= 1)
#pragma unroll
        for (int j = k >> 1; j > 0; j >>= 1)
#pragma unroll
            for (int i = 0; i < N; ++i) { const int l = i ^ j; if (l > i) { if ((i & k) == 0) ce(v[i], v[l]); else ce(v[l], v[i]); } }
}
__device__ __forceinline__ void sort16_desc(float (&v)[16]) {
    ce(v[0], v[13]); ce(v[1], v[12]); ce(v[2], v[15]); ce(v[3], v[14]); ce(v[4], v[8]); ce(v[5], v[6]); ce(v[7], v[11]); ce(v[9], v[10]);
    ce(v[0], v[5]); ce(v[1], v[7]); ce(v[2], v[9]); ce(v[3], v[4]); ce(v[6], v[13]); ce(v[8], v[14]); ce(v[10], v[15]); ce(v[11], v[12]);
    ce(v[0], v[1]); ce(v[2], v[3]); ce(v[4], v[5]); ce(v[6], v[8]); ce(v[7], v[9]); ce(v[10], v[11]); ce(v[12], v[13]); ce(v[14], v[15]);
    ce(v[0], v[2]); ce(v[1], v[3]); ce(v[4], v[10]); ce(v[5], v[11]); ce(v[6], v[7]); ce(v[8], v[9]); ce(v[12], v[14]); ce(v[13], v[15]);
    ce(v[1], v[2]); ce(v[3], v[12]); ce(v[4], v[6]); ce(v[5], v[7]); ce(v[8], v[10]); ce(v[9], v[11]); ce(v[13], v[14]);
    ce(v[1], v[4]); ce(v[2], v[6]); ce(v[5], v[8]); ce(v[7], v[10]); ce(v[9], v[13]); ce(v[11], v[14]);
    ce(v[2], v[4]); ce(v[3], v[6]); ce(v[9], v[12]); ce(v[11], v[13]);
    ce(v[3], v[5]); ce(v[6], v[8]); ce(v[7], v[9]); ce(v[10], v[12]);
    ce(v[3], v[4]); ce(v[5], v[6]); ce(v[7], v[8]); ce(v[9], v[10]); ce(v[11], v[12]);
    ce(v[6], v[7]); ce(v[8], v[9]);
}
template <int N> __device__ __forceinline__ void bitonic_merge_desc(float (&v)[N]) {
#pragma unroll
    for (int j = N >> 1; j > 0; j >>= 1)
#pragma unroll
        for (int i = 0; i < N; ++i) { const int l = i ^ j; if (l > i) ce(v[i], v[l]); }
}
__device__ __forceinline__ void merge_top16(float (&a)[16], const float (&b)[16]) {
#pragma unroll
    for (int i = 0; i < 16; ++i) a[i] = fmaxf(a[i], b[15 - i]);
    bitonic_merge_desc<16>(a);
}
template <bool SORT> __device__ __forceinline__ void pair_merge(float (&a)[16], bool hi) {
    float w[16];
#pragma unroll
    for (int i = 0; i < 16; ++i) w[i] = hi ? a[15 - i] : a[i];
#pragma unroll
    for (int i = 0; i < 16; ++i) { const auto rr = __builtin_amdgcn_permlane32_swap(__float_as_uint(w[i]), __float_as_uint(w[i]), false, false); a[i] = fmaxf(__uint_as_float(rr[0]), __uint_as_float(rr[1])); }
    if (SORT) bitonic_merge_desc<16>(a);
}
__device__ __forceinline__ void fold_tile(const f32x16& acc, int kt, int hi, float (&out)[16]) {
    float g[16];
#pragma unroll
    for (int r = 0; r < 16; ++r) { const unsigned key = (unsigned)(32 * kt + (r & 3) + 8 * (r >> 2)); g[r] = __uint_as_float((__float_as_uint(acc[r]) & ~127u) | key | ((unsigned)hi << 2)); }
    sort16_desc(g);
    if (kt == 0) {
#pragma unroll
        for (int r = 0; r < 16; ++r) out[r] = g[r];
    } else merge_top16(out, g);
}
}
__device__ __forceinline__ void router_phase(Frame& F, const Args& A) {
    using namespace rt;
    const bf16* QP = (const bf16*)(A.ws + WS_GAB); const bf16* SK = (const bf16*)(A.ws + WS_SUBK);
    unsigned short* IDX = (unsigned short*)(A.ws + WS_POOLED); float* GATE = (float*)(A.ws + WS_POOLED + 16 * MiB);
    const int lane = F.lane, n32 = lane & 31, hi = lane >> 5, gw = F.vcu * NWAVES + F.wave, NGW = F.G * NWAVES;
    __syncthreads();
    for (int i = F.tid; i < 2 * 128 * 16; i += NTHREADS) { const int r = i >> 4, ch = i & 15; *(LAS v4u*)(F.lds + r * 272 + ch * 16) = *(const v4u*)(SK + (size_t)r * 128 + ch * 8); }
    __syncthreads();
    LAS unsigned char* scr = F.lds + 73728 + F.wave * 1024;
    const LAS unsigned char* afrag = F.lds + n32 * 272 + hi * 16;
    bf16x8 qa[8], qb[8];
#define RT_QLOAD(task_, p_, q_) do { const int tq_ = (task_) * 4 + (n32 >> 3); const bf16* qr_ = QP + (size_t)tq_ * PQW + (n32 & 7) * 256 + (p_) * 128 + 8 * hi; \
        _Pragma("unroll") for (int i = 0; i < 8; ++i) q_[i] = __builtin_nontemporal_load((const bf16x8*)(qr_ + 16 * i)); } while (0)
#define RT_HALF(p_, q_, out_) do { _Pragma("unroll") for (int kt = 0; kt < 4; ++kt) { f32x16 acc = f32x16{}; \
        _Pragma("unroll") for (int ks = 0; ks < 8; ++ks) { const bf16x8 kf = *(const LAS bf16x8*)(afrag + ((p_) * 128 + 32 * kt) * 272 + 32 * ks); acc = __builtin_amdgcn_mfma_f32_32x32x16_bf16(kf, q_[ks], acc, 0, 0, 0); } \
        fold_tile(acc, kt, hi, out_); } pair_merge<true>(out_, hi != 0); } while (0)
    if (gw < T * PHEADS / 32) RT_QLOAD(gw, 0, qa);
#ifdef TABLES_IN_ROUTER
    int tr0 = gw; const bool late_trip = F.wave >= 4;
#define RT_TABLE_TRIP(cond_) do { if (cond_) { asm volatile("" ::: "memory"); if (tr0 < 2 * PEXP) { p0_table_trip(A, tr0, NGW, lane); tr0 += 4 * NGW; } asm volatile("" ::: "memory"); h2q_rows4(A, task * 4, lane); asm volatile("" ::: "memory"); } } while (0)
#else
#define RT_TABLE_TRIP(cond_) do { } while (0)
#endif
    for (int task = gw; task < T * PHEADS / 32; task += NGW) {
        const int t = task * 4 + (n32 >> 3), h = n32 & 7;
        float la[16], lb[16];
        RT_TABLE_TRIP(!late_trip);
        RT_QLOAD(task, 1, qb);
        RT_HALF(0, qa, la);
        { const int nxt = task + NGW; if (nxt < T * PHEADS / 32) RT_QLOAD(nxt, 0, qa); }
        RT_HALF(1, qb, lb);
        { unsigned w[4];
#pragma unroll
          for (int q = 0; q < 4; ++q) {
              const unsigned i0 = __float_as_uint(hi ? lb[4 * q] : la[4 * q]) & 127u, i1 = __float_as_uint(hi ? lb[4 * q + 1] : la[4 * q + 1]) & 127u, i2 = __float_as_uint(hi ? lb[4 * q + 2] : la[4 * q + 2]) & 127u, i3 = __float_as_uint(hi ? lb[4 * q + 3] : la[4 * q + 3]) & 127u;
              w[q] = i0 | (i1 << 8) | (i2 << 16) | (i3 << 24); }
          *(LAS v4u*)(scr + n32 * 32 + hi * 16) = (v4u){w[0], w[1], w[2], w[3]}; }
        float x[16], y[16];
#pragma unroll
        for (int i = 0; i < 16; ++i) { const float av = __uint_as_float(__float_as_uint(la[i]) & ~127u), bv = __uint_as_float(__float_as_uint(lb[i]) & ~127u); x[i] = hi ? bv : av; y[i] = hi ? av : bv; }
        float c0[16], c1[16];
        {
            const unsigned hb = (unsigned)hi << 8;
#define RT_CAND(i, j) __uint_as_float(((__float_as_uint(x[i] + y[j]) & ~511u) | (unsigned)((i) * 16 + (j))) | hb)
#define RT_DIAG(i) (hi ? -3.0e38f : RT_CAND(i, i))
            c0[0] = RT_DIAG(0);
#pragma unroll
            for (int j = 1; j < 16; ++j) c0[j] = RT_CAND(0, j);
            c1[0] = RT_DIAG(1);
#pragma unroll
            for (int j = 2; j < 8; ++j) c1[j - 1] = RT_CAND(1, j);
            c1[7] = RT_DIAG(2); c1[8] = RT_CAND(2, 3); c1[9] = RT_CAND(2, 4); c1[10] = RT_DIAG(3);
#pragma unroll
            for (int k = 11; k < 16; ++k) c1[k] = -3.0e38f;
#undef RT_CAND
#undef RT_DIAG
        }
        sort16_desc(c0); sort16_desc(c1); merge_top16(c0, c1);
        pair_merge<false>(c0, hi != 0);
        float mx = c0[0];
#pragma unroll
        for (int i = 1; i < 16; ++i) mx = fmaxf(mx, c0[i]);
        float ex[16], sm = 0.f;
#pragma unroll
        for (int i = 0; i < 16; ++i) { ex[i] = __expf(__uint_as_float(__float_as_uint(c0[i]) & ~511u) - mx); sm += ex[i]; }
        const float inv = 1.0f / sm;
        asm volatile("s_waitcnt lgkmcnt(0)" ::: "memory");
        int eo[8]; float go[8];
#pragma unroll
        for (int k = 0; k < 8; ++k) { const float wv = hi ? c0[8 + k] : c0[k]; go[k] = (hi ? ex[8 + k] : ex[k]) * inv;
            const unsigned bits = __float_as_uint(wv), fromhi = (bits >> 8) & 1u, xi = (bits >> 4) & 15u, yj = bits & 15u;
            const unsigned ar = fromhi ? yj : xi, br = fromhi ? xi : yj;
            const unsigned e1 = scr[n32 * 32 + ar], e2 = scr[n32 * 32 + 16 + br];
            eo[k] = (int)(e1 * 128u + e2); }
        unsigned short* ip = IDX + (size_t)t * PSEL + h * PTOP + 8 * hi; float* gp = GATE + (size_t)t * PSEL + h * PTOP + 8 * hi;
        *(v4u*)ip = (v4u){(unsigned)eo[0] | ((unsigned)eo[1] << 16), (unsigned)eo[2] | ((unsigned)eo[3] << 16), (unsigned)eo[4] | ((unsigned)eo[5] << 16), (unsigned)eo[6] | ((unsigned)eo[7] << 16)};
        *(f32x4*)gp = (f32x4){go[0], go[1], go[2], go[3]}; *(f32x4*)(gp + 4) = (f32x4){go[4], go[5], go[6], go[7]};
        asm volatile("s_waitcnt lgkmcnt(0)" ::: "memory");
        RT_TABLE_TRIP(late_trip);
    }
#ifdef TABLES_IN_ROUTER
    while (tr0 < 2 * PEXP) { p0_table_trip(A, tr0, NGW, lane); tr0 += 4 * NGW; }
#endif
#undef RT_TABLE_TRIP
#undef RT_QLOAD
#undef RT_HALF
    __syncthreads();
}

__device__ __forceinline__ float gelu_tanh(float x) { const float u = 0.7978845608028654f * (x + 0.044715f * x * x * x); return x / (1.0f + __expf(-2.0f * u)); }
__device__ __forceinline__ void peer_sliced_phase(Frame& F, const Args& A) {
    const int lane = F.lane, c8 = lane & 7, g8 = lane >> 3, gw = F.vcu * NWAVES + F.wave, NGW = F.G * NWAVES;
    const float* modf = (const float*)(A.ws + WS_MODF);
    const unsigned char* U8 = A.ws + WS_U; const unsigned char* V8 = A.ws + WS_V;
    const f32x2* SUV = (const f32x2*)(A.ws + WS_U + 16 * MiB);
    const unsigned short* IDX = (const unsigned short*)(A.ws + WS_POOLED); const float* GATE = (const float*)(A.ws + WS_POOLED + 16 * MiB);
    const float* gf = A.in[17];
    LAS float* AL = (LAS float*)(F.lds + F.wave * 17664);
    LAS float* SSQ = AL + 2048;
    LAS float* SAV = AL + 3072;
    LAS float* RS2 = AL + 3088;
    LAS float* GS = AL + 3104;
    LAS unsigned short* IDL = (LAS unsigned short*)(AL + 3360);
    for (int tb = gw * 16; tb < T; tb += NGW * 16) {
        for (int i = lane; i < 2048; i += 64) AL[i] = 0.f;
        for (int i = lane; i < 1024; i += 64) SSQ[i] = 0.f;
#pragma unroll
        for (int i = 0; i < 16; ++i) *(LAS unsigned*)(IDL + i * 128 + 2 * lane) = *(const unsigned*)(IDX + (size_t)(tb + i) * PSEL + 2 * lane);
        LDS_WAIT();
        {
            v4i W0[16], W1[16], H0, H1, H; float hs0, hs1, hs;
            const unsigned char* H2Q = A.ws + WS_H2Q; const float* HS = (const float*)(A.ws + WS_HS);
#define PU_X(k, Hx, hx) do { const int k_ = (k) < 128 ? (k) : 127; const int s_ = k_ >> 4, t_ = tb + (k_ & 15); Hx = *(const v4i*)(H2Q + (size_t)t_ * D + 128 * s_ + 16 * c8); hx = HS[(size_t)t_ * 8 + s_]; } while (0)
#define PU_B(k, W) do { const int k_ = (k) < 128 ? (k) : 127; const int s_ = k_ >> 4; const unsigned base_ = ((unsigned)s_ << 21) + 16u * (unsigned)c8; v4u I[2]; I[0] = *(const LAS v4u*)(IDL + (k_ & 15) * 128 + 16 * g8); I[1] = *(const LAS v4u*)(IDL + (k_ & 15) * 128 + 16 * g8 + 8); \
            _Pragma("unroll") for (int j = 0; j < 16; ++j) W[j] = *(const v4i*)(U8 + (base_ + (((I[j >> 3][(j >> 1) & 3] >> (16 * (j & 1))) & 0xffffu) << 7))); \
            } while (0)
#define PU_Q(k, Hx, hx) do { H = Hx; hs = hx; } while (0)
#define PU_C(k, W) do { int part[16]; \
            _Pragma("unroll") for (int j = 0; j < 16; ++j) part[j] = __builtin_amdgcn_sdot4(W[j].x, H.x, __builtin_amdgcn_sdot4(W[j].y, H.y, __builtin_amdgcn_sdot4(W[j].z, H.z, __builtin_amdgcn_sdot4(W[j].w, H.w, 0, false), false), false), false); \
            _Pragma("unroll") for (int step = 4; step >= 1; step >>= 1) { const bool up = (lane & step) != 0; \
                _Pragma("unroll") for (int i = 0; i < 2 * step; ++i) { const int send = up ? part[i] : part[i + 2 * step], keep = up ? part[i + 2 * step] : part[i]; part[i] = keep + __shfl_xor(send, step); } } \
            LAS f32x2* ap_ = (LAS f32x2*)(AL + ((k) & 15) * 128 + 2 * lane); f32x2 a_ = *ap_; a_.x += hs * (float)part[0]; a_.y += hs * (float)part[1]; *ap_ = a_; } while (0)
            PU_X(0, H0, hs0); PU_X(1, H1, hs1); PU_B(0, W0);
#pragma unroll 1
            for (int k = 0; k < 128; k += 2) {
                PU_Q(k, H0, hs0); PU_B(k + 1, W1); PU_X(k + 2, H0, hs0);
                PU_C(k, W0);
                PU_Q(k + 1, H1, hs1); PU_B(k + 2, W0); PU_X(k + 3, H1, hs1);
                PU_C(k + 1, W1);
            }
#undef PU_X
#undef PU_B
#undef PU_Q
#undef PU_C
        }
        LDS_WAIT();
#pragma unroll 4
        for (int i = 0; i < 16; ++i) {
            const int t = tb + i; const unsigned e01 = *(const LAS unsigned*)(IDL + i * 128 + 2 * lane); const int e0 = (int)(e01 & 0xffffu), e1 = (int)(e01 >> 16);
            const f32x2 gt = *(const f32x2*)(GATE + (size_t)t * PSEL + 2 * lane); const f32x2 a = *(LAS f32x2*)(AL + i * 128 + 2 * lane);
            const f32x2 s0 = SUV[e0], s1 = SUV[e1];
            f32x2 av; av.x = gelu_tanh(a.x * s0.x) * gt.x * s0.y; av.y = gelu_tanh(a.y * s1.x) * gt.y * s1.y;
            const float am = wave_max(fmaxf(fabsf(av.x), fabsf(av.y))); const float as = (am > 0.f) ? am * (1.0f / 127.0f) : 1.0f, ainv = 1.0f / as;
            const int q0 = (int)rintf(av.x * ainv), q1 = (int)rintf(av.y * ainv);
            *(LAS unsigned short*)((LAS unsigned char*)AL + i * 512 + 2 * lane) = (unsigned short)((unsigned)(q0 & 255) | ((unsigned)(q1 & 255) << 8));
            if (lane == 0) SAV[i] = as;
        }
        LDS_WAIT();
        {
            v4u W0[16], W1[16]; f32x2 X0, X1, gt2v = (f32x2){0.f, 0.f};
            const int b = tb / SEQ;
#define PV_B(k, W, X) do { const int k_ = (k) < 128 ? (k) : 127; const int s_ = k_ >> 4, t_ = tb + (k_ & 15); const unsigned base_ = ((unsigned)s_ << 21) + 16u * (unsigned)c8; v4u I[2]; I[0] = *(const LAS v4u*)(IDL + (k_ & 15) * 128 + 16 * g8); I[1] = *(const LAS v4u*)(IDL + (k_ & 15) * 128 + 16 * g8 + 8); \
            _Pragma("unroll") for (int j = 0; j < 16; ++j) W[j] = *(const v4u*)(V8 + (base_ + (((I[j >> 3][(j >> 1) & 3] >> (16 * (j & 1))) & 0xffffu) << 7))); \
            X = __builtin_nontemporal_load((const f32x2*)(A.out + (size_t)t_ * D + 128 * s_ + 16 * c8 + 2 * g8)); } while (0)
#define PV_D(W, q4, d, cm) do { const unsigned r0 = W[4 * (q4)].cm, r1 = W[4 * (q4) + 1].cm, r2 = W[4 * (q4) + 2].cm, r3 = W[4 * (q4) + 3].cm; \
                    const unsigned t0 = __builtin_amdgcn_perm(r1, r0, 0x05010400u), t1 = __builtin_amdgcn_perm(r1, r0, 0x07030602u), t2 = __builtin_amdgcn_perm(r3, r2, 0x05010400u), t3 = __builtin_amdgcn_perm(r3, r2, 0x07030602u); \
                    pi[4 * d] = __builtin_amdgcn_sdot4((int)__builtin_amdgcn_perm(t2, t0, 0x05040100u), aq, pi[4 * d], false); pi[4 * d + 1] = __builtin_amdgcn_sdot4((int)__builtin_amdgcn_perm(t2, t0, 0x07060302u), aq, pi[4 * d + 1], false); \
                    pi[4 * d + 2] = __builtin_amdgcn_sdot4((int)__builtin_amdgcn_perm(t3, t1, 0x05040100u), aq, pi[4 * d + 2], false); pi[4 * d + 3] = __builtin_amdgcn_sdot4((int)__builtin_amdgcn_perm(t3, t1, 0x07060302u), aq, pi[4 * d + 3], false); } while (0)
#define PV_Q(W, q4, acm) do { const int aq = (int)a4_.acm; PV_D(W, q4, 0, x); PV_D(W, q4, 1, y); PV_D(W, q4, 2, z); PV_D(W, q4, 3, w); } while (0)
#define PV_C(k, W, X) do { const int s_ = (k) >> 4, i_ = (k) & 15; \
            if (i_ == 0) gt2v = *(const f32x2*)(modf + (size_t)b * 6144 + 5120 + 128 * s_ + 16 * c8 + 2 * g8); \
            int pi[16]; _Pragma("unroll") for (int q = 0; q < 16; ++q) pi[q] = 0; \
            const v4u a4_ = *(const LAS v4u*)((const LAS unsigned char*)AL + i_ * 512 + 16 * g8); \
            PV_Q(W, 0, x); PV_Q(W, 1, y); PV_Q(W, 2, z); PV_Q(W, 3, w); \
            float pc[16]; _Pragma("unroll") for (int q = 0; q < 16; ++q) pc[q] = (float)pi[q];        \
            _Pragma("unroll") for (int step = 4; step >= 1; step >>= 1) { const bool up = (g8 & step) != 0; \
                _Pragma("unroll") for (int i = 0; i < 2 * step; ++i) { const float send = up ? pc[i] : pc[i + 2 * step], keep = up ? pc[i + 2 * step] : pc[i]; pc[i] = keep + __shfl_xor(send, 8 * step); } } \
            const float sav_ = SAV[i_]; f32x2 x2_; x2_.x = X.x + gt2v.x * (sav_ * pc[0]); x2_.y = X.y + gt2v.y * (sav_ * pc[1]); \
            *(f32x2*)(A.out + (size_t)(tb + i_) * D + 128 * s_ + 16 * c8 + 2 * g8) = x2_; \
            SSQ[i_ * 64 + lane] += x2_.x * x2_.x + x2_.y * x2_.y; } while (0)
            PV_B(0, W0, X0);
#pragma unroll 1
            for (int k = 0; k < 128; k += 2) {
                PV_B(k + 1, W1, X1);
                PV_C(k, W0, X0);
                PV_B(k + 2, W0, X0);
                PV_C(k + 1, W1, X1);
            }
#undef PV_B
#undef PV_C
#undef PV_D
#undef PV_Q
        }
        VM_WAIT(); LDS_WAIT();
#pragma unroll 2
        for (int i = 0; i < 16; ++i) {
            float* xr = A.out + (size_t)(tb + i) * D + 16 * lane;
            f32x4 v[4];
#pragma unroll
            for (int q = 0; q < 4; ++q) v[q] = __builtin_nontemporal_load((const f32x4*)(xr + 4 * q));
            const float rs = 1.0f / sqrtf(wave_sum(SSQ[i * 64 + lane]) * (1.0f / D) + RMS_EPS);
#pragma unroll
            for (int q = 0; q < 4; ++q) *(f32x4*)(xr + 4 * q) = v[q] * rs * *(const f32x4*)(gf + 16 * lane + 4 * q);
        }
        LDS_WAIT();
    }
}

template <int NU, bool RS>
__device__ __forceinline__ void stage_unit_tables(Frame& F, const pg8::StaticOrder& S, const float* biasp, int N, LAS float* btab, const float* ss2, LAS float* rtab) {
    pg8::Unit u;
    { const int j = F.tid >> 6, t = F.tid & 63;
      if (j < NU && S.next(j, u)) { const int b = u.pm >> 4, col = u.pn * 256 + 4 * t; f32x4 s = (f32x4){0.f, 0.f, 0.f, 0.f};
#pragma unroll
          for (int kc = 0; kc < 8; ++kc) s += *(const f32x4*)(biasp + (size_t)(kc * 8 + b) * N + col);
          *(LAS f32x4*)(btab + j * 256 + 4 * t) = s; } }
    if (RS) {
#pragma unroll
        for (int jj = 0; jj < (NU * 256 + NTHREADS - 1) / NTHREADS; ++jj) { const int idx = jj * NTHREADS + F.tid, j = idx >> 8, r = idx & 255;
            if (j < NU && S.next(j, u)) { const f32x4* sp = (const f32x4*)(ss2 + (size_t)(u.pm * 256 + r) * 16); const f32x4 s4 = (sp[0] + sp[1]) + (sp[2] + sp[3]);
                rtab[j * 256 + r] = __builtin_amdgcn_rsqf(((s4[0] + s4[1]) + (s4[2] + s4[3])) * (1.0f / D) + RMS_EPS); } }
    }
    __syncthreads();
}

#ifndef PHASE_ONLY
#define PHASE_ONLY -1
#endif
#ifndef PHASE_SKIP
#define PHASE_SKIP -2
#endif
#define PH(n) ((PHASE_ONLY < 0 || PHASE_ONLY == (n)) && PHASE_SKIP != (n))
#ifndef PROBE_DOUBLE
#define PROBE_DOUBLE -1
#endif
#define REPS(n) for (int rep_ = 0; rep_ < ((PROBE_DOUBLE == (n)) ? 2 : 1); ++rep_)
__global__ void __launch_bounds__(NTHREADS, 2) fwd_megakernel(Args A) {
    extern __shared__ __attribute__((aligned(16))) unsigned char lds[];
    Frame F;
    F.lds = (LAS unsigned char*)lds;
    F.MISC = (volatile LAS unsigned*)(F.lds + MISC_OFF);
    F.tid = threadIdx.x; F.lane = F.tid & 63; F.wave = __builtin_amdgcn_readfirstlane(F.tid >> 6);
    F.G = gridDim.x; { const int bx = blockIdx.x; F.vcu = (F.G % 8 == 0) ? (bx % 8) * (F.G / 8) + bx / 8 : bx; }
    F.ctl = (gu32*)(A.ws + WS_CTL);
    for (int u = F.tid; u < (LDS_BYTES - LDSCTL_OFF) / 4; u += NTHREADS) ((LAS unsigned*)(F.lds + LDSCTL_OFF))[u] = 0u;
    __syncthreads();
    XcdBarrier bar = xcd_barrier_post((unsigned*)(F.ctl + CW_BAR), F.MISC + 8);
#define GRID_BAR() do { xcd_barrier(bar); int t_ = threadIdx.x; asm volatile("" : "+v"(t_)); F.tid = t_; F.lane = t_ & 63; F.wave = __builtin_amdgcn_readfirstlane(t_ >> 6); } while (0)
    unsigned char* ws = A.ws;

    REPS(0) if (PH(0)) { p0a_mod(F, A); p0b_prologue<0>(F, A); }
    GRID_BAR();
    REPS(1) if (PH(1)) p0b_prologue<1>(F, A);
    GRID_BAR();
    REPS(2) if (PH(2)) {
        pg8::Gemm g{(const bf16*)(ws + WS_XG), nullptr, (const bf16*)(ws + WS_WIN), nullptr, D, D, D};
        pg8::StaticOrder S; S.init(T, INW, F.G, (int)blockIdx.x);
        LAS float* btab = (LAS float*)(F.lds + BTAB_OFF);
        stage_unit_tables<8, false>(F, S, (const float*)(ws + WS_BIAS1P), INW, btab, nullptr, btab);
        pg8::EpiIn E{(bf16*)(ws + WS_QKVP), (bf16*)(ws + WS_GAB), (const float*)(ws + WS_RSTD1), (const float*)(ws + WS_BIAS1P), (float*)(ws + WS_KSUM), (unsigned*)(ws + WS_CTL) + CW_NRM, btab};
        pg8::gemm_phase<pg8::EpiIn, pg8::StaticOrder, true, true>(F.lds + RING_OFF, g, S, E);
    }
    GRID_BAR();
    REPS(3) if (PH(3)) {
        const attn_body::AttnTensors AT{(const attn_body::bf16*)(ws + WS_QKVP), (const attn_body::bf16*)(ws + WS_QKVP) + (size_t)T * 512, (const attn_body::bf16*)(ws + WS_QKVP) + (size_t)2 * T * 512, (PROBE_DOUBLE == 3 && rep_ == 0) ? (attn_body::bf16*)(ws + WS_XG) : (attn_body::bf16*)(ws + WS_QKVP)};
        const attn_body::StaticOrder S((int)F.G, F.vcu);
        attn_body::attn_phase<attn_body::StaticOrder>((char*)lds + RING_OFF, AT, (const float*)(ws + WS_KSUM), (const float*)((const unsigned*)(ws + WS_CTL) + CW_NRM), S);
    }
    REPS(4) if (PH(4)) pooled_phase(F, A);
    GRID_BAR();
    REPS(5) if (PH(5)) {
        pg8::Gemm g{(const bf16*)(ws + WS_QKVP), (const bf16*)(ws + WS_POOLED), (const bf16*)(ws + WS_WA), (const bf16*)(ws + WS_WP), AW, AW, AW};
        pg8::DualOrder S; S.init(T, D, F.G, (int)blockIdx.x);
        pg8::EpiUp E{(bf16*)(ws + WS_XG), (const bf16*)(ws + WS_GAB), (const float*)(ws + WS_BPRIME)};
        pg8::gemm_phase<pg8::EpiUp, pg8::DualOrder, true, true>(F.lds + RING_OFF, g, S, E);
    }
    GRID_BAR();
    REPS(6) if (PH(6)) {
        pg8::Gemm g{(const bf16*)(ws + WS_XG), nullptr, (const bf16*)(ws + WS_WOUT), nullptr, D, D, D};
        pg8::StaticOrder S; S.init(T, D, F.G, (int)blockIdx.x);
        pg8::EpiOut E{A.in[0], A.out, (bf16*)(ws + WS_QKVP), (const float*)(ws + WS_MODF), A.in[12], (float*)(ws + WS_SS2)};
        pg8::gemm_phase<pg8::EpiOut, pg8::StaticOrder, true, true>(F.lds + RING_OFF, g, S, E);
    }
    GRID_BAR();
    REPS(7) if (PH(7)) {
        pg8::Gemm g{(const bf16*)(ws + WS_QKVP), nullptr, (const bf16*)(ws + WS_WQ), nullptr, D, D, D};
        pg8::StaticOrder S; S.init(T, PQW, F.G, (int)blockIdx.x);
        LAS float* btab = (LAS float*)(F.lds + BTAB_OFF); LAS float* rtab = (LAS float*)(F.lds + RTAB_OFF);
        stage_unit_tables<4, true>(F, S, (const float*)(ws + WS_BIAS2P), PQW, btab, (const float*)(ws + WS_SS2), rtab);
        pg8::EpiPq E{(bf16*)(ws + WS_GAB), (const float*)(ws + WS_SS2), (const float*)(ws + WS_BIAS2P), btab, rtab};
        pg8::gemm_phase<pg8::EpiPq, pg8::StaticOrder, true, true>(F.lds + RING_OFF, g, S, E);
    }
    GRID_BAR();
    REPS(8) if (PH(8)) router_phase(F, A);
    GRID_BAR();
    if (PH(9)) peer_sliced_phase(F, A);
}

extern "C" void kernel_launch(void* const* d_in, const int* in_sizes, int n_in, void* d_out, int out_size, void* d_ws, size_t ws_size, hipStream_t stream) {
    static int grid = 0;
    if (grid == 0) {
        if (n_in != 18 || in_sizes[0] != T * D || out_size != T * D || ws_size < WS_END) { fprintf(stderr, "kernel_launch: unexpected shapes (n_in %d, in0 %d, out %d, ws %zu); nothing launched\n", n_in, n_in > 0 ? in_sizes[0] : -1, out_size, ws_size); grid = -1; return; }
        int dev = 0, cus = 0, per_cu = 0;
        if (hipGetDevice(&dev) != hipSuccess || hipDeviceGetAttribute(&cus, hipDeviceAttributeMultiprocessorCount, dev) != hipSuccess) { grid = -1; return; }
        if (hipFuncSetAttribute((const void*)fwd_megakernel, hipFuncAttributeMaxDynamicSharedMemorySize, LDS_BYTES) != hipSuccess) { fprintf(stderr, "kernel_launch: hipFuncSetAttribute failed\n"); grid = -1; return; }
        if (hipOccupancyMaxActiveBlocksPerMultiprocessor(&per_cu, (const void*)fwd_megakernel, NTHREADS, LDS_BYTES) != hipSuccess || per_cu < 1) { fprintf(stderr, "kernel_launch: occupancy query reports %d workgroups per CU\n", per_cu); per_cu = 1; }
        (void)hipGetLastError();
        grid = cus;
        if ((long)grid * 8 < (long)(T / 256) * (INW / 256) || (long)grid * 4 < (long)(T / 256) * (PQW / 256)) { fprintf(stderr, "kernel_launch: %d workgroups are too few for the per-unit epilogue tables (need >= 256); nothing launched\n", grid); grid = -1; return; }
    }
    if (grid < 0) return;
    if (hipMemsetAsync((char*)d_ws + WS_CTL, 0, CTL_ZERO_BYTES, stream) != hipSuccess) { fprintf(stderr, "kernel_launch: hipMemsetAsync failed\n"); return; }
    Args a{};
    for (int i = 0; i < 18; ++i) a.in[i] = (const float*)d_in[i];
    a.out = (float*)d_out; a.ws = (unsigned char*)d_ws;
    void* kargs[] = {&a};
    hipError_t e = hipLaunchCooperativeKernel((const void*)fwd_megakernel, dim3(grid), dim3(NTHREADS), kargs, LDS_BYTES, stream);
    if (e != hipSuccess) fprintf(stderr, "kernel_launch: cooperative launch failed: %s (grid %d)\n", hipGetErrorString(e), grid);
}
```
